# Optimizing an MI355X kernel written in HIP

```python
import math
import jax, jax.numpy as jnp
from jax import lax
import numpy as np

D_MODEL = 1024
BATCH = 8
SEQ = 4096
DEPTH = 4

DA_HEADS = 4
DA_QK_DIM = 64
DA_V_DIM = 2 * DA_QK_DIM
DA_Q_W = DA_HEADS * 2 * DA_QK_DIM
DA_V_W = DA_HEADS * DA_V_DIM
Q_BLOCK = 128
ML_HEADS = 4
ML_QK_DIM = 64
ML_V_DIM = 128
ML_QK_W = ML_HEADS * ML_QK_DIM
ML_V_W = ML_HEADS * ML_V_DIM
CONV_WIDTH = 4
CHUNK = 64
MIX_W = DA_V_W + ML_V_W
IN_SPLITS = (DA_Q_W, DA_Q_W, DA_V_W, 2 * ML_QK_W, ML_V_W, ML_V_W)
IN_W = sum(IN_SPLITS) + 2 * ML_HEADS
N_EXPERTS = 32
TOP_K = 4
D_FF = 1024
SWIGLU_LIMIT = 7.0
SWIGLU_ALPHA = 1.702
MOE_BLOCK = 128
DN_ALPHA = (2 * DEPTH) ** 0.25
DN_BETA = (8 * DEPTH) ** -0.25
LN_EPS = 1e-5
RMS_EPS = 1e-5

kernel_name = "hybrid_diffattn_mlstm_moe_deepnorm"


def layer_norm(x, g, b):
    xf = x.astype(jnp.float32)
    mu = jnp.mean(xf, -1, keepdims=True)
    var = jnp.mean(jnp.square(xf - mu), -1, keepdims=True)
    return ((xf - mu) * lax.rsqrt(var + LN_EPS) * g + b).astype(x.dtype)


def rms_norm(x, g):
    xf = x.astype(jnp.float32)
    return (xf * lax.rsqrt(jnp.mean(xf * xf, -1, keepdims=True) + RMS_EPS) * g).astype(x.dtype)


def causal_depthwise_conv(x, w, b):
    y = lax.conv_general_dilated(x, w[:, None, :].astype(x.dtype), window_strides=(1,),
                                 padding=[(CONV_WIDTH - 1, 0)],
                                 dimension_numbers=('NWC', 'WIO', 'NWC'),
                                 feature_group_count=x.shape[-1])
    return y + b


def diff_attention(q, k, v, lam, lam_init, norm_g):
    B, S = q.shape[:2]
    nq = S // Q_BLOCK
    scale = DA_QK_DIM ** -0.5
    q_blocks = jnp.moveaxis(q.reshape(B, nq, Q_BLOCK, DA_HEADS, 2, DA_QK_DIM), 1, 0)
    k_pos = jnp.arange(S)

    def one_block(args):
        qb, blk = args
        s = jnp.einsum('bqhcd,bkhcd->bhcqk', qb, k).astype(jnp.float32) * scale
        q_pos = blk * Q_BLOCK + jnp.arange(Q_BLOCK)
        s = jnp.where(q_pos[:, None] >= k_pos[None, :], s, -jnp.inf)
        p = jax.nn.softmax(s, axis=-1)
        a = p[:, :, 0] - lam * p[:, :, 1]
        return jnp.einsum('bhqk,bkhe->bqhe', a.astype(v.dtype), v)

    o = lax.map(one_block, (q_blocks, jnp.arange(nq)))
    o = jnp.moveaxis(o, 0, 1).reshape(B, S, DA_HEADS, DA_V_DIM)
    o = rms_norm(o, norm_g) * (1.0 - lam_init)
    return o.reshape(B, S, DA_V_W)


def mlstm_chunkwise(q, k, v, i_pre, f_pre):
    B, S = q.shape[:2]
    nc = S // CHUNK
    f32 = jnp.float32

    def chunks(t):
        t = t.reshape((B, nc, CHUNK, ML_HEADS) + t.shape[3:])
        return jnp.moveaxis(t, 3, 1)

    q = chunks(q).astype(f32) * (ML_QK_DIM ** -0.5)
    k = chunks(k).astype(f32)
    v = chunks(v).astype(f32)
    ig = chunks(i_pre).astype(f32)
    lf = jax.nn.log_sigmoid(chunks(f_pre).astype(f32))
    bcum = jnp.cumsum(lf, axis=-1)
    g = bcum[..., -1]

    w_end = g[..., None] - bcum + ig
    m_loc = jnp.max(w_end, -1)
    e_end = jnp.exp(w_end - m_loc[..., None])
    C_loc = jnp.einsum('bhcs,bhcsv,bhcsk->bhcvk', e_end, v, k)
    n_loc = jnp.einsum('bhcs,bhcsk->bhck', e_end, k)

    def step(carry, xs):
        C, n, m = carry
        g_c, m_l, C_l, n_l = xs
        m_new = jnp.maximum(g_c + m, m_l)
        a = jnp.exp(g_c + m - m_new)
        bb = jnp.exp(m_l - m_new)
        C_new = a[..., None, None] * C + bb[..., None, None] * C_l
        n_new = a[..., None] * n + bb[..., None] * n_l
        return (C_new, n_new, m_new), (C, n, m)

    init = (jnp.zeros((B, ML_HEADS, ML_V_DIM, ML_QK_DIM), f32),
            jnp.zeros((B, ML_HEADS, ML_QK_DIM), f32),
            jnp.full((B, ML_HEADS), -jnp.inf, f32))
    xs = (jnp.moveaxis(g, 2, 0), jnp.moveaxis(m_loc, 2, 0),
          jnp.moveaxis(C_loc, 2, 0), jnp.moveaxis(n_loc, 2, 0))
    _, (C_prev, n_prev, m_prev) = lax.scan(step, init, xs)
    C_prev = jnp.moveaxis(C_prev, 0, 2)
    n_prev = jnp.moveaxis(n_prev, 0, 2)
    m_prev = jnp.moveaxis(m_prev, 0, 2)

    causal = jnp.tril(jnp.ones((CHUNK, CHUNK), bool))
    D = jnp.where(causal, bcum[..., :, None] - bcum[..., None, :] + ig[..., None, :], -jnp.inf)
    inter_log = bcum + m_prev[..., None]
    m_t = jnp.maximum(inter_log, jnp.max(D, -1))
    d_exp = jnp.exp(D - m_t[..., None])
    inter_w = jnp.exp(inter_log - m_t)
    s = jnp.einsum('bhctk,bhcsk->bhcts', q, k) * d_exp
    num = (inter_w[..., None] * jnp.einsum('bhcvk,bhctk->bhctv', C_prev, q)
           + jnp.einsum('bhcts,bhcsv->bhctv', s, v))
    den = inter_w * jnp.einsum('bhck,bhctk->bhct', n_prev, q) + jnp.sum(s, -1)
    h = num / jnp.maximum(jnp.abs(den), jnp.exp(-m_t))[..., None]
    return jnp.moveaxis(h, 1, 3).reshape(B, S, ML_HEADS, ML_V_DIM)


def mixer(x, w_in, conv_w, conv_b, gate_b, lam_q1, lam_k1, lam_q2, lam_k2, da_norm_g, w_out, lam_init):
    B, S, _ = x.shape
    proj = x @ w_in
    da_q, da_k, da_v, ml_qk, ml_v, ml_o, ml_g = jnp.split(proj, list(np.cumsum(IN_SPLITS)), axis=-1)
    lam = (jnp.exp(jnp.sum(lam_q1 * lam_k1).astype(jnp.float32))
           - jnp.exp(jnp.sum(lam_q2 * lam_k2).astype(jnp.float32)) + lam_init)
    da_out = diff_attention(da_q.reshape(B, S, DA_HEADS, 2, DA_QK_DIM),
                            da_k.reshape(B, S, DA_HEADS, 2, DA_QK_DIM),
                            da_v.reshape(B, S, DA_HEADS, DA_V_DIM), lam, lam_init, da_norm_g)
    ml_qk = jax.nn.silu(causal_depthwise_conv(ml_qk, conv_w, conv_b))
    ml_q, ml_k = jnp.split(ml_qk, 2, axis=-1)
    gates = ml_g + gate_b
    h = mlstm_chunkwise(ml_q.reshape(B, S, ML_HEADS, ML_QK_DIM),
                        ml_k.reshape(B, S, ML_HEADS, ML_QK_DIM),
                        ml_v.reshape(B, S, ML_HEADS, ML_V_DIM),
                        gates[..., :ML_HEADS], gates[..., ML_HEADS:])
    ml_out = (h.reshape(B, S, ML_V_W) * jax.nn.sigmoid(ml_o.astype(jnp.float32))).astype(x.dtype)
    return jnp.concatenate([da_out, ml_out], axis=-1) @ w_out


def moe(x, w_router, b_router, w_gu, b_gu, w_down, b_down):
    B, S, D = x.shape
    N = B * S
    A = N * TOP_K
    xt = x.reshape(N, D)
    logits = (xt @ w_router + b_router).astype(jnp.float32)
    top_v, top_e = lax.top_k(logits, TOP_K)
    gates = jax.nn.softmax(top_v, axis=-1)
    e_flat = top_e.reshape(A)
    tok_flat = jnp.arange(A, dtype=jnp.int32) // TOP_K
    order = jnp.argsort(e_flat)
    e_sorted = e_flat[order]
    tok_sorted = tok_flat[order]
    gate_sorted = gates.reshape(A)[order]
    counts = jnp.zeros((N_EXPERTS,), jnp.int32).at[e_flat].add(1)
    starts = jnp.cumsum(counts) - counts
    padded = (counts + MOE_BLOCK - 1) // MOE_BLOCK * MOE_BLOCK
    pad_ends = jnp.cumsum(padded)
    pad_starts = pad_ends - padded
    dest = pad_starts[e_sorted] + jnp.arange(A, dtype=jnp.int32) - starts[e_sorted]
    n_rows = A + N_EXPERTS * MOE_BLOCK
    n_blocks = n_rows // MOE_BLOCK
    row_tok = jnp.full((n_rows,), N, jnp.int32).at[dest].set(tok_sorted)
    x_pad = jnp.concatenate([xt, jnp.zeros((1, D), xt.dtype)], axis=0)
    xs = x_pad[row_tok].reshape(n_blocks, MOE_BLOCK, D)
    block_e = jnp.minimum(jnp.searchsorted(pad_ends, jnp.arange(n_blocks) * MOE_BLOCK, side='right'),
                          N_EXPERTS - 1)

    def expert_block(args):
        xb, e = args
        hgu = xb @ w_gu[e] + b_gu[e]
        gate = jnp.minimum(hgu[:, :D_FF], SWIGLU_LIMIT)
        up = jnp.clip(hgu[:, D_FF:], -SWIGLU_LIMIT, SWIGLU_LIMIT)
        glu = gate * jax.nn.sigmoid(SWIGLU_ALPHA * gate)
        return ((up + 1.0) * glu) @ w_down[e] + b_down[e]

    ys = lax.map(expert_block, (xs, block_e)).reshape(n_rows, D)
    y = jax.ops.segment_sum(ys[dest] * gate_sorted[:, None].astype(ys.dtype), tok_sorted, num_segments=N)
    return y.reshape(B, S, D)


def setup_inputs(seed: int = 0) -> dict:
    key = jax.random.key(seed)
    ks = jax.random.split(key, 22)
    nrm = jax.random.normal
    f32 = jnp.float32
    x = nrm(ks[0], (BATCH, SEQ, D_MODEL), f32)
    col_scale = np.ones((IN_W,), np.float32)
    off_v = 2 * DA_Q_W
    col_scale[off_v:off_v + DA_V_W] = DN_BETA
    off_mv = 2 * DA_Q_W + DA_V_W + 2 * ML_QK_W
    col_scale[off_mv:off_mv + ML_V_W] = DN_BETA
    w_in = nrm(ks[1], (DEPTH, D_MODEL, IN_W), f32) * (D_MODEL ** -0.5) * jnp.asarray(col_scale)
    conv_w = nrm(ks[2], (DEPTH, CONV_WIDTH, 2 * ML_QK_W), f32) * (CONV_WIDTH ** -0.5)
    conv_b = 0.01 * nrm(ks[3], (DEPTH, 2 * ML_QK_W), f32)
    gate_b = jnp.concatenate([
        0.1 * nrm(ks[4], (DEPTH, ML_HEADS), f32),
        jnp.linspace(3.0, 6.0, ML_HEADS, dtype=f32)[None, :] + 0.1 * nrm(ks[5], (DEPTH, ML_HEADS), f32)], axis=-1)
    lam_q1 = 0.1 * nrm(ks[6], (DEPTH, DA_QK_DIM), f32)
    lam_k1 = 0.1 * nrm(ks[7], (DEPTH, DA_QK_DIM), f32)
    lam_q2 = 0.1 * nrm(ks[8], (DEPTH, DA_QK_DIM), f32)
    lam_k2 = 0.1 * nrm(ks[9], (DEPTH, DA_QK_DIM), f32)
    da_norm_g = 1.0 + 0.01 * nrm(ks[10], (DEPTH, DA_V_DIM), f32)
    w_out = nrm(ks[11], (DEPTH, MIX_W, D_MODEL), f32) * (MIX_W ** -0.5) * DN_BETA
    ln1_g = 1.0 + 0.01 * nrm(ks[12], (DEPTH, D_MODEL), f32)
    ln1_b = 0.01 * nrm(ks[13], (DEPTH, D_MODEL), f32)
    w_router = nrm(ks[14], (DEPTH, D_MODEL, N_EXPERTS), f32) * (D_MODEL ** -0.5)
    b_router = 0.01 * nrm(ks[15], (DEPTH, N_EXPERTS), f32)
    w_gu = nrm(ks[16], (DEPTH, N_EXPERTS, D_MODEL, 2 * D_FF), f32) * (D_MODEL ** -0.5) * DN_BETA
    b_gu = 0.01 * nrm(ks[17], (DEPTH, N_EXPERTS, 2 * D_FF), f32)
    w_down = nrm(ks[18], (DEPTH, N_EXPERTS, D_FF, D_MODEL), f32) * (D_FF ** -0.5) * DN_BETA
    b_down = 0.01 * nrm(ks[19], (DEPTH, N_EXPERTS, D_MODEL), f32)
    ln2_g = 1.0 + 0.01 * nrm(ks[20], (DEPTH, D_MODEL), f32)
    ln2_b = 0.01 * nrm(ks[21], (DEPTH, D_MODEL), f32)
    return {"x": x, "w_in": w_in, "conv_w": conv_w, "conv_b": conv_b, "gate_b": gate_b,
            "lam_q1": lam_q1, "lam_k1": lam_k1, "lam_q2": lam_q2, "lam_k2": lam_k2,
            "da_norm_g": da_norm_g, "w_out": w_out, "ln1_g": ln1_g, "ln1_b": ln1_b,
            "w_router": w_router, "b_router": b_router, "w_gu": w_gu, "b_gu": b_gu,
            "w_down": w_down, "b_down": b_down, "ln2_g": ln2_g, "ln2_b": ln2_b}


def reference(x, w_in, conv_w, conv_b, gate_b, lam_q1, lam_k1, lam_q2, lam_k2, da_norm_g, w_out,
              ln1_g, ln1_b, w_router, b_router, w_gu, b_gu, w_down, b_down, ln2_g, ln2_b):
    for l in range(DEPTH):
        lam_init = 0.8 - 0.6 * math.exp(-0.3 * l)
        mix = mixer(x, w_in[l], conv_w[l], conv_b[l], gate_b[l], lam_q1[l], lam_k1[l], lam_q2[l],
                    lam_k2[l], da_norm_g[l], w_out[l], lam_init)
        x = layer_norm(DN_ALPHA * x + mix, ln1_g[l], ln1_b[l])
        ffn = moe(x, w_router[l], b_router[l], w_gu[l], b_gu[l], w_down[l], b_down[l])
        x = layer_norm(DN_ALPHA * x + ffn, ln2_g[l], ln2_b[l])
    return x
```

```cpp
#include <hip/hip_runtime.h>
#include <cstdio>
#include <cstdint>
#include <cmath>
namespace nv {
constexpr int B = 8, S = 4096, N = B * S, D = 1024, INW = 3080, DEPTH = 4;
constexpr int E = 32, TOPK = 4, DFF = 1024;
constexpr int MAXT = (N * TOPK) / 128 + E;
constexpr int MAXROWS = MAXT * 128;

__device__ __forceinline__ float sigm(float x) { return 1.f / (1.f + expf(-x)); }

template <int MODE>
__device__ __forceinline__ void gemm_tile(const float* __restrict__ A, int lda, const int* __restrict__ rowidx, int m0,
                                          const float* __restrict__ Bm, int ldb, int n0, int Nn, int K,
                                          const float* __restrict__ bias, float* __restrict__ C, int ldc, float* As, float* Bs) {
    const int tid = threadIdx.x, ty = tid >> 4, tx = tid & 15;
    const int ar = tid >> 1, ak = (tid & 1) * 8;
    long arow = rowidx ? (long)rowidx[m0 + ar] : (long)(m0 + ar);
    const float* ap = (arow >= 0) ? A + arow * (long)lda + ak : nullptr;
    const int bk = tid >> 4, bn = (tid & 15) * 8;
    int bcol[8]; bool bok[8];
#pragma unroll
    for (int j = 0; j < 8; ++j) {
        const int c = bn + j;
        int col;
        if (MODE == 0) col = n0 + c; else col = (c < 64) ? (n0 + c) : (1024 + n0 + c - 64);
        bcol[j] = col; bok[j] = col < Nn;
    }
    float acc[8][8];
#pragma unroll
    for (int i = 0; i < 8; ++i)
#pragma unroll
        for (int j = 0; j < 8; ++j) acc[i][j] = 0.f;
    for (int k0 = 0; k0 < K; k0 += 16) {
        float4 a0 = make_float4(0.f, 0.f, 0.f, 0.f), a1 = a0;
        if (ap) { a0 = *(const float4*)(ap + k0); a1 = *(const float4*)(ap + k0 + 4); }
        As[(ak + 0) * 132 + ar] = a0.x; As[(ak + 1) * 132 + ar] = a0.y; As[(ak + 2) * 132 + ar] = a0.z; As[(ak + 3) * 132 + ar] = a0.w;
        As[(ak + 4) * 132 + ar] = a1.x; As[(ak + 5) * 132 + ar] = a1.y; As[(ak + 6) * 132 + ar] = a1.z; As[(ak + 7) * 132 + ar] = a1.w;
#pragma unroll
        for (int j = 0; j < 8; ++j) Bs[bk * 128 + bn + j] = bok[j] ? Bm[(long)(k0 + bk) * ldb + bcol[j]] : 0.f;
        __syncthreads();
#pragma unroll
        for (int kk = 0; kk < 16; ++kk) {
            float a[8], b[8];
#pragma unroll
            for (int i = 0; i < 8; ++i) a[i] = As[kk * 132 + ty * 8 + i];
#pragma unroll
            for (int j = 0; j < 4; ++j) { b[j] = Bs[kk * 128 + tx * 4 + j]; b[j + 4] = Bs[kk * 128 + 64 + tx * 4 + j]; }
#pragma unroll
            for (int i = 0; i < 8; ++i)
#pragma unroll
                for (int j = 0; j < 8; ++j) acc[i][j] += a[i] * b[j];
        }
        __syncthreads();
    }
    if (MODE == 0) {
#pragma unroll
        for (int i = 0; i < 8; ++i) {
            const int m = m0 + ty * 8 + i;
#pragma unroll
            for (int j = 0; j < 8; ++j) {
                const int n = n0 + ((j < 4) ? (tx * 4 + j) : (64 + tx * 4 + j - 4));
                if (n < Nn) C[(long)m * ldc + n] = acc[i][j] + (bias ? bias[n] : 0.f);
            }
        }
    } else {
#pragma unroll
        for (int i = 0; i < 8; ++i) {
            const int m = m0 + ty * 8 + i;
#pragma unroll
            for (int j = 0; j < 4; ++j) {
                const int nh = n0 + tx * 4 + j;
                const float g = fminf(acc[i][j] + bias[nh], 7.0f);
                const float u = fminf(fmaxf(acc[i][j + 4] + bias[1024 + nh], -7.0f), 7.0f);
                const float glu = g * sigm(1.702f * g);
                C[(long)m * ldc + nh] = (u + 1.0f) * glu;
            }
        }
    }
}

__global__ __launch_bounds__(256) void gemm_plain(const float* A, int lda, const float* Bm, int ldb, const float* bias, float* C, int ldc, int Nn, int K) {
    __shared__ float As[16 * 132]; __shared__ float Bs[16 * 128];
    gemm_tile<0>(A, lda, nullptr, blockIdx.y * 128, Bm, ldb, blockIdx.x * 128, Nn, K, bias, C, ldc, As, Bs);
}
template <int MODE>
__global__ __launch_bounds__(256) void gemm_grouped(const float* A, int lda, const int* rowidx, const float* W, int ldb, size_t strideW, const float* bias, size_t strideBias,
                                                    const int* plan, float* C, int ldc, int Nn, int K) {
    __shared__ float As[16 * 132]; __shared__ float Bs[16 * 128];
    const int t = blockIdx.y; if (t >= plan[0]) return;
    const int e = plan[64 + t];
    gemm_tile<MODE>(A, lda, rowidx, t * 128, W + (size_t)e * strideW, ldb, blockIdx.x * (MODE == 0 ? 128 : 64), Nn, K, bias + (size_t)e * strideBias, C, ldc, As, Bs);
}

__global__ void convsilu(const float* proj, const float* cw, const float* cb, float* act) {
    const long i = (long)blockIdx.x * blockDim.x + threadIdx.x; if (i >= (long)N * 512) return;
    const int ch = (int)(i % 512); const long n = i / 512; const int t = (int)(n % S);
    float y = cb[ch];
#pragma unroll
    for (int j = 0; j < 4; ++j) { const int tt = t - 3 + j; if (tt >= 0) y += cw[j * 512 + ch] * proj[(n - 3 + j) * INW + 1536 + ch]; }
    act[i] = y * sigm(y);
}

__device__ __forceinline__ float lam_of(const float* q1, const float* k1, const float* q2, const float* k2, float lam_init) {
    float s1 = 0.f, s2 = 0.f;
    for (int i = 0; i < 64; ++i) { s1 += q1[i] * k1[i]; s2 += q2[i] * k2[i]; }
    return expf(s1) - expf(s2) + lam_init;
}

__global__ __launch_bounds__(256) void attn_naive(const float* proj, const float* q1, const float* k1, const float* q2, const float* k2, const float* ng, float lam_init, float* mixin) {
    extern __shared__ float sm[];
    float* sc = sm;
    __shared__ float qs[4][128]; __shared__ float mx[8], il[8]; __shared__ float part[2][4][128]; __shared__ float rinv[4];
    const int tid = threadIdx.x, lane = tid & 63, w = tid >> 6;
    const int blk = blockIdx.x; const int qb = blk % (S / 4); const int h = (blk / (S / 4)) % 4; const int b = blk / (S / 4) / 4;
    const int t0 = qb * 4, tmax = t0 + 3;
    const long rowb = (long)b * S;
    const float lam = lam_of(q1, k1, q2, k2, lam_init);
    for (int i = tid; i < 512; i += 256) qs[i >> 7][i & 127] = proj[(rowb + t0 + (i >> 7)) * INW + h * 128 + (i & 127)];
    __syncthreads();
    for (int s = tid; s <= tmax; s += 256) {
        const float* kp = proj + (rowb + s) * INW + 512 + h * 128;
        float d[2][4] = {{0.f, 0.f, 0.f, 0.f}, {0.f, 0.f, 0.f, 0.f}};
#pragma unroll
        for (int c = 0; c < 2; ++c)
#pragma unroll 2
            for (int x = 0; x < 64; x += 4) {
                const float4 kv = *(const float4*)(kp + c * 64 + x);
#pragma unroll
                for (int r = 0; r < 4; ++r) d[c][r] += kv.x * qs[r][c * 64 + x] + kv.y * qs[r][c * 64 + x + 1] + kv.z * qs[r][c * 64 + x + 2] + kv.w * qs[r][c * 64 + x + 3];
            }
#pragma unroll
        for (int c = 0; c < 2; ++c)
#pragma unroll
            for (int r = 0; r < 4; ++r) sc[(c * 4 + r) * 4096 + s] = (s <= t0 + r) ? d[c][r] * 0.125f : -INFINITY;
    }
    __syncthreads();
    for (int cb = w; cb < 8; cb += 4) {
        float m = -INFINITY;
        for (int s = lane; s <= tmax; s += 64) m = fmaxf(m, sc[cb * 4096 + s]);
        for (int o = 32; o > 0; o >>= 1) m = fmaxf(m, __shfl_xor(m, o));
        float l = 0.f;
        for (int s = lane; s <= tmax; s += 64) l += expf(sc[cb * 4096 + s] - m);
        for (int o = 32; o > 0; o >>= 1) l += __shfl_xor(l, o);
        if (lane == 0) { mx[cb] = m; il[cb] = 1.f / l; }
    }
    __syncthreads();
    for (int s = tid; s <= tmax; s += 256)
#pragma unroll
        for (int r = 0; r < 4; ++r) {
            const float p0 = expf(sc[(0 * 4 + r) * 4096 + s] - mx[r]) * il[r];
            const float p1 = expf(sc[(1 * 4 + r) * 4096 + s] - mx[4 + r]) * il[4 + r];
            sc[r * 4096 + s] = p0 - lam * p1;
        }
    __syncthreads();
    {
        const int e = tid & 127, half = tid >> 7;
        float acc[4] = {0.f, 0.f, 0.f, 0.f};
        for (int s = half; s <= tmax; s += 2) {
            const float v = proj[(rowb + s) * INW + 1024 + h * 128 + e];
#pragma unroll
            for (int r = 0; r < 4; ++r) acc[r] += sc[r * 4096 + s] * v;
        }
#pragma unroll
        for (int r = 0; r < 4; ++r) part[half][r][e] = acc[r];
    }
    __syncthreads();
    if (tid < 4) { float ss = 0.f; for (int e = 0; e < 128; ++e) { const float o = part[0][tid][e] + part[1][tid][e]; ss += o * o; } rinv[tid] = rsqrtf(ss / 128.f + 1e-5f); }
    __syncthreads();
    for (int i = tid; i < 512; i += 256) { const int r = i >> 7, e = i & 127;
        mixin[(rowb + t0 + r) * 1024 + h * 128 + e] = (part[0][r][e] + part[1][r][e]) * rinv[r] * ng[e] * (1.0f - lam_init); }
}

__global__ __launch_bounds__(512) void mlstm_naive(const float* proj, const float* act, const float* gate_b, float* mixin) {
    const int tid = threadIdx.x, v = tid >> 2, kg = tid & 3;
    const int b = blockIdx.x / 4, h = blockIdx.x % 4;
    float C[16], nn[16];
#pragma unroll
    for (int i = 0; i < 16; ++i) { C[i] = 0.f; nn[i] = 0.f; }
    float m = -INFINITY;
    const float bi_ = gate_b[h], bf_ = gate_b[4 + h];
    for (int t = 0; t < S; ++t) {
        const long n = (long)b * S + t;
        const float* pr = proj + n * INW;
        const float ig = pr[3072 + h] + bi_, fg = pr[3076 + h] + bf_;
        const float lf = fminf(fg, 0.f) - log1pf(expf(-fabsf(fg)));
        const float mn = fmaxf(lf + m, ig);
        const float a = expf(lf + m - mn), bb = expf(ig - mn);
        const float vv = pr[2048 + h * 128 + v];
        const float* qp = act + n * 512 + h * 64 + kg * 16;
        const float* kp = act + n * 512 + 256 + h * 64 + kg * 16;
        float num = 0.f, den = 0.f;
#pragma unroll
        for (int i = 0; i < 16; ++i) {
            const float kk = kp[i], qq = qp[i] * 0.125f;
            C[i] = a * C[i] + bb * vv * kk; nn[i] = a * nn[i] + bb * kk;
            num += C[i] * qq; den += nn[i] * qq;
        }
        num += __shfl_xor(num, 1); num += __shfl_xor(num, 2);
        den += __shfl_xor(den, 1); den += __shfl_xor(den, 2);
        m = mn;
        if (kg == 0) {
            const float hh = num / fmaxf(fabsf(den), expf(-mn));
            mixin[n * 1024 + 512 + h * 128 + v] = hh * sigm(pr[2560 + h * 128 + v]);
        }
    }
}

__global__ __launch_bounds__(256) void ln_res(const float* x, const float* y, const float* g, const float* bta, float alpha, float* out) {
    __shared__ float red[8];
    const long r = blockIdx.x; const int tid = threadIdx.x;
    float v[4]; float s = 0.f;
    for (int j = 0; j < 4; ++j) { const int c = tid + 256 * j; v[j] = alpha * x[r * D + c] + y[r * D + c]; s += v[j]; }
    for (int o = 32; o > 0; o >>= 1) s += __shfl_xor(s, o);
    if ((tid & 63) == 0) red[tid >> 6] = s; __syncthreads();
    const float mean = (red[0] + red[1] + red[2] + red[3]) / D; __syncthreads();
    float q = 0.f; for (int j = 0; j < 4; ++j) { v[j] -= mean; q += v[j] * v[j]; }
    for (int o = 32; o > 0; o >>= 1) q += __shfl_xor(q, o);
    if ((tid & 63) == 0) red[tid >> 6] = q; __syncthreads();
    const float rstd = rsqrtf((red[0] + red[1] + red[2] + red[3]) / D + 1e-5f);
    for (int j = 0; j < 4; ++j) { const int c = tid + 256 * j; out[r * D + c] = v[j] * rstd * g[c] + bta[c]; }
}

__global__ void route(const float* logits, int* cnt, int* tok_e, int* tok_pos, float* tok_g) {
    const int t = blockIdx.x * blockDim.x + threadIdx.x; if (t >= N) return;
    float l[32];
#pragma unroll
    for (int e = 0; e < 32; ++e) l[e] = logits[(long)t * 32 + e];
    int idx[4]; float val[4]; unsigned taken = 0u;
#pragma unroll
    for (int k = 0; k < 4; ++k) { int bi = 0; float bv = -INFINITY;
#pragma unroll
        for (int e = 0; e < 32; ++e) { const bool ok = !((taken >> e) & 1u) && (l[e] > bv); bv = ok ? l[e] : bv; bi = ok ? e : bi; }
        idx[k] = bi; val[k] = bv; taken |= 1u << bi; }
    float s = 0.f, p[4];
#pragma unroll
    for (int k = 0; k < 4; ++k) { p[k] = expf(val[k] - val[0]); s += p[k]; }
#pragma unroll
    for (int k = 0; k < 4; ++k) { tok_e[t * 4 + k] = idx[k]; tok_g[t * 4 + k] = p[k] / s; tok_pos[t * 4 + k] = atomicAdd(&cnt[idx[k]], 1); }
}
__global__ void plan_k(const int* cnt, int* plan) {
    if (threadIdx.x != 0 || blockIdx.x != 0) return;
    int t = 0;
    for (int e = 0; e < 32; ++e) { plan[1 + e] = t * 128; const int nt = (cnt[e] + 127) / 128; for (int i = 0; i < nt; ++i) plan[64 + t + i] = e; t += nt; }
    plan[0] = t;
}
__global__ void scatter_k(const int* tok_e, const int* tok_pos, const int* plan, int* rowtok) {
    const int i = blockIdx.x * blockDim.x + threadIdx.x; if (i >= N * 4) return;
    rowtok[plan[1 + tok_e[i]] + tok_pos[i]] = i >> 2;
}
__global__ __launch_bounds__(256) void combine_ln(const float* x1, const float* Y, const int* tok_e, const int* tok_pos, const float* tok_g, const int* plan,
                                                  const float* g, const float* bta, float alpha, float* out) {
    __shared__ float red[8];
    const long r = blockIdx.x; const int tid = threadIdx.x;
    long yr[4]; float gg[4];
    for (int k = 0; k < 4; ++k) { yr[k] = (long)(plan[1 + tok_e[r * 4 + k]] + tok_pos[r * 4 + k]); gg[k] = tok_g[r * 4 + k]; }
    float v[4]; float s = 0.f;
    for (int j = 0; j < 4; ++j) { const int c = tid + 256 * j; float y = 0.f; for (int k = 0; k < 4; ++k) y += gg[k] * Y[yr[k] * D + c]; v[j] = alpha * x1[r * D + c] + y; s += v[j]; }
    for (int o = 32; o > 0; o >>= 1) s += __shfl_xor(s, o);
    if ((tid & 63) == 0) red[tid >> 6] = s; __syncthreads();
    const float mean = (red[0] + red[1] + red[2] + red[3]) / D; __syncthreads();
    float q = 0.f; for (int j = 0; j < 4; ++j) { v[j] -= mean; q += v[j] * v[j]; }
    for (int o = 32; o > 0; o >>= 1) q += __shfl_xor(q, o);
    if ((tid & 63) == 0) red[tid >> 6] = q; __syncthreads();
    const float rstd = rsqrtf((red[0] + red[1] + red[2] + red[3]) / D + 1e-5f);
    for (int j = 0; j < 4; ++j) { const int c = tid + 256 * j; out[r * D + c] = v[j] * rstd * g[c] + bta[c]; }
}
}
namespace nv {
constexpr size_t MiBn = 1u << 20;
constexpr size_t NW_CTL = 0;
constexpr size_t NW_TOKE = 1 * MiBn, NW_TOKP = 2 * MiBn, NW_TOKG = 3 * MiBn, NW_ROWTOK = 4 * MiBn;
constexpr size_t NW_LOGITS = 8 * MiBn;
constexpr size_t NW_PROJ = 16 * MiBn;
constexpr size_t NW_ACT = NW_PROJ + 400 * MiBn;
constexpr size_t NW_MIXIN = NW_ACT + 64 * MiBn;
constexpr size_t NW_MIX = NW_MIXIN + 128 * MiBn;
constexpr size_t NW_X1 = NW_MIX + 128 * MiBn;
constexpr size_t NW_X = NW_X1 + 128 * MiBn;
constexpr size_t NW_H = NW_X + 128 * MiBn;
constexpr size_t NW_Y = NW_H + 528 * MiBn;
constexpr size_t NW_END = NW_Y + 528 * MiBn;

static void run_naive(void* const* d_in, float* d_out, unsigned char* ws, hipStream_t st) {
    const float* x_in = (const float*)d_in[0]; const float* w_in = (const float*)d_in[1]; const float* conv_w = (const float*)d_in[2]; const float* conv_b = (const float*)d_in[3];
    const float* gate_b = (const float*)d_in[4]; const float* lq1 = (const float*)d_in[5]; const float* lk1 = (const float*)d_in[6]; const float* lq2 = (const float*)d_in[7]; const float* lk2 = (const float*)d_in[8];
    const float* ng = (const float*)d_in[9]; const float* w_out = (const float*)d_in[10]; const float* ln1g = (const float*)d_in[11]; const float* ln1b = (const float*)d_in[12];
    const float* w_router = (const float*)d_in[13]; const float* b_router = (const float*)d_in[14]; const float* w_gu = (const float*)d_in[15]; const float* b_gu = (const float*)d_in[16];
    const float* w_down = (const float*)d_in[17]; const float* b_down = (const float*)d_in[18]; const float* ln2g = (const float*)d_in[19]; const float* ln2b = (const float*)d_in[20];
    int* cnt = (int*)(ws + NW_CTL); int* plan = (int*)(ws + NW_CTL + 4096);
    int* tok_e = (int*)(ws + NW_TOKE); int* tok_pos = (int*)(ws + NW_TOKP); float* tok_g = (float*)(ws + NW_TOKG); int* rowtok = (int*)(ws + NW_ROWTOK);
    float* logits = (float*)(ws + NW_LOGITS); float* proj = (float*)(ws + NW_PROJ); float* act = (float*)(ws + NW_ACT); float* mixin = (float*)(ws + NW_MIXIN);
    float* mix = (float*)(ws + NW_MIX); float* x1 = (float*)(ws + NW_X1); float* X = (float*)(ws + NW_X); float* H = (float*)(ws + NW_H); float* Y = (float*)(ws + NW_Y);
    static bool once = false;
    if (!once) { (void)hipFuncSetAttribute((const void*)attn_naive, hipFuncAttributeMaxDynamicSharedMemorySize, 131072); once = true; }
    const float alpha = 1.681792830507429f;
    for (int l = 0; l < DEPTH; ++l) {
        const float lam_init = (float)(0.8 - 0.6 * exp(-0.3 * (double)l));
        const float* xc = (l == 0) ? x_in : X;
        float* xo = (l == DEPTH - 1) ? d_out : X;
        hipLaunchKernelGGL(gemm_plain, dim3(25, N / 128), dim3(256), 0, st, xc, D, w_in + (size_t)l * D * INW, INW, (const float*)nullptr, proj, INW, INW, D);
        hipLaunchKernelGGL(convsilu, dim3(N * 512 / 256), dim3(256), 0, st, (const float*)proj, conv_w + l * 4 * 512, conv_b + l * 512, act);
        hipLaunchKernelGGL(attn_naive, dim3(B * 4 * (S / 4)), dim3(256), 131072, st, (const float*)proj, lq1 + l * 64, lk1 + l * 64, lq2 + l * 64, lk2 + l * 64, ng + l * 128, lam_init, mixin);
        hipLaunchKernelGGL(mlstm_naive, dim3(B * 4), dim3(512), 0, st, (const float*)proj, (const float*)act, gate_b + l * 8, mixin);
        hipLaunchKernelGGL(gemm_plain, dim3(8, N / 128), dim3(256), 0, st, (const float*)mixin, D, w_out + (size_t)l * D * D, D, (const float*)nullptr, mix, D, D, D);
        hipLaunchKernelGGL(ln_res, dim3(N), dim3(256), 0, st, xc, (const float*)mix, ln1g + l * D, ln1b + l * D, alpha, x1);
        hipLaunchKernelGGL(gemm_plain, dim3(1, N / 128), dim3(256), 0, st, (const float*)x1, D, w_router + (size_t)l * D * E, E, b_router + l * E, logits, E, E, D);
        (void)hipMemsetAsync(cnt, 0, 4096, st);
        hipLaunchKernelGGL(route, dim3(N / 256), dim3(256), 0, st, (const float*)logits, cnt, tok_e, tok_pos, tok_g);
        hipLaunchKernelGGL(plan_k, dim3(1), dim3(64), 0, st, (const int*)cnt, plan);
        (void)hipMemsetAsync(rowtok, 0xFF, (size_t)MAXROWS * 4, st);
        hipLaunchKernelGGL(scatter_k, dim3(N * 4 / 256), dim3(256), 0, st, (const int*)tok_e, (const int*)tok_pos, (const int*)plan, rowtok);
        hipLaunchKernelGGL(gemm_grouped<1>, dim3(16, MAXT), dim3(256), 0, st, (const float*)x1, D, (const int*)rowtok, w_gu + (size_t)l * E * D * 2 * DFF, 2 * DFF, (size_t)D * 2 * DFF,
                           b_gu + (size_t)l * E * 2 * DFF, (size_t)2 * DFF, (const int*)plan, H, DFF, 2 * DFF, D);
        hipLaunchKernelGGL(gemm_grouped<0>, dim3(8, MAXT), dim3(256), 0, st, (const float*)H, DFF, (const int*)nullptr, w_down + (size_t)l * E * DFF * D, D, (size_t)DFF * D,
                           b_down + (size_t)l * E * D, (size_t)D, (const int*)plan, Y, D, D, DFF);
        hipLaunchKernelGGL(combine_ln, dim3(N), dim3(256), 0, st, (const float*)x1, (const float*)Y, (const int*)tok_e, (const int*)tok_pos, (const float*)tok_g, (const int*)plan,
                           ln2g + l * D, ln2b + l * D, alpha, xo);
    }
}
}
extern "C" void kernel_launch(void* const* d_in, const int* in_sizes, int n_in, void* d_out, int out_size, void* d_ws, size_t ws_size, hipStream_t stream) {
    if (n_in != 21 || ws_size < nv::NW_END) { fprintf(stderr, "kernel_launch: unexpected n_in %d or ws %zu\n", n_in, ws_size); return; }
    nv::run_naive(d_in, (float*)d_out, (unsigned char*)d_ws, stream);
}
```

```cpp
#include <hip/hip_runtime.h>
#include <cstdio>
#include <cstdint>
#include <cmath>
namespace pg8 {
#define PG8_LAS __attribute__((address_space(3)))
#ifndef PG8_STORES_IN_FLIGHT
#define PG8_STORES_IN_FLIGHT 0
#endif
#define PG8_NSTORE(n) (PG8_STORES_IN_FLIGHT ? (n) : 0)
typedef unsigned short bf16_t;
typedef short bf16x8 __attribute__((ext_vector_type(8)));
typedef float f32x4 __attribute__((ext_vector_type(4)));
typedef unsigned u32x4 __attribute__((ext_vector_type(4)));
typedef int i32x4_t __attribute__((ext_vector_type(4)));
typedef int i32x8_t __attribute__((ext_vector_type(8)));
constexpr int BM = 256, BK = 64, HALF = 128, HTB = HALF * BK * 2  , STAGE_BYTES = 8 * HTB, NXCD = 8, WGM = 8;

__host__ __device__ __forceinline__ int lds_byte(int r, int c) { const int st = (r >> 4) * 2 + (c >> 5), rr = r & 15, cc = c & 31, ob = rr * 64 + cc * 2; return st * 1024 + (ob ^ (((ob >> 9) & 1) << 5)); }
__host__ __device__ __forceinline__ void stage_rc(int b, int& R, int& C) { const int st = b / 1024, sb = b % 1024, swz = sb ^ (((sb >> 9) & 1) << 5); R = (st >> 1) * 16 + swz / 64; C = (st & 1) * 32 + (swz % 64) / 2; }
__host__ __device__ __forceinline__ int perm32(int rho) { const int n = rho >> 4, i = rho & 15; return 8 * (i >> 2) + 4 * n + (i & 3); }

struct Unit { int pm, pn, e, pnl, nvalid, rbase; };

struct Gemm { const bf16_t* A; const bf16_t* Bt; int M, N, K; };

struct StaticOrder {
    int nM, nN, nwg, G, c; PG8_LAS unsigned* gtab = nullptr;
    __host__ __device__ void init(int M, int N, int G_, int c_) { nM = M / BM; nN = N / BM; nwg = nM * nN; G = G_; c = c_; }
    __host__ __device__ bool next(int i, Unit& u) const {
        const long L = (long)i * G + c; if (L >= nwg) return false;
        int wgid = (int)L; { const int q = nwg / NXCD, r = nwg % NXCD, xcd = wgid % NXCD, off = wgid / NXCD; wgid = (xcd < r ? xcd * (q + 1) : r * (q + 1) + (xcd - r) * q) + off; }
        const int nig = WGM * nN, gid = wgid / nig, fm = gid * WGM, gsz = (nM - fm) < WGM ? (nM - fm) : WGM;
        u.pm = fm + ((wgid % nig) % gsz); u.pn = (wgid % nig) / gsz; u.e = 0; u.pnl = u.pn; u.nvalid = BM; u.rbase = 0; return true;
    }
    __device__ __forceinline__ int arow(const Unit&, int) const { return 0; }
    __device__ __forceinline__ void a_ready(const Unit&) const {}
    __device__ __forceinline__ void done(const Unit&) const {}
};

__device__ __forceinline__ unsigned cvt_pk_bf16(float lo, float hi) { unsigned r; asm volatile("v_cvt_pk_bf16_f32 %0, %1, %2" : "=v"(r) : "v"(lo), "v"(hi)); return r; }
typedef float f32x2 __attribute__((ext_vector_type(2)));
__device__ __forceinline__ f32x2 gelu_pk(f32x2 v) {
    const f32x2 av = __builtin_elementwise_abs(v), d = av * 0.2316418882f + 1.0f;
    f32x2 t; t.x = __builtin_amdgcn_rcpf(d.x); t.y = __builtin_amdgcn_rcpf(d.y);
    f32x2 q = t * 0.5307027145f + (-0.7265760135f); q = q * t + 0.7107068705f; q = q * t + (-0.142248368f); q = q * t + 0.127414796f; q = q * t;
    const f32x2 s = (v * v) * (-0.72134752044f);
    f32x2 e; e.x = __builtin_amdgcn_exp2f(s.x); e.y = __builtin_amdgcn_exp2f(s.y);
    const f32x2 m = v * (q * e), r = v - m;
    f32x2 o; o.x = v.x < 0.f ? m.x : r.x; o.y = v.y < 0.f ? m.y : r.y; return o;
}

template <int ACT  > struct EpiBf16 {
    static constexpr int PERM = 1; static constexpr bool AFTER_DRAIN = false; static_assert(ACT == 0 || ACT == 1, "EpiBf16: ACT is 0 (none) or 1 (gelu_pk)");
    static constexpr int NSTORE = PG8_NSTORE(16); static constexpr bool LDSBIAS = false;
    bf16_t* O; int ldc; const float* bias; int split_cols; size_t split_stride; float scale0;
    float ascale = 1.0f;
    int dbg = 0;
    unsigned cmap = 0u;
    float oscale = 0.0f;
    __device__ __forceinline__ void operator()(const f32x4 (&acc)[2][2][4][2], const Unit& u, int wr, int wc, int fr, int fq) const {
        if (dbg == 2) return;
        const int row0 = u.pm * BM + wr * 64 + fr; int colt = (cmap ? (int)((cmap >> (4 * u.pn)) & 15u) : u.pn) * BM; bf16_t* base = O;
        float sc = 1.f; if (split_cols) { const int t = colt / split_cols; base += (size_t)t * split_stride; colt -= t * split_cols; if (t == 0) sc = scale0; }
        const int col0 = colt + wc * 32 + 8 * fq, bcol0 = u.pn * BM + wc * 32 + 8 * fq;
        f32x4 bv[2][2];
#pragma unroll
        for (int bj = 0; bj < 2; ++bj)
#pragma unroll
            for (int n = 0; n < 2; ++n) bv[bj][n] = bias ? *(const f32x4*)(bias + bcol0 + bj * HALF + 4 * n) : (f32x4){0.f, 0.f, 0.f, 0.f};
#pragma unroll
        for (int ai = 0; ai < 2; ++ai)
#pragma unroll
            for (int m = 0; m < 4; ++m) { bf16_t* rowp = base + (size_t)(row0 + ai * HALF + m * 16) * ldc + col0;
#pragma unroll
                for (int bj = 0; bj < 2; ++bj) {
                    if (ACT == 0 && oscale > 0.f) {
                        const float kq = ascale * oscale; f32x4 a, b;
#pragma unroll
                        for (int i = 0; i < 4; ++i) { a[i] = __builtin_amdgcn_fmed3f(__builtin_fmaf(acc[ai][bj][m][0][i], kq, bv[bj][0][i] * oscale), -448.f, 448.f); b[i] = __builtin_amdgcn_fmed3f(__builtin_fmaf(acc[ai][bj][m][1][i], kq, bv[bj][1][i] * oscale), -448.f, 448.f); }
                        int p = 0, q = 0; p = __builtin_amdgcn_cvt_pk_fp8_f32(a[0], a[1], p, false); p = __builtin_amdgcn_cvt_pk_fp8_f32(a[2], a[3], p, true); q = __builtin_amdgcn_cvt_pk_fp8_f32(b[0], b[1], q, false); q = __builtin_amdgcn_cvt_pk_fp8_f32(b[2], b[3], q, true);
                        typedef int i32x2_f __attribute__((ext_vector_type(2))); *(i32x2_f*)((unsigned char*)base + (size_t)(row0 + ai * HALF + m * 16) * ldc + col0 + bj * HALF) = (i32x2_f){p, q}; continue; }
                    f32x4 v0 = acc[ai][bj][m][0] * ascale + bv[bj][0], v1 = acc[ai][bj][m][1] * ascale + bv[bj][1];
                    if (ACT == 1) { f32x2 a = gelu_pk((f32x2){v0[0], v0[1]}), b = gelu_pk((f32x2){v0[2], v0[3]}), c = gelu_pk((f32x2){v1[0], v1[1]}), d = gelu_pk((f32x2){v1[2], v1[3]});
                        v0 = (f32x4){a.x, a.y, b.x, b.y}; v1 = (f32x4){c.x, c.y, d.x, d.y}; }
                    v0 = v0 * sc; v1 = v1 * sc;
                    if (oscale > 0.f) { f32x4 a = v0 * oscale, b = v1 * oscale;
#pragma unroll
                        for (int i = 0; i < 4; ++i) { a[i] = __builtin_fminf(__builtin_fmaxf(a[i], -448.f), 448.f); b[i] = __builtin_fminf(__builtin_fmaxf(b[i], -448.f), 448.f); }
                        int p = 0, q = 0; p = __builtin_amdgcn_cvt_pk_fp8_f32(a[0], a[1], p, false); p = __builtin_amdgcn_cvt_pk_fp8_f32(a[2], a[3], p, true); q = __builtin_amdgcn_cvt_pk_fp8_f32(b[0], b[1], q, false); q = __builtin_amdgcn_cvt_pk_fp8_f32(b[2], b[3], q, true);
                        typedef int i32x2_t __attribute__((ext_vector_type(2))); *(i32x2_t*)((unsigned char*)base + (size_t)(row0 + ai * HALF + m * 16) * ldc + col0 + bj * HALF) = (i32x2_t){p, q}; }
                    else { u32x4 w; w.x = cvt_pk_bf16(v0[0], v0[1]); w.y = cvt_pk_bf16(v0[2], v0[3]); w.z = cvt_pk_bf16(v1[0], v1[1]); w.w = cvt_pk_bf16(v1[2], v1[3]);
                        *(u32x4*)(rowp + bj * HALF) = w; } } }
    }
};

struct EpiFp8 { static constexpr int ACT = 0;
    static constexpr int PERM = 2; static constexpr bool AFTER_DRAIN = false; static constexpr int NSTORE = PG8_NSTORE(8); static constexpr bool LDSBIAS = true;
    __device__ __forceinline__ const float* bias_src(const Unit& u, int wc, int lane) const { return bias + u.pn * BM + wc * 64 + lane; }
    bf16_t* O; int ldc; const float* bias; int split_cols; size_t split_stride; float scale0;
    float ascale = 1.0f;
    int dbg = 0;
    unsigned cmap = 0u;
    float oscale = 0.0f;
    PG8_LAS const float* lbias = nullptr;
    __device__ __forceinline__ void operator()(const f32x4 (&acc)[2][2][4][2], const Unit& u, int wr, int wc, int fr, int fq) const {
        if (dbg == 2) return;
        const int row0 = u.pm * BM + wr * 64 + fr; int colt = (cmap ? (int)((cmap >> (4 * u.pn)) & 15u) : u.pn) * BM; bf16_t* base = O;
        float sc = 1.f; if (split_cols) { const int t = colt / split_cols; base += (size_t)t * split_stride; colt -= t * split_cols; if (t == 0) sc = scale0; }
        const int col0 = colt + wc * 64 + 16 * fq, bcol0 = u.pn * BM + wc * 64 + 16 * fq;
        f32x4 bv[2][2];
#pragma unroll
        for (int bj = 0; bj < 2; ++bj)
#pragma unroll
            for (int n = 0; n < 2; ++n) bv[bj][n] = lbias ? *(const PG8_LAS f32x4*)(lbias + (wr * 4 + wc) * 64 + 16 * fq + 8 * bj + 4 * n) : (bias ? *(const f32x4*)(bias + bcol0 + 8 * bj + 4 * n) : (f32x4){0.f, 0.f, 0.f, 0.f});
#pragma unroll
        for (int ai = 0; ai < 2; ++ai)
#pragma unroll
            for (int m = 0; m < 4; ++m) { const size_t rowoff = (size_t)(row0 + ai * HALF + m * 16) * ldc + col0;
                if (ACT == 0 && oscale > 0.f) {
                    const float kq = ascale * oscale; int w4[4];
#pragma unroll
                    for (int bj = 0; bj < 2; ++bj)
#pragma unroll
                        for (int n = 0; n < 2; ++n) { float a[4];
#pragma unroll
                            for (int p = 0; p < 2; ++p) { const f32x2 t2 = (f32x2){acc[ai][bj][m][n][2 * p], acc[ai][bj][m][n][2 * p + 1]} * kq + (f32x2){bv[bj][n][2 * p], bv[bj][n][2 * p + 1]} * oscale;
                                a[2 * p] = __builtin_amdgcn_fmed3f(t2.x, -448.f, 448.f); a[2 * p + 1] = __builtin_amdgcn_fmed3f(t2.y, -448.f, 448.f); }
                            int p = 0; p = __builtin_amdgcn_cvt_pk_fp8_f32(a[0], a[1], p, false); p = __builtin_amdgcn_cvt_pk_fp8_f32(a[2], a[3], p, true); w4[2 * bj + n] = p; }
                    *(u32x4*)((unsigned char*)base + rowoff) = (u32x4){(unsigned)w4[0], (unsigned)w4[1], (unsigned)w4[2], (unsigned)w4[3]}; continue; }
                u32x4 wo[2];
#pragma unroll
                for (int bj = 0; bj < 2; ++bj) { f32x4 v0 = acc[ai][bj][m][0] * ascale + bv[bj][0], v1 = acc[ai][bj][m][1] * ascale + bv[bj][1];
                    if (ACT == 1) { f32x2 a = gelu_pk((f32x2){v0[0], v0[1]}), b = gelu_pk((f32x2){v0[2], v0[3]}), c = gelu_pk((f32x2){v1[0], v1[1]}), d = gelu_pk((f32x2){v1[2], v1[3]});
                        v0 = (f32x4){a.x, a.y, b.x, b.y}; v1 = (f32x4){c.x, c.y, d.x, d.y}; }
                    v0 = v0 * sc; v1 = v1 * sc;
                    wo[bj].x = cvt_pk_bf16(v0[0], v0[1]); wo[bj].y = cvt_pk_bf16(v0[2], v0[3]); wo[bj].z = cvt_pk_bf16(v1[0], v1[1]); wo[bj].w = cvt_pk_bf16(v1[2], v1[3]); }
                bf16_t* rowp = base + rowoff; *(u32x4*)rowp = wo[0]; *(u32x4*)(rowp + 8) = wo[1]; }
    }
};

struct EpiSwiglu {
    static constexpr int PERM = 1; static constexpr bool AFTER_DRAIN = false; static constexpr int NSTORE = PG8_NSTORE(8); static constexpr bool LDSBIAS = true;
    bf16_t* H; int ldc; const float* bias; int dff; float ascale; float hscale; int dbg = 0;
    PG8_LAS const float* lbias = nullptr;
    __device__ __forceinline__ const float* bias_src(const Unit& u, int wc, int lane) const { return bias + (size_t)u.e * 2 * dff + u.pnl * HALF + wc * 32 + (lane & 31) + ((lane & 32) ? dff : 0); }
    __device__ __forceinline__ void operator()(const f32x4 (&acc)[2][2][4][2], const Unit& u, int wr, int wc, int fr, int fq) const {
        if (dbg == 2) return;
        const int row0 = u.pm * BM + wr * 64 + fr, hc = u.pnl * HALF + wc * 32 + 8 * fq;
        const float* bg = bias + (size_t)u.e * 2 * dff + hc; const float* bu = bg + dff;
        const float hk = hscale > 0.f ? hscale : 1.0f;
        f32x4 bgv[2], buv[2];
#pragma unroll
        for (int n = 0; n < 2; ++n) { if (lbias) { const PG8_LAS float* lb = lbias + (wr * 4 + wc) * 64 + 8 * fq + 4 * n; bgv[n] = *(const PG8_LAS f32x4*)lb; buv[n] = *(const PG8_LAS f32x4*)(lb + 32); }
            else { bgv[n] = *(const f32x4*)(bg + 4 * n); buv[n] = *(const f32x4*)(bu + 4 * n); } }
#pragma unroll
        for (int ai = 0; ai < 2; ++ai)
#pragma unroll
            for (int m = 0; m < 4; ++m) { bf16_t* rowp = H + (size_t)(row0 + ai * HALF + m * 16) * ldc + hc; float o[8];
#pragma unroll
                for (int n = 0; n < 2; ++n)
#pragma unroll
                    for (int p = 0; p < 2; ++p) {
                        const f32x2 g2 = (f32x2){acc[ai][0][m][n][2 * p], acc[ai][0][m][n][2 * p + 1]} * ascale + (f32x2){bgv[n][2 * p], bgv[n][2 * p + 1]};
                        const f32x2 u2 = (f32x2){acc[ai][1][m][n][2 * p], acc[ai][1][m][n][2 * p + 1]} * ascale + (f32x2){buv[n][2 * p], buv[n][2 * p + 1]};
                        f32x2 gt, up; gt.x = __builtin_fminf(g2.x, 7.0f); gt.y = __builtin_fminf(g2.y, 7.0f); up.x = __builtin_amdgcn_fmed3f(u2.x, -7.0f, 7.0f); up.y = __builtin_amdgcn_fmed3f(u2.y, -7.0f, 7.0f);
                        const f32x2 ee = gt * (-1.702f * 1.4426950408889634f);
                        f32x2 den; den.x = __builtin_amdgcn_exp2f(ee.x); den.y = __builtin_amdgcn_exp2f(ee.y); den = den + 1.0f;
                        f32x2 sg; sg.x = __builtin_amdgcn_rcpf(den.x); sg.y = __builtin_amdgcn_rcpf(den.y);
                        const f32x2 r2 = (up * hk + hk) * (gt * sg);
                        o[4 * n + 2 * p] = r2.x; o[4 * n + 2 * p + 1] = r2.y; }
                if (dbg == 1) { if (o[0] == 123.4567f && o[5] == 7.654f) rowp[0] = 1; continue; }
                if (hscale > 0.f) { int a = 0, b = 0; a = __builtin_amdgcn_cvt_pk_fp8_f32(o[0], o[1], a, false); a = __builtin_amdgcn_cvt_pk_fp8_f32(o[2], o[3], a, true);
                    b = __builtin_amdgcn_cvt_pk_fp8_f32(o[4], o[5], b, false); b = __builtin_amdgcn_cvt_pk_fp8_f32(o[6], o[7], b, true);
                    typedef int i32x2_t __attribute__((ext_vector_type(2))); *(i32x2_t*)((unsigned char*)H + (size_t)(row0 + ai * HALF + m * 16) * ldc + hc) = (i32x2_t){a, b}; }
                else { u32x4 w; w.x = cvt_pk_bf16(o[0], o[1]); w.y = cvt_pk_bf16(o[2], o[3]); w.z = cvt_pk_bf16(o[4], o[5]); w.w = cvt_pk_bf16(o[6], o[7]);
                    *(u32x4*)rowp = w; } }
    }
};
struct MoeOrder {
    const PG8_LAS int* tstart; const PG8_LAS int* cnt; const int* rowtok; int nN, G, c, ntok; PG8_LAS unsigned* gtab;
    int xs = 0;
    __device__ __forceinline__ bool next(int i, Unit& u) const {
        int rt, pnl;
        if (G == 256) { const int x = ((c & 7) + xs) & 7, j = c >> 3, per = 32 / nN; rt = (i * 8 + x) * per + j / nN; pnl = j % nN; }
        else { const int L = i * G + c; rt = L / nN; pnl = L % nN; }
        const int TR = tstart[32]; if (rt >= TR) return false;
        const int ln_ = (int)__builtin_amdgcn_mbcnt_hi(~0u, __builtin_amdgcn_mbcnt_lo(~0u, 0u));
        const int tv_ = tstart[(ln_ & 31) + 1];
        const unsigned long long bal_ = __ballot((ln_ < 31) && (tv_ <= rt));
        int e = __builtin_amdgcn_readfirstlane((int)__popcll(bal_));
        const int lt = rt - tstart[e]; int nv = cnt[e] - lt * BM; nv = nv > BM ? BM : nv;
        u.pm = rt; u.pn = e * nN + pnl; u.e = e; u.pnl = pnl; u.nvalid = __builtin_amdgcn_readfirstlane(nv); u.rbase = __builtin_amdgcn_readfirstlane(e * ntok + lt * BM); return true;
    }
    __device__ __forceinline__ int arow(const Unit& u, int r) const { return rowtok[u.rbase + ((r < u.nvalid) ? r : 0)]; }
    __device__ __forceinline__ const int* aptr(const Unit& u, int r) const { return rowtok + u.rbase + ((r < u.nvalid) ? r : 0); }
    __device__ __forceinline__ void a_ready(const Unit&) const {}
    __device__ __forceinline__ void done(const Unit&) const {}
};

struct PanelStats {
    unsigned* xbuf;
    unsigned* cnt;
    unsigned* tmo;
    int ntn; float eps;
    unsigned code;
    __device__ __forceinline__ bool run(const f32x4 (&v)[2][2][4][2], const Unit& u, int wr, int wc, int fr, int fq, PG8_LAS unsigned char* lds, int wid, int lane) const {
        typedef float f32x2v __attribute__((ext_vector_type(2)));
        PG8_LAS f32x2v* P = (PG8_LAS f32x2v*)lds;
        PG8_LAS f32x2v* S = (PG8_LAS f32x2v*)(lds + 8192);
        PG8_LAS unsigned* flag = (PG8_LAS unsigned*)(lds + 8192 + 2048);
#pragma unroll
        for (int ai = 0; ai < 2; ++ai)
#pragma unroll
            for (int m = 0; m < 4; ++m) {
                float s = 0.f;
#pragma unroll
                for (int bj = 0; bj < 2; ++bj)
#pragma unroll
                    for (int n = 0; n < 2; ++n) { const f32x4 x = v[ai][bj][m][n]; s += (x[0] + x[1]) + (x[2] + x[3]); }
                s += __shfl_xor(s, 16); s += __shfl_xor(s, 32);
                const float mw = s * (1.0f / 64.0f); float q = 0.f;
#pragma unroll
                for (int bj = 0; bj < 2; ++bj)
#pragma unroll
                    for (int n = 0; n < 2; ++n) { const f32x4 d = v[ai][bj][m][n] - mw; q += (d[0] * d[0] + d[1] * d[1]) + (d[2] * d[2] + d[3] * d[3]); }
                q += __shfl_xor(q, 16); q += __shfl_xor(q, 32);
                if (fq == 0) P[(ai * HALF + wr * 64 + m * 16 + fr) * 4 + wc] = (f32x2v){mw, q};
            }
        asm volatile("s_waitcnt lgkmcnt(0)" ::: "memory"); __builtin_amdgcn_s_barrier(); asm volatile("" ::: "memory");
#if defined(BROKEN_EXCHANGE_NO_WAIT)
#warning BROKEN CONTROL BUILD: the row-statistics exchange does not wait; results are wrong by design
        if (blockIdx.x >= 64) { const long long t0_ = clock64(); while (clock64() - t0_ < 60000) __builtin_amdgcn_s_sleep(8); }
#endif
        const int row = wid * 32 + (lane & 31);
        if (lane < 32) {
            const f32x2v a = P[row * 4 + 0], b = P[row * 4 + 1], c = P[row * 4 + 2], d = P[row * 4 + 3];
            const float mt = (a.x + b.x + c.x + d.x) * 0.25f;
            const float da = a.x - mt, db = b.x - mt, dc = c.x - mt, dd = d.x - mt;
            const float m2 = (a.y + b.y) + (c.y + d.y) + 64.0f * ((da * da + db * db) + (dc * dc + dd * dd));
            unsigned long long* slot = (unsigned long long*)xbuf + ((size_t)(u.pm * BM + row) * 4 + u.pn);
            __hip_atomic_store(slot, ((unsigned long long)__float_as_uint(m2) << 32) | __float_as_uint(mt), __ATOMIC_RELAXED, __HIP_MEMORY_SCOPE_AGENT);
        }
        asm volatile("s_waitcnt vmcnt(0)" ::: "memory");
        if (lane == 0) __hip_atomic_fetch_add(cnt + 64 * u.pm, 1u, __ATOMIC_RELAXED, __HIP_MEMORY_SCOPE_AGENT);
        if (wid == 0) {
            bool dead = false; const unsigned long long t0 = __builtin_amdgcn_s_memrealtime(); const unsigned want = 8u * (unsigned)ntn;
            for (;;) {
#if defined(BROKEN_EXCHANGE_NO_WAIT)
                break;
#endif
                if ((unsigned)__builtin_amdgcn_readfirstlane(__hip_atomic_load(cnt + 64 * u.pm, __ATOMIC_RELAXED, __HIP_MEMORY_SCOPE_AGENT)) >= want) break;
                if (__builtin_amdgcn_s_memrealtime() - t0 > 2000000ull) {
                    if (lane == 0) { unsigned expect = 0u; __hip_atomic_compare_exchange_strong(tmo + 1, &expect, code | (unsigned)(u.pm & 0xff), __ATOMIC_RELAXED, __ATOMIC_RELAXED, __HIP_MEMORY_SCOPE_AGENT);
                                     __hip_atomic_store(tmo, 1u, __ATOMIC_RELAXED, __HIP_MEMORY_SCOPE_AGENT); }
                    dead = true; break; }
                __builtin_amdgcn_s_sleep(2);
            }
            __builtin_amdgcn_fence(__ATOMIC_ACQUIRE, "agent");
            if (lane == 0) flag[0] = dead ? 1u : 0u;
        }
        asm volatile("s_waitcnt vmcnt(0) lgkmcnt(0)" ::: "memory"); __builtin_amdgcn_s_barrier(); asm volatile("" ::: "memory");
        const bool bad = flag[0] != 0u;
        if (lane < 32) {
            const unsigned long long* slot = (const unsigned long long*)xbuf + (size_t)(u.pm * BM + row) * 4; float mt[4], m2[4]; float ms = 0.f;
#pragma unroll
            for (int t = 0; t < 4; ++t) { if (t < ntn) { const unsigned long long w = __hip_atomic_load(slot + t, __ATOMIC_RELAXED, __HIP_MEMORY_SCOPE_AGENT); mt[t] = __uint_as_float((unsigned)w); m2[t] = __uint_as_float((unsigned)(w >> 32)); } else { mt[t] = 0.f; m2[t] = 0.f; } ms += mt[t]; }
            const float mean = ms / (float)ntn; float q = 0.f;
#pragma unroll
            for (int t = 0; t < 4; ++t) if (t < ntn) { const float dm = mt[t] - mean; q += m2[t] + 256.0f * dm * dm; }
            S[row] = (f32x2v){mean, 1.0f / sqrtf(q / (256.0f * (float)ntn) + eps)};
        }
        asm volatile("s_waitcnt lgkmcnt(0)" ::: "memory"); __builtin_amdgcn_s_barrier(); asm volatile("" ::: "memory");
        return bad;
    }
};
struct EpiLnRes {
    static constexpr int PERM = 0; static constexpr bool AFTER_DRAIN = true; static constexpr int NSTORE = 0; static constexpr bool LDSBIAS = false;
    const float* base; float* out; int ldc; const float* bias; PanelStats st; unsigned poison;
    __device__ __forceinline__ void fused(f32x4 (&acc)[2][2][4][2], const Unit& u, int wr, int wc, int fr, int fq, PG8_LAS unsigned char* lds, int wid, int lane) const {
        typedef float f32x2v __attribute__((ext_vector_type(2)));
        const PG8_LAS f32x2v* S = (const PG8_LAS f32x2v*)(lds + 8192);
        const int col0 = u.pn * BM + wc * 32 + 4 * fq;
#pragma unroll
        for (int bj = 0; bj < 2; ++bj)
#pragma unroll
            for (int n = 0; n < 2; ++n) { const f32x4 bv = bias ? *(const f32x4*)(bias + col0 + bj * HALF + n * 16) : (f32x4){0.f, 0.f, 0.f, 0.f};
#pragma unroll
                for (int ai = 0; ai < 2; ++ai)
#pragma unroll
                    for (int m = 0; m < 4; ++m) acc[ai][bj][m][n] += bv; }
        f32x4 pre[4][2][2];
#pragma unroll
        for (int m = 0; m < 4; ++m) { const size_t off = (size_t)(u.pm * BM + wr * 64 + m * 16 + fr) * ldc + col0;
#pragma unroll
            for (int bj = 0; bj < 2; ++bj)
#pragma unroll
                for (int n = 0; n < 2; ++n) pre[m][bj][n] = *(const f32x4*)(base + off + bj * HALF + n * 16); }
        const bool bad = st.run(acc, u, wr, wc, fr, fq, lds, wid, lane) || poison != 0u;
        const float qnan = __builtin_nanf("");
#pragma unroll
        for (int ai = 0; ai < 2; ++ai)
#pragma unroll
            for (int m = 0; m < 4; ++m) { const int r = ai * HALF + wr * 64 + m * 16 + fr; const f32x2v sr = S[r]; const size_t off = (size_t)(u.pm * BM + r) * ldc + col0;
#pragma unroll
                for (int bj = 0; bj < 2; ++bj)
#pragma unroll
                    for (int n = 0; n < 2; ++n) { const f32x4 bs = ai == 0 ? pre[m][bj][n] : *(const f32x4*)(base + off + bj * HALF + n * 16); f32x4 o = bs + (acc[ai][bj][m][n] - sr.x) * sr.y;
                        if (bad) o = (f32x4){qnan, qnan, qnan, qnan}; *(f32x4*)(out + off + bj * HALF + n * 16) = o; }
                if (m & 1) asm volatile("" ::: "memory"); }
    }
};
struct EpiLnResLn {
    static constexpr int PERM = 0; static constexpr bool AFTER_DRAIN = true; static constexpr int NSTORE = 0; static constexpr bool LDSBIAS = false;
    const float* base; float* out; bf16_t* xn; int ldc; const float* bias; PanelStats st1, st2; unsigned poison;
    __device__ __forceinline__ void fused(f32x4 (&acc)[2][2][4][2], const Unit& u, int wr, int wc, int fr, int fq, PG8_LAS unsigned char* lds, int wid, int lane) const {
        typedef float f32x2v __attribute__((ext_vector_type(2))); typedef unsigned u32x2v __attribute__((ext_vector_type(2)));
        const PG8_LAS f32x2v* S = (const PG8_LAS f32x2v*)(lds + 8192);
        const int col0 = u.pn * BM + wc * 32 + 4 * fq;
#pragma unroll
        for (int bj = 0; bj < 2; ++bj)
#pragma unroll
            for (int n = 0; n < 2; ++n) { const f32x4 bv = bias ? *(const f32x4*)(bias + col0 + bj * HALF + n * 16) : (f32x4){0.f, 0.f, 0.f, 0.f};
#pragma unroll
                for (int ai = 0; ai < 2; ++ai)
#pragma unroll
                    for (int m = 0; m < 4; ++m) acc[ai][bj][m][n] += bv; }
        bool bad = st1.run(acc, u, wr, wc, fr, fq, lds, wid, lane) || poison != 0u;
        const float qnan = __builtin_nanf("");
#pragma unroll
        for (int ai = 0; ai < 2; ++ai)
#pragma unroll
            for (int m = 0; m < 4; ++m) { const int r = ai * HALF + wr * 64 + m * 16 + fr; const f32x2v sr = S[r]; const size_t off = (size_t)(u.pm * BM + r) * ldc + col0;
#pragma unroll
                for (int bj = 0; bj < 2; ++bj)
#pragma unroll
                    for (int n = 0; n < 2; ++n) { const f32x4 bs = *(const f32x4*)(base + off + bj * HALF + n * 16); acc[ai][bj][m][n] = bs + (acc[ai][bj][m][n] - sr.x) * sr.y; }
                asm volatile("" : "+v"(acc[ai][0][m][0]), "+v"(acc[ai][0][m][1]), "+v"(acc[ai][1][m][0]), "+v"(acc[ai][1][m][1]));
                if (m & 1) asm volatile("" ::: "memory"); }
        const bool bad1 = bad;
        bad = st2.run(acc, u, wr, wc, fr, fq, lds, wid, lane) || bad;
#pragma unroll
        for (int ai = 0; ai < 2; ++ai)
#pragma unroll
            for (int m = 0; m < 4; ++m) { const int r = ai * HALF + wr * 64 + m * 16 + fr; const f32x2v sr = S[r]; const size_t off = (size_t)(u.pm * BM + r) * ldc + col0;
#pragma unroll
                for (int bj = 0; bj < 2; ++bj)
#pragma unroll
                    for (int n = 0; n < 2; ++n) { const f32x4 x1 = acc[ai][bj][m][n]; *(f32x4*)(out + off + bj * HALF + n * 16) = bad1 ? (f32x4){qnan, qnan, qnan, qnan} : x1;
                        const f32x4 o = (x1 - sr.x) * sr.y; u32x2v w; w.x = cvt_pk_bf16(o[0], o[1]); w.y = cvt_pk_bf16(o[2], o[3]);
                        if (bad) { w.x = 0x7fc07fc0u; w.y = 0x7fc07fc0u; } *(u32x2v*)(xn + off + bj * HALF + n * 16) = w; }
                asm volatile("" ::: "memory"); }
    }
};

template <class Epi, class Sched, bool ALIGN_EPI = false, bool SP2 = false, bool GATHER = false, bool FP8 = false>
__device__ __forceinline__ void gemm_phase(PG8_LAS unsigned char* lds, const Gemm g, const Sched& S, const Epi& E) {
    static_assert(!GATHER || SP2, "the gathered-A variant is written for the SP2 loop only");
    int tid_ = threadIdx.x; asm volatile("" : "+v"(tid_));
    const int tid = tid_, wid = __builtin_amdgcn_readfirstlane(tid >> 6), lane = tid & 63, wr = wid >> 2, wc = wid & 3, fr = lane & 15, fq = lane >> 4;
    const int K = g.K, nt = K / BK;
    unsigned voffA[2], voffB[2], voffB2[2][2];
#pragma unroll
    for (int i = 0; i < 2; ++i) { int R, C; stage_rc(tid * 16 + i * 8192, R, C); const int Rb = (Epi::PERM == 1) ? ((R & ~31) + perm32(R & 31)) : R;
        voffA[i] = (unsigned)(R * K + C) * 2u; voffB[i] = (unsigned)(Rb * K + C) * 2u;
        { const int rho = R & 31, n_ = rho >> 4, fq_ = (rho & 15) >> 2, i_ = rho & 3; const int r2 = (Epi::PERM == 3) ? (64 * (R >> 5) + 8 * fq_ + 4 * n_ + i_) : (64 * (R >> 5) + 16 * fq_ + 4 * n_ + i_), hs = (Epi::PERM == 3) ? 32 : 8;
          voffB2[0][i] = (unsigned)(r2 * K + C) * 2u; voffB2[1][i] = (unsigned)((r2 + hs) * K + C) * 2u; } }
#define PG8_GOFF(slot, u) do { int tq_ = threadIdx.x; asm volatile("" : "+v"(tq_)); int gR[2], gC[2]; stage_rc(tq_ * 16, gR[0], gC[0]); stage_rc(tq_ * 16 + 8192, gR[1], gC[1]);     \
        PG8_LAS unsigned* gt_ = S.gtab + (slot) * 2048 + wid * 64;     \
        __builtin_amdgcn_global_load_lds((const unsigned*)S.aptr(u, gR[0]), gt_, 4, 0, 0); __builtin_amdgcn_global_load_lds((const unsigned*)S.aptr(u, gR[1]), gt_ + 512, 4, 0, 0); \
        __builtin_amdgcn_global_load_lds((const unsigned*)S.aptr(u, HALF + gR[0]), gt_ + 1024, 4, 0, 0); __builtin_amdgcn_global_load_lds((const unsigned*)S.aptr(u, HALF + gR[1]), gt_ + 1536, 4, 0, 0); } while (0)
    unsigned gcb[2] = {0u, 0u};
    if constexpr (GATHER) { int r_, c_; stage_rc(tid * 16, r_, c_); gcb[0] = (unsigned)c_ * 2u; stage_rc(tid * 16 + 8192, r_, c_); gcb[1] = (unsigned)c_ * 2u; }
    const unsigned rowB = (unsigned)K * 2u;
    const size_t kstep = (size_t)(BK * 2);
    const size_t hstep = (size_t)HALF * K * 2;
    const size_t tstep = 2 * hstep;
    const unsigned ldsw = (unsigned)wid * 1024u;
    const int aoff = lds_byte(wr * 64 + fr, fq * 8), boff = lds_byte(wc * 32 + fr, fq * 8);
#define PG8_SA(b, h) (((b) * 2 + (h)) * HTB)
#define PG8_SB(b, h) ((4 + (b) * 2 + (h)) * HTB)
#define PG8_STAGE(bufoff, gbase, voff) do { _Pragma("unroll") for (int _i = 0; _i < 2; ++_i) \
        __builtin_amdgcn_global_load_lds((const unsigned*)((const char*)(gbase) + (voff)[_i]), (PG8_LAS unsigned*)(lds + (bufoff) + ldsw + _i * 8192), 16, 0, 0); } while (0)
#define PG8_STAGE_B(bufoff, gbase, h) do { if constexpr (Epi::PERM >= 2) PG8_STAGE(bufoff, gbase, voffB2[h]); else PG8_STAGE(bufoff, (gbase) + (size_t)(h) * hstep, voffB); } while (0)
#define PG8_LDA(dst, b, h) do { _Pragma("unroll") for (int m = 0; m < 4; ++m) { if constexpr (FP8) { dst##8[m].lo = *(const PG8_LAS i32x4_t*)(lds + PG8_SA(b, h) + aoff + m * 2048); dst##8[m].hi = *(const PG8_LAS i32x4_t*)(lds + PG8_SA(b, h) + aoff + m * 2048 + 1024); } \
        else { _Pragma("unroll") for (int k = 0; k < 2; ++k) dst[m][k] = *(const PG8_LAS bf16x8*)(lds + PG8_SA(b, h) + aoff + m * 2048 + k * 1024); } } } while (0)
#define PG8_LDB(dst, b, h) do { _Pragma("unroll") for (int n = 0; n < 2; ++n) { if constexpr (FP8) { dst##8[n].lo = *(const PG8_LAS i32x4_t*)(lds + PG8_SB(b, h) + boff + n * 2048); dst##8[n].hi = *(const PG8_LAS i32x4_t*)(lds + PG8_SB(b, h) + boff + n * 2048 + 1024); } \
        else { _Pragma("unroll") for (int k = 0; k < 2; ++k) dst[n][k] = *(const PG8_LAS bf16x8*)(lds + PG8_SB(b, h) + boff + n * 2048 + k * 1024); } } } while (0)
#define PG8_MMA(ai, bj, At, Bt) do { __builtin_amdgcn_s_setprio(1); \
        if constexpr (FP8) { _Pragma("unroll") for (int m = 0; m < 4; ++m) _Pragma("unroll") for (int n = 0; n < 2; ++n) \
            asm volatile("v_mfma_scale_f32_16x16x128_f8f6f4 %0, %1, %2, %0, %3, %3 op_sel_hi:[0,0,0]" : "+v"(acc[ai][bj][m][n]) : "v"(Bt##8[n]), "v"(At##8[m]), "v"(sc7f)); } \
        else { _Pragma("unroll") for (int m = 0; m < 4; ++m) _Pragma("unroll") for (int n = 0; n < 2; ++n) _Pragma("unroll") for (int k = 0; k < 2; ++k) \
            acc[ai][bj][m][n] = __builtin_amdgcn_mfma_f32_16x16x32_bf16(Bt[n][k], At[m][k], acc[ai][bj][m][n], 0, 0, 0); } \
        __builtin_amdgcn_s_setprio(0); } while (0)
#define PG8_MMAZ(ai, bj, At, Bt) do { __builtin_amdgcn_s_setprio(1); \
        if constexpr (FP8) { _Pragma("unroll") for (int m = 0; m < 4; ++m) _Pragma("unroll") for (int n = 0; n < 2; ++n) \
            asm volatile("v_mfma_scale_f32_16x16x128_f8f6f4 %0, %1, %2, 0, %3, %3 op_sel_hi:[0,0,0]" : "=v"(acc[ai][bj][m][n]) : "v"(Bt##8[n]), "v"(At##8[m]), "v"(sc7f)); } \
        else { _Pragma("unroll") for (int m = 0; m < 4; ++m) _Pragma("unroll") for (int n = 0; n < 2; ++n) { \
            acc[ai][bj][m][n] = __builtin_amdgcn_mfma_f32_16x16x32_bf16(Bt[n][0], At[m][0], (f32x4){0.f, 0.f, 0.f, 0.f}, 0, 0, 0); \
            acc[ai][bj][m][n] = __builtin_amdgcn_mfma_f32_16x16x32_bf16(Bt[n][1], At[m][1], acc[ai][bj][m][n], 0, 0, 0); } } \
        __builtin_amdgcn_s_setprio(0); } while (0)
#define PG8_MMA0(ai, bj, At, Bt) do { if (t == 0) PG8_MMAZ(ai, bj, At, Bt); else PG8_MMA(ai, bj, At, Bt); } while (0)
#define PG8_WAIT_V(n) asm volatile("s_waitcnt vmcnt(" #n ")" ::: "memory")
#define PG8_WAIT_V1 do { if (t != 0 || xtra == 0) PG8_WAIT_V(8); else if (xtra == 1) PG8_WAIT_V(9); else if (xtra == 5) PG8_WAIT_V(13); else if (xtra == 9) PG8_WAIT_V(17); else if (xtra == 13) PG8_WAIT_V(21); \
        else if (xtra == 16) PG8_WAIT_V(24); else if (xtra == 8) PG8_WAIT_V(16); else if (xtra == 12) PG8_WAIT_V(20); else if (xtra == 4) PG8_WAIT_V(12); else PG8_WAIT_V(8); } while (0)
#define PG8_WAIT_L(n) asm volatile("s_waitcnt lgkmcnt(" #n ")" ::: "memory")
#define PG8_BAR __builtin_amdgcn_s_barrier()
#define PG8_SCHED __builtin_amdgcn_sched_barrier(0)
    Unit cur, nxt; int ui = 0;
    if (!S.next(0, cur)) return;
    f32x4 acc[2][2][4][2];
#pragma unroll
    for (int a = 0; a < 2; ++a)
#pragma unroll
        for (int b = 0; b < 2; ++b)
#pragma unroll
            for (int m = 0; m < 4; ++m)
#pragma unroll
                for (int n = 0; n < 2; ++n) acc[a][b][m][n] = (f32x4){0.f, 0.f, 0.f, 0.f};
    bf16x8 At[4][2], B0[2][2], B1[2][2]; i32x8_t At8[4], B08[2], B18[2];
    int sc7f = 0x7f7f7f7f; asm volatile("" : "+v"(sc7f));
    const char* cA = (const char*)g.A + (GATHER ? (size_t)0 : (size_t)cur.pm * tstep); const char* cB = (const char*)g.Bt + (size_t)cur.pn * tstep;
    S.a_ready(cur);
    int gslot = 0;
    if constexpr (GATHER) { PG8_GOFF(0, cur); PG8_WAIT_V(0); }
    const size_t hA = GATHER ? (size_t)0 : hstep;
#define PG8_STAGE_A(bufoff, gbase, h, sl) do { if constexpr (GATHER) { const PG8_LAS unsigned* gt_ = S.gtab + (sl) * 2048 + (h) * 1024 + tid; const unsigned o_[2] = {gt_[0] * rowB + gcb[0], gt_[512] * rowB + gcb[1]}; PG8_STAGE(bufoff, gbase, o_); } \
        else PG8_STAGE(bufoff, (gbase) + (size_t)(h) * hA, voffA); } while (0)
    if constexpr (SP2) {
        PG8_STAGE_B(PG8_SB(0, 0), cB, 0); PG8_STAGE_B(PG8_SB(0, 1), cB, 1); PG8_STAGE_A(PG8_SA(0, 0), cA, 0, 0); PG8_STAGE_A(PG8_SA(0, 1), cA, 1, 0);
        if (wr == 1) PG8_BAR;
        PG8_WAIT_V(2); PG8_BAR;
        PG8_STAGE_B(PG8_SB(1, 0), cB + kstep, 0); PG8_STAGE_A(PG8_SA(1, 0), cA + kstep, 0, 0); PG8_STAGE_B(PG8_SB(1, 1), cB + kstep, 1);
        PG8_WAIT_V(6); PG8_BAR;
    } else {
        PG8_STAGE_B(PG8_SB(0, 0), cB, 0); PG8_STAGE(PG8_SA(0, 0), cA, voffA); PG8_STAGE_B(PG8_SB(0, 1), cB, 1); PG8_STAGE(PG8_SA(0, 1), cA + hstep, voffA);
        if (wr == 1) PG8_BAR;
        PG8_WAIT_V(4); PG8_BAR;
        PG8_STAGE_B(PG8_SB(1, 0), cB + kstep, 0); PG8_STAGE(PG8_SA(1, 0), cA + kstep, voffA); PG8_STAGE_B(PG8_SB(1, 1), cB + kstep, 1);
        PG8_WAIT_V(6); PG8_BAR;
    }
    for (;;) {
        const bool has_next = S.next(ui + 1, nxt);
        const char* nA = (has_next && !GATHER) ? (const char*)g.A + (size_t)nxt.pm * tstep : cA; const char* nB = has_next ? (const char*)g.Bt + (size_t)nxt.pn * tstep : cB;
        if constexpr (GATHER) { if (has_next) PG8_GOFF(gslot ^ 1, nxt); }
        bool lbp = false;
        if constexpr (Epi::LDSBIAS) { if (E.lbias) { lbp = true; __builtin_amdgcn_global_load_lds((const unsigned*)E.bias_src(cur, wc, lane), (PG8_LAS unsigned*)(E.lbias + wid * 64), 4, 0, 0); } }
        const int xtra = ((ui > 0 && E.dbg == 0) ? Epi::NSTORE : 0) + ((GATHER && has_next) ? 4 : 0) + (lbp ? 1 : 0);
#pragma unroll 1
        for (int t = 0; t < nt; t += 2) {
            const bool last = (t == nt - 2);
            const char* a1 = cA + (size_t)(t + 1) * kstep;
            const char* a2 = last ? nA : cA + (size_t)(t + 2) * kstep; const char* b2 = last ? nB : cB + (size_t)(t + 2) * kstep;
            const char* a3 = a2 + kstep; const char* b3 = b2 + kstep;
            if (last && has_next) S.a_ready(nxt);
            const int gnx = (last && has_next) ? (gslot ^ 1) : gslot;
            if constexpr (SP2) {
            PG8_LDB(B0, 0, 0); PG8_LDB(B1, 0, 1); PG8_SCHED; PG8_LDA(At, 0, 0); PG8_STAGE_A(PG8_SA(1, 1), a1, 1, gslot);
            PG8_WAIT_V1;
            PG8_WAIT_L(0); PG8_BAR; PG8_MMA0(0, 0, At, B0); PG8_MMA0(0, 1, At, B1); PG8_BAR; PG8_SCHED;
            PG8_LDA(At, 0, 1); PG8_STAGE_B(PG8_SB(0, 0), b2, 0); PG8_STAGE_B(PG8_SB(0, 1), b2, 1); PG8_STAGE_A(PG8_SA(0, 0), a2, 0, gnx);
            PG8_WAIT_V1;
            PG8_WAIT_L(0); PG8_BAR; PG8_MMA0(1, 0, At, B0); PG8_MMA0(1, 1, At, B1); PG8_BAR; PG8_SCHED;
            PG8_LDB(B0, 1, 0); PG8_LDB(B1, 1, 1); PG8_SCHED; PG8_LDA(At, 1, 0); PG8_STAGE_A(PG8_SA(0, 1), a2, 1, gnx);
            PG8_WAIT_V(8); PG8_WAIT_L(0); PG8_BAR; PG8_MMA(0, 0, At, B0); PG8_MMA(0, 1, At, B1); PG8_BAR; PG8_SCHED;
            PG8_LDA(At, 1, 1); PG8_STAGE_B(PG8_SB(1, 0), b3, 0); PG8_STAGE_B(PG8_SB(1, 1), b3, 1); PG8_STAGE_A(PG8_SA(1, 0), a3, 0, gnx);
            PG8_WAIT_V(8); PG8_WAIT_L(0); PG8_BAR; PG8_MMA(1, 0, At, B0); PG8_MMA(1, 1, At, B1); PG8_BAR; PG8_SCHED;
            } else {
            PG8_LDB(B0, 0, 0); PG8_SCHED; PG8_LDA(At, 0, 0); PG8_STAGE(PG8_SA(1, 1), a1 + hstep, voffA);
            PG8_WAIT_L(8); PG8_BAR; PG8_WAIT_L(0); PG8_MMA(0, 0, At, B0); PG8_BAR; PG8_SCHED;
            PG8_LDB(B1, 0, 1); PG8_STAGE_B(PG8_SB(0, 0), b2, 0);
            PG8_BAR; PG8_WAIT_L(0); PG8_MMA(0, 1, At, B1); PG8_BAR;
            PG8_LDA(At, 0, 1); PG8_STAGE(PG8_SA(0, 0), a2, voffA);
            PG8_BAR; PG8_WAIT_L(0); PG8_MMA(1, 0, At, B0); PG8_BAR; PG8_SCHED;
            PG8_STAGE_B(PG8_SB(0, 1), b2, 1);
            PG8_WAIT_V(6); PG8_BAR; PG8_MMA(1, 1, At, B1); PG8_BAR;
            PG8_LDB(B0, 1, 0); PG8_SCHED; PG8_LDA(At, 1, 0); PG8_STAGE(PG8_SA(0, 1), a2 + hstep, voffA);
            PG8_WAIT_L(8); PG8_BAR; PG8_WAIT_L(0); PG8_MMA(0, 0, At, B0); PG8_BAR; PG8_SCHED;
            PG8_LDB(B1, 1, 1); PG8_STAGE_B(PG8_SB(1, 0), b3, 0);
            PG8_BAR; PG8_WAIT_L(0); PG8_MMA(0, 1, At, B1); PG8_BAR;
            PG8_LDA(At, 1, 1); PG8_STAGE(PG8_SA(1, 0), a3, voffA);
            PG8_BAR; PG8_WAIT_L(0); PG8_MMA(1, 0, At, B0); PG8_BAR; PG8_SCHED;
            PG8_STAGE_B(PG8_SB(1, 1), b3, 1);
            PG8_WAIT_V(6); PG8_BAR; PG8_MMA(1, 1, At, B1); PG8_BAR;
            }
        }
        if constexpr (ALIGN_EPI) { if (wr == 0) PG8_BAR; }
        if constexpr (FP8) asm volatile("s_nop 15\n\ts_nop 15" ::: "memory");
        if constexpr (!Epi::AFTER_DRAIN) { E(acc, cur, wr, wc, fr, fq); S.done(cur); }
        if (!has_next) break;
        if constexpr (!SP2) {
#pragma unroll
        for (int a = 0; a < 2; ++a)
#pragma unroll
            for (int b = 0; b < 2; ++b)
#pragma unroll
                for (int m = 0; m < 4; ++m)
#pragma unroll
                    for (int n = 0; n < 2; ++n) acc[a][b][m][n] = (f32x4){0.f, 0.f, 0.f, 0.f}; }
        cur = nxt; cA = nA; cB = nB; ++ui;
        gslot ^= 1;
        if constexpr (ALIGN_EPI) { if (wr == 1) PG8_BAR; }
    }
    PG8_WAIT_V(0);
    if constexpr (!ALIGN_EPI) { if (wr == 0) PG8_BAR; }
    PG8_BAR;
    if constexpr (Epi::AFTER_DRAIN) { E.fused(acc, cur, wr, wc, fr, fq, lds, wid, lane); S.done(cur); }
#undef PG8_SA
#undef PG8_GOFF
#undef PG8_STAGE_A
#undef PG8_SB
#undef PG8_STAGE
#undef PG8_STAGE_B
#undef PG8_LDA
#undef PG8_LDB
#undef PG8_MMA
#undef PG8_MMAZ
#undef PG8_MMA0
#undef PG8_WAIT_V
#undef PG8_WAIT_V1
#undef PG8_WAIT_L
#undef PG8_BAR
#undef PG8_SCHED
}
}
#include <hip/hip_bf16.h>
#include <cmath>
namespace attn_body {
using bf16=__hip_bfloat16;
using bf16x8=__attribute__((ext_vector_type(8)))short;
using s16x4=__attribute__((ext_vector_type(4)))short;
using f32x16=__attribute__((ext_vector_type(16)))float;
using u32x4=__attribute__((ext_vector_type(4)))unsigned;
constexpr int SEQ=4096,D=64,PIN=3072,PO=1024;
constexpr int NW=8,QBLK=32,QB=QBLK*NW,KVBLK=64,NQB=SEQ/QB;
constexpr int ATTN_UNIT_ROWS=QB;
__device__ __forceinline__ int crow(int r,int hi){return (r&3)+8*(r>>2)+4*hi;}
#define SBAR() __builtin_amdgcn_sched_barrier(0)
__device__ __forceinline__ void cmask(f32x16&p0,f32x16&p1,int jb,int qrel,int hi){
  const float NEG=-INFINITY; int kb=64*jb+4*hi;
  #pragma unroll
  for(int r=0;r<16;++r){int kv=kb+(r&3)+8*(r>>2); if(kv>qrel)p0[r]=NEG; if(kv+32>qrel)p1[r]=NEG;}
}

constexpr int NSLOT=3, SLOTB=8192;
constexpr int LDS_K=0, LDS_V=NSLOT*SLOTB, LDS_V2=2*NSLOT*SLOTB, LDS_WS=3*NSLOT*SLOTB, LDS_OST=LDS_WS+NW*64*4, LDS_BYTES=LDS_OST+NW*4096;
constexpr float C2=0.125f*1.4426950408889634f;
__device__ __forceinline__ void glds16(const void*gsrc,unsigned lds_dst){unsigned keep;
  asm volatile("s_mov_b32 %0, m0\n\ts_mov_b32 m0, %2\n\ts_nop 0\n\tglobal_load_lds_dwordx4 %1, off\n\ts_mov_b32 m0, %0":"=&s"(keep):"v"(gsrc),"s"(lds_dst):"memory");}
__device__ __forceinline__ float max3f(float a,float b,float c){float r;asm("v_max3_f32 %0, %1, %2, %3":"=v"(r):"v"(a),"v"(b),"v"(c));return r;}
__device__ __forceinline__ float max2f(float a,float b){float r;asm("v_max_f32_e32 %0, %1, %2":"=v"(r):"v"(a),"v"(b));return r;}
__device__ __forceinline__ float fadd_s(float a,float b){float r;asm("v_add_f32_e32 %0, %1, %2":"=v"(r):"v"(a),"v"(b));return r;}
__device__ __forceinline__ float fsub_s(float a,float b){float r;asm("v_sub_f32_e32 %0, %1, %2":"=v"(r):"v"(a),"v"(b));return r;}
typedef float f32x2_t __attribute__((ext_vector_type(2))); typedef __bf16 bf16x2_t __attribute__((ext_vector_type(2)));
__device__ __forceinline__ unsigned cvtpk_s(float lo,float hi){f32x2_t v={lo,hi};bf16x2_t b=__builtin_convertvector(v,bf16x2_t);return __builtin_bit_cast(unsigned,b);}
#define WAIT_BAR(N) asm volatile("s_waitcnt vmcnt(" #N ") lgkmcnt(0)\n\ts_barrier":::"memory")

__device__ __forceinline__ void qkt(f32x16&p0,f32x16&p1,const char*Kslot,const bf16x8*qr,const f32x16&negm,int r32,int hi){
  const char*kb=Kslot+hi*1024+r32*16;
  #pragma unroll
  for(int d0=0;d0<4;++d0){
    const bf16x8 b0=*reinterpret_cast<const bf16x8*>(kb+d0*2048);
    const bf16x8 b1=*reinterpret_cast<const bf16x8*>(kb+d0*2048+512);
    if(d0==0){p0=__builtin_amdgcn_mfma_f32_32x32x16_bf16(b0,qr[0],negm,0,0,0);p1=__builtin_amdgcn_mfma_f32_32x32x16_bf16(b1,qr[0],negm,0,0,0);}
    else{p0=__builtin_amdgcn_mfma_f32_32x32x16_bf16(b0,qr[d0],p0,0,0,0);p1=__builtin_amdgcn_mfma_f32_32x32x16_bf16(b1,qr[d0],p1,0,0,0);}}
}
typedef __attribute__((address_space(3))) const char* lds_cptr;
typedef short v4i16_t __attribute__((ext_vector_type(4)));
__device__ __forceinline__ void kload8(bf16x8*kf,lds_cptr kp){
  kf[0]=*(const __attribute__((address_space(3))) bf16x8*)(kp);      kf[1]=*(const __attribute__((address_space(3))) bf16x8*)(kp+512);
  kf[2]=*(const __attribute__((address_space(3))) bf16x8*)(kp+2048); kf[3]=*(const __attribute__((address_space(3))) bf16x8*)(kp+2560);
  kf[4]=*(const __attribute__((address_space(3))) bf16x8*)(kp+4096); kf[5]=*(const __attribute__((address_space(3))) bf16x8*)(kp+4608);
  kf[6]=*(const __attribute__((address_space(3))) bf16x8*)(kp+6144); kf[7]=*(const __attribute__((address_space(3))) bf16x8*)(kp+6656);
}
__device__ __forceinline__ void kload2(bf16x8*kf,lds_cptr kp,int j){ kf[2*j]=*(const __attribute__((address_space(3))) bf16x8*)(kp+j*2048); kf[2*j+1]=*(const __attribute__((address_space(3))) bf16x8*)(kp+j*2048+512); }
__device__ __forceinline__ s16x4 vtr(lds_cptr p){ return __builtin_bit_cast(s16x4,__builtin_amdgcn_ds_read_tr16_b64_v4i16((__attribute__((address_space(3))) v4i16_t*)p)); }
__device__ __forceinline__ float rowmax(const f32x16&p0,const f32x16&p1){
  float a=max3f(p0[0],p0[1],p1[0]),b=max3f(p0[2],p0[3],p1[1]);a=max3f(a,p1[2],p1[3]);
  #pragma unroll
  for(int r=4;r<16;r+=4){a=max3f(a,p0[r],p0[r+1]);b=max3f(b,p0[r+2],p0[r+3]);a=max3f(a,p1[r],p1[r+1]);b=max3f(b,p1[r+2],p1[r+3]);}
  const float m=max2f(a,b);
  auto rr=__builtin_amdgcn_permlane32_swap(__float_as_uint(m),__float_as_uint(m),false,false);
  return max2f(__uint_as_float(rr[0]),__uint_as_float(rr[1]));
}
__device__ __forceinline__ void pv(f32x16*o,int vb,bf16x8 pa0,bf16x8 pa1,bf16x8 pa2,bf16x8 pa3){
  #pragma unroll
  for(int d0=0;d0<2;++d0){s16x4 lo[4],hi[4];
    #pragma unroll
    for(int ks=0;ks<4;++ks){
      asm volatile("ds_read_b64_tr_b16 %0,%1 offset:%c2":"=&v"(lo[ks]):"v"(vb),"i"(d0*4096+ks*1024):"memory");
      asm volatile("ds_read_b64_tr_b16 %0,%1 offset:%c2":"=&v"(hi[ks]):"v"(vb),"i"(d0*4096+ks*1024+512):"memory");}
    asm volatile("s_waitcnt lgkmcnt(0)":::"memory");SBAR();
    #define PK(k) (bf16x8){lo[k][0],lo[k][1],lo[k][2],lo[k][3],hi[k][0],hi[k][1],hi[k][2],hi[k][3]}
    o[d0]=__builtin_amdgcn_mfma_f32_32x32x16_bf16(pa0,PK(0),o[d0],0,0,0);
    o[d0]=__builtin_amdgcn_mfma_f32_32x32x16_bf16(pa1,PK(1),o[d0],0,0,0);
    o[d0]=__builtin_amdgcn_mfma_f32_32x32x16_bf16(pa2,PK(2),o[d0],0,0,0);
    o[d0]=__builtin_amdgcn_mfma_f32_32x32x16_bf16(pa3,PK(3),o[d0],0,0,0);
    #undef PK
  }
}

#ifndef ATTN_STORE16
#define ATTN_STORE16(p,v) (*(u32x4*)(p)=(v))
#endif
template<int THRL> __device__ __forceinline__ void attn_unit(int b,int qb,const bf16*Q,const bf16*__restrict__ K,const bf16*__restrict__ V,bf16*O,char*shm,int cmap,float lam,float osc,const float*ng,bf16*M){
  int tid_=threadIdx.x; asm volatile("":"+v"(tid_)); const int tid=tid_,lane=tid&63,r32=lane&31,hi=lane>>5; const int wid=__builtin_amdgcn_readfirstlane(tid>>6);
  const long rowbase=(long)b*SEQ; const int q0=qb*QB;
  const bf16*Qw=Q+(rowbase+q0+wid*QBLK)*PIN;
  const bf16*Kh=K+rowbase*PIN,*Vh=V+rowbase*PIN;
  const unsigned lds0=(unsigned)(uintptr_t)shm;
  float*wsf=(float*)(shm+LDS_WS)+wid*64;
  const unsigned koff=(unsigned)(lane*PIN+wid*8)*2u, voff=(unsigned)((16*(wid&3)+(lane>>2))*PIN+(wid>>2)*32+(lane&3)*8)*2u;
  const unsigned kdst=lds0+LDS_K+wid*1024, vdst=lds0+LDS_V+wid*1024, vdst2=lds0+LDS_V2+wid*1024;
  #define DMA_K(t,slot) glds16((const char*)Kh+(size_t)(t)*(KVBLK*PIN*2)+koff,(unsigned)__builtin_amdgcn_readfirstlane(kdst+(slot)))
  #define DMA_V(t,slot) do{ glds16((const char*)Vh+(size_t)(t)*(KVBLK*PIN*2)+voff,(unsigned)__builtin_amdgcn_readfirstlane(vdst+(slot))); glds16((const char*)Vh+(size_t)(t)*(KVBLK*PIN*2)+128+voff,(unsigned)__builtin_amdgcn_readfirstlane(vdst2+(slot))); }while(0)
  const int vb0=(int)(lds0+LDS_V)+((lane>>4)&1)*32+(lane&3)*8+(4*hi+((lane&15)>>2))*64;
  const char*Kbase=shm+LDS_K; bf16x8 kf[8];
  const lds_cptr shm3=(lds_cptr)shm; const lds_cptr kp0=shm3+LDS_K+hi*1024+r32*16; const lds_cptr vp0=shm3+LDS_V+((lane>>4)&1)*32+(lane&3)*8+(4*hi+((lane&15)>>2))*64;
  const int NT=(q0+QB)/KVBLK;
  DMA_K(0,0);DMA_V(0,0);DMA_K(1,SLOTB);
  bf16x8 qr[4];
  #pragma unroll
  for(int d0=0;d0<4;++d0)qr[d0]=*reinterpret_cast<const bf16x8*>(&Qw[(long)r32*PIN+d0*16+hi*8]);
  const __attribute__((address_space(3))) bf16x8* qld=(const __attribute__((address_space(3))) bf16x8*)(shm3+LDS_OST+wid*4096)+lane;
  #pragma unroll
  for(int d0=0;d0<4;++d0)((__attribute__((address_space(3))) bf16x8*)(shm3+LDS_OST+wid*4096))[d0*64+lane]=qr[d0];
  float mhat=0.f,l_reg=0.f;f32x16 o[2];o[0]=f32x16{};o[1]=f32x16{};f32x16 o2[2];o2[0]=f32x16{};o2[1]=f32x16{}; const f32x16 zero16=f32x16{};
  const int qrel=wid*QBLK+r32;
  #define CMASK(P0,P1,t) do{int jb_=(t)-(NT-4); if(jb_>=0)cmask(P0,P1,jb_,qrel,hi);}while(0)
  bool resc=false;
  #define START(P0,P1) do{ const float rm=rowmax(P0,P1); resc=false; \
    { const float dl=rm; mhat=fadd_s(mhat,dl); \
      _Pragma("unroll") for(int r=0;r<16;++r){P0[r]=fsub_s(P0[r],dl);P1[r]=fsub_s(P1[r],dl);} } \
    _Pragma("unroll") for(int r=0;r<16;++r)P0[r]=__builtin_amdgcn_exp2f(P0[r]); }while(0)
  #define RESC() do{ if(resc){ asm volatile("s_waitcnt lgkmcnt(0)":::"memory"); \
      _Pragma("unroll") for(int d_=0;d_<2;++d_) _Pragma("unroll") for(int r=0;r<16;++r){ const float f_=wsf[crow(r,hi)]; o[d_][r]*=f_; o2[d_][r]*=f_; } } }while(0)
  f32x16 pA0,pA1,pB0,pB1;
  int sl_prev=0,sl_cur=0,sl_next=SLOTB;
  #define ROT() do{sl_prev=sl_cur;sl_cur=sl_next;sl_next=(sl_next==(NSLOT-1)*SLOTB)?0:sl_next+SLOTB;}while(0)
  DMA_K(2,2*SLOTB);
  WAIT_BAR(3);
  qkt(pA0,pA1,Kbase,qr,zero16,r32,hi);asm volatile("s_nop 15\n\ts_nop 7":"+v"(pA0),"+v"(pA1));CMASK(pA0,pA1,0);
  START(pA0,pA1);
  _Pragma("unroll") for(int r=0;r<16;++r)pA1[r]=__builtin_amdgcn_exp2f(pA1[r]);
  WAIT_BAR(0);
  DMA_K(3,0);DMA_V(1,SLOTB);
  ROT();
  kload8(kf,kp0+sl_cur);
  WAIT_BAR(3);
  s16x4 vlo[8],vhi[8]; u32x4 pw0,pw1,pw2,pw3;
  #define PKW(P,B) cvtpk_s(P[B],P[B+1])
  #define PAF(k) __builtin_bit_cast(bf16x8,pw##k)
  #define VFR(i) (bf16x8){vlo[i][0],vlo[i][1],vlo[i][2],vlo[i][3],vhi[i][0],vhi[i][1],vhi[i][2],vhi[i][3]}
  #define PIN(x) asm volatile("":"+v"(x))
  #define MX3(a,b,c) __builtin_fmaxf(__builtin_fmaxf((a),(b)),(c))
  #define GAPA(MF,A0,A1,A2,A3,W0,W1,PW) do{ MF; sacc+=A0; sacc+=A1; sacc+=A2; sacc+=A3; PIN(sacc); W0; W1; PIN(PW); SBAR(); }while(0)
  #define EX(v) __builtin_amdgcn_exp2f(v)
  #define GAPB(MF,X,B) do{ MF; X[B]=EX(X[B]-mhat); X[B+1]=EX(X[B+1]-mhat); PIN(X); SBAR(); }while(0)
  #define VRD(i) do{ vlo[i]=vtr(vp_+(((i)>>2)*4096+((i)&3)*1024)); vhi[i]=vtr(vp_+(((i)>>2)*4096+((i)&3)*1024+512)); }while(0)
  #define KRD(G,j) do{ if(G){ kload2(kf,kp0+sl_next,j); SBAR(); } }while(0)
  #define V2RD(i) do{ vlo[i]=vtr(vq_+(((i)>>2)*4096+((i)&3)*1024)); vhi[i]=vtr(vq_+(((i)>>2)*4096+((i)&3)*1024+512)); }while(0)
  #define STEP(C0,C1,P0,P1,t,GK,GV,GL) do{ SBAR(); \
    const lds_cptr vp_=vp0+sl_prev; \
    const bf16x8 q0_=qld[0],q1_=qld[64],q2_=qld[128],q3_=qld[192];     \
    VRD(0); SBAR(); float sacc=(P0[0]+P0[1]); \
    GAPA(C0=__builtin_amdgcn_mfma_f32_32x32x16_bf16(kf[0],q0_,zero16,0,0,0), P0[2],P0[3],P0[4],P0[5],     pw0[0]=PKW(P0,0), pw0[1]=PKW(P0,2), pw0); \
    VRD(4); SBAR(); GAPA(C1=__builtin_amdgcn_mfma_f32_32x32x16_bf16(kf[1],q0_,zero16,0,0,0), P0[6],P0[7],P0[8],P0[9],     pw0[2]=PKW(P0,4), pw0[3]=PKW(P0,6), pw0); \
    VRD(1); SBAR(); GAPA(C0=__builtin_amdgcn_mfma_f32_32x32x16_bf16(kf[2],q1_,C0,0,0,0),   P0[10],P0[11],P0[12],P0[13], pw1[0]=PKW(P0,8), pw1[1]=PKW(P0,10), pw1); \
    VRD(5); SBAR(); GAPA(C1=__builtin_amdgcn_mfma_f32_32x32x16_bf16(kf[3],q1_,C1,0,0,0),   P0[14],P0[15],P1[0],P1[1],   pw1[2]=PKW(P0,12),pw1[3]=PKW(P0,14), pw1); \
    VRD(2); SBAR(); GAPA(C0=__builtin_amdgcn_mfma_f32_32x32x16_bf16(kf[4],q2_,C0,0,0,0),   P1[2],P1[3],P1[4],P1[5],     pw2[0]=PKW(P1,0), pw2[1]=PKW(P1,2), pw2); \
    VRD(6); SBAR(); GAPA(C1=__builtin_amdgcn_mfma_f32_32x32x16_bf16(kf[5],q2_,C1,0,0,0),   P1[6],P1[7],P1[8],P1[9],     pw2[2]=PKW(P1,4), pw2[3]=PKW(P1,6), pw2); \
    VRD(3); SBAR(); GAPA(C0=__builtin_amdgcn_mfma_f32_32x32x16_bf16(kf[6],q3_,C0,0,0,0),   P1[10],P1[11],P1[12],P1[13], pw3[0]=PKW(P1,8), pw3[1]=PKW(P1,10), pw3); \
    VRD(7); SBAR(); GAPA(C1=__builtin_amdgcn_mfma_f32_32x32x16_bf16(kf[7],q3_,C1,0,0,0),   P1[14],P1[15],0.f,0.f,       pw3[2]=PKW(P1,12),pw3[3]=PKW(P1,14), pw3); \
    l_reg+=sacc; \
    if(GK){DMA_K((t)+3,sl_cur);} if(GV){DMA_V((t)+1,sl_next);} \
    CMASK(C0,C1,t); \
    { float a=MX3(C0[0],C0[1],C1[0]),b=MX3(C0[2],C0[3],C1[1]); a=MX3(a,C1[2],C1[3]); \
      _Pragma("unroll") for(int r=4;r<16;r+=4){a=MX3(a,C0[r],C0[r+1]);b=MX3(b,C0[r+2],C0[r+3]);a=MX3(a,C1[r],C1[r+1]);b=MX3(b,C1[r+2],C1[r+3]);} \
      float rm=__builtin_fmaxf(a,b); { auto rr=__builtin_amdgcn_permlane32_swap(__float_as_uint(rm),__float_as_uint(rm),false,false); rm=__builtin_fmaxf(__uint_as_float(rr[0]),__uint_as_float(rr[1])); } \
      rm-=mhat; resc=false; \
      if(__builtin_expect(__any(rm>(float)THRL),0)){ const float dl=__builtin_fmaxf(rm,0.f); mhat+=dl; \
        const float f=__builtin_amdgcn_exp2f(-dl); l_reg*=f; if(hi==0)wsf[r32]=f; resc=true; } } \
    SBAR(); \
    const lds_cptr vq_=vp0+(LDS_V2-LDS_V)+sl_prev;     \
    GAPB(o[0]=__builtin_amdgcn_mfma_f32_32x32x16_bf16(PAF(0),VFR(0),o[0],0,0,0), C0,0); \
    GAPB(o[1]=__builtin_amdgcn_mfma_f32_32x32x16_bf16(PAF(0),VFR(4),o[1],0,0,0), C0,2); V2RD(0); V2RD(4); SBAR(); \
    KRD(GL,0); GAPB(o[0]=__builtin_amdgcn_mfma_f32_32x32x16_bf16(PAF(1),VFR(1),o[0],0,0,0), C0,4); \
    KRD(GL,1); GAPB(o[1]=__builtin_amdgcn_mfma_f32_32x32x16_bf16(PAF(1),VFR(5),o[1],0,0,0), C0,6); V2RD(1); V2RD(5); SBAR(); \
    KRD(GL,2); GAPB(o[0]=__builtin_amdgcn_mfma_f32_32x32x16_bf16(PAF(2),VFR(2),o[0],0,0,0), C0,8); \
    KRD(GL,3); GAPB(o[1]=__builtin_amdgcn_mfma_f32_32x32x16_bf16(PAF(2),VFR(6),o[1],0,0,0), C0,10); V2RD(2); V2RD(6); SBAR(); \
    GAPB(o[0]=__builtin_amdgcn_mfma_f32_32x32x16_bf16(PAF(3),VFR(3),o[0],0,0,0), C0,12); \
    GAPB(o[1]=__builtin_amdgcn_mfma_f32_32x32x16_bf16(PAF(3),VFR(7),o[1],0,0,0), C0,14); V2RD(3); V2RD(7); SBAR(); \
    {     \
      GAPB(o2[0]=__builtin_amdgcn_mfma_f32_32x32x16_bf16(PAF(0),VFR(0),o2[0],0,0,0), C1,0); GAPB(o2[1]=__builtin_amdgcn_mfma_f32_32x32x16_bf16(PAF(0),VFR(4),o2[1],0,0,0), C1,2); \
      GAPB(o2[0]=__builtin_amdgcn_mfma_f32_32x32x16_bf16(PAF(1),VFR(1),o2[0],0,0,0), C1,4); GAPB(o2[1]=__builtin_amdgcn_mfma_f32_32x32x16_bf16(PAF(1),VFR(5),o2[1],0,0,0), C1,6); \
      GAPB(o2[0]=__builtin_amdgcn_mfma_f32_32x32x16_bf16(PAF(2),VFR(2),o2[0],0,0,0), C1,8); GAPB(o2[1]=__builtin_amdgcn_mfma_f32_32x32x16_bf16(PAF(2),VFR(6),o2[1],0,0,0), C1,10); \
      GAPB(o2[0]=__builtin_amdgcn_mfma_f32_32x32x16_bf16(PAF(3),VFR(3),o2[0],0,0,0), C1,12); GAPB(o2[1]=__builtin_amdgcn_mfma_f32_32x32x16_bf16(PAF(3),VFR(7),o2[1],0,0,0), C1,14); } \
    }while(0)
  int t=1;
  #undef CMASK
  #define CMASK(P0,P1,t) do{}while(0)
  for(;t+5<NT;t+=2){
    STEP(pB0,pB1,pA0,pA1,t,true,true,true);     WAIT_BAR(3); RESC(); ROT();
    STEP(pA0,pA1,pB0,pB1,t+1,true,true,true);   WAIT_BAR(3); RESC(); ROT();
  }
  #undef CMASK
  #define CMASK(P0,P1,t) do{int jb_=(t)-(NT-4); if(jb_>=0)cmask(P0,P1,jb_,qrel,hi);}while(0)
  #define ENDW(tt) do{ if((tt)+3<NT){WAIT_BAR(3);} else if((tt)+2<NT){WAIT_BAR(2);} else {WAIT_BAR(0);} }while(0)
  for(;t+1<NT;t+=2){
    STEP(pB0,pB1,pA0,pA1,t,(t+3<NT),(t+1<NT),(t+1<NT));       ENDW(t);   RESC(); ROT();
    STEP(pA0,pA1,pB0,pB1,t+1,(t+4<NT),(t+2<NT),(t+2<NT));     ENDW(t+1); RESC(); ROT();
  }
  STEP(pB0,pB1,pA0,pA1,NT-1,false,false,false); RESC();
  { float sacc=pB0[0]+pB0[1]; _Pragma("unroll") for(int r=2;r<16;++r)sacc+=pB0[r]; _Pragma("unroll") for(int r=0;r<16;++r)sacc+=pB1[r]; l_reg+=sacc;
    pw0=(u32x4){PKW(pB0,0),PKW(pB0,2),PKW(pB0,4),PKW(pB0,6)};pw1=(u32x4){PKW(pB0,8),PKW(pB0,10),PKW(pB0,12),PKW(pB0,14)};pw2=(u32x4){PKW(pB1,0),PKW(pB1,2),PKW(pB1,4),PKW(pB1,6)};pw3=(u32x4){PKW(pB1,8),PKW(pB1,10),PKW(pB1,12),PKW(pB1,14)};
    SBAR(); pv(o,vb0+sl_cur,PAF(0),PAF(1),PAF(2),PAF(3)); pv(o2,vb0+(LDS_V2-LDS_V)+sl_cur,PAF(0),PAF(1),PAF(2),PAF(3)); }
  #undef PKW
  #undef PAF
  #undef VFR
  #undef PIN
  #undef MX3
  #undef GAPA
  #undef GAPB
  #undef EX
  #undef VRD
  #undef KRD
  #undef V2RD
  #undef STEP
  #undef ENDW
  {auto rr=__builtin_amdgcn_permlane32_swap(__float_as_uint(l_reg),__float_as_uint(l_reg),false,false);l_reg=__uint_as_float(rr[0])+__uint_as_float(rr[1]);}
  if(hi==0)wsf[32+r32]=l_reg;asm volatile("s_waitcnt lgkmcnt(0)":::"memory");
  float rli[16];
  #pragma unroll
  for(int r=0;r<16;++r)rli[r]=__builtin_amdgcn_rcpf(wsf[32+crow(r,hi)]);
  bf16*Ow=O+(rowbase+q0+wid*QBLK)*PO;
  { bf16*stg=(bf16*)(shm+LDS_OST)+wid*2048;
    if(cmap==0){
      #pragma unroll
      for(int hf=0;hf<2;++hf){
        #pragma unroll
        for(int r=0;r<16;++r){const int orow=crow(r,hi);
          #pragma unroll
          for(int d0=0;d0<2;++d0)stg[orow*64+d0*32+r32]=__float2bfloat16((hf?o2[d0][r]:o[d0][r])*rli[r]);}
        asm volatile("s_waitcnt lgkmcnt(0)":::"memory");
        #pragma unroll
        for(int i=0;i<4;++i){const int row=i*8+(lane>>3),ch=lane&7; const u32x4 v=*(const u32x4*)(stg+row*64+ch*8); ATTN_STORE16(Ow+(long)row*PO+hf*64+ch*8,v);}
        asm volatile("s_waitcnt lgkmcnt(0)":::"memory"); }
    } else {
      asm volatile("s_waitcnt vmcnt(0)":::"memory");
      float dd[2][4][8]; const int ch=lane&7;
      #pragma unroll
      for(int hf=0;hf<2;++hf){
        #pragma unroll
        for(int r=0;r<16;++r){const int orow=crow(r,hi);
          #pragma unroll
          for(int d0=0;d0<2;++d0)stg[orow*64+d0*32+r32]=__float2bfloat16((hf?o2[d0][r]:o[d0][r])*rli[r]);}
        asm volatile("s_waitcnt lgkmcnt(0)":::"memory");
        #pragma unroll
        for(int i=0;i<4;++i){const int row=i*8+(lane>>3); const u32x4 v1=*(const u32x4*)(stg+row*64+ch*8); const u32x4 v0=*(const u32x4*)(Ow+(long)row*PO+hf*64+ch*8);
          #pragma unroll
          for(int j=0;j<4;++j){ dd[hf][i][2*j]=__uint_as_float(v0[j]<<16)-lam*__uint_as_float(v1[j]<<16); dd[hf][i][2*j+1]=__uint_as_float(v0[j]&0xffff0000u)-lam*__uint_as_float(v1[j]&0xffff0000u); } }
        asm volatile("s_waitcnt lgkmcnt(0)":::"memory"); }
      float gg[2][8];
      #pragma unroll
      for(int hf=0;hf<2;++hf){ const float4 a=*(const float4*)(ng+hf*64+ch*8), c4=*(const float4*)(ng+hf*64+ch*8+4); gg[hf][0]=a.x;gg[hf][1]=a.y;gg[hf][2]=a.z;gg[hf][3]=a.w;gg[hf][4]=c4.x;gg[hf][5]=c4.y;gg[hf][6]=c4.z;gg[hf][7]=c4.w; }
      bf16*Mw=M+(rowbase+q0+wid*QBLK)*PO;
      #pragma unroll
      for(int i=0;i<4;++i){ float ss=0.f;
        #pragma unroll
        for(int hf=0;hf<2;++hf)
          #pragma unroll
          for(int j=0;j<8;++j)ss+=dd[hf][i][j]*dd[hf][i][j];
        ss+=__shfl_xor(ss,1);ss+=__shfl_xor(ss,2);ss+=__shfl_xor(ss,4);
        const float rr=osc/sqrtf(ss*(1.0f/128.0f)+1e-5f); const int row=i*8+(lane>>3);
        #pragma unroll
        for(int hf=0;hf<2;++hf){ u32x4 w;
          #pragma unroll
          for(int j=0;j<4;++j)w[j]=cvtpk_s(dd[hf][i][2*j]*rr*gg[hf][2*j],dd[hf][i][2*j+1]*rr*gg[hf][2*j+1]);
          ATTN_STORE16(Mw+(long)row*PO+hf*64+ch*8,w); } }
    } }
  asm volatile("s_waitcnt lgkmcnt(0)\n\ts_barrier":::"memory");
  #undef DMA_K
  #undef DMA_V
  #undef CMASK
  #undef START
  #undef RESC
  #undef ROT
}
constexpr int ATTN_LDS_BYTES=LDS_BYTES;
__device__ __forceinline__ void attn_phase(char*lds,const bf16*proj,bf16*O,bf16*M,const float*ng,float lam,float osc,int vcu){
  const int bh=vcu>>3, s=vcu&7, b=bh>>2, h=bh&3;
  const bf16*V=proj+1024+h*128; bf16*Oc=O+h*128; bf16*Mc=M+h*128;
  for(int i=0;i<2;++i){ const int qb=i?15-s:s;
    for(int c=0;c<2;++c) attn_unit<8>(b,qb,proj+h*128+c*64,proj+512+h*128+c*64,V,Oc,lds,c,lam,osc,ng,Mc); }
}
#undef SBAR
#undef WAIT_BAR
}
#define GAS __attribute__((address_space(1)))
#define LAS __attribute__((address_space(3)))
typedef unsigned short bf16;
typedef unsigned v4u __attribute__((ext_vector_type(4)));
typedef float f32x4 __attribute__((ext_vector_type(4)));
typedef short bf16x8 __attribute__((ext_vector_type(8)));
typedef GAS unsigned gu32;
typedef GAS unsigned long long gu64;
#define RLX_AGENT __ATOMIC_RELAXED, __HIP_MEMORY_SCOPE_AGENT
#define LDS_WAIT() asm volatile("s_waitcnt lgkmcnt(0)" ::: "memory")
#define VM_WAIT() asm volatile("s_waitcnt vmcnt(0)" ::: "memory")
__device__ __forceinline__ unsigned long long rt() { return __builtin_amdgcn_s_memrealtime(); }
__device__ __forceinline__ unsigned f2bf(float f) { unsigned u = __builtin_bit_cast(unsigned, f); return (u + 0x7fffu + ((u >> 16) & 1u)) >> 16; }
__device__ __forceinline__ unsigned pk2(float lo, float hi) { return f2bf(lo) | (f2bf(hi) << 16); }

#define XB_TMO      128
#define XB_XCNT(j)  (256  + 64 * (j))
#define XB_XSUB(j)  (1280 + 64 * (j))
#define XB_XGEN(j)  (2304 + 64 * (j))
#define XB_TOP      3328
#define XB_TOPGEN   3392
#define XCD_BAR_WORDS 3456
#define XB_SPIN_CAP (1u << 18)

__device__ __forceinline__ unsigned xb_ld(unsigned* p)              { return __hip_atomic_load(p, __ATOMIC_RELAXED, __HIP_MEMORY_SCOPE_AGENT); }
__device__ __forceinline__ unsigned xb_add(unsigned* p, unsigned v) { return __hip_atomic_fetch_add(p, v, __ATOMIC_RELAXED, __HIP_MEMORY_SCOPE_AGENT); }
__device__ __forceinline__ unsigned xb_xcc_id() { return (unsigned)__builtin_amdgcn_s_getreg((3 << 11) | 20) & 0xFu; }
#define XB_SPIN(cond, bar) do { unsigned _sp = 0; while (cond) { __builtin_amdgcn_s_sleep(1); \
    if ((++_sp & 255u) == 0u) { if (xb_ld(&(bar)[XB_TMO])) break; if (_sp > XB_SPIN_CAP) { atomicAdd(&(bar)[XB_TMO], 1u); break; } } } } while (0)

struct XcdBarrier {
    unsigned* bar; unsigned x;
    volatile LAS unsigned* st;
};

__device__ __forceinline__ XcdBarrier xcd_barrier_post(unsigned* bar, volatile LAS unsigned* st) {
    XcdBarrier b; b.bar = bar; b.x = xb_xcc_id(); b.st = st;
    if (threadIdx.x == 0) (void)xb_add(&bar[XB_XCNT(b.x)], 1u);
    return b;
}
__device__ __forceinline__ void xcd_barrier_complete(unsigned* bar, unsigned x, unsigned& nloc, unsigned& nx) {
    const unsigned G = gridDim.x * gridDim.y * gridDim.z;
    unsigned sum, cnt, mine, sp = 0u;
    for (;;) {
        sum = 0u; cnt = 0u; mine = 0u;
#pragma unroll
        for (unsigned j = 0; j < 16; ++j) { const unsigned c = xb_ld(&bar[XB_XCNT(j)]); sum += c; cnt += (c > 0u) ? 1u : 0u; mine = (j == x) ? c : mine; }
        if (sum == G) break;
        __builtin_amdgcn_s_sleep(1);
        if ((++sp & 255u) == 0u) { if (xb_ld(&bar[XB_TMO])) break; if (sp > XB_SPIN_CAP) { atomicAdd(&bar[XB_TMO], 1u); break; } }
    }
    nloc = mine > 0u ? mine : 1u; nx = cnt > 0u ? cnt : 1u;
}

__device__ __forceinline__ void xcd_barrier(const XcdBarrier& b) {
    asm volatile("s_waitcnt vmcnt(0)" ::: "memory");
    __syncthreads();
    if (threadIdx.x == 0) {
        unsigned* bar = b.bar;
        __builtin_amdgcn_s_waitcnt(0);
        unsigned nloc = b.st[0], nx = b.st[1];
        if (nloc == 0u) { xcd_barrier_complete(bar, b.x, nloc, nx); b.st[0] = nloc; b.st[1] = nx; }
        const unsigned old = xb_add(&bar[XB_XSUB(b.x)], 1u);
        const unsigned gen = old / nloc;
        if (old + 1u == (gen + 1u) * nloc) {
            __builtin_amdgcn_fence(__ATOMIC_RELEASE, "agent");
            asm volatile("s_waitcnt vmcnt(0)" ::: "memory");
            const unsigned og = xb_add(&bar[XB_TOP], 1u);
            const unsigned tg = og / nx;
            if (og + 1u == (tg + 1u) * nx) xb_add(&bar[XB_TOPGEN], 1u);
            else XB_SPIN(xb_ld(&bar[XB_TOPGEN]) == tg, bar);
            __builtin_amdgcn_fence(__ATOMIC_ACQUIRE, "agent");
            xb_add(&bar[XB_XGEN(b.x)], 1u);
            asm volatile("s_waitcnt vmcnt(0)" ::: "memory");
        } else {
            XB_SPIN(xb_ld(&bar[XB_XGEN(b.x)]) == gen, bar);
            __builtin_amdgcn_fence(__ATOMIC_ACQUIRE, "agent");
            asm volatile("s_waitcnt vmcnt(0)" ::: "memory");
        }
    }
    __syncthreads();
}
constexpr int NWAVES = 8, NTHREADS = NWAVES * 64;
constexpr int BATCH = 8, SEQ = 4096, NTOK = BATCH * SEQ, DMODEL = 1024, INW = 3080, NPROJ = 3072, DEPTH = 4;
constexpr int NEXP = 32, DFF = 1024, CHUNK = 64, NCH = SEQ / CHUNK, NBH = BATCH * 4;
constexpr int MAXRT = (NTOK * 4) / 256 + NEXP;
constexpr float DN_ALPHA = 1.681792830507429f, LN_EPS = 1e-5f, RMS_EPS = 1e-5f;
constexpr int NPH_LAYER = 10, NPHASES = 1 + DEPTH * NPH_LAYER;

constexpr size_t MiB = 1u << 20;
constexpr size_t WS_CTL = 0, CTL_ZERO_BYTES = 1 * MiB;
constexpr size_t WS_WIN = 2 * MiB;
#ifndef MK_SIDEJOB
#define MK_SIDEJOB 0
#endif
#ifndef MK_X1R8
#define MK_X1R8 1
#endif
constexpr float X1R_SCALE = 128.0f;
#ifndef MK_OUTFP8
#define MK_OUTFP8 0
#endif
constexpr float MQ_SCALE = 16.0f, MQ_ML = 2.0f;
constexpr size_t WS_WOUT = WS_WIN + 24 * MiB;
constexpr size_t WS_WGU = WS_WOUT + 8 * MiB;
constexpr size_t WS_WDN = WS_WGU + 512 * MiB;
constexpr size_t WS_XRES = WS_WDN + 256 * MiB;
constexpr size_t WS_X1 = WS_XRES + 128 * MiB;
constexpr size_t WS_XB = WS_X1 + 128 * MiB;
constexpr size_t WS_X1B = WS_XB + 64 * MiB;
constexpr size_t WS_PROJ = WS_X1B + 64 * MiB;
constexpr size_t WS_G = WS_PROJ + 192 * MiB;
constexpr size_t WS_ATTO = WS_G + 1 * MiB;
constexpr size_t WS_MIXIN = WS_ATTO + 64 * MiB;
constexpr size_t WS_MIXO = WS_MIXIN + 64 * MiB;
constexpr size_t WS_CST = WS_MIXO + 64 * MiB;
constexpr size_t WS_NST = WS_CST + 64 * MiB;
constexpr size_t WS_MISC = WS_NST + 1 * MiB;
constexpr size_t WS_WRP = WS_MISC + 512 * 1024;
constexpr size_t WS_TOKE = WS_MISC + 1 * MiB;
constexpr size_t WS_TOKP = WS_TOKE + 1 * MiB;
constexpr size_t WS_TOKG = WS_TOKP + 1 * MiB;
constexpr size_t WS_ROWTOK = WS_TOKG + 1 * MiB;
constexpr size_t WS_H = WS_ROWTOK + 4 * MiB;
constexpr size_t WS_Y = WS_H + 272 * MiB;
constexpr size_t WS_WINQ = WS_Y + 272 * MiB;
constexpr size_t WS_XQ = WS_WINQ + 8 * MiB;
constexpr size_t WS_END = WS_XQ + 32 * MiB;
static_assert((size_t)MAXRT * 256 * 1024 * 2 <= 272 * MiB, "H/Y size");
constexpr int CW_TMO = 0, CW_CODE = 1, CW_BAR = 4096, MAX_BAR_REGIONS = 48, CW_CNT = 200000;
static_assert(CW_BAR + MAX_BAR_REGIONS * 3456 <= CW_CNT && (CW_CNT + 64 * DEPTH) * 4 <= (int)CTL_ZERO_BYTES, "CTL map");
constexpr int RING_OFF = 0, RING_BYTES = 131072;
constexpr int LDSCTL_OFF = RING_BYTES;
constexpr int MISC_OFF = LDSCTL_OFF + 320;
constexpr int LDSX_OFF = LDSCTL_OFF + 512;
constexpr int LDS_BYTES = 163840;

typedef unsigned v2u __attribute__((ext_vector_type(2)));
__device__ __forceinline__ float bflo(unsigned w) { return __uint_as_float(w << 16); }
__device__ __forceinline__ float bfhi(unsigned w) { return __uint_as_float(w & 0xffff0000u); }
__device__ __forceinline__ void unpack8(const v4u w, float* o) { o[0] = bflo(w.x); o[1] = bfhi(w.x); o[2] = bflo(w.y); o[3] = bfhi(w.y); o[4] = bflo(w.z); o[5] = bfhi(w.z); o[6] = bflo(w.w); o[7] = bfhi(w.w); }
constexpr float XQ_SCALE = 8.0f, WQ_SCALE = 512.0f, HQ_SCALE = 8.0f, YQ_SCALE = 64.0f, XLO_SCALE = 4096.0f;
#ifndef MK_XLO
#define MK_XLO 0
#endif
constexpr bool USE_XLO = (MK_XLO != 0);
__device__ __forceinline__ v2u pack8_fp8(const float* o, float sc) { int a = 0, b = 0; a = __builtin_amdgcn_cvt_pk_fp8_f32(o[0] * sc, o[1] * sc, a, false); a = __builtin_amdgcn_cvt_pk_fp8_f32(o[2] * sc, o[3] * sc, a, true);
    b = __builtin_amdgcn_cvt_pk_fp8_f32(o[4] * sc, o[5] * sc, b, false); b = __builtin_amdgcn_cvt_pk_fp8_f32(o[6] * sc, o[7] * sc, b, true); return (v2u){(unsigned)a, (unsigned)b}; }
__device__ __forceinline__ v4u pack8(const float* o) { v4u w; w.x = pk2(o[0], o[1]); w.y = pk2(o[2], o[3]); w.z = pk2(o[4], o[5]); w.w = pk2(o[6], o[7]); return w; }
__device__ __forceinline__ float wave_sum(float v) {
#pragma unroll
    for (int o = 1; o < 64; o <<= 1) v += __shfl_xor(v, o);
    return v;
}
__device__ __forceinline__ float wave_max(float v) {
#pragma unroll
    for (int o = 1; o < 64; o <<= 1) v = fmaxf(v, __shfl_xor(v, o));
    return v;
}
__device__ __forceinline__ float sigmoid_f(float x) { return 1.0f / (1.0f + __expf(-x)); }

struct Ctx {
    LAS unsigned char* lds; int wave, vcu, G; unsigned char* ws; const float* const* in; float* out;
};
__device__ __forceinline__ int ltid() { int t = threadIdx.x; asm volatile("" : "+v"(t)); return t; }
enum { I_X = 0, I_WIN, I_CONVW, I_CONVB, I_GATEB, I_LQ1, I_LK1, I_LQ2, I_LK2, I_NG, I_WOUT, I_LN1G, I_LN1B, I_WR, I_BR, I_WGU, I_BGU, I_WDN, I_BDN, I_LN2G, I_LN2B };

__device__ __forceinline__ void load_row_f32(const float* row, int lane, float* v) {
    const f32x4* p = (const f32x4*)(row + 8 * lane); const f32x4 a = p[0], b = p[1]; const f32x4* q = (const f32x4*)(row + 512 + 8 * lane); const f32x4 c = q[0], d = q[1];
    v[0] = a.x; v[1] = a.y; v[2] = a.z; v[3] = a.w; v[4] = b.x; v[5] = b.y; v[6] = b.z; v[7] = b.w; v[8] = c.x; v[9] = c.y; v[10] = c.z; v[11] = c.w; v[12] = d.x; v[13] = d.y; v[14] = d.z; v[15] = d.w;
}
__device__ __forceinline__ void store_row_f32(float* row, int lane, const float* v) {
    f32x4* p = (f32x4*)(row + 8 * lane); p[0] = (f32x4){v[0], v[1], v[2], v[3]}; p[1] = (f32x4){v[4], v[5], v[6], v[7]};
    f32x4* q = (f32x4*)(row + 512 + 8 * lane); q[0] = (f32x4){v[8], v[9], v[10], v[11]}; q[1] = (f32x4){v[12], v[13], v[14], v[15]};
}
__device__ __forceinline__ void load_row_bf16(const bf16* row, int lane, float* v) {
    const v4u a = *(const v4u*)(row + 8 * lane), b = *(const v4u*)(row + 512 + 8 * lane); unpack8(a, v); unpack8(b, v + 8);
}
__device__ __forceinline__ void load_row_fp8(const unsigned char* row, int lane, float sc, float* v) {
    typedef float f32x2_ __attribute__((ext_vector_type(2)));
    const v2u a = *(const v2u*)(row + 8 * lane), b = *(const v2u*)(row + 512 + 8 * lane); const unsigned w[4] = {a.x, a.y, b.x, b.y};
#pragma unroll
    for (int i = 0; i < 4; ++i) { const f32x2_ lo = __builtin_amdgcn_cvt_pk_f32_fp8((int)w[i], false), hi = __builtin_amdgcn_cvt_pk_f32_fp8((int)w[i], true); v[4 * i] = lo.x * sc; v[4 * i + 1] = lo.y * sc; v[4 * i + 2] = hi.x * sc; v[4 * i + 3] = hi.y * sc; }
}
__device__ __forceinline__ void store_row_fp8(unsigned char* row, int lane, const float* v, float sc) {
    *(v2u*)(row + 8 * lane) = pack8_fp8(v, sc); *(v2u*)(row + 512 + 8 * lane) = pack8_fp8(v + 8, sc);
}
__device__ __forceinline__ void store_row_bf16(bf16* row, int lane, const float* v) {
    *(v4u*)(row + 8 * lane) = pack8(v); *(v4u*)(row + 512 + 8 * lane) = pack8(v + 8);
}
__device__ __forceinline__ void store_row_fp8_nt(unsigned char* row, int lane, const float* v, float sc) {
    __builtin_nontemporal_store(pack8_fp8(v, sc), (v2u*)(row + 8 * lane)); __builtin_nontemporal_store(pack8_fp8(v + 8, sc), (v2u*)(row + 512 + 8 * lane));
}
__device__ __forceinline__ void store_row_bf16_nt(bf16* row, int lane, const float* v) {
    __builtin_nontemporal_store(pack8(v), (v4u*)(row + 8 * lane)); __builtin_nontemporal_store(pack8(v + 8), (v4u*)(row + 512 + 8 * lane));
}
__device__ __forceinline__ void store_row_f32_nt(float* row, int lane, const float* v) {
    f32x4* p = (f32x4*)(row + 8 * lane); __builtin_nontemporal_store((f32x4){v[0], v[1], v[2], v[3]}, p); __builtin_nontemporal_store((f32x4){v[4], v[5], v[6], v[7]}, p + 1);
    f32x4* q = (f32x4*)(row + 512 + 8 * lane); __builtin_nontemporal_store((f32x4){v[8], v[9], v[10], v[11]}, q); __builtin_nontemporal_store((f32x4){v[12], v[13], v[14], v[15]}, q + 1);
}
__device__ __forceinline__ void ln_row(float* v, const float* g, const float* b) {
    float s = 0.f;
#pragma unroll
    for (int i = 0; i < 16; ++i) s += v[i];
    const float mean = wave_sum(s) * (1.0f / DMODEL); float q = 0.f;
#pragma unroll
    for (int i = 0; i < 16; ++i) { v[i] -= mean; q += v[i] * v[i]; }
    const float rstd = 1.0f / sqrtf(wave_sum(q) * (1.0f / DMODEL) + LN_EPS);
#pragma unroll
    for (int i = 0; i < 16; ++i) v[i] = v[i] * rstd * g[i] + b[i];
}
__device__ __forceinline__ void load_vec16(const float* p, int lane, float* v) { load_row_f32(p, lane, v); }

__device__ __forceinline__ void load_gate_w(int tid, const float* w_in_l, LAS f32x4* wgl) {
    for (int idx = tid; idx < 2048; idx += NTHREADS) { const int ln = idx & 63, hq = idx >> 6, half = hq & 1, q = hq >> 1; const int k = (q < 8) ? (8 * ln + q) : (512 + 8 * ln + q - 8);
        wgl[idx] = *(const f32x4*)(w_in_l + (size_t)k * INW + NPROJ + 4 * half); }
}
__device__ __forceinline__ void gates_row(const float* v, const LAS f32x4* wgl, const float* gate_b, float* Grow, int lane) {
    float p[8] = {0.f, 0.f, 0.f, 0.f, 0.f, 0.f, 0.f, 0.f};
#pragma unroll
    for (int q = 0; q < 16; ++q) { const f32x4 w0 = wgl[(q * 2 + 0) * 64 + lane], w1 = wgl[(q * 2 + 1) * 64 + lane];
        p[0] += v[q] * w0.x; p[1] += v[q] * w0.y; p[2] += v[q] * w0.z; p[3] += v[q] * w0.w; p[4] += v[q] * w1.x; p[5] += v[q] * w1.y; p[6] += v[q] * w1.z; p[7] += v[q] * w1.w; }
    const bool b5 = (lane >> 5) & 1, b4 = (lane >> 4) & 1, b3 = (lane >> 3) & 1;
    float r4[4];
#pragma unroll
    for (int i = 0; i < 4; ++i) { const float keep = b5 ? p[4 + i] : p[i], send = b5 ? p[i] : p[4 + i]; r4[i] = keep + __shfl_xor(send, 32); }
    float r2[2];
#pragma unroll
    for (int i = 0; i < 2; ++i) { const float keep = b4 ? r4[2 + i] : r4[i], send = b4 ? r4[i] : r4[2 + i]; r2[i] = keep + __shfl_xor(send, 16); }
    float r1; { const float keep = b3 ? r2[1] : r2[0], send = b3 ? r2[0] : r2[1]; r1 = keep + __shfl_xor(send, 8); }
    r1 += __shfl_xor(r1, 4); r1 += __shfl_xor(r1, 2); r1 += __shfl_xor(r1, 1);
    if ((lane & 7) == 0) { const int gi = (lane >> 3); Grow[gi] = r1 + gate_b[gi]; }
}
struct TrItem { const float* src; unsigned char* dst; int ldw, Kd, fp8; float sc; };
__device__ __forceinline__ void tr_fetch(const TrItem& a, float* ra, int lane) {
    const int kk0 = lane >> 5, nn = lane & 31;
#pragma unroll
    for (int i = 0; i < 64; ++i) ra[i] = a.src[(size_t)(2 * i + kk0) * a.ldw + nn];
}
__device__ __forceinline__ void tr_put(const float* ra, LAS float* scr, int lane) {
    const int kk0 = lane >> 5, nn = lane & 31;
#pragma unroll
    for (int i = 0; i < 64; ++i) scr[(2 * i + kk0) * 33 + nn] = ra[i];
}
__device__ __forceinline__ void tr_store(const TrItem& it, const LAS float* scr, int lane) {
    const int c = lane & 7;
#pragma unroll
    for (int j = 0; j < 4; ++j) { const int n = (lane >> 3) + 8 * j; const LAS float* s = scr + (16 * c) * 33 + n; float o[16];
#pragma unroll
        for (int i = 0; i < 16; ++i) o[i] = s[i * 33];
        if (it.fp8) { const v2u p = pack8_fp8(o, it.sc), q = pack8_fp8(o + 8, it.sc); *(GAS v4u*)(it.dst + (size_t)n * it.Kd + 16 * c) = (v4u){p.x, p.y, q.x, q.y}; }
        else { GAS v4u* d = (GAS v4u*)(it.dst + ((size_t)n * it.Kd + 16 * c) * 2); d[0] = pack8(o); d[1] = pack8(o + 8); } }
}
constexpr int TR_I_IN = DEPTH * 8 * 96, TR_I_OUT = DEPTH * 8 * 32, TR_I_GU = DEPTH * NEXP * 8 * 64, TR_I_DN = DEPTH * NEXP * 8 * 32, TR_ITEMS = TR_I_IN + TR_I_OUT + TR_I_GU + TR_I_DN;
__device__ __forceinline__ TrItem tr_decode(const Ctx& C, int r) {
    TrItem it;
    if (r < TR_I_GU) { const int m = r / 512, q = r % 512, kb = q / 64, nb = q % 64, n0 = 32 * nb;
        const int nn = (n0 < 1024) ? n0 : n0 - 1024; const int drow = 256 * (nn / 128) + (nn % 128) + ((n0 < 1024) ? 0 : 128);
        it.src = C.in[I_WGU] + (size_t)m * DMODEL * 2 * DFF + (size_t)(128 * kb) * (2 * DFF) + n0; it.ldw = 2 * DFF; it.Kd = DMODEL; it.fp8 = 1; it.sc = WQ_SCALE;
        it.dst = C.ws + WS_WGU + (size_t)m * 2 * DFF * DMODEL + (size_t)drow * DMODEL + 128 * kb; return it; }
    r -= TR_I_GU;
    if (r < TR_I_DN) { const int m = r / 256, q = r % 256, kb = q / 32, nb = q % 32;
        it.src = C.in[I_WDN] + (size_t)m * DFF * DMODEL + (size_t)(128 * kb) * DMODEL + 32 * nb; it.ldw = DMODEL; it.Kd = DFF; it.fp8 = 1; it.sc = WQ_SCALE;
        it.dst = C.ws + WS_WDN + (size_t)m * DMODEL * DFF + (size_t)(32 * nb) * DFF + 128 * kb; return it; }
    r -= TR_I_DN;
    if (r < TR_I_IN) { const int l = r / 768, q = r % 768, kb = q / 96, nb = q % 96, n0 = 32 * nb, tile = n0 >> 8;
        const bool q8 = (tile >= 8); const int rank = q8 ? tile - 8 : tile; const int drow = rank * 256 + (n0 & 255);
        it.src = C.in[I_WIN] + (size_t)l * DMODEL * INW + (size_t)(128 * kb) * INW + n0; it.ldw = INW; it.Kd = DMODEL; it.fp8 = q8 ? 1 : 0; it.sc = q8 ? WQ_SCALE : 1.f;
        it.dst = q8 ? C.ws + WS_WINQ + (size_t)l * 1536 * DMODEL + (size_t)drow * DMODEL + 128 * kb : C.ws + WS_WIN + ((size_t)l * NPROJ * DMODEL + (size_t)drow * DMODEL + 128 * kb) * 2; return it; }
    r -= TR_I_IN;
    { const int l = r / 256, q = r % 256, kb = q / 32, nb = q % 32;
        it.src = C.in[I_WOUT] + (size_t)l * DMODEL * DMODEL + (size_t)(128 * kb) * DMODEL + 32 * nb; it.ldw = DMODEL; it.Kd = DMODEL; it.fp8 = MK_OUTFP8; it.sc = MK_OUTFP8 ? ((kb >= 4) ? WQ_SCALE * (MQ_SCALE / MQ_ML) : WQ_SCALE) : 1.f;
        it.dst = C.ws + WS_WOUT + ((size_t)l * DMODEL * DMODEL + (size_t)(32 * nb) * DMODEL + 128 * kb) * (MK_OUTFP8 ? 1 : 2); return it; }
}
#ifndef MK_TRQ_RUNS
#define MK_TRQ_RUNS 0
#endif
constexpr int TR_L_GU = NEXP * 8 * 64, TR_L_DN = NEXP * 8 * 32, TR_L = TR_L_GU + TR_L_DN, TR_P_ITEMS = TR_L + TR_I_IN + TR_I_OUT, TRQ_LAYERS = DEPTH - 1;
__device__ __forceinline__ int trq_per(const Ctx& C) { return (TR_L + C.G - 1) / C.G; }
__device__ __forceinline__ int trq_item(const Ctx& C, int q) {
    const int per = trq_per(C), l = 1 + q / per, i = MK_TRQ_RUNS ? (C.vcu * per + q % per) : ((q % per) * C.G + C.vcu); if (i >= TR_L) return -1;
    return (i < TR_L_GU) ? l * TR_L_GU + i : TR_I_GU + l * TR_L_DN + (i - TR_L_GU); }
__device__ __forceinline__ int trp_item(int p) { return (p < TR_L_GU) ? p : (p < TR_L) ? TR_I_GU + (p - TR_L_GU) : TR_I_GU + TR_I_DN + (p - TR_L); }
__device__ __forceinline__ void tr_one(const Ctx& C, int r, LAS float* scr, int lane) {
    float ra[64]; const TrItem it = tr_decode(C, r); tr_fetch(it, ra, lane); tr_put(ra, scr, lane); LDS_WAIT(); asm volatile("" ::: "memory"); tr_store(it, scr, lane); LDS_WAIT(); asm volatile("" ::: "memory");
}
__device__ __forceinline__ int trq_grab(const Ctx& C, int lane) { unsigned v = 0u; if (lane == 0) v = __hip_atomic_fetch_add((LAS unsigned*)(C.lds + MISC_OFF) + 11, 1u, __ATOMIC_RELAXED, __HIP_MEMORY_SCOPE_WORKGROUP); return (int)__builtin_amdgcn_readfirstlane(v); }
__device__ __forceinline__ void trq_drain(const Ctx& C, int l) {
    const int lane = ltid() & 63, per = trq_per(C), endq = l * per, total = TRQ_LAYERS * per;
    LAS float* scr = (LAS float*)(C.lds + (C.wave < 7 ? RING_OFF + C.wave * 16896 : LDSX_OFF));
    for (;;) { const int q = trq_grab(C, lane); if (q >= total) break; const int r = trq_item(C, q); if (r >= 0) tr_one(C, r, scr, lane); if (q >= endq) break; }
    __syncthreads();
}
__device__ __forceinline__ void p_prologue(const Ctx& C) {
    const int tid = ltid(), lane = tid & 63;
    const int gw = C.vcu * NWAVES + C.wave, NGW = C.G * NWAVES;
    LAS float* scr = (LAS float*)(C.lds + (C.wave < 7 ? RING_OFF + C.wave * 16896 : LDSX_OFF));
    float ra[64]; TrItem cur = tr_decode(C, trp_item(gw < TR_P_ITEMS ? gw : 0));
    if (gw < TR_P_ITEMS) tr_fetch(cur, ra, lane);
    for (int it = gw; it < TR_P_ITEMS; it += NGW) {
        tr_put(ra, scr, lane);
        const bool more = (it + NGW < TR_P_ITEMS); const TrItem nxt = tr_decode(C, trp_item(more ? it + NGW : it));
        if (more) tr_fetch(nxt, ra, lane);
        LDS_WAIT(); asm volatile("" ::: "memory");
        tr_store(cur, scr, lane);
        LDS_WAIT(); asm volatile("" ::: "memory");
        cur = nxt;
    }
    { f32x4* WRP = (f32x4*)(C.ws + WS_WRP); const int gt = (C.vcu * NWAVES + C.wave) * 64 + lane, NGT = C.G * NTHREADS;
        for (int i = gt; i < DEPTH * 8192; i += NGT) { const int l = i >> 13, idx = i & 8191, ln = idx & 63, q4 = (idx >> 6) & 3, e = idx >> 8; const int k = (q4 < 2) ? (8 * ln + 4 * q4) : (512 + 8 * ln + 4 * (q4 - 2));
            const float* wr = C.in[I_WR] + (size_t)l * DMODEL * NEXP; WRP[i] = (f32x4){wr[(size_t)k * NEXP + e], wr[(size_t)(k + 1) * NEXP + e], wr[(size_t)(k + 2) * NEXP + e], wr[(size_t)(k + 3) * NEXP + e]}; } }
    __syncthreads();
    LAS f32x4* wgl = (LAS f32x4*)(C.lds + RING_OFF);
    load_gate_w(tid, C.in[I_WIN], wgl);
    __syncthreads();
    bf16* XB = (bf16*)(C.ws + WS_XB); float* G = (float*)(C.ws + WS_G);
    unsigned char* XLO = (unsigned char*)(C.ws + WS_XRES);
    for (int n = gw; n < NTOK; n += NGW) { float v[16], lo_[16]; load_row_f32(C.in[I_X] + (size_t)n * DMODEL, lane, v); store_row_bf16(XB + (size_t)n * DMODEL, lane, v);
#pragma unroll
        for (int i = 0; i < 16; ++i) lo_[i] = v[i] - __uint_as_float(f2bf(v[i]) << 16);
        if (USE_XLO) store_row_fp8(XLO + (size_t)n * DMODEL, lane, lo_, XLO_SCALE);
        store_row_fp8((unsigned char*)(C.ws + WS_XQ) + (size_t)n * DMODEL, lane, v, XQ_SCALE);
        gates_row(v, wgl, C.in[I_GATEB], G + (size_t)n * 8, lane); }
    __syncthreads();
}

__device__ __forceinline__ void conv_silu8(const bf16* proj, int n, int t, int col, const float* cw, const float* cb, float scale, float* y) {
    const f32x4 b0 = *(const f32x4*)cb, b1 = *(const f32x4*)(cb + 4);
    y[0] = b0.x; y[1] = b0.y; y[2] = b0.z; y[3] = b0.w; y[4] = b1.x; y[5] = b1.y; y[6] = b1.z; y[7] = b1.w;
#pragma unroll
    for (int j = 0; j < 4; ++j) { const int tt = t - 3 + j;
        if (tt >= 0) { const v4u w = *(const v4u*)(proj + (size_t)(n - 3 + j) * NPROJ + col); float x[8]; unpack8(w, x);
            const f32x4 c0 = *(const f32x4*)(cw + j * 512), c1 = *(const f32x4*)(cw + j * 512 + 4);
            y[0] += c0.x * x[0]; y[1] += c0.y * x[1]; y[2] += c0.z * x[2]; y[3] += c0.w * x[3]; y[4] += c1.x * x[4]; y[5] += c1.y * x[5]; y[6] += c1.z * x[6]; y[7] += c1.w * x[7]; } }
#pragma unroll
    for (int i = 0; i < 8; ++i) y[i] = y[i] * sigmoid_f(y[i]) * scale;
}
constexpr int KP = 68;

__device__ __forceinline__ void p_mlstm_states(const Ctx& C, int l) {
    const bf16* proj = (const bf16*)(C.ws + WS_PROJ); const float* G = (const float*)(C.ws + WS_G);
    float* CST = (float*)(C.ws + WS_CST); float* NST = (float*)(C.ws + WS_NST); float* MLOC = (float*)(C.ws + WS_MISC); float* GCH = MLOC + 2048;
    const float* cw = C.in[I_CONVW] + (size_t)l * 4 * 512; const float* cb = C.in[I_CONVB] + (size_t)l * 512;
    LAS float* kf = (LAS float*)(C.lds + RING_OFF);
    LAS float* vf = kf + 64 * 64;
    LAS float* ev = vf + 64 * 128;
    const int tid = ltid(), lane = tid & 63;
    for (int u = C.vcu; u < NBH * NCH; u += C.G) {
        const int bh = u / NCH, c = u % NCH, b = bh >> 2, h = bh & 3; const int n0 = b * SEQ + c * CHUNK;
        { const int s = tid >> 3, cg = tid & 7; float y[8]; conv_silu8(proj, n0 + s, c * CHUNK + s, 1536 + 256 + h * 64 + cg * 8, cw + 256 + h * 64 + cg * 8, cb + 256 + h * 64 + cg * 8, 1.0f, y);
#pragma unroll
            for (int i = 0; i < 8; ++i) kf[s * 64 + cg * 8 + i] = y[i];
            const bf16* vp = proj + (size_t)(n0 + s) * NPROJ + 2048 + h * 128 + cg * 16; float x[16]; unpack8(*(const v4u*)vp, x); unpack8(*(const v4u*)(vp + 8), x + 8);
#pragma unroll
            for (int i = 0; i < 16; ++i) vf[s * 128 + cg * 16 + i] = x[i]; }
        if (C.wave == 0) { const float ig = G[(size_t)(n0 + lane) * 8 + h], fg = G[(size_t)(n0 + lane) * 8 + 4 + h];
            float bc = fminf(fg, 0.f) - log1pf(expf(-fabsf(fg)));
#pragma unroll
            for (int o = 1; o < 64; o <<= 1) { const float t = __shfl_up(bc, o); if (lane >= o) bc += t; }
            const float g = __shfl(bc, 63); const float w = g - bc + ig; const float m = wave_max(w);
            ev[lane] = __expf(w - m); if (lane == 0) { MLOC[u] = m; GCH[u] = g; } }
        __syncthreads();
        { const int v = tid & 127, kg = tid >> 7; float acc[16];
#pragma unroll
            for (int i = 0; i < 16; ++i) acc[i] = 0.f;
            for (int s = 0; s < 64; ++s) { const float a = ev[s] * vf[s * 128 + v];
#pragma unroll
                for (int i4 = 0; i4 < 4; ++i4) { const f32x4 k4 = *(const LAS f32x4*)(kf + s * 64 + kg * 16 + i4 * 4); acc[i4 * 4 + 0] += a * k4.x; acc[i4 * 4 + 1] += a * k4.y; acc[i4 * 4 + 2] += a * k4.z; acc[i4 * 4 + 3] += a * k4.w; } }
            float* dst = CST + (size_t)u * 8192 + v;
#pragma unroll
            for (int i = 0; i < 16; ++i) dst[(kg * 16 + i) * 128] = acc[i]; }
        if (tid < 64) { float a = 0.f; for (int s = 0; s < 64; ++s) a += ev[s] * kf[s * 64 + tid]; NST[(size_t)u * 64 + tid] = a; }
        __syncthreads();
    }
}

__device__ __forceinline__ void p_mlstm_scan(const Ctx& C) {
    v2u* CST = (v2u*)(C.ws + WS_CST); f32x4* NST = (f32x4*)(C.ws + WS_NST); const float* MLOC = (const float*)(C.ws + WS_MISC); const float* GCH = MLOC + 2048; float* MPREV = (float*)(C.ws + WS_MISC) + 4096;
    const int nthr = C.G * NTHREADS, gid = C.vcu * NTHREADS + ltid();
    for (int it = gid; it < NBH * 2064; it += nthr) {
        const int bh = it / 2064, r = it % 2064;
        if (r < 2048) {
            v2u* p = CST + (size_t)bh * NCH * 2048 + r; float carry[4] = {0.f, 0.f, 0.f, 0.f}; float m = -INFINITY;
            for (int c0 = 0; c0 < NCH; c0 += 16) {
                v2u loc[16]; float gg[16], ml[16];
#pragma unroll
                for (int j = 0; j < 16; ++j) { loc[j] = p[(size_t)(c0 + j) * 2048]; gg[j] = GCH[bh * NCH + c0 + j]; ml[j] = MLOC[bh * NCH + c0 + j]; }
#pragma unroll
                for (int j = 0; j < 16; ++j) { p[(size_t)(c0 + j) * 2048] = (v2u){pk2(carry[0], carry[1]), pk2(carry[2], carry[3])}; if (r == 0) MPREV[bh * NCH + c0 + j] = m;
                    const float mn = fmaxf(gg[j] + m, ml[j]); const float a = __expf(gg[j] + m - mn), bb = __expf(ml[j] - mn);
                    carry[0] = carry[0] * a + bflo(loc[j].x) * bb; carry[1] = carry[1] * a + bfhi(loc[j].x) * bb; carry[2] = carry[2] * a + bflo(loc[j].y) * bb; carry[3] = carry[3] * a + bfhi(loc[j].y) * bb;
                    m = mn; }
            }
        } else {
            f32x4* p = NST + (size_t)bh * NCH * 16 + (r - 2048); f32x4 carry = (f32x4){0.f, 0.f, 0.f, 0.f}; float m = -INFINITY;
            for (int c0 = 0; c0 < NCH; c0 += 8) {
                f32x4 loc[8]; float gg[8], ml[8];
#pragma unroll
                for (int j = 0; j < 8; ++j) { loc[j] = p[(size_t)(c0 + j) * 16]; gg[j] = GCH[bh * NCH + c0 + j]; ml[j] = MLOC[bh * NCH + c0 + j]; }
#pragma unroll
                for (int j = 0; j < 8; ++j) { p[(size_t)(c0 + j) * 16] = carry;
                    const float mn = fmaxf(gg[j] + m, ml[j]); const float a = __expf(gg[j] + m - mn), bb = __expf(ml[j] - mn);
                    carry = carry * a + loc[j] * bb; m = mn; }
            }
        }
    }
}

__device__ __forceinline__ void p_mlstm_out(const Ctx& C, int l) {
    const bf16* proj = (const bf16*)(C.ws + WS_PROJ); const float* G = (const float*)(C.ws + WS_G);
    const float* CST = (const float*)(C.ws + WS_CST); const float* NST = (const float*)(C.ws + WS_NST); const float* MPREV = (const float*)(C.ws + WS_MISC) + 4096;
    bf16* MIXIN = (bf16*)(C.ws + WS_MIXIN);
    const float* cw = C.in[I_CONVW] + (size_t)l * 4 * 512; const float* cb = C.in[I_CONVB] + (size_t)l * 512;
    LAS float* qf = (LAS float*)(C.lds + RING_OFF);
    LAS float* kf = qf + 64 * KP;
    LAS float* Sm = kf + 64 * KP;
    LAS float* vf = Sm + 64 * KP;
    LAS float* Ct = vf + 64 * 128;
    LAS float* sv = Ct + 64 * 128;
    static_assert((3 * 64 * KP + 2 * 64 * 128 + 6 * 64) * 4 <= RING_BYTES, "mLSTM LDS");
    const int tid = ltid(), lane = tid & 63;
    for (int u = C.vcu; u < NBH * NCH; u += C.G) {
        const int bh = u / NCH, c = u % NCH, b = bh >> 2, h = bh & 3; const int n0 = b * SEQ + c * CHUNK;
        { const int s = tid >> 3, cg = tid & 7; float y[8];
            conv_silu8(proj, n0 + s, c * CHUNK + s, 1536 + h * 64 + cg * 8, cw + h * 64 + cg * 8, cb + h * 64 + cg * 8, 0.125f, y);
#pragma unroll
            for (int i = 0; i < 8; ++i) qf[s * KP + cg * 8 + i] = y[i];
            conv_silu8(proj, n0 + s, c * CHUNK + s, 1536 + 256 + h * 64 + cg * 8, cw + 256 + h * 64 + cg * 8, cb + 256 + h * 64 + cg * 8, 1.0f, y);
#pragma unroll
            for (int i = 0; i < 8; ++i) kf[s * KP + cg * 8 + i] = y[i];
            const bf16* vp = proj + (size_t)(n0 + s) * NPROJ + 2048 + h * 128 + cg * 16; float x[16]; unpack8(*(const v4u*)vp, x); unpack8(*(const v4u*)(vp + 8), x + 8);
#pragma unroll
            for (int i = 0; i < 16; ++i) vf[s * 128 + cg * 16 + i] = x[i];
            const f32x4* cp = (const f32x4*)(CST + (size_t)u * 8192);
#pragma unroll
            for (int i = 0; i < 4; ++i) *(LAS f32x4*)(Ct + (tid + NTHREADS * i) * 4) = cp[tid + NTHREADS * i]; }
        if (C.wave == 0) { const float ig = G[(size_t)(n0 + lane) * 8 + h], fg = G[(size_t)(n0 + lane) * 8 + 4 + h]; const float mp = MPREV[u];
            float bc = fminf(fg, 0.f) - log1pf(expf(-fabsf(fg)));
#pragma unroll
            for (int o = 1; o < 64; o <<= 1) { const float t = __shfl_up(bc, o); if (lane >= o) bc += t; }
            const float a = ig - bc; float pm = a;
#pragma unroll
            for (int o = 1; o < 64; o <<= 1) { const float t = __shfl_up(pm, o); if (lane >= o) pm = fmaxf(pm, t); }
            const float mt = bc + fmaxf(mp, pm);
            sv[lane] = bc; sv[64 + lane] = a; sv[128 + lane] = mt; sv[192 + lane] = __expf(bc + mp - mt); sv[320 + lane] = NST[(size_t)u * 64 + lane]; }
        __syncthreads();
        {
            const int t = tid >> 3, sg = tid & 7; float qr[64];
#pragma unroll
            for (int i = 0; i < 16; ++i) { const f32x4 q4 = *(const LAS f32x4*)(qf + t * KP + 4 * i); qr[4 * i] = q4.x; qr[4 * i + 1] = q4.y; qr[4 * i + 2] = q4.z; qr[4 * i + 3] = q4.w; }
            const float bt = sv[t] - sv[128 + t]; float dsum = 0.f;
#pragma unroll 2
            for (int j = 0; j < 8; ++j) { const int s = sg + 8 * j; float d = 0.f;
#pragma unroll
                for (int i = 0; i < 16; ++i) { const f32x4 k4 = *(const LAS f32x4*)(kf + s * KP + 4 * i); d += qr[4 * i] * k4.x + qr[4 * i + 1] * k4.y + qr[4 * i + 2] * k4.z + qr[4 * i + 3] * k4.w; }
                const float sc = (s <= t) ? d * __expf(sv[64 + s] + bt) : 0.f; Sm[t * KP + s] = sc; dsum += sc; }
            float nq = 0.f;
#pragma unroll
            for (int i = 0; i < 8; ++i) nq += qf[t * KP + sg * 8 + i] * sv[320 + sg * 8 + i];
            dsum += sv[192 + t] * nq;
            dsum += __shfl_xor(dsum, 1); dsum += __shfl_xor(dsum, 2); dsum += __shfl_xor(dsum, 4);
            if (sg == 0) sv[256 + t] = 1.0f / fmaxf(fabsf(dsum), __expf(-sv[128 + t])); }
        __syncthreads();
        {
            const int t = tid >> 3, vg = tid & 7; float acc[16];
#pragma unroll
            for (int i = 0; i < 16; ++i) acc[i] = 0.f;
            const float iw = sv[192 + t];
            for (int k = 0; k < 64; ++k) { const float a = qf[t * KP + k] * iw;
#pragma unroll
                for (int i4 = 0; i4 < 4; ++i4) { const f32x4 c4 = *(const LAS f32x4*)(Ct + k * 128 + vg * 16 + i4 * 4); acc[i4 * 4] += a * c4.x; acc[i4 * 4 + 1] += a * c4.y; acc[i4 * 4 + 2] += a * c4.z; acc[i4 * 4 + 3] += a * c4.w; } }
            for (int s = 0; s < 64; ++s) { const float a = Sm[t * KP + s];
#pragma unroll
                for (int i4 = 0; i4 < 4; ++i4) { const f32x4 v4 = *(const LAS f32x4*)(vf + s * 128 + vg * 16 + i4 * 4); acc[i4 * 4] += a * v4.x; acc[i4 * 4 + 1] += a * v4.y; acc[i4 * 4 + 2] += a * v4.z; acc[i4 * 4 + 3] += a * v4.w; } }
            const float dn = sv[256 + t];
            const bf16* op = proj + (size_t)(n0 + t) * NPROJ + 2560 + h * 128 + vg * 16; float o[16]; unpack8(*(const v4u*)op, o); unpack8(*(const v4u*)(op + 8), o + 8);
#pragma unroll
            for (int i = 0; i < 16; ++i) o[i] = acc[i] * dn * sigmoid_f(o[i]);
            bf16* dst = MIXIN + (size_t)(n0 + t) * DMODEL + 512 + h * 128 + vg * 16; *(v4u*)dst = pack8(o); *(v4u*)(dst + 8) = pack8(o + 8); }
        __syncthreads();
    }
}

__device__ __forceinline__ void p_da_combine(const Ctx& C, int l, float lam_init) {
    const bf16* ATTO = (const bf16*)(C.ws + WS_ATTO); bf16* MIXIN = (bf16*)(C.ws + WS_MIXIN);
    const int lane = ltid() & 63, gw = C.vcu * NWAVES + C.wave, NGW = C.G * NWAVES;
    const float s1 = wave_sum(C.in[I_LQ1][l * 64 + lane] * C.in[I_LK1][l * 64 + lane]), s2 = wave_sum(C.in[I_LQ2][l * 64 + lane] * C.in[I_LK2][l * 64 + lane]);
    const float lam = expf(s1) - expf(s2) + lam_init, osc = 1.0f - lam_init;
    const int h = lane >> 4, e8 = (lane & 15) * 8;
    float g[8]; { const f32x4 a = *(const f32x4*)(C.in[I_NG] + l * 128 + e8), b2 = *(const f32x4*)(C.in[I_NG] + l * 128 + e8 + 4); g[0] = a.x; g[1] = a.y; g[2] = a.z; g[3] = a.w; g[4] = b2.x; g[5] = b2.y; g[6] = b2.z; g[7] = b2.w; }
    for (int n = gw; n < NTOK; n += NGW) {
        float o0[8], o1[8]; unpack8(*(const v4u*)(ATTO + (size_t)n * DMODEL + h * 256 + e8), o0); unpack8(*(const v4u*)(ATTO + (size_t)n * DMODEL + h * 256 + 128 + e8), o1);
        float ss = 0.f;
#pragma unroll
        for (int i = 0; i < 8; ++i) { o0[i] -= lam * o1[i]; ss += o0[i] * o0[i]; }
        ss += __shfl_xor(ss, 1); ss += __shfl_xor(ss, 2); ss += __shfl_xor(ss, 4); ss += __shfl_xor(ss, 8);
        const float r = 1.0f / sqrtf(ss * (1.0f / 128.0f) + RMS_EPS) * osc;
#pragma unroll
        for (int i = 0; i < 8; ++i) o0[i] = o0[i] * r * g[i];
        *(v4u*)(MIXIN + (size_t)n * DMODEL + h * 128 + e8) = pack8(o0);
    }
}
typedef float f32x16 __attribute__((ext_vector_type(16)));
constexpr int TP = 72;
#define MFMA32(a, b, c) __builtin_amdgcn_mfma_f32_32x32x16_bf16((a), (b), (c), 0, 0, 0)
__device__ __forceinline__ bf16x8 frag_ld(const LAS bf16* tile, int row, int step, int h) { return *(const LAS bf16x8*)(tile + row * TP + step * 16 + 8 * h); }
__device__ __forceinline__ void tr_store16(LAS bf16* tile, int c0, int s, const v4u a, const v4u b) {
    const unsigned w[8] = {a.x, a.y, a.z, a.w, b.x, b.y, b.z, b.w};
#pragma unroll
    for (int i = 0; i < 8; ++i) { tile[(c0 + 2 * i) * TP + s] = (bf16)(w[i] & 0xffffu); tile[(c0 + 2 * i + 1) * TP + s] = (bf16)(w[i] >> 16); }
}

__device__ __forceinline__ void conv_fetch(const bf16* proj, int n, int t, int col, v4u* raw) {
#pragma unroll
    for (int j = 0; j < 4; ++j) { const int tt = t - 3 + j; raw[j] = (tt >= 0) ? *(const v4u*)(proj + (size_t)(n - 3 + j) * NPROJ + col) : (v4u){0u, 0u, 0u, 0u}; }
}
__device__ __forceinline__ void conv_apply(const v4u* raw, const float* cw, const float* cb, float scale, float* y) {
    const f32x4 b0 = *(const f32x4*)cb, b1 = *(const f32x4*)(cb + 4);
    y[0] = b0.x; y[1] = b0.y; y[2] = b0.z; y[3] = b0.w; y[4] = b1.x; y[5] = b1.y; y[6] = b1.z; y[7] = b1.w;
#pragma unroll
    for (int j = 0; j < 4; ++j) { float x[8]; unpack8(raw[j], x);
        const f32x4 c0 = *(const f32x4*)(cw + j * 512), c1 = *(const f32x4*)(cw + j * 512 + 4);
        y[0] += c0.x * x[0]; y[1] += c0.y * x[1]; y[2] += c0.z * x[2]; y[3] += c0.w * x[3]; y[4] += c1.x * x[4]; y[5] += c1.y * x[5]; y[6] += c1.z * x[6]; y[7] += c1.w * x[7]; }
#pragma unroll
    for (int i = 0; i < 8; ++i) y[i] = y[i] * sigmoid_f(y[i]) * scale;
}

__device__ __forceinline__ void p_mlstm_states_mfma(const Ctx& C, int l) {
    const bf16* proj = (const bf16*)(C.ws + WS_PROJ); const float* G = (const float*)(C.ws + WS_G);
    bf16* CST = (bf16*)(C.ws + WS_CST); float* NST = (float*)(C.ws + WS_NST); float* MLOC = (float*)(C.ws + WS_MISC); float* GCH = MLOC + 2048;
    const float* cw = C.in[I_CONVW] + (size_t)l * 4 * 512; const float* cb = C.in[I_CONVB] + (size_t)l * 512;
    LAS bf16* KeT = (LAS bf16*)(C.lds + RING_OFF);
    LAS bf16* Vt = KeT + 64 * TP;
    LAS float* ev = (LAS float*)(Vt + 128 * TP);
    const int tid = ltid(), lane = tid & 63, r = lane & 31, h = lane >> 5, s = tid & 63, cg = tid >> 6;
    v4u rk[4], rv[2]; float rig = 0.f, rfg = 0.f;
#define ST_FETCH(u_) do { const int bh_ = (u_) / NCH, c_ = (u_) % NCH, n0_ = (bh_ >> 2) * SEQ + c_ * CHUNK, hd_ = bh_ & 3; \
        conv_fetch(proj, n0_ + s, c_ * CHUNK + s, 1536 + 256 + hd_ * 64 + cg * 8, rk); const bf16* vp_ = proj + (size_t)(n0_ + s) * NPROJ + 2048 + hd_ * 128 + cg * 16; rv[0] = *(const v4u*)vp_; rv[1] = *(const v4u*)(vp_ + 8); \
        if (C.wave == 0) { rig = G[(size_t)(n0_ + lane) * 8 + hd_]; rfg = G[(size_t)(n0_ + lane) * 8 + 4 + hd_]; } } while (0)
    if (C.vcu < NBH * NCH) ST_FETCH(C.vcu);
    for (int u = C.vcu; u < NBH * NCH; u += C.G) {
        const int bh = u / NCH, hd = bh & 3;
        if (C.wave == 0) { const float ig = rig, fg = rfg;
            float bc = fminf(fg, 0.f) - log1pf(expf(-fabsf(fg)));
#pragma unroll
            for (int o = 1; o < 64; o <<= 1) { const float t = __shfl_up(bc, o); if (lane >= o) bc += t; }
            const float g = __shfl(bc, 63); const float w = g - bc + ig; const float m = wave_max(w);
            ev[lane] = __expf(w - m); if (lane == 0) { MLOC[u] = m; GCH[u] = g; } }
        __syncthreads();
        { float y[8]; conv_apply(rk, cw + 256 + hd * 64 + cg * 8, cb + 256 + hd * 64 + cg * 8, 1.0f, y);
            const float e = ev[s];
#pragma unroll
            for (int i = 0; i < 8; ++i) KeT[(cg * 8 + i) * TP + s] = (bf16)f2bf(y[i] * e);
            tr_store16(Vt, cg * 16, s, rv[0], rv[1]); }
        if (u + C.G < NBH * NCH) ST_FETCH(u + C.G);
        __syncthreads();
        { const int kb = C.wave & 1, vb = C.wave >> 1; f32x16 acc;
#pragma unroll
            for (int i = 0; i < 16; ++i) acc[i] = 0.f;
#pragma unroll
            for (int st = 0; st < 4; ++st) acc = MFMA32(frag_ld(KeT, kb * 32 + r, st, h), frag_ld(Vt, vb * 32 + r, st, h), acc);
            bf16* dst = CST + (size_t)u * 8192 + (size_t)(vb * 32 + r) * 64 + kb * 32 + 4 * h;
#pragma unroll
            for (int g = 0; g < 4; ++g) *(v2u*)(dst + 8 * g) = (v2u){pk2(acc[4 * g], acc[4 * g + 1]), pk2(acc[4 * g + 2], acc[4 * g + 3])}; }
        if (tid < 64) { float a = 0.f;
#pragma unroll 8
            for (int s_ = 0; s_ < 64; s_ += 2) { const unsigned w = *(const LAS unsigned*)(KeT + tid * TP + s_); a += bflo(w) + bfhi(w); }
            NST[(size_t)u * 64 + tid] = a; }
    }
#undef ST_FETCH
    __syncthreads();
}

__device__ __forceinline__ void p_mlstm_out_mfma(const Ctx& C, int l) {
    const bf16* proj = (const bf16*)(C.ws + WS_PROJ); const float* G = (const float*)(C.ws + WS_G);
    const bf16* CST = (const bf16*)(C.ws + WS_CST); const float* NST = (const float*)(C.ws + WS_NST); const float* MPREV = (const float*)(C.ws + WS_MISC) + 4096;
    bf16* MIXIN = (bf16*)(C.ws + WS_MIXIN);
    const float* cw = C.in[I_CONVW] + (size_t)l * 4 * 512; const float* cb = C.in[I_CONVB] + (size_t)l * 512;
    LAS bf16* Qt = (LAS bf16*)(C.lds + RING_OFF);
    LAS bf16* Kt = Qt + 64 * TP;
    LAS bf16* St = Kt + 64 * TP;
    LAS bf16* Vt = St + 64 * TP;
    LAS bf16* Ct = Vt + 128 * TP;
    LAS float* sv = (LAS float*)(Ct + 128 * TP);
    const int tid = ltid(), lane = tid & 63, r = lane & 31, h = lane >> 5;
    const int s = tid >> 3, cg = tid & 7, s2 = tid & 63, vg = tid >> 6, cv = tid >> 2, ck0 = (tid & 3) * 16, ot = (C.wave & 1) * 32 + r, ovb = C.wave >> 1;
    v4u rq[4], rk[4], rv[2], rc[2]; v2u ro[4], roc[4]; float rig = 0.f, rfg = 0.f, rmp = 0.f, rnp = 0.f;
#define OUT_FETCH(u_) do { const int bh_ = (u_) / NCH, c_ = (u_) % NCH, n0_ = (bh_ >> 2) * SEQ + c_ * CHUNK, hd_ = bh_ & 3; \
        conv_fetch(proj, n0_ + s, c_ * CHUNK + s, 1536 + hd_ * 64 + cg * 8, rq); conv_fetch(proj, n0_ + s, c_ * CHUNK + s, 1536 + 256 + hd_ * 64 + cg * 8, rk); \
        const bf16* vp_ = proj + (size_t)(n0_ + s2) * NPROJ + 2048 + hd_ * 128 + vg * 16; rv[0] = *(const v4u*)vp_; rv[1] = *(const v4u*)(vp_ + 8); \
        const v4u* cp_ = (const v4u*)(CST + (size_t)(u_) * 8192 + cv * 64 + ck0); rc[0] = cp_[0]; rc[1] = cp_[1]; \
        const bf16* op_ = proj + (size_t)(n0_ + ot) * NPROJ + 2560 + hd_ * 128 + ovb * 32 + 4 * h; _Pragma("unroll") for (int g_ = 0; g_ < 4; ++g_) ro[g_] = *(const v2u*)(op_ + 8 * g_); \
        if (C.wave == 0) { rig = G[(size_t)(n0_ + lane) * 8 + hd_]; rfg = G[(size_t)(n0_ + lane) * 8 + 4 + hd_]; rmp = MPREV[(u_)]; rnp = NST[(size_t)(u_) * 64 + lane]; } } while (0)
    if (C.vcu < NBH * NCH) OUT_FETCH(C.vcu);
    for (int u = C.vcu; u < NBH * NCH; u += C.G) {
        const int bh = u / NCH, c = u % NCH, b = bh >> 2, hd = bh & 3; const int n0 = b * SEQ + c * CHUNK;
        __syncthreads();
        { float y[8];
            conv_apply(rq, cw + hd * 64 + cg * 8, cb + hd * 64 + cg * 8, 0.125f, y); *(LAS v4u*)(Qt + s * TP + cg * 8) = pack8(y);
            conv_apply(rk, cw + 256 + hd * 64 + cg * 8, cb + 256 + hd * 64 + cg * 8, 1.0f, y); *(LAS v4u*)(Kt + s * TP + cg * 8) = pack8(y);
            tr_store16(Vt, vg * 16, s2, rv[0], rv[1]);
            *(LAS v4u*)(Ct + cv * TP + ck0) = rc[0]; *(LAS v4u*)(Ct + cv * TP + ck0 + 8) = rc[1];
#pragma unroll
            for (int g = 0; g < 4; ++g) roc[g] = ro[g]; }
        if (C.wave == 0) { const float ig = rig, fg = rfg; const float mp = rmp;
            float bc = fminf(fg, 0.f) - log1pf(expf(-fabsf(fg)));
#pragma unroll
            for (int o = 1; o < 64; o <<= 1) { const float t = __shfl_up(bc, o); if (lane >= o) bc += t; }
            const float a = ig - bc; float pm = a;
#pragma unroll
            for (int o = 1; o < 64; o <<= 1) { const float t = __shfl_up(pm, o); if (lane >= o) pm = fmaxf(pm, t); }
            const float mt = bc + fmaxf(mp, pm);
            sv[lane] = bc; sv[64 + lane] = a; sv[128 + lane] = mt; sv[192 + lane] = __expf(bc + mp - mt); sv[256 + lane] = rnp; }
        if (u + C.G < NBH * NCH) OUT_FETCH(u + C.G);
        __syncthreads();
        if (C.wave < 4) {
            const int sb = C.wave & 1, tb = C.wave >> 1; f32x16 x;
#pragma unroll
            for (int i = 0; i < 16; ++i) x[i] = 0.f;
#pragma unroll
            for (int st = 0; st < 4; ++st) x = MFMA32(frag_ld(Kt, sb * 32 + r, st, h), frag_ld(Qt, tb * 32 + r, st, h), x);
            const int t = tb * 32 + r; const float bt = sv[t] - sv[128 + t]; float dsum = 0.f;
#pragma unroll
            for (int g = 0; g < 4; ++g) { const int s0 = sb * 32 + 8 * g + 4 * h; float w[4];
#pragma unroll
                for (int i = 0; i < 4; ++i) { const int s = s0 + i; w[i] = (s <= t) ? x[4 * g + i] * __expf(sv[64 + s] + bt) : 0.f; }
                const unsigned p0 = pk2(w[0], w[1]), p1 = pk2(w[2], w[3]); dsum += (bflo(p0) + bfhi(p0)) + (bflo(p1) + bfhi(p1));
                *(LAS v2u*)(St + t * TP + s0) = (v2u){p0, p1}; }
            sv[384 + (sb * 2 + h) * 64 + t] = dsum;
        } else if (tid < 320) {
            const int t = tid - 256; float a = 0.f;
#pragma unroll 8
            for (int k = 0; k < 64; k += 2) { const unsigned w = *(const LAS unsigned*)(Qt + t * TP + k); a += bflo(w) * sv[256 + k] + bfhi(w) * sv[256 + k + 1]; }
            sv[320 + t] = a; }
        __syncthreads();
        {
            const int vb = C.wave >> 1, tb = C.wave & 1; f32x16 acc;
#pragma unroll
            for (int i = 0; i < 16; ++i) acc[i] = 0.f;
#pragma unroll
            for (int st = 0; st < 4; ++st) acc = MFMA32(frag_ld(Ct, vb * 32 + r, st, h), frag_ld(Qt, tb * 32 + r, st, h), acc);
            const int t = tb * 32 + r; const float iw = sv[192 + t];
#pragma unroll
            for (int i = 0; i < 16; ++i) acc[i] *= iw;
#pragma unroll
            for (int st = 0; st < 4; ++st) acc = MFMA32(frag_ld(Vt, vb * 32 + r, st, h), frag_ld(St, tb * 32 + r, st, h), acc);
            const float den = ((sv[384 + t] + sv[384 + 64 + t]) + (sv[384 + 128 + t] + sv[384 + 192 + t])) + iw * sv[320 + t];
            const float dn = 1.0f / fmaxf(fabsf(den), __expf(-sv[128 + t]));
            bf16* dst = MIXIN + (size_t)(n0 + t) * DMODEL + 512 + hd * 128 + vb * 32 + 4 * h;
#pragma unroll
            for (int g = 0; g < 4; ++g) { const v2u ow = roc[g]; const float o0 = bflo(ow.x), o1 = bfhi(ow.x), o2 = bflo(ow.y), o3 = bfhi(ow.y);
                *(v2u*)(dst + 8 * g) = (v2u){pk2(acc[4 * g] * dn * sigmoid_f(o0), acc[4 * g + 1] * dn * sigmoid_f(o1)), pk2(acc[4 * g + 2] * dn * sigmoid_f(o2), acc[4 * g + 3] * dn * sigmoid_f(o3))}; } }
    }
#undef OUT_FETCH
    __syncthreads();
}
constexpr size_t WS_TOTC = WS_CST + 32 * MiB;
constexpr size_t WS_TOTN = WS_NST + 512 * 1024;
constexpr int MS_DCUM = 6144, MS_TOTM = 8192, MS_TOTG = 8448;

__device__ __forceinline__ void p_mlstm_states_seq(const Ctx& C, int l) {
    const bf16* proj = (const bf16*)(C.ws + WS_PROJ); const float* G = (const float*)(C.ws + WS_G);
    bf16* CST = (bf16*)(C.ws + WS_CST); float* NST = (float*)(C.ws + WS_NST); float* MS = (float*)(C.ws + WS_MISC); float* MPREV = MS + 4096;
    float* TOTC = (float*)(C.ws + WS_TOTC); float* TOTN = (float*)(C.ws + WS_TOTN);
    const float* cw = C.in[I_CONVW] + (size_t)l * 4 * 512; const float* cb = C.in[I_CONVB] + (size_t)l * 512;
    LAS bf16* KeT = (LAS bf16*)(C.lds + RING_OFF);
    LAS bf16* Vt = KeT + 64 * TP;
    LAS float* ev = (LAS float*)(Vt + 128 * TP);
    const int tid = ltid(), lane = tid & 63, r = lane & 31, h = lane >> 5, s = tid & 63, cg = tid >> 6;
    v4u rkA[4], rvA[2], rkB[4], rvB[2]; float rigA = 0.f, rfgA = 0.f, rigB = 0.f, rfgB = 0.f;
#define ST_FETCH(u_) do { const int bh_ = (u_) / NCH, c_ = (u_) % NCH, n0_ = (bh_ >> 2) * SEQ + c_ * CHUNK, hd_ = bh_ & 3; \
        conv_fetch(proj, n0_ + s, c_ * CHUNK + s, 1536 + 256 + hd_ * 64 + cg * 8, rk); const bf16* vp_ = proj + (size_t)(n0_ + s) * NPROJ + 2048 + hd_ * 128 + cg * 16; rv[0] = *(const v4u*)vp_; rv[1] = *(const v4u*)(vp_ + 8); \
        if (C.wave == 0) { rig = G[(size_t)(n0_ + lane) * 8 + hd_]; rfg = G[(size_t)(n0_ + lane) * 8 + 4 + hd_]; } } while (0)
    const bool itw = MK_SIDEJOB && C.wave >= 1 && C.wave <= 6; const int itot = TRQ_LAYERS * trq_per(C);
    LAS float* iscr = (LAS float*)(C.lds + (C.wave <= 5 ? RING_OFF + 32768 + (C.wave - 1) * 16896 : LDSX_OFF));
    float ira[64]; int ir = -1;
#define SIDE_OUT() do { if (ir >= 0) { const TrItem it_ = tr_decode(C, ir); tr_put(ira, iscr, lane); LDS_WAIT(); asm volatile("" ::: "memory"); tr_store(it_, iscr, lane); LDS_WAIT(); asm volatile("" ::: "memory"); ir = -1; } } while (0)
#define SIDE_STEP() do { if (itw) { const int q_ = trq_grab(C, lane); ir = (q_ < itot) ? trq_item(C, q_) : -1; if (ir >= 0) { const TrItem it_ = tr_decode(C, ir); tr_fetch(it_, ira, lane); } } } while (0)
#define SIDE_FLUSH() do { if (itw) SIDE_OUT(); } while (0)
    for (int vc = C.vcu; vc < 256; vc += C.G) {
        const int bh = vc >> 3, hd = bh & 3, u0 = bh * NCH + (vc & 7) * 8;
        f32x16 crun; float nrun = 0.f, mrun = -INFINITY, drun = 0.f;
#pragma unroll
        for (int i = 0; i < 16; ++i) crun[i] = 0.f;
        { v4u (&rk)[4] = rkA; v4u (&rv)[2] = rvA; float& rig = rigA; float& rfg = rfgA; ST_FETCH(u0); }
        { v4u (&rk)[4] = rkB; v4u (&rv)[2] = rvB; float& rig = rigB; float& rfg = rfgB; ST_FETCH(u0 + 1); }
        auto body = [&](const int j, v4u (&rk)[4], v4u (&rv)[2], float& rig, float& rfg) __attribute__((always_inline)) {
            const int u = u0 + j;
            if (C.wave == 0) { const float ig = rig, fg = rfg;
                float bc = fminf(fg, 0.f) - log1pf(expf(-fabsf(fg)));
#pragma unroll
                for (int o = 1; o < 64; o <<= 1) { const float t = __shfl_up(bc, o); if (lane >= o) bc += t; }
                const float g = __shfl(bc, 63); const float w = g - bc + ig; const float m = wave_max(w);
                ev[lane] = __expf(w - m); if (lane == 0) { ev[64] = m; ev[65] = g; } }
            __syncthreads();
            { float y[8]; conv_apply(rk, cw + 256 + hd * 64 + cg * 8, cb + 256 + hd * 64 + cg * 8, 1.0f, y);
                const float e = ev[s];
#pragma unroll
                for (int i = 0; i < 8; ++i) KeT[(cg * 8 + i) * TP + s] = (bf16)f2bf(y[i] * e);
                tr_store16(Vt, cg * 16, s, rv[0], rv[1]); }
            const float mloc = ev[64], gch = ev[65];
            SIDE_FLUSH();
            if (j < 6) ST_FETCH(u + 2);
            __syncthreads();
            const float mnew = fmaxf(gch + mrun, mloc), fa = __expf(gch + mrun - mnew), fb = __expf(mloc - mnew);
            { const int kb = C.wave & 1, vb = C.wave >> 1; f32x16 acc;
#pragma unroll
                for (int i = 0; i < 16; ++i) acc[i] = 0.f;
#pragma unroll
                for (int st = 0; st < 4; ++st) acc = MFMA32(frag_ld(KeT, kb * 32 + r, st, h), frag_ld(Vt, vb * 32 + r, st, h), acc);
                bf16* dst = CST + (size_t)u * 8192 + (size_t)(vb * 32 + r) * 64 + kb * 32 + 4 * h;
#pragma unroll
                for (int g = 0; g < 4; ++g) *(v2u*)(dst + 8 * g) = (v2u){pk2(crun[4 * g], crun[4 * g + 1]), pk2(crun[4 * g + 2], crun[4 * g + 3])};
#pragma unroll
                for (int i = 0; i < 16; ++i) crun[i] = fa * crun[i] + fb * acc[i]; }
            if (tid < 64) { float a = 0.f;
#pragma unroll 8
                for (int s_ = 0; s_ < 64; s_ += 2) { const unsigned w = *(const LAS unsigned*)(KeT + tid * TP + s_); a += bflo(w) + bfhi(w); }
                NST[(size_t)u * 64 + tid] = nrun; nrun = fa * nrun + fb * a; }
            if (tid == 0) { MPREV[u] = mrun; MS[MS_DCUM + u] = drun; }
            mrun = mnew; drun += gch;
            SIDE_STEP();
        };
#pragma unroll 1
        for (int jj = 0; jj < 8; jj += 2) { body(jj, rkA, rvA, rigA, rfgA); body(jj + 1, rkB, rvB, rigB, rfgB); }
        SIDE_FLUSH();
        { const int kb = C.wave & 1, vb = C.wave >> 1; float* dst = TOTC + (size_t)vc * 8192 + (size_t)(vb * 32 + r) * 64 + kb * 32 + 4 * h;
#pragma unroll
            for (int g = 0; g < 4; ++g) *(f32x4*)(dst + 8 * g) = (f32x4){crun[4 * g], crun[4 * g + 1], crun[4 * g + 2], crun[4 * g + 3]}; }
        if (tid < 64) TOTN[vc * 64 + tid] = nrun;
        if (tid == 0) { MS[MS_TOTM + vc] = mrun; MS[MS_TOTG + vc] = drun; }
    }
#undef ST_FETCH
#undef SIDE_STEP
#undef SIDE_FLUSH
#undef SIDE_OUT
    __syncthreads();
}

__device__ __forceinline__ void p_mlstm_out_seq(const Ctx& C, int l) {
    const bf16* proj = (const bf16*)(C.ws + WS_PROJ); const float* G = (const float*)(C.ws + WS_G);
    const bf16* CST = (const bf16*)(C.ws + WS_CST); const float* NST = (const float*)(C.ws + WS_NST); const float* MS = (const float*)(C.ws + WS_MISC); const float* MPREV = MS + 4096;
    const float* TOTC = (const float*)(C.ws + WS_TOTC); const float* TOTN = (const float*)(C.ws + WS_TOTN);
    bf16* MIXIN = (bf16*)(C.ws + WS_MIXIN);
    const float* cw = C.in[I_CONVW] + (size_t)l * 4 * 512; const float* cb = C.in[I_CONVB] + (size_t)l * 512;
    LAS bf16* Qt = (LAS bf16*)(C.lds + RING_OFF);
    LAS bf16* Kt = Qt + 64 * TP;
    LAS bf16* St = Kt + 64 * TP;
    LAS bf16* Vt = St + 64 * TP;
    LAS bf16* Ct = Vt + 128 * TP;
    LAS float* sv = (LAS float*)(Ct + 128 * TP);
    const int tid = ltid(), lane = tid & 63, r = lane & 31, h = lane >> 5;
    const int s = tid >> 3, cg = tid & 7, s2 = tid & 63, vg = tid >> 6, cv = tid >> 2, ck0 = (tid & 3) * 16, ot = (C.wave & 1) * 32 + r, ovb = C.wave >> 1;
    v4u rq[4], rk[4], rv[2], rc[2], ro[2], rop[2]; float rig = 0.f, rfg = 0.f, rml = 0.f, rdc = 0.f, rnp = 0.f;
    LAS float* Os = sv + 640;
    static_assert((3 * 64 + 2 * 128) * TP * 2 + 640 * 4 + 64 * 132 * 4 <= RING_BYTES, "mLSTM LDS");
#define OUT_FETCH(u_) do { const int bh_ = (u_) / NCH, c_ = (u_) % NCH, n0_ = (bh_ >> 2) * SEQ + c_ * CHUNK, hd_ = bh_ & 3; \
        conv_fetch(proj, n0_ + s, c_ * CHUNK + s, 1536 + hd_ * 64 + cg * 8, rq); conv_fetch(proj, n0_ + s, c_ * CHUNK + s, 1536 + 256 + hd_ * 64 + cg * 8, rk); \
        const bf16* vp_ = proj + (size_t)(n0_ + s2) * NPROJ + 2048 + hd_ * 128 + vg * 16; rv[0] = *(const v4u*)vp_; rv[1] = *(const v4u*)(vp_ + 8); \
        const v4u* cp_ = (const v4u*)(CST + (size_t)(u_) * 8192 + cv * 64 + ck0); rc[0] = cp_[0]; rc[1] = cp_[1]; \
        const bf16* op_ = proj + (size_t)(n0_ + s) * NPROJ + 2560 + hd_ * 128 + cg * 16; ro[0] = *(const v4u*)op_; ro[1] = *(const v4u*)(op_ + 8); \
        rml = MPREV[(u_)]; rdc = MS[MS_DCUM + (u_)]; \
        if (C.wave == 0) { rig = G[(size_t)(n0_ + lane) * 8 + hd_]; rfg = G[(size_t)(n0_ + lane) * 8 + 4 + hd_]; rnp = NST[(size_t)(u_) * 64 + lane]; } } while (0)
#define OUT_FLUSH(nb_) do { float hv_[16], og_[16]; const LAS f32x4* hp_ = (const LAS f32x4*)(Os + s * 132 + cg * 16); \
        _Pragma("unroll") for (int q_ = 0; q_ < 4; ++q_) { const f32x4 t4_ = hp_[q_]; hv_[4 * q_] = t4_.x; hv_[4 * q_ + 1] = t4_.y; hv_[4 * q_ + 2] = t4_.z; hv_[4 * q_ + 3] = t4_.w; } \
        unpack8(rop[0], og_); unpack8(rop[1], og_ + 8); _Pragma("unroll") for (int i_ = 0; i_ < 16; ++i_) hv_[i_] *= sigmoid_f(og_[i_]); \
        bf16* dp_ = MIXIN + (size_t)((nb_) + s) * DMODEL + 512 + hd * 128 + cg * 16; *(v4u*)dp_ = pack8(hv_); *(v4u*)(dp_ + 8) = pack8(hv_ + 8); } while (0)
    for (int vc = C.vcu; vc < 256; vc += C.G) {
        const int bh = vc >> 3, gi = vc & 7, b = bh >> 2, hd = bh & 3, u0 = bh * NCH + gi * 8;
        OUT_FETCH(u0);
        float cin[16], nin = 0.f, min_ = -INFINITY;
#pragma unroll
        for (int i = 0; i < 16; ++i) cin[i] = 0.f;
#pragma unroll 1
        for (int g2 = 0; g2 < gi; ++g2) { const int gv = (bh << 3) + g2; const float tm = MS[MS_TOTM + gv], tg = MS[MS_TOTG + gv];
            const f32x4* tp = (const f32x4*)(TOTC + (size_t)gv * 8192 + cv * 64 + ck0); const f32x4 t0 = tp[0], t1 = tp[1], t2 = tp[2], t3 = tp[3]; const float tn = (C.wave == 0) ? TOTN[gv * 64 + lane] : 0.f;
            const float mn = fmaxf(tg + min_, tm), fa = __expf(tg + min_ - mn), fb = __expf(tm - mn);
            const float tt[16] = {t0.x, t0.y, t0.z, t0.w, t1.x, t1.y, t1.z, t1.w, t2.x, t2.y, t2.z, t2.w, t3.x, t3.y, t3.z, t3.w};
#pragma unroll
            for (int i = 0; i < 16; ++i) cin[i] = fa * cin[i] + fb * tt[i];
            nin = fa * nin + fb * tn; min_ = mn; }
#pragma unroll 1
        for (int j = 0; j < 8; ++j) {
            const int u = u0 + j, c = gi * 8 + j; const int n0 = b * SEQ + c * CHUNK;
            const float mp = fmaxf(rdc + min_, rml); const float w1 = (min_ == -INFINITY) ? 0.f : __expf(rdc + min_ - mp), w2 = (rml == -INFINITY) ? 0.f : __expf(rml - mp);
            __syncthreads();
            if (j > 0) OUT_FLUSH(n0 - CHUNK);
            { float y[8];
                conv_apply(rq, cw + hd * 64 + cg * 8, cb + hd * 64 + cg * 8, 0.125f, y); *(LAS v4u*)(Qt + s * TP + cg * 8) = pack8(y);
                conv_apply(rk, cw + 256 + hd * 64 + cg * 8, cb + 256 + hd * 64 + cg * 8, 1.0f, y); *(LAS v4u*)(Kt + s * TP + cg * 8) = pack8(y);
                tr_store16(Vt, vg * 16, s2, rv[0], rv[1]);
                float cl[16]; unpack8(rc[0], cl); unpack8(rc[1], cl + 8);
#pragma unroll
                for (int i = 0; i < 16; ++i) cl[i] = w1 * cin[i] + w2 * cl[i];
                *(LAS v4u*)(Ct + cv * TP + ck0) = pack8(cl); *(LAS v4u*)(Ct + cv * TP + ck0 + 8) = pack8(cl + 8);
                rop[0] = ro[0]; rop[1] = ro[1]; }
            if (C.wave == 0) { const float ig = rig, fg = rfg;
                float bc = fminf(fg, 0.f) - log1pf(expf(-fabsf(fg)));
#pragma unroll
                for (int o = 1; o < 64; o <<= 1) { const float t = __shfl_up(bc, o); if (lane >= o) bc += t; }
                const float a = ig - bc; float pm = a;
#pragma unroll
                for (int o = 1; o < 64; o <<= 1) { const float t = __shfl_up(pm, o); if (lane >= o) pm = fmaxf(pm, t); }
                const float mt = bc + fmaxf(mp, pm);
                sv[lane] = bc; sv[64 + lane] = a; sv[128 + lane] = mt; sv[192 + lane] = __expf(bc + mp - mt); sv[256 + lane] = w1 * nin + w2 * rnp; }
            if (j < 7) OUT_FETCH(u + 1);
            __syncthreads();
            if (C.wave < 4) {
                const int sb = C.wave & 1, tb = C.wave >> 1; f32x16 x;
#pragma unroll
                for (int i = 0; i < 16; ++i) x[i] = 0.f;
#pragma unroll
                for (int st = 0; st < 4; ++st) x = MFMA32(frag_ld(Kt, sb * 32 + r, st, h), frag_ld(Qt, tb * 32 + r, st, h), x);
                const int t = tb * 32 + r; const float bt = sv[t] - sv[128 + t]; float dsum = 0.f;
#pragma unroll
                for (int g = 0; g < 4; ++g) { const int s0 = sb * 32 + 8 * g + 4 * h; float w[4];
#pragma unroll
                    for (int i = 0; i < 4; ++i) { const int ss = s0 + i; w[i] = (ss <= t) ? x[4 * g + i] * __expf(sv[64 + ss] + bt) : 0.f; }
                    const unsigned p0 = pk2(w[0], w[1]), p1 = pk2(w[2], w[3]); dsum += (bflo(p0) + bfhi(p0)) + (bflo(p1) + bfhi(p1));
                    *(LAS v2u*)(St + t * TP + s0) = (v2u){p0, p1}; }
                sv[384 + (sb * 2 + h) * 64 + t] = dsum;
            } else if (tid < 320) {
                const int t = tid - 256; float a = 0.f;
#pragma unroll 8
                for (int k = 0; k < 64; k += 2) { const unsigned w = *(const LAS unsigned*)(Qt + t * TP + k); a += bflo(w) * sv[256 + k] + bfhi(w) * sv[256 + k + 1]; }
                sv[320 + t] = a; }
            __syncthreads();
            {
                const int vb = C.wave >> 1, tb = C.wave & 1; f32x16 acc;
#pragma unroll
                for (int i = 0; i < 16; ++i) acc[i] = 0.f;
#pragma unroll
                for (int st = 0; st < 4; ++st) acc = MFMA32(frag_ld(Ct, vb * 32 + r, st, h), frag_ld(Qt, tb * 32 + r, st, h), acc);
                const int t = tb * 32 + r; const float iw = sv[192 + t];
#pragma unroll
                for (int i = 0; i < 16; ++i) acc[i] *= iw;
#pragma unroll
                for (int st = 0; st < 4; ++st) acc = MFMA32(frag_ld(Vt, vb * 32 + r, st, h), frag_ld(St, tb * 32 + r, st, h), acc);
                const float den = ((sv[384 + t] + sv[384 + 64 + t]) + (sv[384 + 128 + t] + sv[384 + 192 + t])) + iw * sv[320 + t];
                const float dn = 1.0f / fmaxf(fabsf(den), __expf(-sv[128 + t]));
                LAS float* od = Os + t * 132 + vb * 32 + 4 * h;
#pragma unroll
                for (int g = 0; g < 4; ++g) *(LAS f32x4*)(od + 8 * g) = (f32x4){acc[4 * g] * dn, acc[4 * g + 1] * dn, acc[4 * g + 2] * dn, acc[4 * g + 3] * dn}; }
        }
        __syncthreads();
        OUT_FLUSH(b * SEQ + (gi * 8 + 7) * CHUNK);
    }
#undef OUT_FETCH
#undef OUT_FLUSH
    __syncthreads();
}
template <int W> __device__ __forceinline__ void tr_reduce_step(float* val, bool bit, int mask) {
#pragma unroll
    for (int i = 0; i < W / 2; ++i) { const float keep = bit ? val[i + W / 2] : val[i], send = bit ? val[i] : val[i + W / 2]; val[i] = keep + __shfl_xor(send, mask); }
}
__device__ __forceinline__ void p_ln1_router(const Ctx& C, int l, bool claim = true, bool norouter = false, bool nostore = false, bool norows = false, int stsel = 3) {
    const bf16* XBr = (const bf16*)(C.ws + WS_XB); const unsigned char* XLO = (const unsigned char*)(C.ws + WS_XRES);
    const bf16* MIXO = (const bf16*)(C.ws + WS_MIXO); float* X1 = (float*)(C.ws + WS_X1); unsigned char* X1Q = (unsigned char*)(C.ws + WS_X1B);
    int* TOKE = (int*)(C.ws + WS_TOKE); int* TOKP = (int*)(C.ws + WS_TOKP); float* TOKG = (float*)(C.ws + WS_TOKG); int* ROWTOK = (int*)(C.ws + WS_ROWTOK);
    unsigned* cntg = (unsigned*)(C.ws + WS_CTL) + CW_CNT + 64 * l;
    const float* br = C.in[I_BR] + l * NEXP;
    LAS f32x4* wl = (LAS f32x4*)(C.lds + RING_OFF);
    LAS float* lg = (LAS float*)(C.lds + LDSX_OFF) + C.wave * (16 * 32);
    LAS int* lc = (LAS int*)(C.lds + LDSX_OFF + 8 * 16 * 32 * 4);
    const int tid = ltid(), lane = tid & 63;
    { const f32x4* WRP = (const f32x4*)(C.ws + WS_WRP) + (size_t)l * 8192;
        for (int idx = tid; idx < 8192; idx += NTHREADS) wl[idx] = WRP[idx]; }
    LAS f32x4* gbl = (LAS f32x4*)(C.lds + LDSX_OFF + 8 * 16 * 32 * 4 + 512);
    { float g_[16], b_[16]; load_vec16(C.in[I_LN1G] + l * DMODEL, lane, g_); load_vec16(C.in[I_LN1B] + l * DMODEL, lane, b_);
      if (C.wave == 0) {
#pragma unroll
        for (int q = 0; q < 4; ++q) { gbl[q * 64 + lane] = (f32x4){g_[4 * q], g_[4 * q + 1], g_[4 * q + 2], g_[4 * q + 3]}; gbl[(4 + q) * 64 + lane] = (f32x4){b_[4 * q], b_[4 * q + 1], b_[4 * q + 2], b_[4 * q + 3]}; } } }
    const int gw = C.vcu * NWAVES + C.wave, NGW = C.G * NWAVES, NGRP = NTOK / 4;
    for (int g0 = gw; g0 < NGRP; g0 += 4 * NGW) {
        if (tid < 64) lc[tid] = 0;
        __syncthreads();
        v4u pxb[4][2], pmx[4][2]; v2u plo[4][2] = {};
#define LN1_FETCH(grp_) do { _Pragma("unroll") for (int r = 0; r < 4; ++r) { const size_t n_ = (size_t)((grp_) * 4 + r) * DMODEL; \
            pxb[r][0] = __builtin_nontemporal_load((const v4u*)(XBr + n_ + 8 * lane)); pxb[r][1] = __builtin_nontemporal_load((const v4u*)(XBr + n_ + 512 + 8 * lane)); if (USE_XLO) { plo[r][0] = *(const v2u*)(XLO + n_ + 8 * lane); plo[r][1] = *(const v2u*)(XLO + n_ + 512 + 8 * lane); } \
            pmx[r][0] = __builtin_nontemporal_load((const v4u*)(MIXO + n_ + 8 * lane)); pmx[r][1] = __builtin_nontemporal_load((const v4u*)(MIXO + n_ + 512 + 8 * lane)); } } while (0)
        LN1_FETCH(g0);
#pragma unroll 1
        for (int blk = norows ? 4 : 0; blk < 4; ++blk) {
            const int grp = g0 + blk * NGW; if (grp >= NGRP) break;
            float xv[4][16];
#pragma unroll
            for (int r = 0; r < 4; ++r) { const size_t n = (size_t)(grp * 4 + r); float m[16]; typedef float f32x2_ __attribute__((ext_vector_type(2)));
                unpack8(pxb[r][0], xv[r]); unpack8(pxb[r][1], xv[r] + 8); unpack8(pmx[r][0], m); unpack8(pmx[r][1], m + 8);
                const unsigned w_[4] = {plo[r][0].x, plo[r][0].y, plo[r][1].x, plo[r][1].y};
#pragma unroll
                for (int i = 0; i < (USE_XLO ? 4 : 0); ++i) { const f32x2_ lo = __builtin_amdgcn_cvt_pk_f32_fp8((int)w_[i], false), hi = __builtin_amdgcn_cvt_pk_f32_fp8((int)w_[i], true);
                    xv[r][4 * i] += lo.x * (1.0f / XLO_SCALE); xv[r][4 * i + 1] += lo.y * (1.0f / XLO_SCALE); xv[r][4 * i + 2] += hi.x * (1.0f / XLO_SCALE); xv[r][4 * i + 3] += hi.y * (1.0f / XLO_SCALE); }
#pragma unroll
                for (int i = 0; i < 16; ++i) xv[r][i] = DN_ALPHA * xv[r][i] + m[i];
                { float gam[16], bet[16];
#pragma unroll
                  for (int q = 0; q < 4; ++q) { const f32x4 g4_ = gbl[q * 64 + lane], b4_ = gbl[(4 + q) * 64 + lane]; gam[4 * q] = g4_.x; gam[4 * q + 1] = g4_.y; gam[4 * q + 2] = g4_.z; gam[4 * q + 3] = g4_.w; bet[4 * q] = b4_.x; bet[4 * q + 1] = b4_.y; bet[4 * q + 2] = b4_.z; bet[4 * q + 3] = b4_.w; }
                  ln_row(xv[r], gam, bet); }
                if (!nostore) { typedef float f32x2q __attribute__((ext_vector_type(2)));
                    const v2u p0 = pack8_fp8(xv[r], XQ_SCALE), p1 = pack8_fp8(xv[r] + 8, XQ_SCALE); __builtin_nontemporal_store(p0, (v2u*)(X1Q + n * DMODEL + 8 * lane)); __builtin_nontemporal_store(p1, (v2u*)(X1Q + n * DMODEL + 512 + 8 * lane));
                    const unsigned pw_[4] = {p0.x, p0.y, p1.x, p1.y}; float rem_[16];
#pragma unroll
                    for (int i = 0; i < 4; ++i) { const f32x2q lo = __builtin_amdgcn_cvt_pk_f32_fp8((int)pw_[i], false), hi = __builtin_amdgcn_cvt_pk_f32_fp8((int)pw_[i], true);
                        rem_[4 * i] = xv[r][4 * i] - lo.x * (1.0f / XQ_SCALE); rem_[4 * i + 1] = xv[r][4 * i + 1] - lo.y * (1.0f / XQ_SCALE); rem_[4 * i + 2] = xv[r][4 * i + 2] - hi.x * (1.0f / XQ_SCALE); rem_[4 * i + 3] = xv[r][4 * i + 3] - hi.y * (1.0f / XQ_SCALE); }
                    if (MK_X1R8) { unsigned char* rr_ = (unsigned char*)X1 + n * DMODEL; __builtin_nontemporal_store(pack8_fp8(rem_, X1R_SCALE), (v2u*)(rr_ + 8 * lane)); __builtin_nontemporal_store(pack8_fp8(rem_ + 8, X1R_SCALE), (v2u*)(rr_ + 512 + 8 * lane)); }
                    else { bf16* rr_ = (bf16*)X1 + n * DMODEL; __builtin_nontemporal_store(pack8(rem_), (v4u*)(rr_ + 8 * lane)); __builtin_nontemporal_store(pack8(rem_ + 8), (v4u*)(rr_ + 512 + 8 * lane)); }   } else if (xv[r][0] == 123.456f) X1[n * DMODEL + lane] = xv[r][1]; }
            if (blk < 3 && g0 + (blk + 1) * NGW < NGRP) LN1_FETCH(g0 + (blk + 1) * NGW);
            typedef float f32x2p __attribute__((ext_vector_type(2)));
            f32x2p xa[16], xb[16];
#pragma unroll
            for (int i = 0; i < 16; ++i) { xa[i] = (f32x2p){xv[0][i], xv[1][i]}; xb[i] = (f32x2p){xv[2][i], xv[3][i]}; }
#pragma unroll 1
            for (int q = norouter ? 4 : 0; q < 4; ++q) {
                float acc[32];
#pragma unroll
                for (int e = 0; e < 8; ++e) { const LAS f32x4* wp = wl + ((q * 8 + e) * 4) * 64 + lane; const f32x4 w0 = wp[0], w1 = wp[64], w2 = wp[128], w3 = wp[192];
                    const float ww[16] = {w0.x, w0.y, w0.z, w0.w, w1.x, w1.y, w1.z, w1.w, w2.x, w2.y, w2.z, w2.w, w3.x, w3.y, w3.z, w3.w};
                    f32x2p a = xa[0] * ww[0], b = xb[0] * ww[0];
#pragma unroll
                    for (int i = 1; i < 16; ++i) { a += xa[i] * ww[i]; b += xb[i] * ww[i]; }
                    acc[0 * 8 + e] = a.x; acc[1 * 8 + e] = a.y; acc[2 * 8 + e] = b.x; acc[3 * 8 + e] = b.y; }
                tr_reduce_step<32>(acc, (lane >> 4) & 1, 16); tr_reduce_step<16>(acc, (lane >> 3) & 1, 8); tr_reduce_step<8>(acc, (lane >> 2) & 1, 4); tr_reduce_step<4>(acc, (lane >> 1) & 1, 2); tr_reduce_step<2>(acc, lane & 1, 1);
                const float tot = acc[0] + __shfl_xor(acc[0], 32);
                if (lane < 32) lg[(blk * 4 + (lane >> 3)) * 32 + q * 8 + (lane & 7)] = tot + br[q * 8 + (lane & 7)];
            }
        }
#undef LN1_FETCH
        LDS_WAIT(); asm volatile("" ::: "memory");
        int te[4] = {0, 0, 0, 0}, tp[4] = {0, 0, 0, 0}; float tg[4] = {0.f, 0.f, 0.f, 0.f};
        if (lane < 16 && (g0 + (lane >> 2) * NGW) < NGRP) {
            float lv[32];
#pragma unroll
            for (int e = 0; e < 32; ++e) lv[e] = lg[lane * 32 + e];
            unsigned taken = 0u; float val[4];
#pragma unroll
            for (int k = 0; k < 4; ++k) { int bi = 0; float bv = -INFINITY;
#pragma unroll
                for (int e = 0; e < 32; ++e) { const bool ok = !((taken >> e) & 1u) && (lv[e] > bv); bv = ok ? lv[e] : bv; bi = ok ? e : bi; }
                te[k] = bi; val[k] = bv; taken |= 1u << bi; }
            float s = 0.f;
#pragma unroll
            for (int k = 0; k < 4; ++k) { tg[k] = expf(val[k] - val[0]); s += tg[k]; }
#pragma unroll
            for (int k = 0; k < 4; ++k) { tg[k] = tg[k] / s; tp[k] = __hip_atomic_fetch_add(lc + te[k], 1, __ATOMIC_RELAXED, __HIP_MEMORY_SCOPE_WORKGROUP); }
        }
        __syncthreads();
        if (tid < 32 && claim) lc[32 + tid] = (int)__hip_atomic_fetch_add(cntg + tid, (unsigned)lc[tid], __ATOMIC_RELAXED, __HIP_MEMORY_SCOPE_AGENT);
        __syncthreads();
        const int mygrp = g0 + (lane >> 2) * NGW;
        if (lane < 16 && claim && mygrp < NGRP) { const int n = mygrp * 4 + (lane & 3);
#pragma unroll
            for (int k = 0; k < 4; ++k) { const int pos = lc[32 + te[k]] + tp[k]; TOKE[n * 4 + k] = te[k]; TOKP[n * 4 + k] = pos; TOKG[n * 4 + k] = tg[k]; ROWTOK[(size_t)te[k] * NTOK + pos] = n; } }
        __syncthreads();
    }
}

__device__ __forceinline__ void moe_tables(const Ctx& C, int l) {
    LAS int* ts = (LAS int*)(C.lds + LDSCTL_OFF); LAS int* cn = (LAS int*)(C.lds + LDSCTL_OFF + 160);
    const unsigned* cntg = (const unsigned*)(C.ws + WS_CTL) + CW_CNT + 64 * l;
    const int tid = ltid();
    if (tid < 64) { const int lane = tid; const int c = (lane < 32) ? (int)__hip_atomic_load(cntg + lane, __ATOMIC_RELAXED, __HIP_MEMORY_SCOPE_AGENT) : 0; int t = (c + 255) >> 8;
        int inc = t;
#pragma unroll
        for (int o = 1; o < 64; o <<= 1) { const int x = __shfl_up(inc, o); if (lane >= o) inc += x; }
        if (lane < 32) { cn[lane] = c; ts[lane] = inc - t; } if (lane == 32) ts[32] = inc; }
    __syncthreads();
}

__device__ __forceinline__ void p_ln2_combine(const Ctx& C, int l) {
    const bf16* X1 = (const bf16*)(C.ws + WS_X1); const unsigned char* X1Q = (const unsigned char*)(C.ws + WS_X1B); const unsigned char* Y = (const unsigned char*)(C.ws + WS_Y);
    const int* TOKE = (const int*)(C.ws + WS_TOKE); const int* TOKP = (const int*)(C.ws + WS_TOKP); const float* TOKG = (const float*)(C.ws + WS_TOKG);
    float* xo = C.out; unsigned char* XLOw = (unsigned char*)(C.ws + WS_XRES); bf16* XB = (bf16*)(C.ws + WS_XB); float* G = (float*)(C.ws + WS_G);
    const LAS int* ts = (const LAS int*)(C.lds + LDSCTL_OFF);
    LAS f32x4* wgl = (LAS f32x4*)(C.lds + RING_OFF);
    const int tid = ltid(), lane = tid & 63, gw = C.vcu * NWAVES + C.wave, NGW = C.G * NWAVES; const bool nextl = (l + 1 < DEPTH);
    if (nextl) load_gate_w(tid, C.in[I_WIN] + (size_t)(l + 1) * DMODEL * INW, wgl);
    __syncthreads();
    float gam[16], bet[16]; load_vec16(C.in[I_LN2G] + l * DMODEL, lane, gam); load_vec16(C.in[I_LN2B] + l * DMODEL, lane, bet);
    typedef int i32x4_ __attribute__((ext_vector_type(4)));
    i32x4_ ne[2], np[2]; f32x4 ng_[2];
#define LN2_ROUTE(n0_) do { _Pragma("unroll") for (int q = 0; q < 2; ++q) { int nn = (n0_) + q * NGW; nn = nn < NTOK ? nn : (NTOK - 1); ne[q] = *(const i32x4_*)(TOKE + nn * 4); np[q] = *(const i32x4_*)(TOKP + nn * 4); ng_[q] = *(const f32x4*)(TOKG + nn * 4); } } while (0)
    LN2_ROUTE(gw);
    for (int n = gw; n < NTOK; n += 2 * NGW) {
        v4u xr[2][2]; v2u xr8[2][2]; v2u xq[2][2]; v2u yr[2][4][2]; f32x4 g4[2]; int nrow[2];
#pragma unroll
        for (int q = 0; q < 2; ++q) { int nn = n + q * NGW; nn = nn < NTOK ? nn : (NTOK - 1); nrow[q] = nn; g4[q] = ng_[q];
            if (MK_X1R8) { const unsigned char* xp = (const unsigned char*)X1 + (size_t)nn * DMODEL; xr8[q][0] = __builtin_nontemporal_load((const v2u*)(xp + 8 * lane)); xr8[q][1] = __builtin_nontemporal_load((const v2u*)(xp + 512 + 8 * lane)); }
            else { const bf16* xp = X1 + (size_t)nn * DMODEL; xr[q][0] = __builtin_nontemporal_load((const v4u*)(xp + 8 * lane)); xr[q][1] = __builtin_nontemporal_load((const v4u*)(xp + 512 + 8 * lane)); }
            const unsigned char* xqp = X1Q + (size_t)nn * DMODEL; xq[q][0] = __builtin_nontemporal_load((const v2u*)(xqp + 8 * lane)); xq[q][1] = __builtin_nontemporal_load((const v2u*)(xqp + 512 + 8 * lane));
#pragma unroll
            for (int k = 0; k < 4; ++k) { const unsigned char* yp = Y + ((size_t)ts[ne[q][k]] * 256 + np[q][k]) * DMODEL; yr[q][k][0] = __builtin_nontemporal_load((const v2u*)(yp + 8 * lane)); yr[q][k][1] = __builtin_nontemporal_load((const v2u*)(yp + 512 + 8 * lane)); } }
        if (n + 2 * NGW < NTOK) LN2_ROUTE(n + 2 * NGW);
#pragma unroll
        for (int q = 0; q < 2; ++q) {
            if (q == 1 && n + NGW >= NTOK) break;
            typedef float f32x2_ __attribute__((ext_vector_type(2)));
            float v[16];
            if (MK_X1R8) { const unsigned w[4] = {xr8[q][0].x, xr8[q][0].y, xr8[q][1].x, xr8[q][1].y};
#pragma unroll
              for (int i = 0; i < 4; ++i) { const f32x2_ lo = __builtin_amdgcn_cvt_pk_f32_fp8((int)w[i], false), hi = __builtin_amdgcn_cvt_pk_f32_fp8((int)w[i], true);
                  v[4 * i] = lo.x * (1.0f / X1R_SCALE); v[4 * i + 1] = lo.y * (1.0f / X1R_SCALE); v[4 * i + 2] = hi.x * (1.0f / X1R_SCALE); v[4 * i + 3] = hi.y * (1.0f / X1R_SCALE); } }
            else { unpack8(xr[q][0], v); unpack8(xr[q][1], v + 8); }
            { const unsigned w[4] = {xq[q][0].x, xq[q][0].y, xq[q][1].x, xq[q][1].y};
#pragma unroll
              for (int i = 0; i < 4; ++i) { const f32x2_ lo = __builtin_amdgcn_cvt_pk_f32_fp8((int)w[i], false), hi = __builtin_amdgcn_cvt_pk_f32_fp8((int)w[i], true);
                  v[4 * i] += lo.x * (1.0f / XQ_SCALE); v[4 * i + 1] += lo.y * (1.0f / XQ_SCALE); v[4 * i + 2] += hi.x * (1.0f / XQ_SCALE); v[4 * i + 3] += hi.y * (1.0f / XQ_SCALE); } }
#pragma unroll
            for (int i = 0; i < 16; ++i) v[i] *= DN_ALPHA;
#pragma unroll
            for (int k = 0; k < 4; ++k) { const float gk = g4[q][k] * (1.0f / YQ_SCALE); const unsigned w[4] = {yr[q][k][0].x, yr[q][k][0].y, yr[q][k][1].x, yr[q][k][1].y};
#pragma unroll
                for (int i = 0; i < 4; ++i) { const f32x2_ lo = __builtin_amdgcn_cvt_pk_f32_fp8((int)w[i], false), hi = __builtin_amdgcn_cvt_pk_f32_fp8((int)w[i], true);
                    v[4 * i] += gk * lo.x; v[4 * i + 1] += gk * lo.y; v[4 * i + 2] += gk * hi.x; v[4 * i + 3] += gk * hi.y; } }
            ln_row(v, gam, bet);
            const int nn = nrow[q];
            if (!nextl) store_row_f32_nt(xo + (size_t)nn * DMODEL, lane, v);
            if (nextl) { store_row_bf16_nt(XB + (size_t)nn * DMODEL, lane, v); { float lo_[16];
#pragma unroll
                for (int i = 0; i < 16; ++i) lo_[i] = v[i] - __uint_as_float(f2bf(v[i]) << 16);
                if (USE_XLO) store_row_fp8(XLOw + (size_t)nn * DMODEL, lane, lo_, XLO_SCALE);
                store_row_fp8_nt((unsigned char*)(C.ws + WS_XQ) + (size_t)nn * DMODEL, lane, v, XQ_SCALE); }
                gates_row(v, wgl, C.in[I_GATEB] + (l + 1) * 8, G + (size_t)nn * 8, lane); }
        }
    }
#undef LN2_ROUTE
    __syncthreads();
}
#ifndef MK_RELMODE
#define MK_RELMODE 0
#endif
__device__ __forceinline__ void xcd_barrier_w(const XcdBarrier& b, const Ctx& C, volatile LAS unsigned* rel, int minitems = 0) {
    asm volatile("s_waitcnt vmcnt(0)" ::: "memory");
    if (threadIdx.x == 0) *rel = 0u;
    __syncthreads();
    if (C.wave == 0) {
        if (threadIdx.x == 0) {
            unsigned* bar = b.bar;
            __builtin_amdgcn_s_waitcnt(0);
            unsigned nloc = b.st[0], nx = b.st[1];
            if (nloc == 0u) { xcd_barrier_complete(bar, b.x, nloc, nx); b.st[0] = nloc; b.st[1] = nx; }
            const unsigned old = xb_add(&bar[XB_XSUB(b.x)], 1u);
            const unsigned gen = old / nloc;
            if (old + 1u == (gen + 1u) * nloc) {
                if (MK_RELMODE == 0) *rel = 1u;
                __builtin_amdgcn_fence(__ATOMIC_RELEASE, "agent");
                asm volatile("s_waitcnt vmcnt(0)" ::: "memory");
                const unsigned og = xb_add(&bar[XB_TOP], 1u);
                const unsigned tg = og / nx;
                if (og + 1u == (tg + 1u) * nx) xb_add(&bar[XB_TOPGEN], 1u);
                else XB_SPIN(xb_ld(&bar[XB_TOPGEN]) == tg, bar);
                *rel = 1u;
                __builtin_amdgcn_fence(__ATOMIC_ACQUIRE, "agent");
                xb_add(&bar[XB_XGEN(b.x)], 1u);
                asm volatile("s_waitcnt vmcnt(0)" ::: "memory");
            } else {
                if (MK_RELMODE == 0) { XB_SPIN(xb_ld(&bar[XB_XSUB(b.x)]) < (gen + 1u) * nloc, bar);
                    *rel = 1u; }
                XB_SPIN(xb_ld(&bar[XB_XGEN(b.x)]) == gen, bar);
                *rel = 1u;
                __builtin_amdgcn_fence(__ATOMIC_ACQUIRE, "agent");
                asm volatile("s_waitcnt vmcnt(0)" ::: "memory");
            }
        }
    } else {
        const int lane = ltid() & 63, total = TRQ_LAYERS * trq_per(C); LAS float* scr = (LAS float*)(C.lds + RING_OFF + (C.wave - 1) * 16896);
        int done = 0;
        while (done < minitems || *rel == 0u) { const int q = trq_grab(C, lane); if (q >= total) break; const int r = trq_item(C, q); if (r >= 0) tr_one(C, r, scr, lane); ++done; }
    }
    __syncthreads();
}

struct Args { const float* in[21]; float* out; unsigned char* ws; int ph_lo, ph_hi, li, pad; };
__global__ void __launch_bounds__(NTHREADS, 2) mega_fwd(Args args) {
    extern __shared__ __attribute__((aligned(16))) unsigned char lds[];
    Ctx C;
    C.lds = (LAS unsigned char*)lds; C.wave = __builtin_amdgcn_readfirstlane(threadIdx.x >> 6);
    C.G = gridDim.x; { const int bx = blockIdx.x; C.vcu = (C.G % 8 == 0) ? (bx % 8) * (C.G / 8) + bx / 8 : bx; }
    C.ws = args.ws; C.in = args.in; C.out = args.out;
    volatile LAS unsigned* MISC = (volatile LAS unsigned*)(C.lds + MISC_OFF);
    for (int u = threadIdx.x; u < (LDSX_OFF - LDSCTL_OFF) / 4; u += NTHREADS) ((LAS unsigned*)(C.lds + LDSCTL_OFF))[u] = 0u;
    __syncthreads();
    unsigned* ctl = (unsigned*)(C.ws + WS_CTL);
    XcdBarrier bar = xcd_barrier_post(ctl + CW_BAR + args.li * XCD_BAR_WORDS, MISC + 8);
    const int lo = args.ph_lo, hi = args.ph_hi;
#define IN(k) (lo <= (k) && (k) < hi)
#ifndef MK_DBL
#define MK_DBL -1
#endif
#define REP(kind) _Pragma("unroll 1") for (int rep_ = 0; rep_ < ((kind) == MK_DBL ? 2 : 1); ++rep_)
#ifdef MK_PROBE_A
    LAS unsigned long long* tacc = (LAS unsigned long long*)(C.lds + LDSX_OFF + 20480);
    if (blockIdx.x == 0 && threadIdx.x == 0) { for (int i = 0; i < 16; ++i) tacc[i] = 0ull; tacc[14] = tacc[15] = wall_clock64(); }
#define stamper (blockIdx.x == 0 && threadIdx.x == 0)
#define STAMP(kind) do { if (stamper) { const unsigned long long now_ = wall_clock64(); tacc[kind] += now_ - tacc[14]; tacc[14] = now_; } } while (0)
#define SEAM(k) do { if (IN(k) && IN((k) + 1)) xcd_barrier(bar); STAMP((k) == 0 ? 0 : 1 + ((k) - 1) % NPH_LAYER); } while (0)
#else
#define STAMP(kind) do { } while (0)
#define SEAM(k) do { if (IN(k) && IN((k) + 1)) { xcd_barrier_w(bar, C, MISC + 10); if (MK_DBL == 12) xcd_barrier(bar); } } while (0)
#define SEAMW(k, n) do { if (IN(k) && IN((k) + 1)) { xcd_barrier_w(bar, C, MISC + 10, (n)); if (MK_DBL == 12) xcd_barrier(bar); } } while (0)
#ifndef MK_TAILITEMS
#define MK_TAILITEMS 3
#endif
#define MOE_IDLE(nN, xs) ((C.G == 256) ? ((((const LAS int*)(C.lds + LDSCTL_OFF))[32] + 8 * (32 / (nN)) - 1) / (8 * (32 / (nN))) - ((((const LAS int*)(C.lds + LDSCTL_OFF))[32] - ((int)blockIdx.x >> 3) / (nN) - ((((int)blockIdx.x & 7) + (xs)) & 7) * (32 / (nN)) + 8 * (32 / (nN)) - 1) / (8 * (32 / (nN))))) : 0)
#ifndef MK_DOWN_XS
#define MK_DOWN_XS 3
#endif
#endif
    if (IN(0)) { REP(0) p_prologue(C); SEAM(0); }
#pragma unroll 1
    for (int l = 0; l < DEPTH; ++l) {
        const int pb = 1 + l * NPH_LAYER;
        bf16* XB = (bf16*)(C.ws + WS_XB); bf16* PROJ = (bf16*)(C.ws + WS_PROJ);
        if (IN(pb + 0)) {
            { pg8::Gemm g{XB, (const bf16*)(C.ws + WS_WIN) + (size_t)l * NPROJ * DMODEL, NTOK, 2048, DMODEL}; pg8::StaticOrder S; S.init(NTOK, 2048, C.G, (int)blockIdx.x);
              pg8::EpiBf16<0> E{PROJ, NPROJ, nullptr, 512, 512, attn_body::C2};
              REP(1) pg8::gemm_phase<pg8::EpiBf16<0>, pg8::StaticOrder, true, true, false>(C.lds + RING_OFF, g, S, E); }
            { pg8::Gemm g{(const bf16*)(C.ws + WS_XQ), (const bf16*)(C.ws + WS_WINQ + (size_t)l * 1536 * DMODEL), NTOK, 1024, DMODEL / 2}; pg8::StaticOrder S; S.init(NTOK, 1024, C.G, (int)blockIdx.x);
              pg8::EpiBf16<0> E{PROJ + 2048, NPROJ, nullptr, 0, 0, 1.0f, 1.0f / (XQ_SCALE * WQ_SCALE)};
              REP(1) pg8::gemm_phase<pg8::EpiBf16<0>, pg8::StaticOrder, true, true, false, true>(C.lds + RING_OFF, g, S, E); }
            SEAM(pb + 0);
        }
        if (IN(pb + 1)) { REP(2) p_mlstm_states_seq(C, l); SEAM(pb + 1); }
        if (IN(pb + 3)) {
            REP(11) p_mlstm_out_seq(C, l); STAMP(11);
            { const int ln_ = ltid() & 63; const float s1 = wave_sum(C.in[I_LQ1][l * 64 + ln_] * C.in[I_LK1][l * 64 + ln_]), s2 = wave_sum(C.in[I_LQ2][l * 64 + ln_] * C.in[I_LK2][l * 64 + ln_]);
              const float lam_init = __uint_as_float(__builtin_amdgcn_readfirstlane(__float_as_uint(0.8f - 0.6f * expf(-0.3f * (float)l)))); const float lam = __uint_as_float(__builtin_amdgcn_readfirstlane(__float_as_uint(expf(s1) - expf(s2) + lam_init)));
              REP(4) for (int vc = C.vcu; vc < 256; vc += C.G) attn_body::attn_phase((char*)lds + RING_OFF, (const attn_body::bf16*)PROJ, (attn_body::bf16*)(C.ws + WS_ATTO), (attn_body::bf16*)(C.ws + WS_MIXIN), C.in[I_NG] + l * 128, lam, 1.0f - lam_init, vc); }
            SEAM(pb + 3);
        }
        if (IN(pb + 5)) {
#if MK_OUTFP8
            pg8::Gemm g{(const bf16*)(C.ws + WS_MIXIN), (const bf16*)(C.ws + WS_WOUT + (size_t)l * DMODEL * DMODEL), NTOK, DMODEL, DMODEL / 2}; pg8::StaticOrder S; S.init(NTOK, DMODEL, C.G, (int)blockIdx.x);
            pg8::EpiBf16<0> E{(bf16*)(C.ws + WS_MIXO), DMODEL, nullptr, 0, 0, 1.0f, 1.0f / (MQ_SCALE * WQ_SCALE)};
            REP(6) pg8::gemm_phase<pg8::EpiBf16<0>, pg8::StaticOrder, true, true, false, true>(C.lds + RING_OFF, g, S, E);
#else
            pg8::Gemm g{(const bf16*)(C.ws + WS_MIXIN), (const bf16*)(C.ws + WS_WOUT) + (size_t)l * DMODEL * DMODEL, NTOK, DMODEL, DMODEL}; pg8::StaticOrder S; S.init(NTOK, DMODEL, C.G, (int)blockIdx.x);
            pg8::EpiBf16<0> E{(bf16*)(C.ws + WS_MIXO), DMODEL, nullptr, 0, 0, 1.0f};
            REP(6) pg8::gemm_phase<pg8::EpiBf16<0>, pg8::StaticOrder, true, true, false>(C.lds + RING_OFF, g, S, E);
#endif
            SEAM(pb + 5);
        }
        if (IN(pb + 6)) { p_ln1_router(C, l); if (MK_DBL == 7) p_ln1_router(C, l, false); if (MK_DBL == 13) p_ln1_router(C, l, false, true); if (MK_DBL == 14) p_ln1_router(C, l, false, true, true); if (MK_DBL == 15) p_ln1_router(C, l, false, true, true, true); if (MK_DBL == 16) p_ln1_router(C, l, false, true, false, false, 1); if (MK_DBL == 17) p_ln1_router(C, l, false, true, false, false, 2); if (l > 0) trq_drain(C, l); SEAM(pb + 6); }
        if (IN(pb + 7)) {
            moe_tables(C, l);
            pg8::Gemm g{(const bf16*)(C.ws + WS_X1B), (const bf16*)(C.ws + WS_WGU + (size_t)l * NEXP * 2 * DFF * DMODEL), 0, 0, DMODEL / 2};
            pg8::MoeOrder S{(const LAS int*)(C.lds + LDSCTL_OFF), (const LAS int*)(C.lds + LDSCTL_OFF + 160), (const int*)(C.ws + WS_ROWTOK), 8, C.G, (int)blockIdx.x, NTOK, (LAS unsigned*)(C.lds + LDSX_OFF)};
            pg8::EpiSwiglu E{(bf16*)(C.ws + WS_H), DFF, C.in[I_BGU] + (size_t)l * NEXP * 2 * DFF, DFF, 1.0f / (XQ_SCALE * WQ_SCALE), HQ_SCALE, 0, (const LAS float*)(C.lds + LDSX_OFF + 16384)};
            REP(8) pg8::gemm_phase<pg8::EpiSwiglu, pg8::MoeOrder, true, true, true, true>(C.lds + RING_OFF, g, S, E);
            if (MK_DBL == 21) pg8::gemm_phase<pg8::EpiSwiglu, pg8::MoeOrder, true, true, true, true>(C.lds + RING_OFF, g, S, E);
            if (MK_DBL == 18 || MK_DBL == 19) { pg8::EpiSwiglu E2 = E; E2.dbg = (MK_DBL == 18) ? 2 : 1; pg8::gemm_phase<pg8::EpiSwiglu, pg8::MoeOrder, true, true, true, true>(C.lds + RING_OFF, g, S, E2); }
            SEAMW(pb + 7, MK_TAILITEMS * MOE_IDLE(8, 0));
        }
        if (IN(pb + 8)) {
            if (!IN(pb + 7)) moe_tables(C, l);
            pg8::Gemm g{(const bf16*)(C.ws + WS_H), (const bf16*)(C.ws + WS_WDN + (size_t)l * NEXP * DMODEL * DFF), 0, 0, DFF / 2};
            pg8::MoeOrder S{(const LAS int*)(C.lds + LDSCTL_OFF), (const LAS int*)(C.lds + LDSCTL_OFF + 160), (const int*)(C.ws + WS_ROWTOK), 4, C.G, (int)blockIdx.x, NTOK, (LAS unsigned*)(C.lds + LDSX_OFF), MK_DOWN_XS};
            pg8::EpiFp8 E{(bf16*)(C.ws + WS_Y), DMODEL, C.in[I_BDN] + (size_t)l * NEXP * DMODEL, DMODEL, 0, 1.0f, 1.0f / (HQ_SCALE * WQ_SCALE), 0, 0u, YQ_SCALE, (const LAS float*)(C.lds + LDSX_OFF + 16384)};
            REP(9) pg8::gemm_phase<pg8::EpiFp8, pg8::MoeOrder, true, true, false, true>(C.lds + RING_OFF, g, S, E);
            if (MK_DBL == 20) { pg8::EpiFp8 E2 = E; E2.dbg = 2; pg8::gemm_phase<pg8::EpiFp8, pg8::MoeOrder, true, true, false, true>(C.lds + RING_OFF, g, S, E2); }
            SEAMW(pb + 8, MK_TAILITEMS * MOE_IDLE(4, MK_DOWN_XS));
        }
        if (IN(pb + 9)) { if (!IN(pb + 7)) moe_tables(C, l); REP(10) p_ln2_combine(C, l); SEAM(pb + 9); }
    }
#ifdef MK_PROBE_A
    xcd_barrier(bar);
    if (stamper) { const unsigned long long now_ = wall_clock64(); tacc[10] += now_ - tacc[14]; const float tot = (float)(now_ - tacc[15]);
        __hip_atomic_store((float*)(ctl + 8), (float)tacc[MK_PROBE_A] / tot, __ATOMIC_RELAXED, __HIP_MEMORY_SCOPE_AGENT); __hip_atomic_store((float*)(ctl + 9), (float)tacc[MK_PROBE_B] / tot, __ATOMIC_RELAXED, __HIP_MEMORY_SCOPE_AGENT); }
    xcd_barrier(bar);
    { const float fa = __hip_atomic_load((float*)(ctl + 8), __ATOMIC_RELAXED, __HIP_MEMORY_SCOPE_AGENT), fb = __hip_atomic_load((float*)(ctl + 9), __ATOMIC_RELAXED, __HIP_MEMORY_SCOPE_AGENT);
        const size_t gid = (size_t)blockIdx.x * NTHREADS + threadIdx.x, nth = (size_t)gridDim.x * NTHREADS;
        for (size_t i = gid; i < (size_t)NTOK * DMODEL; i += nth) { float v = C.out[i] * (1.0f + 4.0f * fa); if (i == 0) v += 1000.0f * fb; C.out[i] = v; } }
#endif
#undef IN
#undef SEAM
}

#ifndef MK_MODE
#define MK_MODE 0
#endif
static int mega_grid() {
    static int grid = 0;
    if (grid == 0) {
        int dev = 0, cus = 0, per_cu = 0;
        if (hipGetDevice(&dev) != hipSuccess || hipDeviceGetAttribute(&cus, hipDeviceAttributeMultiprocessorCount, dev) != hipSuccess) { grid = -1; return grid; }
        if (hipFuncSetAttribute((const void*)mega_fwd, hipFuncAttributeMaxDynamicSharedMemorySize, LDS_BYTES) != hipSuccess) { fprintf(stderr, "kernel_launch: hipFuncSetAttribute failed\n"); grid = -1; return grid; }
        if (hipOccupancyMaxActiveBlocksPerMultiprocessor(&per_cu, (const void*)mega_fwd, NTHREADS, LDS_BYTES) != hipSuccess || per_cu < 1) fprintf(stderr, "kernel_launch: occupancy query reports %d\n", per_cu);
        (void)hipGetLastError();
        grid = cus;
    }
    return grid;
}
static void mega_launch(void* const* d_in, float* d_out, unsigned char* ws, hipStream_t stream, int lo, int hi, int li) {
    const int grid = mega_grid(); if (grid <= 0) return;
    Args a{};
    for (int i = 0; i < 21; ++i) a.in[i] = (const float*)d_in[i];
    a.out = d_out; a.ws = ws; a.ph_lo = lo; a.ph_hi = hi; a.li = li; a.pad = 0;
    hipLaunchKernelGGL(mega_fwd, dim3(grid), dim3(NTHREADS), LDS_BYTES, stream, a);
    const hipError_t le = hipPeekAtLastError();
    if (le != hipSuccess) fprintf(stderr, "kernel_launch: launch failed: %s\n", hipGetErrorName(le));
}
extern "C" void kernel_launch(void* const* d_in, const int* in_sizes, int n_in, void* d_out, int out_size, void* d_ws, size_t ws_size, hipStream_t stream) {
    if (n_in != 21 || in_sizes[0] != NTOK * DMODEL || out_size != NTOK * DMODEL || ws_size < WS_END) { fprintf(stderr, "kernel_launch: unexpected shapes (n_in %d, ws %zu)\n", n_in, ws_size); return; }
    unsigned char* ws = (unsigned char*)d_ws;
    if (hipMemsetAsync(ws + WS_CTL, 0, CTL_ZERO_BYTES, stream) != hipSuccess) { fprintf(stderr, "kernel_launch: memset failed\n"); return; }
#if MK_MODE == 0
    mega_launch(d_in, (float*)d_out, ws, stream, 0, NPHASES, 0);
#else
    for (int ph = 0; ph < NPHASES; ++ph) mega_launch(d_in, (float*)d_out, ws, stream, ph, ph + 1, 0);
#endif
}
```

```cpp
#include <hip/hip_runtime.h>
#include <cstdio>
#include <cstdint>
#include <cmath>
namespace pg8 {
#define PG8_LAS __attribute__((address_space(3)))
#ifndef PG8_STORES_IN_FLIGHT
#define PG8_STORES_IN_FLIGHT 0
#endif
#define PG8_NSTORE(n) (PG8_STORES_IN_FLIGHT ? (n) : 0)
typedef unsigned short bf16_t;
typedef short bf16x8 __attribute__((ext_vector_type(8)));
typedef float f32x4 __attribute__((ext_vector_type(4)));
typedef unsigned u32x4 __attribute__((ext_vector_type(4)));
typedef int i32x4_t __attribute__((ext_vector_type(4)));
typedef int i32x8_t __attribute__((ext_vector_type(8)));
constexpr int BM = 256, BK = 64, HALF = 128, HTB = HALF * BK * 2  , STAGE_BYTES = 8 * HTB, NXCD = 8, WGM = 8;

__host__ __device__ __forceinline__ int lds_byte(int r, int c) { const int st = (r >> 4) * 2 + (c >> 5), rr = r & 15, cc = c & 31, ob = rr * 64 + cc * 2; return st * 1024 + (ob ^ (((ob >> 9) & 1) << 5)); }
__host__ __device__ __forceinline__ void stage_rc(int b, int& R, int& C) { const int st = b / 1024, sb = b % 1024, swz = sb ^ (((sb >> 9) & 1) << 5); R = (st >> 1) * 16 + swz / 64; C = (st & 1) * 32 + (swz % 64) / 2; }
__host__ __device__ __forceinline__ int perm32(int rho) { const int n = rho >> 4, i = rho & 15; return 8 * (i >> 2) + 4 * n + (i & 3); }

struct Unit { int pm, pn, e, pnl, nvalid, rbase; };

struct Gemm { const bf16_t* A; const bf16_t* Bt; int M, N, K; };

struct StaticOrder {
    int nM, nN, nwg, G, c; PG8_LAS unsigned* gtab = nullptr;
    __host__ __device__ void init(int M, int N, int G_, int c_) { nM = M / BM; nN = N / BM; nwg = nM * nN; G = G_; c = c_; }
    __host__ __device__ bool next(int i, Unit& u) const {
        const long L = (long)i * G + c; if (L >= nwg) return false;
        int wgid = (int)L; { const int q = nwg / NXCD, r = nwg % NXCD, xcd = wgid % NXCD, off = wgid / NXCD; wgid = (xcd < r ? xcd * (q + 1) : r * (q + 1) + (xcd - r) * q) + off; }
        const int nig = WGM * nN, gid = wgid / nig, fm = gid * WGM, gsz = (nM - fm) < WGM ? (nM - fm) : WGM;
        u.pm = fm + ((wgid % nig) % gsz); u.pn = (wgid % nig) / gsz; u.e = 0; u.pnl = u.pn; u.nvalid = BM; u.rbase = 0; return true;
    }
    __device__ __forceinline__ int arow(const Unit&, int) const { return 0; }
    __device__ __forceinline__ void a_ready(const Unit&) const {}
    __device__ __forceinline__ void done(const Unit&) const {}
};

__device__ __forceinline__ unsigned cvt_pk_bf16(float lo, float hi) { unsigned r; asm volatile("v_cvt_pk_bf16_f32 %0, %1, %2" : "=v"(r) : "v"(lo), "v"(hi)); return r; }
typedef float f32x2 __attribute__((ext_vector_type(2)));
__device__ __forceinline__ f32x2 gelu_pk(f32x2 v) {
    const f32x2 av = __builtin_elementwise_abs(v), d = av * 0.2316418882f + 1.0f;
    f32x2 t; t.x = __builtin_amdgcn_rcpf(d.x); t.y = __builtin_amdgcn_rcpf(d.y);
    f32x2 q = t * 0.5307027145f + (-0.7265760135f); q = q * t + 0.7107068705f; q = q * t + (-0.142248368f); q = q * t + 0.127414796f; q = q * t;
    const f32x2 s = (v * v) * (-0.72134752044f);
    f32x2 e; e.x = __builtin_amdgcn_exp2f(s.x); e.y = __builtin_amdgcn_exp2f(s.y);
    const f32x2 m = v * (q * e), r = v - m;
    f32x2 o; o.x = v.x < 0.f ? m.x : r.x; o.y = v.y < 0.f ? m.y : r.y; return o;
}

template <int ACT  > struct EpiBf16 {
    static constexpr int PERM = 1; static constexpr bool AFTER_DRAIN = false; static_assert(ACT == 0 || ACT == 1, "EpiBf16: ACT is 0 (none) or 1 (gelu_pk)");
    static constexpr int NSTORE = PG8_NSTORE(16); static constexpr bool LDSBIAS = false;
    bf16_t* O; int ldc; const float* bias; int split_cols; size_t split_stride; float scale0;
    float ascale = 1.0f;
    int dbg = 0;
    unsigned cmap = 0u;
    float oscale = 0.0f;
    __device__ __forceinline__ void operator()(const f32x4 (&acc)[2][2][4][2], const Unit& u, int wr, int wc, int fr, int fq) const {
        if (dbg == 2) return;
        const int row0 = u.pm * BM + wr * 64 + fr; int colt = (cmap ? (int)((cmap >> (4 * u.pn)) & 15u) : u.pn) * BM; bf16_t* base = O;
        float sc = 1.f; if (split_cols) { const int t = colt / split_cols; base += (size_t)t * split_stride; colt -= t * split_cols; if (t == 0) sc = scale0; }
        const int col0 = colt + wc * 32 + 8 * fq, bcol0 = u.pn * BM + wc * 32 + 8 * fq;
        f32x4 bv[2][2];
#pragma unroll
        for (int bj = 0; bj < 2; ++bj)
#pragma unroll
            for (int n = 0; n < 2; ++n) bv[bj][n] = bias ? *(const f32x4*)(bias + bcol0 + bj * HALF + 4 * n) : (f32x4){0.f, 0.f, 0.f, 0.f};
#pragma unroll
        for (int ai = 0; ai < 2; ++ai)
#pragma unroll
            for (int m = 0; m < 4; ++m) { bf16_t* rowp = base + (size_t)(row0 + ai * HALF + m * 16) * ldc + col0;
#pragma unroll
                for (int bj = 0; bj < 2; ++bj) {
                    if (ACT == 0 && oscale > 0.f) {
                        const float kq = ascale * oscale; f32x4 a, b;
#pragma unroll
                        for (int i = 0; i < 4; ++i) { a[i] = __builtin_amdgcn_fmed3f(__builtin_fmaf(acc[ai][bj][m][0][i], kq, bv[bj][0][i] * oscale), -448.f, 448.f); b[i] = __builtin_amdgcn_fmed3f(__builtin_fmaf(acc[ai][bj][m][1][i], kq, bv[bj][1][i] * oscale), -448.f, 448.f); }
                        int p = 0, q = 0; p = __builtin_amdgcn_cvt_pk_fp8_f32(a[0], a[1], p, false); p = __builtin_amdgcn_cvt_pk_fp8_f32(a[2], a[3], p, true); q = __builtin_amdgcn_cvt_pk_fp8_f32(b[0], b[1], q, false); q = __builtin_amdgcn_cvt_pk_fp8_f32(b[2], b[3], q, true);
                        typedef int i32x2_f __attribute__((ext_vector_type(2))); *(i32x2_f*)((unsigned char*)base + (size_t)(row0 + ai * HALF + m * 16) * ldc + col0 + bj * HALF) = (i32x2_f){p, q}; continue; }
                    f32x4 v0 = acc[ai][bj][m][0] * ascale + bv[bj][0], v1 = acc[ai][bj][m][1] * ascale + bv[bj][1];
                    if (ACT == 1) { f32x2 a = gelu_pk((f32x2){v0[0], v0[1]}), b = gelu_pk((f32x2){v0[2], v0[3]}), c = gelu_pk((f32x2){v1[0], v1[1]}), d = gelu_pk((f32x2){v1[2], v1[3]});
                        v0 = (f32x4){a.x, a.y, b.x, b.y}; v1 = (f32x4){c.x, c.y, d.x, d.y}; }
                    v0 = v0 * sc; v1 = v1 * sc;
                    if (oscale > 0.f) { f32x4 a = v0 * oscale, b = v1 * oscale;
#pragma unroll
                        for (int i = 0; i < 4; ++i) { a[i] = __builtin_fminf(__builtin_fmaxf(a[i], -448.f), 448.f); b[i] = __builtin_fminf(__builtin_fmaxf(b[i], -448.f), 448.f); }
                        int p = 0, q = 0; p = __builtin_amdgcn_cvt_pk_fp8_f32(a[0], a[1], p, false); p = __builtin_amdgcn_cvt_pk_fp8_f32(a[2], a[3], p, true); q = __builtin_amdgcn_cvt_pk_fp8_f32(b[0], b[1], q, false); q = __builtin_amdgcn_cvt_pk_fp8_f32(b[2], b[3], q, true);
                        typedef int i32x2_t __attribute__((ext_vector_type(2))); *(i32x2_t*)((unsigned char*)base + (size_t)(row0 + ai * HALF + m * 16) * ldc + col0 + bj * HALF) = (i32x2_t){p, q}; }
                    else { u32x4 w; w.x = cvt_pk_bf16(v0[0], v0[1]); w.y = cvt_pk_bf16(v0[2], v0[3]); w.z = cvt_pk_bf16(v1[0], v1[1]); w.w = cvt_pk_bf16(v1[2], v1[3]);
                        *(u32x4*)(rowp + bj * HALF) = w; } } }
    }
};

struct EpiFp8 { static constexpr int ACT = 0;
    static constexpr int PERM = 2; static constexpr bool AFTER_DRAIN = false; static constexpr int NSTORE = PG8_NSTORE(8); static constexpr bool LDSBIAS = true;
    __device__ __forceinline__ const float* bias_src(const Unit& u, int wc, int lane) const { return bias + u.pn * BM + wc * 64 + lane; }
    bf16_t* O; int ldc; const float* bias; int split_cols; size_t split_stride; float scale0;
    float ascale = 1.0f;
    int dbg = 0;
    unsigned cmap = 0u;
    float oscale = 0.0f;
    PG8_LAS const float* lbias = nullptr;
    __device__ __forceinline__ void operator()(const f32x4 (&acc)[2][2][4][2], const Unit& u, int wr, int wc, int fr, int fq) const {
        if (dbg == 2) return;
        const int row0 = u.pm * BM + wr * 64 + fr; int colt = (cmap ? (int)((cmap >> (4 * u.pn)) & 15u) : u.pn) * BM; bf16_t* base = O;
        float sc = 1.f; if (split_cols) { const int t = colt / split_cols; base += (size_t)t * split_stride; colt -= t * split_cols; if (t == 0) sc = scale0; }
        const int col0 = colt + wc * 64 + 16 * fq, bcol0 = u.pn * BM + wc * 64 + 16 * fq;
        f32x4 bv[2][2];
#pragma unroll
        for (int bj = 0; bj < 2; ++bj)
#pragma unroll
            for (int n = 0; n < 2; ++n) bv[bj][n] = lbias ? *(const PG8_LAS f32x4*)(lbias + (wr * 4 + wc) * 64 + 16 * fq + 8 * bj + 4 * n) : (bias ? *(const f32x4*)(bias + bcol0 + 8 * bj + 4 * n) : (f32x4){0.f, 0.f, 0.f, 0.f});
#pragma unroll
        for (int ai = 0; ai < 2; ++ai)
#pragma unroll
            for (int m = 0; m < 4; ++m) { const size_t rowoff = (size_t)(row0 + ai * HALF + m * 16) * ldc + col0;
                if (ACT == 0 && oscale > 0.f) {
                    const float kq = ascale * oscale; int w4[4];
#pragma unroll
                    for (int bj = 0; bj < 2; ++bj)
#pragma unroll
                        for (int n = 0; n < 2; ++n) { float a[4];
#pragma unroll
                            for (int p = 0; p < 2; ++p) { const f32x2 t2 = (f32x2){acc[ai][bj][m][n][2 * p], acc[ai][bj][m][n][2 * p + 1]} * kq + (f32x2){bv[bj][n][2 * p], bv[bj][n][2 * p + 1]} * oscale;
                                a[2 * p] = __builtin_amdgcn_fmed3f(t2.x, -448.f, 448.f); a[2 * p + 1] = __builtin_amdgcn_fmed3f(t2.y, -448.f, 448.f); }
                            int p = 0; p = __builtin_amdgcn_cvt_pk_fp8_f32(a[0], a[1], p, false); p = __builtin_amdgcn_cvt_pk_fp8_f32(a[2], a[3], p, true); w4[2 * bj + n] = p; }
                    *(u32x4*)((unsigned char*)base + rowoff) = (u32x4){(unsigned)w4[0], (unsigned)w4[1], (unsigned)w4[2], (unsigned)w4[3]}; continue; }
                u32x4 wo[2];
#pragma unroll
                for (int bj = 0; bj < 2; ++bj) { f32x4 v0 = acc[ai][bj][m][0] * ascale + bv[bj][0], v1 = acc[ai][bj][m][1] * ascale + bv[bj][1];
                    if (ACT == 1) { f32x2 a = gelu_pk((f32x2){v0[0], v0[1]}), b = gelu_pk((f32x2){v0[2], v0[3]}), c = gelu_pk((f32x2){v1[0], v1[1]}), d = gelu_pk((f32x2){v1[2], v1[3]});
                        v0 = (f32x4){a.x, a.y, b.x, b.y}; v1 = (f32x4){c.x, c.y, d.x, d.y}; }
                    v0 = v0 * sc; v1 = v1 * sc;
                    wo[bj].x = cvt_pk_bf16(v0[0], v0[1]); wo[bj].y = cvt_pk_bf16(v0[2], v0[3]); wo[bj].z = cvt_pk_bf16(v1[0], v1[1]); wo[bj].w = cvt_pk_bf16(v1[2], v1[3]); }
                bf16_t* rowp = base + rowoff; *(u32x4*)rowp = wo[0]; *(u32x4*)(rowp + 8) = wo[1]; }
    }
};

struct EpiSwiglu {
    static constexpr int PERM = 1; static constexpr bool AFTER_DRAIN = false; static constexpr int NSTORE = PG8_NSTORE(8); static constexpr bool LDSBIAS = true;
    bf16_t* H; int ldc; const float* bias; int dff; float ascale; float hscale; int dbg = 0;
    PG8_LAS const float* lbias = nullptr;
    __device__ __forceinline__ const float* bias_src(const Unit& u, int wc, int lane) const { return bias + (size_t)u.e * 2 * dff + u.pnl * HALF + wc * 32 + (lane & 31) + ((lane & 32) ? dff : 0); }
    __device__ __forceinline__ void operator()(const f32x4 (&acc)[2][2][4][2], const Unit& u, int wr, int wc, int fr, int fq) const {
        if (dbg == 2) return;
        const int row0 = u.pm * BM + wr * 64 + fr, hc = u.pnl * HALF + wc * 32 + 8 * fq;
        const float* bg = bias + (size_t)u.e * 2 * dff + hc; const float* bu = bg + dff;
        const float hk = hscale > 0.f ? hscale : 1.0f;
        f32x4 bgv[2], buv[2];
#pragma unroll
        for (int n = 0; n < 2; ++n) { if (lbias) { const PG8_LAS float* lb = lbias + (wr * 4 + wc) * 64 + 8 * fq + 4 * n; bgv[n] = *(const PG8_LAS f32x4*)lb; buv[n] = *(const PG8_LAS f32x4*)(lb + 32); }
            else { bgv[n] = *(const f32x4*)(bg + 4 * n); buv[n] = *(const f32x4*)(bu + 4 * n); } }
#pragma unroll
        for (int ai = 0; ai < 2; ++ai)
#pragma unroll
            for (int m = 0; m < 4; ++m) { bf16_t* rowp = H + (size_t)(row0 + ai * HALF + m * 16) * ldc + hc; float o[8];
#pragma unroll
                for (int n = 0; n < 2; ++n)
#pragma unroll
                    for (int p = 0; p < 2; ++p) {
                        const f32x2 g2 = (f32x2){acc[ai][0][m][n][2 * p], acc[ai][0][m][n][2 * p + 1]} * ascale + (f32x2){bgv[n][2 * p], bgv[n][2 * p + 1]};
                        const f32x2 u2 = (f32x2){acc[ai][1][m][n][2 * p], acc[ai][1][m][n][2 * p + 1]} * ascale + (f32x2){buv[n][2 * p], buv[n][2 * p + 1]};
                        f32x2 gt, up; gt.x = __builtin_fminf(g2.x, 7.0f); gt.y = __builtin_fminf(g2.y, 7.0f); up.x = __builtin_amdgcn_fmed3f(u2.x, -7.0f, 7.0f); up.y = __builtin_amdgcn_fmed3f(u2.y, -7.0f, 7.0f);
                        const f32x2 ee = gt * (-1.702f * 1.4426950408889634f);
                        f32x2 den; den.x = __builtin_amdgcn_exp2f(ee.x); den.y = __builtin_amdgcn_exp2f(ee.y); den = den + 1.0f;
                        f32x2 sg; sg.x = __builtin_amdgcn_rcpf(den.x); sg.y = __builtin_amdgcn_rcpf(den.y);
                        const f32x2 r2 = (up * hk + hk) * (gt * sg);
                        o[4 * n + 2 * p] = r2.x; o[4 * n + 2 * p + 1] = r2.y; }
                if (dbg == 1) { if (o[0] == 123.4567f && o[5] == 7.654f) rowp[0] = 1; continue; }
                if (hscale > 0.f) { int a = 0, b = 0; a = __builtin_amdgcn_cvt_pk_fp8_f32(o[0], o[1], a, false); a = __builtin_amdgcn_cvt_pk_fp8_f32(o[2], o[3], a, true);
                    b = __builtin_amdgcn_cvt_pk_fp8_f32(o[4], o[5], b, false); b = __builtin_amdgcn_cvt_pk_fp8_f32(o[6], o[7], b, true);
                    typedef int i32x2_t __attribute__((ext_vector_type(2))); *(i32x2_t*)((unsigned char*)H + (size_t)(row0 + ai * HALF + m * 16) * ldc + hc) = (i32x2_t){a, b}; }
                else { u32x4 w; w.x = cvt_pk_bf16(o[0], o[1]); w.y = cvt_pk_bf16(o[2], o[3]); w.z = cvt_pk_bf16(o[4], o[5]); w.w = cvt_pk_bf16(o[6], o[7]);
                    *(u32x4*)rowp = w; } }
    }
};
struct MoeOrder {
    const PG8_LAS int* tstart; const PG8_LAS int* cnt; const int* rowtok; int nN, G, c, ntok; PG8_LAS unsigned* gtab;
    int xs = 0;
    __device__ __forceinline__ bool next(int i, Unit& u) const {
        int rt, pnl;
        if (G == 256) { const int x = ((c & 7) + xs) & 7, j = c >> 3, per = 32 / nN; rt = (i * 8 + x) * per + j / nN; pnl = j % nN; }
        else { const int L = i * G + c; rt = L / nN; pnl = L % nN; }
        const int TR = tstart[32]; if (rt >= TR) return false;
        const int ln_ = (int)__builtin_amdgcn_mbcnt_hi(~0u, __builtin_amdgcn_mbcnt_lo(~0u, 0u));
        const int tv_ = tstart[(ln_ & 31) + 1];
        const unsigned long long bal_ = __ballot((ln_ < 31) && (tv_ <= rt));
        int e = __builtin_amdgcn_readfirstlane((int)__popcll(bal_));
        const int lt = rt - tstart[e]; int nv = cnt[e] - lt * BM; nv = nv > BM ? BM : nv;
        u.pm = rt; u.pn = e * nN + pnl; u.e = e; u.pnl = pnl; u.nvalid = __builtin_amdgcn_readfirstlane(nv); u.rbase = __builtin_amdgcn_readfirstlane(e * ntok + lt * BM); return true;
    }
    __device__ __forceinline__ int arow(const Unit& u, int r) const { return rowtok[u.rbase + ((r < u.nvalid) ? r : 0)]; }
    __device__ __forceinline__ const int* aptr(const Unit& u, int r) const { return rowtok + u.rbase + ((r < u.nvalid) ? r : 0); }
    __device__ __forceinline__ void a_ready(const Unit&) const {}
    __device__ __forceinline__ void done(const Unit&) const {}
};

struct PanelStats {
    unsigned* xbuf;
    unsigned* cnt;
    unsigned* tmo;
    int ntn; float eps;
    unsigned code;
    __device__ __forceinline__ bool run(const f32x4 (&v)[2][2][4][2], const Unit& u, int wr, int wc, int fr, int fq, PG8_LAS unsigned char* lds, int wid, int lane) const {
        typedef float f32x2v __attribute__((ext_vector_type(2)));
        PG8_LAS f32x2v* P = (PG8_LAS f32x2v*)lds;
        PG8_LAS f32x2v* S = (PG8_LAS f32x2v*)(lds + 8192);
        PG8_LAS unsigned* flag = (PG8_LAS unsigned*)(lds + 8192 + 2048);
#pragma unroll
        for (int ai = 0; ai < 2; ++ai)
#pragma unroll
            for (int m = 0; m < 4; ++m) {
                float s = 0.f;
#pragma unroll
                for (int bj = 0; bj < 2; ++bj)
#pragma unroll
                    for (int n = 0; n < 2; ++n) { const f32x4 x = v[ai][bj][m][n]; s += (x[0] + x[1]) + (x[2] + x[3]); }
                s += __shfl_xor(s, 16); s += __shfl_xor(s, 32);
                const float mw = s * (1.0f / 64.0f); float q = 0.f;
#pragma unroll
                for (int bj = 0; bj < 2; ++bj)
#pragma unroll
                    for (int n = 0; n < 2; ++n) { const f32x4 d = v[ai][bj][m][n] - mw; q += (d[0] * d[0] + d[1] * d[1]) + (d[2] * d[2] + d[3] * d[3]); }
                q += __shfl_xor(q, 16); q += __shfl_xor(q, 32);
                if (fq == 0) P[(ai * HALF + wr * 64 + m * 16 + fr) * 4 + wc] = (f32x2v){mw, q};
            }
        asm volatile("s_waitcnt lgkmcnt(0)" ::: "memory"); __builtin_amdgcn_s_barrier(); asm volatile("" ::: "memory");
#if defined(BROKEN_EXCHANGE_NO_WAIT)
#warning BROKEN CONTROL BUILD: the row-statistics exchange does not wait; results are wrong by design
        if (blockIdx.x >= 64) { const long long t0_ = clock64(); while (clock64() - t0_ < 60000) __builtin_amdgcn_s_sleep(8); }
#endif
        const int row = wid * 32 + (lane & 31);
        if (lane < 32) {
            const f32x2v a = P[row * 4 + 0], b = P[row * 4 + 1], c = P[row * 4 + 2], d = P[row * 4 + 3];
            const float mt = (a.x + b.x + c.x + d.x) * 0.25f;
            const float da = a.x - mt, db = b.x - mt, dc = c.x - mt, dd = d.x - mt;
            const float m2 = (a.y + b.y) + (c.y + d.y) + 64.0f * ((da * da + db * db) + (dc * dc + dd * dd));
            unsigned long long* slot = (unsigned long long*)xbuf + ((size_t)(u.pm * BM + row) * 4 + u.pn);
            __hip_atomic_store(slot, ((unsigned long long)__float_as_uint(m2) << 32) | __float_as_uint(mt), __ATOMIC_RELAXED, __HIP_MEMORY_SCOPE_AGENT);
        }
        asm volatile("s_waitcnt vmcnt(0)" ::: "memory");
        if (lane == 0) __hip_atomic_fetch_add(cnt + 64 * u.pm, 1u, __ATOMIC_RELAXED, __HIP_MEMORY_SCOPE_AGENT);
        if (wid == 0) {
            bool dead = false; const unsigned long long t0 = __builtin_amdgcn_s_memrealtime(); const unsigned want = 8u * (unsigned)ntn;
            for (;;) {
#if defined(BROKEN_EXCHANGE_NO_WAIT)
                break;
#endif
                if ((unsigned)__builtin_amdgcn_readfirstlane(__hip_atomic_load(cnt + 64 * u.pm, __ATOMIC_RELAXED, __HIP_MEMORY_SCOPE_AGENT)) >= want) break;
                if (__builtin_amdgcn_s_memrealtime() - t0 > 2000000ull) {
                    if (lane == 0) { unsigned expect = 0u; __hip_atomic_compare_exchange_strong(tmo + 1, &expect, code | (unsigned)(u.pm & 0xff), __ATOMIC_RELAXED, __ATOMIC_RELAXED, __HIP_MEMORY_SCOPE_AGENT);
                                     __hip_atomic_store(tmo, 1u, __ATOMIC_RELAXED, __HIP_MEMORY_SCOPE_AGENT); }
                    dead = true; break; }
                __builtin_amdgcn_s_sleep(2);
            }
            __builtin_amdgcn_fence(__ATOMIC_ACQUIRE, "agent");
            if (lane == 0) flag[0] = dead ? 1u : 0u;
        }
        asm volatile("s_waitcnt vmcnt(0) lgkmcnt(0)" ::: "memory"); __builtin_amdgcn_s_barrier(); asm volatile("" ::: "memory");
        const bool bad = flag[0] != 0u;
        if (lane < 32) {
            const unsigned long long* slot = (const unsigned long long*)xbuf + (size_t)(u.pm * BM + row) * 4; float mt[4], m2[4]; float ms = 0.f;
#pragma unroll
            for (int t = 0; t < 4; ++t) { if (t < ntn) { const unsigned long long w = __hip_atomic_load(slot + t, __ATOMIC_RELAXED, __HIP_MEMORY_SCOPE_AGENT); mt[t] = __uint_as_float((unsigned)w); m2[t] = __uint_as_float((unsigned)(w >> 32)); } else { mt[t] = 0.f; m2[t] = 0.f; } ms += mt[t]; }
            const float mean = ms / (float)ntn; float q = 0.f;
#pragma unroll
            for (int t = 0; t < 4; ++t) if (t < ntn) { const float dm = mt[t] - mean; q += m2[t] + 256.0f * dm * dm; }
            S[row] = (f32x2v){mean, 1.0f / sqrtf(q / (256.0f * (float)ntn) + eps)};
        }
        asm volatile("s_waitcnt lgkmcnt(0)" ::: "memory"); __builtin_amdgcn_s_barrier(); asm volatile("" ::: "memory");
        return bad;
    }
};
struct EpiLnRes {
    static constexpr int PERM = 0; static constexpr bool AFTER_DRAIN = true; static constexpr int NSTORE = 0; static constexpr bool LDSBIAS = false;
    const float* base; float* out; int ldc; const float* bias; PanelStats st; unsigned poison;
    __device__ __forceinline__ void fused(f32x4 (&acc)[2][2][4][2], const Unit& u, int wr, int wc, int fr, int fq, PG8_LAS unsigned char* lds, int wid, int lane) const {
        typedef float f32x2v __attribute__((ext_vector_type(2)));
        const PG8_LAS f32x2v* S = (const PG8_LAS f32x2v*)(lds + 8192);
        const int col0 = u.pn * BM + wc * 32 + 4 * fq;
#pragma unroll
        for (int bj = 0; bj < 2; ++bj)
#pragma unroll
            for (int n = 0; n < 2; ++n) { const f32x4 bv = bias ? *(const f32x4*)(bias + col0 + bj * HALF + n * 16) : (f32x4){0.f, 0.f, 0.f, 0.f};
#pragma unroll
                for (int ai = 0; ai < 2; ++ai)
#pragma unroll
                    for (int m = 0; m < 4; ++m) acc[ai][bj][m][n] += bv; }
        f32x4 pre[4][2][2];
#pragma unroll
        for (int m = 0; m < 4; ++m) { const size_t off = (size_t)(u.pm * BM + wr * 64 + m * 16 + fr) * ldc + col0;
#pragma unroll
            for (int bj = 0; bj < 2; ++bj)
#pragma unroll
                for (int n = 0; n < 2; ++n) pre[m][bj][n] = *(const f32x4*)(base + off + bj * HALF + n * 16); }
        const bool bad = st.run(acc, u, wr, wc, fr, fq, lds, wid, lane) || poison != 0u;
        const float qnan = __builtin_nanf("");
#pragma unroll
        for (int ai = 0; ai < 2; ++ai)
#pragma unroll
            for (int m = 0; m < 4; ++m) { const int r = ai * HALF + wr * 64 + m * 16 + fr; const f32x2v sr = S[r]; const size_t off = (size_t)(u.pm * BM + r) * ldc + col0;
#pragma unroll
                for (int bj = 0; bj < 2; ++bj)
#pragma unroll
                    for (int n = 0; n < 2; ++n) { const f32x4 bs = ai == 0 ? pre[m][bj][n] : *(const f32x4*)(base + off + bj * HALF + n * 16); f32x4 o = bs + (acc[ai][bj][m][n] - sr.x) * sr.y;
                        if (bad) o = (f32x4){qnan, qnan, qnan, qnan}; *(f32x4*)(out + off + bj * HALF + n * 16) = o; }
                if (m & 1) asm volatile("" ::: "memory"); }
    }
};
struct EpiLnResLn {
    static constexpr int PERM = 0; static constexpr bool AFTER_DRAIN = true; static constexpr int NSTORE = 0; static constexpr bool LDSBIAS = false;
    const float* base; float* out; bf16_t* xn; int ldc; const float* bias; PanelStats st1, st2; unsigned poison;
    __device__ __forceinline__ void fused(f32x4 (&acc)[2][2][4][2], const Unit& u, int wr, int wc, int fr, int fq, PG8_LAS unsigned char* lds, int wid, int lane) const {
        typedef float f32x2v __attribute__((ext_vector_type(2))); typedef unsigned u32x2v __attribute__((ext_vector_type(2)));
        const PG8_LAS f32x2v* S = (const PG8_LAS f32x2v*)(lds + 8192);
        const int col0 = u.pn * BM + wc * 32 + 4 * fq;
#pragma unroll
        for (int bj = 0; bj < 2; ++bj)
#pragma unroll
            for (int n = 0; n < 2; ++n) { const f32x4 bv = bias ? *(const f32x4*)(bias + col0 + bj * HALF + n * 16) : (f32x4){0.f, 0.f, 0.f, 0.f};
#pragma unroll
                for (int ai = 0; ai < 2; ++ai)
#pragma unroll
                    for (int m = 0; m < 4; ++m) acc[ai][bj][m][n] += bv; }
        bool bad = st1.run(acc, u, wr, wc, fr, fq, lds, wid, lane) || poison != 0u;
        const float qnan = __builtin_nanf("");
#pragma unroll
        for (int ai = 0; ai < 2; ++ai)
#pragma unroll
            for (int m = 0; m < 4; ++m) { const int r = ai * HALF + wr * 64 + m * 16 + fr; const f32x2v sr = S[r]; const size_t off = (size_t)(u.pm * BM + r) * ldc + col0;
#pragma unroll
                for (int bj = 0; bj < 2; ++bj)
#pragma unroll
                    for (int n = 0; n < 2; ++n) { const f32x4 bs = *(const f32x4*)(base + off + bj * HALF + n * 16); acc[ai][bj][m][n] = bs + (acc[ai][bj][m][n] - sr.x) * sr.y; }
                asm volatile("" : "+v"(acc[ai][0][m][0]), "+v"(acc[ai][0][m][1]), "+v"(acc[ai][1][m][0]), "+v"(acc[ai][1][m][1]));
                if (m & 1) asm volatile("" ::: "memory"); }
        const bool bad1 = bad;
        bad = st2.run(acc, u, wr, wc, fr, fq, lds, wid, lane) || bad;
#pragma unroll
        for (int ai = 0; ai < 2; ++ai)
#pragma unroll
            for (int m = 0; m < 4; ++m) { const int r = ai * HALF + wr * 64 + m * 16 + fr; const f32x2v sr = S[r]; const size_t off = (size_t)(u.pm * BM + r) * ldc + col0;
#pragma unroll
                for (int bj = 0; bj < 2; ++bj)
#pragma unroll
                    for (int n = 0; n < 2; ++n) { const f32x4 x1 = acc[ai][bj][m][n]; *(f32x4*)(out + off + bj * HALF + n * 16) = bad1 ? (f32x4){qnan, qnan, qnan, qnan} : x1;
                        const f32x4 o = (x1 - sr.x) * sr.y; u32x2v w; w.x = cvt_pk_bf16(o[0], o[1]); w.y = cvt_pk_bf16(o[2], o[3]);
                        if (bad) { w.x = 0x7fc07fc0u; w.y = 0x7fc07fc0u; } *(u32x2v*)(xn + off + bj * HALF + n * 16) = w; }
                asm volatile("" ::: "memory"); }
    }
};

template <class Epi, class Sched, bool ALIGN_EPI = false, bool SP2 = false, bool GATHER = false, bool FP8 = false>
__device__ __forceinline__ void gemm_phase(PG8_LAS unsigned char* lds, const Gemm g, const Sched& S, const Epi& E) {
    static_assert(!GATHER || SP2, "the gathered-A variant is written for the SP2 loop only");
    int tid_ = threadIdx.x; asm volatile("" : "+v"(tid_));
    const int tid = tid_, wid = __builtin_amdgcn_readfirstlane(tid >> 6), lane = tid & 63, wr = wid >> 2, wc = wid & 3, fr = lane & 15, fq = lane >> 4;
    const int K = g.K, nt = K / BK;
    unsigned voffA[2], voffB[2], voffB2[2][2];
#pragma unroll
    for (int i = 0; i < 2; ++i) { int R, C; stage_rc(tid * 16 + i * 8192, R, C); const int Rb = (Epi::PERM == 1) ? ((R & ~31) + perm32(R & 31)) : R;
        voffA[i] = (unsigned)(R * K + C) * 2u; voffB[i] = (unsigned)(Rb * K + C) * 2u;
        { const int rho = R & 31, n_ = rho >> 4, fq_ = (rho & 15) >> 2, i_ = rho & 3; const int r2 = (Epi::PERM == 3) ? (64 * (R >> 5) + 8 * fq_ + 4 * n_ + i_) : (64 * (R >> 5) + 16 * fq_ + 4 * n_ + i_), hs = (Epi::PERM == 3) ? 32 : 8;
          voffB2[0][i] = (unsigned)(r2 * K + C) * 2u; voffB2[1][i] = (unsigned)((r2 + hs) * K + C) * 2u; } }
#define PG8_GOFF(slot, u) do { int tq_ = threadIdx.x; asm volatile("" : "+v"(tq_)); int gR[2], gC[2]; stage_rc(tq_ * 16, gR[0], gC[0]); stage_rc(tq_ * 16 + 8192, gR[1], gC[1]);     \
        PG8_LAS unsigned* gt_ = S.gtab + (slot) * 2048 + wid * 64;     \
        __builtin_amdgcn_global_load_lds((const unsigned*)S.aptr(u, gR[0]), gt_, 4, 0, 0); __builtin_amdgcn_global_load_lds((const unsigned*)S.aptr(u, gR[1]), gt_ + 512, 4, 0, 0); \
        __builtin_amdgcn_global_load_lds((const unsigned*)S.aptr(u, HALF + gR[0]), gt_ + 1024, 4, 0, 0); __builtin_amdgcn_global_load_lds((const unsigned*)S.aptr(u, HALF + gR[1]), gt_ + 1536, 4, 0, 0); } while (0)
    unsigned gcb[2] = {0u, 0u};
    if constexpr (GATHER) { int r_, c_; stage_rc(tid * 16, r_, c_); gcb[0] = (unsigned)c_ * 2u; stage_rc(tid * 16 + 8192, r_, c_); gcb[1] = (unsigned)c_ * 2u; }
    const unsigned rowB = (unsigned)K * 2u;
    const size_t kstep = (size_t)(BK * 2);
    const size_t hstep = (size_t)HALF * K * 2;
    const size_t tstep = 2 * hstep;
    const unsigned ldsw = (unsigned)wid * 1024u;
    const int aoff = lds_byte(wr * 64 + fr, fq * 8), boff = lds_byte(wc * 32 + fr, fq * 8);
#define PG8_SA(b, h) (((b) * 2 + (h)) * HTB)
#define PG8_SB(b, h) ((4 + (b) * 2 + (h)) * HTB)
#define PG8_STAGE(bufoff, gbase, voff) do { _Pragma("unroll") for (int _i = 0; _i < 2; ++_i) \
        __builtin_amdgcn_global_load_lds((const unsigned*)((const char*)(gbase) + (voff)[_i]), (PG8_LAS unsigned*)(lds + (bufoff) + ldsw + _i * 8192), 16, 0, 0); } while (0)
#define PG8_STAGE_B(bufoff, gbase, h) do { if constexpr (Epi::PERM >= 2) PG8_STAGE(bufoff, gbase, voffB2[h]); else PG8_STAGE(bufoff, (gbase) + (size_t)(h) * hstep, voffB); } while (0)
#define PG8_LDA(dst, b, h) do { _Pragma("unroll") for (int m = 0; m < 4; ++m) { if constexpr (FP8) { dst##8[m].lo = *(const PG8_LAS i32x4_t*)(lds + PG8_SA(b, h) + aoff + m * 2048); dst##8[m].hi = *(const PG8_LAS i32x4_t*)(lds + PG8_SA(b, h) + aoff + m * 2048 + 1024); } \
        else { _Pragma("unroll") for (int k = 0; k < 2; ++k) dst[m][k] = *(const PG8_LAS bf16x8*)(lds + PG8_SA(b, h) + aoff + m * 2048 + k * 1024); } } } while (0)
#define PG8_LDB(dst, b, h) do { _Pragma("unroll") for (int n = 0; n < 2; ++n) { if constexpr (FP8) { dst##8[n].lo = *(const PG8_LAS i32x4_t*)(lds + PG8_SB(b, h) + boff + n * 2048); dst##8[n].hi = *(const PG8_LAS i32x4_t*)(lds + PG8_SB(b, h) + boff + n * 2048 + 1024); } \
        else { _Pragma("unroll") for (int k = 0; k < 2; ++k) dst[n][k] = *(const PG8_LAS bf16x8*)(lds + PG8_SB(b, h) + boff + n * 2048 + k * 1024); } } } while (0)
#define PG8_MMA(ai, bj, At, Bt) do { __builtin_amdgcn_s_setprio(1); \
        if constexpr (FP8) { _Pragma("unroll") for (int m = 0; m < 4; ++m) _Pragma("unroll") for (int n = 0; n < 2; ++n) \
            asm volatile("v_mfma_scale_f32_16x16x128_f8f6f4 %0, %1, %2, %0, %3, %3 op_sel_hi:[0,0,0]" : "+v"(acc[ai][bj][m][n]) : "v"(Bt##8[n]), "v"(At##8[m]), "v"(sc7f)); } \
        else { _Pragma("unroll") for (int m = 0; m < 4; ++m) _Pragma("unroll") for (int n = 0; n < 2; ++n) _Pragma("unroll") for (int k = 0; k < 2; ++k) \
            acc[ai][bj][m][n] = __builtin_amdgcn_mfma_f32_16x16x32_bf16(Bt[n][k], At[m][k], acc[ai][bj][m][n], 0, 0, 0); } \
        __builtin_amdgcn_s_setprio(0); } while (0)
#define PG8_WAIT_V(n) asm volatile("s_waitcnt vmcnt(" #n ")" ::: "memory")
#define PG8_WAIT_V1 do { if (t != 0 || xtra == 0) PG8_WAIT_V(8); else if (xtra == 1) PG8_WAIT_V(9); else if (xtra == 5) PG8_WAIT_V(13); else if (xtra == 9) PG8_WAIT_V(17); else if (xtra == 13) PG8_WAIT_V(21); \
        else if (xtra == 16) PG8_WAIT_V(24); else if (xtra == 8) PG8_WAIT_V(16); else if (xtra == 12) PG8_WAIT_V(20); else if (xtra == 4) PG8_WAIT_V(12); else PG8_WAIT_V(8); } while (0)
#define PG8_WAIT_L(n) asm volatile("s_waitcnt lgkmcnt(" #n ")" ::: "memory")
#define PG8_BAR __builtin_amdgcn_s_barrier()
#define PG8_SCHED __builtin_amdgcn_sched_barrier(0)
    Unit cur, nxt; int ui = 0;
    if (!S.next(0, cur)) return;
    f32x4 acc[2][2][4][2];
#pragma unroll
    for (int a = 0; a < 2; ++a)
#pragma unroll
        for (int b = 0; b < 2; ++b)
#pragma unroll
            for (int m = 0; m < 4; ++m)
#pragma unroll
                for (int n = 0; n < 2; ++n) acc[a][b][m][n] = (f32x4){0.f, 0.f, 0.f, 0.f};
    bf16x8 At[4][2], B0[2][2], B1[2][2]; i32x8_t At8[4], B08[2], B18[2];
    int sc7f = 0x7f7f7f7f; asm volatile("" : "+v"(sc7f));
    const char* cA = (const char*)g.A + (GATHER ? (size_t)0 : (size_t)cur.pm * tstep); const char* cB = (const char*)g.Bt + (size_t)cur.pn * tstep;
    S.a_ready(cur);
    int gslot = 0;
    if constexpr (GATHER) { PG8_GOFF(0, cur); PG8_WAIT_V(0); }
    const size_t hA = GATHER ? (size_t)0 : hstep;
#define PG8_STAGE_A(bufoff, gbase, h, sl) do { if constexpr (GATHER) { const PG8_LAS unsigned* gt_ = S.gtab + (sl) * 2048 + (h) * 1024 + tid; const unsigned o_[2] = {gt_[0] * rowB + gcb[0], gt_[512] * rowB + gcb[1]}; PG8_STAGE(bufoff, gbase, o_); } \
        else PG8_STAGE(bufoff, (gbase) + (size_t)(h) * hA, voffA); } while (0)
    if constexpr (SP2) {
        PG8_STAGE_B(PG8_SB(0, 0), cB, 0); PG8_STAGE_B(PG8_SB(0, 1), cB, 1); PG8_STAGE_A(PG8_SA(0, 0), cA, 0, 0); PG8_STAGE_A(PG8_SA(0, 1), cA, 1, 0);
        if (wr == 1) PG8_BAR;
        PG8_WAIT_V(2); PG8_BAR;
        PG8_STAGE_B(PG8_SB(1, 0), cB + kstep, 0); PG8_STAGE_A(PG8_SA(1, 0), cA + kstep, 0, 0); PG8_STAGE_B(PG8_SB(1, 1), cB + kstep, 1);
        PG8_WAIT_V(6); PG8_BAR;
    } else {
        PG8_STAGE_B(PG8_SB(0, 0), cB, 0); PG8_STAGE(PG8_SA(0, 0), cA, voffA); PG8_STAGE_B(PG8_SB(0, 1), cB, 1); PG8_STAGE(PG8_SA(0, 1), cA + hstep, voffA);
        if (wr == 1) PG8_BAR;
        PG8_WAIT_V(4); PG8_BAR;
        PG8_STAGE_B(PG8_SB(1, 0), cB + kstep, 0); PG8_STAGE(PG8_SA(1, 0), cA + kstep, voffA); PG8_STAGE_B(PG8_SB(1, 1), cB + kstep, 1);
        PG8_WAIT_V(6); PG8_BAR;
    }
    for (;;) {
        const bool has_next = S.next(ui + 1, nxt);
        const char* nA = (has_next && !GATHER) ? (const char*)g.A + (size_t)nxt.pm * tstep : cA; const char* nB = has_next ? (const char*)g.Bt + (size_t)nxt.pn * tstep : cB;
        if constexpr (GATHER) { if (has_next) PG8_GOFF(gslot ^ 1, nxt); }
        bool lbp = false;
        if constexpr (Epi::LDSBIAS) { if (E.lbias) { lbp = true; __builtin_amdgcn_global_load_lds((const unsigned*)E.bias_src(cur, wc, lane), (PG8_LAS unsigned*)(E.lbias + wid * 64), 4, 0, 0); } }
        const int xtra = ((ui > 0 && E.dbg == 0) ? Epi::NSTORE : 0) + ((GATHER && has_next) ? 4 : 0) + (lbp ? 1 : 0);
#pragma unroll 1
        for (int t = 0; t < nt; t += 2) {
            const bool last = (t == nt - 2);
            const char* a1 = cA + (size_t)(t + 1) * kstep;
            const char* a2 = last ? nA : cA + (size_t)(t + 2) * kstep; const char* b2 = last ? nB : cB + (size_t)(t + 2) * kstep;
            const char* a3 = a2 + kstep; const char* b3 = b2 + kstep;
            if (last && has_next) S.a_ready(nxt);
            const int gnx = (last && has_next) ? (gslot ^ 1) : gslot;
            if constexpr (SP2) {
            PG8_LDB(B0, 0, 0); PG8_LDB(B1, 0, 1); PG8_SCHED; PG8_LDA(At, 0, 0); PG8_STAGE_A(PG8_SA(1, 1), a1, 1, gslot);
            PG8_WAIT_V1;
            PG8_WAIT_L(0); PG8_BAR; PG8_MMA(0, 0, At, B0); PG8_MMA(0, 1, At, B1); PG8_BAR; PG8_SCHED;
            PG8_LDA(At, 0, 1); PG8_STAGE_B(PG8_SB(0, 0), b2, 0); PG8_STAGE_B(PG8_SB(0, 1), b2, 1); PG8_STAGE_A(PG8_SA(0, 0), a2, 0, gnx);
            PG8_WAIT_V1;
            PG8_WAIT_L(0); PG8_BAR; PG8_MMA(1, 0, At, B0); PG8_MMA(1, 1, At, B1); PG8_BAR; PG8_SCHED;
            PG8_LDB(B0, 1, 0); PG8_LDB(B1, 1, 1); PG8_SCHED; PG8_LDA(At, 1, 0); PG8_STAGE_A(PG8_SA(0, 1), a2, 1, gnx);
            PG8_WAIT_V(8); PG8_WAIT_L(0); PG8_BAR; PG8_MMA(0, 0, At, B0); PG8_MMA(0, 1, At, B1); PG8_BAR; PG8_SCHED;
            PG8_LDA(At, 1, 1); PG8_STAGE_B(PG8_SB(1, 0), b3, 0); PG8_STAGE_B(PG8_SB(1, 1), b3, 1); PG8_STAGE_A(PG8_SA(1, 0), a3, 0, gnx);
            PG8_WAIT_V(8); PG8_WAIT_L(0); PG8_BAR; PG8_MMA(1, 0, At, B0); PG8_MMA(1, 1, At, B1); PG8_BAR; PG8_SCHED;
            } else {
            PG8_LDB(B0, 0, 0); PG8_SCHED; PG8_LDA(At, 0, 0); PG8_STAGE(PG8_SA(1, 1), a1 + hstep, voffA);
            PG8_WAIT_L(8); PG8_BAR; PG8_WAIT_L(0); PG8_MMA(0, 0, At, B0); PG8_BAR; PG8_SCHED;
            PG8_LDB(B1, 0, 1); PG8_STAGE_B(PG8_SB(0, 0), b2, 0);
            PG8_BAR; PG8_WAIT_L(0); PG8_MMA(0, 1, At, B1); PG8_BAR;
            PG8_LDA(At, 0, 1); PG8_STAGE(PG8_SA(0, 0), a2, voffA);
            PG8_BAR; PG8_WAIT_L(0); PG8_MMA(1, 0, At, B0); PG8_BAR; PG8_SCHED;
            PG8_STAGE_B(PG8_SB(0, 1), b2, 1);
            PG8_WAIT_V(6); PG8_BAR; PG8_MMA(1, 1, At, B1); PG8_BAR;
            PG8_LDB(B0, 1, 0); PG8_SCHED; PG8_LDA(At, 1, 0); PG8_STAGE(PG8_SA(0, 1), a2 + hstep, voffA);
            PG8_WAIT_L(8); PG8_BAR; PG8_WAIT_L(0); PG8_MMA(0, 0, At, B0); PG8_BAR; PG8_SCHED;
            PG8_LDB(B1, 1, 1); PG8_STAGE_B(PG8_SB(1, 0), b3, 0);
            PG8_BAR; PG8_WAIT_L(0); PG8_MMA(0, 1, At, B1); PG8_BAR;
            PG8_LDA(At, 1, 1); PG8_STAGE(PG8_SA(1, 0), a3, voffA);
            PG8_BAR; PG8_WAIT_L(0); PG8_MMA(1, 0, At, B0); PG8_BAR; PG8_SCHED;
            PG8_STAGE_B(PG8_SB(1, 1), b3, 1);
            PG8_WAIT_V(6); PG8_BAR; PG8_MMA(1, 1, At, B1); PG8_BAR;
            }
        }
        if constexpr (ALIGN_EPI) { if (wr == 0) PG8_BAR; }
        if constexpr (FP8) asm volatile("s_nop 15\n\ts_nop 15" ::: "memory");
        if constexpr (!Epi::AFTER_DRAIN) { E(acc, cur, wr, wc, fr, fq); S.done(cur); }
        if (!has_next) break;
#pragma unroll
        for (int a = 0; a < 2; ++a)
#pragma unroll
            for (int b = 0; b < 2; ++b)
#pragma unroll
                for (int m = 0; m < 4; ++m)
#pragma unroll
                    for (int n = 0; n < 2; ++n) acc[a][b][m][n] = (f32x4){0.f, 0.f, 0.f, 0.f};
        cur = nxt; cA = nA; cB = nB; ++ui;
        gslot ^= 1;
        if constexpr (ALIGN_EPI) { if (wr == 1) PG8_BAR; }
    }
    PG8_WAIT_V(0);
    if constexpr (!ALIGN_EPI) { if (wr == 0) PG8_BAR; }
    PG8_BAR;
    if constexpr (Epi::AFTER_DRAIN) { E.fused(acc, cur, wr, wc, fr, fq, lds, wid, lane); S.done(cur); }
#undef PG8_SA
#undef PG8_GOFF
#undef PG8_STAGE_A
#undef PG8_SB
#undef PG8_STAGE
#undef PG8_STAGE_B
#undef PG8_LDA
#undef PG8_LDB
#undef PG8_MMA
#undef PG8_WAIT_V
#undef PG8_WAIT_V1
#undef PG8_WAIT_L
#undef PG8_BAR
#undef PG8_SCHED
}
}
#include <hip/hip_bf16.h>
#include <cmath>
namespace attn_body {
using bf16=__hip_bfloat16;
using bf16x8=__attribute__((ext_vector_type(8)))short;
using s16x4=__attribute__((ext_vector_type(4)))short;
using f32x16=__attribute__((ext_vector_type(16)))float;
using u32x4=__attribute__((ext_vector_type(4)))unsigned;
constexpr int SEQ=4096,D=64,PIN=3072,PO=1024;
constexpr int NW=8,QBLK=32,QB=QBLK*NW,KVBLK=64,NQB=SEQ/QB;
constexpr int ATTN_UNIT_ROWS=QB;
__device__ __forceinline__ int crow(int r,int hi){return (r&3)+8*(r>>2)+4*hi;}
#define SBAR() __builtin_amdgcn_sched_barrier(0)
__device__ __forceinline__ void cmask(f32x16&p0,f32x16&p1,int jb,int qrel,int hi){
  const float NEG=-INFINITY; int kb=64*jb+4*hi;
  #pragma unroll
  for(int r=0;r<16;++r){int kv=kb+(r&3)+8*(r>>2); if(kv>qrel)p0[r]=NEG; if(kv+32>qrel)p1[r]=NEG;}
}

constexpr int NSLOT=3, SLOTB=8192;
constexpr int LDS_K=0, LDS_V=NSLOT*SLOTB, LDS_V2=2*NSLOT*SLOTB, LDS_WS=3*NSLOT*SLOTB, LDS_OST=LDS_WS+NW*64*4, LDS_BYTES=LDS_OST+NW*4096;
constexpr float C2=0.125f*1.4426950408889634f;
__device__ __forceinline__ void glds16(const void*gsrc,unsigned lds_dst){unsigned keep;
  asm volatile("s_mov_b32 %0, m0\n\ts_mov_b32 m0, %2\n\ts_nop 0\n\tglobal_load_lds_dwordx4 %1, off\n\ts_mov_b32 m0, %0":"=&s"(keep):"v"(gsrc),"s"(lds_dst):"memory");}
__device__ __forceinline__ float max3f(float a,float b,float c){float r;asm("v_max3_f32 %0, %1, %2, %3":"=v"(r):"v"(a),"v"(b),"v"(c));return r;}
__device__ __forceinline__ float max2f(float a,float b){float r;asm("v_max_f32_e32 %0, %1, %2":"=v"(r):"v"(a),"v"(b));return r;}
__device__ __forceinline__ float fadd_s(float a,float b){float r;asm("v_add_f32_e32 %0, %1, %2":"=v"(r):"v"(a),"v"(b));return r;}
__device__ __forceinline__ float fsub_s(float a,float b){float r;asm("v_sub_f32_e32 %0, %1, %2":"=v"(r):"v"(a),"v"(b));return r;}
typedef float f32x2_t __attribute__((ext_vector_type(2))); typedef __bf16 bf16x2_t __attribute__((ext_vector_type(2)));
__device__ __forceinline__ unsigned cvtpk_s(float lo,float hi){f32x2_t v={lo,hi};bf16x2_t b=__builtin_convertvector(v,bf16x2_t);return __builtin_bit_cast(unsigned,b);}
#define WAIT_BAR(N) asm volatile("s_waitcnt vmcnt(" #N ") lgkmcnt(0)\n\ts_barrier":::"memory")

__device__ __forceinline__ void qkt(f32x16&p0,f32x16&p1,const char*Kslot,const bf16x8*qr,const f32x16&negm,int r32,int hi){
  const char*kb=Kslot+hi*1024+r32*16;
  #pragma unroll
  for(int d0=0;d0<4;++d0){
    const bf16x8 b0=*reinterpret_cast<const bf16x8*>(kb+d0*2048);
    const bf16x8 b1=*reinterpret_cast<const bf16x8*>(kb+d0*2048+512);
    if(d0==0){p0=__builtin_amdgcn_mfma_f32_32x32x16_bf16(b0,qr[0],negm,0,0,0);p1=__builtin_amdgcn_mfma_f32_32x32x16_bf16(b1,qr[0],negm,0,0,0);}
    else{p0=__builtin_amdgcn_mfma_f32_32x32x16_bf16(b0,qr[d0],p0,0,0,0);p1=__builtin_amdgcn_mfma_f32_32x32x16_bf16(b1,qr[d0],p1,0,0,0);}}
}
typedef __attribute__((address_space(3))) const char* lds_cptr;
typedef short v4i16_t __attribute__((ext_vector_type(4)));
__device__ __forceinline__ void kload8(bf16x8*kf,lds_cptr kp){
  kf[0]=*(const __attribute__((address_space(3))) bf16x8*)(kp);      kf[1]=*(const __attribute__((address_space(3))) bf16x8*)(kp+512);
  kf[2]=*(const __attribute__((address_space(3))) bf16x8*)(kp+2048); kf[3]=*(const __attribute__((address_space(3))) bf16x8*)(kp+2560);
  kf[4]=*(const __attribute__((address_space(3))) bf16x8*)(kp+4096); kf[5]=*(const __attribute__((address_space(3))) bf16x8*)(kp+4608);
  kf[6]=*(const __attribute__((address_space(3))) bf16x8*)(kp+6144); kf[7]=*(const __attribute__((address_space(3))) bf16x8*)(kp+6656);
}
__device__ __forceinline__ void kload2(bf16x8*kf,lds_cptr kp,int j){ kf[2*j]=*(const __attribute__((address_space(3))) bf16x8*)(kp+j*2048); kf[2*j+1]=*(const __attribute__((address_space(3))) bf16x8*)(kp+j*2048+512); }
__device__ __forceinline__ s16x4 vtr(lds_cptr p){ return __builtin_bit_cast(s16x4,__builtin_amdgcn_ds_read_tr16_b64_v4i16((__attribute__((address_space(3))) v4i16_t*)p)); }
__device__ __forceinline__ float rowmax(const f32x16&p0,const f32x16&p1){
  float a=max3f(p0[0],p0[1],p1[0]),b=max3f(p0[2],p0[3],p1[1]);a=max3f(a,p1[2],p1[3]);
  #pragma unroll
  for(int r=4;r<16;r+=4){a=max3f(a,p0[r],p0[r+1]);b=max3f(b,p0[r+2],p0[r+3]);a=max3f(a,p1[r],p1[r+1]);b=max3f(b,p1[r+2],p1[r+3]);}
  const float m=max2f(a,b);
  auto rr=__builtin_amdgcn_permlane32_swap(__float_as_uint(m),__float_as_uint(m),false,false);
  return max2f(__uint_as_float(rr[0]),__uint_as_float(rr[1]));
}
__device__ __forceinline__ void pv(f32x16*o,int vb,bf16x8 pa0,bf16x8 pa1,bf16x8 pa2,bf16x8 pa3){
  #pragma unroll
  for(int d0=0;d0<2;++d0){s16x4 lo[4],hi[4];
    #pragma unroll
    for(int ks=0;ks<4;++ks){
      asm volatile("ds_read_b64_tr_b16 %0,%1 offset:%c2":"=&v"(lo[ks]):"v"(vb),"i"(d0*4096+ks*1024):"memory");
      asm volatile("ds_read_b64_tr_b16 %0,%1 offset:%c2":"=&v"(hi[ks]):"v"(vb),"i"(d0*4096+ks*1024+512):"memory");}
    asm volatile("s_waitcnt lgkmcnt(0)":::"memory");SBAR();
    #define PK(k) (bf16x8){lo[k][0],lo[k][1],lo[k][2],lo[k][3],hi[k][0],hi[k][1],hi[k][2],hi[k][3]}
    o[d0]=__builtin_amdgcn_mfma_f32_32x32x16_bf16(pa0,PK(0),o[d0],0,0,0);
    o[d0]=__builtin_amdgcn_mfma_f32_32x32x16_bf16(pa1,PK(1),o[d0],0,0,0);
    o[d0]=__builtin_amdgcn_mfma_f32_32x32x16_bf16(pa2,PK(2),o[d0],0,0,0);
    o[d0]=__builtin_amdgcn_mfma_f32_32x32x16_bf16(pa3,PK(3),o[d0],0,0,0);
    #undef PK
  }
}

#ifndef ATTN_STORE16
#define ATTN_STORE16(p,v) (*(u32x4*)(p)=(v))
#endif
template<int THRL> __device__ __forceinline__ void attn_unit(int b,int qb,const bf16*Q,const bf16*__restrict__ K,const bf16*__restrict__ V,bf16*O,char*shm,int cmap,float lam,float osc,const float*ng,bf16*M){
  int tid_=threadIdx.x; asm volatile("":"+v"(tid_)); const int tid=tid_,lane=tid&63,r32=lane&31,hi=lane>>5; const int wid=__builtin_amdgcn_readfirstlane(tid>>6);
  const long rowbase=(long)b*SEQ; const int q0=qb*QB;
  const bf16*Qw=Q+(rowbase+q0+wid*QBLK)*PIN;
  const bf16*Kh=K+rowbase*PIN,*Vh=V+rowbase*PIN;
  const unsigned lds0=(unsigned)(uintptr_t)shm;
  float*wsf=(float*)(shm+LDS_WS)+wid*64;
  const unsigned koff=(unsigned)(lane*PIN+wid*8)*2u, voff=(unsigned)((16*(wid&3)+(lane>>2))*PIN+(wid>>2)*32+(lane&3)*8)*2u;
  const unsigned kdst=lds0+LDS_K+wid*1024, vdst=lds0+LDS_V+wid*1024, vdst2=lds0+LDS_V2+wid*1024;
  #define DMA_K(t,slot) glds16((const char*)Kh+(size_t)(t)*(KVBLK*PIN*2)+koff,(unsigned)__builtin_amdgcn_readfirstlane(kdst+(slot)))
  #define DMA_V(t,slot) do{ glds16((const char*)Vh+(size_t)(t)*(KVBLK*PIN*2)+voff,(unsigned)__builtin_amdgcn_readfirstlane(vdst+(slot))); glds16((const char*)Vh+(size_t)(t)*(KVBLK*PIN*2)+128+voff,(unsigned)__builtin_amdgcn_readfirstlane(vdst2+(slot))); }while(0)
  const int vb0=(int)(lds0+LDS_V)+((lane>>4)&1)*32+(lane&3)*8+(4*hi+((lane&15)>>2))*64;
  const char*Kbase=shm+LDS_K; bf16x8 kf[8];
  const lds_cptr shm3=(lds_cptr)shm; const lds_cptr kp0=shm3+LDS_K+hi*1024+r32*16; const lds_cptr vp0=shm3+LDS_V+((lane>>4)&1)*32+(lane&3)*8+(4*hi+((lane&15)>>2))*64;
  const int NT=(q0+QB)/KVBLK;
  DMA_K(0,0);DMA_V(0,0);DMA_K(1,SLOTB);
  bf16x8 qr[4];
  #pragma unroll
  for(int d0=0;d0<4;++d0)qr[d0]=*reinterpret_cast<const bf16x8*>(&Qw[(long)r32*PIN+d0*16+hi*8]);
  const __attribute__((address_space(3))) bf16x8* qld=(const __attribute__((address_space(3))) bf16x8*)(shm3+LDS_OST+wid*4096)+lane;
  #pragma unroll
  for(int d0=0;d0<4;++d0)((__attribute__((address_space(3))) bf16x8*)(shm3+LDS_OST+wid*4096))[d0*64+lane]=qr[d0];
  float mhat=0.f,l_reg=0.f;f32x16 o[2];o[0]=f32x16{};o[1]=f32x16{};f32x16 o2[2];o2[0]=f32x16{};o2[1]=f32x16{}; const f32x16 zero16=f32x16{};
  const int qrel=wid*QBLK+r32;
  #define CMASK(P0,P1,t) do{int jb_=(t)-(NT-4); if(jb_>=0)cmask(P0,P1,jb_,qrel,hi);}while(0)
  bool resc=false;
  #define START(P0,P1) do{ const float rm=rowmax(P0,P1); resc=false; \
    { const float dl=rm; mhat=fadd_s(mhat,dl); \
      _Pragma("unroll") for(int r=0;r<16;++r){P0[r]=fsub_s(P0[r],dl);P1[r]=fsub_s(P1[r],dl);} } \
    _Pragma("unroll") for(int r=0;r<16;++r)P0[r]=__builtin_amdgcn_exp2f(P0[r]); }while(0)
  #define RESC() do{ if(resc){ asm volatile("s_waitcnt lgkmcnt(0)":::"memory"); \
      _Pragma("unroll") for(int d_=0;d_<2;++d_) _Pragma("unroll") for(int r=0;r<16;++r){ const float f_=wsf[crow(r,hi)]; o[d_][r]*=f_; o2[d_][r]*=f_; } } }while(0)
  f32x16 pA0,pA1,pB0,pB1;
  int sl_prev=0,sl_cur=0,sl_next=SLOTB;
  #define ROT() do{sl_prev=sl_cur;sl_cur=sl_next;sl_next=(sl_next==(NSLOT-1)*SLOTB)?0:sl_next+SLOTB;}while(0)
  DMA_K(2,2*SLOTB);
  WAIT_BAR(3);
  qkt(pA0,pA1,Kbase,qr,zero16,r32,hi);asm volatile("s_nop 15\n\ts_nop 7":"+v"(pA0),"+v"(pA1));CMASK(pA0,pA1,0);
  START(pA0,pA1);
  _Pragma("unroll") for(int r=0;r<16;++r)pA1[r]=__builtin_amdgcn_exp2f(pA1[r]);
  WAIT_BAR(0);
  DMA_K(3,0);DMA_V(1,SLOTB);
  ROT();
  kload8(kf,kp0+sl_cur);
  WAIT_BAR(3);
  s16x4 vlo[8],vhi[8]; u32x4 pw0,pw1,pw2,pw3;
  #define PKW(P,B) cvtpk_s(P[B],P[B+1])
  #define PAF(k) __builtin_bit_cast(bf16x8,pw##k)
  #define VFR(i) (bf16x8){vlo[i][0],vlo[i][1],vlo[i][2],vlo[i][3],vhi[i][0],vhi[i][1],vhi[i][2],vhi[i][3]}
  #define PIN(x) asm volatile("":"+v"(x))
  #define MX3(a,b,c) __builtin_fmaxf(__builtin_fmaxf((a),(b)),(c))
  #define GAPA(MF,A0,A1,A2,A3,W0,W1,PW) do{ MF; sacc+=A0; sacc+=A1; sacc+=A2; sacc+=A3; PIN(sacc); W0; W1; PIN(PW); SBAR(); }while(0)
  #define EX(v) __builtin_amdgcn_exp2f(v)
  #define GAPB(MF,X,B) do{ MF; X[B]=EX(X[B]-mhat); X[B+1]=EX(X[B+1]-mhat); PIN(X); SBAR(); }while(0)
  #define VRD(i) do{ vlo[i]=vtr(vp_+(((i)>>2)*4096+((i)&3)*1024)); vhi[i]=vtr(vp_+(((i)>>2)*4096+((i)&3)*1024+512)); }while(0)
  #define KRD(G,j) do{ if(G){ kload2(kf,kp0+sl_next,j); SBAR(); } }while(0)
  #define V2RD(i) do{ vlo[i]=vtr(vq_+(((i)>>2)*4096+((i)&3)*1024)); vhi[i]=vtr(vq_+(((i)>>2)*4096+((i)&3)*1024+512)); }while(0)
  #define STEP(C0,C1,P0,P1,t,GK,GV,GL) do{ SBAR(); \
    const lds_cptr vp_=vp0+sl_prev; \
    const bf16x8 q0_=qld[0],q1_=qld[64],q2_=qld[128],q3_=qld[192];     \
    VRD(0); SBAR(); float sacc=(P0[0]+P0[1]); \
    GAPA(C0=__builtin_amdgcn_mfma_f32_32x32x16_bf16(kf[0],q0_,zero16,0,0,0), P0[2],P0[3],P0[4],P0[5],     pw0[0]=PKW(P0,0), pw0[1]=PKW(P0,2), pw0); \
    VRD(4); SBAR(); GAPA(C1=__builtin_amdgcn_mfma_f32_32x32x16_bf16(kf[1],q0_,zero16,0,0,0), P0[6],P0[7],P0[8],P0[9],     pw0[2]=PKW(P0,4), pw0[3]=PKW(P0,6), pw0); \
    VRD(1); SBAR(); GAPA(C0=__builtin_amdgcn_mfma_f32_32x32x16_bf16(kf[2],q1_,C0,0,0,0),   P0[10],P0[11],P0[12],P0[13], pw1[0]=PKW(P0,8), pw1[1]=PKW(P0,10), pw1); \
    VRD(5); SBAR(); GAPA(C1=__builtin_amdgcn_mfma_f32_32x32x16_bf16(kf[3],q1_,C1,0,0,0),   P0[14],P0[15],P1[0],P1[1],   pw1[2]=PKW(P0,12),pw1[3]=PKW(P0,14), pw1); \
    VRD(2); SBAR(); GAPA(C0=__builtin_amdgcn_mfma_f32_32x32x16_bf16(kf[4],q2_,C0,0,0,0),   P1[2],P1[3],P1[4],P1[5],     pw2[0]=PKW(P1,0), pw2[1]=PKW(P1,2), pw2); \
    VRD(6); SBAR(); GAPA(C1=__builtin_amdgcn_mfma_f32_32x32x16_bf16(kf[5],q2_,C1,0,0,0),   P1[6],P1[7],P1[8],P1[9],     pw2[2]=PKW(P1,4), pw2[3]=PKW(P1,6), pw2); \
    VRD(3); SBAR(); GAPA(C0=__builtin_amdgcn_mfma_f32_32x32x16_bf16(kf[6],q3_,C0,0,0,0),   P1[10],P1[11],P1[12],P1[13], pw3[0]=PKW(P1,8), pw3[1]=PKW(P1,10), pw3); \
    VRD(7); SBAR(); GAPA(C1=__builtin_amdgcn_mfma_f32_32x32x16_bf16(kf[7],q3_,C1,0,0,0),   P1[14],P1[15],0.f,0.f,       pw3[2]=PKW(P1,12),pw3[3]=PKW(P1,14), pw3); \
    l_reg+=sacc; \
    if(GK){DMA_K((t)+3,sl_cur);} if(GV){DMA_V((t)+1,sl_next);} \
    CMASK(C0,C1,t); \
    { float a=MX3(C0[0],C0[1],C1[0]),b=MX3(C0[2],C0[3],C1[1]); a=MX3(a,C1[2],C1[3]); \
      _Pragma("unroll") for(int r=4;r<16;r+=4){a=MX3(a,C0[r],C0[r+1]);b=MX3(b,C0[r+2],C0[r+3]);a=MX3(a,C1[r],C1[r+1]);b=MX3(b,C1[r+2],C1[r+3]);} \
      float rm=__builtin_fmaxf(a,b); { auto rr=__builtin_amdgcn_permlane32_swap(__float_as_uint(rm),__float_as_uint(rm),false,false); rm=__builtin_fmaxf(__uint_as_float(rr[0]),__uint_as_float(rr[1])); } \
      rm-=mhat; resc=false; \
      if(__builtin_expect(__any(rm>(float)THRL),0)){ const float dl=__builtin_fmaxf(rm,0.f); mhat+=dl; \
        const float f=__builtin_amdgcn_exp2f(-dl); l_reg*=f; if(hi==0)wsf[r32]=f; resc=true; } } \
    SBAR(); \
    const lds_cptr vq_=vp0+(LDS_V2-LDS_V)+sl_prev;     \
    GAPB(o[0]=__builtin_amdgcn_mfma_f32_32x32x16_bf16(PAF(0),VFR(0),o[0],0,0,0), C0,0); \
    GAPB(o[1]=__builtin_amdgcn_mfma_f32_32x32x16_bf16(PAF(0),VFR(4),o[1],0,0,0), C0,2); V2RD(0); V2RD(4); SBAR(); \
    KRD(GL,0); GAPB(o[0]=__builtin_amdgcn_mfma_f32_32x32x16_bf16(PAF(1),VFR(1),o[0],0,0,0), C0,4); \
    KRD(GL,1); GAPB(o[1]=__builtin_amdgcn_mfma_f32_32x32x16_bf16(PAF(1),VFR(5),o[1],0,0,0), C0,6); V2RD(1); V2RD(5); SBAR(); \
    KRD(GL,2); GAPB(o[0]=__builtin_amdgcn_mfma_f32_32x32x16_bf16(PAF(2),VFR(2),o[0],0,0,0), C0,8); \
    KRD(GL,3); GAPB(o[1]=__builtin_amdgcn_mfma_f32_32x32x16_bf16(PAF(2),VFR(6),o[1],0,0,0), C0,10); V2RD(2); V2RD(6); SBAR(); \
    GAPB(o[0]=__builtin_amdgcn_mfma_f32_32x32x16_bf16(PAF(3),VFR(3),o[0],0,0,0), C0,12); \
    GAPB(o[1]=__builtin_amdgcn_mfma_f32_32x32x16_bf16(PAF(3),VFR(7),o[1],0,0,0), C0,14); V2RD(3); V2RD(7); SBAR(); \
    {     \
      GAPB(o2[0]=__builtin_amdgcn_mfma_f32_32x32x16_bf16(PAF(0),VFR(0),o2[0],0,0,0), C1,0); GAPB(o2[1]=__builtin_amdgcn_mfma_f32_32x32x16_bf16(PAF(0),VFR(4),o2[1],0,0,0), C1,2); \
      GAPB(o2[0]=__builtin_amdgcn_mfma_f32_32x32x16_bf16(PAF(1),VFR(1),o2[0],0,0,0), C1,4); GAPB(o2[1]=__builtin_amdgcn_mfma_f32_32x32x16_bf16(PAF(1),VFR(5),o2[1],0,0,0), C1,6); \
      GAPB(o2[0]=__builtin_amdgcn_mfma_f32_32x32x16_bf16(PAF(2),VFR(2),o2[0],0,0,0), C1,8); GAPB(o2[1]=__builtin_amdgcn_mfma_f32_32x32x16_bf16(PAF(2),VFR(6),o2[1],0,0,0), C1,10); \
      GAPB(o2[0]=__builtin_amdgcn_mfma_f32_32x32x16_bf16(PAF(3),VFR(3),o2[0],0,0,0), C1,12); GAPB(o2[1]=__builtin_amdgcn_mfma_f32_32x32x16_bf16(PAF(3),VFR(7),o2[1],0,0,0), C1,14); } \
    }while(0)
  int t=1;
  #undef CMASK
  #define CMASK(P0,P1,t) do{}while(0)
  for(;t+5<NT;t+=2){
    STEP(pB0,pB1,pA0,pA1,t,true,true,true);     WAIT_BAR(3); RESC(); ROT();
    STEP(pA0,pA1,pB0,pB1,t+1,true,true,true);   WAIT_BAR(3); RESC(); ROT();
  }
  #undef CMASK
  #define CMASK(P0,P1,t) do{int jb_=(t)-(NT-4); if(jb_>=0)cmask(P0,P1,jb_,qrel,hi);}while(0)
  #define ENDW(tt) do{ if((tt)+3<NT){WAIT_BAR(3);} else if((tt)+2<NT){WAIT_BAR(2);} else {WAIT_BAR(0);} }while(0)
  for(;t+1<NT;t+=2){
    STEP(pB0,pB1,pA0,pA1,t,(t+3<NT),(t+1<NT),(t+1<NT));       ENDW(t);   RESC(); ROT();
    STEP(pA0,pA1,pB0,pB1,t+1,(t+4<NT),(t+2<NT),(t+2<NT));     ENDW(t+1); RESC(); ROT();
  }
  STEP(pB0,pB1,pA0,pA1,NT-1,false,false,false); RESC();
  { float sacc=pB0[0]+pB0[1]; _Pragma("unroll") for(int r=2;r<16;++r)sacc+=pB0[r]; _Pragma("unroll") for(int r=0;r<16;++r)sacc+=pB1[r]; l_reg+=sacc;
    pw0=(u32x4){PKW(pB0,0),PKW(pB0,2),PKW(pB0,4),PKW(pB0,6)};pw1=(u32x4){PKW(pB0,8),PKW(pB0,10),PKW(pB0,12),PKW(pB0,14)};pw2=(u32x4){PKW(pB1,0),PKW(pB1,2),PKW(pB1,4),PKW(pB1,6)};pw3=(u32x4){PKW(pB1,8),PKW(pB1,10),PKW(pB1,12),PKW(pB1,14)};
    SBAR(); pv(o,vb0+sl_cur,PAF(0),PAF(1),PAF(2),PAF(3)); pv(o2,vb0+(LDS_V2-LDS_V)+sl_cur,PAF(0),PAF(1),PAF(2),PAF(3)); }
  #undef PKW
  #undef PAF
  #undef VFR
  #undef PIN
  #undef MX3
  #undef GAPA
  #undef GAPB
  #undef EX
  #undef VRD
  #undef KRD
  #undef V2RD
  #undef STEP
  #undef ENDW
  {auto rr=__builtin_amdgcn_permlane32_swap(__float_as_uint(l_reg),__float_as_uint(l_reg),false,false);l_reg=__uint_as_float(rr[0])+__uint_as_float(rr[1]);}
  if(hi==0)wsf[32+r32]=l_reg;asm volatile("s_waitcnt lgkmcnt(0)":::"memory");
  float rli[16];
  #pragma unroll
  for(int r=0;r<16;++r)rli[r]=__builtin_amdgcn_rcpf(wsf[32+crow(r,hi)]);
  bf16*Ow=O+(rowbase+q0+wid*QBLK)*PO;
  { bf16*stg=(bf16*)(shm+LDS_OST)+wid*2048;
    if(cmap==0){
      #pragma unroll
      for(int hf=0;hf<2;++hf){
        #pragma unroll
        for(int r=0;r<16;++r){const int orow=crow(r,hi);
          #pragma unroll
          for(int d0=0;d0<2;++d0)stg[orow*64+d0*32+r32]=__float2bfloat16((hf?o2[d0][r]:o[d0][r])*rli[r]);}
        asm volatile("s_waitcnt lgkmcnt(0)":::"memory");
        #pragma unroll
        for(int i=0;i<4;++i){const int row=i*8+(lane>>3),ch=lane&7; const u32x4 v=*(const u32x4*)(stg+row*64+ch*8); ATTN_STORE16(Ow+(long)row*PO+hf*64+ch*8,v);}
        asm volatile("s_waitcnt lgkmcnt(0)":::"memory"); }
    } else {
      asm volatile("s_waitcnt vmcnt(0)":::"memory");
      float dd[2][4][8]; const int ch=lane&7;
      #pragma unroll
      for(int hf=0;hf<2;++hf){
        #pragma unroll
        for(int r=0;r<16;++r){const int orow=crow(r,hi);
          #pragma unroll
          for(int d0=0;d0<2;++d0)stg[orow*64+d0*32+r32]=__float2bfloat16((hf?o2[d0][r]:o[d0][r])*rli[r]);}
        asm volatile("s_waitcnt lgkmcnt(0)":::"memory");
        #pragma unroll
        for(int i=0;i<4;++i){const int row=i*8+(lane>>3); const u32x4 v1=*(const u32x4*)(stg+row*64+ch*8); const u32x4 v0=*(const u32x4*)(Ow+(long)row*PO+hf*64+ch*8);
          #pragma unroll
          for(int j=0;j<4;++j){ dd[hf][i][2*j]=__uint_as_float(v0[j]<<16)-lam*__uint_as_float(v1[j]<<16); dd[hf][i][2*j+1]=__uint_as_float(v0[j]&0xffff0000u)-lam*__uint_as_float(v1[j]&0xffff0000u); } }
        asm volatile("s_waitcnt lgkmcnt(0)":::"memory"); }
      float gg[2][8];
      #pragma unroll
      for(int hf=0;hf<2;++hf){ const float4 a=*(const float4*)(ng+hf*64+ch*8), c4=*(const float4*)(ng+hf*64+ch*8+4); gg[hf][0]=a.x;gg[hf][1]=a.y;gg[hf][2]=a.z;gg[hf][3]=a.w;gg[hf][4]=c4.x;gg[hf][5]=c4.y;gg[hf][6]=c4.z;gg[hf][7]=c4.w; }
      bf16*Mw=M+(rowbase+q0+wid*QBLK)*PO;
      #pragma unroll
      for(int i=0;i<4;++i){ float ss=0.f;
        #pragma unroll
        for(int hf=0;hf<2;++hf)
          #pragma unroll
          for(int j=0;j<8;++j)ss+=dd[hf][i][j]*dd[hf][i][j];
        ss+=__shfl_xor(ss,1);ss+=__shfl_xor(ss,2);ss+=__shfl_xor(ss,4);
        const float rr=osc/sqrtf(ss*(1.0f/128.0f)+1e-5f); const int row=i*8+(lane>>3);
        #pragma unroll
        for(int hf=0;hf<2;++hf){ u32x4 w;
          #pragma unroll
          for(int j=0;j<4;++j)w[j]=cvtpk_s(dd[hf][i][2*j]*rr*gg[hf][2*j],dd[hf][i][2*j+1]*rr*gg[hf][2*j+1]);
          ATTN_STORE16(Mw+(long)row*PO+hf*64+ch*8,w); } }
    } }
  asm volatile("s_waitcnt lgkmcnt(0)\n\ts_barrier":::"memory");
  #undef DMA_K
  #undef DMA_V
  #undef CMASK
  #undef START
  #undef RESC
  #undef ROT
}
constexpr int ATTN_LDS_BYTES=LDS_BYTES;
__device__ __forceinline__ void attn_phase(char*lds,const bf16*proj,bf16*O,bf16*M,const float*ng,float lam,float osc,int vcu){
  const int bh=vcu>>3, s=vcu&7, b=bh>>2, h=bh&3;
  const bf16*V=proj+1024+h*128; bf16*Oc=O+h*128; bf16*Mc=M+h*128;
  for(int i=0;i<2;++i){ const int qb=i?15-s:s;
    for(int c=0;c<2;++c) attn_unit<8>(b,qb,proj+h*128+c*64,proj+512+h*128+c*64,V,Oc,lds,c,lam,osc,ng,Mc); }
}
#undef SBAR
#undef WAIT_BAR
}
#define GAS __attribute__((address_space(1)))
#define LAS __attribute__((address_space(3)))
typedef unsigned short bf16;
typedef unsigned v4u __attribute__((ext_vector_type(4)));
typedef float f32x4 __attribute__((ext_vector_type(4)));
typedef short bf16x8 __attribute__((ext_vector_type(8)));
typedef GAS unsigned gu32;
typedef GAS unsigned long long gu64;
#define RLX_AGENT __ATOMIC_RELAXED, __HIP_MEMORY_SCOPE_AGENT
#define LDS_WAIT() asm volatile("s_waitcnt lgkmcnt(0)" ::: "memory")
#define VM_WAIT() asm volatile("s_waitcnt vmcnt(0)" ::: "memory")
__device__ __forceinline__ unsigned long long rt() { return __builtin_amdgcn_s_memrealtime(); }
__device__ __forceinline__ unsigned f2bf(float f) { unsigned u = __builtin_bit_cast(unsigned, f); return (u + 0x7fffu + ((u >> 16) & 1u)) >> 16; }
__device__ __forceinline__ unsigned pk2(float lo, float hi) { return f2bf(lo) | (f2bf(hi) << 16); }

#define XB_TMO      128
#define XB_XCNT(j)  (256  + 64 * (j))
#define XB_XSUB(j)  (1280 + 64 * (j))
#define XB_XGEN(j)  (2304 + 64 * (j))
#define XB_TOP      3328
#define XB_TOPGEN   3392
#define XCD_BAR_WORDS 3456
#define XB_SPIN_CAP (1u << 18)

__device__ __forceinline__ unsigned xb_ld(unsigned* p)              { return __hip_atomic_load(p, __ATOMIC_RELAXED, __HIP_MEMORY_SCOPE_AGENT); }
__device__ __forceinline__ unsigned xb_add(unsigned* p, unsigned v) { return __hip_atomic_fetch_add(p, v, __ATOMIC_RELAXED, __HIP_MEMORY_SCOPE_AGENT); }
__device__ __forceinline__ unsigned xb_xcc_id() { return (unsigned)__builtin_amdgcn_s_getreg((3 << 11) | 20) & 0xFu; }
#define XB_SPIN(cond, bar) do { unsigned _sp = 0; while (cond) { __builtin_amdgcn_s_sleep(1); \
    if ((++_sp & 255u) == 0u) { if (xb_ld(&(bar)[XB_TMO])) break; if (_sp > XB_SPIN_CAP) { atomicAdd(&(bar)[XB_TMO], 1u); break; } } } } while (0)

struct XcdBarrier {
    unsigned* bar; unsigned x;
    volatile LAS unsigned* st;
};

__device__ __forceinline__ XcdBarrier xcd_barrier_post(unsigned* bar, volatile LAS unsigned* st) {
    XcdBarrier b; b.bar = bar; b.x = xb_xcc_id(); b.st = st;
    if (threadIdx.x == 0) (void)xb_add(&bar[XB_XCNT(b.x)], 1u);
    return b;
}
__device__ __forceinline__ void xcd_barrier_complete(unsigned* bar, unsigned x, unsigned& nloc, unsigned& nx) {
    const unsigned G = gridDim.x * gridDim.y * gridDim.z;
    unsigned sum, cnt, mine, sp = 0u;
    for (;;) {
        sum = 0u; cnt = 0u; mine = 0u;
#pragma unroll
        for (unsigned j = 0; j < 16; ++j) { const unsigned c = xb_ld(&bar[XB_XCNT(j)]); sum += c; cnt += (c > 0u) ? 1u : 0u; mine = (j == x) ? c : mine; }
        if (sum == G) break;
        __builtin_amdgcn_s_sleep(1);
        if ((++sp & 255u) == 0u) { if (xb_ld(&bar[XB_TMO])) break; if (sp > XB_SPIN_CAP) { atomicAdd(&bar[XB_TMO], 1u); break; } }
    }
    nloc = mine > 0u ? mine : 1u; nx = cnt > 0u ? cnt : 1u;
}

__device__ __forceinline__ void xcd_barrier(const XcdBarrier& b) {
    asm volatile("s_waitcnt vmcnt(0)" ::: "memory");
    __syncthreads();
    if (threadIdx.x == 0) {
        unsigned* bar = b.bar;
        __builtin_amdgcn_s_waitcnt(0);
        unsigned nloc = b.st[0], nx = b.st[1];
        if (nloc == 0u) { xcd_barrier_complete(bar, b.x, nloc, nx); b.st[0] = nloc; b.st[1] = nx; }
        const unsigned old = xb_add(&bar[XB_XSUB(b.x)], 1u);
        const unsigned gen = old / nloc;
        if (old + 1u == (gen + 1u) * nloc) {
            __builtin_amdgcn_fence(__ATOMIC_RELEASE, "agent");
            asm volatile("s_waitcnt vmcnt(0)" ::: "memory");
            const unsigned og = xb_add(&bar[XB_TOP], 1u);
            const unsigned tg = og / nx;
            if (og + 1u == (tg + 1u) * nx) xb_add(&bar[XB_TOPGEN], 1u);
            else XB_SPIN(xb_ld(&bar[XB_TOPGEN]) == tg, bar);
            __builtin_amdgcn_fence(__ATOMIC_ACQUIRE, "agent");
            xb_add(&bar[XB_XGEN(b.x)], 1u);
            asm volatile("s_waitcnt vmcnt(0)" ::: "memory");
        } else {
            XB_SPIN(xb_ld(&bar[XB_XGEN(b.x)]) == gen, bar);
            __builtin_amdgcn_fence(__ATOMIC_ACQUIRE, "agent");
            asm volatile("s_waitcnt vmcnt(0)" ::: "memory");
        }
    }
    __syncthreads();
}
constexpr int NWAVES = 8, NTHREADS = NWAVES * 64;
constexpr int BATCH = 8, SEQ = 4096, NTOK = BATCH * SEQ, DMODEL = 1024, INW = 3080, NPROJ = 3072, DEPTH = 4;
constexpr int NEXP = 32, DFF = 1024, CHUNK = 64, NCH = SEQ / CHUNK, NBH = BATCH * 4;
constexpr int MAXRT = (NTOK * 4) / 256 + NEXP;
constexpr float DN_ALPHA = 1.681792830507429f, LN_EPS = 1e-5f, RMS_EPS = 1e-5f;
constexpr int NPH_LAYER = 10, NPHASES = 1 + DEPTH * NPH_LAYER;

constexpr size_t MiB = 1u << 20;
constexpr size_t WS_CTL = 0, CTL_ZERO_BYTES = 1 * MiB;
constexpr size_t WS_WIN = 2 * MiB;
#ifndef MK_SIDEJOB
#define MK_SIDEJOB 0
#endif
#ifndef MK_X1R8
#define MK_X1R8 1
#endif
constexpr float X1R_SCALE = 128.0f;
#ifndef MK_OUTFP8
#define MK_OUTFP8 0
#endif
constexpr float MQ_SCALE = 16.0f, MQ_ML = 2.0f;
constexpr size_t WS_WOUT = WS_WIN + 24 * MiB;
constexpr size_t WS_WGU = WS_WOUT + 8 * MiB;
constexpr size_t WS_WDN = WS_WGU + 512 * MiB;
constexpr size_t WS_XRES = WS_WDN + 256 * MiB;
constexpr size_t WS_X1 = WS_XRES + 128 * MiB;
constexpr size_t WS_XB = WS_X1 + 128 * MiB;
constexpr size_t WS_X1B = WS_XB + 64 * MiB;
constexpr size_t WS_PROJ = WS_X1B + 64 * MiB;
constexpr size_t WS_G = WS_PROJ + 192 * MiB;
constexpr size_t WS_ATTO = WS_G + 1 * MiB;
constexpr size_t WS_MIXIN = WS_ATTO + 64 * MiB;
constexpr size_t WS_MIXO = WS_MIXIN + 64 * MiB;
constexpr size_t WS_CST = WS_MIXO + 64 * MiB;
constexpr size_t WS_NST = WS_CST + 64 * MiB;
constexpr size_t WS_MISC = WS_NST + 1 * MiB;
constexpr size_t WS_WRP = WS_MISC + 512 * 1024;
constexpr size_t WS_TOKE = WS_MISC + 1 * MiB;
constexpr size_t WS_TOKP = WS_TOKE + 1 * MiB;
constexpr size_t WS_TOKG = WS_TOKP + 1 * MiB;
constexpr size_t WS_ROWTOK = WS_TOKG + 1 * MiB;
constexpr size_t WS_H = WS_ROWTOK + 4 * MiB;
constexpr size_t WS_Y = WS_H + 272 * MiB;
constexpr size_t WS_WINQ = WS_Y + 272 * MiB;
constexpr size_t WS_XQ = WS_WINQ + 8 * MiB;
constexpr size_t WS_END = WS_XQ + 32 * MiB;
static_assert((size_t)MAXRT * 256 * 1024 * 2 <= 272 * MiB, "H/Y size");
constexpr int CW_TMO = 0, CW_CODE = 1, CW_BAR = 4096, MAX_BAR_REGIONS = 48, CW_CNT = 200000;
static_assert(CW_BAR + MAX_BAR_REGIONS * 3456 <= CW_CNT && (CW_CNT + 64 * DEPTH) * 4 <= (int)CTL_ZERO_BYTES, "CTL map");
constexpr int RING_OFF = 0, RING_BYTES = 131072;
constexpr int LDSCTL_OFF = RING_BYTES;
constexpr int MISC_OFF = LDSCTL_OFF + 320;
constexpr int LDSX_OFF = LDSCTL_OFF + 512;
constexpr int LDS_BYTES = 163840;

typedef unsigned v2u __attribute__((ext_vector_type(2)));
__device__ __forceinline__ float bflo(unsigned w) { return __uint_as_float(w << 16); }
__device__ __forceinline__ float bfhi(unsigned w) { return __uint_as_float(w & 0xffff0000u); }
__device__ __forceinline__ void unpack8(const v4u w, float* o) { o[0] = bflo(w.x); o[1] = bfhi(w.x); o[2] = bflo(w.y); o[3] = bfhi(w.y); o[4] = bflo(w.z); o[5] = bfhi(w.z); o[6] = bflo(w.w); o[7] = bfhi(w.w); }
constexpr float XQ_SCALE = 8.0f, WQ_SCALE = 512.0f, HQ_SCALE = 8.0f, YQ_SCALE = 64.0f, XLO_SCALE = 4096.0f;
#ifndef MK_XLO
#define MK_XLO 0
#endif
constexpr bool USE_XLO = (MK_XLO != 0);
__device__ __forceinline__ v2u pack8_fp8(const float* o, float sc) { int a = 0, b = 0; a = __builtin_amdgcn_cvt_pk_fp8_f32(o[0] * sc, o[1] * sc, a, false); a = __builtin_amdgcn_cvt_pk_fp8_f32(o[2] * sc, o[3] * sc, a, true);
    b = __builtin_amdgcn_cvt_pk_fp8_f32(o[4] * sc, o[5] * sc, b, false); b = __builtin_amdgcn_cvt_pk_fp8_f32(o[6] * sc, o[7] * sc, b, true); return (v2u){(unsigned)a, (unsigned)b}; }
__device__ __forceinline__ v4u pack8(const float* o) { v4u w; w.x = pk2(o[0], o[1]); w.y = pk2(o[2], o[3]); w.z = pk2(o[4], o[5]); w.w = pk2(o[6], o[7]); return w; }
__device__ __forceinline__ float wave_sum(float v) {
#pragma unroll
    for (int o = 1; o < 64; o <<= 1) v += __shfl_xor(v, o);
    return v;
}
__device__ __forceinline__ float wave_max(float v) {
#pragma unroll
    for (int o = 1; o < 64; o <<= 1) v = fmaxf(v, __shfl_xor(v, o));
    return v;
}
__device__ __forceinline__ float sigmoid_f(float x) { return 1.0f / (1.0f + __expf(-x)); }

struct Ctx {
    LAS unsigned char* lds; int wave, vcu, G; unsigned char* ws; const float* const* in; float* out;
};
__device__ __forceinline__ int ltid() { int t = threadIdx.x; asm volatile("" : "+v"(t)); return t; }
enum { I_X = 0, I_WIN, I_CONVW, I_CONVB, I_GATEB, I_LQ1, I_LK1, I_LQ2, I_LK2, I_NG, I_WOUT, I_LN1G, I_LN1B, I_WR, I_BR, I_WGU, I_BGU, I_WDN, I_BDN, I_LN2G, I_LN2B };

__device__ __forceinline__ void load_row_f32(const float* row, int lane, float* v) {
    const f32x4* p = (const f32x4*)(row + 8 * lane); const f32x4 a = p[0], b = p[1]; const f32x4* q = (const f32x4*)(row + 512 + 8 * lane); const f32x4 c = q[0], d = q[1];
    v[0] = a.x; v[1] = a.y; v[2] = a.z; v[3] = a.w; v[4] = b.x; v[5] = b.y; v[6] = b.z; v[7] = b.w; v[8] = c.x; v[9] = c.y; v[10] = c.z; v[11] = c.w; v[12] = d.x; v[13] = d.y; v[14] = d.z; v[15] = d.w;
}
__device__ __forceinline__ void store_row_f32(float* row, int lane, const float* v) {
    f32x4* p = (f32x4*)(row + 8 * lane); p[0] = (f32x4){v[0], v[1], v[2], v[3]}; p[1] = (f32x4){v[4], v[5], v[6], v[7]};
    f32x4* q = (f32x4*)(row + 512 + 8 * lane); q[0] = (f32x4){v[8], v[9], v[10], v[11]}; q[1] = (f32x4){v[12], v[13], v[14], v[15]};
}
__device__ __forceinline__ void load_row_bf16(const bf16* row, int lane, float* v) {
    const v4u a = *(const v4u*)(row + 8 * lane), b = *(const v4u*)(row + 512 + 8 * lane); unpack8(a, v); unpack8(b, v + 8);
}
__device__ __forceinline__ void load_row_fp8(const unsigned char* row, int lane, float sc, float* v) {
    typedef float f32x2_ __attribute__((ext_vector_type(2)));
    const v2u a = *(const v2u*)(row + 8 * lane), b = *(const v2u*)(row + 512 + 8 * lane); const unsigned w[4] = {a.x, a.y, b.x, b.y};
#pragma unroll
    for (int i = 0; i < 4; ++i) { const f32x2_ lo = __builtin_amdgcn_cvt_pk_f32_fp8((int)w[i], false), hi = __builtin_amdgcn_cvt_pk_f32_fp8((int)w[i], true); v[4 * i] = lo.x * sc; v[4 * i + 1] = lo.y * sc; v[4 * i + 2] = hi.x * sc; v[4 * i + 3] = hi.y * sc; }
}
__device__ __forceinline__ void store_row_fp8(unsigned char* row, int lane, const float* v, float sc) {
    *(v2u*)(row + 8 * lane) = pack8_fp8(v, sc); *(v2u*)(row + 512 + 8 * lane) = pack8_fp8(v + 8, sc);
}
__device__ __forceinline__ void store_row_bf16(bf16* row, int lane, const float* v) {
    *(v4u*)(row + 8 * lane) = pack8(v); *(v4u*)(row + 512 + 8 * lane) = pack8(v + 8);
}
__device__ __forceinline__ void store_row_fp8_nt(unsigned char* row, int lane, const float* v, float sc) {
    __builtin_nontemporal_store(pack8_fp8(v, sc), (v2u*)(row + 8 * lane)); __builtin_nontemporal_store(pack8_fp8(v + 8, sc), (v2u*)(row + 512 + 8 * lane));
}
__device__ __forceinline__ void store_row_bf16_nt(bf16* row, int lane, const float* v) {
    __builtin_nontemporal_store(pack8(v), (v4u*)(row + 8 * lane)); __builtin_nontemporal_store(pack8(v + 8), (v4u*)(row + 512 + 8 * lane));
}
__device__ __forceinline__ void store_row_f32_nt(float* row, int lane, const float* v) {
    f32x4* p = (f32x4*)(row + 8 * lane); __builtin_nontemporal_store((f32x4){v[0], v[1], v[2], v[3]}, p); __builtin_nontemporal_store((f32x4){v[4], v[5], v[6], v[7]}, p + 1);
    f32x4* q = (f32x4*)(row + 512 + 8 * lane); __builtin_nontemporal_store((f32x4){v[8], v[9], v[10], v[11]}, q); __builtin_nontemporal_store((f32x4){v[12], v[13], v[14], v[15]}, q + 1);
}
__device__ __forceinline__ void ln_row(float* v, const float* g, const float* b) {
    float s = 0.f;
#pragma unroll
    for (int i = 0; i < 16; ++i) s += v[i];
    const float mean = wave_sum(s) * (1.0f / DMODEL); float q = 0.f;
#pragma unroll
    for (int i = 0; i < 16; ++i) { v[i] -= mean; q += v[i] * v[i]; }
    const float rstd = 1.0f / sqrtf(wave_sum(q) * (1.0f / DMODEL) + LN_EPS);
#pragma unroll
    for (int i = 0; i < 16; ++i) v[i] = v[i] * rstd * g[i] + b[i];
}
__device__ __forceinline__ void load_vec16(const float* p, int lane, float* v) { load_row_f32(p, lane, v); }

__device__ __forceinline__ void load_gate_w(int tid, const float* w_in_l, LAS f32x4* wgl) {
    for (int idx = tid; idx < 2048; idx += NTHREADS) { const int ln = idx & 63, hq = idx >> 6, half = hq & 1, q = hq >> 1; const int k = (q < 8) ? (8 * ln + q) : (512 + 8 * ln + q - 8);
        wgl[idx] = *(const f32x4*)(w_in_l + (size_t)k * INW + NPROJ + 4 * half); }
}
__device__ __forceinline__ void gates_row(const float* v, const LAS f32x4* wgl, const float* gate_b, float* Grow, int lane) {
    float p[8] = {0.f, 0.f, 0.f, 0.f, 0.f, 0.f, 0.f, 0.f};
#pragma unroll
    for (int q = 0; q < 16; ++q) { const f32x4 w0 = wgl[(q * 2 + 0) * 64 + lane], w1 = wgl[(q * 2 + 1) * 64 + lane];
        p[0] += v[q] * w0.x; p[1] += v[q] * w0.y; p[2] += v[q] * w0.z; p[3] += v[q] * w0.w; p[4] += v[q] * w1.x; p[5] += v[q] * w1.y; p[6] += v[q] * w1.z; p[7] += v[q] * w1.w; }
    const bool b5 = (lane >> 5) & 1, b4 = (lane >> 4) & 1, b3 = (lane >> 3) & 1;
    float r4[4];
#pragma unroll
    for (int i = 0; i < 4; ++i) { const float keep = b5 ? p[4 + i] : p[i], send = b5 ? p[i] : p[4 + i]; r4[i] = keep + __shfl_xor(send, 32); }
    float r2[2];
#pragma unroll
    for (int i = 0; i < 2; ++i) { const float keep = b4 ? r4[2 + i] : r4[i], send = b4 ? r4[i] : r4[2 + i]; r2[i] = keep + __shfl_xor(send, 16); }
    float r1; { const float keep = b3 ? r2[1] : r2[0], send = b3 ? r2[0] : r2[1]; r1 = keep + __shfl_xor(send, 8); }
    r1 += __shfl_xor(r1, 4); r1 += __shfl_xor(r1, 2); r1 += __shfl_xor(r1, 1);
    if ((lane & 7) == 0) { const int gi = (lane >> 3); Grow[gi] = r1 + gate_b[gi]; }
}
struct TrItem { const float* src; unsigned char* dst; int ldw, Kd, fp8; float sc; };
__device__ __forceinline__ void tr_fetch(const TrItem& a, float* ra, int lane) {
    const int kk0 = lane >> 5, nn = lane & 31;
#pragma unroll
    for (int i = 0; i < 64; ++i) ra[i] = a.src[(size_t)(2 * i + kk0) * a.ldw + nn];
}
__device__ __forceinline__ void tr_put(const float* ra, LAS float* scr, int lane) {
    const int kk0 = lane >> 5, nn = lane & 31;
#pragma unroll
    for (int i = 0; i < 64; ++i) scr[(2 * i + kk0) * 33 + nn] = ra[i];
}
__device__ __forceinline__ void tr_store(const TrItem& it, const LAS float* scr, int lane) {
    const int c = lane & 7;
#pragma unroll
    for (int j = 0; j < 4; ++j) { const int n = (lane >> 3) + 8 * j; const LAS float* s = scr + (16 * c) * 33 + n; float o[16];
#pragma unroll
        for (int i = 0; i < 16; ++i) o[i] = s[i * 33];
        if (it.fp8) { const v2u p = pack8_fp8(o, it.sc), q = pack8_fp8(o + 8, it.sc); *(GAS v4u*)(it.dst + (size_t)n * it.Kd + 16 * c) = (v4u){p.x, p.y, q.x, q.y}; }
        else { GAS v4u* d = (GAS v4u*)(it.dst + ((size_t)n * it.Kd + 16 * c) * 2); d[0] = pack8(o); d[1] = pack8(o + 8); } }
}
constexpr int TR_I_IN = DEPTH * 8 * 96, TR_I_OUT = DEPTH * 8 * 32, TR_I_GU = DEPTH * NEXP * 8 * 64, TR_I_DN = DEPTH * NEXP * 8 * 32, TR_ITEMS = TR_I_IN + TR_I_OUT + TR_I_GU + TR_I_DN;
__device__ __forceinline__ TrItem tr_decode(const Ctx& C, int r) {
    TrItem it;
    if (r < TR_I_GU) { const int m = r / 512, q = r % 512, kb = q / 64, nb = q % 64, n0 = 32 * nb;
        const int nn = (n0 < 1024) ? n0 : n0 - 1024; const int drow = 256 * (nn / 128) + (nn % 128) + ((n0 < 1024) ? 0 : 128);
        it.src = C.in[I_WGU] + (size_t)m * DMODEL * 2 * DFF + (size_t)(128 * kb) * (2 * DFF) + n0; it.ldw = 2 * DFF; it.Kd = DMODEL; it.fp8 = 1; it.sc = WQ_SCALE;
        it.dst = C.ws + WS_WGU + (size_t)m * 2 * DFF * DMODEL + (size_t)drow * DMODEL + 128 * kb; return it; }
    r -= TR_I_GU;
    if (r < TR_I_DN) { const int m = r / 256, q = r % 256, kb = q / 32, nb = q % 32;
        it.src = C.in[I_WDN] + (size_t)m * DFF * DMODEL + (size_t)(128 * kb) * DMODEL + 32 * nb; it.ldw = DMODEL; it.Kd = DFF; it.fp8 = 1; it.sc = WQ_SCALE;
        it.dst = C.ws + WS_WDN + (size_t)m * DMODEL * DFF + (size_t)(32 * nb) * DFF + 128 * kb; return it; }
    r -= TR_I_DN;
    if (r < TR_I_IN) { const int l = r / 768, q = r % 768, kb = q / 96, nb = q % 96, n0 = 32 * nb, tile = n0 >> 8;
        const bool q8 = (tile >= 8); const int rank = q8 ? tile - 8 : tile; const int drow = rank * 256 + (n0 & 255);
        it.src = C.in[I_WIN] + (size_t)l * DMODEL * INW + (size_t)(128 * kb) * INW + n0; it.ldw = INW; it.Kd = DMODEL; it.fp8 = q8 ? 1 : 0; it.sc = q8 ? WQ_SCALE : 1.f;
        it.dst = q8 ? C.ws + WS_WINQ + (size_t)l * 1536 * DMODEL + (size_t)drow * DMODEL + 128 * kb : C.ws + WS_WIN + ((size_t)l * NPROJ * DMODEL + (size_t)drow * DMODEL + 128 * kb) * 2; return it; }
    r -= TR_I_IN;
    { const int l = r / 256, q = r % 256, kb = q / 32, nb = q % 32;
        it.src = C.in[I_WOUT] + (size_t)l * DMODEL * DMODEL + (size_t)(128 * kb) * DMODEL + 32 * nb; it.ldw = DMODEL; it.Kd = DMODEL; it.fp8 = MK_OUTFP8; it.sc = MK_OUTFP8 ? ((kb >= 4) ? WQ_SCALE * (MQ_SCALE / MQ_ML) : WQ_SCALE) : 1.f;
        it.dst = C.ws + WS_WOUT + ((size_t)l * DMODEL * DMODEL + (size_t)(32 * nb) * DMODEL + 128 * kb) * (MK_OUTFP8 ? 1 : 2); return it; }
}
#ifndef MK_TRQ_RUNS
#define MK_TRQ_RUNS 0
#endif
constexpr int TR_L_GU = NEXP * 8 * 64, TR_L_DN = NEXP * 8 * 32, TR_L = TR_L_GU + TR_L_DN, TR_P_ITEMS = TR_L + TR_I_IN + TR_I_OUT, TRQ_LAYERS = DEPTH - 1;
__device__ __forceinline__ int trq_per(const Ctx& C) { return (TR_L + C.G - 1) / C.G; }
__device__ __forceinline__ int trq_item(const Ctx& C, int q) {
    const int per = trq_per(C), l = 1 + q / per, i = MK_TRQ_RUNS ? (C.vcu * per + q % per) : ((q % per) * C.G + C.vcu); if (i >= TR_L) return -1;
    return (i < TR_L_GU) ? l * TR_L_GU + i : TR_I_GU + l * TR_L_DN + (i - TR_L_GU); }
__device__ __forceinline__ int trp_item(int p) { return (p < TR_L_GU) ? p : (p < TR_L) ? TR_I_GU + (p - TR_L_GU) : TR_I_GU + TR_I_DN + (p - TR_L); }
__device__ __forceinline__ void tr_one(const Ctx& C, int r, LAS float* scr, int lane) {
    float ra[64]; const TrItem it = tr_decode(C, r); tr_fetch(it, ra, lane); tr_put(ra, scr, lane); LDS_WAIT(); asm volatile("" ::: "memory"); tr_store(it, scr, lane); LDS_WAIT(); asm volatile("" ::: "memory");
}
__device__ __forceinline__ int trq_grab(const Ctx& C, int lane) { unsigned v = 0u; if (lane == 0) v = __hip_atomic_fetch_add((LAS unsigned*)(C.lds + MISC_OFF) + 11, 1u, __ATOMIC_RELAXED, __HIP_MEMORY_SCOPE_WORKGROUP); return (int)__builtin_amdgcn_readfirstlane(v); }
__device__ __forceinline__ void trq_drain(const Ctx& C, int l) {
    const int lane = ltid() & 63, per = trq_per(C), endq = l * per, total = TRQ_LAYERS * per;
    LAS float* scr = (LAS float*)(C.lds + (C.wave < 7 ? RING_OFF + C.wave * 16896 : LDSX_OFF));
    for (;;) { const int q = trq_grab(C, lane); if (q >= total) break; const int r = trq_item(C, q); if (r >= 0) tr_one(C, r, scr, lane); if (q >= endq) break; }
    __syncthreads();
}
__device__ __forceinline__ void p_prologue(const Ctx& C) {
    const int tid = ltid(), lane = tid & 63;
    const int gw = C.vcu * NWAVES + C.wave, NGW = C.G * NWAVES;
    LAS float* scr = (LAS float*)(C.lds + (C.wave < 7 ? RING_OFF + C.wave * 16896 : LDSX_OFF));
    float ra[64]; TrItem cur = tr_decode(C, trp_item(gw < TR_P_ITEMS ? gw : 0));
    if (gw < TR_P_ITEMS) tr_fetch(cur, ra, lane);
    for (int it = gw; it < TR_P_ITEMS; it += NGW) {
        tr_put(ra, scr, lane);
        const bool more = (it + NGW < TR_P_ITEMS); const TrItem nxt = tr_decode(C, trp_item(more ? it + NGW : it));
        if (more) tr_fetch(nxt, ra, lane);
        LDS_WAIT(); asm volatile("" ::: "memory");
        tr_store(cur, scr, lane);
        LDS_WAIT(); asm volatile("" ::: "memory");
        cur = nxt;
    }
    { f32x4* WRP = (f32x4*)(C.ws + WS_WRP); const int gt = (C.vcu * NWAVES + C.wave) * 64 + lane, NGT = C.G * NTHREADS;
        for (int i = gt; i < DEPTH * 8192; i += NGT) { const int l = i >> 13, idx = i & 8191, ln = idx & 63, q4 = (idx >> 6) & 3, e = idx >> 8; const int k = (q4 < 2) ? (8 * ln + 4 * q4) : (512 + 8 * ln + 4 * (q4 - 2));
            const float* wr = C.in[I_WR] + (size_t)l * DMODEL * NEXP; WRP[i] = (f32x4){wr[(size_t)k * NEXP + e], wr[(size_t)(k + 1) * NEXP + e], wr[(size_t)(k + 2) * NEXP + e], wr[(size_t)(k + 3) * NEXP + e]}; } }
    __syncthreads();
    LAS f32x4* wgl = (LAS f32x4*)(C.lds + RING_OFF);
    load_gate_w(tid, C.in[I_WIN], wgl);
    __syncthreads();
    bf16* XB = (bf16*)(C.ws + WS_XB); float* G = (float*)(C.ws + WS_G);
    unsigned char* XLO = (unsigned char*)(C.ws + WS_XRES);
    for (int n = gw; n < NTOK; n += NGW) { float v[16], lo_[16]; load_row_f32(C.in[I_X] + (size_t)n * DMODEL, lane, v); store_row_bf16(XB + (size_t)n * DMODEL, lane, v);
#pragma unroll
        for (int i = 0; i < 16; ++i) lo_[i] = v[i] - __uint_as_float(f2bf(v[i]) << 16);
        if (USE_XLO) store_row_fp8(XLO + (size_t)n * DMODEL, lane, lo_, XLO_SCALE);
        store_row_fp8((unsigned char*)(C.ws + WS_XQ) + (size_t)n * DMODEL, lane, v, XQ_SCALE);
        gates_row(v, wgl, C.in[I_GATEB], G + (size_t)n * 8, lane); }
    __syncthreads();
}

__device__ __forceinline__ void conv_silu8(const bf16* proj, int n, int t, int col, const float* cw, const float* cb, float scale, float* y) {
    const f32x4 b0 = *(const f32x4*)cb, b1 = *(const f32x4*)(cb + 4);
    y[0] = b0.x; y[1] = b0.y; y[2] = b0.z; y[3] = b0.w; y[4] = b1.x; y[5] = b1.y; y[6] = b1.z; y[7] = b1.w;
#pragma unroll
    for (int j = 0; j < 4; ++j) { const int tt = t - 3 + j;
        if (tt >= 0) { const v4u w = *(const v4u*)(proj + (size_t)(n - 3 + j) * NPROJ + col); float x[8]; unpack8(w, x);
            const f32x4 c0 = *(const f32x4*)(cw + j * 512), c1 = *(const f32x4*)(cw + j * 512 + 4);
            y[0] += c0.x * x[0]; y[1] += c0.y * x[1]; y[2] += c0.z * x[2]; y[3] += c0.w * x[3]; y[4] += c1.x * x[4]; y[5] += c1.y * x[5]; y[6] += c1.z * x[6]; y[7] += c1.w * x[7]; } }
#pragma unroll
    for (int i = 0; i < 8; ++i) y[i] = y[i] * sigmoid_f(y[i]) * scale;
}
constexpr int KP = 68;

__device__ __forceinline__ void p_mlstm_states(const Ctx& C, int l) {
    const bf16* proj = (const bf16*)(C.ws + WS_PROJ); const float* G = (const float*)(C.ws + WS_G);
    float* CST = (float*)(C.ws + WS_CST); float* NST = (float*)(C.ws + WS_NST); float* MLOC = (float*)(C.ws + WS_MISC); float* GCH = MLOC + 2048;
    const float* cw = C.in[I_CONVW] + (size_t)l * 4 * 512; const float* cb = C.in[I_CONVB] + (size_t)l * 512;
    LAS float* kf = (LAS float*)(C.lds + RING_OFF);
    LAS float* vf = kf + 64 * 64;
    LAS float* ev = vf + 64 * 128;
    const int tid = ltid(), lane = tid & 63;
    for (int u = C.vcu; u < NBH * NCH; u += C.G) {
        const int bh = u / NCH, c = u % NCH, b = bh >> 2, h = bh & 3; const int n0 = b * SEQ + c * CHUNK;
        { const int s = tid >> 3, cg = tid & 7; float y[8]; conv_silu8(proj, n0 + s, c * CHUNK + s, 1536 + 256 + h * 64 + cg * 8, cw + 256 + h * 64 + cg * 8, cb + 256 + h * 64 + cg * 8, 1.0f, y);
#pragma unroll
            for (int i = 0; i < 8; ++i) kf[s * 64 + cg * 8 + i] = y[i];
            const bf16* vp = proj + (size_t)(n0 + s) * NPROJ + 2048 + h * 128 + cg * 16; float x[16]; unpack8(*(const v4u*)vp, x); unpack8(*(const v4u*)(vp + 8), x + 8);
#pragma unroll
            for (int i = 0; i < 16; ++i) vf[s * 128 + cg * 16 + i] = x[i]; }
        if (C.wave == 0) { const float ig = G[(size_t)(n0 + lane) * 8 + h], fg = G[(size_t)(n0 + lane) * 8 + 4 + h];
            float bc = fminf(fg, 0.f) - log1pf(expf(-fabsf(fg)));
#pragma unroll
            for (int o = 1; o < 64; o <<= 1) { const float t = __shfl_up(bc, o); if (lane >= o) bc += t; }
            const float g = __shfl(bc, 63); const float w = g - bc + ig; const float m = wave_max(w);
            ev[lane] = __expf(w - m); if (lane == 0) { MLOC[u] = m; GCH[u] = g; } }
        __syncthreads();
        { const int v = tid & 127, kg = tid >> 7; float acc[16];
#pragma unroll
            for (int i = 0; i < 16; ++i) acc[i] = 0.f;
            for (int s = 0; s < 64; ++s) { const float a = ev[s] * vf[s * 128 + v];
#pragma unroll
                for (int i4 = 0; i4 < 4; ++i4) { const f32x4 k4 = *(const LAS f32x4*)(kf + s * 64 + kg * 16 + i4 * 4); acc[i4 * 4 + 0] += a * k4.x; acc[i4 * 4 + 1] += a * k4.y; acc[i4 * 4 + 2] += a * k4.z; acc[i4 * 4 + 3] += a * k4.w; } }
            float* dst = CST + (size_t)u * 8192 + v;
#pragma unroll
            for (int i = 0; i < 16; ++i) dst[(kg * 16 + i) * 128] = acc[i]; }
        if (tid < 64) { float a = 0.f; for (int s = 0; s < 64; ++s) a += ev[s] * kf[s * 64 + tid]; NST[(size_t)u * 64 + tid] = a; }
        __syncthreads();
    }
}

__device__ __forceinline__ void p_mlstm_scan(const Ctx& C) {
    v2u* CST = (v2u*)(C.ws + WS_CST); f32x4* NST = (f32x4*)(C.ws + WS_NST); const float* MLOC = (const float*)(C.ws + WS_MISC); const float* GCH = MLOC + 2048; float* MPREV = (float*)(C.ws + WS_MISC) + 4096;
    const int nthr = C.G * NTHREADS, gid = C.vcu * NTHREADS + ltid();
    for (int it = gid; it < NBH * 2064; it += nthr) {
        const int bh = it / 2064, r = it % 2064;
        if (r < 2048) {
            v2u* p = CST + (size_t)bh * NCH * 2048 + r; float carry[4] = {0.f, 0.f, 0.f, 0.f}; float m = -INFINITY;
            for (int c0 = 0; c0 < NCH; c0 += 16) {
                v2u loc[16]; float gg[16], ml[16];
#pragma unroll
                for (int j = 0; j < 16; ++j) { loc[j] = p[(size_t)(c0 + j) * 2048]; gg[j] = GCH[bh * NCH + c0 + j]; ml[j] = MLOC[bh * NCH + c0 + j]; }
#pragma unroll
                for (int j = 0; j < 16; ++j) { p[(size_t)(c0 + j) * 2048] = (v2u){pk2(carry[0], carry[1]), pk2(carry[2], carry[3])}; if (r == 0) MPREV[bh * NCH + c0 + j] = m;
                    const float mn = fmaxf(gg[j] + m, ml[j]); const float a = __expf(gg[j] + m - mn), bb = __expf(ml[j] - mn);
                    carry[0] = carry[0] * a + bflo(loc[j].x) * bb; carry[1] = carry[1] * a + bfhi(loc[j].x) * bb; carry[2] = carry[2] * a + bflo(loc[j].y) * bb; carry[3] = carry[3] * a + bfhi(loc[j].y) * bb;
                    m = mn; }
            }
        } else {
            f32x4* p = NST + (size_t)bh * NCH * 16 + (r - 2048); f32x4 carry = (f32x4){0.f, 0.f, 0.f, 0.f}; float m = -INFINITY;
            for (int c0 = 0; c0 < NCH; c0 += 8) {
                f32x4 loc[8]; float gg[8], ml[8];
#pragma unroll
                for (int j = 0; j < 8; ++j) { loc[j] = p[(size_t)(c0 + j) * 16]; gg[j] = GCH[bh * NCH + c0 + j]; ml[j] = MLOC[bh * NCH + c0 + j]; }
#pragma unroll
                for (int j = 0; j < 8; ++j) { p[(size_t)(c0 + j) * 16] = carry;
                    const float mn = fmaxf(gg[j] + m, ml[j]); const float a = __expf(gg[j] + m - mn), bb = __expf(ml[j] - mn);
                    carry = carry * a + loc[j] * bb; m = mn; }
            }
        }
    }
}

__device__ __forceinline__ void p_mlstm_out(const Ctx& C, int l) {
    const bf16* proj = (const bf16*)(C.ws + WS_PROJ); const float* G = (const float*)(C.ws + WS_G);
    const float* CST = (const float*)(C.ws + WS_CST); const float* NST = (const float*)(C.ws + WS_NST); const float* MPREV = (const float*)(C.ws + WS_MISC) + 4096;
    bf16* MIXIN = (bf16*)(C.ws + WS_MIXIN);
    const float* cw = C.in[I_CONVW] + (size_t)l * 4 * 512; const float* cb = C.in[I_CONVB] + (size_t)l * 512;
    LAS float* qf = (LAS float*)(C.lds + RING_OFF);
    LAS float* kf = qf + 64 * KP;
    LAS float* Sm = kf + 64 * KP;
    LAS float* vf = Sm + 64 * KP;
    LAS float* Ct = vf + 64 * 128;
    LAS float* sv = Ct + 64 * 128;
    static_assert((3 * 64 * KP + 2 * 64 * 128 + 6 * 64) * 4 <= RING_BYTES, "mLSTM LDS");
    const int tid = ltid(), lane = tid & 63;
    for (int u = C.vcu; u < NBH * NCH; u += C.G) {
        const int bh = u / NCH, c = u % NCH, b = bh >> 2, h = bh & 3; const int n0 = b * SEQ + c * CHUNK;
        { const int s = tid >> 3, cg = tid & 7; float y[8];
            conv_silu8(proj, n0 + s, c * CHUNK + s, 1536 + h * 64 + cg * 8, cw + h * 64 + cg * 8, cb + h * 64 + cg * 8, 0.125f, y);
#pragma unroll
            for (int i = 0; i < 8; ++i) qf[s * KP + cg * 8 + i] = y[i];
            conv_silu8(proj, n0 + s, c * CHUNK + s, 1536 + 256 + h * 64 + cg * 8, cw + 256 + h * 64 + cg * 8, cb + 256 + h * 64 + cg * 8, 1.0f, y);
#pragma unroll
            for (int i = 0; i < 8; ++i) kf[s * KP + cg * 8 + i] = y[i];
            const bf16* vp = proj + (size_t)(n0 + s) * NPROJ + 2048 + h * 128 + cg * 16; float x[16]; unpack8(*(const v4u*)vp, x); unpack8(*(const v4u*)(vp + 8), x + 8);
#pragma unroll
            for (int i = 0; i < 16; ++i) vf[s * 128 + cg * 16 + i] = x[i];
            const f32x4* cp = (const f32x4*)(CST + (size_t)u * 8192);
#pragma unroll
            for (int i = 0; i < 4; ++i) *(LAS f32x4*)(Ct + (tid + NTHREADS * i) * 4) = cp[tid + NTHREADS * i]; }
        if (C.wave == 0) { const float ig = G[(size_t)(n0 + lane) * 8 + h], fg = G[(size_t)(n0 + lane) * 8 + 4 + h]; const float mp = MPREV[u];
            float bc = fminf(fg, 0.f) - log1pf(expf(-fabsf(fg)));
#pragma unroll
            for (int o = 1; o < 64; o <<= 1) { const float t = __shfl_up(bc, o); if (lane >= o) bc += t; }
            const float a = ig - bc; float pm = a;
#pragma unroll
            for (int o = 1; o < 64; o <<= 1) { const float t = __shfl_up(pm, o); if (lane >= o) pm = fmaxf(pm, t); }
            const float mt = bc + fmaxf(mp, pm);
            sv[lane] = bc; sv[64 + lane] = a; sv[128 + lane] = mt; sv[192 + lane] = __expf(bc + mp - mt); sv[320 + lane] = NST[(size_t)u * 64 + lane]; }
        __syncthreads();
        {
            const int t = tid >> 3, sg = tid & 7; float qr[64];
#pragma unroll
            for (int i = 0; i < 16; ++i) { const f32x4 q4 = *(const LAS f32x4*)(qf + t * KP + 4 * i); qr[4 * i] = q4.x; qr[4 * i + 1] = q4.y; qr[4 * i + 2] = q4.z; qr[4 * i + 3] = q4.w; }
            const float bt = sv[t] - sv[128 + t]; float dsum = 0.f;
#pragma unroll 2
            for (int j = 0; j < 8; ++j) { const int s = sg + 8 * j; float d = 0.f;
#pragma unroll
                for (int i = 0; i < 16; ++i) { const f32x4 k4 = *(const LAS f32x4*)(kf + s * KP + 4 * i); d += qr[4 * i] * k4.x + qr[4 * i + 1] * k4.y + qr[4 * i + 2] * k4.z + qr[4 * i + 3] * k4.w; }
                const float sc = (s <= t) ? d * __expf(sv[64 + s] + bt) : 0.f; Sm[t * KP + s] = sc; dsum += sc; }
            float nq = 0.f;
#pragma unroll
            for (int i = 0; i < 8; ++i) nq += qf[t * KP + sg * 8 + i] * sv[320 + sg * 8 + i];
            dsum += sv[192 + t] * nq;
            dsum += __shfl_xor(dsum, 1); dsum += __shfl_xor(dsum, 2); dsum += __shfl_xor(dsum, 4);
            if (sg == 0) sv[256 + t] = 1.0f / fmaxf(fabsf(dsum), __expf(-sv[128 + t])); }
        __syncthreads();
        {
            const int t = tid >> 3, vg = tid & 7; float acc[16];
#pragma unroll
            for (int i = 0; i < 16; ++i) acc[i] = 0.f;
            const float iw = sv[192 + t];
            for (int k = 0; k < 64; ++k) { const float a = qf[t * KP + k] * iw;
#pragma unroll
                for (int i4 = 0; i4 < 4; ++i4) { const f32x4 c4 = *(const LAS f32x4*)(Ct + k * 128 + vg * 16 + i4 * 4); acc[i4 * 4] += a * c4.x; acc[i4 * 4 + 1] += a * c4.y; acc[i4 * 4 + 2] += a * c4.z; acc[i4 * 4 + 3] += a * c4.w; } }
            for (int s = 0; s < 64; ++s) { const float a = Sm[t * KP + s];
#pragma unroll
                for (int i4 = 0; i4 < 4; ++i4) { const f32x4 v4 = *(const LAS f32x4*)(vf + s * 128 + vg * 16 + i4 * 4); acc[i4 * 4] += a * v4.x; acc[i4 * 4 + 1] += a * v4.y; acc[i4 * 4 + 2] += a * v4.z; acc[i4 * 4 + 3] += a * v4.w; } }
            const float dn = sv[256 + t];
            const bf16* op = proj + (size_t)(n0 + t) * NPROJ + 2560 + h * 128 + vg * 16; float o[16]; unpack8(*(const v4u*)op, o); unpack8(*(const v4u*)(op + 8), o + 8);
#pragma unroll
            for (int i = 0; i < 16; ++i) o[i] = acc[i] * dn * sigmoid_f(o[i]);
            bf16* dst = MIXIN + (size_t)(n0 + t) * DMODEL + 512 + h * 128 + vg * 16; *(v4u*)dst = pack8(o); *(v4u*)(dst + 8) = pack8(o + 8); }
        __syncthreads();
    }
}

__device__ __forceinline__ void p_da_combine(const Ctx& C, int l, float lam_init) {
    const bf16* ATTO = (const bf16*)(C.ws + WS_ATTO); bf16* MIXIN = (bf16*)(C.ws + WS_MIXIN);
    const int lane = ltid() & 63, gw = C.vcu * NWAVES + C.wave, NGW = C.G * NWAVES;
    const float s1 = wave_sum(C.in[I_LQ1][l * 64 + lane] * C.in[I_LK1][l * 64 + lane]), s2 = wave_sum(C.in[I_LQ2][l * 64 + lane] * C.in[I_LK2][l * 64 + lane]);
    const float lam = expf(s1) - expf(s2) + lam_init, osc = 1.0f - lam_init;
    const int h = lane >> 4, e8 = (lane & 15) * 8;
    float g[8]; { const f32x4 a = *(const f32x4*)(C.in[I_NG] + l * 128 + e8), b2 = *(const f32x4*)(C.in[I_NG] + l * 128 + e8 + 4); g[0] = a.x; g[1] = a.y; g[2] = a.z; g[3] = a.w; g[4] = b2.x; g[5] = b2.y; g[6] = b2.z; g[7] = b2.w; }
    for (int n = gw; n < NTOK; n += NGW) {
        float o0[8], o1[8]; unpack8(*(const v4u*)(ATTO + (size_t)n * DMODEL + h * 256 + e8), o0); unpack8(*(const v4u*)(ATTO + (size_t)n * DMODEL + h * 256 + 128 + e8), o1);
        float ss = 0.f;
#pragma unroll
        for (int i = 0; i < 8; ++i) { o0[i] -= lam * o1[i]; ss += o0[i] * o0[i]; }
        ss += __shfl_xor(ss, 1); ss += __shfl_xor(ss, 2); ss += __shfl_xor(ss, 4); ss += __shfl_xor(ss, 8);
        const float r = 1.0f / sqrtf(ss * (1.0f / 128.0f) + RMS_EPS) * osc;
#pragma unroll
        for (int i = 0; i < 8; ++i) o0[i] = o0[i] * r * g[i];
        *(v4u*)(MIXIN + (size_t)n * DMODEL + h * 128 + e8) = pack8(o0);
    }
}
typedef float f32x16 __attribute__((ext_vector_type(16)));
constexpr int TP = 72;
#define MFMA32(a, b, c) __builtin_amdgcn_mfma_f32_32x32x16_bf16((a), (b), (c), 0, 0, 0)
__device__ __forceinline__ bf16x8 frag_ld(const LAS bf16* tile, int row, int step, int h) { return *(const LAS bf16x8*)(tile + row * TP + step * 16 + 8 * h); }
__device__ __forceinline__ void tr_store16(LAS bf16* tile, int c0, int s, const v4u a, const v4u b) {
    const unsigned w[8] = {a.x, a.y, a.z, a.w, b.x, b.y, b.z, b.w};
#pragma unroll
    for (int i = 0; i < 8; ++i) { tile[(c0 + 2 * i) * TP + s] = (bf16)(w[i] & 0xffffu); tile[(c0 + 2 * i + 1) * TP + s] = (bf16)(w[i] >> 16); }
}

__device__ __forceinline__ void conv_fetch(const bf16* proj, int n, int t, int col, v4u* raw) {
#pragma unroll
    for (int j = 0; j < 4; ++j) { const int tt = t - 3 + j; raw[j] = (tt >= 0) ? *(const v4u*)(proj + (size_t)(n - 3 + j) * NPROJ + col) : (v4u){0u, 0u, 0u, 0u}; }
}
__device__ __forceinline__ void conv_apply(const v4u* raw, const float* cw, const float* cb, float scale, float* y) {
    const f32x4 b0 = *(const f32x4*)cb, b1 = *(const f32x4*)(cb + 4);
    y[0] = b0.x; y[1] = b0.y; y[2] = b0.z; y[3] = b0.w; y[4] = b1.x; y[5] = b1.y; y[6] = b1.z; y[7] = b1.w;
#pragma unroll
    for (int j = 0; j < 4; ++j) { float x[8]; unpack8(raw[j], x);
        const f32x4 c0 = *(const f32x4*)(cw + j * 512), c1 = *(const f32x4*)(cw + j * 512 + 4);
        y[0] += c0.x * x[0]; y[1] += c0.y * x[1]; y[2] += c0.z * x[2]; y[3] += c0.w * x[3]; y[4] += c1.x * x[4]; y[5] += c1.y * x[5]; y[6] += c1.z * x[6]; y[7] += c1.w * x[7]; }
#pragma unroll
    for (int i = 0; i < 8; ++i) y[i] = y[i] * sigmoid_f(y[i]) * scale;
}

__device__ __forceinline__ void p_mlstm_states_mfma(const Ctx& C, int l) {
    const bf16* proj = (const bf16*)(C.ws + WS_PROJ); const float* G = (const float*)(C.ws + WS_G);
    bf16* CST = (bf16*)(C.ws + WS_CST); float* NST = (float*)(C.ws + WS_NST); float* MLOC = (float*)(C.ws + WS_MISC); float* GCH = MLOC + 2048;
    const float* cw = C.in[I_CONVW] + (size_t)l * 4 * 512; const float* cb = C.in[I_CONVB] + (size_t)l * 512;
    LAS bf16* KeT = (LAS bf16*)(C.lds + RING_OFF);
    LAS bf16* Vt = KeT + 64 * TP;
    LAS float* ev = (LAS float*)(Vt + 128 * TP);
    const int tid = ltid(), lane = tid & 63, r = lane & 31, h = lane >> 5, s = tid & 63, cg = tid >> 6;
    v4u rk[4], rv[2]; float rig = 0.f, rfg = 0.f;
#define ST_FETCH(u_) do { const int bh_ = (u_) / NCH, c_ = (u_) % NCH, n0_ = (bh_ >> 2) * SEQ + c_ * CHUNK, hd_ = bh_ & 3; \
        conv_fetch(proj, n0_ + s, c_ * CHUNK + s, 1536 + 256 + hd_ * 64 + cg * 8, rk); const bf16* vp_ = proj + (size_t)(n0_ + s) * NPROJ + 2048 + hd_ * 128 + cg * 16; rv[0] = *(const v4u*)vp_; rv[1] = *(const v4u*)(vp_ + 8); \
        if (C.wave == 0) { rig = G[(size_t)(n0_ + lane) * 8 + hd_]; rfg = G[(size_t)(n0_ + lane) * 8 + 4 + hd_]; } } while (0)
    if (C.vcu < NBH * NCH) ST_FETCH(C.vcu);
    for (int u = C.vcu; u < NBH * NCH; u += C.G) {
        const int bh = u / NCH, hd = bh & 3;
        if (C.wave == 0) { const float ig = rig, fg = rfg;
            float bc = fminf(fg, 0.f) - log1pf(expf(-fabsf(fg)));
#pragma unroll
            for (int o = 1; o < 64; o <<= 1) { const float t = __shfl_up(bc, o); if (lane >= o) bc += t; }
            const float g = __shfl(bc, 63); const float w = g - bc + ig; const float m = wave_max(w);
            ev[lane] = __expf(w - m); if (lane == 0) { MLOC[u] = m; GCH[u] = g; } }
        __syncthreads();
        { float y[8]; conv_apply(rk, cw + 256 + hd * 64 + cg * 8, cb + 256 + hd * 64 + cg * 8, 1.0f, y);
            const float e = ev[s];
#pragma unroll
            for (int i = 0; i < 8; ++i) KeT[(cg * 8 + i) * TP + s] = (bf16)f2bf(y[i] * e);
            tr_store16(Vt, cg * 16, s, rv[0], rv[1]); }
        if (u + C.G < NBH * NCH) ST_FETCH(u + C.G);
        __syncthreads();
        { const int kb = C.wave & 1, vb = C.wave >> 1; f32x16 acc;
#pragma unroll
            for (int i = 0; i < 16; ++i) acc[i] = 0.f;
#pragma unroll
            for (int st = 0; st < 4; ++st) acc = MFMA32(frag_ld(KeT, kb * 32 + r, st, h), frag_ld(Vt, vb * 32 + r, st, h), acc);
            bf16* dst = CST + (size_t)u * 8192 + (size_t)(vb * 32 + r) * 64 + kb * 32 + 4 * h;
#pragma unroll
            for (int g = 0; g < 4; ++g) *(v2u*)(dst + 8 * g) = (v2u){pk2(acc[4 * g], acc[4 * g + 1]), pk2(acc[4 * g + 2], acc[4 * g + 3])}; }
        if (tid < 64) { float a = 0.f;
#pragma unroll 8
            for (int s_ = 0; s_ < 64; s_ += 2) { const unsigned w = *(const LAS unsigned*)(KeT + tid * TP + s_); a += bflo(w) + bfhi(w); }
            NST[(size_t)u * 64 + tid] = a; }
    }
#undef ST_FETCH
    __syncthreads();
}

__device__ __forceinline__ void p_mlstm_out_mfma(const Ctx& C, int l) {
    const bf16* proj = (const bf16*)(C.ws + WS_PROJ); const float* G = (const float*)(C.ws + WS_G);
    const bf16* CST = (const bf16*)(C.ws + WS_CST); const float* NST = (const float*)(C.ws + WS_NST); const float* MPREV = (const float*)(C.ws + WS_MISC) + 4096;
    bf16* MIXIN = (bf16*)(C.ws + WS_MIXIN);
    const float* cw = C.in[I_CONVW] + (size_t)l * 4 * 512; const float* cb = C.in[I_CONVB] + (size_t)l * 512;
    LAS bf16* Qt = (LAS bf16*)(C.lds + RING_OFF);
    LAS bf16* Kt = Qt + 64 * TP;
    LAS bf16* St = Kt + 64 * TP;
    LAS bf16* Vt = St + 64 * TP;
    LAS bf16* Ct = Vt + 128 * TP;
    LAS float* sv = (LAS float*)(Ct + 128 * TP);
    const int tid = ltid(), lane = tid & 63, r = lane & 31, h = lane >> 5;
    const int s = tid >> 3, cg = tid & 7, s2 = tid & 63, vg = tid >> 6, cv = tid >> 2, ck0 = (tid & 3) * 16, ot = (C.wave & 1) * 32 + r, ovb = C.wave >> 1;
    v4u rq[4], rk[4], rv[2], rc[2]; v2u ro[4], roc[4]; float rig = 0.f, rfg = 0.f, rmp = 0.f, rnp = 0.f;
#define OUT_FETCH(u_) do { const int bh_ = (u_) / NCH, c_ = (u_) % NCH, n0_ = (bh_ >> 2) * SEQ + c_ * CHUNK, hd_ = bh_ & 3; \
        conv_fetch(proj, n0_ + s, c_ * CHUNK + s, 1536 + hd_ * 64 + cg * 8, rq); conv_fetch(proj, n0_ + s, c_ * CHUNK + s, 1536 + 256 + hd_ * 64 + cg * 8, rk); \
        const bf16* vp_ = proj + (size_t)(n0_ + s2) * NPROJ + 2048 + hd_ * 128 + vg * 16; rv[0] = *(const v4u*)vp_; rv[1] = *(const v4u*)(vp_ + 8); \
        const v4u* cp_ = (const v4u*)(CST + (size_t)(u_) * 8192 + cv * 64 + ck0); rc[0] = cp_[0]; rc[1] = cp_[1]; \
        const bf16* op_ = proj + (size_t)(n0_ + ot) * NPROJ + 2560 + hd_ * 128 + ovb * 32 + 4 * h; _Pragma("unroll") for (int g_ = 0; g_ < 4; ++g_) ro[g_] = *(const v2u*)(op_ + 8 * g_); \
        if (C.wave == 0) { rig = G[(size_t)(n0_ + lane) * 8 + hd_]; rfg = G[(size_t)(n0_ + lane) * 8 + 4 + hd_]; rmp = MPREV[(u_)]; rnp = NST[(size_t)(u_) * 64 + lane]; } } while (0)
    if (C.vcu < NBH * NCH) OUT_FETCH(C.vcu);
    for (int u = C.vcu; u < NBH * NCH; u += C.G) {
        const int bh = u / NCH, c = u % NCH, b = bh >> 2, hd = bh & 3; const int n0 = b * SEQ + c * CHUNK;
        __syncthreads();
        { float y[8];
            conv_apply(rq, cw + hd * 64 + cg * 8, cb + hd * 64 + cg * 8, 0.125f, y); *(LAS v4u*)(Qt + s * TP + cg * 8) = pack8(y);
            conv_apply(rk, cw + 256 + hd * 64 + cg * 8, cb + 256 + hd * 64 + cg * 8, 1.0f, y); *(LAS v4u*)(Kt + s * TP + cg * 8) = pack8(y);
            tr_store16(Vt, vg * 16, s2, rv[0], rv[1]);
            *(LAS v4u*)(Ct + cv * TP + ck0) = rc[0]; *(LAS v4u*)(Ct + cv * TP + ck0 + 8) = rc[1];
#pragma unroll
            for (int g = 0; g < 4; ++g) roc[g] = ro[g]; }
        if (C.wave == 0) { const float ig = rig, fg = rfg; const float mp = rmp;
            float bc = fminf(fg, 0.f) - log1pf(expf(-fabsf(fg)));
#pragma unroll
            for (int o = 1; o < 64; o <<= 1) { const float t = __shfl_up(bc, o); if (lane >= o) bc += t; }
            const float a = ig - bc; float pm = a;
#pragma unroll
            for (int o = 1; o < 64; o <<= 1) { const float t = __shfl_up(pm, o); if (lane >= o) pm = fmaxf(pm, t); }
            const float mt = bc + fmaxf(mp, pm);
            sv[lane] = bc; sv[64 + lane] = a; sv[128 + lane] = mt; sv[192 + lane] = __expf(bc + mp - mt); sv[256 + lane] = rnp; }
        if (u + C.G < NBH * NCH) OUT_FETCH(u + C.G);
        __syncthreads();
        if (C.wave < 4) {
            const int sb = C.wave & 1, tb = C.wave >> 1; f32x16 x;
#pragma unroll
            for (int i = 0; i < 16; ++i) x[i] = 0.f;
#pragma unroll
            for (int st = 0; st < 4; ++st) x = MFMA32(frag_ld(Kt, sb * 32 + r, st, h), frag_ld(Qt, tb * 32 + r, st, h), x);
            const int t = tb * 32 + r; const float bt = sv[t] - sv[128 + t]; float dsum = 0.f;
#pragma unroll
            for (int g = 0; g < 4; ++g) { const int s0 = sb * 32 + 8 * g + 4 * h; float w[4];
#pragma unroll
                for (int i = 0; i < 4; ++i) { const int s = s0 + i; w[i] = (s <= t) ? x[4 * g + i] * __expf(sv[64 + s] + bt) : 0.f; }
                const unsigned p0 = pk2(w[0], w[1]), p1 = pk2(w[2], w[3]); dsum += (bflo(p0) + bfhi(p0)) + (bflo(p1) + bfhi(p1));
                *(LAS v2u*)(St + t * TP + s0) = (v2u){p0, p1}; }
            sv[384 + (sb * 2 + h) * 64 + t] = dsum;
        } else if (tid < 320) {
            const int t = tid - 256; float a = 0.f;
#pragma unroll 8
            for (int k = 0; k < 64; k += 2) { const unsigned w = *(const LAS unsigned*)(Qt + t * TP + k); a += bflo(w) * sv[256 + k] + bfhi(w) * sv[256 + k + 1]; }
            sv[320 + t] = a; }
        __syncthreads();
        {
            const int vb = C.wave >> 1, tb = C.wave & 1; f32x16 acc;
#pragma unroll
            for (int i = 0; i < 16; ++i) acc[i] = 0.f;
#pragma unroll
            for (int st = 0; st < 4; ++st) acc = MFMA32(frag_ld(Ct, vb * 32 + r, st, h), frag_ld(Qt, tb * 32 + r, st, h), acc);
            const int t = tb * 32 + r; const float iw = sv[192 + t];
#pragma unroll
            for (int i = 0; i < 16; ++i) acc[i] *= iw;
#pragma unroll
            for (int st = 0; st < 4; ++st) acc = MFMA32(frag_ld(Vt, vb * 32 + r, st, h), frag_ld(St, tb * 32 + r, st, h), acc);
            const float den = ((sv[384 + t] + sv[384 + 64 + t]) + (sv[384 + 128 + t] + sv[384 + 192 + t])) + iw * sv[320 + t];
            const float dn = 1.0f / fmaxf(fabsf(den), __expf(-sv[128 + t]));
            bf16* dst = MIXIN + (size_t)(n0 + t) * DMODEL + 512 + hd * 128 + vb * 32 + 4 * h;
#pragma unroll
            for (int g = 0; g < 4; ++g) { const v2u ow = roc[g]; const float o0 = bflo(ow.x), o1 = bfhi(ow.x), o2 = bflo(ow.y), o3 = bfhi(ow.y);
                *(v2u*)(dst + 8 * g) = (v2u){pk2(acc[4 * g] * dn * sigmoid_f(o0), acc[4 * g + 1] * dn * sigmoid_f(o1)), pk2(acc[4 * g + 2] * dn * sigmoid_f(o2), acc[4 * g + 3] * dn * sigmoid_f(o3))}; } }
    }
#undef OUT_FETCH
    __syncthreads();
}
constexpr size_t WS_TOTC = WS_CST + 32 * MiB;
constexpr size_t WS_TOTN = WS_NST + 512 * 1024;
constexpr int MS_DCUM = 6144, MS_TOTM = 8192, MS_TOTG = 8448;

__device__ __forceinline__ void p_mlstm_states_seq(const Ctx& C, int l) {
    const bf16* proj = (const bf16*)(C.ws + WS_PROJ); const float* G = (const float*)(C.ws + WS_G);
    bf16* CST = (bf16*)(C.ws + WS_CST); float* NST = (float*)(C.ws + WS_NST); float* MS = (float*)(C.ws + WS_MISC); float* MPREV = MS + 4096;
    float* TOTC = (float*)(C.ws + WS_TOTC); float* TOTN = (float*)(C.ws + WS_TOTN);
    const float* cw = C.in[I_CONVW] + (size_t)l * 4 * 512; const float* cb = C.in[I_CONVB] + (size_t)l * 512;
    LAS bf16* KeT0 = (LAS bf16*)(C.lds + RING_OFF);
    LAS bf16* Vt0 = KeT0 + 64 * TP;
    LAS bf16* KeT1 = Vt0 + 128 * TP; LAS bf16* Vt1 = KeT1 + 64 * TP;
    LAS float* ev0 = (LAS float*)(Vt1 + 128 * TP); LAS float* ev1 = ev0 + 80;
    const int tid = ltid(), lane = tid & 63, r = lane & 31, h = lane >> 5, s = tid & 63, cg = tid >> 6;
    v4u rkA[4], rvA[2], rkB[4], rvB[2]; float rigA = 0.f, rfgA = 0.f, rigB = 0.f, rfgB = 0.f;
#define ST_FETCH(u_, GW) do { const int bh_ = (u_) / NCH, c_ = (u_) % NCH, n0_ = (bh_ >> 2) * SEQ + c_ * CHUNK, hd_ = bh_ & 3; \
        conv_fetch(proj, n0_ + s, c_ * CHUNK + s, 1536 + 256 + hd_ * 64 + cg * 8, rk); const bf16* vp_ = proj + (size_t)(n0_ + s) * NPROJ + 2048 + hd_ * 128 + cg * 16; rv[0] = *(const v4u*)vp_; rv[1] = *(const v4u*)(vp_ + 8); \
        if (C.wave == (GW)) { rig = G[(size_t)(n0_ + lane) * 8 + hd_]; rfg = G[(size_t)(n0_ + lane) * 8 + 4 + hd_]; } } while (0)
#define ST_FETCH2(u_) do { { v4u (&rk)[4] = rkA; v4u (&rv)[2] = rvA; float& rig = rigA; float& rfg = rfgA; ST_FETCH((u_), 0); } \
        { v4u (&rk)[4] = rkB; v4u (&rv)[2] = rvB; float& rig = rigB; float& rfg = rfgB; ST_FETCH((u_) + 1, 1); } } while (0)
    for (int vc = C.vcu; vc < 256; vc += C.G) {
        const int bh = vc >> 3, hd = bh & 3, u0 = bh * NCH + (vc & 7) * 8;
        f32x16 crun; float nrun = 0.f, mrun = -INFINITY, drun = 0.f;
#pragma unroll
        for (int i = 0; i < 16; ++i) crun[i] = 0.f;
        ST_FETCH2(u0);
#pragma unroll 1
        for (int j = 0; j < 8; j += 2) {
            const int u = u0 + j;
            if (C.wave < 2) { const float ig = C.wave ? rigB : rigA, fg = C.wave ? rfgB : rfgA; LAS float* evw = C.wave ? ev1 : ev0;
                float bc = fminf(fg, 0.f) - log1pf(expf(-fabsf(fg)));
#pragma unroll
                for (int o = 1; o < 64; o <<= 1) { const float t = __shfl_up(bc, o); if (lane >= o) bc += t; }
                const float g = __shfl(bc, 63); const float w = g - bc + ig; const float m = wave_max(w);
                evw[lane] = __expf(w - m); if (lane == 0) { evw[64] = m; evw[65] = g; } }
            __syncthreads();
            { float y[8]; conv_apply(rkA, cw + 256 + hd * 64 + cg * 8, cb + 256 + hd * 64 + cg * 8, 1.0f, y);
                const float e = ev0[s];
#pragma unroll
                for (int i = 0; i < 8; ++i) KeT0[(cg * 8 + i) * TP + s] = (bf16)f2bf(y[i] * e);
                tr_store16(Vt0, cg * 16, s, rvA[0], rvA[1]); }
            { float y[8]; conv_apply(rkB, cw + 256 + hd * 64 + cg * 8, cb + 256 + hd * 64 + cg * 8, 1.0f, y);
                const float e = ev1[s];
#pragma unroll
                for (int i = 0; i < 8; ++i) KeT1[(cg * 8 + i) * TP + s] = (bf16)f2bf(y[i] * e);
                tr_store16(Vt1, cg * 16, s, rvB[0], rvB[1]); }
            const float mloc0 = ev0[64], gch0 = ev0[65], mloc1 = ev1[64], gch1 = ev1[65];
            if (j < 6) ST_FETCH2(u + 2);
            __syncthreads();
            const float mnew0 = fmaxf(gch0 + mrun, mloc0), fa0 = __expf(gch0 + mrun - mnew0), fb0 = __expf(mloc0 - mnew0);
            const float mnew1 = fmaxf(gch1 + mnew0, mloc1), fa1 = __expf(gch1 + mnew0 - mnew1), fb1 = __expf(mloc1 - mnew1);
            { const int kb = C.wave & 1, vb = C.wave >> 1; f32x16 acc0, acc1;
#pragma unroll
                for (int i = 0; i < 16; ++i) { acc0[i] = 0.f; acc1[i] = 0.f; }
#pragma unroll
                for (int st = 0; st < 4; ++st) { acc0 = MFMA32(frag_ld(KeT0, kb * 32 + r, st, h), frag_ld(Vt0, vb * 32 + r, st, h), acc0); acc1 = MFMA32(frag_ld(KeT1, kb * 32 + r, st, h), frag_ld(Vt1, vb * 32 + r, st, h), acc1); }
                bf16* dst = CST + (size_t)u * 8192 + (size_t)(vb * 32 + r) * 64 + kb * 32 + 4 * h;
#pragma unroll
                for (int g = 0; g < 4; ++g) *(v2u*)(dst + 8 * g) = (v2u){pk2(crun[4 * g], crun[4 * g + 1]), pk2(crun[4 * g + 2], crun[4 * g + 3])};
#pragma unroll
                for (int i = 0; i < 16; ++i) crun[i] = fa0 * crun[i] + fb0 * acc0[i];
#pragma unroll
                for (int g = 0; g < 4; ++g) *(v2u*)(dst + 8192 + 8 * g) = (v2u){pk2(crun[4 * g], crun[4 * g + 1]), pk2(crun[4 * g + 2], crun[4 * g + 3])};
#pragma unroll
                for (int i = 0; i < 16; ++i) crun[i] = fa1 * crun[i] + fb1 * acc1[i]; }
            if (tid < 64) { float a0 = 0.f, a1 = 0.f;
#pragma unroll 8
                for (int s_ = 0; s_ < 64; s_ += 2) { const unsigned w0 = *(const LAS unsigned*)(KeT0 + tid * TP + s_), w1 = *(const LAS unsigned*)(KeT1 + tid * TP + s_); a0 += bflo(w0) + bfhi(w0); a1 += bflo(w1) + bfhi(w1); }
                NST[(size_t)u * 64 + tid] = nrun; nrun = fa0 * nrun + fb0 * a0; NST[(size_t)(u + 1) * 64 + tid] = nrun; nrun = fa1 * nrun + fb1 * a1; }
            if (tid == 0) { MPREV[u] = mrun; MS[MS_DCUM + u] = drun; MPREV[u + 1] = mnew0; MS[MS_DCUM + u + 1] = drun + gch0; }
            mrun = mnew1; drun += gch0; drun += gch1;
        }
        { const int kb = C.wave & 1, vb = C.wave >> 1; float* dst = TOTC + (size_t)vc * 8192 + (size_t)(vb * 32 + r) * 64 + kb * 32 + 4 * h;
#pragma unroll
            for (int g = 0; g < 4; ++g) *(f32x4*)(dst + 8 * g) = (f32x4){crun[4 * g], crun[4 * g + 1], crun[4 * g + 2], crun[4 * g + 3]}; }
        if (tid < 64) TOTN[vc * 64 + tid] = nrun;
        if (tid == 0) { MS[MS_TOTM + vc] = mrun; MS[MS_TOTG + vc] = drun; }
    }
#undef ST_FETCH
#undef ST_FETCH2
    __syncthreads();
}

__device__ __forceinline__ void p_mlstm_out_seq(const Ctx& C, int l) {
    const bf16* proj = (const bf16*)(C.ws + WS_PROJ); const float* G = (const float*)(C.ws + WS_G);
    const bf16* CST = (const bf16*)(C.ws + WS_CST); const float* NST = (const float*)(C.ws + WS_NST); const float* MS = (const float*)(C.ws + WS_MISC); const float* MPREV = MS + 4096;
    const float* TOTC = (const float*)(C.ws + WS_TOTC); const float* TOTN = (const float*)(C.ws + WS_TOTN);
    bf16* MIXIN = (bf16*)(C.ws + WS_MIXIN);
    const float* cw = C.in[I_CONVW] + (size_t)l * 4 * 512; const float* cb = C.in[I_CONVB] + (size_t)l * 512;
    LAS bf16* Qt = (LAS bf16*)(C.lds + RING_OFF);
    LAS bf16* Kt = Qt + 64 * TP;
    LAS bf16* St = Kt + 64 * TP;
    LAS bf16* Vt = St + 64 * TP;
    LAS bf16* Ct = Vt + 128 * TP;
    LAS float* sv = (LAS float*)(Ct + 128 * TP);
    const int tid = ltid(), lane = tid & 63, r = lane & 31, h = lane >> 5;
    const int s = tid >> 3, cg = tid & 7, s2 = tid & 63, vg = tid >> 6, cv = tid >> 2, ck0 = (tid & 3) * 16, ot = (C.wave & 1) * 32 + r, ovb = C.wave >> 1;
    v4u rq[4], rk[4], rv[2], rc[2], ro[2], rop[2]; float rig = 0.f, rfg = 0.f, rml = 0.f, rdc = 0.f, rnp = 0.f;
    LAS float* Os = sv + 640;
    static_assert((3 * 64 + 2 * 128) * TP * 2 + 640 * 4 + 64 * 132 * 4 <= RING_BYTES, "mLSTM LDS");
#define OUT_FETCH(u_) do { const int bh_ = (u_) / NCH, c_ = (u_) % NCH, n0_ = (bh_ >> 2) * SEQ + c_ * CHUNK, hd_ = bh_ & 3; \
        conv_fetch(proj, n0_ + s, c_ * CHUNK + s, 1536 + hd_ * 64 + cg * 8, rq); conv_fetch(proj, n0_ + s, c_ * CHUNK + s, 1536 + 256 + hd_ * 64 + cg * 8, rk); \
        const bf16* vp_ = proj + (size_t)(n0_ + s2) * NPROJ + 2048 + hd_ * 128 + vg * 16; rv[0] = *(const v4u*)vp_; rv[1] = *(const v4u*)(vp_ + 8); \
        const v4u* cp_ = (const v4u*)(CST + (size_t)(u_) * 8192 + cv * 64 + ck0); rc[0] = cp_[0]; rc[1] = cp_[1]; \
        const bf16* op_ = proj + (size_t)(n0_ + s) * NPROJ + 2560 + hd_ * 128 + cg * 16; ro[0] = *(const v4u*)op_; ro[1] = *(const v4u*)(op_ + 8); \
        rml = MPREV[(u_)]; rdc = MS[MS_DCUM + (u_)]; \
        if (C.wave == 0) { rig = G[(size_t)(n0_ + lane) * 8 + hd_]; rfg = G[(size_t)(n0_ + lane) * 8 + 4 + hd_]; rnp = NST[(size_t)(u_) * 64 + lane]; } } while (0)
#define OUT_FLUSH(nb_) do { float hv_[16], og_[16]; const LAS f32x4* hp_ = (const LAS f32x4*)(Os + s * 132 + cg * 16); \
        _Pragma("unroll") for (int q_ = 0; q_ < 4; ++q_) { const f32x4 t4_ = hp_[q_]; hv_[4 * q_] = t4_.x; hv_[4 * q_ + 1] = t4_.y; hv_[4 * q_ + 2] = t4_.z; hv_[4 * q_ + 3] = t4_.w; } \
        unpack8(rop[0], og_); unpack8(rop[1], og_ + 8); _Pragma("unroll") for (int i_ = 0; i_ < 16; ++i_) hv_[i_] *= sigmoid_f(og_[i_]); \
        bf16* dp_ = MIXIN + (size_t)((nb_) + s) * DMODEL + 512 + hd * 128 + cg * 16; *(v4u*)dp_ = pack8(hv_); *(v4u*)(dp_ + 8) = pack8(hv_ + 8); } while (0)
    for (int vc = C.vcu; vc < 256; vc += C.G) {
        const int bh = vc >> 3, gi = vc & 7, b = bh >> 2, hd = bh & 3, u0 = bh * NCH + gi * 8;
        OUT_FETCH(u0);
        float cin[16], nin = 0.f, min_ = -INFINITY;
#pragma unroll
        for (int i = 0; i < 16; ++i) cin[i] = 0.f;
#pragma unroll 1
        for (int g2 = 0; g2 < gi; ++g2) { const int gv = (bh << 3) + g2; const float tm = MS[MS_TOTM + gv], tg = MS[MS_TOTG + gv];
            const f32x4* tp = (const f32x4*)(TOTC + (size_t)gv * 8192 + cv * 64 + ck0); const f32x4 t0 = tp[0], t1 = tp[1], t2 = tp[2], t3 = tp[3]; const float tn = (C.wave == 0) ? TOTN[gv * 64 + lane] : 0.f;
            const float mn = fmaxf(tg + min_, tm), fa = __expf(tg + min_ - mn), fb = __expf(tm - mn);
            const float tt[16] = {t0.x, t0.y, t0.z, t0.w, t1.x, t1.y, t1.z, t1.w, t2.x, t2.y, t2.z, t2.w, t3.x, t3.y, t3.z, t3.w};
#pragma unroll
            for (int i = 0; i < 16; ++i) cin[i] = fa * cin[i] + fb * tt[i];
            nin = fa * nin + fb * tn; min_ = mn; }
#pragma unroll 1
        for (int j = 0; j < 8; ++j) {
            const int u = u0 + j, c = gi * 8 + j; const int n0 = b * SEQ + c * CHUNK;
            const float mp = fmaxf(rdc + min_, rml); const float w1 = (min_ == -INFINITY) ? 0.f : __expf(rdc + min_ - mp), w2 = (rml == -INFINITY) ? 0.f : __expf(rml - mp);
            __syncthreads();
            if (j > 0) OUT_FLUSH(n0 - CHUNK);
            { float y[8];
                conv_apply(rq, cw + hd * 64 + cg * 8, cb + hd * 64 + cg * 8, 0.125f, y); *(LAS v4u*)(Qt + s * TP + cg * 8) = pack8(y);
                conv_apply(rk, cw + 256 + hd * 64 + cg * 8, cb + 256 + hd * 64 + cg * 8, 1.0f, y); *(LAS v4u*)(Kt + s * TP + cg * 8) = pack8(y);
                tr_store16(Vt, vg * 16, s2, rv[0], rv[1]);
                float cl[16]; unpack8(rc[0], cl); unpack8(rc[1], cl + 8);
#pragma unroll
                for (int i = 0; i < 16; ++i) cl[i] = w1 * cin[i] + w2 * cl[i];
                *(LAS v4u*)(Ct + cv * TP + ck0) = pack8(cl); *(LAS v4u*)(Ct + cv * TP + ck0 + 8) = pack8(cl + 8);
                rop[0] = ro[0]; rop[1] = ro[1]; }
            if (C.wave == 0) { const float ig = rig, fg = rfg;
                float bc = fminf(fg, 0.f) - log1pf(expf(-fabsf(fg)));
#pragma unroll
                for (int o = 1; o < 64; o <<= 1) { const float t = __shfl_up(bc, o); if (lane >= o) bc += t; }
                const float a = ig - bc; float pm = a;
#pragma unroll
                for (int o = 1; o < 64; o <<= 1) { const float t = __shfl_up(pm, o); if (lane >= o) pm = fmaxf(pm, t); }
                const float mt = bc + fmaxf(mp, pm);
                sv[lane] = bc; sv[64 + lane] = a; sv[128 + lane] = mt; sv[192 + lane] = __expf(bc + mp - mt); sv[256 + lane] = w1 * nin + w2 * rnp; }
            if (j < 7) OUT_FETCH(u + 1);
            __syncthreads();
            if (C.wave < 4) {
                const int sb = C.wave & 1, tb = C.wave >> 1; f32x16 x;
#pragma unroll
                for (int i = 0; i < 16; ++i) x[i] = 0.f;
#pragma unroll
                for (int st = 0; st < 4; ++st) x = MFMA32(frag_ld(Kt, sb * 32 + r, st, h), frag_ld(Qt, tb * 32 + r, st, h), x);
                const int t = tb * 32 + r; const float bt = sv[t] - sv[128 + t]; float dsum = 0.f;
#pragma unroll
                for (int g = 0; g < 4; ++g) { const int s0 = sb * 32 + 8 * g + 4 * h; float w[4];
#pragma unroll
                    for (int i = 0; i < 4; ++i) { const int ss = s0 + i; w[i] = (ss <= t) ? x[4 * g + i] * __expf(sv[64 + ss] + bt) : 0.f; }
                    const unsigned p0 = pk2(w[0], w[1]), p1 = pk2(w[2], w[3]); dsum += (bflo(p0) + bfhi(p0)) + (bflo(p1) + bfhi(p1));
                    *(LAS v2u*)(St + t * TP + s0) = (v2u){p0, p1}; }
                sv[384 + (sb * 2 + h) * 64 + t] = dsum;
            } else if (tid < 320) {
                const int t = tid - 256; float a = 0.f;
#pragma unroll 8
                for (int k = 0; k < 64; k += 2) { const unsigned w = *(const LAS unsigned*)(Qt + t * TP + k); a += bflo(w) * sv[256 + k] + bfhi(w) * sv[256 + k + 1]; }
                sv[320 + t] = a; }
            __syncthreads();
            {
                const int vb = C.wave >> 1, tb = C.wave & 1; f32x16 acc;
#pragma unroll
                for (int i = 0; i < 16; ++i) acc[i] = 0.f;
#pragma unroll
                for (int st = 0; st < 4; ++st) acc = MFMA32(frag_ld(Ct, vb * 32 + r, st, h), frag_ld(Qt, tb * 32 + r, st, h), acc);
                const int t = tb * 32 + r; const float iw = sv[192 + t];
#pragma unroll
                for (int i = 0; i < 16; ++i) acc[i] *= iw;
#pragma unroll
                for (int st = 0; st < 4; ++st) acc = MFMA32(frag_ld(Vt, vb * 32 + r, st, h), frag_ld(St, tb * 32 + r, st, h), acc);
                const float den = ((sv[384 + t] + sv[384 + 64 + t]) + (sv[384 + 128 + t] + sv[384 + 192 + t])) + iw * sv[320 + t];
                const float dn = 1.0f / fmaxf(fabsf(den), __expf(-sv[128 + t]));
                LAS float* od = Os + t * 132 + vb * 32 + 4 * h;
#pragma unroll
                for (int g = 0; g < 4; ++g) *(LAS f32x4*)(od + 8 * g) = (f32x4){acc[4 * g] * dn, acc[4 * g + 1] * dn, acc[4 * g + 2] * dn, acc[4 * g + 3] * dn}; }
        }
        __syncthreads();
        OUT_FLUSH(b * SEQ + (gi * 8 + 7) * CHUNK);
    }
#undef OUT_FETCH
#undef OUT_FLUSH
    __syncthreads();
}
template <int W> __device__ __forceinline__ void tr_reduce_step(float* val, bool bit, int mask) {
#pragma unroll
    for (int i = 0; i < W / 2; ++i) { const float keep = bit ? val[i + W / 2] : val[i], send = bit ? val[i] : val[i + W / 2]; val[i] = keep + __shfl_xor(send, mask); }
}
__device__ __forceinline__ void p_ln1_router(const Ctx& C, int l, bool claim = true, bool norouter = false, bool nostore = false, bool norows = false, int stsel = 3) {
    const bf16* XBr = (const bf16*)(C.ws + WS_XB); const unsigned char* XLO = (const unsigned char*)(C.ws + WS_XRES);
    const bf16* MIXO = (const bf16*)(C.ws + WS_MIXO); float* X1 = (float*)(C.ws + WS_X1); unsigned char* X1Q = (unsigned char*)(C.ws + WS_X1B);
    int* TOKE = (int*)(C.ws + WS_TOKE); int* TOKP = (int*)(C.ws + WS_TOKP); float* TOKG = (float*)(C.ws + WS_TOKG); int* ROWTOK = (int*)(C.ws + WS_ROWTOK);
    unsigned* cntg = (unsigned*)(C.ws + WS_CTL) + CW_CNT + 64 * l;
    const float* br = C.in[I_BR] + l * NEXP;
    LAS f32x4* wl = (LAS f32x4*)(C.lds + RING_OFF);
    LAS float* lg = (LAS float*)(C.lds + LDSX_OFF) + C.wave * (16 * 32);
    LAS int* lc = (LAS int*)(C.lds + LDSX_OFF + 8 * 16 * 32 * 4);
    const int tid = ltid(), lane = tid & 63;
    { const f32x4* WRP = (const f32x4*)(C.ws + WS_WRP) + (size_t)l * 8192;
        for (int idx = tid; idx < 8192; idx += NTHREADS) wl[idx] = WRP[idx]; }
    LAS f32x4* gbl = (LAS f32x4*)(C.lds + LDSX_OFF + 8 * 16 * 32 * 4 + 512);
    { float g_[16], b_[16]; load_vec16(C.in[I_LN1G] + l * DMODEL, lane, g_); load_vec16(C.in[I_LN1B] + l * DMODEL, lane, b_);
      if (C.wave == 0) {
#pragma unroll
        for (int q = 0; q < 4; ++q) { gbl[q * 64 + lane] = (f32x4){g_[4 * q], g_[4 * q + 1], g_[4 * q + 2], g_[4 * q + 3]}; gbl[(4 + q) * 64 + lane] = (f32x4){b_[4 * q], b_[4 * q + 1], b_[4 * q + 2], b_[4 * q + 3]}; } } }
    const int gw = C.vcu * NWAVES + C.wave, NGW = C.G * NWAVES, NGRP = NTOK / 4;
    for (int g0 = gw; g0 < NGRP; g0 += 4 * NGW) {
        if (tid < 64) lc[tid] = 0;
        __syncthreads();
        v4u pxb[4][2], pmx[4][2]; v2u plo[4][2] = {};
#define LN1_FETCH(grp_) do { _Pragma("unroll") for (int r = 0; r < 4; ++r) { const size_t n_ = (size_t)((grp_) * 4 + r) * DMODEL; \
            pxb[r][0] = __builtin_nontemporal_load((const v4u*)(XBr + n_ + 8 * lane)); pxb[r][1] = __builtin_nontemporal_load((const v4u*)(XBr + n_ + 512 + 8 * lane)); if (USE_XLO) { plo[r][0] = *(const v2u*)(XLO + n_ + 8 * lane); plo[r][1] = *(const v2u*)(XLO + n_ + 512 + 8 * lane); } \
            pmx[r][0] = __builtin_nontemporal_load((const v4u*)(MIXO + n_ + 8 * lane)); pmx[r][1] = __builtin_nontemporal_load((const v4u*)(MIXO + n_ + 512 + 8 * lane)); } } while (0)
        LN1_FETCH(g0);
#pragma unroll 1
        for (int blk = norows ? 4 : 0; blk < 4; ++blk) {
            const int grp = g0 + blk * NGW; if (grp >= NGRP) break;
            float xv[4][16];
#pragma unroll
            for (int r = 0; r < 4; ++r) { const size_t n = (size_t)(grp * 4 + r); float m[16]; typedef float f32x2_ __attribute__((ext_vector_type(2)));
                unpack8(pxb[r][0], xv[r]); unpack8(pxb[r][1], xv[r] + 8); unpack8(pmx[r][0], m); unpack8(pmx[r][1], m + 8);
                const unsigned w_[4] = {plo[r][0].x, plo[r][0].y, plo[r][1].x, plo[r][1].y};
#pragma unroll
                for (int i = 0; i < (USE_XLO ? 4 : 0); ++i) { const f32x2_ lo = __builtin_amdgcn_cvt_pk_f32_fp8((int)w_[i], false), hi = __builtin_amdgcn_cvt_pk_f32_fp8((int)w_[i], true);
                    xv[r][4 * i] += lo.x * (1.0f / XLO_SCALE); xv[r][4 * i + 1] += lo.y * (1.0f / XLO_SCALE); xv[r][4 * i + 2] += hi.x * (1.0f / XLO_SCALE); xv[r][4 * i + 3] += hi.y * (1.0f / XLO_SCALE); }
#pragma unroll
                for (int i = 0; i < 16; ++i) xv[r][i] = DN_ALPHA * xv[r][i] + m[i];
                { float gam[16], bet[16];
#pragma unroll
                  for (int q = 0; q < 4; ++q) { const f32x4 g4_ = gbl[q * 64 + lane], b4_ = gbl[(4 + q) * 64 + lane]; gam[4 * q] = g4_.x; gam[4 * q + 1] = g4_.y; gam[4 * q + 2] = g4_.z; gam[4 * q + 3] = g4_.w; bet[4 * q] = b4_.x; bet[4 * q + 1] = b4_.y; bet[4 * q + 2] = b4_.z; bet[4 * q + 3] = b4_.w; }
                  ln_row(xv[r], gam, bet); }
                if (!nostore) { typedef float f32x2q __attribute__((ext_vector_type(2)));
                    const v2u p0 = pack8_fp8(xv[r], XQ_SCALE), p1 = pack8_fp8(xv[r] + 8, XQ_SCALE); __builtin_nontemporal_store(p0, (v2u*)(X1Q + n * DMODEL + 8 * lane)); __builtin_nontemporal_store(p1, (v2u*)(X1Q + n * DMODEL + 512 + 8 * lane));
                    const unsigned pw_[4] = {p0.x, p0.y, p1.x, p1.y}; float rem_[16];
#pragma unroll
                    for (int i = 0; i < 4; ++i) { const f32x2q lo = __builtin_amdgcn_cvt_pk_f32_fp8((int)pw_[i], false), hi = __builtin_amdgcn_cvt_pk_f32_fp8((int)pw_[i], true);
                        rem_[4 * i] = xv[r][4 * i] - lo.x * (1.0f / XQ_SCALE); rem_[4 * i + 1] = xv[r][4 * i + 1] - lo.y * (1.0f / XQ_SCALE); rem_[4 * i + 2] = xv[r][4 * i + 2] - hi.x * (1.0f / XQ_SCALE); rem_[4 * i + 3] = xv[r][4 * i + 3] - hi.y * (1.0f / XQ_SCALE); }
                    if (MK_X1R8) { unsigned char* rr_ = (unsigned char*)X1 + n * DMODEL; __builtin_nontemporal_store(pack8_fp8(rem_, X1R_SCALE), (v2u*)(rr_ + 8 * lane)); __builtin_nontemporal_store(pack8_fp8(rem_ + 8, X1R_SCALE), (v2u*)(rr_ + 512 + 8 * lane)); }
                    else { bf16* rr_ = (bf16*)X1 + n * DMODEL; __builtin_nontemporal_store(pack8(rem_), (v4u*)(rr_ + 8 * lane)); __builtin_nontemporal_store(pack8(rem_ + 8), (v4u*)(rr_ + 512 + 8 * lane)); }   } else if (xv[r][0] == 123.456f) X1[n * DMODEL + lane] = xv[r][1]; }
            if (blk < 3 && g0 + (blk + 1) * NGW < NGRP) LN1_FETCH(g0 + (blk + 1) * NGW);
            typedef float f32x2p __attribute__((ext_vector_type(2)));
            f32x2p xa[16], xb[16];
#pragma unroll
            for (int i = 0; i < 16; ++i) { xa[i] = (f32x2p){xv[0][i], xv[1][i]}; xb[i] = (f32x2p){xv[2][i], xv[3][i]}; }
#pragma unroll 1
            for (int q = norouter ? 4 : 0; q < 4; ++q) {
                float acc[32];
#pragma unroll
                for (int e = 0; e < 8; ++e) { const LAS f32x4* wp = wl + ((q * 8 + e) * 4) * 64 + lane; const f32x4 w0 = wp[0], w1 = wp[64], w2 = wp[128], w3 = wp[192];
                    const float ww[16] = {w0.x, w0.y, w0.z, w0.w, w1.x, w1.y, w1.z, w1.w, w2.x, w2.y, w2.z, w2.w, w3.x, w3.y, w3.z, w3.w};
                    f32x2p a = xa[0] * ww[0], b = xb[0] * ww[0];
#pragma unroll
                    for (int i = 1; i < 16; ++i) { a += xa[i] * ww[i]; b += xb[i] * ww[i]; }
                    acc[0 * 8 + e] = a.x; acc[1 * 8 + e] = a.y; acc[2 * 8 + e] = b.x; acc[3 * 8 + e] = b.y; }
                tr_reduce_step<32>(acc, (lane >> 4) & 1, 16); tr_reduce_step<16>(acc, (lane >> 3) & 1, 8); tr_reduce_step<8>(acc, (lane >> 2) & 1, 4); tr_reduce_step<4>(acc, (lane >> 1) & 1, 2); tr_reduce_step<2>(acc, lane & 1, 1);
                const float tot = acc[0] + __shfl_xor(acc[0], 32);
                if (lane < 32) lg[(blk * 4 + (lane >> 3)) * 32 + q * 8 + (lane & 7)] = tot + br[q * 8 + (lane & 7)];
            }
        }
#undef LN1_FETCH
        LDS_WAIT(); asm volatile("" ::: "memory");
        int te[4] = {0, 0, 0, 0}, tp[4] = {0, 0, 0, 0}; float tg[4] = {0.f, 0.f, 0.f, 0.f};
        if (lane < 16 && (g0 + (lane >> 2) * NGW) < NGRP) {
            float lv[32];
#pragma unroll
            for (int e = 0; e < 32; ++e) lv[e] = lg[lane * 32 + e];
            unsigned taken = 0u; float val[4];
#pragma unroll
            for (int k = 0; k < 4; ++k) { int bi = 0; float bv = -INFINITY;
#pragma unroll
                for (int e = 0; e < 32; ++e) { const bool ok = !((taken >> e) & 1u) && (lv[e] > bv); bv = ok ? lv[e] : bv; bi = ok ? e : bi; }
                te[k] = bi; val[k] = bv; taken |= 1u << bi; }
            float s = 0.f;
#pragma unroll
            for (int k = 0; k < 4; ++k) { tg[k] = expf(val[k] - val[0]); s += tg[k]; }
#pragma unroll
            for (int k = 0; k < 4; ++k) { tg[k] = tg[k] / s; tp[k] = __hip_atomic_fetch_add(lc + te[k], 1, __ATOMIC_RELAXED, __HIP_MEMORY_SCOPE_WORKGROUP); }
        }
        __syncthreads();
        if (tid < 32 && claim) lc[32 + tid] = (int)__hip_atomic_fetch_add(cntg + tid, (unsigned)lc[tid], __ATOMIC_RELAXED, __HIP_MEMORY_SCOPE_AGENT);
        __syncthreads();
        const int mygrp = g0 + (lane >> 2) * NGW;
        if (lane < 16 && claim && mygrp < NGRP) { const int n = mygrp * 4 + (lane & 3);
#pragma unroll
            for (int k = 0; k < 4; ++k) { const int pos = lc[32 + te[k]] + tp[k]; TOKE[n * 4 + k] = te[k]; TOKP[n * 4 + k] = pos; TOKG[n * 4 + k] = tg[k]; ROWTOK[(size_t)te[k] * NTOK + pos] = n; } }
        __syncthreads();
    }
}

__device__ __forceinline__ void moe_tables(const Ctx& C, int l) {
    LAS int* ts = (LAS int*)(C.lds + LDSCTL_OFF); LAS int* cn = (LAS int*)(C.lds + LDSCTL_OFF + 160);
    const unsigned* cntg = (const unsigned*)(C.ws + WS_CTL) + CW_CNT + 64 * l;
    const int tid = ltid();
    if (tid < 64) { const int lane = tid; const int c = (lane < 32) ? (int)__hip_atomic_load(cntg + lane, __ATOMIC_RELAXED, __HIP_MEMORY_SCOPE_AGENT) : 0; int t = (c + 255) >> 8;
        int inc = t;
#pragma unroll
        for (int o = 1; o < 64; o <<= 1) { const int x = __shfl_up(inc, o); if (lane >= o) inc += x; }
        if (lane < 32) { cn[lane] = c; ts[lane] = inc - t; } if (lane == 32) ts[32] = inc; }
    __syncthreads();
}

__device__ __forceinline__ void p_ln2_combine(const Ctx& C, int l) {
    const bf16* X1 = (const bf16*)(C.ws + WS_X1); const unsigned char* X1Q = (const unsigned char*)(C.ws + WS_X1B); const unsigned char* Y = (const unsigned char*)(C.ws + WS_Y);
    const int* TOKE = (const int*)(C.ws + WS_TOKE); const int* TOKP = (const int*)(C.ws + WS_TOKP); const float* TOKG = (const float*)(C.ws + WS_TOKG);
    float* xo = C.out; unsigned char* XLOw = (unsigned char*)(C.ws + WS_XRES); bf16* XB = (bf16*)(C.ws + WS_XB); float* G = (float*)(C.ws + WS_G);
    const LAS int* ts = (const LAS int*)(C.lds + LDSCTL_OFF);
    LAS f32x4* wgl = (LAS f32x4*)(C.lds + RING_OFF);
    const int tid = ltid(), lane = tid & 63, gw = C.vcu * NWAVES + C.wave, NGW = C.G * NWAVES; const bool nextl = (l + 1 < DEPTH);
    if (nextl) load_gate_w(tid, C.in[I_WIN] + (size_t)(l + 1) * DMODEL * INW, wgl);
    __syncthreads();
    float gam[16], bet[16]; load_vec16(C.in[I_LN2G] + l * DMODEL, lane, gam); load_vec16(C.in[I_LN2B] + l * DMODEL, lane, bet);
    typedef int i32x4_ __attribute__((ext_vector_type(4)));
    i32x4_ ne[2], np[2]; f32x4 ng_[2];
#define LN2_ROUTE(n0_) do { _Pragma("unroll") for (int q = 0; q < 2; ++q) { int nn = (n0_) + q * NGW; nn = nn < NTOK ? nn : (NTOK - 1); ne[q] = *(const i32x4_*)(TOKE + nn * 4); np[q] = *(const i32x4_*)(TOKP + nn * 4); ng_[q] = *(const f32x4*)(TOKG + nn * 4); } } while (0)
    LN2_ROUTE(gw);
    for (int n = gw; n < NTOK; n += 2 * NGW) {
        v4u xr[2][2]; v2u xr8[2][2]; v2u xq[2][2]; v2u yr[2][4][2]; f32x4 g4[2]; int nrow[2];
#pragma unroll
        for (int q = 0; q < 2; ++q) { int nn = n + q * NGW; nn = nn < NTOK ? nn : (NTOK - 1); nrow[q] = nn; g4[q] = ng_[q];
            if (MK_X1R8) { const unsigned char* xp = (const unsigned char*)X1 + (size_t)nn * DMODEL; xr8[q][0] = __builtin_nontemporal_load((const v2u*)(xp + 8 * lane)); xr8[q][1] = __builtin_nontemporal_load((const v2u*)(xp + 512 + 8 * lane)); }
            else { const bf16* xp = X1 + (size_t)nn * DMODEL; xr[q][0] = __builtin_nontemporal_load((const v4u*)(xp + 8 * lane)); xr[q][1] = __builtin_nontemporal_load((const v4u*)(xp + 512 + 8 * lane)); }
            const unsigned char* xqp = X1Q + (size_t)nn * DMODEL; xq[q][0] = __builtin_nontemporal_load((const v2u*)(xqp + 8 * lane)); xq[q][1] = __builtin_nontemporal_load((const v2u*)(xqp + 512 + 8 * lane));
#pragma unroll
            for (int k = 0; k < 4; ++k) { const unsigned char* yp = Y + ((size_t)ts[ne[q][k]] * 256 + np[q][k]) * DMODEL; yr[q][k][0] = __builtin_nontemporal_load((const v2u*)(yp + 8 * lane)); yr[q][k][1] = __builtin_nontemporal_load((const v2u*)(yp + 512 + 8 * lane)); } }
        if (n + 2 * NGW < NTOK) LN2_ROUTE(n + 2 * NGW);
#pragma unroll
        for (int q = 0; q < 2; ++q) {
            if (q == 1 && n + NGW >= NTOK) break;
            typedef float f32x2_ __attribute__((ext_vector_type(2)));
            float v[16];
            if (MK_X1R8) { const unsigned w[4] = {xr8[q][0].x, xr8[q][0].y, xr8[q][1].x, xr8[q][1].y};
#pragma unroll
              for (int i = 0; i < 4; ++i) { const f32x2_ lo = __builtin_amdgcn_cvt_pk_f32_fp8((int)w[i], false), hi = __builtin_amdgcn_cvt_pk_f32_fp8((int)w[i], true);
                  v[4 * i] = lo.x * (1.0f / X1R_SCALE); v[4 * i + 1] = lo.y * (1.0f / X1R_SCALE); v[4 * i + 2] = hi.x * (1.0f / X1R_SCALE); v[4 * i + 3] = hi.y * (1.0f / X1R_SCALE); } }
            else { unpack8(xr[q][0], v); unpack8(xr[q][1], v + 8); }
            { const unsigned w[4] = {xq[q][0].x, xq[q][0].y, xq[q][1].x, xq[q][1].y};
#pragma unroll
              for (int i = 0; i < 4; ++i) { const f32x2_ lo = __builtin_amdgcn_cvt_pk_f32_fp8((int)w[i], false), hi = __builtin_amdgcn_cvt_pk_f32_fp8((int)w[i], true);
                  v[4 * i] += lo.x * (1.0f / XQ_SCALE); v[4 * i + 1] += lo.y * (1.0f / XQ_SCALE); v[4 * i + 2] += hi.x * (1.0f / XQ_SCALE); v[4 * i + 3] += hi.y * (1.0f / XQ_SCALE); } }
#pragma unroll
            for (int i = 0; i < 16; ++i) v[i] *= DN_ALPHA;
#pragma unroll
            for (int k = 0; k < 4; ++k) { const float gk = g4[q][k] * (1.0f / YQ_SCALE); const unsigned w[4] = {yr[q][k][0].x, yr[q][k][0].y, yr[q][k][1].x, yr[q][k][1].y};
#pragma unroll
                for (int i = 0; i < 4; ++i) { const f32x2_ lo = __builtin_amdgcn_cvt_pk_f32_fp8((int)w[i], false), hi = __builtin_amdgcn_cvt_pk_f32_fp8((int)w[i], true);
                    v[4 * i] += gk * lo.x; v[4 * i + 1] += gk * lo.y; v[4 * i + 2] += gk * hi.x; v[4 * i + 3] += gk * hi.y; } }
            ln_row(v, gam, bet);
            const int nn = nrow[q];
            if (!nextl) store_row_f32_nt(xo + (size_t)nn * DMODEL, lane, v);
            if (nextl) { store_row_bf16_nt(XB + (size_t)nn * DMODEL, lane, v); { float lo_[16];
#pragma unroll
                for (int i = 0; i < 16; ++i) lo_[i] = v[i] - __uint_as_float(f2bf(v[i]) << 16);
                if (USE_XLO) store_row_fp8(XLOw + (size_t)nn * DMODEL, lane, lo_, XLO_SCALE);
                store_row_fp8_nt((unsigned char*)(C.ws + WS_XQ) + (size_t)nn * DMODEL, lane, v, XQ_SCALE); }
                gates_row(v, wgl, C.in[I_GATEB] + (l + 1) * 8, G + (size_t)nn * 8, lane); }
        }
    }
#undef LN2_ROUTE
    __syncthreads();
}
#ifndef MK_RELMODE
#define MK_RELMODE 0
#endif
__device__ __forceinline__ void xcd_barrier_w(const XcdBarrier& b, const Ctx& C, volatile LAS unsigned* rel, int minitems = 0) {
    asm volatile("s_waitcnt vmcnt(0)" ::: "memory");
    if (threadIdx.x == 0) *rel = 0u;
    __syncthreads();
    if (C.wave == 0) {
        if (threadIdx.x == 0) {
            unsigned* bar = b.bar;
            __builtin_amdgcn_s_waitcnt(0);
            unsigned nloc = b.st[0], nx = b.st[1];
            if (nloc == 0u) { xcd_barrier_complete(bar, b.x, nloc, nx); b.st[0] = nloc; b.st[1] = nx; }
            const unsigned old = xb_add(&bar[XB_XSUB(b.x)], 1u);
            const unsigned gen = old / nloc;
            if (old + 1u == (gen + 1u) * nloc) {
                if (MK_RELMODE == 0) *rel = 1u;
                __builtin_amdgcn_fence(__ATOMIC_RELEASE, "agent");
                asm volatile("s_waitcnt vmcnt(0)" ::: "memory");
                const unsigned og = xb_add(&bar[XB_TOP], 1u);
                const unsigned tg = og / nx;
                if (og + 1u == (tg + 1u) * nx) xb_add(&bar[XB_TOPGEN], 1u);
                else XB_SPIN(xb_ld(&bar[XB_TOPGEN]) == tg, bar);
                *rel = 1u;
                __builtin_amdgcn_fence(__ATOMIC_ACQUIRE, "agent");
                xb_add(&bar[XB_XGEN(b.x)], 1u);
                asm volatile("s_waitcnt vmcnt(0)" ::: "memory");
            } else {
                if (MK_RELMODE == 0) { XB_SPIN(xb_ld(&bar[XB_XSUB(b.x)]) < (gen + 1u) * nloc, bar);
                    *rel = 1u; }
                XB_SPIN(xb_ld(&bar[XB_XGEN(b.x)]) == gen, bar);
                *rel = 1u;
                __builtin_amdgcn_fence(__ATOMIC_ACQUIRE, "agent");
                asm volatile("s_waitcnt vmcnt(0)" ::: "memory");
            }
        }
    } else {
        const int lane = ltid() & 63, total = TRQ_LAYERS * trq_per(C); LAS float* scr = (LAS float*)(C.lds + RING_OFF + (C.wave - 1) * 16896);
        int done = 0;
        while (done < minitems || *rel == 0u) { const int q = trq_grab(C, lane); if (q >= total) break; const int r = trq_item(C, q); if (r >= 0) tr_one(C, r, scr, lane); ++done; }
    }
    __syncthreads();
}

struct Args { const float* in[21]; float* out; unsigned char* ws; int ph_lo, ph_hi, li, pad; };
__global__ void __launch_bounds__(NTHREADS, 2) mega_fwd(Args args) {
    extern __shared__ __attribute__((aligned(16))) unsigned char lds[];
    Ctx C;
    C.lds = (LAS unsigned char*)lds; C.wave = __builtin_amdgcn_readfirstlane(threadIdx.x >> 6);
    C.G = gridDim.x; { const int bx = blockIdx.x; C.vcu = (C.G % 8 == 0) ? (bx % 8) * (C.G / 8) + bx / 8 : bx; }
    C.ws = args.ws; C.in = args.in; C.out = args.out;
    volatile LAS unsigned* MISC = (volatile LAS unsigned*)(C.lds + MISC_OFF);
    for (int u = threadIdx.x; u < (LDSX_OFF - LDSCTL_OFF) / 4; u += NTHREADS) ((LAS unsigned*)(C.lds + LDSCTL_OFF))[u] = 0u;
    __syncthreads();
    unsigned* ctl = (unsigned*)(C.ws + WS_CTL);
    XcdBarrier bar = xcd_barrier_post(ctl + CW_BAR + args.li * XCD_BAR_WORDS, MISC + 8);
    const int lo = args.ph_lo, hi = args.ph_hi;
#define IN(k) (lo <= (k) && (k) < hi)
#ifndef MK_DBL
#define MK_DBL -1
#endif
#define REP(kind) _Pragma("unroll 1") for (int rep_ = 0; rep_ < ((kind) == MK_DBL ? 2 : 1); ++rep_)
#ifdef MK_PROBE_A
    LAS unsigned long long* tacc = (LAS unsigned long long*)(C.lds + LDSX_OFF + 20480);
    if (blockIdx.x == 0 && threadIdx.x == 0) { for (int i = 0; i < 16; ++i) tacc[i] = 0ull; tacc[14] = tacc[15] = wall_clock64(); }
#define stamper (blockIdx.x == 0 && threadIdx.x == 0)
#define STAMP(kind) do { if (stamper) { const unsigned long long now_ = wall_clock64(); tacc[kind] += now_ - tacc[14]; tacc[14] = now_; } } while (0)
#define SEAM(k) do { if (IN(k) && IN((k) + 1)) xcd_barrier(bar); STAMP((k) == 0 ? 0 : 1 + ((k) - 1) % NPH_LAYER); } while (0)
#else
#define STAMP(kind) do { } while (0)
#define SEAM(k) do { if (IN(k) && IN((k) + 1)) { xcd_barrier_w(bar, C, MISC + 10); if (MK_DBL == 12) xcd_barrier(bar); } } while (0)
#define SEAMW(k, n) do { if (IN(k) && IN((k) + 1)) { xcd_barrier_w(bar, C, MISC + 10, (n)); if (MK_DBL == 12) xcd_barrier(bar); } } while (0)
#ifndef MK_TAILITEMS
#define MK_TAILITEMS 3
#endif
#define MOE_IDLE(nN, xs) ((C.G == 256) ? ((((const LAS int*)(C.lds + LDSCTL_OFF))[32] + 8 * (32 / (nN)) - 1) / (8 * (32 / (nN))) - ((((const LAS int*)(C.lds + LDSCTL_OFF))[32] - ((int)blockIdx.x >> 3) / (nN) - ((((int)blockIdx.x & 7) + (xs)) & 7) * (32 / (nN)) + 8 * (32 / (nN)) - 1) / (8 * (32 / (nN))))) : 0)
#ifndef MK_DOWN_XS
#define MK_DOWN_XS 3
#endif
#endif
    if (IN(0)) { REP(0) p_prologue(C); SEAM(0); }
#pragma unroll 1
    for (int l = 0; l < DEPTH; ++l) {
        const int pb = 1 + l * NPH_LAYER;
        bf16* XB = (bf16*)(C.ws + WS_XB); bf16* PROJ = (bf16*)(C.ws + WS_PROJ);
        if (IN(pb + 0)) {
            { pg8::Gemm g{XB, (const bf16*)(C.ws + WS_WIN) + (size_t)l * NPROJ * DMODEL, NTOK, 2048, DMODEL}; pg8::StaticOrder S; S.init(NTOK, 2048, C.G, (int)blockIdx.x);
              pg8::EpiBf16<0> E{PROJ, NPROJ, nullptr, 512, 512, attn_body::C2};
              REP(1) pg8::gemm_phase<pg8::EpiBf16<0>, pg8::StaticOrder, true, true, false>(C.lds + RING_OFF, g, S, E); }
            { pg8::Gemm g{(const bf16*)(C.ws + WS_XQ), (const bf16*)(C.ws + WS_WINQ + (size_t)l * 1536 * DMODEL), NTOK, 1024, DMODEL / 2}; pg8::StaticOrder S; S.init(NTOK, 1024, C.G, (int)blockIdx.x);
              pg8::EpiBf16<0> E{PROJ + 2048, NPROJ, nullptr, 0, 0, 1.0f, 1.0f / (XQ_SCALE * WQ_SCALE)};
              REP(1) pg8::gemm_phase<pg8::EpiBf16<0>, pg8::StaticOrder, true, true, false, true>(C.lds + RING_OFF, g, S, E); }
            SEAM(pb + 0);
        }
        if (IN(pb + 1)) { REP(2) p_mlstm_states_seq(C, l); SEAM(pb + 1); }
        if (IN(pb + 3)) {
            REP(11) p_mlstm_out_seq(C, l); STAMP(11);
            { const int ln_ = ltid() & 63; const float s1 = wave_sum(C.in[I_LQ1][l * 64 + ln_] * C.in[I_LK1][l * 64 + ln_]), s2 = wave_sum(C.in[I_LQ2][l * 64 + ln_] * C.in[I_LK2][l * 64 + ln_]);
              const float lam_init = __uint_as_float(__builtin_amdgcn_readfirstlane(__float_as_uint(0.8f - 0.6f * expf(-0.3f * (float)l)))); const float lam = __uint_as_float(__builtin_amdgcn_readfirstlane(__float_as_uint(expf(s1) - expf(s2) + lam_init)));
              REP(4) for (int vc = C.vcu; vc < 256; vc += C.G) attn_body::attn_phase((char*)lds + RING_OFF, (const attn_body::bf16*)PROJ, (attn_body::bf16*)(C.ws + WS_ATTO), (attn_body::bf16*)(C.ws + WS_MIXIN), C.in[I_NG] + l * 128, lam, 1.0f - lam_init, vc); }
            SEAM(pb + 3);
        }
        if (IN(pb + 5)) {
#if MK_OUTFP8
            pg8::Gemm g{(const bf16*)(C.ws + WS_MIXIN), (const bf16*)(C.ws + WS_WOUT + (size_t)l * DMODEL * DMODEL), NTOK, DMODEL, DMODEL / 2}; pg8::StaticOrder S; S.init(NTOK, DMODEL, C.G, (int)blockIdx.x);
            pg8::EpiBf16<0> E{(bf16*)(C.ws + WS_MIXO), DMODEL, nullptr, 0, 0, 1.0f, 1.0f / (MQ_SCALE * WQ_SCALE)};
            REP(6) pg8::gemm_phase<pg8::EpiBf16<0>, pg8::StaticOrder, true, true, false, true>(C.lds + RING_OFF, g, S, E);
#else
            pg8::Gemm g{(const bf16*)(C.ws + WS_MIXIN), (const bf16*)(C.ws + WS_WOUT) + (size_t)l * DMODEL * DMODEL, NTOK, DMODEL, DMODEL}; pg8::StaticOrder S; S.init(NTOK, DMODEL, C.G, (int)blockIdx.x);
            pg8::EpiBf16<0> E{(bf16*)(C.ws + WS_MIXO), DMODEL, nullptr, 0, 0, 1.0f};
            REP(6) pg8::gemm_phase<pg8::EpiBf16<0>, pg8::StaticOrder, true, true, false>(C.lds + RING_OFF, g, S, E);
#endif
            SEAM(pb + 5);
        }
        if (IN(pb + 6)) { p_ln1_router(C, l); if (MK_DBL == 7) p_ln1_router(C, l, false); if (MK_DBL == 13) p_ln1_router(C, l, false, true); if (MK_DBL == 14) p_ln1_router(C, l, false, true, true); if (MK_DBL == 15) p_ln1_router(C, l, false, true, true, true); if (MK_DBL == 16) p_ln1_router(C, l, false, true, false, false, 1); if (MK_DBL == 17) p_ln1_router(C, l, false, true, false, false, 2); if (l > 0) trq_drain(C, l); SEAM(pb + 6); }
        if (IN(pb + 7)) {
            moe_tables(C, l);
            pg8::Gemm g{(const bf16*)(C.ws + WS_X1B), (const bf16*)(C.ws + WS_WGU + (size_t)l * NEXP * 2 * DFF * DMODEL), 0, 0, DMODEL / 2};
            pg8::MoeOrder S{(const LAS int*)(C.lds + LDSCTL_OFF), (const LAS int*)(C.lds + LDSCTL_OFF + 160), (const int*)(C.ws + WS_ROWTOK), 8, C.G, (int)blockIdx.x, NTOK, (LAS unsigned*)(C.lds + LDSX_OFF)};
            pg8::EpiSwiglu E{(bf16*)(C.ws + WS_H), DFF, C.in[I_BGU] + (size_t)l * NEXP * 2 * DFF, DFF, 1.0f / (XQ_SCALE * WQ_SCALE), HQ_SCALE, 0, (const LAS float*)(C.lds + LDSX_OFF + 16384)};
            REP(8) pg8::gemm_phase<pg8::EpiSwiglu, pg8::MoeOrder, true, true, true, true>(C.lds + RING_OFF, g, S, E);
            if (MK_DBL == 21) pg8::gemm_phase<pg8::EpiSwiglu, pg8::MoeOrder, true, true, true, true>(C.lds + RING_OFF, g, S, E);
            if (MK_DBL == 18 || MK_DBL == 19) { pg8::EpiSwiglu E2 = E; E2.dbg = (MK_DBL == 18) ? 2 : 1; pg8::gemm_phase<pg8::EpiSwiglu, pg8::MoeOrder, true, true, true, true>(C.lds + RING_OFF, g, S, E2); }
            SEAMW(pb + 7, MK_TAILITEMS * MOE_IDLE(8, 0));
        }
        if (IN(pb + 8)) {
            if (!IN(pb + 7)) moe_tables(C, l);
            pg8::Gemm g{(const bf16*)(C.ws + WS_H), (const bf16*)(C.ws + WS_WDN + (size_t)l * NEXP * DMODEL * DFF), 0, 0, DFF / 2};
            pg8::MoeOrder S{(const LAS int*)(C.lds + LDSCTL_OFF), (const LAS int*)(C.lds + LDSCTL_OFF + 160), (const int*)(C.ws + WS_ROWTOK), 4, C.G, (int)blockIdx.x, NTOK, (LAS unsigned*)(C.lds + LDSX_OFF), MK_DOWN_XS};
            pg8::EpiFp8 E{(bf16*)(C.ws + WS_Y), DMODEL, C.in[I_BDN] + (size_t)l * NEXP * DMODEL, DMODEL, 0, 1.0f, 1.0f / (HQ_SCALE * WQ_SCALE), 0, 0u, YQ_SCALE, (const LAS float*)(C.lds + LDSX_OFF + 16384)};
            REP(9) pg8::gemm_phase<pg8::EpiFp8, pg8::MoeOrder, true, true, false, true>(C.lds + RING_OFF, g, S, E);
            if (MK_DBL == 20) { pg8::EpiFp8 E2 = E; E2.dbg = 2; pg8::gemm_phase<pg8::EpiFp8, pg8::MoeOrder, true, true, false, true>(C.lds + RING_OFF, g, S, E2); }
            SEAMW(pb + 8, MK_TAILITEMS * MOE_IDLE(4, MK_DOWN_XS));
        }
        if (IN(pb + 9)) { if (!IN(pb + 7)) moe_tables(C, l); REP(10) p_ln2_combine(C, l); SEAM(pb + 9); }
    }
#ifdef MK_PROBE_A
    xcd_barrier(bar);
    if (stamper) { const unsigned long long now_ = wall_clock64(); tacc[10] += now_ - tacc[14]; const float tot = (float)(now_ - tacc[15]);
        __hip_atomic_store((float*)(ctl + 8), (float)tacc[MK_PROBE_A] / tot, __ATOMIC_RELAXED, __HIP_MEMORY_SCOPE_AGENT); __hip_atomic_store((float*)(ctl + 9), (float)tacc[MK_PROBE_B] / tot, __ATOMIC_RELAXED, __HIP_MEMORY_SCOPE_AGENT); }
    xcd_barrier(bar);
    { const float fa = __hip_atomic_load((float*)(ctl + 8), __ATOMIC_RELAXED, __HIP_MEMORY_SCOPE_AGENT), fb = __hip_atomic_load((float*)(ctl + 9), __ATOMIC_RELAXED, __HIP_MEMORY_SCOPE_AGENT);
        const size_t gid = (size_t)blockIdx.x * NTHREADS + threadIdx.x, nth = (size_t)gridDim.x * NTHREADS;
        for (size_t i = gid; i < (size_t)NTOK * DMODEL; i += nth) { float v = C.out[i] * (1.0f + 4.0f * fa); if (i == 0) v += 1000.0f * fb; C.out[i] = v; } }
#endif
#undef IN
#undef SEAM
}

#ifndef MK_MODE
#define MK_MODE 0
#endif
static int mega_grid() {
    static int grid = 0;
    if (grid == 0) {
        int dev = 0, cus = 0, per_cu = 0;
        if (hipGetDevice(&dev) != hipSuccess || hipDeviceGetAttribute(&cus, hipDeviceAttributeMultiprocessorCount, dev) != hipSuccess) { grid = -1; return grid; }
        if (hipFuncSetAttribute((const void*)mega_fwd, hipFuncAttributeMaxDynamicSharedMemorySize, LDS_BYTES) != hipSuccess) { fprintf(stderr, "kernel_launch: hipFuncSetAttribute failed\n"); grid = -1; return grid; }
        if (hipOccupancyMaxActiveBlocksPerMultiprocessor(&per_cu, (const void*)mega_fwd, NTHREADS, LDS_BYTES) != hipSuccess || per_cu < 1) fprintf(stderr, "kernel_launch: occupancy query reports %d\n", per_cu);
        (void)hipGetLastError();
        grid = cus;
    }
    return grid;
}
static void mega_launch(void* const* d_in, float* d_out, unsigned char* ws, hipStream_t stream, int lo, int hi, int li) {
    const int grid = mega_grid(); if (grid <= 0) return;
    Args a{};
    for (int i = 0; i < 21; ++i) a.in[i] = (const float*)d_in[i];
    a.out = d_out; a.ws = ws; a.ph_lo = lo; a.ph_hi = hi; a.li = li; a.pad = 0;
    hipLaunchKernelGGL(mega_fwd, dim3(grid), dim3(NTHREADS), LDS_BYTES, stream, a);
    const hipError_t le = hipPeekAtLastError();
    if (le != hipSuccess) fprintf(stderr, "kernel_launch: launch failed: %s\n", hipGetErrorName(le));
}
extern "C" void kernel_launch(void* const* d_in, const int* in_sizes, int n_in, void* d_out, int out_size, void* d_ws, size_t ws_size, hipStream_t stream) {
    if (n_in != 21 || in_sizes[0] != NTOK * DMODEL || out_size != NTOK * DMODEL || ws_size < WS_END) { fprintf(stderr, "kernel_launch: unexpected shapes (n_in %d, ws %zu)\n", n_in, ws_size); return; }
    unsigned char* ws = (unsigned char*)d_ws;
    if (hipMemsetAsync(ws + WS_CTL, 0, CTL_ZERO_BYTES, stream) != hipSuccess) { fprintf(stderr, "kernel_launch: memset failed\n"); return; }
#if MK_MODE == 0
    mega_launch(d_in, (float*)d_out, ws, stream, 0, NPHASES, 0);
#else
    for (int ph = 0; ph < NPHASES; ++ph) mega_launch(d_in, (float*)d_out, ws, stream, ph, ph + 1, 0);
#endif
}
```

```cpp
#include <hip/hip_runtime.h>
#include <cstdio>
#include <cstdint>
#include <cmath>
namespace pg8 {
#define PG8_LAS __attribute__((address_space(3)))
#ifndef PG8_STORES_IN_FLIGHT
#define PG8_STORES_IN_FLIGHT 0
#endif
#define PG8_NSTORE(n) (PG8_STORES_IN_FLIGHT ? (n) : 0)
typedef unsigned short bf16_t;
typedef short bf16x8 __attribute__((ext_vector_type(8)));
typedef float f32x4 __attribute__((ext_vector_type(4)));
typedef unsigned u32x4 __attribute__((ext_vector_type(4)));
typedef int i32x4_t __attribute__((ext_vector_type(4)));
typedef int i32x8_t __attribute__((ext_vector_type(8)));
constexpr int BM = 256, BK = 64, HALF = 128, HTB = HALF * BK * 2  , STAGE_BYTES = 8 * HTB, NXCD = 8, WGM = 8;

__host__ __device__ __forceinline__ int lds_byte(int r, int c) { const int st = (r >> 4) * 2 + (c >> 5), rr = r & 15, cc = c & 31, ob = rr * 64 + cc * 2; return st * 1024 + (ob ^ (((ob >> 9) & 1) << 5)); }
__host__ __device__ __forceinline__ void stage_rc(int b, int& R, int& C) { const int st = b / 1024, sb = b % 1024, swz = sb ^ (((sb >> 9) & 1) << 5); R = (st >> 1) * 16 + swz / 64; C = (st & 1) * 32 + (swz % 64) / 2; }
__host__ __device__ __forceinline__ int perm32(int rho) { const int n = rho >> 4, i = rho & 15; return 8 * (i >> 2) + 4 * n + (i & 3); }

struct Unit { int pm, pn, e, pnl, nvalid, rbase; };

struct Gemm { const bf16_t* A; const bf16_t* Bt; int M, N, K; };

struct StaticOrder {
    int nM, nN, nwg, G, c; PG8_LAS unsigned* gtab = nullptr;
    __host__ __device__ void init(int M, int N, int G_, int c_) { nM = M / BM; nN = N / BM; nwg = nM * nN; G = G_; c = c_; }
    __host__ __device__ bool next(int i, Unit& u) const {
        const long L = (long)i * G + c; if (L >= nwg) return false;
        int wgid = (int)L; { const int q = nwg / NXCD, r = nwg % NXCD, xcd = wgid % NXCD, off = wgid / NXCD; wgid = (xcd < r ? xcd * (q + 1) : r * (q + 1) + (xcd - r) * q) + off; }
        const int nig = WGM * nN, gid = wgid / nig, fm = gid * WGM, gsz = (nM - fm) < WGM ? (nM - fm) : WGM;
        u.pm = fm + ((wgid % nig) % gsz); u.pn = (wgid % nig) / gsz; u.e = 0; u.pnl = u.pn; u.nvalid = BM; u.rbase = 0; return true;
    }
    __device__ __forceinline__ int arow(const Unit&, int) const { return 0; }
    __device__ __forceinline__ void a_ready(const Unit&) const {}
    __device__ __forceinline__ void done(const Unit&) const {}
};

__device__ __forceinline__ unsigned cvt_pk_bf16(float lo, float hi) { unsigned r; asm volatile("v_cvt_pk_bf16_f32 %0, %1, %2" : "=v"(r) : "v"(lo), "v"(hi)); return r; }
typedef float f32x2 __attribute__((ext_vector_type(2)));
__device__ __forceinline__ f32x2 gelu_pk(f32x2 v) {
    const f32x2 av = __builtin_elementwise_abs(v), d = av * 0.2316418882f + 1.0f;
    f32x2 t; t.x = __builtin_amdgcn_rcpf(d.x); t.y = __builtin_amdgcn_rcpf(d.y);
    f32x2 q = t * 0.5307027145f + (-0.7265760135f); q = q * t + 0.7107068705f; q = q * t + (-0.142248368f); q = q * t + 0.127414796f; q = q * t;
    const f32x2 s = (v * v) * (-0.72134752044f);
    f32x2 e; e.x = __builtin_amdgcn_exp2f(s.x); e.y = __builtin_amdgcn_exp2f(s.y);
    const f32x2 m = v * (q * e), r = v - m;
    f32x2 o; o.x = v.x < 0.f ? m.x : r.x; o.y = v.y < 0.f ? m.y : r.y; return o;
}

template <int ACT  > struct EpiBf16 {
    static constexpr int PERM = 1; static constexpr bool AFTER_DRAIN = false; static_assert(ACT == 0 || ACT == 1, "EpiBf16: ACT is 0 (none) or 1 (gelu_pk)");
    static constexpr int NSTORE = PG8_NSTORE(16); static constexpr bool LDSBIAS = false;
    bf16_t* O; int ldc; const float* bias; int split_cols; size_t split_stride; float scale0;
    float ascale = 1.0f;
    int dbg = 0;
    unsigned cmap = 0u;
    float oscale = 0.0f;
    __device__ __forceinline__ void operator()(const f32x4 (&acc)[2][2][4][2], const Unit& u, int wr, int wc, int fr, int fq) const {
        if (dbg == 2) return;
        const int row0 = u.pm * BM + wr * 64 + fr; int colt = (cmap ? (int)((cmap >> (4 * u.pn)) & 15u) : u.pn) * BM; bf16_t* base = O;
        float sc = 1.f; if (split_cols) { const int t = colt / split_cols; base += (size_t)t * split_stride; colt -= t * split_cols; if (t == 0) sc = scale0; }
        const int col0 = colt + wc * 32 + 8 * fq, bcol0 = u.pn * BM + wc * 32 + 8 * fq;
        f32x4 bv[2][2];
#pragma unroll
        for (int bj = 0; bj < 2; ++bj)
#pragma unroll
            for (int n = 0; n < 2; ++n) bv[bj][n] = bias ? *(const f32x4*)(bias + bcol0 + bj * HALF + 4 * n) : (f32x4){0.f, 0.f, 0.f, 0.f};
#pragma unroll
        for (int ai = 0; ai < 2; ++ai)
#pragma unroll
            for (int m = 0; m < 4; ++m) { bf16_t* rowp = base + (size_t)(row0 + ai * HALF + m * 16) * ldc + col0;
#pragma unroll
                for (int bj = 0; bj < 2; ++bj) {
                    if (ACT == 0 && oscale > 0.f) {
                        const float kq = ascale * oscale; f32x4 a, b;
#pragma unroll
                        for (int i = 0; i < 4; ++i) { a[i] = __builtin_amdgcn_fmed3f(__builtin_fmaf(acc[ai][bj][m][0][i], kq, bv[bj][0][i] * oscale), -448.f, 448.f); b[i] = __builtin_amdgcn_fmed3f(__builtin_fmaf(acc[ai][bj][m][1][i], kq, bv[bj][1][i] * oscale), -448.f, 448.f); }
                        int p = 0, q = 0; p = __builtin_amdgcn_cvt_pk_fp8_f32(a[0], a[1], p, false); p = __builtin_amdgcn_cvt_pk_fp8_f32(a[2], a[3], p, true); q = __builtin_amdgcn_cvt_pk_fp8_f32(b[0], b[1], q, false); q = __builtin_amdgcn_cvt_pk_fp8_f32(b[2], b[3], q, true);
                        typedef int i32x2_f __attribute__((ext_vector_type(2))); *(i32x2_f*)((unsigned char*)base + (size_t)(row0 + ai * HALF + m * 16) * ldc + col0 + bj * HALF) = (i32x2_f){p, q}; continue; }
                    f32x4 v0 = acc[ai][bj][m][0] * ascale + bv[bj][0], v1 = acc[ai][bj][m][1] * ascale + bv[bj][1];
                    if (ACT == 1) { f32x2 a = gelu_pk((f32x2){v0[0], v0[1]}), b = gelu_pk((f32x2){v0[2], v0[3]}), c = gelu_pk((f32x2){v1[0], v1[1]}), d = gelu_pk((f32x2){v1[2], v1[3]});
                        v0 = (f32x4){a.x, a.y, b.x, b.y}; v1 = (f32x4){c.x, c.y, d.x, d.y}; }
                    v0 = v0 * sc; v1 = v1 * sc;
                    if (oscale > 0.f) { f32x4 a = v0 * oscale, b = v1 * oscale;
#pragma unroll
                        for (int i = 0; i < 4; ++i) { a[i] = __builtin_fminf(__builtin_fmaxf(a[i], -448.f), 448.f); b[i] = __builtin_fminf(__builtin_fmaxf(b[i], -448.f), 448.f); }
                        int p = 0, q = 0; p = __builtin_amdgcn_cvt_pk_fp8_f32(a[0], a[1], p, false); p = __builtin_amdgcn_cvt_pk_fp8_f32(a[2], a[3], p, true); q = __builtin_amdgcn_cvt_pk_fp8_f32(b[0], b[1], q, false); q = __builtin_amdgcn_cvt_pk_fp8_f32(b[2], b[3], q, true);
                        typedef int i32x2_t __attribute__((ext_vector_type(2))); *(i32x2_t*)((unsigned char*)base + (size_t)(row0 + ai * HALF + m * 16) * ldc + col0 + bj * HALF) = (i32x2_t){p, q}; }
                    else { u32x4 w; w.x = cvt_pk_bf16(v0[0], v0[1]); w.y = cvt_pk_bf16(v0[2], v0[3]); w.z = cvt_pk_bf16(v1[0], v1[1]); w.w = cvt_pk_bf16(v1[2], v1[3]);
                        *(u32x4*)(rowp + bj * HALF) = w; } } }
    }
};

struct EpiFp8 { static constexpr int ACT = 0;
    static constexpr int PERM = 2; static constexpr bool AFTER_DRAIN = false; static constexpr int NSTORE = PG8_NSTORE(8); static constexpr bool LDSBIAS = true;
    __device__ __forceinline__ const float* bias_src(const Unit& u, int wc, int lane) const { return bias + u.pn * BM + wc * 64 + lane; }
    bf16_t* O; int ldc; const float* bias; int split_cols; size_t split_stride; float scale0;
    float ascale = 1.0f;
    int dbg = 0;
    unsigned cmap = 0u;
    float oscale = 0.0f;
    PG8_LAS const float* lbias = nullptr;
    __device__ __forceinline__ void operator()(const f32x4 (&acc)[2][2][4][2], const Unit& u, int wr, int wc, int fr, int fq) const {
        if (dbg == 2) return;
        const int row0 = u.pm * BM + wr * 64 + fr; int colt = (cmap ? (int)((cmap >> (4 * u.pn)) & 15u) : u.pn) * BM; bf16_t* base = O;
        float sc = 1.f; if (split_cols) { const int t = colt / split_cols; base += (size_t)t * split_stride; colt -= t * split_cols; if (t == 0) sc = scale0; }
        const int col0 = colt + wc * 64 + 16 * fq, bcol0 = u.pn * BM + wc * 64 + 16 * fq;
        f32x4 bv[2][2];
#pragma unroll
        for (int bj = 0; bj < 2; ++bj)
#pragma unroll
            for (int n = 0; n < 2; ++n) bv[bj][n] = lbias ? *(const PG8_LAS f32x4*)(lbias + (wr * 4 + wc) * 64 + 16 * fq + 8 * bj + 4 * n) : (bias ? *(const f32x4*)(bias + bcol0 + 8 * bj + 4 * n) : (f32x4){0.f, 0.f, 0.f, 0.f});
#pragma unroll
        for (int ai = 0; ai < 2; ++ai)
#pragma unroll
            for (int m = 0; m < 4; ++m) { const size_t rowoff = (size_t)(row0 + ai * HALF + m * 16) * ldc + col0;
                if (ACT == 0 && oscale > 0.f) {
                    const float kq = ascale * oscale; int w4[4];
#pragma unroll
                    for (int bj = 0; bj < 2; ++bj)
#pragma unroll
                        for (int n = 0; n < 2; ++n) { float a[4];
#pragma unroll
                            for (int p = 0; p < 2; ++p) { const f32x2 t2 = (f32x2){acc[ai][bj][m][n][2 * p], acc[ai][bj][m][n][2 * p + 1]} * kq + (f32x2){bv[bj][n][2 * p], bv[bj][n][2 * p + 1]} * oscale;
                                a[2 * p] = __builtin_amdgcn_fmed3f(t2.x, -448.f, 448.f); a[2 * p + 1] = __builtin_amdgcn_fmed3f(t2.y, -448.f, 448.f); }
                            int p = 0; p = __builtin_amdgcn_cvt_pk_fp8_f32(a[0], a[1], p, false); p = __builtin_amdgcn_cvt_pk_fp8_f32(a[2], a[3], p, true); w4[2 * bj + n] = p; }
                    *(u32x4*)((unsigned char*)base + rowoff) = (u32x4){(unsigned)w4[0], (unsigned)w4[1], (unsigned)w4[2], (unsigned)w4[3]}; continue; }
                u32x4 wo[2];
#pragma unroll
                for (int bj = 0; bj < 2; ++bj) { f32x4 v0 = acc[ai][bj][m][0] * ascale + bv[bj][0], v1 = acc[ai][bj][m][1] * ascale + bv[bj][1];
                    if (ACT == 1) { f32x2 a = gelu_pk((f32x2){v0[0], v0[1]}), b = gelu_pk((f32x2){v0[2], v0[3]}), c = gelu_pk((f32x2){v1[0], v1[1]}), d = gelu_pk((f32x2){v1[2], v1[3]});
                        v0 = (f32x4){a.x, a.y, b.x, b.y}; v1 = (f32x4){c.x, c.y, d.x, d.y}; }
                    v0 = v0 * sc; v1 = v1 * sc;
                    wo[bj].x = cvt_pk_bf16(v0[0], v0[1]); wo[bj].y = cvt_pk_bf16(v0[2], v0[3]); wo[bj].z = cvt_pk_bf16(v1[0], v1[1]); wo[bj].w = cvt_pk_bf16(v1[2], v1[3]); }
                bf16_t* rowp = base + rowoff; *(u32x4*)rowp = wo[0]; *(u32x4*)(rowp + 8) = wo[1]; }
    }
};

struct EpiSwiglu {
    static constexpr int PERM = 1; static constexpr bool AFTER_DRAIN = false; static constexpr int NSTORE = PG8_NSTORE(8); static constexpr bool LDSBIAS = true;
    bf16_t* H; int ldc; const float* bias; int dff; float ascale; float hscale; int dbg = 0;
    PG8_LAS const float* lbias = nullptr;
    __device__ __forceinline__ const float* bias_src(const Unit& u, int wc, int lane) const { return bias + (size_t)u.e * 2 * dff + u.pnl * HALF + wc * 32 + (lane & 31) + ((lane & 32) ? dff : 0); }
    __device__ __forceinline__ void operator()(const f32x4 (&acc)[2][2][4][2], const Unit& u, int wr, int wc, int fr, int fq) const {
        if (dbg == 2) return;
        const int row0 = u.pm * BM + wr * 64 + fr, hc = u.pnl * HALF + wc * 32 + 8 * fq;
        const float* bg = bias + (size_t)u.e * 2 * dff + hc; const float* bu = bg + dff;
        const float hk = hscale > 0.f ? hscale : 1.0f;
        f32x4 bgv[2], buv[2];
#pragma unroll
        for (int n = 0; n < 2; ++n) { if (lbias) { const PG8_LAS float* lb = lbias + (wr * 4 + wc) * 64 + 8 * fq + 4 * n; bgv[n] = *(const PG8_LAS f32x4*)lb; buv[n] = *(const PG8_LAS f32x4*)(lb + 32); }
            else { bgv[n] = *(const f32x4*)(bg + 4 * n); buv[n] = *(const f32x4*)(bu + 4 * n); } }
#pragma unroll
        for (int ai = 0; ai < 2; ++ai)
#pragma unroll
            for (int m = 0; m < 4; ++m) { bf16_t* rowp = H + (size_t)(row0 + ai * HALF + m * 16) * ldc + hc; float o[8];
#pragma unroll
                for (int n = 0; n < 2; ++n)
#pragma unroll
                    for (int p = 0; p < 2; ++p) {
                        const f32x2 g2 = (f32x2){acc[ai][0][m][n][2 * p], acc[ai][0][m][n][2 * p + 1]} * ascale + (f32x2){bgv[n][2 * p], bgv[n][2 * p + 1]};
                        const f32x2 u2 = (f32x2){acc[ai][1][m][n][2 * p], acc[ai][1][m][n][2 * p + 1]} * ascale + (f32x2){buv[n][2 * p], buv[n][2 * p + 1]};
                        f32x2 gt, up; gt.x = __builtin_fminf(g2.x, 7.0f); gt.y = __builtin_fminf(g2.y, 7.0f); up.x = __builtin_amdgcn_fmed3f(u2.x, -7.0f, 7.0f); up.y = __builtin_amdgcn_fmed3f(u2.y, -7.0f, 7.0f);
                        const f32x2 ee = gt * (-1.702f * 1.4426950408889634f);
                        f32x2 den; den.x = __builtin_amdgcn_exp2f(ee.x); den.y = __builtin_amdgcn_exp2f(ee.y); den = den + 1.0f;
                        f32x2 sg; sg.x = __builtin_amdgcn_rcpf(den.x); sg.y = __builtin_amdgcn_rcpf(den.y);
                        const f32x2 r2 = (up * hk + hk) * (gt * sg);
                        o[4 * n + 2 * p] = r2.x; o[4 * n + 2 * p + 1] = r2.y; }
                if (dbg == 1) { if (o[0] == 123.4567f && o[5] == 7.654f) rowp[0] = 1; continue; }
                if (hscale > 0.f) { int a = 0, b = 0; a = __builtin_amdgcn_cvt_pk_fp8_f32(o[0], o[1], a, false); a = __builtin_amdgcn_cvt_pk_fp8_f32(o[2], o[3], a, true);
                    b = __builtin_amdgcn_cvt_pk_fp8_f32(o[4], o[5], b, false); b = __builtin_amdgcn_cvt_pk_fp8_f32(o[6], o[7], b, true);
                    typedef int i32x2_t __attribute__((ext_vector_type(2))); *(i32x2_t*)((unsigned char*)H + (size_t)(row0 + ai * HALF + m * 16) * ldc + hc) = (i32x2_t){a, b}; }
                else { u32x4 w; w.x = cvt_pk_bf16(o[0], o[1]); w.y = cvt_pk_bf16(o[2], o[3]); w.z = cvt_pk_bf16(o[4], o[5]); w.w = cvt_pk_bf16(o[6], o[7]);
                    *(u32x4*)rowp = w; } }
    }
};
struct MoeOrder {
    const PG8_LAS int* tstart; const PG8_LAS int* cnt; const int* rowtok; int nN, G, c, ntok; PG8_LAS unsigned* gtab;
    int xs = 0;
    __device__ __forceinline__ bool next(int i, Unit& u) const {
        int rt, pnl;
        if (G == 256) { const int x = ((c & 7) + xs) & 7, j = c >> 3, per = 32 / nN; rt = (i * 8 + x) * per + j / nN; pnl = j % nN; }
        else { const int L = i * G + c; rt = L / nN; pnl = L % nN; }
        const int TR = tstart[32]; if (rt >= TR) return false;
        const int ln_ = (int)__builtin_amdgcn_mbcnt_hi(~0u, __builtin_amdgcn_mbcnt_lo(~0u, 0u));
        const int tv_ = tstart[(ln_ & 31) + 1];
        const unsigned long long bal_ = __ballot((ln_ < 31) && (tv_ <= rt));
        int e = __builtin_amdgcn_readfirstlane((int)__popcll(bal_));
        const int lt = rt - tstart[e]; int nv = cnt[e] - lt * BM; nv = nv > BM ? BM : nv;
        u.pm = rt; u.pn = e * nN + pnl; u.e = e; u.pnl = pnl; u.nvalid = __builtin_amdgcn_readfirstlane(nv); u.rbase = __builtin_amdgcn_readfirstlane(e * ntok + lt * BM); return true;
    }
    __device__ __forceinline__ int arow(const Unit& u, int r) const { return rowtok[u.rbase + ((r < u.nvalid) ? r : 0)]; }
    __device__ __forceinline__ const int* aptr(const Unit& u, int r) const { return rowtok + u.rbase + ((r < u.nvalid) ? r : 0); }
    __device__ __forceinline__ void a_ready(const Unit&) const {}
    __device__ __forceinline__ void done(const Unit&) const {}
};

struct PanelStats {
    unsigned* xbuf;
    unsigned* cnt;
    unsigned* tmo;
    int ntn; float eps;
    unsigned code;
    __device__ __forceinline__ bool run(const f32x4 (&v)[2][2][4][2], const Unit& u, int wr, int wc, int fr, int fq, PG8_LAS unsigned char* lds, int wid, int lane) const {
        typedef float f32x2v __attribute__((ext_vector_type(2)));
        PG8_LAS f32x2v* P = (PG8_LAS f32x2v*)lds;
        PG8_LAS f32x2v* S = (PG8_LAS f32x2v*)(lds + 8192);
        PG8_LAS unsigned* flag = (PG8_LAS unsigned*)(lds + 8192 + 2048);
#pragma unroll
        for (int ai = 0; ai < 2; ++ai)
#pragma unroll
            for (int m = 0; m < 4; ++m) {
                float s = 0.f;
#pragma unroll
                for (int bj = 0; bj < 2; ++bj)
#pragma unroll
                    for (int n = 0; n < 2; ++n) { const f32x4 x = v[ai][bj][m][n]; s += (x[0] + x[1]) + (x[2] + x[3]); }
                s += __shfl_xor(s, 16); s += __shfl_xor(s, 32);
                const float mw = s * (1.0f / 64.0f); float q = 0.f;
#pragma unroll
                for (int bj = 0; bj < 2; ++bj)
#pragma unroll
                    for (int n = 0; n < 2; ++n) { const f32x4 d = v[ai][bj][m][n] - mw; q += (d[0] * d[0] + d[1] * d[1]) + (d[2] * d[2] + d[3] * d[3]); }
                q += __shfl_xor(q, 16); q += __shfl_xor(q, 32);
                if (fq == 0) P[(ai * HALF + wr * 64 + m * 16 + fr) * 4 + wc] = (f32x2v){mw, q};
            }
        asm volatile("s_waitcnt lgkmcnt(0)" ::: "memory"); __builtin_amdgcn_s_barrier(); asm volatile("" ::: "memory");
#if defined(BROKEN_EXCHANGE_NO_WAIT)
#warning BROKEN CONTROL BUILD: the row-statistics exchange does not wait; results are wrong by design
        if (blockIdx.x >= 64) { const long long t0_ = clock64(); while (clock64() - t0_ < 60000) __builtin_amdgcn_s_sleep(8); }
#endif
        const int row = wid * 32 + (lane & 31);
        if (lane < 32) {
            const f32x2v a = P[row * 4 + 0], b = P[row * 4 + 1], c = P[row * 4 + 2], d = P[row * 4 + 3];
            const float mt = (a.x + b.x + c.x + d.x) * 0.25f;
            const float da = a.x - mt, db = b.x - mt, dc = c.x - mt, dd = d.x - mt;
            const float m2 = (a.y + b.y) + (c.y + d.y) + 64.0f * ((da * da + db * db) + (dc * dc + dd * dd));
            unsigned long long* slot = (unsigned long long*)xbuf + ((size_t)(u.pm * BM + row) * 4 + u.pn);
            __hip_atomic_store(slot, ((unsigned long long)__float_as_uint(m2) << 32) | __float_as_uint(mt), __ATOMIC_RELAXED, __HIP_MEMORY_SCOPE_AGENT);
        }
        asm volatile("s_waitcnt vmcnt(0)" ::: "memory");
        if (lane == 0) __hip_atomic_fetch_add(cnt + 64 * u.pm, 1u, __ATOMIC_RELAXED, __HIP_MEMORY_SCOPE_AGENT);
        if (wid == 0) {
            bool dead = false; const unsigned long long t0 = __builtin_amdgcn_s_memrealtime(); const unsigned want = 8u * (unsigned)ntn;
            for (;;) {
#if defined(BROKEN_EXCHANGE_NO_WAIT)
                break;
#endif
                if ((unsigned)__builtin_amdgcn_readfirstlane(__hip_atomic_load(cnt + 64 * u.pm, __ATOMIC_RELAXED, __HIP_MEMORY_SCOPE_AGENT)) >= want) break;
                if (__builtin_amdgcn_s_memrealtime() - t0 > 2000000ull) {
                    if (lane == 0) { unsigned expect = 0u; __hip_atomic_compare_exchange_strong(tmo + 1, &expect, code | (unsigned)(u.pm & 0xff), __ATOMIC_RELAXED, __ATOMIC_RELAXED, __HIP_MEMORY_SCOPE_AGENT);
                                     __hip_atomic_store(tmo, 1u, __ATOMIC_RELAXED, __HIP_MEMORY_SCOPE_AGENT); }
                    dead = true; break; }
                __builtin_amdgcn_s_sleep(2);
            }
            __builtin_amdgcn_fence(__ATOMIC_ACQUIRE, "agent");
            if (lane == 0) flag[0] = dead ? 1u : 0u;
        }
        asm volatile("s_waitcnt vmcnt(0) lgkmcnt(0)" ::: "memory"); __builtin_amdgcn_s_barrier(); asm volatile("" ::: "memory");
        const bool bad = flag[0] != 0u;
        if (lane < 32) {
            const unsigned long long* slot = (const unsigned long long*)xbuf + (size_t)(u.pm * BM + row) * 4; float mt[4], m2[4]; float ms = 0.f;
#pragma unroll
            for (int t = 0; t < 4; ++t) { if (t < ntn) { const unsigned long long w = __hip_atomic_load(slot + t, __ATOMIC_RELAXED, __HIP_MEMORY_SCOPE_AGENT); mt[t] = __uint_as_float((unsigned)w); m2[t] = __uint_as_float((unsigned)(w >> 32)); } else { mt[t] = 0.f; m2[t] = 0.f; } ms += mt[t]; }
            const float mean = ms / (float)ntn; float q = 0.f;
#pragma unroll
            for (int t = 0; t < 4; ++t) if (t < ntn) { const float dm = mt[t] - mean; q += m2[t] + 256.0f * dm * dm; }
            S[row] = (f32x2v){mean, 1.0f / sqrtf(q / (256.0f * (float)ntn) + eps)};
        }
        asm volatile("s_waitcnt lgkmcnt(0)" ::: "memory"); __builtin_amdgcn_s_barrier(); asm volatile("" ::: "memory");
        return bad;
    }
};
struct EpiLnRes {
    static constexpr int PERM = 0; static constexpr bool AFTER_DRAIN = true; static constexpr int NSTORE = 0; static constexpr bool LDSBIAS = false;
    const float* base; float* out; int ldc; const float* bias; PanelStats st; unsigned poison;
    __device__ __forceinline__ void fused(f32x4 (&acc)[2][2][4][2], const Unit& u, int wr, int wc, int fr, int fq, PG8_LAS unsigned char* lds, int wid, int lane) const {
        typedef float f32x2v __attribute__((ext_vector_type(2)));
        const PG8_LAS f32x2v* S = (const PG8_LAS f32x2v*)(lds + 8192);
        const int col0 = u.pn * BM + wc * 32 + 4 * fq;
#pragma unroll
        for (int bj = 0; bj < 2; ++bj)
#pragma unroll
            for (int n = 0; n < 2; ++n) { const f32x4 bv = bias ? *(const f32x4*)(bias + col0 + bj * HALF + n * 16) : (f32x4){0.f, 0.f, 0.f, 0.f};
#pragma unroll
                for (int ai = 0; ai < 2; ++ai)
#pragma unroll
                    for (int m = 0; m < 4; ++m) acc[ai][bj][m][n] += bv; }
        f32x4 pre[4][2][2];
#pragma unroll
        for (int m = 0; m < 4; ++m) { const size_t off = (size_t)(u.pm * BM + wr * 64 + m * 16 + fr) * ldc + col0;
#pragma unroll
            for (int bj = 0; bj < 2; ++bj)
#pragma unroll
                for (int n = 0; n < 2; ++n) pre[m][bj][n] = *(const f32x4*)(base + off + bj * HALF + n * 16); }
        const bool bad = st.run(acc, u, wr, wc, fr, fq, lds, wid, lane) || poison != 0u;
        const float qnan = __builtin_nanf("");
#pragma unroll
        for (int ai = 0; ai < 2; ++ai)
#pragma unroll
            for (int m = 0; m < 4; ++m) { const int r = ai * HALF + wr * 64 + m * 16 + fr; const f32x2v sr = S[r]; const size_t off = (size_t)(u.pm * BM + r) * ldc + col0;
#pragma unroll
                for (int bj = 0; bj < 2; ++bj)
#pragma unroll
                    for (int n = 0; n < 2; ++n) { const f32x4 bs = ai == 0 ? pre[m][bj][n] : *(const f32x4*)(base + off + bj * HALF + n * 16); f32x4 o = bs + (acc[ai][bj][m][n] - sr.x) * sr.y;
                        if (bad) o = (f32x4){qnan, qnan, qnan, qnan}; *(f32x4*)(out + off + bj * HALF + n * 16) = o; }
                if (m & 1) asm volatile("" ::: "memory"); }
    }
};
struct EpiLnResLn {
    static constexpr int PERM = 0; static constexpr bool AFTER_DRAIN = true; static constexpr int NSTORE = 0; static constexpr bool LDSBIAS = false;
    const float* base; float* out; bf16_t* xn; int ldc; const float* bias; PanelStats st1, st2; unsigned poison;
    __device__ __forceinline__ void fused(f32x4 (&acc)[2][2][4][2], const Unit& u, int wr, int wc, int fr, int fq, PG8_LAS unsigned char* lds, int wid, int lane) const {
        typedef float f32x2v __attribute__((ext_vector_type(2))); typedef unsigned u32x2v __attribute__((ext_vector_type(2)));
        const PG8_LAS f32x2v* S = (const PG8_LAS f32x2v*)(lds + 8192);
        const int col0 = u.pn * BM + wc * 32 + 4 * fq;
#pragma unroll
        for (int bj = 0; bj < 2; ++bj)
#pragma unroll
            for (int n = 0; n < 2; ++n) { const f32x4 bv = bias ? *(const f32x4*)(bias + col0 + bj * HALF + n * 16) : (f32x4){0.f, 0.f, 0.f, 0.f};
#pragma unroll
                for (int ai = 0; ai < 2; ++ai)
#pragma unroll
                    for (int m = 0; m < 4; ++m) acc[ai][bj][m][n] += bv; }
        bool bad = st1.run(acc, u, wr, wc, fr, fq, lds, wid, lane) || poison != 0u;
        const float qnan = __builtin_nanf("");
#pragma unroll
        for (int ai = 0; ai < 2; ++ai)
#pragma unroll
            for (int m = 0; m < 4; ++m) { const int r = ai * HALF + wr * 64 + m * 16 + fr; const f32x2v sr = S[r]; const size_t off = (size_t)(u.pm * BM + r) * ldc + col0;
#pragma unroll
                for (int bj = 0; bj < 2; ++bj)
#pragma unroll
                    for (int n = 0; n < 2; ++n) { const f32x4 bs = *(const f32x4*)(base + off + bj * HALF + n * 16); acc[ai][bj][m][n] = bs + (acc[ai][bj][m][n] - sr.x) * sr.y; }
                asm volatile("" : "+v"(acc[ai][0][m][0]), "+v"(acc[ai][0][m][1]), "+v"(acc[ai][1][m][0]), "+v"(acc[ai][1][m][1]));
                if (m & 1) asm volatile("" ::: "memory"); }
        const bool bad1 = bad;
        bad = st2.run(acc, u, wr, wc, fr, fq, lds, wid, lane) || bad;
#pragma unroll
        for (int ai = 0; ai < 2; ++ai)
#pragma unroll
            for (int m = 0; m < 4; ++m) { const int r = ai * HALF + wr * 64 + m * 16 + fr; const f32x2v sr = S[r]; const size_t off = (size_t)(u.pm * BM + r) * ldc + col0;
#pragma unroll
                for (int bj = 0; bj < 2; ++bj)
#pragma unroll
                    for (int n = 0; n < 2; ++n) { const f32x4 x1 = acc[ai][bj][m][n]; *(f32x4*)(out + off + bj * HALF + n * 16) = bad1 ? (f32x4){qnan, qnan, qnan, qnan} : x1;
                        const f32x4 o = (x1 - sr.x) * sr.y; u32x2v w; w.x = cvt_pk_bf16(o[0], o[1]); w.y = cvt_pk_bf16(o[2], o[3]);
                        if (bad) { w.x = 0x7fc07fc0u; w.y = 0x7fc07fc0u; } *(u32x2v*)(xn + off + bj * HALF + n * 16) = w; }
                asm volatile("" ::: "memory"); }
    }
};

template <class Epi, class Sched, bool ALIGN_EPI = false, bool SP2 = false, bool GATHER = false, bool FP8 = false>
__device__ __forceinline__ void gemm_phase(PG8_LAS unsigned char* lds, const Gemm g, const Sched& S, const Epi& E) {
    static_assert(!GATHER || SP2, "the gathered-A variant is written for the SP2 loop only");
    int tid_ = threadIdx.x; asm volatile("" : "+v"(tid_));
    const int tid = tid_, wid = __builtin_amdgcn_readfirstlane(tid >> 6), lane = tid & 63, wr = wid >> 2, wc = wid & 3, fr = lane & 15, fq = lane >> 4;
    const int K = g.K, nt = K / BK;
    unsigned voffA[2], voffB[2], voffB2[2][2];
#pragma unroll
    for (int i = 0; i < 2; ++i) { int R, C; stage_rc(tid * 16 + i * 8192, R, C); const int Rb = (Epi::PERM == 1) ? ((R & ~31) + perm32(R & 31)) : R;
        voffA[i] = (unsigned)(R * K + C) * 2u; voffB[i] = (unsigned)(Rb * K + C) * 2u;
        { const int rho = R & 31, n_ = rho >> 4, fq_ = (rho & 15) >> 2, i_ = rho & 3; const int r2 = (Epi::PERM == 3) ? (64 * (R >> 5) + 8 * fq_ + 4 * n_ + i_) : (64 * (R >> 5) + 16 * fq_ + 4 * n_ + i_), hs = (Epi::PERM == 3) ? 32 : 8;
          voffB2[0][i] = (unsigned)(r2 * K + C) * 2u; voffB2[1][i] = (unsigned)((r2 + hs) * K + C) * 2u; } }
#define PG8_GOFF(slot, u) do { int tq_ = threadIdx.x; asm volatile("" : "+v"(tq_)); int gR[2], gC[2]; stage_rc(tq_ * 16, gR[0], gC[0]); stage_rc(tq_ * 16 + 8192, gR[1], gC[1]);     \
        PG8_LAS unsigned* gt_ = S.gtab + (slot) * 2048 + wid * 64;     \
        __builtin_amdgcn_global_load_lds((const unsigned*)S.aptr(u, gR[0]), gt_, 4, 0, 0); __builtin_amdgcn_global_load_lds((const unsigned*)S.aptr(u, gR[1]), gt_ + 512, 4, 0, 0); \
        __builtin_amdgcn_global_load_lds((const unsigned*)S.aptr(u, HALF + gR[0]), gt_ + 1024, 4, 0, 0); __builtin_amdgcn_global_load_lds((const unsigned*)S.aptr(u, HALF + gR[1]), gt_ + 1536, 4, 0, 0); } while (0)
    unsigned gcb[2] = {0u, 0u};
    if constexpr (GATHER) { int r_, c_; stage_rc(tid * 16, r_, c_); gcb[0] = (unsigned)c_ * 2u; stage_rc(tid * 16 + 8192, r_, c_); gcb[1] = (unsigned)c_ * 2u; }
    const unsigned rowB = (unsigned)K * 2u;
    const size_t kstep = (size_t)(BK * 2);
    const size_t hstep = (size_t)HALF * K * 2;
    const size_t tstep = 2 * hstep;
    const unsigned ldsw = (unsigned)wid * 1024u;
    const int aoff = lds_byte(wr * 64 + fr, fq * 8), boff = lds_byte(wc * 32 + fr, fq * 8);
#define PG8_SA(b, h) (((b) * 2 + (h)) * HTB)
#define PG8_SB(b, h) ((4 + (b) * 2 + (h)) * HTB)
#define PG8_STAGE(bufoff, gbase, voff) do { _Pragma("unroll") for (int _i = 0; _i < 2; ++_i) \
        __builtin_amdgcn_global_load_lds((const unsigned*)((const char*)(gbase) + (voff)[_i]), (PG8_LAS unsigned*)(lds + (bufoff) + ldsw + _i * 8192), 16, 0, 0); } while (0)
#define PG8_STAGE_B(bufoff, gbase, h) do { if constexpr (Epi::PERM >= 2) PG8_STAGE(bufoff, gbase, voffB2[h]); else PG8_STAGE(bufoff, (gbase) + (size_t)(h) * hstep, voffB); } while (0)
#define PG8_LDA(dst, b, h) do { _Pragma("unroll") for (int m = 0; m < 4; ++m) { if constexpr (FP8) { dst##8[m].lo = *(const PG8_LAS i32x4_t*)(lds + PG8_SA(b, h) + aoff + m * 2048); dst##8[m].hi = *(const PG8_LAS i32x4_t*)(lds + PG8_SA(b, h) + aoff + m * 2048 + 1024); } \
        else { _Pragma("unroll") for (int k = 0; k < 2; ++k) dst[m][k] = *(const PG8_LAS bf16x8*)(lds + PG8_SA(b, h) + aoff + m * 2048 + k * 1024); } } } while (0)
#define PG8_LDB(dst, b, h) do { _Pragma("unroll") for (int n = 0; n < 2; ++n) { if constexpr (FP8) { dst##8[n].lo = *(const PG8_LAS i32x4_t*)(lds + PG8_SB(b, h) + boff + n * 2048); dst##8[n].hi = *(const PG8_LAS i32x4_t*)(lds + PG8_SB(b, h) + boff + n * 2048 + 1024); } \
        else { _Pragma("unroll") for (int k = 0; k < 2; ++k) dst[n][k] = *(const PG8_LAS bf16x8*)(lds + PG8_SB(b, h) + boff + n * 2048 + k * 1024); } } } while (0)
#define PG8_MMA(ai, bj, At, Bt) do { __builtin_amdgcn_s_setprio(1); \
        if constexpr (FP8) { _Pragma("unroll") for (int m = 0; m < 4; ++m) _Pragma("unroll") for (int n = 0; n < 2; ++n) \
            asm volatile("v_mfma_scale_f32_16x16x128_f8f6f4 %0, %1, %2, %0, %3, %3 op_sel_hi:[0,0,0]" : "+v"(acc[ai][bj][m][n]) : "v"(Bt##8[n]), "v"(At##8[m]), "v"(sc7f)); } \
        else { _Pragma("unroll") for (int m = 0; m < 4; ++m) _Pragma("unroll") for (int n = 0; n < 2; ++n) _Pragma("unroll") for (int k = 0; k < 2; ++k) \
            acc[ai][bj][m][n] = __builtin_amdgcn_mfma_f32_16x16x32_bf16(Bt[n][k], At[m][k], acc[ai][bj][m][n], 0, 0, 0); } \
        __builtin_amdgcn_s_setprio(0); } while (0)
#define PG8_WAIT_V(n) asm volatile("s_waitcnt vmcnt(" #n ")" ::: "memory")
#define PG8_WAIT_V1 do { if (t != 0 || xtra == 0) PG8_WAIT_V(8); else if (xtra == 1) PG8_WAIT_V(9); else if (xtra == 5) PG8_WAIT_V(13); else if (xtra == 9) PG8_WAIT_V(17); else if (xtra == 13) PG8_WAIT_V(21); \
        else if (xtra == 16) PG8_WAIT_V(24); else if (xtra == 8) PG8_WAIT_V(16); else if (xtra == 12) PG8_WAIT_V(20); else if (xtra == 4) PG8_WAIT_V(12); else PG8_WAIT_V(8); } while (0)
#define PG8_WAIT_L(n) asm volatile("s_waitcnt lgkmcnt(" #n ")" ::: "memory")
#define PG8_BAR __builtin_amdgcn_s_barrier()
#define PG8_SCHED __builtin_amdgcn_sched_barrier(0)
    Unit cur, nxt; int ui = 0;
    if (!S.next(0, cur)) return;
    f32x4 acc[2][2][4][2];
#pragma unroll
    for (int a = 0; a < 2; ++a)
#pragma unroll
        for (int b = 0; b < 2; ++b)
#pragma unroll
            for (int m = 0; m < 4; ++m)
#pragma unroll
                for (int n = 0; n < 2; ++n) acc[a][b][m][n] = (f32x4){0.f, 0.f, 0.f, 0.f};
    bf16x8 At[4][2], B0[2][2], B1[2][2]; i32x8_t At8[4], B08[2], B18[2];
    int sc7f = 0x7f7f7f7f; asm volatile("" : "+v"(sc7f));
    const char* cA = (const char*)g.A + (GATHER ? (size_t)0 : (size_t)cur.pm * tstep); const char* cB = (const char*)g.Bt + (size_t)cur.pn * tstep;
    S.a_ready(cur);
    int gslot = 0;
    if constexpr (GATHER) { PG8_GOFF(0, cur); PG8_WAIT_V(0); }
    const size_t hA = GATHER ? (size_t)0 : hstep;
#define PG8_STAGE_A(bufoff, gbase, h, sl) do { if constexpr (GATHER) { const PG8_LAS unsigned* gt_ = S.gtab + (sl) * 2048 + (h) * 1024 + tid; const unsigned o_[2] = {gt_[0] * rowB + gcb[0], gt_[512] * rowB + gcb[1]}; PG8_STAGE(bufoff, gbase, o_); } \
        else PG8_STAGE(bufoff, (gbase) + (size_t)(h) * hA, voffA); } while (0)
    if constexpr (SP2) {
        PG8_STAGE_B(PG8_SB(0, 0), cB, 0); PG8_STAGE_B(PG8_SB(0, 1), cB, 1); PG8_STAGE_A(PG8_SA(0, 0), cA, 0, 0); PG8_STAGE_A(PG8_SA(0, 1), cA, 1, 0);
        if (wr == 1) PG8_BAR;
        PG8_WAIT_V(2); PG8_BAR;
        PG8_STAGE_B(PG8_SB(1, 0), cB + kstep, 0); PG8_STAGE_A(PG8_SA(1, 0), cA + kstep, 0, 0); PG8_STAGE_B(PG8_SB(1, 1), cB + kstep, 1);
        PG8_WAIT_V(6); PG8_BAR;
    } else {
        PG8_STAGE_B(PG8_SB(0, 0), cB, 0); PG8_STAGE(PG8_SA(0, 0), cA, voffA); PG8_STAGE_B(PG8_SB(0, 1), cB, 1); PG8_STAGE(PG8_SA(0, 1), cA + hstep, voffA);
        if (wr == 1) PG8_BAR;
        PG8_WAIT_V(4); PG8_BAR;
        PG8_STAGE_B(PG8_SB(1, 0), cB + kstep, 0); PG8_STAGE(PG8_SA(1, 0), cA + kstep, voffA); PG8_STAGE_B(PG8_SB(1, 1), cB + kstep, 1);
        PG8_WAIT_V(6); PG8_BAR;
    }
    for (;;) {
        const bool has_next = S.next(ui + 1, nxt);
        const char* nA = (has_next && !GATHER) ? (const char*)g.A + (size_t)nxt.pm * tstep : cA; const char* nB = has_next ? (const char*)g.Bt + (size_t)nxt.pn * tstep : cB;
        if constexpr (GATHER) { if (has_next) PG8_GOFF(gslot ^ 1, nxt); }
        bool lbp = false;
        if constexpr (Epi::LDSBIAS) { if (E.lbias) { lbp = true; __builtin_amdgcn_global_load_lds((const unsigned*)E.bias_src(cur, wc, lane), (PG8_LAS unsigned*)(E.lbias + wid * 64), 4, 0, 0); } }
        const int xtra = ((ui > 0 && E.dbg == 0) ? Epi::NSTORE : 0) + ((GATHER && has_next) ? 4 : 0) + (lbp ? 1 : 0);
#pragma unroll 1
        for (int t = 0; t < nt; t += 2) {
            const bool last = (t == nt - 2);
            const char* a1 = cA + (size_t)(t + 1) * kstep;
            const char* a2 = last ? nA : cA + (size_t)(t + 2) * kstep; const char* b2 = last ? nB : cB + (size_t)(t + 2) * kstep;
            const char* a3 = a2 + kstep; const char* b3 = b2 + kstep;
            if (last && has_next) S.a_ready(nxt);
            const int gnx = (last && has_next) ? (gslot ^ 1) : gslot;
            if constexpr (SP2) {
            PG8_LDB(B0, 0, 0); PG8_LDB(B1, 0, 1); PG8_SCHED; PG8_LDA(At, 0, 0); PG8_STAGE_A(PG8_SA(1, 1), a1, 1, gslot);
            PG8_WAIT_V1;
            PG8_WAIT_L(0); PG8_BAR; PG8_MMA(0, 0, At, B0); PG8_MMA(0, 1, At, B1); PG8_BAR; PG8_SCHED;
            PG8_LDA(At, 0, 1); PG8_STAGE_B(PG8_SB(0, 0), b2, 0); PG8_STAGE_B(PG8_SB(0, 1), b2, 1); PG8_STAGE_A(PG8_SA(0, 0), a2, 0, gnx);
            PG8_WAIT_V1;
            PG8_WAIT_L(0); PG8_BAR; PG8_MMA(1, 0, At, B0); PG8_MMA(1, 1, At, B1); PG8_BAR; PG8_SCHED;
            PG8_LDB(B0, 1, 0); PG8_LDB(B1, 1, 1); PG8_SCHED; PG8_LDA(At, 1, 0); PG8_STAGE_A(PG8_SA(0, 1), a2, 1, gnx);
            PG8_WAIT_V(8); PG8_WAIT_L(0); PG8_BAR; PG8_MMA(0, 0, At, B0); PG8_MMA(0, 1, At, B1); PG8_BAR; PG8_SCHED;
            PG8_LDA(At, 1, 1); PG8_STAGE_B(PG8_SB(1, 0), b3, 0); PG8_STAGE_B(PG8_SB(1, 1), b3, 1); PG8_STAGE_A(PG8_SA(1, 0), a3, 0, gnx);
            PG8_WAIT_V(8); PG8_WAIT_L(0); PG8_BAR; PG8_MMA(1, 0, At, B0); PG8_MMA(1, 1, At, B1); PG8_BAR; PG8_SCHED;
            } else {
            PG8_LDB(B0, 0, 0); PG8_SCHED; PG8_LDA(At, 0, 0); PG8_STAGE(PG8_SA(1, 1), a1 + hstep, voffA);
            PG8_WAIT_L(8); PG8_BAR; PG8_WAIT_L(0); PG8_MMA(0, 0, At, B0); PG8_BAR; PG8_SCHED;
            PG8_LDB(B1, 0, 1); PG8_STAGE_B(PG8_SB(0, 0), b2, 0);
            PG8_BAR; PG8_WAIT_L(0); PG8_MMA(0, 1, At, B1); PG8_BAR;
            PG8_LDA(At, 0, 1); PG8_STAGE(PG8_SA(0, 0), a2, voffA);
            PG8_BAR; PG8_WAIT_L(0); PG8_MMA(1, 0, At, B0); PG8_BAR; PG8_SCHED;
            PG8_STAGE_B(PG8_SB(0, 1), b2, 1);
            PG8_WAIT_V(6); PG8_BAR; PG8_MMA(1, 1, At, B1); PG8_BAR;
            PG8_LDB(B0, 1, 0); PG8_SCHED; PG8_LDA(At, 1, 0); PG8_STAGE(PG8_SA(0, 1), a2 + hstep, voffA);
            PG8_WAIT_L(8); PG8_BAR; PG8_WAIT_L(0); PG8_MMA(0, 0, At, B0); PG8_BAR; PG8_SCHED;
            PG8_LDB(B1, 1, 1); PG8_STAGE_B(PG8_SB(1, 0), b3, 0);
            PG8_BAR; PG8_WAIT_L(0); PG8_MMA(0, 1, At, B1); PG8_BAR;
            PG8_LDA(At, 1, 1); PG8_STAGE(PG8_SA(1, 0), a3, voffA);
            PG8_BAR; PG8_WAIT_L(0); PG8_MMA(1, 0, At, B0); PG8_BAR; PG8_SCHED;
            PG8_STAGE_B(PG8_SB(1, 1), b3, 1);
            PG8_WAIT_V(6); PG8_BAR; PG8_MMA(1, 1, At, B1); PG8_BAR;
            }
        }
        if constexpr (ALIGN_EPI) { if (wr == 0) PG8_BAR; }
        if constexpr (FP8) asm volatile("s_nop 15\n\ts_nop 15" ::: "memory");
        if constexpr (!Epi::AFTER_DRAIN) { E(acc, cur, wr, wc, fr, fq); S.done(cur); }
        if (!has_next) break;
#pragma unroll
        for (int a = 0; a < 2; ++a)
#pragma unroll
            for (int b = 0; b < 2; ++b)
#pragma unroll
                for (int m = 0; m < 4; ++m)
#pragma unroll
                    for (int n = 0; n < 2; ++n) acc[a][b][m][n] = (f32x4){0.f, 0.f, 0.f, 0.f};
        cur = nxt; cA = nA; cB = nB; ++ui;
        gslot ^= 1;
        if constexpr (ALIGN_EPI) { if (wr == 1) PG8_BAR; }
    }
    PG8_WAIT_V(0);
    if constexpr (!ALIGN_EPI) { if (wr == 0) PG8_BAR; }
    PG8_BAR;
    if constexpr (Epi::AFTER_DRAIN) { E.fused(acc, cur, wr, wc, fr, fq, lds, wid, lane); S.done(cur); }
#undef PG8_SA
#undef PG8_GOFF
#undef PG8_STAGE_A
#undef PG8_SB
#undef PG8_STAGE
#undef PG8_STAGE_B
#undef PG8_LDA
#undef PG8_LDB
#undef PG8_MMA
#undef PG8_WAIT_V
#undef PG8_WAIT_V1
#undef PG8_WAIT_L
#undef PG8_BAR
#undef PG8_SCHED
}
}
#include <hip/hip_bf16.h>
#include <cmath>
namespace attn_body {
using bf16=__hip_bfloat16;
using bf16x8=__attribute__((ext_vector_type(8)))short;
using s16x4=__attribute__((ext_vector_type(4)))short;
using f32x16=__attribute__((ext_vector_type(16)))float;
using u32x4=__attribute__((ext_vector_type(4)))unsigned;
constexpr int SEQ=4096,D=64,PIN=3072,PO=1024;
constexpr int NW=8,QBLK=32,QB=QBLK*NW,KVBLK=64,NQB=SEQ/QB;
constexpr int ATTN_UNIT_ROWS=QB;
__device__ __forceinline__ int crow(int r,int hi){return (r&3)+8*(r>>2)+4*hi;}
#define SBAR() __builtin_amdgcn_sched_barrier(0)
__device__ __forceinline__ void cmask(f32x16&p0,f32x16&p1,int jb,int qrel,int hi){
  const float NEG=-INFINITY; int kb=64*jb+4*hi;
  #pragma unroll
  for(int r=0;r<16;++r){int kv=kb+(r&3)+8*(r>>2); if(kv>qrel)p0[r]=NEG; if(kv+32>qrel)p1[r]=NEG;}
}

constexpr int NSLOT=3, SLOTB=8192;
constexpr int LDS_K=0, LDS_V=NSLOT*SLOTB, LDS_V2=2*NSLOT*SLOTB, LDS_WS=3*NSLOT*SLOTB, LDS_OST=LDS_WS+NW*64*4, LDS_BYTES=LDS_OST+NW*4096;
constexpr float C2=0.125f*1.4426950408889634f;
__device__ __forceinline__ void glds16(const void*gsrc,unsigned lds_dst){unsigned keep;
  asm volatile("s_mov_b32 %0, m0\n\ts_mov_b32 m0, %2\n\ts_nop 0\n\tglobal_load_lds_dwordx4 %1, off\n\ts_mov_b32 m0, %0":"=&s"(keep):"v"(gsrc),"s"(lds_dst):"memory");}
__device__ __forceinline__ float max3f(float a,float b,float c){float r;asm("v_max3_f32 %0, %1, %2, %3":"=v"(r):"v"(a),"v"(b),"v"(c));return r;}
__device__ __forceinline__ float max2f(float a,float b){float r;asm("v_max_f32_e32 %0, %1, %2":"=v"(r):"v"(a),"v"(b));return r;}
__device__ __forceinline__ float fadd_s(float a,float b){float r;asm("v_add_f32_e32 %0, %1, %2":"=v"(r):"v"(a),"v"(b));return r;}
__device__ __forceinline__ float fsub_s(float a,float b){float r;asm("v_sub_f32_e32 %0, %1, %2":"=v"(r):"v"(a),"v"(b));return r;}
typedef float f32x2_t __attribute__((ext_vector_type(2))); typedef __bf16 bf16x2_t __attribute__((ext_vector_type(2)));
__device__ __forceinline__ unsigned cvtpk_s(float lo,float hi){f32x2_t v={lo,hi};bf16x2_t b=__builtin_convertvector(v,bf16x2_t);return __builtin_bit_cast(unsigned,b);}
#define WAIT_BAR(N) asm volatile("s_waitcnt vmcnt(" #N ") lgkmcnt(0)\n\ts_barrier":::"memory")

__device__ __forceinline__ void qkt(f32x16&p0,f32x16&p1,const char*Kslot,const bf16x8*qr,const f32x16&negm,int r32,int hi){
  const char*kb=Kslot+hi*1024+r32*16;
  #pragma unroll
  for(int d0=0;d0<4;++d0){
    const bf16x8 b0=*reinterpret_cast<const bf16x8*>(kb+d0*2048);
    const bf16x8 b1=*reinterpret_cast<const bf16x8*>(kb+d0*2048+512);
    if(d0==0){p0=__builtin_amdgcn_mfma_f32_32x32x16_bf16(b0,qr[0],negm,0,0,0);p1=__builtin_amdgcn_mfma_f32_32x32x16_bf16(b1,qr[0],negm,0,0,0);}
    else{p0=__builtin_amdgcn_mfma_f32_32x32x16_bf16(b0,qr[d0],p0,0,0,0);p1=__builtin_amdgcn_mfma_f32_32x32x16_bf16(b1,qr[d0],p1,0,0,0);}}
}
typedef __attribute__((address_space(3))) const char* lds_cptr;
typedef short v4i16_t __attribute__((ext_vector_type(4)));
__device__ __forceinline__ void kload8(bf16x8*kf,lds_cptr kp){
  kf[0]=*(const __attribute__((address_space(3))) bf16x8*)(kp);      kf[1]=*(const __attribute__((address_space(3))) bf16x8*)(kp+512);
  kf[2]=*(const __attribute__((address_space(3))) bf16x8*)(kp+2048); kf[3]=*(const __attribute__((address_space(3))) bf16x8*)(kp+2560);
  kf[4]=*(const __attribute__((address_space(3))) bf16x8*)(kp+4096); kf[5]=*(const __attribute__((address_space(3))) bf16x8*)(kp+4608);
  kf[6]=*(const __attribute__((address_space(3))) bf16x8*)(kp+6144); kf[7]=*(const __attribute__((address_space(3))) bf16x8*)(kp+6656);
}
__device__ __forceinline__ void kload2(bf16x8*kf,lds_cptr kp,int j){ kf[2*j]=*(const __attribute__((address_space(3))) bf16x8*)(kp+j*2048); kf[2*j+1]=*(const __attribute__((address_space(3))) bf16x8*)(kp+j*2048+512); }
__device__ __forceinline__ s16x4 vtr(lds_cptr p){ return __builtin_bit_cast(s16x4,__builtin_amdgcn_ds_read_tr16_b64_v4i16((__attribute__((address_space(3))) v4i16_t*)p)); }
__device__ __forceinline__ float rowmax(const f32x16&p0,const f32x16&p1){
  float a=max3f(p0[0],p0[1],p1[0]),b=max3f(p0[2],p0[3],p1[1]);a=max3f(a,p1[2],p1[3]);
  #pragma unroll
  for(int r=4;r<16;r+=4){a=max3f(a,p0[r],p0[r+1]);b=max3f(b,p0[r+2],p0[r+3]);a=max3f(a,p1[r],p1[r+1]);b=max3f(b,p1[r+2],p1[r+3]);}
  const float m=max2f(a,b);
  auto rr=__builtin_amdgcn_permlane32_swap(__float_as_uint(m),__float_as_uint(m),false,false);
  return max2f(__uint_as_float(rr[0]),__uint_as_float(rr[1]));
}
__device__ __forceinline__ void pv(f32x16*o,int vb,bf16x8 pa0,bf16x8 pa1,bf16x8 pa2,bf16x8 pa3){
  #pragma unroll
  for(int d0=0;d0<2;++d0){s16x4 lo[4],hi[4];
    #pragma unroll
    for(int ks=0;ks<4;++ks){
      asm volatile("ds_read_b64_tr_b16 %0,%1 offset:%c2":"=&v"(lo[ks]):"v"(vb),"i"(d0*4096+ks*1024):"memory");
      asm volatile("ds_read_b64_tr_b16 %0,%1 offset:%c2":"=&v"(hi[ks]):"v"(vb),"i"(d0*4096+ks*1024+512):"memory");}
    asm volatile("s_waitcnt lgkmcnt(0)":::"memory");SBAR();
    #define PK(k) (bf16x8){lo[k][0],lo[k][1],lo[k][2],lo[k][3],hi[k][0],hi[k][1],hi[k][2],hi[k][3]}
    o[d0]=__builtin_amdgcn_mfma_f32_32x32x16_bf16(pa0,PK(0),o[d0],0,0,0);
    o[d0]=__builtin_amdgcn_mfma_f32_32x32x16_bf16(pa1,PK(1),o[d0],0,0,0);
    o[d0]=__builtin_amdgcn_mfma_f32_32x32x16_bf16(pa2,PK(2),o[d0],0,0,0);
    o[d0]=__builtin_amdgcn_mfma_f32_32x32x16_bf16(pa3,PK(3),o[d0],0,0,0);
    #undef PK
  }
}

#ifndef ATTN_STORE16
#define ATTN_STORE16(p,v) (*(u32x4*)(p)=(v))
#endif
template<int THRL> __device__ __forceinline__ void attn_unit(int b,int qb,const bf16*Q,const bf16*__restrict__ K,const bf16*__restrict__ V,bf16*O,char*shm,int cmap,float lam,float osc,const float*ng,bf16*M){
  int tid_=threadIdx.x; asm volatile("":"+v"(tid_)); const int tid=tid_,lane=tid&63,r32=lane&31,hi=lane>>5; const int wid=__builtin_amdgcn_readfirstlane(tid>>6);
  const long rowbase=(long)b*SEQ; const int q0=qb*QB;
  const bf16*Qw=Q+(rowbase+q0+wid*QBLK)*PIN;
  const bf16*Kh=K+rowbase*PIN,*Vh=V+rowbase*PIN;
  const unsigned lds0=(unsigned)(uintptr_t)shm;
  float*wsf=(float*)(shm+LDS_WS)+wid*64;
  const unsigned koff=(unsigned)(lane*PIN+wid*8)*2u, voff=(unsigned)((16*(wid&3)+(lane>>2))*PIN+(wid>>2)*32+(lane&3)*8)*2u;
  const unsigned kdst=lds0+LDS_K+wid*1024, vdst=lds0+LDS_V+wid*1024, vdst2=lds0+LDS_V2+wid*1024;
  #define DMA_K(t,slot) glds16((const char*)Kh+(size_t)(t)*(KVBLK*PIN*2)+koff,(unsigned)__builtin_amdgcn_readfirstlane(kdst+(slot)))
  #define DMA_V(t,slot) do{ glds16((const char*)Vh+(size_t)(t)*(KVBLK*PIN*2)+voff,(unsigned)__builtin_amdgcn_readfirstlane(vdst+(slot))); glds16((const char*)Vh+(size_t)(t)*(KVBLK*PIN*2)+128+voff,(unsigned)__builtin_amdgcn_readfirstlane(vdst2+(slot))); }while(0)
  const int vb0=(int)(lds0+LDS_V)+((lane>>4)&1)*32+(lane&3)*8+(4*hi+((lane&15)>>2))*64;
  const char*Kbase=shm+LDS_K; bf16x8 kf[8];
  const lds_cptr shm3=(lds_cptr)shm; const lds_cptr kp0=shm3+LDS_K+hi*1024+r32*16; const lds_cptr vp0=shm3+LDS_V+((lane>>4)&1)*32+(lane&3)*8+(4*hi+((lane&15)>>2))*64;
  const int NT=(q0+QB)/KVBLK;
  DMA_K(0,0);DMA_V(0,0);DMA_K(1,SLOTB);
  bf16x8 qr[4];
  #pragma unroll
  for(int d0=0;d0<4;++d0)qr[d0]=*reinterpret_cast<const bf16x8*>(&Qw[(long)r32*PIN+d0*16+hi*8]);
  const __attribute__((address_space(3))) bf16x8* qld=(const __attribute__((address_space(3))) bf16x8*)(shm3+LDS_OST+wid*4096)+lane;
  #pragma unroll
  for(int d0=0;d0<4;++d0)((__attribute__((address_space(3))) bf16x8*)(shm3+LDS_OST+wid*4096))[d0*64+lane]=qr[d0];
  float mhat=0.f,l_reg=0.f;f32x16 o[2];o[0]=f32x16{};o[1]=f32x16{};f32x16 o2[2];o2[0]=f32x16{};o2[1]=f32x16{}; const f32x16 zero16=f32x16{};
  const int qrel=wid*QBLK+r32;
  #define CMASK(P0,P1,t) do{int jb_=(t)-(NT-4); if(jb_>=0)cmask(P0,P1,jb_,qrel,hi);}while(0)
  bool resc=false;
  #define START(P0,P1) do{ const float rm=rowmax(P0,P1); resc=false; \
    { const float dl=rm; mhat=fadd_s(mhat,dl); \
      _Pragma("unroll") for(int r=0;r<16;++r){P0[r]=fsub_s(P0[r],dl);P1[r]=fsub_s(P1[r],dl);} } \
    _Pragma("unroll") for(int r=0;r<16;++r)P0[r]=__builtin_amdgcn_exp2f(P0[r]); }while(0)
  #define RESC() do{ if(resc){ asm volatile("s_waitcnt lgkmcnt(0)":::"memory"); \
      _Pragma("unroll") for(int d_=0;d_<2;++d_) _Pragma("unroll") for(int r=0;r<16;++r){ const float f_=wsf[crow(r,hi)]; o[d_][r]*=f_; o2[d_][r]*=f_; } } }while(0)
  f32x16 pA0,pA1,pB0,pB1;
  int sl_prev=0,sl_cur=0,sl_next=SLOTB;
  #define ROT() do{sl_prev=sl_cur;sl_cur=sl_next;sl_next=(sl_next==(NSLOT-1)*SLOTB)?0:sl_next+SLOTB;}while(0)
  DMA_K(2,2*SLOTB);
  WAIT_BAR(3);
  qkt(pA0,pA1,Kbase,qr,zero16,r32,hi);asm volatile("s_nop 15\n\ts_nop 7":"+v"(pA0),"+v"(pA1));CMASK(pA0,pA1,0);
  START(pA0,pA1);
  _Pragma("unroll") for(int r=0;r<16;++r)pA1[r]=__builtin_amdgcn_exp2f(pA1[r]);
  WAIT_BAR(0);
  DMA_K(3,0);DMA_V(1,SLOTB);
  ROT();
  kload8(kf,kp0+sl_cur);
  WAIT_BAR(3);
  s16x4 vlo[8],vhi[8]; u32x4 pw0,pw1,pw2,pw3;
  #define PKW(P,B) cvtpk_s(P[B],P[B+1])
  #define PAF(k) __builtin_bit_cast(bf16x8,pw##k)
  #define VFR(i) (bf16x8){vlo[i][0],vlo[i][1],vlo[i][2],vlo[i][3],vhi[i][0],vhi[i][1],vhi[i][2],vhi[i][3]}
  #define PIN(x) asm volatile("":"+v"(x))
  #define MX3(a,b,c) __builtin_fmaxf(__builtin_fmaxf((a),(b)),(c))
  #define GAPA(MF,A0,A1,A2,A3,W0,W1,PW) do{ MF; sacc+=A0; sacc+=A1; sacc+=A2; sacc+=A3; PIN(sacc); W0; W1; PIN(PW); SBAR(); }while(0)
  #define EX(v) __builtin_amdgcn_exp2f(v)
  #define GAPB(MF,X,B) do{ MF; X[B]=EX(X[B]-mhat); X[B+1]=EX(X[B+1]-mhat); PIN(X); SBAR(); }while(0)
  #define VRD(i) do{ vlo[i]=vtr(vp_+(((i)>>2)*4096+((i)&3)*1024)); vhi[i]=vtr(vp_+(((i)>>2)*4096+((i)&3)*1024+512)); }while(0)
  #define KRD(G,j) do{ if(G){ kload2(kf,kp0+sl_next,j); SBAR(); } }while(0)
  #define V2RD(i) do{ vlo[i]=vtr(vq_+(((i)>>2)*4096+((i)&3)*1024)); vhi[i]=vtr(vq_+(((i)>>2)*4096+((i)&3)*1024+512)); }while(0)
  #define STEP(C0,C1,P0,P1,t,GK,GV,GL) do{ SBAR(); \
    const lds_cptr vp_=vp0+sl_prev; \
    const bf16x8 q0_=qld[0],q1_=qld[64],q2_=qld[128],q3_=qld[192];     \
    VRD(0); SBAR(); float sacc=(P0[0]+P0[1]); \
    GAPA(C0=__builtin_amdgcn_mfma_f32_32x32x16_bf16(kf[0],q0_,zero16,0,0,0), P0[2],P0[3],P0[4],P0[5],     pw0[0]=PKW(P0,0), pw0[1]=PKW(P0,2), pw0); \
    VRD(4); SBAR(); GAPA(C1=__builtin_amdgcn_mfma_f32_32x32x16_bf16(kf[1],q0_,zero16,0,0,0), P0[6],P0[7],P0[8],P0[9],     pw0[2]=PKW(P0,4), pw0[3]=PKW(P0,6), pw0); \
    VRD(1); SBAR(); GAPA(C0=__builtin_amdgcn_mfma_f32_32x32x16_bf16(kf[2],q1_,C0,0,0,0),   P0[10],P0[11],P0[12],P0[13], pw1[0]=PKW(P0,8), pw1[1]=PKW(P0,10), pw1); \
    VRD(5); SBAR(); GAPA(C1=__builtin_amdgcn_mfma_f32_32x32x16_bf16(kf[3],q1_,C1,0,0,0),   P0[14],P0[15],P1[0],P1[1],   pw1[2]=PKW(P0,12),pw1[3]=PKW(P0,14), pw1); \
    VRD(2); SBAR(); GAPA(C0=__builtin_amdgcn_mfma_f32_32x32x16_bf16(kf[4],q2_,C0,0,0,0),   P1[2],P1[3],P1[4],P1[5],     pw2[0]=PKW(P1,0), pw2[1]=PKW(P1,2), pw2); \
    VRD(6); SBAR(); GAPA(C1=__builtin_amdgcn_mfma_f32_32x32x16_bf16(kf[5],q2_,C1,0,0,0),   P1[6],P1[7],P1[8],P1[9],     pw2[2]=PKW(P1,4), pw2[3]=PKW(P1,6), pw2); \
    VRD(3); SBAR(); GAPA(C0=__builtin_amdgcn_mfma_f32_32x32x16_bf16(kf[6],q3_,C0,0,0,0),   P1[10],P1[11],P1[12],P1[13], pw3[0]=PKW(P1,8), pw3[1]=PKW(P1,10), pw3); \
    VRD(7); SBAR(); GAPA(C1=__builtin_amdgcn_mfma_f32_32x32x16_bf16(kf[7],q3_,C1,0,0,0),   P1[14],P1[15],0.f,0.f,       pw3[2]=PKW(P1,12),pw3[3]=PKW(P1,14), pw3); \
    l_reg+=sacc; \
    if(GK){DMA_K((t)+3,sl_cur);} if(GV){DMA_V((t)+1,sl_next);} \
    CMASK(C0,C1,t); \
    { float a=MX3(C0[0],C0[1],C1[0]),b=MX3(C0[2],C0[3],C1[1]); a=MX3(a,C1[2],C1[3]); \
      _Pragma("unroll") for(int r=4;r<16;r+=4){a=MX3(a,C0[r],C0[r+1]);b=MX3(b,C0[r+2],C0[r+3]);a=MX3(a,C1[r],C1[r+1]);b=MX3(b,C1[r+2],C1[r+3]);} \
      float rm=__builtin_fmaxf(a,b); { auto rr=__builtin_amdgcn_permlane32_swap(__float_as_uint(rm),__float_as_uint(rm),false,false); rm=__builtin_fmaxf(__uint_as_float(rr[0]),__uint_as_float(rr[1])); } \
      rm-=mhat; resc=false; \
      if(__builtin_expect(__any(rm>(float)THRL),0)){ const float dl=__builtin_fmaxf(rm,0.f); mhat+=dl; \
        const float f=__builtin_amdgcn_exp2f(-dl); l_reg*=f; if(hi==0)wsf[r32]=f; resc=true; } } \
    SBAR(); \
    const lds_cptr vq_=vp0+(LDS_V2-LDS_V)+sl_prev;     \
    GAPB(o[0]=__builtin_amdgcn_mfma_f32_32x32x16_bf16(PAF(0),VFR(0),o[0],0,0,0), C0,0); \
    GAPB(o[1]=__builtin_amdgcn_mfma_f32_32x32x16_bf16(PAF(0),VFR(4),o[1],0,0,0), C0,2); V2RD(0); V2RD(4); SBAR(); \
    KRD(GL,0); GAPB(o[0]=__builtin_amdgcn_mfma_f32_32x32x16_bf16(PAF(1),VFR(1),o[0],0,0,0), C0,4); \
    KRD(GL,1); GAPB(o[1]=__builtin_amdgcn_mfma_f32_32x32x16_bf16(PAF(1),VFR(5),o[1],0,0,0), C0,6); V2RD(1); V2RD(5); SBAR(); \
    KRD(GL,2); GAPB(o[0]=__builtin_amdgcn_mfma_f32_32x32x16_bf16(PAF(2),VFR(2),o[0],0,0,0), C0,8); \
    KRD(GL,3); GAPB(o[1]=__builtin_amdgcn_mfma_f32_32x32x16_bf16(PAF(2),VFR(6),o[1],0,0,0), C0,10); V2RD(2); V2RD(6); SBAR(); \
    GAPB(o[0]=__builtin_amdgcn_mfma_f32_32x32x16_bf16(PAF(3),VFR(3),o[0],0,0,0), C0,12); \
    GAPB(o[1]=__builtin_amdgcn_mfma_f32_32x32x16_bf16(PAF(3),VFR(7),o[1],0,0,0), C0,14); V2RD(3); V2RD(7); SBAR(); \
    {     \
      GAPB(o2[0]=__builtin_amdgcn_mfma_f32_32x32x16_bf16(PAF(0),VFR(0),o2[0],0,0,0), C1,0); GAPB(o2[1]=__builtin_amdgcn_mfma_f32_32x32x16_bf16(PAF(0),VFR(4),o2[1],0,0,0), C1,2); \
      GAPB(o2[0]=__builtin_amdgcn_mfma_f32_32x32x16_bf16(PAF(1),VFR(1),o2[0],0,0,0), C1,4); GAPB(o2[1]=__builtin_amdgcn_mfma_f32_32x32x16_bf16(PAF(1),VFR(5),o2[1],0,0,0), C1,6); \
      GAPB(o2[0]=__builtin_amdgcn_mfma_f32_32x32x16_bf16(PAF(2),VFR(2),o2[0],0,0,0), C1,8); GAPB(o2[1]=__builtin_amdgcn_mfma_f32_32x32x16_bf16(PAF(2),VFR(6),o2[1],0,0,0), C1,10); \
      GAPB(o2[0]=__builtin_amdgcn_mfma_f32_32x32x16_bf16(PAF(3),VFR(3),o2[0],0,0,0), C1,12); GAPB(o2[1]=__builtin_amdgcn_mfma_f32_32x32x16_bf16(PAF(3),VFR(7),o2[1],0,0,0), C1,14); } \
    }while(0)
  int t=1;
  #undef CMASK
  #define CMASK(P0,P1,t) do{}while(0)
  for(;t+5<NT;t+=2){
    STEP(pB0,pB1,pA0,pA1,t,true,true,true);     WAIT_BAR(3); RESC(); ROT();
    STEP(pA0,pA1,pB0,pB1,t+1,true,true,true);   WAIT_BAR(3); RESC(); ROT();
  }
  #undef CMASK
  #define CMASK(P0,P1,t) do{int jb_=(t)-(NT-4); if(jb_>=0)cmask(P0,P1,jb_,qrel,hi);}while(0)
  #define ENDW(tt) do{ if((tt)+3<NT){WAIT_BAR(3);} else if((tt)+2<NT){WAIT_BAR(2);} else {WAIT_BAR(0);} }while(0)
  for(;t+1<NT;t+=2){
    STEP(pB0,pB1,pA0,pA1,t,(t+3<NT),(t+1<NT),(t+1<NT));       ENDW(t);   RESC(); ROT();
    STEP(pA0,pA1,pB0,pB1,t+1,(t+4<NT),(t+2<NT),(t+2<NT));     ENDW(t+1); RESC(); ROT();
  }
  STEP(pB0,pB1,pA0,pA1,NT-1,false,false,false); RESC();
  { float sacc=pB0[0]+pB0[1]; _Pragma("unroll") for(int r=2;r<16;++r)sacc+=pB0[r]; _Pragma("unroll") for(int r=0;r<16;++r)sacc+=pB1[r]; l_reg+=sacc;
    pw0=(u32x4){PKW(pB0,0),PKW(pB0,2),PKW(pB0,4),PKW(pB0,6)};pw1=(u32x4){PKW(pB0,8),PKW(pB0,10),PKW(pB0,12),PKW(pB0,14)};pw2=(u32x4){PKW(pB1,0),PKW(pB1,2),PKW(pB1,4),PKW(pB1,6)};pw3=(u32x4){PKW(pB1,8),PKW(pB1,10),PKW(pB1,12),PKW(pB1,14)};
    SBAR(); pv(o,vb0+sl_cur,PAF(0),PAF(1),PAF(2),PAF(3)); pv(o2,vb0+(LDS_V2-LDS_V)+sl_cur,PAF(0),PAF(1),PAF(2),PAF(3)); }
  #undef PKW
  #undef PAF
  #undef VFR
  #undef PIN
  #undef MX3
  #undef GAPA
  #undef GAPB
  #undef EX
  #undef VRD
  #undef KRD
  #undef V2RD
  #undef STEP
  #undef ENDW
  {auto rr=__builtin_amdgcn_permlane32_swap(__float_as_uint(l_reg),__float_as_uint(l_reg),false,false);l_reg=__uint_as_float(rr[0])+__uint_as_float(rr[1]);}
  if(hi==0)wsf[32+r32]=l_reg;asm volatile("s_waitcnt lgkmcnt(0)":::"memory");
  float rli[16];
  #pragma unroll
  for(int r=0;r<16;++r)rli[r]=__builtin_amdgcn_rcpf(wsf[32+crow(r,hi)]);
  bf16*Ow=O+(rowbase+q0+wid*QBLK)*PO;
  { bf16*stg=(bf16*)(shm+LDS_OST)+wid*2048;
    if(cmap==0){
      #pragma unroll
      for(int hf=0;hf<2;++hf){
        #pragma unroll
        for(int r=0;r<16;++r){const int orow=crow(r,hi);
          #pragma unroll
          for(int d0=0;d0<2;++d0)stg[orow*64+d0*32+r32]=__float2bfloat16((hf?o2[d0][r]:o[d0][r])*rli[r]);}
        asm volatile("s_waitcnt lgkmcnt(0)":::"memory");
        #pragma unroll
        for(int i=0;i<4;++i){const int row=i*8+(lane>>3),ch=lane&7; const u32x4 v=*(const u32x4*)(stg+row*64+ch*8); ATTN_STORE16(Ow+(long)row*PO+hf*64+ch*8,v);}
        asm volatile("s_waitcnt lgkmcnt(0)":::"memory"); }
    } else {
      asm volatile("s_waitcnt vmcnt(0)":::"memory");
      float dd[2][4][8]; const int ch=lane&7;
      #pragma unroll
      for(int hf=0;hf<2;++hf){
        #pragma unroll
        for(int r=0;r<16;++r){const int orow=crow(r,hi);
          #pragma unroll
          for(int d0=0;d0<2;++d0)stg[orow*64+d0*32+r32]=__float2bfloat16((hf?o2[d0][r]:o[d0][r])*rli[r]);}
        asm volatile("s_waitcnt lgkmcnt(0)":::"memory");
        #pragma unroll
        for(int i=0;i<4;++i){const int row=i*8+(lane>>3); const u32x4 v1=*(const u32x4*)(stg+row*64+ch*8); const u32x4 v0=*(const u32x4*)(Ow+(long)row*PO+hf*64+ch*8);
          #pragma unroll
          for(int j=0;j<4;++j){ dd[hf][i][2*j]=__uint_as_float(v0[j]<<16)-lam*__uint_as_float(v1[j]<<16); dd[hf][i][2*j+1]=__uint_as_float(v0[j]&0xffff0000u)-lam*__uint_as_float(v1[j]&0xffff0000u); } }
        asm volatile("s_waitcnt lgkmcnt(0)":::"memory"); }
      float gg[2][8];
      #pragma unroll
      for(int hf=0;hf<2;++hf){ const float4 a=*(const float4*)(ng+hf*64+ch*8), c4=*(const float4*)(ng+hf*64+ch*8+4); gg[hf][0]=a.x;gg[hf][1]=a.y;gg[hf][2]=a.z;gg[hf][3]=a.w;gg[hf][4]=c4.x;gg[hf][5]=c4.y;gg[hf][6]=c4.z;gg[hf][7]=c4.w; }
      bf16*Mw=M+(rowbase+q0+wid*QBLK)*PO;
      #pragma unroll
      for(int i=0;i<4;++i){ float ss=0.f;
        #pragma unroll
        for(int hf=0;hf<2;++hf)
          #pragma unroll
          for(int j=0;j<8;++j)ss+=dd[hf][i][j]*dd[hf][i][j];
        ss+=__shfl_xor(ss,1);ss+=__shfl_xor(ss,2);ss+=__shfl_xor(ss,4);
        const float rr=osc/sqrtf(ss*(1.0f/128.0f)+1e-5f); const int row=i*8+(lane>>3);
        #pragma unroll
        for(int hf=0;hf<2;++hf){ u32x4 w;
          #pragma unroll
          for(int j=0;j<4;++j)w[j]=cvtpk_s(dd[hf][i][2*j]*rr*gg[hf][2*j],dd[hf][i][2*j+1]*rr*gg[hf][2*j+1]);
          ATTN_STORE16(Mw+(long)row*PO+hf*64+ch*8,w); } }
    } }
  asm volatile("s_waitcnt lgkmcnt(0)\n\ts_barrier":::"memory");
  #undef DMA_K
  #undef DMA_V
  #undef CMASK
  #undef START
  #undef RESC
  #undef ROT
}
constexpr int ATTN_LDS_BYTES=LDS_BYTES;
__device__ __forceinline__ void attn_phase(char*lds,const bf16*proj,bf16*O,bf16*M,const float*ng,float lam,float osc,int vcu){
  const int bh=vcu>>3, s=vcu&7, b=bh>>2, h=bh&3;
  const bf16*V=proj+1024+h*128; bf16*Oc=O+h*128; bf16*Mc=M+h*128;
  for(int i=0;i<2;++i){ const int qb=i?15-s:s;
    for(int c=0;c<2;++c) attn_unit<8>(b,qb,proj+h*128+c*64,proj+512+h*128+c*64,V,Oc,lds,c,lam,osc,ng,Mc); }
}
#undef SBAR
#undef WAIT_BAR
}
#define GAS __attribute__((address_space(1)))
#define LAS __attribute__((address_space(3)))
typedef unsigned short bf16;
typedef unsigned v4u __attribute__((ext_vector_type(4)));
typedef float f32x4 __attribute__((ext_vector_type(4)));
typedef short bf16x8 __attribute__((ext_vector_type(8)));
typedef GAS unsigned gu32;
typedef GAS unsigned long long gu64;
#define RLX_AGENT __ATOMIC_RELAXED, __HIP_MEMORY_SCOPE_AGENT
#define LDS_WAIT() asm volatile("s_waitcnt lgkmcnt(0)" ::: "memory")
#define VM_WAIT() asm volatile("s_waitcnt vmcnt(0)" ::: "memory")
__device__ __forceinline__ unsigned long long rt() { return __builtin_amdgcn_s_memrealtime(); }
__device__ __forceinline__ unsigned f2bf(float f) { unsigned u = __builtin_bit_cast(unsigned, f); return (u + 0x7fffu + ((u >> 16) & 1u)) >> 16; }
__device__ __forceinline__ unsigned pk2(float lo, float hi) { return f2bf(lo) | (f2bf(hi) << 16); }

#define XB_TMO      128
#define XB_XCNT(j)  (256  + 64 * (j))
#define XB_XSUB(j)  (1280 + 64 * (j))
#define XB_XGEN(j)  (2304 + 64 * (j))
#define XB_TOP      3328
#define XB_TOPGEN   3392
#define XCD_BAR_WORDS 3456
#define XB_SPIN_CAP (1u << 18)

__device__ __forceinline__ unsigned xb_ld(unsigned* p)              { return __hip_atomic_load(p, __ATOMIC_RELAXED, __HIP_MEMORY_SCOPE_AGENT); }
__device__ __forceinline__ unsigned xb_add(unsigned* p, unsigned v) { return __hip_atomic_fetch_add(p, v, __ATOMIC_RELAXED, __HIP_MEMORY_SCOPE_AGENT); }
__device__ __forceinline__ unsigned xb_xcc_id() { return (unsigned)__builtin_amdgcn_s_getreg((3 << 11) | 20) & 0xFu; }
#define XB_SPIN(cond, bar) do { unsigned _sp = 0; while (cond) { __builtin_amdgcn_s_sleep(1); \
    if ((++_sp & 255u) == 0u) { if (xb_ld(&(bar)[XB_TMO])) break; if (_sp > XB_SPIN_CAP) { atomicAdd(&(bar)[XB_TMO], 1u); break; } } } } while (0)

struct XcdBarrier {
    unsigned* bar; unsigned x;
    volatile LAS unsigned* st;
};

__device__ __forceinline__ XcdBarrier xcd_barrier_post(unsigned* bar, volatile LAS unsigned* st) {
    XcdBarrier b; b.bar = bar; b.x = xb_xcc_id(); b.st = st;
    if (threadIdx.x == 0) (void)xb_add(&bar[XB_XCNT(b.x)], 1u);
    return b;
}
__device__ __forceinline__ void xcd_barrier_complete(unsigned* bar, unsigned x, unsigned& nloc, unsigned& nx) {
    const unsigned G = gridDim.x * gridDim.y * gridDim.z;
    unsigned sum, cnt, mine, sp = 0u;
    for (;;) {
        sum = 0u; cnt = 0u; mine = 0u;
#pragma unroll
        for (unsigned j = 0; j < 16; ++j) { const unsigned c = xb_ld(&bar[XB_XCNT(j)]); sum += c; cnt += (c > 0u) ? 1u : 0u; mine = (j == x) ? c : mine; }
        if (sum == G) break;
        __builtin_amdgcn_s_sleep(1);
        if ((++sp & 255u) == 0u) { if (xb_ld(&bar[XB_TMO])) break; if (sp > XB_SPIN_CAP) { atomicAdd(&bar[XB_TMO], 1u); break; } }
    }
    nloc = mine > 0u ? mine : 1u; nx = cnt > 0u ? cnt : 1u;
}

__device__ __forceinline__ void xcd_barrier(const XcdBarrier& b) {
    asm volatile("s_waitcnt vmcnt(0)" ::: "memory");
    __syncthreads();
    if (threadIdx.x == 0) {
        unsigned* bar = b.bar;
        __builtin_amdgcn_s_waitcnt(0);
        unsigned nloc = b.st[0], nx = b.st[1];
        if (nloc == 0u) { xcd_barrier_complete(bar, b.x, nloc, nx); b.st[0] = nloc; b.st[1] = nx; }
        const unsigned old = xb_add(&bar[XB_XSUB(b.x)], 1u);
        const unsigned gen = old / nloc;
        if (old + 1u == (gen + 1u) * nloc) {
            __builtin_amdgcn_fence(__ATOMIC_RELEASE, "agent");
            asm volatile("s_waitcnt vmcnt(0)" ::: "memory");
            const unsigned og = xb_add(&bar[XB_TOP], 1u);
            const unsigned tg = og / nx;
            if (og + 1u == (tg + 1u) * nx) xb_add(&bar[XB_TOPGEN], 1u);
            else XB_SPIN(xb_ld(&bar[XB_TOPGEN]) == tg, bar);
            __builtin_amdgcn_fence(__ATOMIC_ACQUIRE, "agent");
            xb_add(&bar[XB_XGEN(b.x)], 1u);
            asm volatile("s_waitcnt vmcnt(0)" ::: "memory");
        } else {
            XB_SPIN(xb_ld(&bar[XB_XGEN(b.x)]) == gen, bar);
            __builtin_amdgcn_fence(__ATOMIC_ACQUIRE, "agent");
            asm volatile("s_waitcnt vmcnt(0)" ::: "memory");
        }
    }
    __syncthreads();
}
constexpr int NWAVES = 8, NTHREADS = NWAVES * 64;
constexpr int BATCH = 8, SEQ = 4096, NTOK = BATCH * SEQ, DMODEL = 1024, INW = 3080, NPROJ = 3072, DEPTH = 4;
constexpr int NEXP = 32, DFF = 1024, CHUNK = 64, NCH = SEQ / CHUNK, NBH = BATCH * 4;
constexpr int MAXRT = (NTOK * 4) / 256 + NEXP;
constexpr float DN_ALPHA = 1.681792830507429f, LN_EPS = 1e-5f, RMS_EPS = 1e-5f;
constexpr int NPH_LAYER = 10, NPHASES = 1 + DEPTH * NPH_LAYER;

constexpr size_t MiB = 1u << 20;
constexpr size_t WS_CTL = 0, CTL_ZERO_BYTES = 1 * MiB;
constexpr size_t WS_WIN = 2 * MiB;
#ifndef MK_SIDEJOB
#define MK_SIDEJOB 0
#endif
#ifndef MK_X1R8
#define MK_X1R8 1
#endif
constexpr float X1R_SCALE = 128.0f;
#ifndef MK_OUTFP8
#define MK_OUTFP8 0
#endif
constexpr float MQ_SCALE = 16.0f, MQ_ML = 2.0f;
constexpr size_t WS_WOUT = WS_WIN + 24 * MiB;
constexpr size_t WS_WGU = WS_WOUT + 8 * MiB;
constexpr size_t WS_WDN = WS_WGU + 512 * MiB;
constexpr size_t WS_XRES = WS_WDN + 256 * MiB;
constexpr size_t WS_X1 = WS_XRES + 128 * MiB;
constexpr size_t WS_XB = WS_X1 + 128 * MiB;
constexpr size_t WS_X1B = WS_XB + 64 * MiB;
constexpr size_t WS_PROJ = WS_X1B + 64 * MiB;
constexpr size_t WS_G = WS_PROJ + 192 * MiB;
constexpr size_t WS_ATTO = WS_G + 1 * MiB;
constexpr size_t WS_MIXIN = WS_ATTO + 64 * MiB;
constexpr size_t WS_MIXO = WS_MIXIN + 64 * MiB;
constexpr size_t WS_CST = WS_MIXO + 64 * MiB;
constexpr size_t WS_NST = WS_CST + 64 * MiB;
constexpr size_t WS_MISC = WS_NST + 1 * MiB;
constexpr size_t WS_WRP = WS_MISC + 512 * 1024;
constexpr size_t WS_TOKE = WS_MISC + 1 * MiB;
constexpr size_t WS_TOKP = WS_TOKE + 1 * MiB;
constexpr size_t WS_TOKG = WS_TOKP + 1 * MiB;
constexpr size_t WS_ROWTOK = WS_TOKG + 1 * MiB;
constexpr size_t WS_H = WS_ROWTOK + 4 * MiB;
constexpr size_t WS_Y = WS_H + 272 * MiB;
constexpr size_t WS_WINQ = WS_Y + 272 * MiB;
constexpr size_t WS_XQ = WS_WINQ + 8 * MiB;
constexpr size_t WS_END = WS_XQ + 32 * MiB;
static_assert((size_t)MAXRT * 256 * 1024 * 2 <= 272 * MiB, "H/Y size");
constexpr int CW_TMO = 0, CW_CODE = 1, CW_BAR = 4096, MAX_BAR_REGIONS = 48, CW_CNT = 200000;
static_assert(CW_BAR + MAX_BAR_REGIONS * 3456 <= CW_CNT && (CW_CNT + 64 * DEPTH) * 4 <= (int)CTL_ZERO_BYTES, "CTL map");
constexpr int RING_OFF = 0, RING_BYTES = 131072;
constexpr int LDSCTL_OFF = RING_BYTES;
constexpr int MISC_OFF = LDSCTL_OFF + 320;
constexpr int LDSX_OFF = LDSCTL_OFF + 512;
constexpr int LDS_BYTES = 163840;

typedef unsigned v2u __attribute__((ext_vector_type(2)));
__device__ __forceinline__ float bflo(unsigned w) { return __uint_as_float(w << 16); }
__device__ __forceinline__ float bfhi(unsigned w) { return __uint_as_float(w & 0xffff0000u); }
__device__ __forceinline__ void unpack8(const v4u w, float* o) { o[0] = bflo(w.x); o[1] = bfhi(w.x); o[2] = bflo(w.y); o[3] = bfhi(w.y); o[4] = bflo(w.z); o[5] = bfhi(w.z); o[6] = bflo(w.w); o[7] = bfhi(w.w); }
constexpr float XQ_SCALE = 8.0f, WQ_SCALE = 512.0f, HQ_SCALE = 8.0f, YQ_SCALE = 64.0f, XLO_SCALE = 4096.0f;
#ifndef MK_XLO
#define MK_XLO 0
#endif
constexpr bool USE_XLO = (MK_XLO != 0);
__device__ __forceinline__ v2u pack8_fp8(const float* o, float sc) { int a = 0, b = 0; a = __builtin_amdgcn_cvt_pk_fp8_f32(o[0] * sc, o[1] * sc, a, false); a = __builtin_amdgcn_cvt_pk_fp8_f32(o[2] * sc, o[3] * sc, a, true);
    b = __builtin_amdgcn_cvt_pk_fp8_f32(o[4] * sc, o[5] * sc, b, false); b = __builtin_amdgcn_cvt_pk_fp8_f32(o[6] * sc, o[7] * sc, b, true); return (v2u){(unsigned)a, (unsigned)b}; }
__device__ __forceinline__ v4u pack8(const float* o) { v4u w; w.x = pk2(o[0], o[1]); w.y = pk2(o[2], o[3]); w.z = pk2(o[4], o[5]); w.w = pk2(o[6], o[7]); return w; }
__device__ __forceinline__ float wave_sum(float v) {
#pragma unroll
    for (int o = 1; o < 64; o <<= 1) v += __shfl_xor(v, o);
    return v;
}
__device__ __forceinline__ float wave_max(float v) {
#pragma unroll
    for (int o = 1; o < 64; o <<= 1) v = fmaxf(v, __shfl_xor(v, o));
    return v;
}
__device__ __forceinline__ float sigmoid_f(float x) { return 1.0f / (1.0f + __expf(-x)); }

struct Ctx {
    LAS unsigned char* lds; int wave, vcu, G; unsigned char* ws; const float* const* in; float* out;
};
__device__ __forceinline__ int ltid() { int t = threadIdx.x; asm volatile("" : "+v"(t)); return t; }
enum { I_X = 0, I_WIN, I_CONVW, I_CONVB, I_GATEB, I_LQ1, I_LK1, I_LQ2, I_LK2, I_NG, I_WOUT, I_LN1G, I_LN1B, I_WR, I_BR, I_WGU, I_BGU, I_WDN, I_BDN, I_LN2G, I_LN2B };

__device__ __forceinline__ void load_row_f32(const float* row, int lane, float* v) {
    const f32x4* p = (const f32x4*)(row + 8 * lane); const f32x4 a = p[0], b = p[1]; const f32x4* q = (const f32x4*)(row + 512 + 8 * lane); const f32x4 c = q[0], d = q[1];
    v[0] = a.x; v[1] = a.y; v[2] = a.z; v[3] = a.w; v[4] = b.x; v[5] = b.y; v[6] = b.z; v[7] = b.w; v[8] = c.x; v[9] = c.y; v[10] = c.z; v[11] = c.w; v[12] = d.x; v[13] = d.y; v[14] = d.z; v[15] = d.w;
}
__device__ __forceinline__ void store_row_f32(float* row, int lane, const float* v) {
    f32x4* p = (f32x4*)(row + 8 * lane); p[0] = (f32x4){v[0], v[1], v[2], v[3]}; p[1] = (f32x4){v[4], v[5], v[6], v[7]};
    f32x4* q = (f32x4*)(row + 512 + 8 * lane); q[0] = (f32x4){v[8], v[9], v[10], v[11]}; q[1] = (f32x4){v[12], v[13], v[14], v[15]};
}
__device__ __forceinline__ void load_row_bf16(const bf16* row, int lane, float* v) {
    const v4u a = *(const v4u*)(row + 8 * lane), b = *(const v4u*)(row + 512 + 8 * lane); unpack8(a, v); unpack8(b, v + 8);
}
__device__ __forceinline__ void load_row_fp8(const unsigned char* row, int lane, float sc, float* v) {
    typedef float f32x2_ __attribute__((ext_vector_type(2)));
    const v2u a = *(const v2u*)(row + 8 * lane), b = *(const v2u*)(row + 512 + 8 * lane); const unsigned w[4] = {a.x, a.y, b.x, b.y};
#pragma unroll
    for (int i = 0; i < 4; ++i) { const f32x2_ lo = __builtin_amdgcn_cvt_pk_f32_fp8((int)w[i], false), hi = __builtin_amdgcn_cvt_pk_f32_fp8((int)w[i], true); v[4 * i] = lo.x * sc; v[4 * i + 1] = lo.y * sc; v[4 * i + 2] = hi.x * sc; v[4 * i + 3] = hi.y * sc; }
}
__device__ __forceinline__ void store_row_fp8(unsigned char* row, int lane, const float* v, float sc) {
    *(v2u*)(row + 8 * lane) = pack8_fp8(v, sc); *(v2u*)(row + 512 + 8 * lane) = pack8_fp8(v + 8, sc);
}
__device__ __forceinline__ void store_row_bf16(bf16* row, int lane, const float* v) {
    *(v4u*)(row + 8 * lane) = pack8(v); *(v4u*)(row + 512 + 8 * lane) = pack8(v + 8);
}
__device__ __forceinline__ void store_row_fp8_nt(unsigned char* row, int lane, const float* v, float sc) {
    __builtin_nontemporal_store(pack8_fp8(v, sc), (v2u*)(row + 8 * lane)); __builtin_nontemporal_store(pack8_fp8(v + 8, sc), (v2u*)(row + 512 + 8 * lane));
}
__device__ __forceinline__ void store_row_bf16_nt(bf16* row, int lane, const float* v) {
    __builtin_nontemporal_store(pack8(v), (v4u*)(row + 8 * lane)); __builtin_nontemporal_store(pack8(v + 8), (v4u*)(row + 512 + 8 * lane));
}
__device__ __forceinline__ void store_row_f32_nt(float* row, int lane, const float* v) {
    f32x4* p = (f32x4*)(row + 8 * lane); __builtin_nontemporal_store((f32x4){v[0], v[1], v[2], v[3]}, p); __builtin_nontemporal_store((f32x4){v[4], v[5], v[6], v[7]}, p + 1);
    f32x4* q = (f32x4*)(row + 512 + 8 * lane); __builtin_nontemporal_store((f32x4){v[8], v[9], v[10], v[11]}, q); __builtin_nontemporal_store((f32x4){v[12], v[13], v[14], v[15]}, q + 1);
}
__device__ __forceinline__ void ln_row(float* v, const float* g, const float* b) {
    float s = 0.f;
#pragma unroll
    for (int i = 0; i < 16; ++i) s += v[i];
    const float mean = wave_sum(s) * (1.0f / DMODEL); float q = 0.f;
#pragma unroll
    for (int i = 0; i < 16; ++i) { v[i] -= mean; q += v[i] * v[i]; }
    const float rstd = 1.0f / sqrtf(wave_sum(q) * (1.0f / DMODEL) + LN_EPS);
#pragma unroll
    for (int i = 0; i < 16; ++i) v[i] = v[i] * rstd * g[i] + b[i];
}
__device__ __forceinline__ void load_vec16(const float* p, int lane, float* v) { load_row_f32(p, lane, v); }

__device__ __forceinline__ void load_gate_w(int tid, const float* w_in_l, LAS f32x4* wgl) {
    for (int idx = tid; idx < 2048; idx += NTHREADS) { const int ln = idx & 63, hq = idx >> 6, half = hq & 1, q = hq >> 1; const int k = (q < 8) ? (8 * ln + q) : (512 + 8 * ln + q - 8);
        wgl[idx] = *(const f32x4*)(w_in_l + (size_t)k * INW + NPROJ + 4 * half); }
}
__device__ __forceinline__ void gates_row(const float* v, const LAS f32x4* wgl, const float* gate_b, float* Grow, int lane) {
    float p[8] = {0.f, 0.f, 0.f, 0.f, 0.f, 0.f, 0.f, 0.f};
#pragma unroll
    for (int q = 0; q < 16; ++q) { const f32x4 w0 = wgl[(q * 2 + 0) * 64 + lane], w1 = wgl[(q * 2 + 1) * 64 + lane];
        p[0] += v[q] * w0.x; p[1] += v[q] * w0.y; p[2] += v[q] * w0.z; p[3] += v[q] * w0.w; p[4] += v[q] * w1.x; p[5] += v[q] * w1.y; p[6] += v[q] * w1.z; p[7] += v[q] * w1.w; }
    const bool b5 = (lane >> 5) & 1, b4 = (lane >> 4) & 1, b3 = (lane >> 3) & 1;
    float r4[4];
#pragma unroll
    for (int i = 0; i < 4; ++i) { const float keep = b5 ? p[4 + i] : p[i], send = b5 ? p[i] : p[4 + i]; r4[i] = keep + __shfl_xor(send, 32); }
    float r2[2];
#pragma unroll
    for (int i = 0; i < 2; ++i) { const float keep = b4 ? r4[2 + i] : r4[i], send = b4 ? r4[i] : r4[2 + i]; r2[i] = keep + __shfl_xor(send, 16); }
    float r1; { const float keep = b3 ? r2[1] : r2[0], send = b3 ? r2[0] : r2[1]; r1 = keep + __shfl_xor(send, 8); }
    r1 += __shfl_xor(r1, 4); r1 += __shfl_xor(r1, 2); r1 += __shfl_xor(r1, 1);
    if ((lane & 7) == 0) { const int gi = (lane >> 3); Grow[gi] = r1 + gate_b[gi]; }
}
struct TrItem { const float* src; unsigned char* dst; int ldw, Kd, fp8; float sc; };
__device__ __forceinline__ void tr_fetch(const TrItem& a, float* ra, int lane) {
    const int kk0 = lane >> 5, nn = lane & 31;
#pragma unroll
    for (int i = 0; i < 64; ++i) ra[i] = a.src[(size_t)(2 * i + kk0) * a.ldw + nn];
}
__device__ __forceinline__ void tr_put(const float* ra, LAS float* scr, int lane) {
    const int kk0 = lane >> 5, nn = lane & 31;
#pragma unroll
    for (int i = 0; i < 64; ++i) scr[(2 * i + kk0) * 33 + nn] = ra[i];
}
__device__ __forceinline__ void tr_store(const TrItem& it, const LAS float* scr, int lane) {
    const int c = lane & 7;
#pragma unroll
    for (int j = 0; j < 4; ++j) { const int n = (lane >> 3) + 8 * j; const LAS float* s = scr + (16 * c) * 33 + n; float o[16];
#pragma unroll
        for (int i = 0; i < 16; ++i) o[i] = s[i * 33];
        if (it.fp8) { const v2u p = pack8_fp8(o, it.sc), q = pack8_fp8(o + 8, it.sc); *(GAS v4u*)(it.dst + (size_t)n * it.Kd + 16 * c) = (v4u){p.x, p.y, q.x, q.y}; }
        else { GAS v4u* d = (GAS v4u*)(it.dst + ((size_t)n * it.Kd + 16 * c) * 2); d[0] = pack8(o); d[1] = pack8(o + 8); } }
}
constexpr int TR_I_IN = DEPTH * 8 * 96, TR_I_OUT = DEPTH * 8 * 32, TR_I_GU = DEPTH * NEXP * 8 * 64, TR_I_DN = DEPTH * NEXP * 8 * 32, TR_ITEMS = TR_I_IN + TR_I_OUT + TR_I_GU + TR_I_DN;
__device__ __forceinline__ TrItem tr_decode(const Ctx& C, int r) {
    TrItem it;
    if (r < TR_I_GU) { const int m = r / 512, q = r % 512, kb = q / 64, nb = q % 64, n0 = 32 * nb;
        const int nn = (n0 < 1024) ? n0 : n0 - 1024; const int drow = 256 * (nn / 128) + (nn % 128) + ((n0 < 1024) ? 0 : 128);
        it.src = C.in[I_WGU] + (size_t)m * DMODEL * 2 * DFF + (size_t)(128 * kb) * (2 * DFF) + n0; it.ldw = 2 * DFF; it.Kd = DMODEL; it.fp8 = 1; it.sc = WQ_SCALE;
        it.dst = C.ws + WS_WGU + (size_t)m * 2 * DFF * DMODEL + (size_t)drow * DMODEL + 128 * kb; return it; }
    r -= TR_I_GU;
    if (r < TR_I_DN) { const int m = r / 256, q = r % 256, kb = q / 32, nb = q % 32;
        it.src = C.in[I_WDN] + (size_t)m * DFF * DMODEL + (size_t)(128 * kb) * DMODEL + 32 * nb; it.ldw = DMODEL; it.Kd = DFF; it.fp8 = 1; it.sc = WQ_SCALE;
        it.dst = C.ws + WS_WDN + (size_t)m * DMODEL * DFF + (size_t)(32 * nb) * DFF + 128 * kb; return it; }
    r -= TR_I_DN;
    if (r < TR_I_IN) { const int l = r / 768, q = r % 768, kb = q / 96, nb = q % 96, n0 = 32 * nb, tile = n0 >> 8;
        const bool q8 = (tile >= 8); const int rank = q8 ? tile - 8 : tile; const int drow = rank * 256 + (n0 & 255);
        it.src = C.in[I_WIN] + (size_t)l * DMODEL * INW + (size_t)(128 * kb) * INW + n0; it.ldw = INW; it.Kd = DMODEL; it.fp8 = q8 ? 1 : 0; it.sc = q8 ? WQ_SCALE : 1.f;
        it.dst = q8 ? C.ws + WS_WINQ + (size_t)l * 1536 * DMODEL + (size_t)drow * DMODEL + 128 * kb : C.ws + WS_WIN + ((size_t)l * NPROJ * DMODEL + (size_t)drow * DMODEL + 128 * kb) * 2; return it; }
    r -= TR_I_IN;
    { const int l = r / 256, q = r % 256, kb = q / 32, nb = q % 32;
        it.src = C.in[I_WOUT] + (size_t)l * DMODEL * DMODEL + (size_t)(128 * kb) * DMODEL + 32 * nb; it.ldw = DMODEL; it.Kd = DMODEL; it.fp8 = MK_OUTFP8; it.sc = MK_OUTFP8 ? ((kb >= 4) ? WQ_SCALE * (MQ_SCALE / MQ_ML) : WQ_SCALE) : 1.f;
        it.dst = C.ws + WS_WOUT + ((size_t)l * DMODEL * DMODEL + (size_t)(32 * nb) * DMODEL + 128 * kb) * (MK_OUTFP8 ? 1 : 2); return it; }
}
#ifndef MK_TRQ_RUNS
#define MK_TRQ_RUNS 0
#endif
constexpr int TR_L_GU = NEXP * 8 * 64, TR_L_DN = NEXP * 8 * 32, TR_L = TR_L_GU + TR_L_DN, TR_P_ITEMS = TR_L + TR_I_IN + TR_I_OUT, TRQ_LAYERS = DEPTH - 1;
__device__ __forceinline__ int trq_per(const Ctx& C) { return (TR_L + C.G - 1) / C.G; }
__device__ __forceinline__ int trq_item(const Ctx& C, int q) {
    const int per = trq_per(C), l = 1 + q / per, i = MK_TRQ_RUNS ? (C.vcu * per + q % per) : ((q % per) * C.G + C.vcu); if (i >= TR_L) return -1;
    return (i < TR_L_GU) ? l * TR_L_GU + i : TR_I_GU + l * TR_L_DN + (i - TR_L_GU); }
__device__ __forceinline__ int trp_item(int p) { return (p < TR_L_GU) ? p : (p < TR_L) ? TR_I_GU + (p - TR_L_GU) : TR_I_GU + TR_I_DN + (p - TR_L); }
__device__ __forceinline__ void tr_one(const Ctx& C, int r, LAS float* scr, int lane) {
    float ra[64]; const TrItem it = tr_decode(C, r); tr_fetch(it, ra, lane); tr_put(ra, scr, lane); LDS_WAIT(); asm volatile("" ::: "memory"); tr_store(it, scr, lane); LDS_WAIT(); asm volatile("" ::: "memory");
}
__device__ __forceinline__ int trq_grab(const Ctx& C, int lane) { unsigned v = 0u; if (lane == 0) v = __hip_atomic_fetch_add((LAS unsigned*)(C.lds + MISC_OFF) + 11, 1u, __ATOMIC_RELAXED, __HIP_MEMORY_SCOPE_WORKGROUP); return (int)__builtin_amdgcn_readfirstlane(v); }
__device__ __forceinline__ void trq_drain(const Ctx& C, int l) {
    const int lane = ltid() & 63, per = trq_per(C), endq = l * per, total = TRQ_LAYERS * per;
    LAS float* scr = (LAS float*)(C.lds + (C.wave < 7 ? RING_OFF + C.wave * 16896 : LDSX_OFF));
    for (;;) { const int q = trq_grab(C, lane); if (q >= total) break; const int r = trq_item(C, q); if (r >= 0) tr_one(C, r, scr, lane); if (q >= endq) break; }
    __syncthreads();
}
__device__ __forceinline__ void p_prologue(const Ctx& C) {
    const int tid = ltid(), lane = tid & 63;
    const int gw = C.vcu * NWAVES + C.wave, NGW = C.G * NWAVES;
    LAS float* scr = (LAS float*)(C.lds + (C.wave < 7 ? RING_OFF + C.wave * 16896 : LDSX_OFF));
    float ra[64]; TrItem cur = tr_decode(C, trp_item(gw < TR_P_ITEMS ? gw : 0));
    if (gw < TR_P_ITEMS) tr_fetch(cur, ra, lane);
    for (int it = gw; it < TR_P_ITEMS; it += NGW) {
        tr_put(ra, scr, lane);
        const bool more = (it + NGW < TR_P_ITEMS); const TrItem nxt = tr_decode(C, trp_item(more ? it + NGW : it));
        if (more) tr_fetch(nxt, ra, lane);
        LDS_WAIT(); asm volatile("" ::: "memory");
        tr_store(cur, scr, lane);
        LDS_WAIT(); asm volatile("" ::: "memory");
        cur = nxt;
    }
    { f32x4* WRP = (f32x4*)(C.ws + WS_WRP); const int gt = (C.vcu * NWAVES + C.wave) * 64 + lane, NGT = C.G * NTHREADS;
        for (int i = gt; i < DEPTH * 8192; i += NGT) { const int l = i >> 13, idx = i & 8191, ln = idx & 63, q4 = (idx >> 6) & 3, e = idx >> 8; const int k = (q4 < 2) ? (8 * ln + 4 * q4) : (512 + 8 * ln + 4 * (q4 - 2));
            const float* wr = C.in[I_WR] + (size_t)l * DMODEL * NEXP; WRP[i] = (f32x4){wr[(size_t)k * NEXP + e], wr[(size_t)(k + 1) * NEXP + e], wr[(size_t)(k + 2) * NEXP + e], wr[(size_t)(k + 3) * NEXP + e]}; } }
    __syncthreads();
    LAS f32x4* wgl = (LAS f32x4*)(C.lds + RING_OFF);
    load_gate_w(tid, C.in[I_WIN], wgl);
    __syncthreads();
    bf16* XB = (bf16*)(C.ws + WS_XB); float* G = (float*)(C.ws + WS_G);
    unsigned char* XLO = (unsigned char*)(C.ws + WS_XRES);
    for (int n = gw; n < NTOK; n += NGW) { float v[16], lo_[16]; load_row_f32(C.in[I_X] + (size_t)n * DMODEL, lane, v); store_row_bf16(XB + (size_t)n * DMODEL, lane, v);
#pragma unroll
        for (int i = 0; i < 16; ++i) lo_[i] = v[i] - __uint_as_float(f2bf(v[i]) << 16);
        if (USE_XLO) store_row_fp8(XLO + (size_t)n * DMODEL, lane, lo_, XLO_SCALE);
        store_row_fp8((unsigned char*)(C.ws + WS_XQ) + (size_t)n * DMODEL, lane, v, XQ_SCALE);
        gates_row(v, wgl, C.in[I_GATEB], G + (size_t)n * 8, lane); }
    __syncthreads();
}

__device__ __forceinline__ void conv_silu8(const bf16* proj, int n, int t, int col, const float* cw, const float* cb, float scale, float* y) {
    const f32x4 b0 = *(const f32x4*)cb, b1 = *(const f32x4*)(cb + 4);
    y[0] = b0.x; y[1] = b0.y; y[2] = b0.z; y[3] = b0.w; y[4] = b1.x; y[5] = b1.y; y[6] = b1.z; y[7] = b1.w;
#pragma unroll
    for (int j = 0; j < 4; ++j) { const int tt = t - 3 + j;
        if (tt >= 0) { const v4u w = *(const v4u*)(proj + (size_t)(n - 3 + j) * NPROJ + col); float x[8]; unpack8(w, x);
            const f32x4 c0 = *(const f32x4*)(cw + j * 512), c1 = *(const f32x4*)(cw + j * 512 + 4);
            y[0] += c0.x * x[0]; y[1] += c0.y * x[1]; y[2] += c0.z * x[2]; y[3] += c0.w * x[3]; y[4] += c1.x * x[4]; y[5] += c1.y * x[5]; y[6] += c1.z * x[6]; y[7] += c1.w * x[7]; } }
#pragma unroll
    for (int i = 0; i < 8; ++i) y[i] = y[i] * sigmoid_f(y[i]) * scale;
}
constexpr int KP = 68;

__device__ __forceinline__ void p_mlstm_states(const Ctx& C, int l) {
    const bf16* proj = (const bf16*)(C.ws + WS_PROJ); const float* G = (const float*)(C.ws + WS_G);
    float* CST = (float*)(C.ws + WS_CST); float* NST = (float*)(C.ws + WS_NST); float* MLOC = (float*)(C.ws + WS_MISC); float* GCH = MLOC + 2048;
    const float* cw = C.in[I_CONVW] + (size_t)l * 4 * 512; const float* cb = C.in[I_CONVB] + (size_t)l * 512;
    LAS float* kf = (LAS float*)(C.lds + RING_OFF);
    LAS float* vf = kf + 64 * 64;
    LAS float* ev = vf + 64 * 128;
    const int tid = ltid(), lane = tid & 63;
    for (int u = C.vcu; u < NBH * NCH; u += C.G) {
        const int bh = u / NCH, c = u % NCH, b = bh >> 2, h = bh & 3; const int n0 = b * SEQ + c * CHUNK;
        { const int s = tid >> 3, cg = tid & 7; float y[8]; conv_silu8(proj, n0 + s, c * CHUNK + s, 1536 + 256 + h * 64 + cg * 8, cw + 256 + h * 64 + cg * 8, cb + 256 + h * 64 + cg * 8, 1.0f, y);
#pragma unroll
            for (int i = 0; i < 8; ++i) kf[s * 64 + cg * 8 + i] = y[i];
            const bf16* vp = proj + (size_t)(n0 + s) * NPROJ + 2048 + h * 128 + cg * 16; float x[16]; unpack8(*(const v4u*)vp, x); unpack8(*(const v4u*)(vp + 8), x + 8);
#pragma unroll
            for (int i = 0; i < 16; ++i) vf[s * 128 + cg * 16 + i] = x[i]; }
        if (C.wave == 0) { const float ig = G[(size_t)(n0 + lane) * 8 + h], fg = G[(size_t)(n0 + lane) * 8 + 4 + h];
            float bc = fminf(fg, 0.f) - log1pf(expf(-fabsf(fg)));
#pragma unroll
            for (int o = 1; o < 64; o <<= 1) { const float t = __shfl_up(bc, o); if (lane >= o) bc += t; }
            const float g = __shfl(bc, 63); const float w = g - bc + ig; const float m = wave_max(w);
            ev[lane] = __expf(w - m); if (lane == 0) { MLOC[u] = m; GCH[u] = g; } }
        __syncthreads();
        { const int v = tid & 127, kg = tid >> 7; float acc[16];
#pragma unroll
            for (int i = 0; i < 16; ++i) acc[i] = 0.f;
            for (int s = 0; s < 64; ++s) { const float a = ev[s] * vf[s * 128 + v];
#pragma unroll
                for (int i4 = 0; i4 < 4; ++i4) { const f32x4 k4 = *(const LAS f32x4*)(kf + s * 64 + kg * 16 + i4 * 4); acc[i4 * 4 + 0] += a * k4.x; acc[i4 * 4 + 1] += a * k4.y; acc[i4 * 4 + 2] += a * k4.z; acc[i4 * 4 + 3] += a * k4.w; } }
            float* dst = CST + (size_t)u * 8192 + v;
#pragma unroll
            for (int i = 0; i < 16; ++i) dst[(kg * 16 + i) * 128] = acc[i]; }
        if (tid < 64) { float a = 0.f; for (int s = 0; s < 64; ++s) a += ev[s] * kf[s * 64 + tid]; NST[(size_t)u * 64 + tid] = a; }
        __syncthreads();
    }
}

__device__ __forceinline__ void p_mlstm_scan(const Ctx& C) {
    v2u* CST = (v2u*)(C.ws + WS_CST); f32x4* NST = (f32x4*)(C.ws + WS_NST); const float* MLOC = (const float*)(C.ws + WS_MISC); const float* GCH = MLOC + 2048; float* MPREV = (float*)(C.ws + WS_MISC) + 4096;
    const int nthr = C.G * NTHREADS, gid = C.vcu * NTHREADS + ltid();
    for (int it = gid; it < NBH * 2064; it += nthr) {
        const int bh = it / 2064, r = it % 2064;
        if (r < 2048) {
            v2u* p = CST + (size_t)bh * NCH * 2048 + r; float carry[4] = {0.f, 0.f, 0.f, 0.f}; float m = -INFINITY;
            for (int c0 = 0; c0 < NCH; c0 += 16) {
                v2u loc[16]; float gg[16], ml[16];
#pragma unroll
                for (int j = 0; j < 16; ++j) { loc[j] = p[(size_t)(c0 + j) * 2048]; gg[j] = GCH[bh * NCH + c0 + j]; ml[j] = MLOC[bh * NCH + c0 + j]; }
#pragma unroll
                for (int j = 0; j < 16; ++j) { p[(size_t)(c0 + j) * 2048] = (v2u){pk2(carry[0], carry[1]), pk2(carry[2], carry[3])}; if (r == 0) MPREV[bh * NCH + c0 + j] = m;
                    const float mn = fmaxf(gg[j] + m, ml[j]); const float a = __expf(gg[j] + m - mn), bb = __expf(ml[j] - mn);
                    carry[0] = carry[0] * a + bflo(loc[j].x) * bb; carry[1] = carry[1] * a + bfhi(loc[j].x) * bb; carry[2] = carry[2] * a + bflo(loc[j].y) * bb; carry[3] = carry[3] * a + bfhi(loc[j].y) * bb;
                    m = mn; }
            }
        } else {
            f32x4* p = NST + (size_t)bh * NCH * 16 + (r - 2048); f32x4 carry = (f32x4){0.f, 0.f, 0.f, 0.f}; float m = -INFINITY;
            for (int c0 = 0; c0 < NCH; c0 += 8) {
                f32x4 loc[8]; float gg[8], ml[8];
#pragma unroll
                for (int j = 0; j < 8; ++j) { loc[j] = p[(size_t)(c0 + j) * 16]; gg[j] = GCH[bh * NCH + c0 + j]; ml[j] = MLOC[bh * NCH + c0 + j]; }
#pragma unroll
                for (int j = 0; j < 8; ++j) { p[(size_t)(c0 + j) * 16] = carry;
                    const float mn = fmaxf(gg[j] + m, ml[j]); const float a = __expf(gg[j] + m - mn), bb = __expf(ml[j] - mn);
                    carry = carry * a + loc[j] * bb; m = mn; }
            }
        }
    }
}

__device__ __forceinline__ void p_mlstm_out(const Ctx& C, int l) {
    const bf16* proj = (const bf16*)(C.ws + WS_PROJ); const float* G = (const float*)(C.ws + WS_G);
    const float* CST = (const float*)(C.ws + WS_CST); const float* NST = (const float*)(C.ws + WS_NST); const float* MPREV = (const float*)(C.ws + WS_MISC) + 4096;
    bf16* MIXIN = (bf16*)(C.ws + WS_MIXIN);
    const float* cw = C.in[I_CONVW] + (size_t)l * 4 * 512; const float* cb = C.in[I_CONVB] + (size_t)l * 512;
    LAS float* qf = (LAS float*)(C.lds + RING_OFF);
    LAS float* kf = qf + 64 * KP;
    LAS float* Sm = kf + 64 * KP;
    LAS float* vf = Sm + 64 * KP;
    LAS float* Ct = vf + 64 * 128;
    LAS float* sv = Ct + 64 * 128;
    static_assert((3 * 64 * KP + 2 * 64 * 128 + 6 * 64) * 4 <= RING_BYTES, "mLSTM LDS");
    const int tid = ltid(), lane = tid & 63;
    for (int u = C.vcu; u < NBH * NCH; u += C.G) {
        const int bh = u / NCH, c = u % NCH, b = bh >> 2, h = bh & 3; const int n0 = b * SEQ + c * CHUNK;
        { const int s = tid >> 3, cg = tid & 7; float y[8];
            conv_silu8(proj, n0 + s, c * CHUNK + s, 1536 + h * 64 + cg * 8, cw + h * 64 + cg * 8, cb + h * 64 + cg * 8, 0.125f, y);
#pragma unroll
            for (int i = 0; i < 8; ++i) qf[s * KP + cg * 8 + i] = y[i];
            conv_silu8(proj, n0 + s, c * CHUNK + s, 1536 + 256 + h * 64 + cg * 8, cw + 256 + h * 64 + cg * 8, cb + 256 + h * 64 + cg * 8, 1.0f, y);
#pragma unroll
            for (int i = 0; i < 8; ++i) kf[s * KP + cg * 8 + i] = y[i];
            const bf16* vp = proj + (size_t)(n0 + s) * NPROJ + 2048 + h * 128 + cg * 16; float x[16]; unpack8(*(const v4u*)vp, x); unpack8(*(const v4u*)(vp + 8), x + 8);
#pragma unroll
            for (int i = 0; i < 16; ++i) vf[s * 128 + cg * 16 + i] = x[i];
            const f32x4* cp = (const f32x4*)(CST + (size_t)u * 8192);
#pragma unroll
            for (int i = 0; i < 4; ++i) *(LAS f32x4*)(Ct + (tid + NTHREADS * i) * 4) = cp[tid + NTHREADS * i]; }
        if (C.wave == 0) { const float ig = G[(size_t)(n0 + lane) * 8 + h], fg = G[(size_t)(n0 + lane) * 8 + 4 + h]; const float mp = MPREV[u];
            float bc = fminf(fg, 0.f) - log1pf(expf(-fabsf(fg)));
#pragma unroll
            for (int o = 1; o < 64; o <<= 1) { const float t = __shfl_up(bc, o); if (lane >= o) bc += t; }
            const float a = ig - bc; float pm = a;
#pragma unroll
            for (int o = 1; o < 64; o <<= 1) { const float t = __shfl_up(pm, o); if (lane >= o) pm = fmaxf(pm, t); }
            const float mt = bc + fmaxf(mp, pm);
            sv[lane] = bc; sv[64 + lane] = a; sv[128 + lane] = mt; sv[192 + lane] = __expf(bc + mp - mt); sv[320 + lane] = NST[(size_t)u * 64 + lane]; }
        __syncthreads();
        {
            const int t = tid >> 3, sg = tid & 7; float qr[64];
#pragma unroll
            for (int i = 0; i < 16; ++i) { const f32x4 q4 = *(const LAS f32x4*)(qf + t * KP + 4 * i); qr[4 * i] = q4.x; qr[4 * i + 1] = q4.y; qr[4 * i + 2] = q4.z; qr[4 * i + 3] = q4.w; }
            const float bt = sv[t] - sv[128 + t]; float dsum = 0.f;
#pragma unroll 2
            for (int j = 0; j < 8; ++j) { const int s = sg + 8 * j; float d = 0.f;
#pragma unroll
                for (int i = 0; i < 16; ++i) { const f32x4 k4 = *(const LAS f32x4*)(kf + s * KP + 4 * i); d += qr[4 * i] * k4.x + qr[4 * i + 1] * k4.y + qr[4 * i + 2] * k4.z + qr[4 * i + 3] * k4.w; }
                const float sc = (s <= t) ? d * __expf(sv[64 + s] + bt) : 0.f; Sm[t * KP + s] = sc; dsum += sc; }
            float nq = 0.f;
#pragma unroll
            for (int i = 0; i < 8; ++i) nq += qf[t * KP + sg * 8 + i] * sv[320 + sg * 8 + i];
            dsum += sv[192 + t] * nq;
            dsum += __shfl_xor(dsum, 1); dsum += __shfl_xor(dsum, 2); dsum += __shfl_xor(dsum, 4);
            if (sg == 0) sv[256 + t] = 1.0f / fmaxf(fabsf(dsum), __expf(-sv[128 + t])); }
        __syncthreads();
        {
            const int t = tid >> 3, vg = tid & 7; float acc[16];
#pragma unroll
            for (int i = 0; i < 16; ++i) acc[i] = 0.f;
            const float iw = sv[192 + t];
            for (int k = 0; k < 64; ++k) { const float a = qf[t * KP + k] * iw;
#pragma unroll
                for (int i4 = 0; i4 < 4; ++i4) { const f32x4 c4 = *(const LAS f32x4*)(Ct + k * 128 + vg * 16 + i4 * 4); acc[i4 * 4] += a * c4.x; acc[i4 * 4 + 1] += a * c4.y; acc[i4 * 4 + 2] += a * c4.z; acc[i4 * 4 + 3] += a * c4.w; } }
            for (int s = 0; s < 64; ++s) { const float a = Sm[t * KP + s];
#pragma unroll
                for (int i4 = 0; i4 < 4; ++i4) { const f32x4 v4 = *(const LAS f32x4*)(vf + s * 128 + vg * 16 + i4 * 4); acc[i4 * 4] += a * v4.x; acc[i4 * 4 + 1] += a * v4.y; acc[i4 * 4 + 2] += a * v4.z; acc[i4 * 4 + 3] += a * v4.w; } }
            const float dn = sv[256 + t];
            const bf16* op = proj + (size_t)(n0 + t) * NPROJ + 2560 + h * 128 + vg * 16; float o[16]; unpack8(*(const v4u*)op, o); unpack8(*(const v4u*)(op + 8), o + 8);
#pragma unroll
            for (int i = 0; i < 16; ++i) o[i] = acc[i] * dn * sigmoid_f(o[i]);
            bf16* dst = MIXIN + (size_t)(n0 + t) * DMODEL + 512 + h * 128 + vg * 16; *(v4u*)dst = pack8(o); *(v4u*)(dst + 8) = pack8(o + 8); }
        __syncthreads();
    }
}

__device__ __forceinline__ void p_da_combine(const Ctx& C, int l, float lam_init) {
    const bf16* ATTO = (const bf16*)(C.ws + WS_ATTO); bf16* MIXIN = (bf16*)(C.ws + WS_MIXIN);
    const int lane = ltid() & 63, gw = C.vcu * NWAVES + C.wave, NGW = C.G * NWAVES;
    const float s1 = wave_sum(C.in[I_LQ1][l * 64 + lane] * C.in[I_LK1][l * 64 + lane]), s2 = wave_sum(C.in[I_LQ2][l * 64 + lane] * C.in[I_LK2][l * 64 + lane]);
    const float lam = expf(s1) - expf(s2) + lam_init, osc = 1.0f - lam_init;
    const int h = lane >> 4, e8 = (lane & 15) * 8;
    float g[8]; { const f32x4 a = *(const f32x4*)(C.in[I_NG] + l * 128 + e8), b2 = *(const f32x4*)(C.in[I_NG] + l * 128 + e8 + 4); g[0] = a.x; g[1] = a.y; g[2] = a.z; g[3] = a.w; g[4] = b2.x; g[5] = b2.y; g[6] = b2.z; g[7] = b2.w; }
    for (int n = gw; n < NTOK; n += NGW) {
        float o0[8], o1[8]; unpack8(*(const v4u*)(ATTO + (size_t)n * DMODEL + h * 256 + e8), o0); unpack8(*(const v4u*)(ATTO + (size_t)n * DMODEL + h * 256 + 128 + e8), o1);
        float ss = 0.f;
#pragma unroll
        for (int i = 0; i < 8; ++i) { o0[i] -= lam * o1[i]; ss += o0[i] * o0[i]; }
        ss += __shfl_xor(ss, 1); ss += __shfl_xor(ss, 2); ss += __shfl_xor(ss, 4); ss += __shfl_xor(ss, 8);
        const float r = 1.0f / sqrtf(ss * (1.0f / 128.0f) + RMS_EPS) * osc;
#pragma unroll
        for (int i = 0; i < 8; ++i) o0[i] = o0[i] * r * g[i];
        *(v4u*)(MIXIN + (size_t)n * DMODEL + h * 128 + e8) = pack8(o0);
    }
}
typedef float f32x16 __attribute__((ext_vector_type(16)));
constexpr int TP = 72;
#define MFMA32(a, b, c) __builtin_amdgcn_mfma_f32_32x32x16_bf16((a), (b), (c), 0, 0, 0)
__device__ __forceinline__ bf16x8 frag_ld(const LAS bf16* tile, int row, int step, int h) { return *(const LAS bf16x8*)(tile + row * TP + step * 16 + 8 * h); }
__device__ __forceinline__ void tr_store16(LAS bf16* tile, int c0, int s, const v4u a, const v4u b) {
    const unsigned w[8] = {a.x, a.y, a.z, a.w, b.x, b.y, b.z, b.w};
#pragma unroll
    for (int i = 0; i < 8; ++i) { tile[(c0 + 2 * i) * TP + s] = (bf16)(w[i] & 0xffffu); tile[(c0 + 2 * i + 1) * TP + s] = (bf16)(w[i] >> 16); }
}

__device__ __forceinline__ void conv_fetch(const bf16* proj, int n, int t, int col, v4u* raw) {
#pragma unroll
    for (int j = 0; j < 4; ++j) { const int tt = t - 3 + j; raw[j] = (tt >= 0) ? *(const v4u*)(proj + (size_t)(n - 3 + j) * NPROJ + col) : (v4u){0u, 0u, 0u, 0u}; }
}
__device__ __forceinline__ void conv_stage(LAS float* cwl, const float* cw, const float* cb, int ch0, int tid) {
    if (tid < 320) cwl[tid] = (tid < 256) ? cw[(tid >> 6) * 512 + ch0 + (tid & 63)] : cb[ch0 + (tid - 256)];
}
__device__ __forceinline__ void conv_apply_l(const v4u* raw, const LAS float* cwl, int c0, float scale, float* y) {
    const f32x4 b0 = *(const LAS f32x4*)(cwl + 256 + c0), b1 = *(const LAS f32x4*)(cwl + 256 + c0 + 4);
    y[0] = b0.x; y[1] = b0.y; y[2] = b0.z; y[3] = b0.w; y[4] = b1.x; y[5] = b1.y; y[6] = b1.z; y[7] = b1.w;
#pragma unroll
    for (int j = 0; j < 4; ++j) { float x[8]; unpack8(raw[j], x);
        const f32x4 c0_ = *(const LAS f32x4*)(cwl + j * 64 + c0), c1_ = *(const LAS f32x4*)(cwl + j * 64 + c0 + 4);
        y[0] += c0_.x * x[0]; y[1] += c0_.y * x[1]; y[2] += c0_.z * x[2]; y[3] += c0_.w * x[3]; y[4] += c1_.x * x[4]; y[5] += c1_.y * x[5]; y[6] += c1_.z * x[6]; y[7] += c1_.w * x[7]; }
#pragma unroll
    for (int i = 0; i < 8; ++i) y[i] = y[i] * sigmoid_f(y[i]) * scale;
}
__device__ __forceinline__ void conv_apply(const v4u* raw, const float* cw, const float* cb, float scale, float* y) {
    const f32x4 b0 = *(const f32x4*)cb, b1 = *(const f32x4*)(cb + 4);
    y[0] = b0.x; y[1] = b0.y; y[2] = b0.z; y[3] = b0.w; y[4] = b1.x; y[5] = b1.y; y[6] = b1.z; y[7] = b1.w;
#pragma unroll
    for (int j = 0; j < 4; ++j) { float x[8]; unpack8(raw[j], x);
        const f32x4 c0 = *(const f32x4*)(cw + j * 512), c1 = *(const f32x4*)(cw + j * 512 + 4);
        y[0] += c0.x * x[0]; y[1] += c0.y * x[1]; y[2] += c0.z * x[2]; y[3] += c0.w * x[3]; y[4] += c1.x * x[4]; y[5] += c1.y * x[5]; y[6] += c1.z * x[6]; y[7] += c1.w * x[7]; }
#pragma unroll
    for (int i = 0; i < 8; ++i) y[i] = y[i] * sigmoid_f(y[i]) * scale;
}

__device__ __forceinline__ void p_mlstm_states_mfma(const Ctx& C, int l) {
    const bf16* proj = (const bf16*)(C.ws + WS_PROJ); const float* G = (const float*)(C.ws + WS_G);
    bf16* CST = (bf16*)(C.ws + WS_CST); float* NST = (float*)(C.ws + WS_NST); float* MLOC = (float*)(C.ws + WS_MISC); float* GCH = MLOC + 2048;
    const float* cw = C.in[I_CONVW] + (size_t)l * 4 * 512; const float* cb = C.in[I_CONVB] + (size_t)l * 512;
    LAS bf16* KeT = (LAS bf16*)(C.lds + RING_OFF);
    LAS bf16* Vt = KeT + 64 * TP;
    LAS float* ev = (LAS float*)(Vt + 128 * TP);
    const int tid = ltid(), lane = tid & 63, r = lane & 31, h = lane >> 5, s = tid & 63, cg = tid >> 6;
    v4u rk[4], rv[2]; float rig = 0.f, rfg = 0.f;
#define ST_FETCH(u_) do { const int bh_ = (u_) / NCH, c_ = (u_) % NCH, n0_ = (bh_ >> 2) * SEQ + c_ * CHUNK, hd_ = bh_ & 3; \
        conv_fetch(proj, n0_ + s, c_ * CHUNK + s, 1536 + 256 + hd_ * 64 + cg * 8, rk); const bf16* vp_ = proj + (size_t)(n0_ + s) * NPROJ + 2048 + hd_ * 128 + cg * 16; rv[0] = *(const v4u*)vp_; rv[1] = *(const v4u*)(vp_ + 8); \
        if (C.wave == 0) { rig = G[(size_t)(n0_ + lane) * 8 + hd_]; rfg = G[(size_t)(n0_ + lane) * 8 + 4 + hd_]; } } while (0)
    if (C.vcu < NBH * NCH) ST_FETCH(C.vcu);
    for (int u = C.vcu; u < NBH * NCH; u += C.G) {
        const int bh = u / NCH, hd = bh & 3;
        if (C.wave == 0) { const float ig = rig, fg = rfg;
            float bc = fminf(fg, 0.f) - log1pf(expf(-fabsf(fg)));
#pragma unroll
            for (int o = 1; o < 64; o <<= 1) { const float t = __shfl_up(bc, o); if (lane >= o) bc += t; }
            const float g = __shfl(bc, 63); const float w = g - bc + ig; const float m = wave_max(w);
            ev[lane] = __expf(w - m); if (lane == 0) { MLOC[u] = m; GCH[u] = g; } }
        __syncthreads();
        { float y[8]; conv_apply(rk, cw + 256 + hd * 64 + cg * 8, cb + 256 + hd * 64 + cg * 8, 1.0f, y);
            const float e = ev[s];
#pragma unroll
            for (int i = 0; i < 8; ++i) KeT[(cg * 8 + i) * TP + s] = (bf16)f2bf(y[i] * e);
            tr_store16(Vt, cg * 16, s, rv[0], rv[1]); }
        if (u + C.G < NBH * NCH) ST_FETCH(u + C.G);
        __syncthreads();
        { const int kb = C.wave & 1, vb = C.wave >> 1; f32x16 acc;
#pragma unroll
            for (int i = 0; i < 16; ++i) acc[i] = 0.f;
#pragma unroll
            for (int st = 0; st < 4; ++st) acc = MFMA32(frag_ld(KeT, kb * 32 + r, st, h), frag_ld(Vt, vb * 32 + r, st, h), acc);
            bf16* dst = CST + (size_t)u * 8192 + (size_t)(vb * 32 + r) * 64 + kb * 32 + 4 * h;
#pragma unroll
            for (int g = 0; g < 4; ++g) *(v2u*)(dst + 8 * g) = (v2u){pk2(acc[4 * g], acc[4 * g + 1]), pk2(acc[4 * g + 2], acc[4 * g + 3])}; }
        if (tid < 64) { float a = 0.f;
#pragma unroll 8
            for (int s_ = 0; s_ < 64; s_ += 2) { const unsigned w = *(const LAS unsigned*)(KeT + tid * TP + s_); a += bflo(w) + bfhi(w); }
            NST[(size_t)u * 64 + tid] = a; }
    }
#undef ST_FETCH
    __syncthreads();
}

__device__ __forceinline__ void p_mlstm_out_mfma(const Ctx& C, int l) {
    const bf16* proj = (const bf16*)(C.ws + WS_PROJ); const float* G = (const float*)(C.ws + WS_G);
    const bf16* CST = (const bf16*)(C.ws + WS_CST); const float* NST = (const float*)(C.ws + WS_NST); const float* MPREV = (const float*)(C.ws + WS_MISC) + 4096;
    bf16* MIXIN = (bf16*)(C.ws + WS_MIXIN);
    const float* cw = C.in[I_CONVW] + (size_t)l * 4 * 512; const float* cb = C.in[I_CONVB] + (size_t)l * 512;
    LAS bf16* Qt = (LAS bf16*)(C.lds + RING_OFF);
    LAS bf16* Kt = Qt + 64 * TP;
    LAS bf16* St = Kt + 64 * TP;
    LAS bf16* Vt = St + 64 * TP;
    LAS bf16* Ct = Vt + 128 * TP;
    LAS float* sv = (LAS float*)(Ct + 128 * TP);
    const int tid = ltid(), lane = tid & 63, r = lane & 31, h = lane >> 5;
    const int s = tid >> 3, cg = tid & 7, s2 = tid & 63, vg = tid >> 6, cv = tid >> 2, ck0 = (tid & 3) * 16, ot = (C.wave & 1) * 32 + r, ovb = C.wave >> 1;
    v4u rq[4], rk[4], rv[2], rc[2]; v2u ro[4], roc[4]; float rig = 0.f, rfg = 0.f, rmp = 0.f, rnp = 0.f;
#define OUT_FETCH(u_) do { const int bh_ = (u_) / NCH, c_ = (u_) % NCH, n0_ = (bh_ >> 2) * SEQ + c_ * CHUNK, hd_ = bh_ & 3; \
        conv_fetch(proj, n0_ + s, c_ * CHUNK + s, 1536 + hd_ * 64 + cg * 8, rq); conv_fetch(proj, n0_ + s, c_ * CHUNK + s, 1536 + 256 + hd_ * 64 + cg * 8, rk); \
        const bf16* vp_ = proj + (size_t)(n0_ + s2) * NPROJ + 2048 + hd_ * 128 + vg * 16; rv[0] = *(const v4u*)vp_; rv[1] = *(const v4u*)(vp_ + 8); \
        const v4u* cp_ = (const v4u*)(CST + (size_t)(u_) * 8192 + cv * 64 + ck0); rc[0] = cp_[0]; rc[1] = cp_[1]; \
        const bf16* op_ = proj + (size_t)(n0_ + ot) * NPROJ + 2560 + hd_ * 128 + ovb * 32 + 4 * h; _Pragma("unroll") for (int g_ = 0; g_ < 4; ++g_) ro[g_] = *(const v2u*)(op_ + 8 * g_); \
        if (C.wave == 0) { rig = G[(size_t)(n0_ + lane) * 8 + hd_]; rfg = G[(size_t)(n0_ + lane) * 8 + 4 + hd_]; rmp = MPREV[(u_)]; rnp = NST[(size_t)(u_) * 64 + lane]; } } while (0)
    if (C.vcu < NBH * NCH) OUT_FETCH(C.vcu);
    for (int u = C.vcu; u < NBH * NCH; u += C.G) {
        const int bh = u / NCH, c = u % NCH, b = bh >> 2, hd = bh & 3; const int n0 = b * SEQ + c * CHUNK;
        __syncthreads();
        { float y[8];
            conv_apply(rq, cw + hd * 64 + cg * 8, cb + hd * 64 + cg * 8, 0.125f, y); *(LAS v4u*)(Qt + s * TP + cg * 8) = pack8(y);
            conv_apply(rk, cw + 256 + hd * 64 + cg * 8, cb + 256 + hd * 64 + cg * 8, 1.0f, y); *(LAS v4u*)(Kt + s * TP + cg * 8) = pack8(y);
            tr_store16(Vt, vg * 16, s2, rv[0], rv[1]);
            *(LAS v4u*)(Ct + cv * TP + ck0) = rc[0]; *(LAS v4u*)(Ct + cv * TP + ck0 + 8) = rc[1];
#pragma unroll
            for (int g = 0; g < 4; ++g) roc[g] = ro[g]; }
        if (C.wave == 0) { const float ig = rig, fg = rfg; const float mp = rmp;
            float bc = fminf(fg, 0.f) - log1pf(expf(-fabsf(fg)));
#pragma unroll
            for (int o = 1; o < 64; o <<= 1) { const float t = __shfl_up(bc, o); if (lane >= o) bc += t; }
            const float a = ig - bc; float pm = a;
#pragma unroll
            for (int o = 1; o < 64; o <<= 1) { const float t = __shfl_up(pm, o); if (lane >= o) pm = fmaxf(pm, t); }
            const float mt = bc + fmaxf(mp, pm);
            sv[lane] = bc; sv[64 + lane] = a; sv[128 + lane] = mt; sv[192 + lane] = __expf(bc + mp - mt); sv[256 + lane] = rnp; }
        if (u + C.G < NBH * NCH) OUT_FETCH(u + C.G);
        __syncthreads();
        if (C.wave < 4) {
            const int sb = C.wave & 1, tb = C.wave >> 1; f32x16 x;
#pragma unroll
            for (int i = 0; i < 16; ++i) x[i] = 0.f;
#pragma unroll
            for (int st = 0; st < 4; ++st) x = MFMA32(frag_ld(Kt, sb * 32 + r, st, h), frag_ld(Qt, tb * 32 + r, st, h), x);
            const int t = tb * 32 + r; const float bt = sv[t] - sv[128 + t]; float dsum = 0.f;
#pragma unroll
            for (int g = 0; g < 4; ++g) { const int s0 = sb * 32 + 8 * g + 4 * h; float w[4];
#pragma unroll
                for (int i = 0; i < 4; ++i) { const int s = s0 + i; w[i] = (s <= t) ? x[4 * g + i] * __expf(sv[64 + s] + bt) : 0.f; }
                const unsigned p0 = pk2(w[0], w[1]), p1 = pk2(w[2], w[3]); dsum += (bflo(p0) + bfhi(p0)) + (bflo(p1) + bfhi(p1));
                *(LAS v2u*)(St + t * TP + s0) = (v2u){p0, p1}; }
            sv[384 + (sb * 2 + h) * 64 + t] = dsum;
        } else if (tid < 320) {
            const int t = tid - 256; float a = 0.f;
#pragma unroll 8
            for (int k = 0; k < 64; k += 2) { const unsigned w = *(const LAS unsigned*)(Qt + t * TP + k); a += bflo(w) * sv[256 + k] + bfhi(w) * sv[256 + k + 1]; }
            sv[320 + t] = a; }
        __syncthreads();
        {
            const int vb = C.wave >> 1, tb = C.wave & 1; f32x16 acc;
#pragma unroll
            for (int i = 0; i < 16; ++i) acc[i] = 0.f;
#pragma unroll
            for (int st = 0; st < 4; ++st) acc = MFMA32(frag_ld(Ct, vb * 32 + r, st, h), frag_ld(Qt, tb * 32 + r, st, h), acc);
            const int t = tb * 32 + r; const float iw = sv[192 + t];
#pragma unroll
            for (int i = 0; i < 16; ++i) acc[i] *= iw;
#pragma unroll
            for (int st = 0; st < 4; ++st) acc = MFMA32(frag_ld(Vt, vb * 32 + r, st, h), frag_ld(St, tb * 32 + r, st, h), acc);
            const float den = ((sv[384 + t] + sv[384 + 64 + t]) + (sv[384 + 128 + t] + sv[384 + 192 + t])) + iw * sv[320 + t];
            const float dn = 1.0f / fmaxf(fabsf(den), __expf(-sv[128 + t]));
            bf16* dst = MIXIN + (size_t)(n0 + t) * DMODEL + 512 + hd * 128 + vb * 32 + 4 * h;
#pragma unroll
            for (int g = 0; g < 4; ++g) { const v2u ow = roc[g]; const float o0 = bflo(ow.x), o1 = bfhi(ow.x), o2 = bflo(ow.y), o3 = bfhi(ow.y);
                *(v2u*)(dst + 8 * g) = (v2u){pk2(acc[4 * g] * dn * sigmoid_f(o0), acc[4 * g + 1] * dn * sigmoid_f(o1)), pk2(acc[4 * g + 2] * dn * sigmoid_f(o2), acc[4 * g + 3] * dn * sigmoid_f(o3))}; } }
    }
#undef OUT_FETCH
    __syncthreads();
}
constexpr size_t WS_TOTC = WS_CST + 32 * MiB;
constexpr size_t WS_TOTN = WS_NST + 512 * 1024;
constexpr int MS_DCUM = 6144, MS_TOTM = 8192, MS_TOTG = 8448;

__device__ __forceinline__ void p_mlstm_states_seq(const Ctx& C, int l) {
    const bf16* proj = (const bf16*)(C.ws + WS_PROJ); const float* G = (const float*)(C.ws + WS_G);
    bf16* CST = (bf16*)(C.ws + WS_CST); float* NST = (float*)(C.ws + WS_NST); float* MS = (float*)(C.ws + WS_MISC); float* MPREV = MS + 4096;
    float* TOTC = (float*)(C.ws + WS_TOTC); float* TOTN = (float*)(C.ws + WS_TOTN);
    const float* cw = C.in[I_CONVW] + (size_t)l * 4 * 512; const float* cb = C.in[I_CONVB] + (size_t)l * 512;
    LAS bf16* KeT = (LAS bf16*)(C.lds + RING_OFF);
    LAS bf16* Vt = KeT + 64 * TP;
    LAS float* ev = (LAS float*)(Vt + 128 * TP);
    LAS float* cwl = ev + 80;
    const int tid = ltid(), lane = tid & 63, r = lane & 31, h = lane >> 5, s = tid & 63, cg = tid >> 6;
    v4u rkA[4], rvA[2], rkB[4], rvB[2]; float rigA = 0.f, rfgA = 0.f, rigB = 0.f, rfgB = 0.f;
#define ST_FETCH(u_) do { const int bh_ = (u_) / NCH, c_ = (u_) % NCH, n0_ = (bh_ >> 2) * SEQ + c_ * CHUNK, hd_ = bh_ & 3; \
        conv_fetch(proj, n0_ + s, c_ * CHUNK + s, 1536 + 256 + hd_ * 64 + cg * 8, rk); const bf16* vp_ = proj + (size_t)(n0_ + s) * NPROJ + 2048 + hd_ * 128 + cg * 16; rv[0] = *(const v4u*)vp_; rv[1] = *(const v4u*)(vp_ + 8); \
        if (C.wave == 0) { rig = G[(size_t)(n0_ + lane) * 8 + hd_]; rfg = G[(size_t)(n0_ + lane) * 8 + 4 + hd_]; } } while (0)
    const bool itw = MK_SIDEJOB && C.wave >= 1 && C.wave <= 6; const int itot = TRQ_LAYERS * trq_per(C);
    LAS float* iscr = (LAS float*)(C.lds + (C.wave <= 5 ? RING_OFF + 32768 + (C.wave - 1) * 16896 : LDSX_OFF));
    float ira[64]; int ir = -1;
#define SIDE_OUT() do { if (ir >= 0) { const TrItem it_ = tr_decode(C, ir); tr_put(ira, iscr, lane); LDS_WAIT(); asm volatile("" ::: "memory"); tr_store(it_, iscr, lane); LDS_WAIT(); asm volatile("" ::: "memory"); ir = -1; } } while (0)
#define SIDE_STEP() do { if (itw) { const int q_ = trq_grab(C, lane); ir = (q_ < itot) ? trq_item(C, q_) : -1; if (ir >= 0) { const TrItem it_ = tr_decode(C, ir); tr_fetch(it_, ira, lane); } } } while (0)
#define SIDE_FLUSH() do { if (itw) SIDE_OUT(); } while (0)
    for (int vc = C.vcu; vc < 256; vc += C.G) {
        const int bh = vc >> 3, hd = bh & 3, u0 = bh * NCH + (vc & 7) * 8;
        f32x16 crun; float nrun = 0.f, mrun = -INFINITY, drun = 0.f;
#pragma unroll
        for (int i = 0; i < 16; ++i) crun[i] = 0.f;
        conv_stage(cwl, cw, cb, 256 + hd * 64, tid);
        { v4u (&rk)[4] = rkA; v4u (&rv)[2] = rvA; float& rig = rigA; float& rfg = rfgA; ST_FETCH(u0); }
        { v4u (&rk)[4] = rkB; v4u (&rv)[2] = rvB; float& rig = rigB; float& rfg = rfgB; ST_FETCH(u0 + 1); }
        auto body = [&](const int j, v4u (&rk)[4], v4u (&rv)[2], float& rig, float& rfg) __attribute__((always_inline)) {
            const int u = u0 + j;
            if (C.wave == 0) { const float ig = rig, fg = rfg;
                float bc = fminf(fg, 0.f) - log1pf(expf(-fabsf(fg)));
#pragma unroll
                for (int o = 1; o < 64; o <<= 1) { const float t = __shfl_up(bc, o); if (lane >= o) bc += t; }
                const float g = __shfl(bc, 63); const float w = g - bc + ig; const float m = wave_max(w);
                ev[lane] = __expf(w - m); if (lane == 0) { ev[64] = m; ev[65] = g; } }
            __syncthreads();
            { float y[8]; conv_apply_l(rk, cwl, cg * 8, 1.0f, y);
                const float e = ev[s];
#pragma unroll
                for (int i = 0; i < 8; ++i) KeT[(cg * 8 + i) * TP + s] = (bf16)f2bf(y[i] * e);
                tr_store16(Vt, cg * 16, s, rv[0], rv[1]); }
            const float mloc = ev[64], gch = ev[65];
            SIDE_FLUSH();
            if (j < 6) ST_FETCH(u + 2);
            __syncthreads();
            const float mnew = fmaxf(gch + mrun, mloc), fa = __expf(gch + mrun - mnew), fb = __expf(mloc - mnew);
            { const int kb = C.wave & 1, vb = C.wave >> 1; f32x16 acc;
#pragma unroll
                for (int i = 0; i < 16; ++i) acc[i] = 0.f;
#pragma unroll
                for (int st = 0; st < 4; ++st) acc = MFMA32(frag_ld(KeT, kb * 32 + r, st, h), frag_ld(Vt, vb * 32 + r, st, h), acc);
                bf16* dst = CST + (size_t)u * 8192 + (size_t)(vb * 32 + r) * 64 + kb * 32 + 4 * h;
#pragma unroll
                for (int g = 0; g < 4; ++g) *(v2u*)(dst + 8 * g) = (v2u){pk2(crun[4 * g], crun[4 * g + 1]), pk2(crun[4 * g + 2], crun[4 * g + 3])};
#pragma unroll
                for (int i = 0; i < 16; ++i) crun[i] = fa * crun[i] + fb * acc[i]; }
            if (tid < 64) { float a = 0.f;
#pragma unroll 8
                for (int s_ = 0; s_ < 64; s_ += 2) { const unsigned w = *(const LAS unsigned*)(KeT + tid * TP + s_); a += bflo(w) + bfhi(w); }
                NST[(size_t)u * 64 + tid] = nrun; nrun = fa * nrun + fb * a; }
            if (tid == 0) { MPREV[u] = mrun; MS[MS_DCUM + u] = drun; }
            mrun = mnew; drun += gch;
            SIDE_STEP();
        };
#pragma unroll 1
        for (int jj = 0; jj < 8; jj += 2) { body(jj, rkA, rvA, rigA, rfgA); body(jj + 1, rkB, rvB, rigB, rfgB); }
        SIDE_FLUSH();
        { const int kb = C.wave & 1, vb = C.wave >> 1; float* dst = TOTC + (size_t)vc * 8192 + (size_t)(vb * 32 + r) * 64 + kb * 32 + 4 * h;
#pragma unroll
            for (int g = 0; g < 4; ++g) *(f32x4*)(dst + 8 * g) = (f32x4){crun[4 * g], crun[4 * g + 1], crun[4 * g + 2], crun[4 * g + 3]}; }
        if (tid < 64) TOTN[vc * 64 + tid] = nrun;
        if (tid == 0) { MS[MS_TOTM + vc] = mrun; MS[MS_TOTG + vc] = drun; }
    }
#undef ST_FETCH
#undef SIDE_STEP
#undef SIDE_FLUSH
#undef SIDE_OUT
    __syncthreads();
}

__device__ __forceinline__ void p_mlstm_out_seq(const Ctx& C, int l) {
    const bf16* proj = (const bf16*)(C.ws + WS_PROJ); const float* G = (const float*)(C.ws + WS_G);
    const bf16* CST = (const bf16*)(C.ws + WS_CST); const float* NST = (const float*)(C.ws + WS_NST); const float* MS = (const float*)(C.ws + WS_MISC); const float* MPREV = MS + 4096;
    const float* TOTC = (const float*)(C.ws + WS_TOTC); const float* TOTN = (const float*)(C.ws + WS_TOTN);
    bf16* MIXIN = (bf16*)(C.ws + WS_MIXIN);
    const float* cw = C.in[I_CONVW] + (size_t)l * 4 * 512; const float* cb = C.in[I_CONVB] + (size_t)l * 512;
    LAS bf16* Qt = (LAS bf16*)(C.lds + RING_OFF);
    LAS bf16* Kt = Qt + 64 * TP;
    LAS bf16* St = Kt + 64 * TP;
    LAS bf16* Vt = St + 64 * TP;
    LAS bf16* Ct = Vt + 128 * TP;
    LAS float* sv = (LAS float*)(Ct + 128 * TP);
    const int tid = ltid(), lane = tid & 63, r = lane & 31, h = lane >> 5;
    const int s = tid >> 3, cg = tid & 7, s2 = tid & 63, vg = tid >> 6, cv = tid >> 2, ck0 = (tid & 3) * 16, ot = (C.wave & 1) * 32 + r, ovb = C.wave >> 1;
    v4u rq[4], rk[4], rv[2], rc[2], ro[2], rop[2]; float rig = 0.f, rfg = 0.f, rml = 0.f, rdc = 0.f, rnp = 0.f;
    LAS float* Os = sv + 640;
    LAS float* cwq = Os + 64 * 132; LAS float* cwk = cwq + 320;
    static_assert((3 * 64 + 2 * 128) * TP * 2 + 640 * 4 + 64 * 132 * 4 + 640 * 4 <= RING_BYTES, "mLSTM LDS");
#define OUT_FETCH(u_) do { const int bh_ = (u_) / NCH, c_ = (u_) % NCH, n0_ = (bh_ >> 2) * SEQ + c_ * CHUNK, hd_ = bh_ & 3; \
        conv_fetch(proj, n0_ + s, c_ * CHUNK + s, 1536 + hd_ * 64 + cg * 8, rq); conv_fetch(proj, n0_ + s, c_ * CHUNK + s, 1536 + 256 + hd_ * 64 + cg * 8, rk); \
        const bf16* vp_ = proj + (size_t)(n0_ + s2) * NPROJ + 2048 + hd_ * 128 + vg * 16; rv[0] = *(const v4u*)vp_; rv[1] = *(const v4u*)(vp_ + 8); \
        const v4u* cp_ = (const v4u*)(CST + (size_t)(u_) * 8192 + cv * 64 + ck0); rc[0] = cp_[0]; rc[1] = cp_[1]; \
        const bf16* op_ = proj + (size_t)(n0_ + s) * NPROJ + 2560 + hd_ * 128 + cg * 16; ro[0] = *(const v4u*)op_; ro[1] = *(const v4u*)(op_ + 8); \
        rml = MPREV[(u_)]; rdc = MS[MS_DCUM + (u_)]; \
        if (C.wave == 0) { rig = G[(size_t)(n0_ + lane) * 8 + hd_]; rfg = G[(size_t)(n0_ + lane) * 8 + 4 + hd_]; rnp = NST[(size_t)(u_) * 64 + lane]; } } while (0)
#define OUT_FLUSH(nb_) do { float hv_[16], og_[16]; const LAS f32x4* hp_ = (const LAS f32x4*)(Os + s * 132 + cg * 16); \
        _Pragma("unroll") for (int q_ = 0; q_ < 4; ++q_) { const f32x4 t4_ = hp_[q_]; hv_[4 * q_] = t4_.x; hv_[4 * q_ + 1] = t4_.y; hv_[4 * q_ + 2] = t4_.z; hv_[4 * q_ + 3] = t4_.w; } \
        unpack8(rop[0], og_); unpack8(rop[1], og_ + 8); _Pragma("unroll") for (int i_ = 0; i_ < 16; ++i_) hv_[i_] *= sigmoid_f(og_[i_]); \
        bf16* dp_ = MIXIN + (size_t)((nb_) + s) * DMODEL + 512 + hd * 128 + cg * 16; *(v4u*)dp_ = pack8(hv_); *(v4u*)(dp_ + 8) = pack8(hv_ + 8); } while (0)
    for (int vc = C.vcu; vc < 256; vc += C.G) {
        const int bh = vc >> 3, gi = vc & 7, b = bh >> 2, hd = bh & 3, u0 = bh * NCH + gi * 8;
        conv_stage(cwq, cw, cb, hd * 64, tid); conv_stage(cwk, cw, cb, 256 + hd * 64, tid);
        OUT_FETCH(u0);
        float cin[16], nin = 0.f, min_ = -INFINITY;
#pragma unroll
        for (int i = 0; i < 16; ++i) cin[i] = 0.f;
#pragma unroll 1
        for (int g2 = 0; g2 < gi; ++g2) { const int gv = (bh << 3) + g2; const float tm = MS[MS_TOTM + gv], tg = MS[MS_TOTG + gv];
            const f32x4* tp = (const f32x4*)(TOTC + (size_t)gv * 8192 + cv * 64 + ck0); const f32x4 t0 = tp[0], t1 = tp[1], t2 = tp[2], t3 = tp[3]; const float tn = (C.wave == 0) ? TOTN[gv * 64 + lane] : 0.f;
            const float mn = fmaxf(tg + min_, tm), fa = __expf(tg + min_ - mn), fb = __expf(tm - mn);
            const float tt[16] = {t0.x, t0.y, t0.z, t0.w, t1.x, t1.y, t1.z, t1.w, t2.x, t2.y, t2.z, t2.w, t3.x, t3.y, t3.z, t3.w};
#pragma unroll
            for (int i = 0; i < 16; ++i) cin[i] = fa * cin[i] + fb * tt[i];
            nin = fa * nin + fb * tn; min_ = mn; }
#pragma unroll 1
        for (int j = 0; j < 8; ++j) {
            const int u = u0 + j, c = gi * 8 + j; const int n0 = b * SEQ + c * CHUNK;
            const float mp = fmaxf(rdc + min_, rml); const float w1 = (min_ == -INFINITY) ? 0.f : __expf(rdc + min_ - mp), w2 = (rml == -INFINITY) ? 0.f : __expf(rml - mp);
            __syncthreads();
            if (j > 0) OUT_FLUSH(n0 - CHUNK);
            { float y[8];
                conv_apply_l(rq, cwq, cg * 8, 0.125f, y); *(LAS v4u*)(Qt + s * TP + cg * 8) = pack8(y);
                conv_apply_l(rk, cwk, cg * 8, 1.0f, y); *(LAS v4u*)(Kt + s * TP + cg * 8) = pack8(y);
                tr_store16(Vt, vg * 16, s2, rv[0], rv[1]);
                float cl[16]; unpack8(rc[0], cl); unpack8(rc[1], cl + 8);
#pragma unroll
                for (int i = 0; i < 16; ++i) cl[i] = w1 * cin[i] + w2 * cl[i];
                *(LAS v4u*)(Ct + cv * TP + ck0) = pack8(cl); *(LAS v4u*)(Ct + cv * TP + ck0 + 8) = pack8(cl + 8);
                rop[0] = ro[0]; rop[1] = ro[1]; }
            if (C.wave == 0) { const float ig = rig, fg = rfg;
                float bc = fminf(fg, 0.f) - log1pf(expf(-fabsf(fg)));
#pragma unroll
                for (int o = 1; o < 64; o <<= 1) { const float t = __shfl_up(bc, o); if (lane >= o) bc += t; }
                const float a = ig - bc; float pm = a;
#pragma unroll
                for (int o = 1; o < 64; o <<= 1) { const float t = __shfl_up(pm, o); if (lane >= o) pm = fmaxf(pm, t); }
                const float mt = bc + fmaxf(mp, pm);
                sv[lane] = bc; sv[64 + lane] = a; sv[128 + lane] = mt; sv[192 + lane] = __expf(bc + mp - mt); sv[256 + lane] = w1 * nin + w2 * rnp; }
            if (j < 7) OUT_FETCH(u + 1);
            __syncthreads();
            if (C.wave < 4) {
                const int sb = C.wave & 1, tb = C.wave >> 1; f32x16 x;
#pragma unroll
                for (int i = 0; i < 16; ++i) x[i] = 0.f;
#pragma unroll
                for (int st = 0; st < 4; ++st) x = MFMA32(frag_ld(Kt, sb * 32 + r, st, h), frag_ld(Qt, tb * 32 + r, st, h), x);
                const int t = tb * 32 + r; const float bt = sv[t] - sv[128 + t]; float dsum = 0.f;
#pragma unroll
                for (int g = 0; g < 4; ++g) { const int s0 = sb * 32 + 8 * g + 4 * h; float w[4];
#pragma unroll
                    for (int i = 0; i < 4; ++i) { const int ss = s0 + i; w[i] = (ss <= t) ? x[4 * g + i] * __expf(sv[64 + ss] + bt) : 0.f; }
                    const unsigned p0 = pk2(w[0], w[1]), p1 = pk2(w[2], w[3]); dsum += (bflo(p0) + bfhi(p0)) + (bflo(p1) + bfhi(p1));
                    *(LAS v2u*)(St + t * TP + s0) = (v2u){p0, p1}; }
                sv[384 + (sb * 2 + h) * 64 + t] = dsum;
            } else if (tid < 320) {
                const int t = tid - 256; float a = 0.f;
#pragma unroll 8
                for (int k = 0; k < 64; k += 2) { const unsigned w = *(const LAS unsigned*)(Qt + t * TP + k); a += bflo(w) * sv[256 + k] + bfhi(w) * sv[256 + k + 1]; }
                sv[320 + t] = a; }
            __syncthreads();
            {
                const int vb = C.wave >> 1, tb = C.wave & 1; f32x16 acc;
#pragma unroll
                for (int i = 0; i < 16; ++i) acc[i] = 0.f;
#pragma unroll
                for (int st = 0; st < 4; ++st) acc = MFMA32(frag_ld(Ct, vb * 32 + r, st, h), frag_ld(Qt, tb * 32 + r, st, h), acc);
                const int t = tb * 32 + r; const float iw = sv[192 + t];
#pragma unroll
                for (int i = 0; i < 16; ++i) acc[i] *= iw;
#pragma unroll
                for (int st = 0; st < 4; ++st) acc = MFMA32(frag_ld(Vt, vb * 32 + r, st, h), frag_ld(St, tb * 32 + r, st, h), acc);
                const float den = ((sv[384 + t] + sv[384 + 64 + t]) + (sv[384 + 128 + t] + sv[384 + 192 + t])) + iw * sv[320 + t];
                const float dn = 1.0f / fmaxf(fabsf(den), __expf(-sv[128 + t]));
                LAS float* od = Os + t * 132 + vb * 32 + 4 * h;
#pragma unroll
                for (int g = 0; g < 4; ++g) *(LAS f32x4*)(od + 8 * g) = (f32x4){acc[4 * g] * dn, acc[4 * g + 1] * dn, acc[4 * g + 2] * dn, acc[4 * g + 3] * dn}; }
        }
        __syncthreads();
        OUT_FLUSH(b * SEQ + (gi * 8 + 7) * CHUNK);
    }
#undef OUT_FETCH
#undef OUT_FLUSH
    __syncthreads();
}
template <int W> __device__ __forceinline__ void tr_reduce_step(float* val, bool bit, int mask) {
#pragma unroll
    for (int i = 0; i < W / 2; ++i) { const float keep = bit ? val[i + W / 2] : val[i], send = bit ? val[i] : val[i + W / 2]; val[i] = keep + __shfl_xor(send, mask); }
}
__device__ __forceinline__ void p_ln1_router(const Ctx& C, int l, bool claim = true, bool norouter = false, bool nostore = false, bool norows = false, int stsel = 3) {
    const bf16* XBr = (const bf16*)(C.ws + WS_XB); const unsigned char* XLO = (const unsigned char*)(C.ws + WS_XRES);
    const bf16* MIXO = (const bf16*)(C.ws + WS_MIXO); float* X1 = (float*)(C.ws + WS_X1); unsigned char* X1Q = (unsigned char*)(C.ws + WS_X1B);
    int* TOKE = (int*)(C.ws + WS_TOKE); int* TOKP = (int*)(C.ws + WS_TOKP); float* TOKG = (float*)(C.ws + WS_TOKG); int* ROWTOK = (int*)(C.ws + WS_ROWTOK);
    unsigned* cntg = (unsigned*)(C.ws + WS_CTL) + CW_CNT + 64 * l;
    const float* br = C.in[I_BR] + l * NEXP;
    LAS f32x4* wl = (LAS f32x4*)(C.lds + RING_OFF);
    LAS float* lg = (LAS float*)(C.lds + LDSX_OFF) + C.wave * (16 * 32);
    LAS int* lc = (LAS int*)(C.lds + LDSX_OFF + 8 * 16 * 32 * 4);
    const int tid = ltid(), lane = tid & 63;
    { const f32x4* WRP = (const f32x4*)(C.ws + WS_WRP) + (size_t)l * 8192;
        for (int idx = tid; idx < 8192; idx += NTHREADS) wl[idx] = WRP[idx]; }
    LAS f32x4* gbl = (LAS f32x4*)(C.lds + LDSX_OFF + 8 * 16 * 32 * 4 + 512);
    { float g_[16], b_[16]; load_vec16(C.in[I_LN1G] + l * DMODEL, lane, g_); load_vec16(C.in[I_LN1B] + l * DMODEL, lane, b_);
      if (C.wave == 0) {
#pragma unroll
        for (int q = 0; q < 4; ++q) { gbl[q * 64 + lane] = (f32x4){g_[4 * q], g_[4 * q + 1], g_[4 * q + 2], g_[4 * q + 3]}; gbl[(4 + q) * 64 + lane] = (f32x4){b_[4 * q], b_[4 * q + 1], b_[4 * q + 2], b_[4 * q + 3]}; } } }
    const int gw = C.vcu * NWAVES + C.wave, NGW = C.G * NWAVES, NGRP = NTOK / 4;
    for (int g0 = gw; g0 < NGRP; g0 += 4 * NGW) {
        if (tid < 64) lc[tid] = 0;
        __syncthreads();
        v4u pxb[4][2], pmx[4][2]; v2u plo[4][2] = {};
#define LN1_FETCH(grp_) do { _Pragma("unroll") for (int r = 0; r < 4; ++r) { const size_t n_ = (size_t)((grp_) * 4 + r) * DMODEL; \
            pxb[r][0] = __builtin_nontemporal_load((const v4u*)(XBr + n_ + 8 * lane)); pxb[r][1] = __builtin_nontemporal_load((const v4u*)(XBr + n_ + 512 + 8 * lane)); if (USE_XLO) { plo[r][0] = *(const v2u*)(XLO + n_ + 8 * lane); plo[r][1] = *(const v2u*)(XLO + n_ + 512 + 8 * lane); } \
            pmx[r][0] = __builtin_nontemporal_load((const v4u*)(MIXO + n_ + 8 * lane)); pmx[r][1] = __builtin_nontemporal_load((const v4u*)(MIXO + n_ + 512 + 8 * lane)); } } while (0)
        LN1_FETCH(g0);
#pragma unroll 1
        for (int blk = norows ? 4 : 0; blk < 4; ++blk) {
            const int grp = g0 + blk * NGW; if (grp >= NGRP) break;
            float xv[4][16];
#pragma unroll
            for (int r = 0; r < 4; ++r) { const size_t n = (size_t)(grp * 4 + r); float m[16]; typedef float f32x2_ __attribute__((ext_vector_type(2)));
                unpack8(pxb[r][0], xv[r]); unpack8(pxb[r][1], xv[r] + 8); unpack8(pmx[r][0], m); unpack8(pmx[r][1], m + 8);
                const unsigned w_[4] = {plo[r][0].x, plo[r][0].y, plo[r][1].x, plo[r][1].y};
#pragma unroll
                for (int i = 0; i < (USE_XLO ? 4 : 0); ++i) { const f32x2_ lo = __builtin_amdgcn_cvt_pk_f32_fp8((int)w_[i], false), hi = __builtin_amdgcn_cvt_pk_f32_fp8((int)w_[i], true);
                    xv[r][4 * i] += lo.x * (1.0f / XLO_SCALE); xv[r][4 * i + 1] += lo.y * (1.0f / XLO_SCALE); xv[r][4 * i + 2] += hi.x * (1.0f / XLO_SCALE); xv[r][4 * i + 3] += hi.y * (1.0f / XLO_SCALE); }
#pragma unroll
                for (int i = 0; i < 16; ++i) xv[r][i] = DN_ALPHA * xv[r][i] + m[i];
                { float gam[16], bet[16];
#pragma unroll
                  for (int q = 0; q < 4; ++q) { const f32x4 g4_ = gbl[q * 64 + lane], b4_ = gbl[(4 + q) * 64 + lane]; gam[4 * q] = g4_.x; gam[4 * q + 1] = g4_.y; gam[4 * q + 2] = g4_.z; gam[4 * q + 3] = g4_.w; bet[4 * q] = b4_.x; bet[4 * q + 1] = b4_.y; bet[4 * q + 2] = b4_.z; bet[4 * q + 3] = b4_.w; }
                  ln_row(xv[r], gam, bet); }
                if (!nostore) { typedef float f32x2q __attribute__((ext_vector_type(2)));
                    const v2u p0 = pack8_fp8(xv[r], XQ_SCALE), p1 = pack8_fp8(xv[r] + 8, XQ_SCALE); __builtin_nontemporal_store(p0, (v2u*)(X1Q + n * DMODEL + 8 * lane)); __builtin_nontemporal_store(p1, (v2u*)(X1Q + n * DMODEL + 512 + 8 * lane));
                    const unsigned pw_[4] = {p0.x, p0.y, p1.x, p1.y}; float rem_[16];
#pragma unroll
                    for (int i = 0; i < 4; ++i) { const f32x2q lo = __builtin_amdgcn_cvt_pk_f32_fp8((int)pw_[i], false), hi = __builtin_amdgcn_cvt_pk_f32_fp8((int)pw_[i], true);
                        rem_[4 * i] = xv[r][4 * i] - lo.x * (1.0f / XQ_SCALE); rem_[4 * i + 1] = xv[r][4 * i + 1] - lo.y * (1.0f / XQ_SCALE); rem_[4 * i + 2] = xv[r][4 * i + 2] - hi.x * (1.0f / XQ_SCALE); rem_[4 * i + 3] = xv[r][4 * i + 3] - hi.y * (1.0f / XQ_SCALE); }
                    if (MK_X1R8) { unsigned char* rr_ = (unsigned char*)X1 + n * DMODEL; __builtin_nontemporal_store(pack8_fp8(rem_, X1R_SCALE), (v2u*)(rr_ + 8 * lane)); __builtin_nontemporal_store(pack8_fp8(rem_ + 8, X1R_SCALE), (v2u*)(rr_ + 512 + 8 * lane)); }
                    else { bf16* rr_ = (bf16*)X1 + n * DMODEL; __builtin_nontemporal_store(pack8(rem_), (v4u*)(rr_ + 8 * lane)); __builtin_nontemporal_store(pack8(rem_ + 8), (v4u*)(rr_ + 512 + 8 * lane)); }   } else if (xv[r][0] == 123.456f) X1[n * DMODEL + lane] = xv[r][1]; }
            if (blk < 3 && g0 + (blk + 1) * NGW < NGRP) LN1_FETCH(g0 + (blk + 1) * NGW);
            typedef float f32x2p __attribute__((ext_vector_type(2)));
            f32x2p xa[16], xb[16];
#pragma unroll
            for (int i = 0; i < 16; ++i) { xa[i] = (f32x2p){xv[0][i], xv[1][i]}; xb[i] = (f32x2p){xv[2][i], xv[3][i]}; }
#pragma unroll 1
            for (int q = norouter ? 4 : 0; q < 4; ++q) {
                float acc[32];
#pragma unroll
                for (int e = 0; e < 8; ++e) { const LAS f32x4* wp = wl + ((q * 8 + e) * 4) * 64 + lane; const f32x4 w0 = wp[0], w1 = wp[64], w2 = wp[128], w3 = wp[192];
                    const float ww[16] = {w0.x, w0.y, w0.z, w0.w, w1.x, w1.y, w1.z, w1.w, w2.x, w2.y, w2.z, w2.w, w3.x, w3.y, w3.z, w3.w};
                    f32x2p a = xa[0] * ww[0], b = xb[0] * ww[0];
#pragma unroll
                    for (int i = 1; i < 16; ++i) { a += xa[i] * ww[i]; b += xb[i] * ww[i]; }
                    acc[0 * 8 + e] = a.x; acc[1 * 8 + e] = a.y; acc[2 * 8 + e] = b.x; acc[3 * 8 + e] = b.y; }
                tr_reduce_step<32>(acc, (lane >> 4) & 1, 16); tr_reduce_step<16>(acc, (lane >> 3) & 1, 8); tr_reduce_step<8>(acc, (lane >> 2) & 1, 4); tr_reduce_step<4>(acc, (lane >> 1) & 1, 2); tr_reduce_step<2>(acc, lane & 1, 1);
                const float tot = acc[0] + __shfl_xor(acc[0], 32);
                if (lane < 32) lg[(blk * 4 + (lane >> 3)) * 32 + q * 8 + (lane & 7)] = tot + br[q * 8 + (lane & 7)];
            }
        }
#undef LN1_FETCH
        LDS_WAIT(); asm volatile("" ::: "memory");
        int te[4] = {0, 0, 0, 0}, tp[4] = {0, 0, 0, 0}; float tg[4] = {0.f, 0.f, 0.f, 0.f};
        if (lane < 16 && (g0 + (lane >> 2) * NGW) < NGRP) {
            float lv[32];
#pragma unroll
            for (int e = 0; e < 32; ++e) lv[e] = lg[lane * 32 + e];
            unsigned taken = 0u; float val[4];
#pragma unroll
            for (int k = 0; k < 4; ++k) { int bi = 0; float bv = -INFINITY;
#pragma unroll
                for (int e = 0; e < 32; ++e) { const bool ok = !((taken >> e) & 1u) && (lv[e] > bv); bv = ok ? lv[e] : bv; bi = ok ? e : bi; }
                te[k] = bi; val[k] = bv; taken |= 1u << bi; }
            float s = 0.f;
#pragma unroll
            for (int k = 0; k < 4; ++k) { tg[k] = expf(val[k] - val[0]); s += tg[k]; }
#pragma unroll
            for (int k = 0; k < 4; ++k) { tg[k] = tg[k] / s; tp[k] = __hip_atomic_fetch_add(lc + te[k], 1, __ATOMIC_RELAXED, __HIP_MEMORY_SCOPE_WORKGROUP); }
        }
        __syncthreads();
        if (tid < 32 && claim) lc[32 + tid] = (int)__hip_atomic_fetch_add(cntg + tid, (unsigned)lc[tid], __ATOMIC_RELAXED, __HIP_MEMORY_SCOPE_AGENT);
        __syncthreads();
        const int mygrp = g0 + (lane >> 2) * NGW;
        if (lane < 16 && claim && mygrp < NGRP) { const int n = mygrp * 4 + (lane & 3);
#pragma unroll
            for (int k = 0; k < 4; ++k) { const int pos = lc[32 + te[k]] + tp[k]; TOKE[n * 4 + k] = te[k]; TOKP[n * 4 + k] = pos; TOKG[n * 4 + k] = tg[k]; ROWTOK[(size_t)te[k] * NTOK + pos] = n; } }
        __syncthreads();
    }
}

__device__ __forceinline__ void moe_tables(const Ctx& C, int l) {
    LAS int* ts = (LAS int*)(C.lds + LDSCTL_OFF); LAS int* cn = (LAS int*)(C.lds + LDSCTL_OFF + 160);
    const unsigned* cntg = (const unsigned*)(C.ws + WS_CTL) + CW_CNT + 64 * l;
    const int tid = ltid();
    if (tid < 64) { const int lane = tid; const int c = (lane < 32) ? (int)__hip_atomic_load(cntg + lane, __ATOMIC_RELAXED, __HIP_MEMORY_SCOPE_AGENT) : 0; int t = (c + 255) >> 8;
        int inc = t;
#pragma unroll
        for (int o = 1; o < 64; o <<= 1) { const int x = __shfl_up(inc, o); if (lane >= o) inc += x; }
        if (lane < 32) { cn[lane] = c; ts[lane] = inc - t; } if (lane == 32) ts[32] = inc; }
    __syncthreads();
}

__device__ __forceinline__ void p_ln2_combine(const Ctx& C, int l) {
    const bf16* X1 = (const bf16*)(C.ws + WS_X1); const unsigned char* X1Q = (const unsigned char*)(C.ws + WS_X1B); const unsigned char* Y = (const unsigned char*)(C.ws + WS_Y);
    const int* TOKE = (const int*)(C.ws + WS_TOKE); const int* TOKP = (const int*)(C.ws + WS_TOKP); const float* TOKG = (const float*)(C.ws + WS_TOKG);
    float* xo = C.out; unsigned char* XLOw = (unsigned char*)(C.ws + WS_XRES); bf16* XB = (bf16*)(C.ws + WS_XB); float* G = (float*)(C.ws + WS_G);
    const LAS int* ts = (const LAS int*)(C.lds + LDSCTL_OFF);
    LAS f32x4* wgl = (LAS f32x4*)(C.lds + RING_OFF);
    const int tid = ltid(), lane = tid & 63, gw = C.vcu * NWAVES + C.wave, NGW = C.G * NWAVES; const bool nextl = (l + 1 < DEPTH);
    if (nextl) load_gate_w(tid, C.in[I_WIN] + (size_t)(l + 1) * DMODEL * INW, wgl);
    __syncthreads();
    float gam[16], bet[16]; load_vec16(C.in[I_LN2G] + l * DMODEL, lane, gam); load_vec16(C.in[I_LN2B] + l * DMODEL, lane, bet);
    typedef int i32x4_ __attribute__((ext_vector_type(4)));
    i32x4_ ne[2], np[2]; f32x4 ng_[2];
#define LN2_ROUTE(n0_) do { _Pragma("unroll") for (int q = 0; q < 2; ++q) { int nn = (n0_) + q * NGW; nn = nn < NTOK ? nn : (NTOK - 1); ne[q] = *(const i32x4_*)(TOKE + nn * 4); np[q] = *(const i32x4_*)(TOKP + nn * 4); ng_[q] = *(const f32x4*)(TOKG + nn * 4); } } while (0)
    LN2_ROUTE(gw);
    for (int n = gw; n < NTOK; n += 2 * NGW) {
        v4u xr[2][2]; v2u xr8[2][2]; v2u xq[2][2]; v2u yr[2][4][2]; f32x4 g4[2]; int nrow[2];
#pragma unroll
        for (int q = 0; q < 2; ++q) { int nn = n + q * NGW; nn = nn < NTOK ? nn : (NTOK - 1); nrow[q] = nn; g4[q] = ng_[q];
            if (MK_X1R8) { const unsigned char* xp = (const unsigned char*)X1 + (size_t)nn * DMODEL; xr8[q][0] = __builtin_nontemporal_load((const v2u*)(xp + 8 * lane)); xr8[q][1] = __builtin_nontemporal_load((const v2u*)(xp + 512 + 8 * lane)); }
            else { const bf16* xp = X1 + (size_t)nn * DMODEL; xr[q][0] = __builtin_nontemporal_load((const v4u*)(xp + 8 * lane)); xr[q][1] = __builtin_nontemporal_load((const v4u*)(xp + 512 + 8 * lane)); }
            const unsigned char* xqp = X1Q + (size_t)nn * DMODEL; xq[q][0] = __builtin_nontemporal_load((const v2u*)(xqp + 8 * lane)); xq[q][1] = __builtin_nontemporal_load((const v2u*)(xqp + 512 + 8 * lane));
#pragma unroll
            for (int k = 0; k < 4; ++k) { const unsigned char* yp = Y + ((size_t)ts[ne[q][k]] * 256 + np[q][k]) * DMODEL; yr[q][k][0] = __builtin_nontemporal_load((const v2u*)(yp + 8 * lane)); yr[q][k][1] = __builtin_nontemporal_load((const v2u*)(yp + 512 + 8 * lane)); } }
        if (n + 2 * NGW < NTOK) LN2_ROUTE(n + 2 * NGW);
#pragma unroll
        for (int q = 0; q < 2; ++q) {
            if (q == 1 && n + NGW >= NTOK) break;
            typedef float f32x2_ __attribute__((ext_vector_type(2)));
            float v[16];
            if (MK_X1R8) { const unsigned w[4] = {xr8[q][0].x, xr8[q][0].y, xr8[q][1].x, xr8[q][1].y};
#pragma unroll
              for (int i = 0; i < 4; ++i) { const f32x2_ lo = __builtin_amdgcn_cvt_pk_f32_fp8((int)w[i], false), hi = __builtin_amdgcn_cvt_pk_f32_fp8((int)w[i], true);
                  v[4 * i] = lo.x * (1.0f / X1R_SCALE); v[4 * i + 1] = lo.y * (1.0f / X1R_SCALE); v[4 * i + 2] = hi.x * (1.0f / X1R_SCALE); v[4 * i + 3] = hi.y * (1.0f / X1R_SCALE); } }
            else { unpack8(xr[q][0], v); unpack8(xr[q][1], v + 8); }
            { const unsigned w[4] = {xq[q][0].x, xq[q][0].y, xq[q][1].x, xq[q][1].y};
#pragma unroll
              for (int i = 0; i < 4; ++i) { const f32x2_ lo = __builtin_amdgcn_cvt_pk_f32_fp8((int)w[i], false), hi = __builtin_amdgcn_cvt_pk_f32_fp8((int)w[i], true);
                  v[4 * i] += lo.x * (1.0f / XQ_SCALE); v[4 * i + 1] += lo.y * (1.0f / XQ_SCALE); v[4 * i + 2] += hi.x * (1.0f / XQ_SCALE); v[4 * i + 3] += hi.y * (1.0f / XQ_SCALE); } }
#pragma unroll
            for (int i = 0; i < 16; ++i) v[i] *= DN_ALPHA;
#pragma unroll
            for (int k = 0; k < 4; ++k) { const float gk = g4[q][k] * (1.0f / YQ_SCALE); const unsigned w[4] = {yr[q][k][0].x, yr[q][k][0].y, yr[q][k][1].x, yr[q][k][1].y};
#pragma unroll
                for (int i = 0; i < 4; ++i) { const f32x2_ lo = __builtin_amdgcn_cvt_pk_f32_fp8((int)w[i], false), hi = __builtin_amdgcn_cvt_pk_f32_fp8((int)w[i], true);
                    v[4 * i] += gk * lo.x; v[4 * i + 1] += gk * lo.y; v[4 * i + 2] += gk * hi.x; v[4 * i + 3] += gk * hi.y; } }
            ln_row(v, gam, bet);
            const int nn = nrow[q];
            if (!nextl) store_row_f32_nt(xo + (size_t)nn * DMODEL, lane, v);
            if (nextl) { store_row_bf16_nt(XB + (size_t)nn * DMODEL, lane, v); { float lo_[16];
#pragma unroll
                for (int i = 0; i < 16; ++i) lo_[i] = v[i] - __uint_as_float(f2bf(v[i]) << 16);
                if (USE_XLO) store_row_fp8(XLOw + (size_t)nn * DMODEL, lane, lo_, XLO_SCALE);
                store_row_fp8_nt((unsigned char*)(C.ws + WS_XQ) + (size_t)nn * DMODEL, lane, v, XQ_SCALE); }
                gates_row(v, wgl, C.in[I_GATEB] + (l + 1) * 8, G + (size_t)nn * 8, lane); }
        }
    }
#undef LN2_ROUTE
    __syncthreads();
}
#ifndef MK_RELMODE
#define MK_RELMODE 0
#endif
__device__ __forceinline__ void xcd_barrier_w(const XcdBarrier& b, const Ctx& C, volatile LAS unsigned* rel, int minitems = 0) {
    asm volatile("s_waitcnt vmcnt(0)" ::: "memory");
    if (threadIdx.x == 0) *rel = 0u;
    __syncthreads();
    if (C.wave == 0) {
        if (threadIdx.x == 0) {
            unsigned* bar = b.bar;
            __builtin_amdgcn_s_waitcnt(0);
            unsigned nloc = b.st[0], nx = b.st[1];
            if (nloc == 0u) { xcd_barrier_complete(bar, b.x, nloc, nx); b.st[0] = nloc; b.st[1] = nx; }
            const unsigned old = xb_add(&bar[XB_XSUB(b.x)], 1u);
            const unsigned gen = old / nloc;
            if (old + 1u == (gen + 1u) * nloc) {
                if (MK_RELMODE == 0) *rel = 1u;
                __builtin_amdgcn_fence(__ATOMIC_RELEASE, "agent");
                asm volatile("s_waitcnt vmcnt(0)" ::: "memory");
                const unsigned og = xb_add(&bar[XB_TOP], 1u);
                const unsigned tg = og / nx;
                if (og + 1u == (tg + 1u) * nx) xb_add(&bar[XB_TOPGEN], 1u);
                else XB_SPIN(xb_ld(&bar[XB_TOPGEN]) == tg, bar);
                *rel = 1u;
                __builtin_amdgcn_fence(__ATOMIC_ACQUIRE, "agent");
                xb_add(&bar[XB_XGEN(b.x)], 1u);
                asm volatile("s_waitcnt vmcnt(0)" ::: "memory");
            } else {
                if (MK_RELMODE == 0) { XB_SPIN(xb_ld(&bar[XB_XSUB(b.x)]) < (gen + 1u) * nloc, bar);
                    *rel = 1u; }
                XB_SPIN(xb_ld(&bar[XB_XGEN(b.x)]) == gen, bar);
                *rel = 1u;
                __builtin_amdgcn_fence(__ATOMIC_ACQUIRE, "agent");
                asm volatile("s_waitcnt vmcnt(0)" ::: "memory");
            }
        }
    } else {
        const int lane = ltid() & 63, total = TRQ_LAYERS * trq_per(C); LAS float* scr = (LAS float*)(C.lds + RING_OFF + (C.wave - 1) * 16896);
        int done = 0;
        while (done < minitems || *rel == 0u) { const int q = trq_grab(C, lane); if (q >= total) break; const int r = trq_item(C, q); if (r >= 0) tr_one(C, r, scr, lane); ++done; }
    }
    __syncthreads();
}

struct Args { const float* in[21]; float* out; unsigned char* ws; int ph_lo, ph_hi, li, pad; };
__global__ void __launch_bounds__(NTHREADS, 2) mega_fwd(Args args) {
    extern __shared__ __attribute__((aligned(16))) unsigned char lds[];
    Ctx C;
    C.lds = (LAS unsigned char*)lds; C.wave = __builtin_amdgcn_readfirstlane(threadIdx.x >> 6);
    C.G = gridDim.x; { const int bx = blockIdx.x; C.vcu = (C.G % 8 == 0) ? (bx % 8) * (C.G / 8) + bx / 8 : bx; }
    C.ws = args.ws; C.in = args.in; C.out = args.out;
    volatile LAS unsigned* MISC = (volatile LAS unsigned*)(C.lds + MISC_OFF);
    for (int u = threadIdx.x; u < (LDSX_OFF - LDSCTL_OFF) / 4; u += NTHREADS) ((LAS unsigned*)(C.lds + LDSCTL_OFF))[u] = 0u;
    __syncthreads();
    unsigned* ctl = (unsigned*)(C.ws + WS_CTL);
    XcdBarrier bar = xcd_barrier_post(ctl + CW_BAR + args.li * XCD_BAR_WORDS, MISC + 8);
    const int lo = args.ph_lo, hi = args.ph_hi;
#define IN(k) (lo <= (k) && (k) < hi)
#ifndef MK_DBL
#define MK_DBL -1
#endif
#define REP(kind) _Pragma("unroll 1") for (int rep_ = 0; rep_ < ((kind) == MK_DBL ? 2 : 1); ++rep_)
#ifdef MK_PROBE_A
    LAS unsigned long long* tacc = (LAS unsigned long long*)(C.lds + LDSX_OFF + 20480);
    if (blockIdx.x == 0 && threadIdx.x == 0) { for (int i = 0; i < 16; ++i) tacc[i] = 0ull; tacc[14] = tacc[15] = wall_clock64(); }
#define stamper (blockIdx.x == 0 && threadIdx.x == 0)
#define STAMP(kind) do { if (stamper) { const unsigned long long now_ = wall_clock64(); tacc[kind] += now_ - tacc[14]; tacc[14] = now_; } } while (0)
#define SEAM(k) do { if (IN(k) && IN((k) + 1)) xcd_barrier(bar); STAMP((k) == 0 ? 0 : 1 + ((k) - 1) % NPH_LAYER); } while (0)
#else
#define STAMP(kind) do { } while (0)
#define SEAM(k) do { if (IN(k) && IN((k) + 1)) { xcd_barrier_w(bar, C, MISC + 10); if (MK_DBL == 12) xcd_barrier(bar); } } while (0)
#define SEAMW(k, n) do { if (IN(k) && IN((k) + 1)) { xcd_barrier_w(bar, C, MISC + 10, (n)); if (MK_DBL == 12) xcd_barrier(bar); } } while (0)
#ifndef MK_TAILITEMS
#define MK_TAILITEMS 3
#endif
#define MOE_IDLE(nN, xs) ((C.G == 256) ? ((((const LAS int*)(C.lds + LDSCTL_OFF))[32] + 8 * (32 / (nN)) - 1) / (8 * (32 / (nN))) - ((((const LAS int*)(C.lds + LDSCTL_OFF))[32] - ((int)blockIdx.x >> 3) / (nN) - ((((int)blockIdx.x & 7) + (xs)) & 7) * (32 / (nN)) + 8 * (32 / (nN)) - 1) / (8 * (32 / (nN))))) : 0)
#ifndef MK_DOWN_XS
#define MK_DOWN_XS 3
#endif
#endif
    if (IN(0)) { REP(0) p_prologue(C); SEAM(0); }
#pragma unroll 1
    for (int l = 0; l < DEPTH; ++l) {
        const int pb = 1 + l * NPH_LAYER;
        bf16* XB = (bf16*)(C.ws + WS_XB); bf16* PROJ = (bf16*)(C.ws + WS_PROJ);
        if (IN(pb + 0)) {
            { pg8::Gemm g{XB, (const bf16*)(C.ws + WS_WIN) + (size_t)l * NPROJ * DMODEL, NTOK, 2048, DMODEL}; pg8::StaticOrder S; S.init(NTOK, 2048, C.G, (int)blockIdx.x);
              pg8::EpiBf16<0> E{PROJ, NPROJ, nullptr, 512, 512, attn_body::C2};
              REP(1) pg8::gemm_phase<pg8::EpiBf16<0>, pg8::StaticOrder, true, true, false>(C.lds + RING_OFF, g, S, E); }
            { pg8::Gemm g{(const bf16*)(C.ws + WS_XQ), (const bf16*)(C.ws + WS_WINQ + (size_t)l * 1536 * DMODEL), NTOK, 1024, DMODEL / 2}; pg8::StaticOrder S; S.init(NTOK, 1024, C.G, (int)blockIdx.x);
              pg8::EpiBf16<0> E{PROJ + 2048, NPROJ, nullptr, 0, 0, 1.0f, 1.0f / (XQ_SCALE * WQ_SCALE)};
              REP(1) pg8::gemm_phase<pg8::EpiBf16<0>, pg8::StaticOrder, true, true, false, true>(C.lds + RING_OFF, g, S, E); }
            SEAM(pb + 0);
        }
        if (IN(pb + 1)) { REP(2) p_mlstm_states_seq(C, l); SEAM(pb + 1); }
        if (IN(pb + 3)) {
            REP(11) p_mlstm_out_seq(C, l); STAMP(11);
            { const int ln_ = ltid() & 63; const float s1 = wave_sum(C.in[I_LQ1][l * 64 + ln_] * C.in[I_LK1][l * 64 + ln_]), s2 = wave_sum(C.in[I_LQ2][l * 64 + ln_] * C.in[I_LK2][l * 64 + ln_]);
              const float lam_init = __uint_as_float(__builtin_amdgcn_readfirstlane(__float_as_uint(0.8f - 0.6f * expf(-0.3f * (float)l)))); const float lam = __uint_as_float(__builtin_amdgcn_readfirstlane(__float_as_uint(expf(s1) - expf(s2) + lam_init)));
              REP(4) for (int vc = C.vcu; vc < 256; vc += C.G) attn_body::attn_phase((char*)lds + RING_OFF, (const attn_body::bf16*)PROJ, (attn_body::bf16*)(C.ws + WS_ATTO), (attn_body::bf16*)(C.ws + WS_MIXIN), C.in[I_NG] + l * 128, lam, 1.0f - lam_init, vc); }
            SEAM(pb + 3);
        }
        if (IN(pb + 5)) {
#if MK_OUTFP8
            pg8::Gemm g{(const bf16*)(C.ws + WS_MIXIN), (const bf16*)(C.ws + WS_WOUT + (size_t)l * DMODEL * DMODEL), NTOK, DMODEL, DMODEL / 2}; pg8::StaticOrder S; S.init(NTOK, DMODEL, C.G, (int)blockIdx.x);
            pg8::EpiBf16<0> E{(bf16*)(C.ws + WS_MIXO), DMODEL, nullptr, 0, 0, 1.0f, 1.0f / (MQ_SCALE * WQ_SCALE)};
            REP(6) pg8::gemm_phase<pg8::EpiBf16<0>, pg8::StaticOrder, true, true, false, true>(C.lds + RING_OFF, g, S, E);
#else
            pg8::Gemm g{(const bf16*)(C.ws + WS_MIXIN), (const bf16*)(C.ws + WS_WOUT) + (size_t)l * DMODEL * DMODEL, NTOK, DMODEL, DMODEL}; pg8::StaticOrder S; S.init(NTOK, DMODEL, C.G, (int)blockIdx.x);
            pg8::EpiBf16<0> E{(bf16*)(C.ws + WS_MIXO), DMODEL, nullptr, 0, 0, 1.0f};
            REP(6) pg8::gemm_phase<pg8::EpiBf16<0>, pg8::StaticOrder, true, true, false>(C.lds + RING_OFF, g, S, E);
#endif
            SEAM(pb + 5);
        }
        if (IN(pb + 6)) { p_ln1_router(C, l); if (MK_DBL == 7) p_ln1_router(C, l, false); if (MK_DBL == 13) p_ln1_router(C, l, false, true); if (MK_DBL == 14) p_ln1_router(C, l, false, true, true); if (MK_DBL == 15) p_ln1_router(C, l, false, true, true, true); if (MK_DBL == 16) p_ln1_router(C, l, false, true, false, false, 1); if (MK_DBL == 17) p_ln1_router(C, l, false, true, false, false, 2); if (l > 0) trq_drain(C, l); SEAM(pb + 6); }
        if (IN(pb + 7)) {
            moe_tables(C, l);
            pg8::Gemm g{(const bf16*)(C.ws + WS_X1B), (const bf16*)(C.ws + WS_WGU + (size_t)l * NEXP * 2 * DFF * DMODEL), 0, 0, DMODEL / 2};
            pg8::MoeOrder S{(const LAS int*)(C.lds + LDSCTL_OFF), (const LAS int*)(C.lds + LDSCTL_OFF + 160), (const int*)(C.ws + WS_ROWTOK), 8, C.G, (int)blockIdx.x, NTOK, (LAS unsigned*)(C.lds + LDSX_OFF)};
            pg8::EpiSwiglu E{(bf16*)(C.ws + WS_H), DFF, C.in[I_BGU] + (size_t)l * NEXP * 2 * DFF, DFF, 1.0f / (XQ_SCALE * WQ_SCALE), HQ_SCALE, 0, (const LAS float*)(C.lds + LDSX_OFF + 16384)};
            REP(8) pg8::gemm_phase<pg8::EpiSwiglu, pg8::MoeOrder, true, true, true, true>(C.lds + RING_OFF, g, S, E);
            if (MK_DBL == 21) pg8::gemm_phase<pg8::EpiSwiglu, pg8::MoeOrder, true, true, true, true>(C.lds + RING_OFF, g, S, E);
            if (MK_DBL == 18 || MK_DBL == 19) { pg8::EpiSwiglu E2 = E; E2.dbg = (MK_DBL == 18) ? 2 : 1; pg8::gemm_phase<pg8::EpiSwiglu, pg8::MoeOrder, true, true, true, true>(C.lds + RING_OFF, g, S, E2); }
            SEAMW(pb + 7, MK_TAILITEMS * MOE_IDLE(8, 0));
        }
        if (IN(pb + 8)) {
            if (!IN(pb + 7)) moe_tables(C, l);
            pg8::Gemm g{(const bf16*)(C.ws + WS_H), (const bf16*)(C.ws + WS_WDN + (size_t)l * NEXP * DMODEL * DFF), 0, 0, DFF / 2};
            pg8::MoeOrder S{(const LAS int*)(C.lds + LDSCTL_OFF), (const LAS int*)(C.lds + LDSCTL_OFF + 160), (const int*)(C.ws + WS_ROWTOK), 4, C.G, (int)blockIdx.x, NTOK, (LAS unsigned*)(C.lds + LDSX_OFF), MK_DOWN_XS};
            pg8::EpiFp8 E{(bf16*)(C.ws + WS_Y), DMODEL, C.in[I_BDN] + (size_t)l * NEXP * DMODEL, DMODEL, 0, 1.0f, 1.0f / (HQ_SCALE * WQ_SCALE), 0, 0u, YQ_SCALE, (const LAS float*)(C.lds + LDSX_OFF + 16384)};
            REP(9) pg8::gemm_phase<pg8::EpiFp8, pg8::MoeOrder, true, true, false, true>(C.lds + RING_OFF, g, S, E);
            if (MK_DBL == 20) { pg8::EpiFp8 E2 = E; E2.dbg = 2; pg8::gemm_phase<pg8::EpiFp8, pg8::MoeOrder, true, true, false, true>(C.lds + RING_OFF, g, S, E2); }
            SEAMW(pb + 8, MK_TAILITEMS * MOE_IDLE(4, MK_DOWN_XS));
        }
        if (IN(pb + 9)) { if (!IN(pb + 7)) moe_tables(C, l); REP(10) p_ln2_combine(C, l); SEAM(pb + 9); }
    }
#ifdef MK_PROBE_A
    xcd_barrier(bar);
    if (stamper) { const unsigned long long now_ = wall_clock64(); tacc[10] += now_ - tacc[14]; const float tot = (float)(now_ - tacc[15]);
        __hip_atomic_store((float*)(ctl + 8), (float)tacc[MK_PROBE_A] / tot, __ATOMIC_RELAXED, __HIP_MEMORY_SCOPE_AGENT); __hip_atomic_store((float*)(ctl + 9), (float)tacc[MK_PROBE_B] / tot, __ATOMIC_RELAXED, __HIP_MEMORY_SCOPE_AGENT); }
    xcd_barrier(bar);
    { const float fa = __hip_atomic_load((float*)(ctl + 8), __ATOMIC_RELAXED, __HIP_MEMORY_SCOPE_AGENT), fb = __hip_atomic_load((float*)(ctl + 9), __ATOMIC_RELAXED, __HIP_MEMORY_SCOPE_AGENT);
        const size_t gid = (size_t)blockIdx.x * NTHREADS + threadIdx.x, nth = (size_t)gridDim.x * NTHREADS;
        for (size_t i = gid; i < (size_t)NTOK * DMODEL; i += nth) { float v = C.out[i] * (1.0f + 4.0f * fa); if (i == 0) v += 1000.0f * fb; C.out[i] = v; } }
#endif
#undef IN
#undef SEAM
}

#ifndef MK_MODE
#define MK_MODE 0
#endif
static int mega_grid() {
    static int grid = 0;
    if (grid == 0) {
        int dev = 0, cus = 0, per_cu = 0;
        if (hipGetDevice(&dev) != hipSuccess || hipDeviceGetAttribute(&cus, hipDeviceAttributeMultiprocessorCount, dev) != hipSuccess) { grid = -1; return grid; }
        if (hipFuncSetAttribute((const void*)mega_fwd, hipFuncAttributeMaxDynamicSharedMemorySize, LDS_BYTES) != hipSuccess) { fprintf(stderr, "kernel_launch: hipFuncSetAttribute failed\n"); grid = -1; return grid; }
        if (hipOccupancyMaxActiveBlocksPerMultiprocessor(&per_cu, (const void*)mega_fwd, NTHREADS, LDS_BYTES) != hipSuccess || per_cu < 1) fprintf(stderr, "kernel_launch: occupancy query reports %d\n", per_cu);
        (void)hipGetLastError();
        grid = cus;
    }
    return grid;
}
static void mega_launch(void* const* d_in, float* d_out, unsigned char* ws, hipStream_t stream, int lo, int hi, int li) {
    const int grid = mega_grid(); if (grid <= 0) return;
    Args a{};
    for (int i = 0; i < 21; ++i) a.in[i] = (const float*)d_in[i];
    a.out = d_out; a.ws = ws; a.ph_lo = lo; a.ph_hi = hi; a.li = li; a.pad = 0;
    hipLaunchKernelGGL(mega_fwd, dim3(grid), dim3(NTHREADS), LDS_BYTES, stream, a);
    const hipError_t le = hipPeekAtLastError();
    if (le != hipSuccess) fprintf(stderr, "kernel_launch: launch failed: %s\n", hipGetErrorName(le));
}
extern "C" void kernel_launch(void* const* d_in, const int* in_sizes, int n_in, void* d_out, int out_size, void* d_ws, size_t ws_size, hipStream_t stream) {
    if (n_in != 21 || in_sizes[0] != NTOK * DMODEL || out_size != NTOK * DMODEL || ws_size < WS_END) { fprintf(stderr, "kernel_launch: unexpected shapes (n_in %d, ws %zu)\n", n_in, ws_size); return; }
    unsigned char* ws = (unsigned char*)d_ws;
    if (hipMemsetAsync(ws + WS_CTL, 0, CTL_ZERO_BYTES, stream) != hipSuccess) { fprintf(stderr, "kernel_launch: memset failed\n"); return; }
#if MK_MODE == 0
    mega_launch(d_in, (float*)d_out, ws, stream, 0, NPHASES, 0);
#else
    for (int ph = 0; ph < NPHASES; ++ph) mega_launch(d_in, (float*)d_out, ws, stream, ph, ph + 1, 0);
#endif
}
```

```cpp
#include <hip/hip_runtime.h>
#include <cstdio>
#include <cstdint>
#include <cmath>
namespace pg8 {
#define PG8_LAS __attribute__((address_space(3)))
#ifndef PG8_STORES_IN_FLIGHT
#define PG8_STORES_IN_FLIGHT 0
#endif
#define PG8_NSTORE(n) (PG8_STORES_IN_FLIGHT ? (n) : 0)
typedef unsigned short bf16_t;
typedef short bf16x8 __attribute__((ext_vector_type(8)));
typedef float f32x4 __attribute__((ext_vector_type(4)));
typedef unsigned u32x4 __attribute__((ext_vector_type(4)));
typedef int i32x4_t __attribute__((ext_vector_type(4)));
typedef int i32x8_t __attribute__((ext_vector_type(8)));
constexpr int BM = 256, BK = 64, HALF = 128, HTB = HALF * BK * 2  , STAGE_BYTES = 8 * HTB, NXCD = 8, WGM = 8;

__host__ __device__ __forceinline__ int lds_byte(int r, int c) { const int st = (r >> 4) * 2 + (c >> 5), rr = r & 15, cc = c & 31, ob = rr * 64 + cc * 2; return st * 1024 + (ob ^ (((ob >> 9) & 1) << 5)); }
__host__ __device__ __forceinline__ void stage_rc(int b, int& R, int& C) { const int st = b / 1024, sb = b % 1024, swz = sb ^ (((sb >> 9) & 1) << 5); R = (st >> 1) * 16 + swz / 64; C = (st & 1) * 32 + (swz % 64) / 2; }
__host__ __device__ __forceinline__ int perm32(int rho) { const int n = rho >> 4, i = rho & 15; return 8 * (i >> 2) + 4 * n + (i & 3); }

struct Unit { int pm, pn, e, pnl, nvalid, rbase; };

struct Gemm { const bf16_t* A; const bf16_t* Bt; int M, N, K; };

struct StaticOrder {
    int nM, nN, nwg, G, c; PG8_LAS unsigned* gtab = nullptr;
    __host__ __device__ void init(int M, int N, int G_, int c_) { nM = M / BM; nN = N / BM; nwg = nM * nN; G = G_; c = c_; }
    __host__ __device__ bool next(int i, Unit& u) const {
        const long L = (long)i * G + c; if (L >= nwg) return false;
        int wgid = (int)L; { const int q = nwg / NXCD, r = nwg % NXCD, xcd = wgid % NXCD, off = wgid / NXCD; wgid = (xcd < r ? xcd * (q + 1) : r * (q + 1) + (xcd - r) * q) + off; }
        const int nig = WGM * nN, gid = wgid / nig, fm = gid * WGM, gsz = (nM - fm) < WGM ? (nM - fm) : WGM;
        u.pm = fm + ((wgid % nig) % gsz); u.pn = (wgid % nig) / gsz; u.e = 0; u.pnl = u.pn; u.nvalid = BM; u.rbase = 0; return true;
    }
    __device__ __forceinline__ int arow(const Unit&, int) const { return 0; }
    __device__ __forceinline__ void a_ready(const Unit&) const {}
    __device__ __forceinline__ void done(const Unit&) const {}
};

__device__ __forceinline__ unsigned cvt_pk_bf16(float lo, float hi) { unsigned r; asm volatile("v_cvt_pk_bf16_f32 %0, %1, %2" : "=v"(r) : "v"(lo), "v"(hi)); return r; }
typedef float f32x2 __attribute__((ext_vector_type(2)));
__device__ __forceinline__ f32x2 gelu_pk(f32x2 v) {
    const f32x2 av = __builtin_elementwise_abs(v), d = av * 0.2316418882f + 1.0f;
    f32x2 t; t.x = __builtin_amdgcn_rcpf(d.x); t.y = __builtin_amdgcn_rcpf(d.y);
    f32x2 q = t * 0.5307027145f + (-0.7265760135f); q = q * t + 0.7107068705f; q = q * t + (-0.142248368f); q = q * t + 0.127414796f; q = q * t;
    const f32x2 s = (v * v) * (-0.72134752044f);
    f32x2 e; e.x = __builtin_amdgcn_exp2f(s.x); e.y = __builtin_amdgcn_exp2f(s.y);
    const f32x2 m = v * (q * e), r = v - m;
    f32x2 o; o.x = v.x < 0.f ? m.x : r.x; o.y = v.y < 0.f ? m.y : r.y; return o;
}

template <int ACT  > struct EpiBf16 {
    static constexpr int PERM = 1; static constexpr bool AFTER_DRAIN = false; static_assert(ACT == 0 || ACT == 1, "EpiBf16: ACT is 0 (none) or 1 (gelu_pk)");
    static constexpr int NSTORE = PG8_NSTORE(16); static constexpr bool LDSBIAS = false;
    bf16_t* O; int ldc; const float* bias; int split_cols; size_t split_stride; float scale0;
    float ascale = 1.0f;
    int dbg = 0;
    unsigned cmap = 0u;
    float oscale = 0.0f;
    __device__ __forceinline__ void operator()(const f32x4 (&acc)[2][2][4][2], const Unit& u, int wr, int wc, int fr, int fq) const {
        if (dbg == 2) return;
        const int row0 = u.pm * BM + wr * 64 + fr; int colt = (cmap ? (int)((cmap >> (4 * u.pn)) & 15u) : u.pn) * BM; bf16_t* base = O;
        float sc = 1.f; if (split_cols) { const int t = colt / split_cols; base += (size_t)t * split_stride; colt -= t * split_cols; if (t == 0) sc = scale0; }
        const int col0 = colt + wc * 32 + 8 * fq, bcol0 = u.pn * BM + wc * 32 + 8 * fq;
        f32x4 bv[2][2];
#pragma unroll
        for (int bj = 0; bj < 2; ++bj)
#pragma unroll
            for (int n = 0; n < 2; ++n) bv[bj][n] = bias ? *(const f32x4*)(bias + bcol0 + bj * HALF + 4 * n) : (f32x4){0.f, 0.f, 0.f, 0.f};
#pragma unroll
        for (int ai = 0; ai < 2; ++ai)
#pragma unroll
            for (int m = 0; m < 4; ++m) { bf16_t* rowp = base + (size_t)(row0 + ai * HALF + m * 16) * ldc + col0;
#pragma unroll
                for (int bj = 0; bj < 2; ++bj) {
                    if (ACT == 0 && oscale > 0.f) {
                        const float kq = ascale * oscale; f32x4 a, b;
#pragma unroll
                        for (int i = 0; i < 4; ++i) { a[i] = __builtin_amdgcn_fmed3f(__builtin_fmaf(acc[ai][bj][m][0][i], kq, bv[bj][0][i] * oscale), -448.f, 448.f); b[i] = __builtin_amdgcn_fmed3f(__builtin_fmaf(acc[ai][bj][m][1][i], kq, bv[bj][1][i] * oscale), -448.f, 448.f); }
                        int p = 0, q = 0; p = __builtin_amdgcn_cvt_pk_fp8_f32(a[0], a[1], p, false); p = __builtin_amdgcn_cvt_pk_fp8_f32(a[2], a[3], p, true); q = __builtin_amdgcn_cvt_pk_fp8_f32(b[0], b[1], q, false); q = __builtin_amdgcn_cvt_pk_fp8_f32(b[2], b[3], q, true);
                        typedef int i32x2_f __attribute__((ext_vector_type(2))); *(i32x2_f*)((unsigned char*)base + (size_t)(row0 + ai * HALF + m * 16) * ldc + col0 + bj * HALF) = (i32x2_f){p, q}; continue; }
                    f32x4 v0 = acc[ai][bj][m][0] * ascale + bv[bj][0], v1 = acc[ai][bj][m][1] * ascale + bv[bj][1];
                    if (ACT == 1) { f32x2 a = gelu_pk((f32x2){v0[0], v0[1]}), b = gelu_pk((f32x2){v0[2], v0[3]}), c = gelu_pk((f32x2){v1[0], v1[1]}), d = gelu_pk((f32x2){v1[2], v1[3]});
                        v0 = (f32x4){a.x, a.y, b.x, b.y}; v1 = (f32x4){c.x, c.y, d.x, d.y}; }
                    v0 = v0 * sc; v1 = v1 * sc;
                    if (oscale > 0.f) { f32x4 a = v0 * oscale, b = v1 * oscale;
#pragma unroll
                        for (int i = 0; i < 4; ++i) { a[i] = __builtin_fminf(__builtin_fmaxf(a[i], -448.f), 448.f); b[i] = __builtin_fminf(__builtin_fmaxf(b[i], -448.f), 448.f); }
                        int p = 0, q = 0; p = __builtin_amdgcn_cvt_pk_fp8_f32(a[0], a[1], p, false); p = __builtin_amdgcn_cvt_pk_fp8_f32(a[2], a[3], p, true); q = __builtin_amdgcn_cvt_pk_fp8_f32(b[0], b[1], q, false); q = __builtin_amdgcn_cvt_pk_fp8_f32(b[2], b[3], q, true);
                        typedef int i32x2_t __attribute__((ext_vector_type(2))); *(i32x2_t*)((unsigned char*)base + (size_t)(row0 + ai * HALF + m * 16) * ldc + col0 + bj * HALF) = (i32x2_t){p, q}; }
                    else { u32x4 w; w.x = cvt_pk_bf16(v0[0], v0[1]); w.y = cvt_pk_bf16(v0[2], v0[3]); w.z = cvt_pk_bf16(v1[0], v1[1]); w.w = cvt_pk_bf16(v1[2], v1[3]);
                        *(u32x4*)(rowp + bj * HALF) = w; } } }
    }
};

struct EpiFp8 { static constexpr int ACT = 0;
    static constexpr int PERM = 2; static constexpr bool AFTER_DRAIN = false; static constexpr int NSTORE = PG8_NSTORE(8); static constexpr bool LDSBIAS = true;
    __device__ __forceinline__ const float* bias_src(const Unit& u, int wc, int lane) const { return bias + u.pn * BM + wc * 64 + lane; }
    bf16_t* O; int ldc; const float* bias; int split_cols; size_t split_stride; float scale0;
    float ascale = 1.0f;
    int dbg = 0;
    unsigned cmap = 0u;
    float oscale = 0.0f;
    PG8_LAS const float* lbias = nullptr;
    __device__ __forceinline__ void operator()(const f32x4 (&acc)[2][2][4][2], const Unit& u, int wr, int wc, int fr, int fq) const {
        if (dbg == 2) return;
        const int row0 = u.pm * BM + wr * 64 + fr; int colt = (cmap ? (int)((cmap >> (4 * u.pn)) & 15u) : u.pn) * BM; bf16_t* base = O;
        float sc = 1.f; if (split_cols) { const int t = colt / split_cols; base += (size_t)t * split_stride; colt -= t * split_cols; if (t == 0) sc = scale0; }
        const int col0 = colt + wc * 64 + 16 * fq, bcol0 = u.pn * BM + wc * 64 + 16 * fq;
        f32x4 bv[2][2];
#pragma unroll
        for (int bj = 0; bj < 2; ++bj)
#pragma unroll
            for (int n = 0; n < 2; ++n) bv[bj][n] = lbias ? *(const PG8_LAS f32x4*)(lbias + (wr * 4 + wc) * 64 + 16 * fq + 8 * bj + 4 * n) : (bias ? *(const f32x4*)(bias + bcol0 + 8 * bj + 4 * n) : (f32x4){0.f, 0.f, 0.f, 0.f});
#pragma unroll
        for (int ai = 0; ai < 2; ++ai)
#pragma unroll
            for (int m = 0; m < 4; ++m) { const size_t rowoff = (size_t)(row0 + ai * HALF + m * 16) * ldc + col0;
                if (ACT == 0 && oscale > 0.f) {
                    const float kq = ascale * oscale; int w4[4];
#pragma unroll
                    for (int bj = 0; bj < 2; ++bj)
#pragma unroll
                        for (int n = 0; n < 2; ++n) { float a[4];
#pragma unroll
                            for (int p = 0; p < 2; ++p) { const f32x2 t2 = (f32x2){acc[ai][bj][m][n][2 * p], acc[ai][bj][m][n][2 * p + 1]} * kq + (f32x2){bv[bj][n][2 * p], bv[bj][n][2 * p + 1]} * oscale;
                                a[2 * p] = __builtin_amdgcn_fmed3f(t2.x, -448.f, 448.f); a[2 * p + 1] = __builtin_amdgcn_fmed3f(t2.y, -448.f, 448.f); }
                            int p = 0; p = __builtin_amdgcn_cvt_pk_fp8_f32(a[0], a[1], p, false); p = __builtin_amdgcn_cvt_pk_fp8_f32(a[2], a[3], p, true); w4[2 * bj + n] = p; }
                    *(u32x4*)((unsigned char*)base + rowoff) = (u32x4){(unsigned)w4[0], (unsigned)w4[1], (unsigned)w4[2], (unsigned)w4[3]}; continue; }
                u32x4 wo[2];
#pragma unroll
                for (int bj = 0; bj < 2; ++bj) { f32x4 v0 = acc[ai][bj][m][0] * ascale + bv[bj][0], v1 = acc[ai][bj][m][1] * ascale + bv[bj][1];
                    if (ACT == 1) { f32x2 a = gelu_pk((f32x2){v0[0], v0[1]}), b = gelu_pk((f32x2){v0[2], v0[3]}), c = gelu_pk((f32x2){v1[0], v1[1]}), d = gelu_pk((f32x2){v1[2], v1[3]});
                        v0 = (f32x4){a.x, a.y, b.x, b.y}; v1 = (f32x4){c.x, c.y, d.x, d.y}; }
                    v0 = v0 * sc; v1 = v1 * sc;
                    wo[bj].x = cvt_pk_bf16(v0[0], v0[1]); wo[bj].y = cvt_pk_bf16(v0[2], v0[3]); wo[bj].z = cvt_pk_bf16(v1[0], v1[1]); wo[bj].w = cvt_pk_bf16(v1[2], v1[3]); }
                bf16_t* rowp = base + rowoff; *(u32x4*)rowp = wo[0]; *(u32x4*)(rowp + 8) = wo[1]; }
    }
};

struct EpiSwiglu {
    static constexpr int PERM = 1; static constexpr bool AFTER_DRAIN = false; static constexpr int NSTORE = PG8_NSTORE(8); static constexpr bool LDSBIAS = true;
    bf16_t* H; int ldc; const float* bias; int dff; float ascale; float hscale; int dbg = 0;
    PG8_LAS const float* lbias = nullptr;
    __device__ __forceinline__ const float* bias_src(const Unit& u, int wc, int lane) const { return bias + (size_t)u.e * 2 * dff + u.pnl * HALF + wc * 32 + (lane & 31) + ((lane & 32) ? dff : 0); }
    __device__ __forceinline__ void operator()(const f32x4 (&acc)[2][2][4][2], const Unit& u, int wr, int wc, int fr, int fq) const {
        if (dbg == 2) return;
        const int row0 = u.pm * BM + wr * 64 + fr, hc = u.pnl * HALF + wc * 32 + 8 * fq;
        const float* bg = bias + (size_t)u.e * 2 * dff + hc; const float* bu = bg + dff;
        const float hk = hscale > 0.f ? hscale : 1.0f;
        f32x4 bgv[2], buv[2];
#pragma unroll
        for (int n = 0; n < 2; ++n) { if (lbias) { const PG8_LAS float* lb = lbias + (wr * 4 + wc) * 64 + 8 * fq + 4 * n; bgv[n] = *(const PG8_LAS f32x4*)lb; buv[n] = *(const PG8_LAS f32x4*)(lb + 32); }
            else { bgv[n] = *(const f32x4*)(bg + 4 * n); buv[n] = *(const f32x4*)(bu + 4 * n); } }
#pragma unroll
        for (int ai = 0; ai < 2; ++ai)
#pragma unroll
            for (int m = 0; m < 4; ++m) { bf16_t* rowp = H + (size_t)(row0 + ai * HALF + m * 16) * ldc + hc; float o[8];
#pragma unroll
                for (int n = 0; n < 2; ++n)
#pragma unroll
                    for (int p = 0; p < 2; ++p) {
                        const f32x2 g2 = (f32x2){acc[ai][0][m][n][2 * p], acc[ai][0][m][n][2 * p + 1]} * ascale + (f32x2){bgv[n][2 * p], bgv[n][2 * p + 1]};
                        const f32x2 u2 = (f32x2){acc[ai][1][m][n][2 * p], acc[ai][1][m][n][2 * p + 1]} * ascale + (f32x2){buv[n][2 * p], buv[n][2 * p + 1]};
                        f32x2 gt, up; gt.x = __builtin_fminf(g2.x, 7.0f); gt.y = __builtin_fminf(g2.y, 7.0f); up.x = __builtin_amdgcn_fmed3f(u2.x, -7.0f, 7.0f); up.y = __builtin_amdgcn_fmed3f(u2.y, -7.0f, 7.0f);
                        const f32x2 ee = gt * (-1.702f * 1.4426950408889634f);
                        f32x2 den; den.x = __builtin_amdgcn_exp2f(ee.x); den.y = __builtin_amdgcn_exp2f(ee.y); den = den + 1.0f;
                        f32x2 sg; sg.x = __builtin_amdgcn_rcpf(den.x); sg.y = __builtin_amdgcn_rcpf(den.y);
                        const f32x2 r2 = (up * hk + hk) * (gt * sg);
                        o[4 * n + 2 * p] = r2.x; o[4 * n + 2 * p + 1] = r2.y; }
                if (dbg == 1) { if (o[0] == 123.4567f && o[5] == 7.654f) rowp[0] = 1; continue; }
                if (hscale > 0.f) { int a = 0, b = 0; a = __builtin_amdgcn_cvt_pk_fp8_f32(o[0], o[1], a, false); a = __builtin_amdgcn_cvt_pk_fp8_f32(o[2], o[3], a, true);
                    b = __builtin_amdgcn_cvt_pk_fp8_f32(o[4], o[5], b, false); b = __builtin_amdgcn_cvt_pk_fp8_f32(o[6], o[7], b, true);
                    typedef int i32x2_t __attribute__((ext_vector_type(2))); *(i32x2_t*)((unsigned char*)H + (size_t)(row0 + ai * HALF + m * 16) * ldc + hc) = (i32x2_t){a, b}; }
                else { u32x4 w; w.x = cvt_pk_bf16(o[0], o[1]); w.y = cvt_pk_bf16(o[2], o[3]); w.z = cvt_pk_bf16(o[4], o[5]); w.w = cvt_pk_bf16(o[6], o[7]);
                    *(u32x4*)rowp = w; } }
    }
};
struct MoeOrder {
    const PG8_LAS int* tstart; const PG8_LAS int* cnt; const int* rowtok; int nN, G, c, ntok; PG8_LAS unsigned* gtab;
    int xs = 0;
    __device__ __forceinline__ bool next(int i, Unit& u) const {
        int rt, pnl;
        if (G == 256) { const int x = ((c & 7) + xs) & 7, j = c >> 3, per = 32 / nN; rt = (i * 8 + x) * per + j / nN; pnl = j % nN; }
        else { const int L = i * G + c; rt = L / nN; pnl = L % nN; }
        const int TR = tstart[32]; if (rt >= TR) return false;
        const int ln_ = (int)__builtin_amdgcn_mbcnt_hi(~0u, __builtin_amdgcn_mbcnt_lo(~0u, 0u));
        const int tv_ = tstart[(ln_ & 31) + 1];
        const unsigned long long bal_ = __ballot((ln_ < 31) && (tv_ <= rt));
        int e = __builtin_amdgcn_readfirstlane((int)__popcll(bal_));
        const int lt = rt - tstart[e]; int nv = cnt[e] - lt * BM; nv = nv > BM ? BM : nv;
        u.pm = rt; u.pn = e * nN + pnl; u.e = e; u.pnl = pnl; u.nvalid = __builtin_amdgcn_readfirstlane(nv); u.rbase = __builtin_amdgcn_readfirstlane(e * ntok + lt * BM); return true;
    }
    __device__ __forceinline__ int arow(const Unit& u, int r) const { return rowtok[u.rbase + ((r < u.nvalid) ? r : 0)]; }
    __device__ __forceinline__ const int* aptr(const Unit& u, int r) const { return rowtok + u.rbase + ((r < u.nvalid) ? r : 0); }
    __device__ __forceinline__ void a_ready(const Unit&) const {}
    __device__ __forceinline__ void done(const Unit&) const {}
};

struct PanelStats {
    unsigned* xbuf;
    unsigned* cnt;
    unsigned* tmo;
    int ntn; float eps;
    unsigned code;
    __device__ __forceinline__ bool run(const f32x4 (&v)[2][2][4][2], const Unit& u, int wr, int wc, int fr, int fq, PG8_LAS unsigned char* lds, int wid, int lane) const {
        typedef float f32x2v __attribute__((ext_vector_type(2)));
        PG8_LAS f32x2v* P = (PG8_LAS f32x2v*)lds;
        PG8_LAS f32x2v* S = (PG8_LAS f32x2v*)(lds + 8192);
        PG8_LAS unsigned* flag = (PG8_LAS unsigned*)(lds + 8192 + 2048);
#pragma unroll
        for (int ai = 0; ai < 2; ++ai)
#pragma unroll
            for (int m = 0; m < 4; ++m) {
                float s = 0.f;
#pragma unroll
                for (int bj = 0; bj < 2; ++bj)
#pragma unroll
                    for (int n = 0; n < 2; ++n) { const f32x4 x = v[ai][bj][m][n]; s += (x[0] + x[1]) + (x[2] + x[3]); }
                s += __shfl_xor(s, 16); s += __shfl_xor(s, 32);
                const float mw = s * (1.0f / 64.0f); float q = 0.f;
#pragma unroll
                for (int bj = 0; bj < 2; ++bj)
#pragma unroll
                    for (int n = 0; n < 2; ++n) { const f32x4 d = v[ai][bj][m][n] - mw; q += (d[0] * d[0] + d[1] * d[1]) + (d[2] * d[2] + d[3] * d[3]); }
                q += __shfl_xor(q, 16); q += __shfl_xor(q, 32);
                if (fq == 0) P[(ai * HALF + wr * 64 + m * 16 + fr) * 4 + wc] = (f32x2v){mw, q};
            }
        asm volatile("s_waitcnt lgkmcnt(0)" ::: "memory"); __builtin_amdgcn_s_barrier(); asm volatile("" ::: "memory");
#if defined(BROKEN_EXCHANGE_NO_WAIT)
#warning BROKEN CONTROL BUILD: the row-statistics exchange does not wait; results are wrong by design
        if (blockIdx.x >= 64) { const long long t0_ = clock64(); while (clock64() - t0_ < 60000) __builtin_amdgcn_s_sleep(8); }
#endif
        const int row = wid * 32 + (lane & 31);
        if (lane < 32) {
            const f32x2v a = P[row * 4 + 0], b = P[row * 4 + 1], c = P[row * 4 + 2], d = P[row * 4 + 3];
            const float mt = (a.x + b.x + c.x + d.x) * 0.25f;
            const float da = a.x - mt, db = b.x - mt, dc = c.x - mt, dd = d.x - mt;
            const float m2 = (a.y + b.y) + (c.y + d.y) + 64.0f * ((da * da + db * db) + (dc * dc + dd * dd));
            unsigned long long* slot = (unsigned long long*)xbuf + ((size_t)(u.pm * BM + row) * 4 + u.pn);
            __hip_atomic_store(slot, ((unsigned long long)__float_as_uint(m2) << 32) | __float_as_uint(mt), __ATOMIC_RELAXED, __HIP_MEMORY_SCOPE_AGENT);
        }
        asm volatile("s_waitcnt vmcnt(0)" ::: "memory");
        if (lane == 0) __hip_atomic_fetch_add(cnt + 64 * u.pm, 1u, __ATOMIC_RELAXED, __HIP_MEMORY_SCOPE_AGENT);
        if (wid == 0) {
            bool dead = false; const unsigned long long t0 = __builtin_amdgcn_s_memrealtime(); const unsigned want = 8u * (unsigned)ntn;
            for (;;) {
#if defined(BROKEN_EXCHANGE_NO_WAIT)
                break;
#endif
                if ((unsigned)__builtin_amdgcn_readfirstlane(__hip_atomic_load(cnt + 64 * u.pm, __ATOMIC_RELAXED, __HIP_MEMORY_SCOPE_AGENT)) >= want) break;
                if (__builtin_amdgcn_s_memrealtime() - t0 > 2000000ull) {
                    if (lane == 0) { unsigned expect = 0u; __hip_atomic_compare_exchange_strong(tmo + 1, &expect, code | (unsigned)(u.pm & 0xff), __ATOMIC_RELAXED, __ATOMIC_RELAXED, __HIP_MEMORY_SCOPE_AGENT);
                                     __hip_atomic_store(tmo, 1u, __ATOMIC_RELAXED, __HIP_MEMORY_SCOPE_AGENT); }
                    dead = true; break; }
                __builtin_amdgcn_s_sleep(2);
            }
            __builtin_amdgcn_fence(__ATOMIC_ACQUIRE, "agent");
            if (lane == 0) flag[0] = dead ? 1u : 0u;
        }
        asm volatile("s_waitcnt vmcnt(0) lgkmcnt(0)" ::: "memory"); __builtin_amdgcn_s_barrier(); asm volatile("" ::: "memory");
        const bool bad = flag[0] != 0u;
        if (lane < 32) {
            const unsigned long long* slot = (const unsigned long long*)xbuf + (size_t)(u.pm * BM + row) * 4; float mt[4], m2[4]; float ms = 0.f;
#pragma unroll
            for (int t = 0; t < 4; ++t) { if (t < ntn) { const unsigned long long w = __hip_atomic_load(slot + t, __ATOMIC_RELAXED, __HIP_MEMORY_SCOPE_AGENT); mt[t] = __uint_as_float((unsigned)w); m2[t] = __uint_as_float((unsigned)(w >> 32)); } else { mt[t] = 0.f; m2[t] = 0.f; } ms += mt[t]; }
            const float mean = ms / (float)ntn; float q = 0.f;
#pragma unroll
            for (int t = 0; t < 4; ++t) if (t < ntn) { const float dm = mt[t] - mean; q += m2[t] + 256.0f * dm * dm; }
            S[row] = (f32x2v){mean, 1.0f / sqrtf(q / (256.0f * (float)ntn) + eps)};
        }
        asm volatile("s_waitcnt lgkmcnt(0)" ::: "memory"); __builtin_amdgcn_s_barrier(); asm volatile("" ::: "memory");
        return bad;
    }
};
struct EpiLnRes {
    static constexpr int PERM = 0; static constexpr bool AFTER_DRAIN = true; static constexpr int NSTORE = 0; static constexpr bool LDSBIAS = false;
    const float* base; float* out; int ldc; const float* bias; PanelStats st; unsigned poison;
    __device__ __forceinline__ void fused(f32x4 (&acc)[2][2][4][2], const Unit& u, int wr, int wc, int fr, int fq, PG8_LAS unsigned char* lds, int wid, int lane) const {
        typedef float f32x2v __attribute__((ext_vector_type(2)));
        const PG8_LAS f32x2v* S = (const PG8_LAS f32x2v*)(lds + 8192);
        const int col0 = u.pn * BM + wc * 32 + 4 * fq;
#pragma unroll
        for (int bj = 0; bj < 2; ++bj)
#pragma unroll
            for (int n = 0; n < 2; ++n) { const f32x4 bv = bias ? *(const f32x4*)(bias + col0 + bj * HALF + n * 16) : (f32x4){0.f, 0.f, 0.f, 0.f};
#pragma unroll
                for (int ai = 0; ai < 2; ++ai)
#pragma unroll
                    for (int m = 0; m < 4; ++m) acc[ai][bj][m][n] += bv; }
        f32x4 pre[4][2][2];
#pragma unroll
        for (int m = 0; m < 4; ++m) { const size_t off = (size_t)(u.pm * BM + wr * 64 + m * 16 + fr) * ldc + col0;
#pragma unroll
            for (int bj = 0; bj < 2; ++bj)
#pragma unroll
                for (int n = 0; n < 2; ++n) pre[m][bj][n] = *(const f32x4*)(base + off + bj * HALF + n * 16); }
        const bool bad = st.run(acc, u, wr, wc, fr, fq, lds, wid, lane) || poison != 0u;
        const float qnan = __builtin_nanf("");
#pragma unroll
        for (int ai = 0; ai < 2; ++ai)
#pragma unroll
            for (int m = 0; m < 4; ++m) { const int r = ai * HALF + wr * 64 + m * 16 + fr; const f32x2v sr = S[r]; const size_t off = (size_t)(u.pm * BM + r) * ldc + col0;
#pragma unroll
                for (int bj = 0; bj < 2; ++bj)
#pragma unroll
                    for (int n = 0; n < 2; ++n) { const f32x4 bs = ai == 0 ? pre[m][bj][n] : *(const f32x4*)(base + off + bj * HALF + n * 16); f32x4 o = bs + (acc[ai][bj][m][n] - sr.x) * sr.y;
                        if (bad) o = (f32x4){qnan, qnan, qnan, qnan}; *(f32x4*)(out + off + bj * HALF + n * 16) = o; }
                if (m & 1) asm volatile("" ::: "memory"); }
    }
};
struct EpiLnResLn {
    static constexpr int PERM = 0; static constexpr bool AFTER_DRAIN = true; static constexpr int NSTORE = 0; static constexpr bool LDSBIAS = false;
    const float* base; float* out; bf16_t* xn; int ldc; const float* bias; PanelStats st1, st2; unsigned poison;
    __device__ __forceinline__ void fused(f32x4 (&acc)[2][2][4][2], const Unit& u, int wr, int wc, int fr, int fq, PG8_LAS unsigned char* lds, int wid, int lane) const {
        typedef float f32x2v __attribute__((ext_vector_type(2))); typedef unsigned u32x2v __attribute__((ext_vector_type(2)));
        const PG8_LAS f32x2v* S = (const PG8_LAS f32x2v*)(lds + 8192);
        const int col0 = u.pn * BM + wc * 32 + 4 * fq;
#pragma unroll
        for (int bj = 0; bj < 2; ++bj)
#pragma unroll
            for (int n = 0; n < 2; ++n) { const f32x4 bv = bias ? *(const f32x4*)(bias + col0 + bj * HALF + n * 16) : (f32x4){0.f, 0.f, 0.f, 0.f};
#pragma unroll
                for (int ai = 0; ai < 2; ++ai)
#pragma unroll
                    for (int m = 0; m < 4; ++m) acc[ai][bj][m][n] += bv; }
        bool bad = st1.run(acc, u, wr, wc, fr, fq, lds, wid, lane) || poison != 0u;
        const float qnan = __builtin_nanf("");
#pragma unroll
        for (int ai = 0; ai < 2; ++ai)
#pragma unroll
            for (int m = 0; m < 4; ++m) { const int r = ai * HALF + wr * 64 + m * 16 + fr; const f32x2v sr = S[r]; const size_t off = (size_t)(u.pm * BM + r) * ldc + col0;
#pragma unroll
                for (int bj = 0; bj < 2; ++bj)
#pragma unroll
                    for (int n = 0; n < 2; ++n) { const f32x4 bs = *(const f32x4*)(base + off + bj * HALF + n * 16); acc[ai][bj][m][n] = bs + (acc[ai][bj][m][n] - sr.x) * sr.y; }
                asm volatile("" : "+v"(acc[ai][0][m][0]), "+v"(acc[ai][0][m][1]), "+v"(acc[ai][1][m][0]), "+v"(acc[ai][1][m][1]));
                if (m & 1) asm volatile("" ::: "memory"); }
        const bool bad1 = bad;
        bad = st2.run(acc, u, wr, wc, fr, fq, lds, wid, lane) || bad;
#pragma unroll
        for (int ai = 0; ai < 2; ++ai)
#pragma unroll
            for (int m = 0; m < 4; ++m) { const int r = ai * HALF + wr * 64 + m * 16 + fr; const f32x2v sr = S[r]; const size_t off = (size_t)(u.pm * BM + r) * ldc + col0;
#pragma unroll
                for (int bj = 0; bj < 2; ++bj)
#pragma unroll
                    for (int n = 0; n < 2; ++n) { const f32x4 x1 = acc[ai][bj][m][n]; *(f32x4*)(out + off + bj * HALF + n * 16) = bad1 ? (f32x4){qnan, qnan, qnan, qnan} : x1;
                        const f32x4 o = (x1 - sr.x) * sr.y; u32x2v w; w.x = cvt_pk_bf16(o[0], o[1]); w.y = cvt_pk_bf16(o[2], o[3]);
                        if (bad) { w.x = 0x7fc07fc0u; w.y = 0x7fc07fc0u; } *(u32x2v*)(xn + off + bj * HALF + n * 16) = w; }
                asm volatile("" ::: "memory"); }
    }
};

template <class Epi, class Sched, bool ALIGN_EPI = false, bool SP2 = false, bool GATHER = false, bool FP8 = false>
__device__ __forceinline__ void gemm_phase(PG8_LAS unsigned char* lds, const Gemm g, const Sched& S, const Epi& E) {
    static_assert(!GATHER || SP2, "the gathered-A variant is written for the SP2 loop only");
    int tid_ = threadIdx.x; asm volatile("" : "+v"(tid_));
    const int tid = tid_, wid = __builtin_amdgcn_readfirstlane(tid >> 6), lane = tid & 63, wr = wid >> 2, wc = wid & 3, fr = lane & 15, fq = lane >> 4;
    const int K = g.K, nt = K / BK;
    unsigned voffA[2], voffB[2], voffB2[2][2];
#pragma unroll
    for (int i = 0; i < 2; ++i) { int R, C; stage_rc(tid * 16 + i * 8192, R, C); const int Rb = (Epi::PERM == 1) ? ((R & ~31) + perm32(R & 31)) : R;
        voffA[i] = (unsigned)(R * K + C) * 2u; voffB[i] = (unsigned)(Rb * K + C) * 2u;
        { const int rho = R & 31, n_ = rho >> 4, fq_ = (rho & 15) >> 2, i_ = rho & 3; const int r2 = (Epi::PERM == 3) ? (64 * (R >> 5) + 8 * fq_ + 4 * n_ + i_) : (64 * (R >> 5) + 16 * fq_ + 4 * n_ + i_), hs = (Epi::PERM == 3) ? 32 : 8;
          voffB2[0][i] = (unsigned)(r2 * K + C) * 2u; voffB2[1][i] = (unsigned)((r2 + hs) * K + C) * 2u; } }
#define PG8_GOFF(slot, u) do { int tq_ = threadIdx.x; asm volatile("" : "+v"(tq_)); int gR[2], gC[2]; stage_rc(tq_ * 16, gR[0], gC[0]); stage_rc(tq_ * 16 + 8192, gR[1], gC[1]);     \
        PG8_LAS unsigned* gt_ = S.gtab + (slot) * 2048 + wid * 64;     \
        __builtin_amdgcn_global_load_lds((const unsigned*)S.aptr(u, gR[0]), gt_, 4, 0, 0); __builtin_amdgcn_global_load_lds((const unsigned*)S.aptr(u, gR[1]), gt_ + 512, 4, 0, 0); \
        __builtin_amdgcn_global_load_lds((const unsigned*)S.aptr(u, HALF + gR[0]), gt_ + 1024, 4, 0, 0); __builtin_amdgcn_global_load_lds((const unsigned*)S.aptr(u, HALF + gR[1]), gt_ + 1536, 4, 0, 0); } while (0)
    unsigned gcb[2] = {0u, 0u};
    if constexpr (GATHER) { int r_, c_; stage_rc(tid * 16, r_, c_); gcb[0] = (unsigned)c_ * 2u; stage_rc(tid * 16 + 8192, r_, c_); gcb[1] = (unsigned)c_ * 2u; }
    const unsigned rowB = (unsigned)K * 2u;
    const size_t kstep = (size_t)(BK * 2);
    const size_t hstep = (size_t)HALF * K * 2;
    const size_t tstep = 2 * hstep;
    const unsigned ldsw = (unsigned)wid * 1024u;
    const int aoff = lds_byte(wr * 64 + fr, fq * 8), boff = lds_byte(wc * 32 + fr, fq * 8);
#define PG8_SA(b, h) (((b) * 2 + (h)) * HTB)
#define PG8_SB(b, h) ((4 + (b) * 2 + (h)) * HTB)
#define PG8_STAGE(bufoff, gbase, voff) do { _Pragma("unroll") for (int _i = 0; _i < 2; ++_i) \
        __builtin_amdgcn_global_load_lds((const unsigned*)((const char*)(gbase) + (voff)[_i]), (PG8_LAS unsigned*)(lds + (bufoff) + ldsw + _i * 8192), 16, 0, 0); } while (0)
#define PG8_STAGE_B(bufoff, gbase, h) do { if constexpr (Epi::PERM >= 2) PG8_STAGE(bufoff, gbase, voffB2[h]); else PG8_STAGE(bufoff, (gbase) + (size_t)(h) * hstep, voffB); } while (0)
#define PG8_LDA(dst, b, h) do { _Pragma("unroll") for (int m = 0; m < 4; ++m) { if constexpr (FP8) { dst##8[m].lo = *(const PG8_LAS i32x4_t*)(lds + PG8_SA(b, h) + aoff + m * 2048); dst##8[m].hi = *(const PG8_LAS i32x4_t*)(lds + PG8_SA(b, h) + aoff + m * 2048 + 1024); } \
        else { _Pragma("unroll") for (int k = 0; k < 2; ++k) dst[m][k] = *(const PG8_LAS bf16x8*)(lds + PG8_SA(b, h) + aoff + m * 2048 + k * 1024); } } } while (0)
#define PG8_LDB(dst, b, h) do { _Pragma("unroll") for (int n = 0; n < 2; ++n) { if constexpr (FP8) { dst##8[n].lo = *(const PG8_LAS i32x4_t*)(lds + PG8_SB(b, h) + boff + n * 2048); dst##8[n].hi = *(const PG8_LAS i32x4_t*)(lds + PG8_SB(b, h) + boff + n * 2048 + 1024); } \
        else { _Pragma("unroll") for (int k = 0; k < 2; ++k) dst[n][k] = *(const PG8_LAS bf16x8*)(lds + PG8_SB(b, h) + boff + n * 2048 + k * 1024); } } } while (0)
#define PG8_MMA(ai, bj, At, Bt) do { __builtin_amdgcn_s_setprio(1); \
        if constexpr (FP8) { _Pragma("unroll") for (int m = 0; m < 4; ++m) _Pragma("unroll") for (int n = 0; n < 2; ++n) \
            asm volatile("v_mfma_scale_f32_16x16x128_f8f6f4 %0, %1, %2, %0, %3, %3 op_sel_hi:[0,0,0]" : "+v"(acc[ai][bj][m][n]) : "v"(Bt##8[n]), "v"(At##8[m]), "v"(sc7f)); } \
        else { _Pragma("unroll") for (int m = 0; m < 4; ++m) _Pragma("unroll") for (int n = 0; n < 2; ++n) _Pragma("unroll") for (int k = 0; k < 2; ++k) \
            acc[ai][bj][m][n] = __builtin_amdgcn_mfma_f32_16x16x32_bf16(Bt[n][k], At[m][k], acc[ai][bj][m][n], 0, 0, 0); } \
        __builtin_amdgcn_s_setprio(0); } while (0)
#define PG8_WAIT_V(n) asm volatile("s_waitcnt vmcnt(" #n ")" ::: "memory")
#define PG8_WAIT_V1 do { if (t != 0 || xtra == 0) PG8_WAIT_V(8); else if (xtra == 1) PG8_WAIT_V(9); else if (xtra == 5) PG8_WAIT_V(13); else if (xtra == 9) PG8_WAIT_V(17); else if (xtra == 13) PG8_WAIT_V(21); \
        else if (xtra == 16) PG8_WAIT_V(24); else if (xtra == 8) PG8_WAIT_V(16); else if (xtra == 12) PG8_WAIT_V(20); else if (xtra == 4) PG8_WAIT_V(12); else PG8_WAIT_V(8); } while (0)
#define PG8_WAIT_L(n) asm volatile("s_waitcnt lgkmcnt(" #n ")" ::: "memory")
#define PG8_BAR __builtin_amdgcn_s_barrier()
#define PG8_SCHED __builtin_amdgcn_sched_barrier(0)
    Unit cur, nxt; int ui = 0;
    if (!S.next(0, cur)) return;
    f32x4 acc[2][2][4][2];
#pragma unroll
    for (int a = 0; a < 2; ++a)
#pragma unroll
        for (int b = 0; b < 2; ++b)
#pragma unroll
            for (int m = 0; m < 4; ++m)
#pragma unroll
                for (int n = 0; n < 2; ++n) acc[a][b][m][n] = (f32x4){0.f, 0.f, 0.f, 0.f};
    bf16x8 At[4][2], B0[2][2], B1[2][2]; i32x8_t At8[4], B08[2], B18[2];
    int sc7f = 0x7f7f7f7f; asm volatile("" : "+v"(sc7f));
    const char* cA = (const char*)g.A + (GATHER ? (size_t)0 : (size_t)cur.pm * tstep); const char* cB = (const char*)g.Bt + (size_t)cur.pn * tstep;
    S.a_ready(cur);
    int gslot = 0;
    if constexpr (GATHER) { PG8_GOFF(0, cur); PG8_WAIT_V(0); }
    const size_t hA = GATHER ? (size_t)0 : hstep;
#define PG8_STAGE_A(bufoff, gbase, h, sl) do { if constexpr (GATHER) { const PG8_LAS unsigned* gt_ = S.gtab + (sl) * 2048 + (h) * 1024 + tid; const unsigned o_[2] = {gt_[0] * rowB + gcb[0], gt_[512] * rowB + gcb[1]}; PG8_STAGE(bufoff, gbase, o_); } \
        else PG8_STAGE(bufoff, (gbase) + (size_t)(h) * hA, voffA); } while (0)
    if constexpr (SP2) {
        PG8_STAGE_B(PG8_SB(0, 0), cB, 0); PG8_STAGE_B(PG8_SB(0, 1), cB, 1); PG8_STAGE_A(PG8_SA(0, 0), cA, 0, 0); PG8_STAGE_A(PG8_SA(0, 1), cA, 1, 0);
        if (wr == 1) PG8_BAR;
        PG8_WAIT_V(2); PG8_BAR;
        PG8_STAGE_B(PG8_SB(1, 0), cB + kstep, 0); PG8_STAGE_A(PG8_SA(1, 0), cA + kstep, 0, 0); PG8_STAGE_B(PG8_SB(1, 1), cB + kstep, 1);
        PG8_WAIT_V(6); PG8_BAR;
    } else {
        PG8_STAGE_B(PG8_SB(0, 0), cB, 0); PG8_STAGE(PG8_SA(0, 0), cA, voffA); PG8_STAGE_B(PG8_SB(0, 1), cB, 1); PG8_STAGE(PG8_SA(0, 1), cA + hstep, voffA);
        if (wr == 1) PG8_BAR;
        PG8_WAIT_V(4); PG8_BAR;
        PG8_STAGE_B(PG8_SB(1, 0), cB + kstep, 0); PG8_STAGE(PG8_SA(1, 0), cA + kstep, voffA); PG8_STAGE_B(PG8_SB(1, 1), cB + kstep, 1);
        PG8_WAIT_V(6); PG8_BAR;
    }
    for (;;) {
        const bool has_next = S.next(ui + 1, nxt);
        const char* nA = (has_next && !GATHER) ? (const char*)g.A + (size_t)nxt.pm * tstep : cA; const char* nB = has_next ? (const char*)g.Bt + (size_t)nxt.pn * tstep : cB;
        if constexpr (GATHER) { if (has_next) PG8_GOFF(gslot ^ 1, nxt); }
        bool lbp = false;
        if constexpr (Epi::LDSBIAS) { if (E.lbias) { lbp = true; __builtin_amdgcn_global_load_lds((const unsigned*)E.bias_src(cur, wc, lane), (PG8_LAS unsigned*)(E.lbias + wid * 64), 4, 0, 0); } }
        const int xtra = ((ui > 0 && E.dbg == 0) ? Epi::NSTORE : 0) + ((GATHER && has_next) ? 4 : 0) + (lbp ? 1 : 0);
#pragma unroll 1
        for (int t = 0; t < nt; t += 2) {
            const bool last = (t == nt - 2);
            const char* a1 = cA + (size_t)(t + 1) * kstep;
            const char* a2 = last ? nA : cA + (size_t)(t + 2) * kstep; const char* b2 = last ? nB : cB + (size_t)(t + 2) * kstep;
            const char* a3 = a2 + kstep; const char* b3 = b2 + kstep;
            if (last && has_next) S.a_ready(nxt);
            const int gnx = (last && has_next) ? (gslot ^ 1) : gslot;
            if constexpr (SP2) {
            PG8_LDB(B0, 0, 0); PG8_LDB(B1, 0, 1); PG8_SCHED; PG8_LDA(At, 0, 0); PG8_STAGE_A(PG8_SA(1, 1), a1, 1, gslot);
            PG8_WAIT_V1;
            PG8_WAIT_L(0); PG8_BAR; PG8_MMA(0, 0, At, B0); PG8_MMA(0, 1, At, B1); PG8_BAR; PG8_SCHED;
            PG8_LDA(At, 0, 1); PG8_STAGE_B(PG8_SB(0, 0), b2, 0); PG8_STAGE_B(PG8_SB(0, 1), b2, 1); PG8_STAGE_A(PG8_SA(0, 0), a2, 0, gnx);
            PG8_WAIT_V1;
            PG8_WAIT_L(0); PG8_BAR; PG8_MMA(1, 0, At, B0); PG8_MMA(1, 1, At, B1); PG8_BAR; PG8_SCHED;
            PG8_LDB(B0, 1, 0); PG8_LDB(B1, 1, 1); PG8_SCHED; PG8_LDA(At, 1, 0); PG8_STAGE_A(PG8_SA(0, 1), a2, 1, gnx);
            PG8_WAIT_V(8); PG8_WAIT_L(0); PG8_BAR; PG8_MMA(0, 0, At, B0); PG8_MMA(0, 1, At, B1); PG8_BAR; PG8_SCHED;
            PG8_LDA(At, 1, 1); PG8_STAGE_B(PG8_SB(1, 0), b3, 0); PG8_STAGE_B(PG8_SB(1, 1), b3, 1); PG8_STAGE_A(PG8_SA(1, 0), a3, 0, gnx);
            PG8_WAIT_V(8); PG8_WAIT_L(0); PG8_BAR; PG8_MMA(1, 0, At, B0); PG8_MMA(1, 1, At, B1); PG8_BAR; PG8_SCHED;
            } else {
            PG8_LDB(B0, 0, 0); PG8_SCHED; PG8_LDA(At, 0, 0); PG8_STAGE(PG8_SA(1, 1), a1 + hstep, voffA);
            PG8_WAIT_L(8); PG8_BAR; PG8_WAIT_L(0); PG8_MMA(0, 0, At, B0); PG8_BAR; PG8_SCHED;
            PG8_LDB(B1, 0, 1); PG8_STAGE_B(PG8_SB(0, 0), b2, 0);
            PG8_BAR; PG8_WAIT_L(0); PG8_MMA(0, 1, At, B1); PG8_BAR;
            PG8_LDA(At, 0, 1); PG8_STAGE(PG8_SA(0, 0), a2, voffA);
            PG8_BAR; PG8_WAIT_L(0); PG8_MMA(1, 0, At, B0); PG8_BAR; PG8_SCHED;
            PG8_STAGE_B(PG8_SB(0, 1), b2, 1);
            PG8_WAIT_V(6); PG8_BAR; PG8_MMA(1, 1, At, B1); PG8_BAR;
            PG8_LDB(B0, 1, 0); PG8_SCHED; PG8_LDA(At, 1, 0); PG8_STAGE(PG8_SA(0, 1), a2 + hstep, voffA);
            PG8_WAIT_L(8); PG8_BAR; PG8_WAIT_L(0); PG8_MMA(0, 0, At, B0); PG8_BAR; PG8_SCHED;
            PG8_LDB(B1, 1, 1); PG8_STAGE_B(PG8_SB(1, 0), b3, 0);
            PG8_BAR; PG8_WAIT_L(0); PG8_MMA(0, 1, At, B1); PG8_BAR;
            PG8_LDA(At, 1, 1); PG8_STAGE(PG8_SA(1, 0), a3, voffA);
            PG8_BAR; PG8_WAIT_L(0); PG8_MMA(1, 0, At, B0); PG8_BAR; PG8_SCHED;
            PG8_STAGE_B(PG8_SB(1, 1), b3, 1);
            PG8_WAIT_V(6); PG8_BAR; PG8_MMA(1, 1, At, B1); PG8_BAR;
            }
        }
        if constexpr (ALIGN_EPI) { if (wr == 0) PG8_BAR; }
        if constexpr (FP8) asm volatile("s_nop 15\n\ts_nop 15" ::: "memory");
        if constexpr (!Epi::AFTER_DRAIN) { E(acc, cur, wr, wc, fr, fq); S.done(cur); }
        if (!has_next) break;
#pragma unroll
        for (int a = 0; a < 2; ++a)
#pragma unroll
            for (int b = 0; b < 2; ++b)
#pragma unroll
                for (int m = 0; m < 4; ++m)
#pragma unroll
                    for (int n = 0; n < 2; ++n) acc[a][b][m][n] = (f32x4){0.f, 0.f, 0.f, 0.f};
        cur = nxt; cA = nA; cB = nB; ++ui;
        gslot ^= 1;
        if constexpr (ALIGN_EPI) { if (wr == 1) PG8_BAR; }
    }
    PG8_WAIT_V(0);
    if constexpr (!ALIGN_EPI) { if (wr == 0) PG8_BAR; }
    PG8_BAR;
    if constexpr (Epi::AFTER_DRAIN) { E.fused(acc, cur, wr, wc, fr, fq, lds, wid, lane); S.done(cur); }
#undef PG8_SA
#undef PG8_GOFF
#undef PG8_STAGE_A
#undef PG8_SB
#undef PG8_STAGE
#undef PG8_STAGE_B
#undef PG8_LDA
#undef PG8_LDB
#undef PG8_MMA
#undef PG8_WAIT_V
#undef PG8_WAIT_V1
#undef PG8_WAIT_L
#undef PG8_BAR
#undef PG8_SCHED
}
}
#include <hip/hip_bf16.h>
#include <cmath>
namespace attn_body {
using bf16=__hip_bfloat16;
using bf16x8=__attribute__((ext_vector_type(8)))short;
using s16x4=__attribute__((ext_vector_type(4)))short;
using f32x16=__attribute__((ext_vector_type(16)))float;
using u32x4=__attribute__((ext_vector_type(4)))unsigned;
constexpr int SEQ=4096,D=64,PIN=3072,PO=1024;
constexpr int NW=8,QBLK=32,QB=QBLK*NW,KVBLK=64,NQB=SEQ/QB;
constexpr int ATTN_UNIT_ROWS=QB;
__device__ __forceinline__ int crow(int r,int hi){return (r&3)+8*(r>>2)+4*hi;}
#define SBAR() __builtin_amdgcn_sched_barrier(0)
__device__ __forceinline__ void cmask(f32x16&p0,f32x16&p1,int jb,int qrel,int hi){
  const float NEG=-INFINITY; int kb=64*jb+4*hi;
  #pragma unroll
  for(int r=0;r<16;++r){int kv=kb+(r&3)+8*(r>>2); if(kv>qrel)p0[r]=NEG; if(kv+32>qrel)p1[r]=NEG;}
}

constexpr int NSLOT=3, SLOTB=8192;
constexpr int LDS_K=0, LDS_V=NSLOT*SLOTB, LDS_V2=2*NSLOT*SLOTB, LDS_WS=3*NSLOT*SLOTB, LDS_OST=LDS_WS+NW*64*4, LDS_BYTES=LDS_OST+NW*4096;
constexpr float C2=0.125f*1.4426950408889634f;
__device__ __forceinline__ void glds16(const void*gsrc,unsigned lds_dst){unsigned keep;
  asm volatile("s_mov_b32 %0, m0\n\ts_mov_b32 m0, %2\n\ts_nop 0\n\tglobal_load_lds_dwordx4 %1, off\n\ts_mov_b32 m0, %0":"=&s"(keep):"v"(gsrc),"s"(lds_dst):"memory");}
__device__ __forceinline__ float max3f(float a,float b,float c){float r;asm("v_max3_f32 %0, %1, %2, %3":"=v"(r):"v"(a),"v"(b),"v"(c));return r;}
__device__ __forceinline__ float max2f(float a,float b){float r;asm("v_max_f32_e32 %0, %1, %2":"=v"(r):"v"(a),"v"(b));return r;}
__device__ __forceinline__ float fadd_s(float a,float b){float r;asm("v_add_f32_e32 %0, %1, %2":"=v"(r):"v"(a),"v"(b));return r;}
__device__ __forceinline__ float fsub_s(float a,float b){float r;asm("v_sub_f32_e32 %0, %1, %2":"=v"(r):"v"(a),"v"(b));return r;}
typedef float f32x2_t __attribute__((ext_vector_type(2))); typedef __bf16 bf16x2_t __attribute__((ext_vector_type(2)));
__device__ __forceinline__ unsigned cvtpk_s(float lo,float hi){f32x2_t v={lo,hi};bf16x2_t b=__builtin_convertvector(v,bf16x2_t);return __builtin_bit_cast(unsigned,b);}
#define WAIT_BAR(N) asm volatile("s_waitcnt vmcnt(" #N ") lgkmcnt(0)\n\ts_barrier":::"memory")

__device__ __forceinline__ void qkt(f32x16&p0,f32x16&p1,const char*Kslot,const bf16x8*qr,const f32x16&negm,int r32,int hi){
  const char*kb=Kslot+hi*1024+r32*16;
  #pragma unroll
  for(int d0=0;d0<4;++d0){
    const bf16x8 b0=*reinterpret_cast<const bf16x8*>(kb+d0*2048);
    const bf16x8 b1=*reinterpret_cast<const bf16x8*>(kb+d0*2048+512);
    if(d0==0){p0=__builtin_amdgcn_mfma_f32_32x32x16_bf16(b0,qr[0],negm,0,0,0);p1=__builtin_amdgcn_mfma_f32_32x32x16_bf16(b1,qr[0],negm,0,0,0);}
    else{p0=__builtin_amdgcn_mfma_f32_32x32x16_bf16(b0,qr[d0],p0,0,0,0);p1=__builtin_amdgcn_mfma_f32_32x32x16_bf16(b1,qr[d0],p1,0,0,0);}}
}
typedef __attribute__((address_space(3))) const char* lds_cptr;
typedef short v4i16_t __attribute__((ext_vector_type(4)));
__device__ __forceinline__ void kload8(bf16x8*kf,lds_cptr kp){
  kf[0]=*(const __attribute__((address_space(3))) bf16x8*)(kp);      kf[1]=*(const __attribute__((address_space(3))) bf16x8*)(kp+512);
  kf[2]=*(const __attribute__((address_space(3))) bf16x8*)(kp+2048); kf[3]=*(const __attribute__((address_space(3))) bf16x8*)(kp+2560);
  kf[4]=*(const __attribute__((address_space(3))) bf16x8*)(kp+4096); kf[5]=*(const __attribute__((address_space(3))) bf16x8*)(kp+4608);
  kf[6]=*(const __attribute__((address_space(3))) bf16x8*)(kp+6144); kf[7]=*(const __attribute__((address_space(3))) bf16x8*)(kp+6656);
}
__device__ __forceinline__ void kload2(bf16x8*kf,lds_cptr kp,int j){ kf[2*j]=*(const __attribute__((address_space(3))) bf16x8*)(kp+j*2048); kf[2*j+1]=*(const __attribute__((address_space(3))) bf16x8*)(kp+j*2048+512); }
__device__ __forceinline__ s16x4 vtr(lds_cptr p){ return __builtin_bit_cast(s16x4,__builtin_amdgcn_ds_read_tr16_b64_v4i16((__attribute__((address_space(3))) v4i16_t*)p)); }
__device__ __forceinline__ float rowmax(const f32x16&p0,const f32x16&p1){
  float a=max3f(p0[0],p0[1],p1[0]),b=max3f(p0[2],p0[3],p1[1]);a=max3f(a,p1[2],p1[3]);
  #pragma unroll
  for(int r=4;r<16;r+=4){a=max3f(a,p0[r],p0[r+1]);b=max3f(b,p0[r+2],p0[r+3]);a=max3f(a,p1[r],p1[r+1]);b=max3f(b,p1[r+2],p1[r+3]);}
  const float m=max2f(a,b);
  auto rr=__builtin_amdgcn_permlane32_swap(__float_as_uint(m),__float_as_uint(m),false,false);
  return max2f(__uint_as_float(rr[0]),__uint_as_float(rr[1]));
}
__device__ __forceinline__ void pv(f32x16*o,int vb,bf16x8 pa0,bf16x8 pa1,bf16x8 pa2,bf16x8 pa3){
  #pragma unroll
  for(int d0=0;d0<2;++d0){s16x4 lo[4],hi[4];
    #pragma unroll
    for(int ks=0;ks<4;++ks){
      asm volatile("ds_read_b64_tr_b16 %0,%1 offset:%c2":"=&v"(lo[ks]):"v"(vb),"i"(d0*4096+ks*1024):"memory");
      asm volatile("ds_read_b64_tr_b16 %0,%1 offset:%c2":"=&v"(hi[ks]):"v"(vb),"i"(d0*4096+ks*1024+512):"memory");}
    asm volatile("s_waitcnt lgkmcnt(0)":::"memory");SBAR();
    #define PK(k) (bf16x8){lo[k][0],lo[k][1],lo[k][2],lo[k][3],hi[k][0],hi[k][1],hi[k][2],hi[k][3]}
    o[d0]=__builtin_amdgcn_mfma_f32_32x32x16_bf16(pa0,PK(0),o[d0],0,0,0);
    o[d0]=__builtin_amdgcn_mfma_f32_32x32x16_bf16(pa1,PK(1),o[d0],0,0,0);
    o[d0]=__builtin_amdgcn_mfma_f32_32x32x16_bf16(pa2,PK(2),o[d0],0,0,0);
    o[d0]=__builtin_amdgcn_mfma_f32_32x32x16_bf16(pa3,PK(3),o[d0],0,0,0);
    #undef PK
  }
}

#ifndef ATTN_STORE16
#define ATTN_STORE16(p,v) (*(u32x4*)(p)=(v))
#endif
template<int THRL> __device__ __forceinline__ void attn_unit(int b,int qb,const bf16*Q,const bf16*__restrict__ K,const bf16*__restrict__ V,bf16*O,char*shm,int cmap,float lam,float osc,const float*ng,bf16*M){
  int tid_=threadIdx.x; asm volatile("":"+v"(tid_)); const int tid=tid_,lane=tid&63,r32=lane&31,hi=lane>>5; const int wid=__builtin_amdgcn_readfirstlane(tid>>6);
  const long rowbase=(long)b*SEQ; const int q0=qb*QB;
  const bf16*Qw=Q+(rowbase+q0+wid*QBLK)*PIN;
  const bf16*Kh=K+rowbase*PIN,*Vh=V+rowbase*PIN;
  const unsigned lds0=(unsigned)(uintptr_t)shm;
  float*wsf=(float*)(shm+LDS_WS)+wid*64;
  const unsigned koff=(unsigned)(lane*PIN+wid*8)*2u, voff=(unsigned)((16*(wid&3)+(lane>>2))*PIN+(wid>>2)*32+(lane&3)*8)*2u;
  const unsigned kdst=lds0+LDS_K+wid*1024, vdst=lds0+LDS_V+wid*1024, vdst2=lds0+LDS_V2+wid*1024;
  #define DMA_K(t,slot) glds16((const char*)Kh+(size_t)(t)*(KVBLK*PIN*2)+koff,(unsigned)__builtin_amdgcn_readfirstlane(kdst+(slot)))
  #define DMA_V(t,slot) do{ glds16((const char*)Vh+(size_t)(t)*(KVBLK*PIN*2)+voff,(unsigned)__builtin_amdgcn_readfirstlane(vdst+(slot))); glds16((const char*)Vh+(size_t)(t)*(KVBLK*PIN*2)+128+voff,(unsigned)__builtin_amdgcn_readfirstlane(vdst2+(slot))); }while(0)
  const int vb0=(int)(lds0+LDS_V)+((lane>>4)&1)*32+(lane&3)*8+(4*hi+((lane&15)>>2))*64;
  const char*Kbase=shm+LDS_K; bf16x8 kf[8];
  const lds_cptr shm3=(lds_cptr)shm; const lds_cptr kp0=shm3+LDS_K+hi*1024+r32*16; const lds_cptr vp0=shm3+LDS_V+((lane>>4)&1)*32+(lane&3)*8+(4*hi+((lane&15)>>2))*64;
  const int NT=(q0+QB)/KVBLK;
  DMA_K(0,0);DMA_V(0,0);DMA_K(1,SLOTB);
  bf16x8 qr[4];
  #pragma unroll
  for(int d0=0;d0<4;++d0)qr[d0]=*reinterpret_cast<const bf16x8*>(&Qw[(long)r32*PIN+d0*16+hi*8]);
  const __attribute__((address_space(3))) bf16x8* qld=(const __attribute__((address_space(3))) bf16x8*)(shm3+LDS_OST+wid*4096)+lane;
  #pragma unroll
  for(int d0=0;d0<4;++d0)((__attribute__((address_space(3))) bf16x8*)(shm3+LDS_OST+wid*4096))[d0*64+lane]=qr[d0];
  float mhat=0.f,l_reg=0.f;f32x16 o[2];o[0]=f32x16{};o[1]=f32x16{};f32x16 o2[2];o2[0]=f32x16{};o2[1]=f32x16{}; const f32x16 zero16=f32x16{};
  const int qrel=wid*QBLK+r32;
  #define CMASK(P0,P1,t) do{int jb_=(t)-(NT-4); if(jb_>=0)cmask(P0,P1,jb_,qrel,hi);}while(0)
  bool resc=false;
  #define START(P0,P1) do{ const float rm=rowmax(P0,P1); resc=false; \
    { const float dl=rm; mhat=fadd_s(mhat,dl); \
      _Pragma("unroll") for(int r=0;r<16;++r){P0[r]=fsub_s(P0[r],dl);P1[r]=fsub_s(P1[r],dl);} } \
    _Pragma("unroll") for(int r=0;r<16;++r)P0[r]=__builtin_amdgcn_exp2f(P0[r]); }while(0)
  #define RESC() do{ if(resc){ asm volatile("s_waitcnt lgkmcnt(0)":::"memory"); \
      _Pragma("unroll") for(int d_=0;d_<2;++d_) _Pragma("unroll") for(int r=0;r<16;++r){ const float f_=wsf[crow(r,hi)]; o[d_][r]*=f_; o2[d_][r]*=f_; } } }while(0)
  f32x16 pA0,pA1,pB0,pB1;
  int sl_prev=0,sl_cur=0,sl_next=SLOTB;
  #define ROT() do{sl_prev=sl_cur;sl_cur=sl_next;sl_next=(sl_next==(NSLOT-1)*SLOTB)?0:sl_next+SLOTB;}while(0)
  DMA_K(2,2*SLOTB);
  WAIT_BAR(3);
  qkt(pA0,pA1,Kbase,qr,zero16,r32,hi);asm volatile("s_nop 15\n\ts_nop 7":"+v"(pA0),"+v"(pA1));CMASK(pA0,pA1,0);
  START(pA0,pA1);
  _Pragma("unroll") for(int r=0;r<16;++r)pA1[r]=__builtin_amdgcn_exp2f(pA1[r]);
  WAIT_BAR(0);
  DMA_K(3,0);DMA_V(1,SLOTB);
  ROT();
  kload8(kf,kp0+sl_cur);
  WAIT_BAR(3);
  s16x4 vlo[8],vhi[8]; u32x4 pw0,pw1,pw2,pw3;
  #define PKW(P,B) cvtpk_s(P[B],P[B+1])
  #define PAF(k) __builtin_bit_cast(bf16x8,pw##k)
  #define VFR(i) (bf16x8){vlo[i][0],vlo[i][1],vlo[i][2],vlo[i][3],vhi[i][0],vhi[i][1],vhi[i][2],vhi[i][3]}
  #define PIN(x) asm volatile("":"+v"(x))
  #define MX3(a,b,c) __builtin_fmaxf(__builtin_fmaxf((a),(b)),(c))
  #define GAPA(MF,A0,A1,A2,A3,W0,W1,PW) do{ MF; sacc+=A0; sacc+=A1; sacc+=A2; sacc+=A3; PIN(sacc); W0; W1; PIN(PW); SBAR(); }while(0)
  #define EX(v) __builtin_amdgcn_exp2f(v)
  #define GAPB(MF,X,B) do{ MF; X[B]=EX(X[B]-mhat); X[B+1]=EX(X[B+1]-mhat); PIN(X); SBAR(); }while(0)
  #define VRD(i) do{ vlo[i]=vtr(vp_+(((i)>>2)*4096+((i)&3)*1024)); vhi[i]=vtr(vp_+(((i)>>2)*4096+((i)&3)*1024+512)); }while(0)
  #define KRD(G,j) do{ if(G){ kload2(kf,kp0+sl_next,j); SBAR(); } }while(0)
  #define V2RD(i) do{ vlo[i]=vtr(vq_+(((i)>>2)*4096+((i)&3)*1024)); vhi[i]=vtr(vq_+(((i)>>2)*4096+((i)&3)*1024+512)); }while(0)
  #define STEP(C0,C1,P0,P1,t,GK,GV,GL) do{ SBAR(); \
    const lds_cptr vp_=vp0+sl_prev; \
    const bf16x8 q0_=qld[0],q1_=qld[64],q2_=qld[128],q3_=qld[192];     \
    VRD(0); SBAR(); float sacc=(P0[0]+P0[1]); \
    GAPA(C0=__builtin_amdgcn_mfma_f32_32x32x16_bf16(kf[0],q0_,zero16,0,0,0), P0[2],P0[3],P0[4],P0[5],     pw0[0]=PKW(P0,0), pw0[1]=PKW(P0,2), pw0); \
    VRD(4); SBAR(); GAPA(C1=__builtin_amdgcn_mfma_f32_32x32x16_bf16(kf[1],q0_,zero16,0,0,0), P0[6],P0[7],P0[8],P0[9],     pw0[2]=PKW(P0,4), pw0[3]=PKW(P0,6), pw0); \
    VRD(1); SBAR(); GAPA(C0=__builtin_amdgcn_mfma_f32_32x32x16_bf16(kf[2],q1_,C0,0,0,0),   P0[10],P0[11],P0[12],P0[13], pw1[0]=PKW(P0,8), pw1[1]=PKW(P0,10), pw1); \
    VRD(5); SBAR(); GAPA(C1=__builtin_amdgcn_mfma_f32_32x32x16_bf16(kf[3],q1_,C1,0,0,0),   P0[14],P0[15],P1[0],P1[1],   pw1[2]=PKW(P0,12),pw1[3]=PKW(P0,14), pw1); \
    VRD(2); SBAR(); GAPA(C0=__builtin_amdgcn_mfma_f32_32x32x16_bf16(kf[4],q2_,C0,0,0,0),   P1[2],P1[3],P1[4],P1[5],     pw2[0]=PKW(P1,0), pw2[1]=PKW(P1,2), pw2); \
    VRD(6); SBAR(); GAPA(C1=__builtin_amdgcn_mfma_f32_32x32x16_bf16(kf[5],q2_,C1,0,0,0),   P1[6],P1[7],P1[8],P1[9],     pw2[2]=PKW(P1,4), pw2[3]=PKW(P1,6), pw2); \
    VRD(3); SBAR(); GAPA(C0=__builtin_amdgcn_mfma_f32_32x32x16_bf16(kf[6],q3_,C0,0,0,0),   P1[10],P1[11],P1[12],P1[13], pw3[0]=PKW(P1,8), pw3[1]=PKW(P1,10), pw3); \
    VRD(7); SBAR(); GAPA(C1=__builtin_amdgcn_mfma_f32_32x32x16_bf16(kf[7],q3_,C1,0,0,0),   P1[14],P1[15],0.f,0.f,       pw3[2]=PKW(P1,12),pw3[3]=PKW(P1,14), pw3); \
    l_reg+=sacc; \
    if(GK){DMA_K((t)+3,sl_cur);} if(GV){DMA_V((t)+1,sl_next);} \
    CMASK(C0,C1,t); \
    { float a=MX3(C0[0],C0[1],C1[0]),b=MX3(C0[2],C0[3],C1[1]); a=MX3(a,C1[2],C1[3]); \
      _Pragma("unroll") for(int r=4;r<16;r+=4){a=MX3(a,C0[r],C0[r+1]);b=MX3(b,C0[r+2],C0[r+3]);a=MX3(a,C1[r],C1[r+1]);b=MX3(b,C1[r+2],C1[r+3]);} \
      float rm=__builtin_fmaxf(a,b); { auto rr=__builtin_amdgcn_permlane32_swap(__float_as_uint(rm),__float_as_uint(rm),false,false); rm=__builtin_fmaxf(__uint_as_float(rr[0]),__uint_as_float(rr[1])); } \
      rm-=mhat; resc=false; \
      if(__builtin_expect(__any(rm>(float)THRL),0)){ const float dl=__builtin_fmaxf(rm,0.f); mhat+=dl; \
        const float f=__builtin_amdgcn_exp2f(-dl); l_reg*=f; if(hi==0)wsf[r32]=f; resc=true; } } \
    SBAR(); \
    const lds_cptr vq_=vp0+(LDS_V2-LDS_V)+sl_prev;     \
    GAPB(o[0]=__builtin_amdgcn_mfma_f32_32x32x16_bf16(PAF(0),VFR(0),o[0],0,0,0), C0,0); \
    GAPB(o[1]=__builtin_amdgcn_mfma_f32_32x32x16_bf16(PAF(0),VFR(4),o[1],0,0,0), C0,2); V2RD(0); V2RD(4); SBAR(); \
    KRD(GL,0); GAPB(o[0]=__builtin_amdgcn_mfma_f32_32x32x16_bf16(PAF(1),VFR(1),o[0],0,0,0), C0,4); \
    KRD(GL,1); GAPB(o[1]=__builtin_amdgcn_mfma_f32_32x32x16_bf16(PAF(1),VFR(5),o[1],0,0,0), C0,6); V2RD(1); V2RD(5); SBAR(); \
    KRD(GL,2); GAPB(o[0]=__builtin_amdgcn_mfma_f32_32x32x16_bf16(PAF(2),VFR(2),o[0],0,0,0), C0,8); \
    KRD(GL,3); GAPB(o[1]=__builtin_amdgcn_mfma_f32_32x32x16_bf16(PAF(2),VFR(6),o[1],0,0,0), C0,10); V2RD(2); V2RD(6); SBAR(); \
    GAPB(o[0]=__builtin_amdgcn_mfma_f32_32x32x16_bf16(PAF(3),VFR(3),o[0],0,0,0), C0,12); \
    GAPB(o[1]=__builtin_amdgcn_mfma_f32_32x32x16_bf16(PAF(3),VFR(7),o[1],0,0,0), C0,14); V2RD(3); V2RD(7); SBAR(); \
    {     \
      GAPB(o2[0]=__builtin_amdgcn_mfma_f32_32x32x16_bf16(PAF(0),VFR(0),o2[0],0,0,0), C1,0); GAPB(o2[1]=__builtin_amdgcn_mfma_f32_32x32x16_bf16(PAF(0),VFR(4),o2[1],0,0,0), C1,2); \
      GAPB(o2[0]=__builtin_amdgcn_mfma_f32_32x32x16_bf16(PAF(1),VFR(1),o2[0],0,0,0), C1,4); GAPB(o2[1]=__builtin_amdgcn_mfma_f32_32x32x16_bf16(PAF(1),VFR(5),o2[1],0,0,0), C1,6); \
      GAPB(o2[0]=__builtin_amdgcn_mfma_f32_32x32x16_bf16(PAF(2),VFR(2),o2[0],0,0,0), C1,8); GAPB(o2[1]=__builtin_amdgcn_mfma_f32_32x32x16_bf16(PAF(2),VFR(6),o2[1],0,0,0), C1,10); \
      GAPB(o2[0]=__builtin_amdgcn_mfma_f32_32x32x16_bf16(PAF(3),VFR(3),o2[0],0,0,0), C1,12); GAPB(o2[1]=__builtin_amdgcn_mfma_f32_32x32x16_bf16(PAF(3),VFR(7),o2[1],0,0,0), C1,14); } \
    }while(0)
  int t=1;
  #undef CMASK
  #define CMASK(P0,P1,t) do{}while(0)
  for(;t+5<NT;t+=2){
    STEP(pB0,pB1,pA0,pA1,t,true,true,true);     WAIT_BAR(3); RESC(); ROT();
    STEP(pA0,pA1,pB0,pB1,t+1,true,true,true);   WAIT_BAR(3); RESC(); ROT();
  }
  #undef CMASK
  #define CMASK(P0,P1,t) do{int jb_=(t)-(NT-4); if(jb_>=0)cmask(P0,P1,jb_,qrel,hi);}while(0)
  #define ENDW(tt) do{ if((tt)+3<NT){WAIT_BAR(3);} else if((tt)+2<NT){WAIT_BAR(2);} else {WAIT_BAR(0);} }while(0)
  for(;t+1<NT;t+=2){
    STEP(pB0,pB1,pA0,pA1,t,(t+3<NT),(t+1<NT),(t+1<NT));       ENDW(t);   RESC(); ROT();
    STEP(pA0,pA1,pB0,pB1,t+1,(t+4<NT),(t+2<NT),(t+2<NT));     ENDW(t+1); RESC(); ROT();
  }
  STEP(pB0,pB1,pA0,pA1,NT-1,false,false,false); RESC();
  { float sacc=pB0[0]+pB0[1]; _Pragma("unroll") for(int r=2;r<16;++r)sacc+=pB0[r]; _Pragma("unroll") for(int r=0;r<16;++r)sacc+=pB1[r]; l_reg+=sacc;
    pw0=(u32x4){PKW(pB0,0),PKW(pB0,2),PKW(pB0,4),PKW(pB0,6)};pw1=(u32x4){PKW(pB0,8),PKW(pB0,10),PKW(pB0,12),PKW(pB0,14)};pw2=(u32x4){PKW(pB1,0),PKW(pB1,2),PKW(pB1,4),PKW(pB1,6)};pw3=(u32x4){PKW(pB1,8),PKW(pB1,10),PKW(pB1,12),PKW(pB1,14)};
    SBAR(); pv(o,vb0+sl_cur,PAF(0),PAF(1),PAF(2),PAF(3)); pv(o2,vb0+(LDS_V2-LDS_V)+sl_cur,PAF(0),PAF(1),PAF(2),PAF(3)); }
  #undef PKW
  #undef PAF
  #undef VFR
  #undef PIN
  #undef MX3
  #undef GAPA
  #undef GAPB
  #undef EX
  #undef VRD
  #undef KRD
  #undef V2RD
  #undef STEP
  #undef ENDW
  {auto rr=__builtin_amdgcn_permlane32_swap(__float_as_uint(l_reg),__float_as_uint(l_reg),false,false);l_reg=__uint_as_float(rr[0])+__uint_as_float(rr[1]);}
  if(hi==0)wsf[32+r32]=l_reg;asm volatile("s_waitcnt lgkmcnt(0)":::"memory");
  float rli[16];
  #pragma unroll
  for(int r=0;r<16;++r)rli[r]=__builtin_amdgcn_rcpf(wsf[32+crow(r,hi)]);
  bf16*Ow=O+(rowbase+q0+wid*QBLK)*PO;
  { bf16*stg=(bf16*)(shm+LDS_OST)+wid*2048;
    if(cmap==0){
      #pragma unroll
      for(int hf=0;hf<2;++hf){
        #pragma unroll
        for(int r=0;r<16;++r){const int orow=crow(r,hi);
          #pragma unroll
          for(int d0=0;d0<2;++d0)stg[orow*64+d0*32+r32]=__float2bfloat16((hf?o2[d0][r]:o[d0][r])*rli[r]);}
        asm volatile("s_waitcnt lgkmcnt(0)":::"memory");
        #pragma unroll
        for(int i=0;i<4;++i){const int row=i*8+(lane>>3),ch=lane&7; const u32x4 v=*(const u32x4*)(stg+row*64+ch*8); ATTN_STORE16(Ow+(long)row*PO+hf*64+ch*8,v);}
        asm volatile("s_waitcnt lgkmcnt(0)":::"memory"); }
    } else {
      asm volatile("s_waitcnt vmcnt(0)":::"memory");
      float dd[2][4][8]; const int ch=lane&7;
      #pragma unroll
      for(int hf=0;hf<2;++hf){
        #pragma unroll
        for(int r=0;r<16;++r){const int orow=crow(r,hi);
          #pragma unroll
          for(int d0=0;d0<2;++d0)stg[orow*64+d0*32+r32]=__float2bfloat16((hf?o2[d0][r]:o[d0][r])*rli[r]);}
        asm volatile("s_waitcnt lgkmcnt(0)":::"memory");
        #pragma unroll
        for(int i=0;i<4;++i){const int row=i*8+(lane>>3); const u32x4 v1=*(const u32x4*)(stg+row*64+ch*8); const u32x4 v0=*(const u32x4*)(Ow+(long)row*PO+hf*64+ch*8);
          #pragma unroll
          for(int j=0;j<4;++j){ dd[hf][i][2*j]=__uint_as_float(v0[j]<<16)-lam*__uint_as_float(v1[j]<<16); dd[hf][i][2*j+1]=__uint_as_float(v0[j]&0xffff0000u)-lam*__uint_as_float(v1[j]&0xffff0000u); } }
        asm volatile("s_waitcnt lgkmcnt(0)":::"memory"); }
      float gg[2][8];
      #pragma unroll
      for(int hf=0;hf<2;++hf){ const float4 a=*(const float4*)(ng+hf*64+ch*8), c4=*(const float4*)(ng+hf*64+ch*8+4); gg[hf][0]=a.x;gg[hf][1]=a.y;gg[hf][2]=a.z;gg[hf][3]=a.w;gg[hf][4]=c4.x;gg[hf][5]=c4.y;gg[hf][6]=c4.z;gg[hf][7]=c4.w; }
      bf16*Mw=M+(rowbase+q0+wid*QBLK)*PO;
      #pragma unroll
      for(int i=0;i<4;++i){ float ss=0.f;
        #pragma unroll
        for(int hf=0;hf<2;++hf)
          #pragma unroll
          for(int j=0;j<8;++j)ss+=dd[hf][i][j]*dd[hf][i][j];
        ss+=__shfl_xor(ss,1);ss+=__shfl_xor(ss,2);ss+=__shfl_xor(ss,4);
        const float rr=osc/sqrtf(ss*(1.0f/128.0f)+1e-5f); const int row=i*8+(lane>>3);
        #pragma unroll
        for(int hf=0;hf<2;++hf){ u32x4 w;
          #pragma unroll
          for(int j=0;j<4;++j)w[j]=cvtpk_s(dd[hf][i][2*j]*rr*gg[hf][2*j],dd[hf][i][2*j+1]*rr*gg[hf][2*j+1]);
          ATTN_STORE16(Mw+(long)row*PO+hf*64+ch*8,w); } }
    } }
  asm volatile("s_waitcnt lgkmcnt(0)\n\ts_barrier":::"memory");
  #undef DMA_K
  #undef DMA_V
  #undef CMASK
  #undef START
  #undef RESC
  #undef ROT
}
constexpr int ATTN_LDS_BYTES=LDS_BYTES;
__device__ __forceinline__ void attn_phase(char*lds,const bf16*proj,bf16*O,bf16*M,const float*ng,float lam,float osc,int vcu){
  const int bh=vcu>>3, s=vcu&7, b=bh>>2, h=bh&3;
  const bf16*V=proj+1024+h*128; bf16*Oc=O+h*128; bf16*Mc=M+h*128;
  for(int i=0;i<2;++i){ const int qb=i?15-s:s;
    for(int c=0;c<2;++c) attn_unit<8>(b,qb,proj+h*128+c*64,proj+512+h*128+c*64,V,Oc,lds,c,lam,osc,ng,Mc); }
}
#undef SBAR
#undef WAIT_BAR
}
#define GAS __attribute__((address_space(1)))
#define LAS __attribute__((address_space(3)))
typedef unsigned short bf16;
typedef unsigned v4u __attribute__((ext_vector_type(4)));
typedef float f32x4 __attribute__((ext_vector_type(4)));
typedef short bf16x8 __attribute__((ext_vector_type(8)));
typedef GAS unsigned gu32;
typedef GAS unsigned long long gu64;
#define RLX_AGENT __ATOMIC_RELAXED, __HIP_MEMORY_SCOPE_AGENT
#define LDS_WAIT() asm volatile("s_waitcnt lgkmcnt(0)" ::: "memory")
#define VM_WAIT() asm volatile("s_waitcnt vmcnt(0)" ::: "memory")
__device__ __forceinline__ unsigned long long rt() { return __builtin_amdgcn_s_memrealtime(); }
__device__ __forceinline__ unsigned f2bf(float f) { unsigned u = __builtin_bit_cast(unsigned, f); return (u + 0x7fffu + ((u >> 16) & 1u)) >> 16; }
__device__ __forceinline__ unsigned pk2(float lo, float hi) { return f2bf(lo) | (f2bf(hi) << 16); }

#define XB_TMO      128
#define XB_XCNT(j)  (256  + 64 * (j))
#define XB_XSUB(j)  (1280 + 64 * (j))
#define XB_XGEN(j)  (2304 + 64 * (j))
#define XB_TOP      3328
#define XB_TOPGEN   3392
#define XCD_BAR_WORDS 3456
#define XB_SPIN_CAP (1u << 18)

__device__ __forceinline__ unsigned xb_ld(unsigned* p)              { return __hip_atomic_load(p, __ATOMIC_RELAXED, __HIP_MEMORY_SCOPE_AGENT); }
__device__ __forceinline__ unsigned xb_add(unsigned* p, unsigned v) { return __hip_atomic_fetch_add(p, v, __ATOMIC_RELAXED, __HIP_MEMORY_SCOPE_AGENT); }
__device__ __forceinline__ unsigned xb_xcc_id() { return (unsigned)__builtin_amdgcn_s_getreg((3 << 11) | 20) & 0xFu; }
#define XB_SPIN(cond, bar) do { unsigned _sp = 0; while (cond) { __builtin_amdgcn_s_sleep(1); \
    if ((++_sp & 255u) == 0u) { if (xb_ld(&(bar)[XB_TMO])) break; if (_sp > XB_SPIN_CAP) { atomicAdd(&(bar)[XB_TMO], 1u); break; } } } } while (0)

struct XcdBarrier {
    unsigned* bar; unsigned x;
    volatile LAS unsigned* st;
};

__device__ __forceinline__ XcdBarrier xcd_barrier_post(unsigned* bar, volatile LAS unsigned* st) {
    XcdBarrier b; b.bar = bar; b.x = xb_xcc_id(); b.st = st;
    if (threadIdx.x == 0) (void)xb_add(&bar[XB_XCNT(b.x)], 1u);
    return b;
}
__device__ __forceinline__ void xcd_barrier_complete(unsigned* bar, unsigned x, unsigned& nloc, unsigned& nx) {
    const unsigned G = gridDim.x * gridDim.y * gridDim.z;
    unsigned sum, cnt, mine, sp = 0u;
    for (;;) {
        sum = 0u; cnt = 0u; mine = 0u;
#pragma unroll
        for (unsigned j = 0; j < 16; ++j) { const unsigned c = xb_ld(&bar[XB_XCNT(j)]); sum += c; cnt += (c > 0u) ? 1u : 0u; mine = (j == x) ? c : mine; }
        if (sum == G) break;
        __builtin_amdgcn_s_sleep(1);
        if ((++sp & 255u) == 0u) { if (xb_ld(&bar[XB_TMO])) break; if (sp > XB_SPIN_CAP) { atomicAdd(&bar[XB_TMO], 1u); break; } }
    }
    nloc = mine > 0u ? mine : 1u; nx = cnt > 0u ? cnt : 1u;
}

__device__ __forceinline__ void xcd_barrier(const XcdBarrier& b) {
    asm volatile("s_waitcnt vmcnt(0)" ::: "memory");
    __syncthreads();
    if (threadIdx.x == 0) {
        unsigned* bar = b.bar;
        __builtin_amdgcn_s_waitcnt(0);
        unsigned nloc = b.st[0], nx = b.st[1];
        if (nloc == 0u) { xcd_barrier_complete(bar, b.x, nloc, nx); b.st[0] = nloc; b.st[1] = nx; }
        const unsigned old = xb_add(&bar[XB_XSUB(b.x)], 1u);
        const unsigned gen = old / nloc;
        if (old + 1u == (gen + 1u) * nloc) {
            __builtin_amdgcn_fence(__ATOMIC_RELEASE, "agent");
            asm volatile("s_waitcnt vmcnt(0)" ::: "memory");
            const unsigned og = xb_add(&bar[XB_TOP], 1u);
            const unsigned tg = og / nx;
            if (og + 1u == (tg + 1u) * nx) xb_add(&bar[XB_TOPGEN], 1u);
            else XB_SPIN(xb_ld(&bar[XB_TOPGEN]) == tg, bar);
            __builtin_amdgcn_fence(__ATOMIC_ACQUIRE, "agent");
            xb_add(&bar[XB_XGEN(b.x)], 1u);
            asm volatile("s_waitcnt vmcnt(0)" ::: "memory");
        } else {
            XB_SPIN(xb_ld(&bar[XB_XGEN(b.x)]) == gen, bar);
            __builtin_amdgcn_fence(__ATOMIC_ACQUIRE, "agent");
            asm volatile("s_waitcnt vmcnt(0)" ::: "memory");
        }
    }
    __syncthreads();
}
constexpr int NWAVES = 8, NTHREADS = NWAVES * 64;
constexpr int BATCH = 8, SEQ = 4096, NTOK = BATCH * SEQ, DMODEL = 1024, INW = 3080, NPROJ = 3072, DEPTH = 4;
constexpr int NEXP = 32, DFF = 1024, CHUNK = 64, NCH = SEQ / CHUNK, NBH = BATCH * 4;
constexpr int MAXRT = (NTOK * 4) / 256 + NEXP;
constexpr float DN_ALPHA = 1.681792830507429f, LN_EPS = 1e-5f, RMS_EPS = 1e-5f;
constexpr int NPH_LAYER = 10, NPHASES = 1 + DEPTH * NPH_LAYER;

constexpr size_t MiB = 1u << 20;
constexpr size_t WS_CTL = 0, CTL_ZERO_BYTES = 1 * MiB;
constexpr size_t WS_WIN = 2 * MiB;
#ifndef MK_SIDEJOB
#define MK_SIDEJOB 0
#endif
#ifndef MK_X1R8
#define MK_X1R8 1
#endif
constexpr float X1R_SCALE = 128.0f;
#ifndef MK_OUTFP8
#define MK_OUTFP8 0
#endif
constexpr float MQ_SCALE = 16.0f, MQ_ML = 2.0f;
constexpr size_t WS_WOUT = WS_WIN + 24 * MiB;
constexpr size_t WS_WGU = WS_WOUT + 8 * MiB;
constexpr size_t WS_WDN = WS_WGU + 512 * MiB;
constexpr size_t WS_XRES = WS_WDN + 256 * MiB;
constexpr size_t WS_X1 = WS_XRES + 128 * MiB;
constexpr size_t WS_XB = WS_X1 + 128 * MiB;
constexpr size_t WS_X1B = WS_XB + 64 * MiB;
constexpr size_t WS_PROJ = WS_X1B + 64 * MiB;
constexpr size_t WS_G = WS_PROJ + 192 * MiB;
constexpr size_t WS_ATTO = WS_G + 1 * MiB;
constexpr size_t WS_MIXIN = WS_ATTO + 64 * MiB;
constexpr size_t WS_MIXO = WS_MIXIN + 64 * MiB;
constexpr size_t WS_CST = WS_MIXO + 64 * MiB;
constexpr size_t WS_NST = WS_CST + 64 * MiB;
constexpr size_t WS_MISC = WS_NST + 1 * MiB;
constexpr size_t WS_WRP = WS_MISC + 512 * 1024;
constexpr size_t WS_TOKE = WS_MISC + 1 * MiB;
constexpr size_t WS_TOKP = WS_TOKE + 1 * MiB;
constexpr size_t WS_TOKG = WS_TOKP + 1 * MiB;
constexpr size_t WS_ROWTOK = WS_TOKG + 1 * MiB;
constexpr size_t WS_H = WS_ROWTOK + 4 * MiB;
constexpr size_t WS_Y = WS_H + 272 * MiB;
constexpr size_t WS_WINQ = WS_Y + 272 * MiB;
constexpr size_t WS_XQ = WS_WINQ + 8 * MiB;
constexpr size_t WS_END = WS_XQ + 32 * MiB;
static_assert((size_t)MAXRT * 256 * 1024 * 2 <= 272 * MiB, "H/Y size");
constexpr int CW_TMO = 0, CW_CODE = 1, CW_BAR = 4096, MAX_BAR_REGIONS = 48, CW_CNT = 200000;
static_assert(CW_BAR + MAX_BAR_REGIONS * 3456 <= CW_CNT && (CW_CNT + 64 * DEPTH) * 4 <= (int)CTL_ZERO_BYTES, "CTL map");
constexpr int RING_OFF = 0, RING_BYTES = 131072;
constexpr int LDSCTL_OFF = RING_BYTES;
constexpr int MISC_OFF = LDSCTL_OFF + 320;
constexpr int LDSX_OFF = LDSCTL_OFF + 512;
constexpr int LDS_BYTES = 163840;

typedef unsigned v2u __attribute__((ext_vector_type(2)));
__device__ __forceinline__ float bflo(unsigned w) { return __uint_as_float(w << 16); }
__device__ __forceinline__ float bfhi(unsigned w) { return __uint_as_float(w & 0xffff0000u); }
__device__ __forceinline__ void unpack8(const v4u w, float* o) { o[0] = bflo(w.x); o[1] = bfhi(w.x); o[2] = bflo(w.y); o[3] = bfhi(w.y); o[4] = bflo(w.z); o[5] = bfhi(w.z); o[6] = bflo(w.w); o[7] = bfhi(w.w); }
constexpr float XQ_SCALE = 8.0f, WQ_SCALE = 512.0f, HQ_SCALE = 8.0f, YQ_SCALE = 64.0f, XLO_SCALE = 4096.0f;
#ifndef MK_XLO
#define MK_XLO 0
#endif
constexpr bool USE_XLO = (MK_XLO != 0);
__device__ __forceinline__ v2u pack8_fp8(const float* o, float sc) { int a = 0, b = 0; a = __builtin_amdgcn_cvt_pk_fp8_f32(o[0] * sc, o[1] * sc, a, false); a = __builtin_amdgcn_cvt_pk_fp8_f32(o[2] * sc, o[3] * sc, a, true);
    b = __builtin_amdgcn_cvt_pk_fp8_f32(o[4] * sc, o[5] * sc, b, false); b = __builtin_amdgcn_cvt_pk_fp8_f32(o[6] * sc, o[7] * sc, b, true); return (v2u){(unsigned)a, (unsigned)b}; }
__device__ __forceinline__ v4u pack8(const float* o) { v4u w; w.x = pk2(o[0], o[1]); w.y = pk2(o[2], o[3]); w.z = pk2(o[4], o[5]); w.w = pk2(o[6], o[7]); return w; }
__device__ __forceinline__ float wave_sum(float v) {
#pragma unroll
    for (int o = 1; o < 64; o <<= 1) v += __shfl_xor(v, o);
    return v;
}
__device__ __forceinline__ float wave_max(float v) {
#pragma unroll
    for (int o = 1; o < 64; o <<= 1) v = fmaxf(v, __shfl_xor(v, o));
    return v;
}
__device__ __forceinline__ float sigmoid_f(float x) { return 1.0f / (1.0f + __expf(-x)); }

struct Ctx {
    LAS unsigned char* lds; int wave, vcu, G; unsigned char* ws; const float* const* in; float* out;
};
__device__ __forceinline__ int ltid() { int t = threadIdx.x; asm volatile("" : "+v"(t)); return t; }
enum { I_X = 0, I_WIN, I_CONVW, I_CONVB, I_GATEB, I_LQ1, I_LK1, I_LQ2, I_LK2, I_NG, I_WOUT, I_LN1G, I_LN1B, I_WR, I_BR, I_WGU, I_BGU, I_WDN, I_BDN, I_LN2G, I_LN2B };

__device__ __forceinline__ void load_row_f32(const float* row, int lane, float* v) {
    const f32x4* p = (const f32x4*)(row + 8 * lane); const f32x4 a = p[0], b = p[1]; const f32x4* q = (const f32x4*)(row + 512 + 8 * lane); const f32x4 c = q[0], d = q[1];
    v[0] = a.x; v[1] = a.y; v[2] = a.z; v[3] = a.w; v[4] = b.x; v[5] = b.y; v[6] = b.z; v[7] = b.w; v[8] = c.x; v[9] = c.y; v[10] = c.z; v[11] = c.w; v[12] = d.x; v[13] = d.y; v[14] = d.z; v[15] = d.w;
}
__device__ __forceinline__ void store_row_f32(float* row, int lane, const float* v) {
    f32x4* p = (f32x4*)(row + 8 * lane); p[0] = (f32x4){v[0], v[1], v[2], v[3]}; p[1] = (f32x4){v[4], v[5], v[6], v[7]};
    f32x4* q = (f32x4*)(row + 512 + 8 * lane); q[0] = (f32x4){v[8], v[9], v[10], v[11]}; q[1] = (f32x4){v[12], v[13], v[14], v[15]};
}
__device__ __forceinline__ void load_row_bf16(const bf16* row, int lane, float* v) {
    const v4u a = *(const v4u*)(row + 8 * lane), b = *(const v4u*)(row + 512 + 8 * lane); unpack8(a, v); unpack8(b, v + 8);
}
__device__ __forceinline__ void load_row_fp8(const unsigned char* row, int lane, float sc, float* v) {
    typedef float f32x2_ __attribute__((ext_vector_type(2)));
    const v2u a = *(const v2u*)(row + 8 * lane), b = *(const v2u*)(row + 512 + 8 * lane); const unsigned w[4] = {a.x, a.y, b.x, b.y};
#pragma unroll
    for (int i = 0; i < 4; ++i) { const f32x2_ lo = __builtin_amdgcn_cvt_pk_f32_fp8((int)w[i], false), hi = __builtin_amdgcn_cvt_pk_f32_fp8((int)w[i], true); v[4 * i] = lo.x * sc; v[4 * i + 1] = lo.y * sc; v[4 * i + 2] = hi.x * sc; v[4 * i + 3] = hi.y * sc; }
}
__device__ __forceinline__ void store_row_fp8(unsigned char* row, int lane, const float* v, float sc) {
    *(v2u*)(row + 8 * lane) = pack8_fp8(v, sc); *(v2u*)(row + 512 + 8 * lane) = pack8_fp8(v + 8, sc);
}
__device__ __forceinline__ void store_row_bf16(bf16* row, int lane, const float* v) {
    *(v4u*)(row + 8 * lane) = pack8(v); *(v4u*)(row + 512 + 8 * lane) = pack8(v + 8);
}
__device__ __forceinline__ void store_row_fp8_nt(unsigned char* row, int lane, const float* v, float sc) {
    __builtin_nontemporal_store(pack8_fp8(v, sc), (v2u*)(row + 8 * lane)); __builtin_nontemporal_store(pack8_fp8(v + 8, sc), (v2u*)(row + 512 + 8 * lane));
}
__device__ __forceinline__ void store_row_bf16_nt(bf16* row, int lane, const float* v) {
    __builtin_nontemporal_store(pack8(v), (v4u*)(row + 8 * lane)); __builtin_nontemporal_store(pack8(v + 8), (v4u*)(row + 512 + 8 * lane));
}
__device__ __forceinline__ void store_row_f32_nt(float* row, int lane, const float* v) {
    f32x4* p = (f32x4*)(row + 8 * lane); __builtin_nontemporal_store((f32x4){v[0], v[1], v[2], v[3]}, p); __builtin_nontemporal_store((f32x4){v[4], v[5], v[6], v[7]}, p + 1);
    f32x4* q = (f32x4*)(row + 512 + 8 * lane); __builtin_nontemporal_store((f32x4){v[8], v[9], v[10], v[11]}, q); __builtin_nontemporal_store((f32x4){v[12], v[13], v[14], v[15]}, q + 1);
}
__device__ __forceinline__ void ln_row(float* v, const float* g, const float* b) {
    float s = 0.f;
#pragma unroll
    for (int i = 0; i < 16; ++i) s += v[i];
    const float mean = wave_sum(s) * (1.0f / DMODEL); float q = 0.f;
#pragma unroll
    for (int i = 0; i < 16; ++i) { v[i] -= mean; q += v[i] * v[i]; }
    const float rstd = 1.0f / sqrtf(wave_sum(q) * (1.0f / DMODEL) + LN_EPS);
#pragma unroll
    for (int i = 0; i < 16; ++i) v[i] = v[i] * rstd * g[i] + b[i];
}
__device__ __forceinline__ void load_vec16(const float* p, int lane, float* v) { load_row_f32(p, lane, v); }

__device__ __forceinline__ void load_gate_w(int tid, const float* w_in_l, LAS f32x4* wgl) {
    for (int idx = tid; idx < 2048; idx += NTHREADS) { const int ln = idx & 63, hq = idx >> 6, half = hq & 1, q = hq >> 1; const int k = (q < 8) ? (8 * ln + q) : (512 + 8 * ln + q - 8);
        wgl[idx] = *(const f32x4*)(w_in_l + (size_t)k * INW + NPROJ + 4 * half); }
}
__device__ __forceinline__ void gates_row(const float* v, const LAS f32x4* wgl, const float* gate_b, float* Grow, int lane) {
    float p[8] = {0.f, 0.f, 0.f, 0.f, 0.f, 0.f, 0.f, 0.f};
#pragma unroll
    for (int q = 0; q < 16; ++q) { const f32x4 w0 = wgl[(q * 2 + 0) * 64 + lane], w1 = wgl[(q * 2 + 1) * 64 + lane];
        p[0] += v[q] * w0.x; p[1] += v[q] * w0.y; p[2] += v[q] * w0.z; p[3] += v[q] * w0.w; p[4] += v[q] * w1.x; p[5] += v[q] * w1.y; p[6] += v[q] * w1.z; p[7] += v[q] * w1.w; }
    const bool b5 = (lane >> 5) & 1, b4 = (lane >> 4) & 1, b3 = (lane >> 3) & 1;
    float r4[4];
#pragma unroll
    for (int i = 0; i < 4; ++i) { const float keep = b5 ? p[4 + i] : p[i], send = b5 ? p[i] : p[4 + i]; r4[i] = keep + __shfl_xor(send, 32); }
    float r2[2];
#pragma unroll
    for (int i = 0; i < 2; ++i) { const float keep = b4 ? r4[2 + i] : r4[i], send = b4 ? r4[i] : r4[2 + i]; r2[i] = keep + __shfl_xor(send, 16); }
    float r1; { const float keep = b3 ? r2[1] : r2[0], send = b3 ? r2[0] : r2[1]; r1 = keep + __shfl_xor(send, 8); }
    r1 += __shfl_xor(r1, 4); r1 += __shfl_xor(r1, 2); r1 += __shfl_xor(r1, 1);
    if ((lane & 7) == 0) { const int gi = (lane >> 3); Grow[gi] = r1 + gate_b[gi]; }
}
struct TrItem { const float* src; unsigned char* dst; int ldw, Kd, fp8; float sc; };
__device__ __forceinline__ void tr_fetch(const TrItem& a, float* ra, int lane) {
    const int kk0 = lane >> 5, nn = lane & 31;
#pragma unroll
    for (int i = 0; i < 64; ++i) ra[i] = a.src[(size_t)(2 * i + kk0) * a.ldw + nn];
}
__device__ __forceinline__ void tr_put(const float* ra, LAS float* scr, int lane) {
    const int kk0 = lane >> 5, nn = lane & 31;
#pragma unroll
    for (int i = 0; i < 64; ++i) scr[(2 * i + kk0) * 33 + nn] = ra[i];
}
__device__ __forceinline__ void tr_store(const TrItem& it, const LAS float* scr, int lane) {
    const int c = lane & 7;
#pragma unroll
    for (int j = 0; j < 4; ++j) { const int n = (lane >> 3) + 8 * j; const LAS float* s = scr + (16 * c) * 33 + n; float o[16];
#pragma unroll
        for (int i = 0; i < 16; ++i) o[i] = s[i * 33];
        if (it.fp8) { const v2u p = pack8_fp8(o, it.sc), q = pack8_fp8(o + 8, it.sc); *(GAS v4u*)(it.dst + (size_t)n * it.Kd + 16 * c) = (v4u){p.x, p.y, q.x, q.y}; }
        else { GAS v4u* d = (GAS v4u*)(it.dst + ((size_t)n * it.Kd + 16 * c) * 2); d[0] = pack8(o); d[1] = pack8(o + 8); } }
}
constexpr int TR_I_IN = DEPTH * 8 * 96, TR_I_OUT = DEPTH * 8 * 32, TR_I_GU = DEPTH * NEXP * 8 * 64, TR_I_DN = DEPTH * NEXP * 8 * 32, TR_ITEMS = TR_I_IN + TR_I_OUT + TR_I_GU + TR_I_DN;
__device__ __forceinline__ TrItem tr_decode(const Ctx& C, int r) {
    TrItem it;
    if (r < TR_I_GU) { const int m = r / 512, q = r % 512, kb = q / 64, nb = q % 64, n0 = 32 * nb;
        const int nn = (n0 < 1024) ? n0 : n0 - 1024; const int drow = 256 * (nn / 128) + (nn % 128) + ((n0 < 1024) ? 0 : 128);
        it.src = C.in[I_WGU] + (size_t)m * DMODEL * 2 * DFF + (size_t)(128 * kb) * (2 * DFF) + n0; it.ldw = 2 * DFF; it.Kd = DMODEL; it.fp8 = 1; it.sc = WQ_SCALE;
        it.dst = C.ws + WS_WGU + (size_t)m * 2 * DFF * DMODEL + (size_t)drow * DMODEL + 128 * kb; return it; }
    r -= TR_I_GU;
    if (r < TR_I_DN) { const int m = r / 256, q = r % 256, kb = q / 32, nb = q % 32;
        it.src = C.in[I_WDN] + (size_t)m * DFF * DMODEL + (size_t)(128 * kb) * DMODEL + 32 * nb; it.ldw = DMODEL; it.Kd = DFF; it.fp8 = 1; it.sc = WQ_SCALE;
        it.dst = C.ws + WS_WDN + (size_t)m * DMODEL * DFF + (size_t)(32 * nb) * DFF + 128 * kb; return it; }
    r -= TR_I_DN;
    if (r < TR_I_IN) { const int l = r / 768, q = r % 768, kb = q / 96, nb = q % 96, n0 = 32 * nb, tile = n0 >> 8;
        const bool q8 = (tile >= 8); const int rank = q8 ? tile - 8 : tile; const int drow = rank * 256 + (n0 & 255);
        it.src = C.in[I_WIN] + (size_t)l * DMODEL * INW + (size_t)(128 * kb) * INW + n0; it.ldw = INW; it.Kd = DMODEL; it.fp8 = q8 ? 1 : 0; it.sc = q8 ? WQ_SCALE : 1.f;
        it.dst = q8 ? C.ws + WS_WINQ + (size_t)l * 1536 * DMODEL + (size_t)drow * DMODEL + 128 * kb : C.ws + WS_WIN + ((size_t)l * NPROJ * DMODEL + (size_t)drow * DMODEL + 128 * kb) * 2; return it; }
    r -= TR_I_IN;
    { const int l = r / 256, q = r % 256, kb = q / 32, nb = q % 32;
        it.src = C.in[I_WOUT] + (size_t)l * DMODEL * DMODEL + (size_t)(128 * kb) * DMODEL + 32 * nb; it.ldw = DMODEL; it.Kd = DMODEL; it.fp8 = MK_OUTFP8; it.sc = MK_OUTFP8 ? ((kb >= 4) ? WQ_SCALE * (MQ_SCALE / MQ_ML) : WQ_SCALE) : 1.f;
        it.dst = C.ws + WS_WOUT + ((size_t)l * DMODEL * DMODEL + (size_t)(32 * nb) * DMODEL + 128 * kb) * (MK_OUTFP8 ? 1 : 2); return it; }
}
#ifndef MK_TRQ_RUNS
#define MK_TRQ_RUNS 0
#endif
constexpr int TR_L_GU = NEXP * 8 * 64, TR_L_DN = NEXP * 8 * 32, TR_L = TR_L_GU + TR_L_DN, TR_P_ITEMS = TR_L + TR_I_IN + TR_I_OUT, TRQ_LAYERS = DEPTH - 1;
__device__ __forceinline__ int trq_per(const Ctx& C) { return (TR_L + C.G - 1) / C.G; }
__device__ __forceinline__ int trq_item(const Ctx& C, int q) {
    const int per = trq_per(C), l = 1 + q / per, i = MK_TRQ_RUNS ? (C.vcu * per + q % per) : ((q % per) * C.G + C.vcu); if (i >= TR_L) return -1;
    return (i < TR_L_GU) ? l * TR_L_GU + i : TR_I_GU + l * TR_L_DN + (i - TR_L_GU); }
__device__ __forceinline__ int trp_item(int p) { return (p < TR_L_GU) ? p : (p < TR_L) ? TR_I_GU + (p - TR_L_GU) : TR_I_GU + TR_I_DN + (p - TR_L); }
__device__ __forceinline__ void tr_one(const Ctx& C, int r, LAS float* scr, int lane) {
    float ra[64]; const TrItem it = tr_decode(C, r); tr_fetch(it, ra, lane); tr_put(ra, scr, lane); LDS_WAIT(); asm volatile("" ::: "memory"); tr_store(it, scr, lane); LDS_WAIT(); asm volatile("" ::: "memory");
}
__device__ __forceinline__ int trq_grab(const Ctx& C, int lane) { unsigned v = 0u; if (lane == 0) v = __hip_atomic_fetch_add((LAS unsigned*)(C.lds + MISC_OFF) + 11, 1u, __ATOMIC_RELAXED, __HIP_MEMORY_SCOPE_WORKGROUP); return (int)__builtin_amdgcn_readfirstlane(v); }
__device__ __forceinline__ void trq_drain(const Ctx& C, int l) {
    const int lane = ltid() & 63, per = trq_per(C), endq = l * per, total = TRQ_LAYERS * per;
    LAS float* scr = (LAS float*)(C.lds + (C.wave < 7 ? RING_OFF + C.wave * 16896 : LDSX_OFF));
    for (;;) { const int q = trq_grab(C, lane); if (q >= total) break; const int r = trq_item(C, q); if (r >= 0) tr_one(C, r, scr, lane); if (q >= endq) break; }
    __syncthreads();
}
__device__ __forceinline__ void p_prologue(const Ctx& C) {
    const int tid = ltid(), lane = tid & 63;
    const int gw = C.vcu * NWAVES + C.wave, NGW = C.G * NWAVES;
    LAS float* scr = (LAS float*)(C.lds + (C.wave < 7 ? RING_OFF + C.wave * 16896 : LDSX_OFF));
    float ra[64]; TrItem cur = tr_decode(C, trp_item(gw < TR_P_ITEMS ? gw : 0));
    if (gw < TR_P_ITEMS) tr_fetch(cur, ra, lane);
    for (int it = gw; it < TR_P_ITEMS; it += NGW) {
        tr_put(ra, scr, lane);
        const bool more = (it + NGW < TR_P_ITEMS); const TrItem nxt = tr_decode(C, trp_item(more ? it + NGW : it));
        if (more) tr_fetch(nxt, ra, lane);
        LDS_WAIT(); asm volatile("" ::: "memory");
        tr_store(cur, scr, lane);
        LDS_WAIT(); asm volatile("" ::: "memory");
        cur = nxt;
    }
    { f32x4* WRP = (f32x4*)(C.ws + WS_WRP); const int gt = (C.vcu * NWAVES + C.wave) * 64 + lane, NGT = C.G * NTHREADS;
        for (int i = gt; i < DEPTH * 8192; i += NGT) { const int l = i >> 13, idx = i & 8191, ln = idx & 63, q4 = (idx >> 6) & 3, e = idx >> 8; const int k = (q4 < 2) ? (8 * ln + 4 * q4) : (512 + 8 * ln + 4 * (q4 - 2));
            const float* wr = C.in[I_WR] + (size_t)l * DMODEL * NEXP; WRP[i] = (f32x4){wr[(size_t)k * NEXP + e], wr[(size_t)(k + 1) * NEXP + e], wr[(size_t)(k + 2) * NEXP + e], wr[(size_t)(k + 3) * NEXP + e]}; } }
    __syncthreads();
    LAS f32x4* wgl = (LAS f32x4*)(C.lds + RING_OFF);
    load_gate_w(tid, C.in[I_WIN], wgl);
    __syncthreads();
    bf16* XB = (bf16*)(C.ws + WS_XB); float* G = (float*)(C.ws + WS_G);
    unsigned char* XLO = (unsigned char*)(C.ws + WS_XRES);
    for (int n = gw; n < NTOK; n += NGW) { float v[16], lo_[16]; load_row_f32(C.in[I_X] + (size_t)n * DMODEL, lane, v); store_row_bf16(XB + (size_t)n * DMODEL, lane, v);
#pragma unroll
        for (int i = 0; i < 16; ++i) lo_[i] = v[i] - __uint_as_float(f2bf(v[i]) << 16);
        if (USE_XLO) store_row_fp8(XLO + (size_t)n * DMODEL, lane, lo_, XLO_SCALE);
        store_row_fp8((unsigned char*)(C.ws + WS_XQ) + (size_t)n * DMODEL, lane, v, XQ_SCALE);
        gates_row(v, wgl, C.in[I_GATEB], G + (size_t)n * 8, lane); }
    __syncthreads();
}

__device__ __forceinline__ void conv_silu8(const bf16* proj, int n, int t, int col, const float* cw, const float* cb, float scale, float* y) {
    const f32x4 b0 = *(const f32x4*)cb, b1 = *(const f32x4*)(cb + 4);
    y[0] = b0.x; y[1] = b0.y; y[2] = b0.z; y[3] = b0.w; y[4] = b1.x; y[5] = b1.y; y[6] = b1.z; y[7] = b1.w;
#pragma unroll
    for (int j = 0; j < 4; ++j) { const int tt = t - 3 + j;
        if (tt >= 0) { const v4u w = *(const v4u*)(proj + (size_t)(n - 3 + j) * NPROJ + col); float x[8]; unpack8(w, x);
            const f32x4 c0 = *(const f32x4*)(cw + j * 512), c1 = *(const f32x4*)(cw + j * 512 + 4);
            y[0] += c0.x * x[0]; y[1] += c0.y * x[1]; y[2] += c0.z * x[2]; y[3] += c0.w * x[3]; y[4] += c1.x * x[4]; y[5] += c1.y * x[5]; y[6] += c1.z * x[6]; y[7] += c1.w * x[7]; } }
#pragma unroll
    for (int i = 0; i < 8; ++i) y[i] = y[i] * sigmoid_f(y[i]) * scale;
}
constexpr int KP = 68;

__device__ __forceinline__ void p_mlstm_states(const Ctx& C, int l) {
    const bf16* proj = (const bf16*)(C.ws + WS_PROJ); const float* G = (const float*)(C.ws + WS_G);
    float* CST = (float*)(C.ws + WS_CST); float* NST = (float*)(C.ws + WS_NST); float* MLOC = (float*)(C.ws + WS_MISC); float* GCH = MLOC + 2048;
    const float* cw = C.in[I_CONVW] + (size_t)l * 4 * 512; const float* cb = C.in[I_CONVB] + (size_t)l * 512;
    LAS float* kf = (LAS float*)(C.lds + RING_OFF);
    LAS float* vf = kf + 64 * 64;
    LAS float* ev = vf + 64 * 128;
    const int tid = ltid(), lane = tid & 63;
    for (int u = C.vcu; u < NBH * NCH; u += C.G) {
        const int bh = u / NCH, c = u % NCH, b = bh >> 2, h = bh & 3; const int n0 = b * SEQ + c * CHUNK;
        { const int s = tid >> 3, cg = tid & 7; float y[8]; conv_silu8(proj, n0 + s, c * CHUNK + s, 1536 + 256 + h * 64 + cg * 8, cw + 256 + h * 64 + cg * 8, cb + 256 + h * 64 + cg * 8, 1.0f, y);
#pragma unroll
            for (int i = 0; i < 8; ++i) kf[s * 64 + cg * 8 + i] = y[i];
            const bf16* vp = proj + (size_t)(n0 + s) * NPROJ + 2048 + h * 128 + cg * 16; float x[16]; unpack8(*(const v4u*)vp, x); unpack8(*(const v4u*)(vp + 8), x + 8);
#pragma unroll
            for (int i = 0; i < 16; ++i) vf[s * 128 + cg * 16 + i] = x[i]; }
        if (C.wave == 0) { const float ig = G[(size_t)(n0 + lane) * 8 + h], fg = G[(size_t)(n0 + lane) * 8 + 4 + h];
            float bc = fminf(fg, 0.f) - log1pf(expf(-fabsf(fg)));
#pragma unroll
            for (int o = 1; o < 64; o <<= 1) { const float t = __shfl_up(bc, o); if (lane >= o) bc += t; }
            const float g = __shfl(bc, 63); const float w = g - bc + ig; const float m = wave_max(w);
            ev[lane] = __expf(w - m); if (lane == 0) { MLOC[u] = m; GCH[u] = g; } }
        __syncthreads();
        { const int v = tid & 127, kg = tid >> 7; float acc[16];
#pragma unroll
            for (int i = 0; i < 16; ++i) acc[i] = 0.f;
            for (int s = 0; s < 64; ++s) { const float a = ev[s] * vf[s * 128 + v];
#pragma unroll
                for (int i4 = 0; i4 < 4; ++i4) { const f32x4 k4 = *(const LAS f32x4*)(kf + s * 64 + kg * 16 + i4 * 4); acc[i4 * 4 + 0] += a * k4.x; acc[i4 * 4 + 1] += a * k4.y; acc[i4 * 4 + 2] += a * k4.z; acc[i4 * 4 + 3] += a * k4.w; } }
            float* dst = CST + (size_t)u * 8192 + v;
#pragma unroll
            for (int i = 0; i < 16; ++i) dst[(kg * 16 + i) * 128] = acc[i]; }
        if (tid < 64) { float a = 0.f; for (int s = 0; s < 64; ++s) a += ev[s] * kf[s * 64 + tid]; NST[(size_t)u * 64 + tid] = a; }
        __syncthreads();
    }
}

__device__ __forceinline__ void p_mlstm_scan(const Ctx& C) {
    v2u* CST = (v2u*)(C.ws + WS_CST); f32x4* NST = (f32x4*)(C.ws + WS_NST); const float* MLOC = (const float*)(C.ws + WS_MISC); const float* GCH = MLOC + 2048; float* MPREV = (float*)(C.ws + WS_MISC) + 4096;
    const int nthr = C.G * NTHREADS, gid = C.vcu * NTHREADS + ltid();
    for (int it = gid; it < NBH * 2064; it += nthr) {
        const int bh = it / 2064, r = it % 2064;
        if (r < 2048) {
            v2u* p = CST + (size_t)bh * NCH * 2048 + r; float carry[4] = {0.f, 0.f, 0.f, 0.f}; float m = -INFINITY;
            for (int c0 = 0; c0 < NCH; c0 += 16) {
                v2u loc[16]; float gg[16], ml[16];
#pragma unroll
                for (int j = 0; j < 16; ++j) { loc[j] = p[(size_t)(c0 + j) * 2048]; gg[j] = GCH[bh * NCH + c0 + j]; ml[j] = MLOC[bh * NCH + c0 + j]; }
#pragma unroll
                for (int j = 0; j < 16; ++j) { p[(size_t)(c0 + j) * 2048] = (v2u){pk2(carry[0], carry[1]), pk2(carry[2], carry[3])}; if (r == 0) MPREV[bh * NCH + c0 + j] = m;
                    const float mn = fmaxf(gg[j] + m, ml[j]); const float a = __expf(gg[j] + m - mn), bb = __expf(ml[j] - mn);
                    carry[0] = carry[0] * a + bflo(loc[j].x) * bb; carry[1] = carry[1] * a + bfhi(loc[j].x) * bb; carry[2] = carry[2] * a + bflo(loc[j].y) * bb; carry[3] = carry[3] * a + bfhi(loc[j].y) * bb;
                    m = mn; }
            }
        } else {
            f32x4* p = NST + (size_t)bh * NCH * 16 + (r - 2048); f32x4 carry = (f32x4){0.f, 0.f, 0.f, 0.f}; float m = -INFINITY;
            for (int c0 = 0; c0 < NCH; c0 += 8) {
                f32x4 loc[8]; float gg[8], ml[8];
#pragma unroll
                for (int j = 0; j < 8; ++j) { loc[j] = p[(size_t)(c0 + j) * 16]; gg[j] = GCH[bh * NCH + c0 + j]; ml[j] = MLOC[bh * NCH + c0 + j]; }
#pragma unroll
                for (int j = 0; j < 8; ++j) { p[(size_t)(c0 + j) * 16] = carry;
                    const float mn = fmaxf(gg[j] + m, ml[j]); const float a = __expf(gg[j] + m - mn), bb = __expf(ml[j] - mn);
                    carry = carry * a + loc[j] * bb; m = mn; }
            }
        }
    }
}

__device__ __forceinline__ void p_mlstm_out(const Ctx& C, int l) {
    const bf16* proj = (const bf16*)(C.ws + WS_PROJ); const float* G = (const float*)(C.ws + WS_G);
    const float* CST = (const float*)(C.ws + WS_CST); const float* NST = (const float*)(C.ws + WS_NST); const float* MPREV = (const float*)(C.ws + WS_MISC) + 4096;
    bf16* MIXIN = (bf16*)(C.ws + WS_MIXIN);
    const float* cw = C.in[I_CONVW] + (size_t)l * 4 * 512; const float* cb = C.in[I_CONVB] + (size_t)l * 512;
    LAS float* qf = (LAS float*)(C.lds + RING_OFF);
    LAS float* kf = qf + 64 * KP;
    LAS float* Sm = kf + 64 * KP;
    LAS float* vf = Sm + 64 * KP;
    LAS float* Ct = vf + 64 * 128;
    LAS float* sv = Ct + 64 * 128;
    static_assert((3 * 64 * KP + 2 * 64 * 128 + 6 * 64) * 4 <= RING_BYTES, "mLSTM LDS");
    const int tid = ltid(), lane = tid & 63;
    for (int u = C.vcu; u < NBH * NCH; u += C.G) {
        const int bh = u / NCH, c = u % NCH, b = bh >> 2, h = bh & 3; const int n0 = b * SEQ + c * CHUNK;
        { const int s = tid >> 3, cg = tid & 7; float y[8];
            conv_silu8(proj, n0 + s, c * CHUNK + s, 1536 + h * 64 + cg * 8, cw + h * 64 + cg * 8, cb + h * 64 + cg * 8, 0.125f, y);
#pragma unroll
            for (int i = 0; i < 8; ++i) qf[s * KP + cg * 8 + i] = y[i];
            conv_silu8(proj, n0 + s, c * CHUNK + s, 1536 + 256 + h * 64 + cg * 8, cw + 256 + h * 64 + cg * 8, cb + 256 + h * 64 + cg * 8, 1.0f, y);
#pragma unroll
            for (int i = 0; i < 8; ++i) kf[s * KP + cg * 8 + i] = y[i];
            const bf16* vp = proj + (size_t)(n0 + s) * NPROJ + 2048 + h * 128 + cg * 16; float x[16]; unpack8(*(const v4u*)vp, x); unpack8(*(const v4u*)(vp + 8), x + 8);
#pragma unroll
            for (int i = 0; i < 16; ++i) vf[s * 128 + cg * 16 + i] = x[i];
            const f32x4* cp = (const f32x4*)(CST + (size_t)u * 8192);
#pragma unroll
            for (int i = 0; i < 4; ++i) *(LAS f32x4*)(Ct + (tid + NTHREADS * i) * 4) = cp[tid + NTHREADS * i]; }
        if (C.wave == 0) { const float ig = G[(size_t)(n0 + lane) * 8 + h], fg = G[(size_t)(n0 + lane) * 8 + 4 + h]; const float mp = MPREV[u];
            float bc = fminf(fg, 0.f) - log1pf(expf(-fabsf(fg)));
#pragma unroll
            for (int o = 1; o < 64; o <<= 1) { const float t = __shfl_up(bc, o); if (lane >= o) bc += t; }
            const float a = ig - bc; float pm = a;
#pragma unroll
            for (int o = 1; o < 64; o <<= 1) { const float t = __shfl_up(pm, o); if (lane >= o) pm = fmaxf(pm, t); }
            const float mt = bc + fmaxf(mp, pm);
            sv[lane] = bc; sv[64 + lane] = a; sv[128 + lane] = mt; sv[192 + lane] = __expf(bc + mp - mt); sv[320 + lane] = NST[(size_t)u * 64 + lane]; }
        __syncthreads();
        {
            const int t = tid >> 3, sg = tid & 7; float qr[64];
#pragma unroll
            for (int i = 0; i < 16; ++i) { const f32x4 q4 = *(const LAS f32x4*)(qf + t * KP + 4 * i); qr[4 * i] = q4.x; qr[4 * i + 1] = q4.y; qr[4 * i + 2] = q4.z; qr[4 * i + 3] = q4.w; }
            const float bt = sv[t] - sv[128 + t]; float dsum = 0.f;
#pragma unroll 2
            for (int j = 0; j < 8; ++j) { const int s = sg + 8 * j; float d = 0.f;
#pragma unroll
                for (int i = 0; i < 16; ++i) { const f32x4 k4 = *(const LAS f32x4*)(kf + s * KP + 4 * i); d += qr[4 * i] * k4.x + qr[4 * i + 1] * k4.y + qr[4 * i + 2] * k4.z + qr[4 * i + 3] * k4.w; }
                const float sc = (s <= t) ? d * __expf(sv[64 + s] + bt) : 0.f; Sm[t * KP + s] = sc; dsum += sc; }
            float nq = 0.f;
#pragma unroll
            for (int i = 0; i < 8; ++i) nq += qf[t * KP + sg * 8 + i] * sv[320 + sg * 8 + i];
            dsum += sv[192 + t] * nq;
            dsum += __shfl_xor(dsum, 1); dsum += __shfl_xor(dsum, 2); dsum += __shfl_xor(dsum, 4);
            if (sg == 0) sv[256 + t] = 1.0f / fmaxf(fabsf(dsum), __expf(-sv[128 + t])); }
        __syncthreads();
        {
            const int t = tid >> 3, vg = tid & 7; float acc[16];
#pragma unroll
            for (int i = 0; i < 16; ++i) acc[i] = 0.f;
            const float iw = sv[192 + t];
            for (int k = 0; k < 64; ++k) { const float a = qf[t * KP + k] * iw;
#pragma unroll
                for (int i4 = 0; i4 < 4; ++i4) { const f32x4 c4 = *(const LAS f32x4*)(Ct + k * 128 + vg * 16 + i4 * 4); acc[i4 * 4] += a * c4.x; acc[i4 * 4 + 1] += a * c4.y; acc[i4 * 4 + 2] += a * c4.z; acc[i4 * 4 + 3] += a * c4.w; } }
            for (int s = 0; s < 64; ++s) { const float a = Sm[t * KP + s];
#pragma unroll
                for (int i4 = 0; i4 < 4; ++i4) { const f32x4 v4 = *(const LAS f32x4*)(vf + s * 128 + vg * 16 + i4 * 4); acc[i4 * 4] += a * v4.x; acc[i4 * 4 + 1] += a * v4.y; acc[i4 * 4 + 2] += a * v4.z; acc[i4 * 4 + 3] += a * v4.w; } }
            const float dn = sv[256 + t];
            const bf16* op = proj + (size_t)(n0 + t) * NPROJ + 2560 + h * 128 + vg * 16; float o[16]; unpack8(*(const v4u*)op, o); unpack8(*(const v4u*)(op + 8), o + 8);
#pragma unroll
            for (int i = 0; i < 16; ++i) o[i] = acc[i] * dn * sigmoid_f(o[i]);
            bf16* dst = MIXIN + (size_t)(n0 + t) * DMODEL + 512 + h * 128 + vg * 16; *(v4u*)dst = pack8(o); *(v4u*)(dst + 8) = pack8(o + 8); }
        __syncthreads();
    }
}

__device__ __forceinline__ void p_da_combine(const Ctx& C, int l, float lam_init) {
    const bf16* ATTO = (const bf16*)(C.ws + WS_ATTO); bf16* MIXIN = (bf16*)(C.ws + WS_MIXIN);
    const int lane = ltid() & 63, gw = C.vcu * NWAVES + C.wave, NGW = C.G * NWAVES;
    const float s1 = wave_sum(C.in[I_LQ1][l * 64 + lane] * C.in[I_LK1][l * 64 + lane]), s2 = wave_sum(C.in[I_LQ2][l * 64 + lane] * C.in[I_LK2][l * 64 + lane]);
    const float lam = expf(s1) - expf(s2) + lam_init, osc = 1.0f - lam_init;
    const int h = lane >> 4, e8 = (lane & 15) * 8;
    float g[8]; { const f32x4 a = *(const f32x4*)(C.in[I_NG] + l * 128 + e8), b2 = *(const f32x4*)(C.in[I_NG] + l * 128 + e8 + 4); g[0] = a.x; g[1] = a.y; g[2] = a.z; g[3] = a.w; g[4] = b2.x; g[5] = b2.y; g[6] = b2.z; g[7] = b2.w; }
    for (int n = gw; n < NTOK; n += NGW) {
        float o0[8], o1[8]; unpack8(*(const v4u*)(ATTO + (size_t)n * DMODEL + h * 256 + e8), o0); unpack8(*(const v4u*)(ATTO + (size_t)n * DMODEL + h * 256 + 128 + e8), o1);
        float ss = 0.f;
#pragma unroll
        for (int i = 0; i < 8; ++i) { o0[i] -= lam * o1[i]; ss += o0[i] * o0[i]; }
        ss += __shfl_xor(ss, 1); ss += __shfl_xor(ss, 2); ss += __shfl_xor(ss, 4); ss += __shfl_xor(ss, 8);
        const float r = 1.0f / sqrtf(ss * (1.0f / 128.0f) + RMS_EPS) * osc;
#pragma unroll
        for (int i = 0; i < 8; ++i) o0[i] = o0[i] * r * g[i];
        *(v4u*)(MIXIN + (size_t)n * DMODEL + h * 128 + e8) = pack8(o0);
    }
}
typedef float f32x16 __attribute__((ext_vector_type(16)));
constexpr int TP = 72;
#define MFMA32(a, b, c) __builtin_amdgcn_mfma_f32_32x32x16_bf16((a), (b), (c), 0, 0, 0)
__device__ __forceinline__ bf16x8 frag_ld(const LAS bf16* tile, int row, int step, int h) { return *(const LAS bf16x8*)(tile + row * TP + step * 16 + 8 * h); }
__device__ __forceinline__ void tr_store16(LAS bf16* tile, int c0, int s, const v4u a, const v4u b) {
    const unsigned w[8] = {a.x, a.y, a.z, a.w, b.x, b.y, b.z, b.w};
#pragma unroll
    for (int i = 0; i < 8; ++i) { tile[(c0 + 2 * i) * TP + s] = (bf16)(w[i] & 0xffffu); tile[(c0 + 2 * i + 1) * TP + s] = (bf16)(w[i] >> 16); }
}

__device__ __forceinline__ void conv_fetch(const bf16* proj, int n, int t, int col, v4u* raw) {
#pragma unroll
    for (int j = 0; j < 4; ++j) { const int tt = t - 3 + j; raw[j] = (tt >= 0) ? *(const v4u*)(proj + (size_t)(n - 3 + j) * NPROJ + col) : (v4u){0u, 0u, 0u, 0u}; }
}
__device__ __forceinline__ void conv_stage(LAS float* cwl, const float* cw, const float* cb, int ch0, int tid) {
    if (tid < 320) cwl[tid] = (tid < 256) ? cw[(tid >> 6) * 512 + ch0 + (tid & 63)] : cb[ch0 + (tid - 256)];
}
__device__ __forceinline__ void conv_apply_l(const v4u* raw, const LAS float* cwl, int c0, float scale, float* y) {
    const f32x4 b0 = *(const LAS f32x4*)(cwl + 256 + c0), b1 = *(const LAS f32x4*)(cwl + 256 + c0 + 4);
    y[0] = b0.x; y[1] = b0.y; y[2] = b0.z; y[3] = b0.w; y[4] = b1.x; y[5] = b1.y; y[6] = b1.z; y[7] = b1.w;
#pragma unroll
    for (int j = 0; j < 4; ++j) { float x[8]; unpack8(raw[j], x);
        const f32x4 c0_ = *(const LAS f32x4*)(cwl + j * 64 + c0), c1_ = *(const LAS f32x4*)(cwl + j * 64 + c0 + 4);
        y[0] += c0_.x * x[0]; y[1] += c0_.y * x[1]; y[2] += c0_.z * x[2]; y[3] += c0_.w * x[3]; y[4] += c1_.x * x[4]; y[5] += c1_.y * x[5]; y[6] += c1_.z * x[6]; y[7] += c1_.w * x[7]; }
#pragma unroll
    for (int i = 0; i < 8; ++i) y[i] = y[i] * sigmoid_f(y[i]) * scale;
}
__device__ __forceinline__ void conv_apply(const v4u* raw, const float* cw, const float* cb, float scale, float* y) {
    const f32x4 b0 = *(const f32x4*)cb, b1 = *(const f32x4*)(cb + 4);
    y[0] = b0.x; y[1] = b0.y; y[2] = b0.z; y[3] = b0.w; y[4] = b1.x; y[5] = b1.y; y[6] = b1.z; y[7] = b1.w;
#pragma unroll
    for (int j = 0; j < 4; ++j) { float x[8]; unpack8(raw[j], x);
        const f32x4 c0 = *(const f32x4*)(cw + j * 512), c1 = *(const f32x4*)(cw + j * 512 + 4);
        y[0] += c0.x * x[0]; y[1] += c0.y * x[1]; y[2] += c0.z * x[2]; y[3] += c0.w * x[3]; y[4] += c1.x * x[4]; y[5] += c1.y * x[5]; y[6] += c1.z * x[6]; y[7] += c1.w * x[7]; }
#pragma unroll
    for (int i = 0; i < 8; ++i) y[i] = y[i] * sigmoid_f(y[i]) * scale;
}

__device__ __forceinline__ void p_mlstm_states_mfma(const Ctx& C, int l) {
    const bf16* proj = (const bf16*)(C.ws + WS_PROJ); const float* G = (const float*)(C.ws + WS_G);
    bf16* CST = (bf16*)(C.ws + WS_CST); float* NST = (float*)(C.ws + WS_NST); float* MLOC = (float*)(C.ws + WS_MISC); float* GCH = MLOC + 2048;
    const float* cw = C.in[I_CONVW] + (size_t)l * 4 * 512; const float* cb = C.in[I_CONVB] + (size_t)l * 512;
    LAS bf16* KeT = (LAS bf16*)(C.lds + RING_OFF);
    LAS bf16* Vt = KeT + 64 * TP;
    LAS float* ev = (LAS float*)(Vt + 128 * TP);
    const int tid = ltid(), lane = tid & 63, r = lane & 31, h = lane >> 5, s = tid & 63, cg = tid >> 6;
    v4u rk[4], rv[2]; float rig = 0.f, rfg = 0.f;
#define ST_FETCH(u_) do { const int bh_ = (u_) / NCH, c_ = (u_) % NCH, n0_ = (bh_ >> 2) * SEQ + c_ * CHUNK, hd_ = bh_ & 3; \
        conv_fetch(proj, n0_ + s, c_ * CHUNK + s, 1536 + 256 + hd_ * 64 + cg * 8, rk); const bf16* vp_ = proj + (size_t)(n0_ + s) * NPROJ + 2048 + hd_ * 128 + cg * 16; rv[0] = *(const v4u*)vp_; rv[1] = *(const v4u*)(vp_ + 8); \
        if (C.wave == 0) { rig = G[(size_t)(n0_ + lane) * 8 + hd_]; rfg = G[(size_t)(n0_ + lane) * 8 + 4 + hd_]; } } while (0)
    if (C.vcu < NBH * NCH) ST_FETCH(C.vcu);
    for (int u = C.vcu; u < NBH * NCH; u += C.G) {
        const int bh = u / NCH, hd = bh & 3;
        if (C.wave == 0) { const float ig = rig, fg = rfg;
            float bc = fminf(fg, 0.f) - log1pf(expf(-fabsf(fg)));
#pragma unroll
            for (int o = 1; o < 64; o <<= 1) { const float t = __shfl_up(bc, o); if (lane >= o) bc += t; }
            const float g = __shfl(bc, 63); const float w = g - bc + ig; const float m = wave_max(w);
            ev[lane] = __expf(w - m); if (lane == 0) { MLOC[u] = m; GCH[u] = g; } }
        __syncthreads();
        { float y[8]; conv_apply(rk, cw + 256 + hd * 64 + cg * 8, cb + 256 + hd * 64 + cg * 8, 1.0f, y);
            const float e = ev[s];
#pragma unroll
            for (int i = 0; i < 8; ++i) KeT[(cg * 8 + i) * TP + s] = (bf16)f2bf(y[i] * e);
            tr_store16(Vt, cg * 16, s, rv[0], rv[1]); }
        if (u + C.G < NBH * NCH) ST_FETCH(u + C.G);
        __syncthreads();
        { const int kb = C.wave & 1, vb = C.wave >> 1; f32x16 acc;
#pragma unroll
            for (int i = 0; i < 16; ++i) acc[i] = 0.f;
#pragma unroll
            for (int st = 0; st < 4; ++st) acc = MFMA32(frag_ld(KeT, kb * 32 + r, st, h), frag_ld(Vt, vb * 32 + r, st, h), acc);
            bf16* dst = CST + (size_t)u * 8192 + (size_t)(vb * 32 + r) * 64 + kb * 32 + 4 * h;
#pragma unroll
            for (int g = 0; g < 4; ++g) *(v2u*)(dst + 8 * g) = (v2u){pk2(acc[4 * g], acc[4 * g + 1]), pk2(acc[4 * g + 2], acc[4 * g + 3])}; }
        if (tid < 64) { float a = 0.f;
#pragma unroll 8
            for (int s_ = 0; s_ < 64; s_ += 2) { const unsigned w = *(const LAS unsigned*)(KeT + tid * TP + s_); a += bflo(w) + bfhi(w); }
            NST[(size_t)u * 64 + tid] = a; }
    }
#undef ST_FETCH
    __syncthreads();
}

__device__ __forceinline__ void p_mlstm_out_mfma(const Ctx& C, int l) {
    const bf16* proj = (const bf16*)(C.ws + WS_PROJ); const float* G = (const float*)(C.ws + WS_G);
    const bf16* CST = (const bf16*)(C.ws + WS_CST); const float* NST = (const float*)(C.ws + WS_NST); const float* MPREV = (const float*)(C.ws + WS_MISC) + 4096;
    bf16* MIXIN = (bf16*)(C.ws + WS_MIXIN);
    const float* cw = C.in[I_CONVW] + (size_t)l * 4 * 512; const float* cb = C.in[I_CONVB] + (size_t)l * 512;
    LAS bf16* Qt = (LAS bf16*)(C.lds + RING_OFF);
    LAS bf16* Kt = Qt + 64 * TP;
    LAS bf16* St = Kt + 64 * TP;
    LAS bf16* Vt = St + 64 * TP;
    LAS bf16* Ct = Vt + 128 * TP;
    LAS float* sv = (LAS float*)(Ct + 128 * TP);
    const int tid = ltid(), lane = tid & 63, r = lane & 31, h = lane >> 5;
    const int s = tid >> 3, cg = tid & 7, s2 = tid & 63, vg = tid >> 6, cv = tid >> 2, ck0 = (tid & 3) * 16, ot = (C.wave & 1) * 32 + r, ovb = C.wave >> 1;
    v4u rq[4], rk[4], rv[2], rc[2]; v2u ro[4], roc[4]; float rig = 0.f, rfg = 0.f, rmp = 0.f, rnp = 0.f;
#define OUT_FETCH(u_) do { const int bh_ = (u_) / NCH, c_ = (u_) % NCH, n0_ = (bh_ >> 2) * SEQ + c_ * CHUNK, hd_ = bh_ & 3; \
        conv_fetch(proj, n0_ + s, c_ * CHUNK + s, 1536 + hd_ * 64 + cg * 8, rq); conv_fetch(proj, n0_ + s, c_ * CHUNK + s, 1536 + 256 + hd_ * 64 + cg * 8, rk); \
        const bf16* vp_ = proj + (size_t)(n0_ + s2) * NPROJ + 2048 + hd_ * 128 + vg * 16; rv[0] = *(const v4u*)vp_; rv[1] = *(const v4u*)(vp_ + 8); \
        const v4u* cp_ = (const v4u*)(CST + (size_t)(u_) * 8192 + cv * 64 + ck0); rc[0] = cp_[0]; rc[1] = cp_[1]; \
        const bf16* op_ = proj + (size_t)(n0_ + ot) * NPROJ + 2560 + hd_ * 128 + ovb * 32 + 4 * h; _Pragma("unroll") for (int g_ = 0; g_ < 4; ++g_) ro[g_] = *(const v2u*)(op_ + 8 * g_); \
        if (C.wave == 0) { rig = G[(size_t)(n0_ + lane) * 8 + hd_]; rfg = G[(size_t)(n0_ + lane) * 8 + 4 + hd_]; rmp = MPREV[(u_)]; rnp = NST[(size_t)(u_) * 64 + lane]; } } while (0)
    if (C.vcu < NBH * NCH) OUT_FETCH(C.vcu);
    for (int u = C.vcu; u < NBH * NCH; u += C.G) {
        const int bh = u / NCH, c = u % NCH, b = bh >> 2, hd = bh & 3; const int n0 = b * SEQ + c * CHUNK;
        __syncthreads();
        { float y[8];
            conv_apply(rq, cw + hd * 64 + cg * 8, cb + hd * 64 + cg * 8, 0.125f, y); *(LAS v4u*)(Qt + s * TP + cg * 8) = pack8(y);
            conv_apply(rk, cw + 256 + hd * 64 + cg * 8, cb + 256 + hd * 64 + cg * 8, 1.0f, y); *(LAS v4u*)(Kt + s * TP + cg * 8) = pack8(y);
            tr_store16(Vt, vg * 16, s2, rv[0], rv[1]);
            *(LAS v4u*)(Ct + cv * TP + ck0) = rc[0]; *(LAS v4u*)(Ct + cv * TP + ck0 + 8) = rc[1];
#pragma unroll
            for (int g = 0; g < 4; ++g) roc[g] = ro[g]; }
        if (C.wave == 0) { const float ig = rig, fg = rfg; const float mp = rmp;
            float bc = fminf(fg, 0.f) - log1pf(expf(-fabsf(fg)));
#pragma unroll
            for (int o = 1; o < 64; o <<= 1) { const float t = __shfl_up(bc, o); if (lane >= o) bc += t; }
            const float a = ig - bc; float pm = a;
#pragma unroll
            for (int o = 1; o < 64; o <<= 1) { const float t = __shfl_up(pm, o); if (lane >= o) pm = fmaxf(pm, t); }
            const float mt = bc + fmaxf(mp, pm);
            sv[lane] = bc; sv[64 + lane] = a; sv[128 + lane] = mt; sv[192 + lane] = __expf(bc + mp - mt); sv[256 + lane] = rnp; }
        if (u + C.G < NBH * NCH) OUT_FETCH(u + C.G);
        __syncthreads();
        if (C.wave < 4) {
            const int sb = C.wave & 1, tb = C.wave >> 1; f32x16 x;
#pragma unroll
            for (int i = 0; i < 16; ++i) x[i] = 0.f;
#pragma unroll
            for (int st = 0; st < 4; ++st) x = MFMA32(frag_ld(Kt, sb * 32 + r, st, h), frag_ld(Qt, tb * 32 + r, st, h), x);
            const int t = tb * 32 + r; const float bt = sv[t] - sv[128 + t]; float dsum = 0.f;
#pragma unroll
            for (int g = 0; g < 4; ++g) { const int s0 = sb * 32 + 8 * g + 4 * h; float w[4];
#pragma unroll
                for (int i = 0; i < 4; ++i) { const int s = s0 + i; w[i] = (s <= t) ? x[4 * g + i] * __expf(sv[64 + s] + bt) : 0.f; }
                const unsigned p0 = pk2(w[0], w[1]), p1 = pk2(w[2], w[3]); dsum += (bflo(p0) + bfhi(p0)) + (bflo(p1) + bfhi(p1));
                *(LAS v2u*)(St + t * TP + s0) = (v2u){p0, p1}; }
            sv[384 + (sb * 2 + h) * 64 + t] = dsum;
        } else if (tid < 320) {
            const int t = tid - 256; float a = 0.f;
#pragma unroll 8
            for (int k = 0; k < 64; k += 2) { const unsigned w = *(const LAS unsigned*)(Qt + t * TP + k); a += bflo(w) * sv[256 + k] + bfhi(w) * sv[256 + k + 1]; }
            sv[320 + t] = a; }
        __syncthreads();
        {
            const int vb = C.wave >> 1, tb = C.wave & 1; f32x16 acc;
#pragma unroll
            for (int i = 0; i < 16; ++i) acc[i] = 0.f;
#pragma unroll
            for (int st = 0; st < 4; ++st) acc = MFMA32(frag_ld(Ct, vb * 32 + r, st, h), frag_ld(Qt, tb * 32 + r, st, h), acc);
            const int t = tb * 32 + r; const float iw = sv[192 + t];
#pragma unroll
            for (int i = 0; i < 16; ++i) acc[i] *= iw;
#pragma unroll
            for (int st = 0; st < 4; ++st) acc = MFMA32(frag_ld(Vt, vb * 32 + r, st, h), frag_ld(St, tb * 32 + r, st, h), acc);
            const float den = ((sv[384 + t] + sv[384 + 64 + t]) + (sv[384 + 128 + t] + sv[384 + 192 + t])) + iw * sv[320 + t];
            const float dn = 1.0f / fmaxf(fabsf(den), __expf(-sv[128 + t]));
            bf16* dst = MIXIN + (size_t)(n0 + t) * DMODEL + 512 + hd * 128 + vb * 32 + 4 * h;
#pragma unroll
            for (int g = 0; g < 4; ++g) { const v2u ow = roc[g]; const float o0 = bflo(ow.x), o1 = bfhi(ow.x), o2 = bflo(ow.y), o3 = bfhi(ow.y);
                *(v2u*)(dst + 8 * g) = (v2u){pk2(acc[4 * g] * dn * sigmoid_f(o0), acc[4 * g + 1] * dn * sigmoid_f(o1)), pk2(acc[4 * g + 2] * dn * sigmoid_f(o2), acc[4 * g + 3] * dn * sigmoid_f(o3))}; } }
    }
#undef OUT_FETCH
    __syncthreads();
}
constexpr size_t WS_TOTC = WS_CST + 32 * MiB;
constexpr size_t WS_TOTN = WS_NST + 512 * 1024;
constexpr int MS_DCUM = 6144, MS_TOTM = 8192, MS_TOTG = 8448;

__device__ __forceinline__ void p_mlstm_states_seq(const Ctx& C, int l) {
    const bf16* proj = (const bf16*)(C.ws + WS_PROJ); const float* G = (const float*)(C.ws + WS_G);
    bf16* CST = (bf16*)(C.ws + WS_CST); float* NST = (float*)(C.ws + WS_NST); float* MS = (float*)(C.ws + WS_MISC); float* MPREV = MS + 4096;
    float* TOTC = (float*)(C.ws + WS_TOTC); float* TOTN = (float*)(C.ws + WS_TOTN);
    const float* cw = C.in[I_CONVW] + (size_t)l * 4 * 512; const float* cb = C.in[I_CONVB] + (size_t)l * 512;
    LAS bf16* KeT = (LAS bf16*)(C.lds + RING_OFF);
    LAS bf16* Vt = KeT + 64 * TP;
    LAS float* ev = (LAS float*)(Vt + 128 * TP);
    LAS float* cwl = ev + 80;
    LAS bf16* Cs = (LAS bf16*)(cwl + 320);
#define CST_FLUSH(uu_) do { const int row_ = tid >> 2, pc_ = (tid & 3) * 16; const LAS v4u* sp_ = (const LAS v4u*)(Cs + row_ * TP + pc_); const v4u a_ = sp_[0], b_ = sp_[1]; \
        v4u* gp_ = (v4u*)(CST + (size_t)(uu_) * 8192 + row_ * 64 + pc_); gp_[0] = a_; gp_[1] = b_; } while (0)
    const int tid = ltid(), lane = tid & 63, r = lane & 31, h = lane >> 5, s = tid & 63, cg = tid >> 6;
    v4u rkA[4], rvA[2], rkB[4], rvB[2]; float rigA = 0.f, rfgA = 0.f, rigB = 0.f, rfgB = 0.f;
#define ST_FETCH(u_) do { const int bh_ = (u_) / NCH, c_ = (u_) % NCH, n0_ = (bh_ >> 2) * SEQ + c_ * CHUNK, hd_ = bh_ & 3; \
        conv_fetch(proj, n0_ + s, c_ * CHUNK + s, 1536 + 256 + hd_ * 64 + cg * 8, rk); const bf16* vp_ = proj + (size_t)(n0_ + s) * NPROJ + 2048 + hd_ * 128 + cg * 16; rv[0] = *(const v4u*)vp_; rv[1] = *(const v4u*)(vp_ + 8); \
        if (C.wave == 0) { rig = G[(size_t)(n0_ + lane) * 8 + hd_]; rfg = G[(size_t)(n0_ + lane) * 8 + 4 + hd_]; } } while (0)
    const bool itw = MK_SIDEJOB && C.wave >= 1 && C.wave <= 6; const int itot = TRQ_LAYERS * trq_per(C);
    LAS float* iscr = (LAS float*)(C.lds + (C.wave <= 5 ? RING_OFF + 32768 + (C.wave - 1) * 16896 : LDSX_OFF));
    float ira[64]; int ir = -1;
#define SIDE_OUT() do { if (ir >= 0) { const TrItem it_ = tr_decode(C, ir); tr_put(ira, iscr, lane); LDS_WAIT(); asm volatile("" ::: "memory"); tr_store(it_, iscr, lane); LDS_WAIT(); asm volatile("" ::: "memory"); ir = -1; } } while (0)
#define SIDE_STEP() do { if (itw) { const int q_ = trq_grab(C, lane); ir = (q_ < itot) ? trq_item(C, q_) : -1; if (ir >= 0) { const TrItem it_ = tr_decode(C, ir); tr_fetch(it_, ira, lane); } } } while (0)
#define SIDE_FLUSH() do { if (itw) SIDE_OUT(); } while (0)
    for (int vc = C.vcu; vc < 256; vc += C.G) {
        const int bh = vc >> 3, hd = bh & 3, u0 = bh * NCH + (vc & 7) * 8;
        f32x16 crun; float nrun = 0.f, mrun = -INFINITY, drun = 0.f;
#pragma unroll
        for (int i = 0; i < 16; ++i) crun[i] = 0.f;
        conv_stage(cwl, cw, cb, 256 + hd * 64, tid);
        { v4u (&rk)[4] = rkA; v4u (&rv)[2] = rvA; float& rig = rigA; float& rfg = rfgA; ST_FETCH(u0); }
        { v4u (&rk)[4] = rkB; v4u (&rv)[2] = rvB; float& rig = rigB; float& rfg = rfgB; ST_FETCH(u0 + 1); }
        auto body = [&](const int j, v4u (&rk)[4], v4u (&rv)[2], float& rig, float& rfg) __attribute__((always_inline)) {
            const int u = u0 + j;
            if (C.wave == 0) { const float ig = rig, fg = rfg;
                float bc = fminf(fg, 0.f) - log1pf(expf(-fabsf(fg)));
#pragma unroll
                for (int o = 1; o < 64; o <<= 1) { const float t = __shfl_up(bc, o); if (lane >= o) bc += t; }
                const float g = __shfl(bc, 63); const float w = g - bc + ig; const float m = wave_max(w);
                ev[lane] = __expf(w - m); if (lane == 0) { ev[64] = m; ev[65] = g; } }
            __syncthreads();
            if (j > 0) CST_FLUSH(u - 1);
            { float y[8]; conv_apply_l(rk, cwl, cg * 8, 1.0f, y);
                const float e = ev[s];
#pragma unroll
                for (int i = 0; i < 8; ++i) KeT[(cg * 8 + i) * TP + s] = (bf16)f2bf(y[i] * e);
                tr_store16(Vt, cg * 16, s, rv[0], rv[1]); }
            const float mloc = ev[64], gch = ev[65];
            SIDE_FLUSH();
            if (j < 6) ST_FETCH(u + 2);
            __syncthreads();
            const float mnew = fmaxf(gch + mrun, mloc), fa = __expf(gch + mrun - mnew), fb = __expf(mloc - mnew);
            { const int kb = C.wave & 1, vb = C.wave >> 1; f32x16 acc;
#pragma unroll
                for (int i = 0; i < 16; ++i) acc[i] = 0.f;
#pragma unroll
                for (int st = 0; st < 4; ++st) acc = MFMA32(frag_ld(KeT, kb * 32 + r, st, h), frag_ld(Vt, vb * 32 + r, st, h), acc);
                LAS bf16* dst = Cs + (vb * 32 + r) * TP + kb * 32 + 4 * h;
#pragma unroll
                for (int g = 0; g < 4; ++g) *(LAS v2u*)(dst + 8 * g) = (v2u){pk2(crun[4 * g], crun[4 * g + 1]), pk2(crun[4 * g + 2], crun[4 * g + 3])};
#pragma unroll
                for (int i = 0; i < 16; ++i) crun[i] = fa * crun[i] + fb * acc[i]; }
            if (tid < 64) { float a = 0.f;
#pragma unroll 8
                for (int s_ = 0; s_ < 64; s_ += 2) { const unsigned w = *(const LAS unsigned*)(KeT + tid * TP + s_); a += bflo(w) + bfhi(w); }
                NST[(size_t)u * 64 + tid] = nrun; nrun = fa * nrun + fb * a; }
            if (tid == 0) { MPREV[u] = mrun; MS[MS_DCUM + u] = drun; }
            mrun = mnew; drun += gch;
            SIDE_STEP();
        };
#pragma unroll 1
        for (int jj = 0; jj < 8; jj += 2) { body(jj, rkA, rvA, rigA, rfgA); body(jj + 1, rkB, rvB, rigB, rfgB); }
        __syncthreads(); CST_FLUSH(u0 + 7);
        SIDE_FLUSH();
        { const int kb = C.wave & 1, vb = C.wave >> 1; float* dst = TOTC + (size_t)vc * 8192 + (size_t)(vb * 32 + r) * 64 + kb * 32 + 4 * h;
#pragma unroll
            for (int g = 0; g < 4; ++g) *(f32x4*)(dst + 8 * g) = (f32x4){crun[4 * g], crun[4 * g + 1], crun[4 * g + 2], crun[4 * g + 3]}; }
        if (tid < 64) TOTN[vc * 64 + tid] = nrun;
        if (tid == 0) { MS[MS_TOTM + vc] = mrun; MS[MS_TOTG + vc] = drun; }
    }
#undef ST_FETCH
#undef CST_FLUSH
#undef SIDE_STEP
#undef SIDE_FLUSH
#undef SIDE_OUT
    __syncthreads();
}

__device__ __forceinline__ void p_mlstm_out_seq(const Ctx& C, int l) {
    const bf16* proj = (const bf16*)(C.ws + WS_PROJ); const float* G = (const float*)(C.ws + WS_G);
    const bf16* CST = (const bf16*)(C.ws + WS_CST); const float* NST = (const float*)(C.ws + WS_NST); const float* MS = (const float*)(C.ws + WS_MISC); const float* MPREV = MS + 4096;
    const float* TOTC = (const float*)(C.ws + WS_TOTC); const float* TOTN = (const float*)(C.ws + WS_TOTN);
    bf16* MIXIN = (bf16*)(C.ws + WS_MIXIN);
    const float* cw = C.in[I_CONVW] + (size_t)l * 4 * 512; const float* cb = C.in[I_CONVB] + (size_t)l * 512;
    LAS bf16* Qt = (LAS bf16*)(C.lds + RING_OFF);
    LAS bf16* Kt = Qt + 64 * TP;
    LAS bf16* St = Kt + 64 * TP;
    LAS bf16* Vt = St + 64 * TP;
    LAS bf16* Ct = Vt + 128 * TP;
    LAS float* sv = (LAS float*)(Ct + 128 * TP);
    const int tid = ltid(), lane = tid & 63, r = lane & 31, h = lane >> 5;
    const int s = tid >> 3, cg = tid & 7, s2 = tid & 63, vg = tid >> 6, cv = tid >> 2, ck0 = (tid & 3) * 16, ot = (C.wave & 1) * 32 + r, ovb = C.wave >> 1;
    v4u rq[4], rk[4], rv[2], rc[2], ro[2], rop[2]; float rig = 0.f, rfg = 0.f, rml = 0.f, rdc = 0.f, rnp = 0.f;
    LAS float* Os = sv + 640;
    LAS float* cwq = Os + 64 * 132; LAS float* cwk = cwq + 320;
    static_assert((3 * 64 + 2 * 128) * TP * 2 + 640 * 4 + 64 * 132 * 4 + 640 * 4 <= RING_BYTES, "mLSTM LDS");
#define OUT_FETCH(u_) do { const int bh_ = (u_) / NCH, c_ = (u_) % NCH, n0_ = (bh_ >> 2) * SEQ + c_ * CHUNK, hd_ = bh_ & 3; \
        conv_fetch(proj, n0_ + s, c_ * CHUNK + s, 1536 + hd_ * 64 + cg * 8, rq); conv_fetch(proj, n0_ + s, c_ * CHUNK + s, 1536 + 256 + hd_ * 64 + cg * 8, rk); \
        const bf16* vp_ = proj + (size_t)(n0_ + s2) * NPROJ + 2048 + hd_ * 128 + vg * 16; rv[0] = *(const v4u*)vp_; rv[1] = *(const v4u*)(vp_ + 8); \
        const v4u* cp_ = (const v4u*)(CST + (size_t)(u_) * 8192 + cv * 64 + ck0); rc[0] = cp_[0]; rc[1] = cp_[1]; \
        const bf16* op_ = proj + (size_t)(n0_ + s) * NPROJ + 2560 + hd_ * 128 + cg * 16; ro[0] = *(const v4u*)op_; ro[1] = *(const v4u*)(op_ + 8); \
        rml = MPREV[(u_)]; rdc = MS[MS_DCUM + (u_)]; \
        if (C.wave == 0) { rig = G[(size_t)(n0_ + lane) * 8 + hd_]; rfg = G[(size_t)(n0_ + lane) * 8 + 4 + hd_]; rnp = NST[(size_t)(u_) * 64 + lane]; } } while (0)
#define OUT_FLUSH(nb_) do { float hv_[16], og_[16]; const LAS f32x4* hp_ = (const LAS f32x4*)(Os + s * 132 + cg * 16); \
        _Pragma("unroll") for (int q_ = 0; q_ < 4; ++q_) { const f32x4 t4_ = hp_[q_]; hv_[4 * q_] = t4_.x; hv_[4 * q_ + 1] = t4_.y; hv_[4 * q_ + 2] = t4_.z; hv_[4 * q_ + 3] = t4_.w; } \
        unpack8(rop[0], og_); unpack8(rop[1], og_ + 8); _Pragma("unroll") for (int i_ = 0; i_ < 16; ++i_) hv_[i_] *= sigmoid_f(og_[i_]); \
        bf16* dp_ = MIXIN + (size_t)((nb_) + s) * DMODEL + 512 + hd * 128 + cg * 16; *(v4u*)dp_ = pack8(hv_); *(v4u*)(dp_ + 8) = pack8(hv_ + 8); } while (0)
    for (int vc = C.vcu; vc < 256; vc += C.G) {
        const int bh = vc >> 3, gi = vc & 7, b = bh >> 2, hd = bh & 3, u0 = bh * NCH + gi * 8;
        conv_stage(cwq, cw, cb, hd * 64, tid); conv_stage(cwk, cw, cb, 256 + hd * 64, tid);
        OUT_FETCH(u0);
        float cin[16], nin = 0.f, min_ = -INFINITY;
#pragma unroll
        for (int i = 0; i < 16; ++i) cin[i] = 0.f;
#pragma unroll 1
        for (int g2 = 0; g2 < gi; ++g2) { const int gv = (bh << 3) + g2; const float tm = MS[MS_TOTM + gv], tg = MS[MS_TOTG + gv];
            const f32x4* tp = (const f32x4*)(TOTC + (size_t)gv * 8192 + cv * 64 + ck0); const f32x4 t0 = tp[0], t1 = tp[1], t2 = tp[2], t3 = tp[3]; const float tn = (C.wave == 0) ? TOTN[gv * 64 + lane] : 0.f;
            const float mn = fmaxf(tg + min_, tm), fa = __expf(tg + min_ - mn), fb = __expf(tm - mn);
            const float tt[16] = {t0.x, t0.y, t0.z, t0.w, t1.x, t1.y, t1.z, t1.w, t2.x, t2.y, t2.z, t2.w, t3.x, t3.y, t3.z, t3.w};
#pragma unroll
            for (int i = 0; i < 16; ++i) cin[i] = fa * cin[i] + fb * tt[i];
            nin = fa * nin + fb * tn; min_ = mn; }
#pragma unroll 1
        for (int j = 0; j < 8; ++j) {
            const int u = u0 + j, c = gi * 8 + j; const int n0 = b * SEQ + c * CHUNK;
            const float mp = fmaxf(rdc + min_, rml); const float w1 = (min_ == -INFINITY) ? 0.f : __expf(rdc + min_ - mp), w2 = (rml == -INFINITY) ? 0.f : __expf(rml - mp);
            __syncthreads();
            if (j > 0) OUT_FLUSH(n0 - CHUNK);
            { float y[8];
                conv_apply_l(rq, cwq, cg * 8, 0.125f, y); *(LAS v4u*)(Qt + s * TP + cg * 8) = pack8(y);
                conv_apply_l(rk, cwk, cg * 8, 1.0f, y); *(LAS v4u*)(Kt + s * TP + cg * 8) = pack8(y);
                tr_store16(Vt, vg * 16, s2, rv[0], rv[1]);
                float cl[16]; unpack8(rc[0], cl); unpack8(rc[1], cl + 8);
#pragma unroll
                for (int i = 0; i < 16; ++i) cl[i] = w1 * cin[i] + w2 * cl[i];
                *(LAS v4u*)(Ct + cv * TP + ck0) = pack8(cl); *(LAS v4u*)(Ct + cv * TP + ck0 + 8) = pack8(cl + 8);
                rop[0] = ro[0]; rop[1] = ro[1]; }
            if (C.wave == 0) { const float ig = rig, fg = rfg;
                float bc = fminf(fg, 0.f) - log1pf(expf(-fabsf(fg)));
#pragma unroll
                for (int o = 1; o < 64; o <<= 1) { const float t = __shfl_up(bc, o); if (lane >= o) bc += t; }
                const float a = ig - bc; float pm = a;
#pragma unroll
                for (int o = 1; o < 64; o <<= 1) { const float t = __shfl_up(pm, o); if (lane >= o) pm = fmaxf(pm, t); }
                const float mt = bc + fmaxf(mp, pm);
                sv[lane] = bc; sv[64 + lane] = a; sv[128 + lane] = mt; sv[192 + lane] = __expf(bc + mp - mt); sv[256 + lane] = w1 * nin + w2 * rnp; }
            if (j < 7) OUT_FETCH(u + 1);
            __syncthreads();
            if (C.wave < 4) {
                const int sb = C.wave & 1, tb = C.wave >> 1; f32x16 x;
#pragma unroll
                for (int i = 0; i < 16; ++i) x[i] = 0.f;
#pragma unroll
                for (int st = 0; st < 4; ++st) x = MFMA32(frag_ld(Kt, sb * 32 + r, st, h), frag_ld(Qt, tb * 32 + r, st, h), x);
                const int t = tb * 32 + r; const float bt = sv[t] - sv[128 + t]; float dsum = 0.f;
#pragma unroll
                for (int g = 0; g < 4; ++g) { const int s0 = sb * 32 + 8 * g + 4 * h; float w[4];
#pragma unroll
                    for (int i = 0; i < 4; ++i) { const int ss = s0 + i; w[i] = (ss <= t) ? x[4 * g + i] * __expf(sv[64 + ss] + bt) : 0.f; }
                    const unsigned p0 = pk2(w[0], w[1]), p1 = pk2(w[2], w[3]); dsum += (bflo(p0) + bfhi(p0)) + (bflo(p1) + bfhi(p1));
                    *(LAS v2u*)(St + t * TP + s0) = (v2u){p0, p1}; }
                sv[384 + (sb * 2 + h) * 64 + t] = dsum;
            } else if (tid < 320) {
                const int t = tid - 256; float a = 0.f;
#pragma unroll 8
                for (int k = 0; k < 64; k += 2) { const unsigned w = *(const LAS unsigned*)(Qt + t * TP + k); a += bflo(w) * sv[256 + k] + bfhi(w) * sv[256 + k + 1]; }
                sv[320 + t] = a; }
            __syncthreads();
            {
                const int vb = C.wave >> 1, tb = C.wave & 1; f32x16 acc;
#pragma unroll
                for (int i = 0; i < 16; ++i) acc[i] = 0.f;
#pragma unroll
                for (int st = 0; st < 4; ++st) acc = MFMA32(frag_ld(Ct, vb * 32 + r, st, h), frag_ld(Qt, tb * 32 + r, st, h), acc);
                const int t = tb * 32 + r; const float iw = sv[192 + t];
#pragma unroll
                for (int i = 0; i < 16; ++i) acc[i] *= iw;
#pragma unroll
                for (int st = 0; st < 4; ++st) acc = MFMA32(frag_ld(Vt, vb * 32 + r, st, h), frag_ld(St, tb * 32 + r, st, h), acc);
                const float den = ((sv[384 + t] + sv[384 + 64 + t]) + (sv[384 + 128 + t] + sv[384 + 192 + t])) + iw * sv[320 + t];
                const float dn = 1.0f / fmaxf(fabsf(den), __expf(-sv[128 + t]));
                LAS float* od = Os + t * 132 + vb * 32 + 4 * h;
#pragma unroll
                for (int g = 0; g < 4; ++g) *(LAS f32x4*)(od + 8 * g) = (f32x4){acc[4 * g] * dn, acc[4 * g + 1] * dn, acc[4 * g + 2] * dn, acc[4 * g + 3] * dn}; }
        }
        __syncthreads();
        OUT_FLUSH(b * SEQ + (gi * 8 + 7) * CHUNK);
    }
#undef OUT_FETCH
#undef OUT_FLUSH
    __syncthreads();
}
template <int W> __device__ __forceinline__ void tr_reduce_step(float* val, bool bit, int mask) {
#pragma unroll
    for (int i = 0; i < W / 2; ++i) { const float keep = bit ? val[i + W / 2] : val[i], send = bit ? val[i] : val[i + W / 2]; val[i] = keep + __shfl_xor(send, mask); }
}
__device__ __forceinline__ void p_ln1_router(const Ctx& C, int l, bool claim = true, bool norouter = false, bool nostore = false, bool norows = false, int stsel = 3) {
    const bf16* XBr = (const bf16*)(C.ws + WS_XB); const unsigned char* XLO = (const unsigned char*)(C.ws + WS_XRES);
    const bf16* MIXO = (const bf16*)(C.ws + WS_MIXO); float* X1 = (float*)(C.ws + WS_X1); unsigned char* X1Q = (unsigned char*)(C.ws + WS_X1B);
    int* TOKE = (int*)(C.ws + WS_TOKE); int* TOKP = (int*)(C.ws + WS_TOKP); float* TOKG = (float*)(C.ws + WS_TOKG); int* ROWTOK = (int*)(C.ws + WS_ROWTOK);
    unsigned* cntg = (unsigned*)(C.ws + WS_CTL) + CW_CNT + 64 * l;
    const float* br = C.in[I_BR] + l * NEXP;
    LAS f32x4* wl = (LAS f32x4*)(C.lds + RING_OFF);
    LAS float* lg = (LAS float*)(C.lds + LDSX_OFF) + C.wave * (16 * 32);
    LAS int* lc = (LAS int*)(C.lds + LDSX_OFF + 8 * 16 * 32 * 4);
    const int tid = ltid(), lane = tid & 63;
    { const f32x4* WRP = (const f32x4*)(C.ws + WS_WRP) + (size_t)l * 8192;
        for (int idx = tid; idx < 8192; idx += NTHREADS) wl[idx] = WRP[idx]; }
    LAS f32x4* gbl = (LAS f32x4*)(C.lds + LDSX_OFF + 8 * 16 * 32 * 4 + 512);
    { float g_[16], b_[16]; load_vec16(C.in[I_LN1G] + l * DMODEL, lane, g_); load_vec16(C.in[I_LN1B] + l * DMODEL, lane, b_);
      if (C.wave == 0) {
#pragma unroll
        for (int q = 0; q < 4; ++q) { gbl[q * 64 + lane] = (f32x4){g_[4 * q], g_[4 * q + 1], g_[4 * q + 2], g_[4 * q + 3]}; gbl[(4 + q) * 64 + lane] = (f32x4){b_[4 * q], b_[4 * q + 1], b_[4 * q + 2], b_[4 * q + 3]}; } } }
    const int gw = C.vcu * NWAVES + C.wave, NGW = C.G * NWAVES, NGRP = NTOK / 4;
    for (int g0 = gw; g0 < NGRP; g0 += 4 * NGW) {
        if (tid < 64) lc[tid] = 0;
        __syncthreads();
        v4u pxb[4][2], pmx[4][2]; v2u plo[4][2] = {};
#define LN1_FETCH(grp_) do { _Pragma("unroll") for (int r = 0; r < 4; ++r) { const size_t n_ = (size_t)((grp_) * 4 + r) * DMODEL; \
            pxb[r][0] = __builtin_nontemporal_load((const v4u*)(XBr + n_ + 8 * lane)); pxb[r][1] = __builtin_nontemporal_load((const v4u*)(XBr + n_ + 512 + 8 * lane)); if (USE_XLO) { plo[r][0] = *(const v2u*)(XLO + n_ + 8 * lane); plo[r][1] = *(const v2u*)(XLO + n_ + 512 + 8 * lane); } \
            pmx[r][0] = __builtin_nontemporal_load((const v4u*)(MIXO + n_ + 8 * lane)); pmx[r][1] = __builtin_nontemporal_load((const v4u*)(MIXO + n_ + 512 + 8 * lane)); } } while (0)
        LN1_FETCH(g0);
#pragma unroll 1
        for (int blk = norows ? 4 : 0; blk < 4; ++blk) {
            const int grp = g0 + blk * NGW; if (grp >= NGRP) break;
            float xv[4][16];
#pragma unroll
            for (int r = 0; r < 4; ++r) { const size_t n = (size_t)(grp * 4 + r); float m[16]; typedef float f32x2_ __attribute__((ext_vector_type(2)));
                unpack8(pxb[r][0], xv[r]); unpack8(pxb[r][1], xv[r] + 8); unpack8(pmx[r][0], m); unpack8(pmx[r][1], m + 8);
                const unsigned w_[4] = {plo[r][0].x, plo[r][0].y, plo[r][1].x, plo[r][1].y};
#pragma unroll
                for (int i = 0; i < (USE_XLO ? 4 : 0); ++i) { const f32x2_ lo = __builtin_amdgcn_cvt_pk_f32_fp8((int)w_[i], false), hi = __builtin_amdgcn_cvt_pk_f32_fp8((int)w_[i], true);
                    xv[r][4 * i] += lo.x * (1.0f / XLO_SCALE); xv[r][4 * i + 1] += lo.y * (1.0f / XLO_SCALE); xv[r][4 * i + 2] += hi.x * (1.0f / XLO_SCALE); xv[r][4 * i + 3] += hi.y * (1.0f / XLO_SCALE); }
#pragma unroll
                for (int i = 0; i < 16; ++i) xv[r][i] = DN_ALPHA * xv[r][i] + m[i];
                { float gam[16], bet[16];
#pragma unroll
                  for (int q = 0; q < 4; ++q) { const f32x4 g4_ = gbl[q * 64 + lane], b4_ = gbl[(4 + q) * 64 + lane]; gam[4 * q] = g4_.x; gam[4 * q + 1] = g4_.y; gam[4 * q + 2] = g4_.z; gam[4 * q + 3] = g4_.w; bet[4 * q] = b4_.x; bet[4 * q + 1] = b4_.y; bet[4 * q + 2] = b4_.z; bet[4 * q + 3] = b4_.w; }
                  ln_row(xv[r], gam, bet); }
                if (!nostore) { typedef float f32x2q __attribute__((ext_vector_type(2)));
                    const v2u p0 = pack8_fp8(xv[r], XQ_SCALE), p1 = pack8_fp8(xv[r] + 8, XQ_SCALE); __builtin_nontemporal_store(p0, (v2u*)(X1Q + n * DMODEL + 8 * lane)); __builtin_nontemporal_store(p1, (v2u*)(X1Q + n * DMODEL + 512 + 8 * lane));
                    const unsigned pw_[4] = {p0.x, p0.y, p1.x, p1.y}; float rem_[16];
#pragma unroll
                    for (int i = 0; i < 4; ++i) { const f32x2q lo = __builtin_amdgcn_cvt_pk_f32_fp8((int)pw_[i], false), hi = __builtin_amdgcn_cvt_pk_f32_fp8((int)pw_[i], true);
                        rem_[4 * i] = xv[r][4 * i] - lo.x * (1.0f / XQ_SCALE); rem_[4 * i + 1] = xv[r][4 * i + 1] - lo.y * (1.0f / XQ_SCALE); rem_[4 * i + 2] = xv[r][4 * i + 2] - hi.x * (1.0f / XQ_SCALE); rem_[4 * i + 3] = xv[r][4 * i + 3] - hi.y * (1.0f / XQ_SCALE); }
                    if (MK_X1R8) { unsigned char* rr_ = (unsigned char*)X1 + n * DMODEL; __builtin_nontemporal_store(pack8_fp8(rem_, X1R_SCALE), (v2u*)(rr_ + 8 * lane)); __builtin_nontemporal_store(pack8_fp8(rem_ + 8, X1R_SCALE), (v2u*)(rr_ + 512 + 8 * lane)); }
                    else { bf16* rr_ = (bf16*)X1 + n * DMODEL; __builtin_nontemporal_store(pack8(rem_), (v4u*)(rr_ + 8 * lane)); __builtin_nontemporal_store(pack8(rem_ + 8), (v4u*)(rr_ + 512 + 8 * lane)); }   } else if (xv[r][0] == 123.456f) X1[n * DMODEL + lane] = xv[r][1]; }
            if (blk < 3 && g0 + (blk + 1) * NGW < NGRP) LN1_FETCH(g0 + (blk + 1) * NGW);
            typedef float f32x2p __attribute__((ext_vector_type(2)));
            f32x2p xa[16], xb[16];
#pragma unroll
            for (int i = 0; i < 16; ++i) { xa[i] = (f32x2p){xv[0][i], xv[1][i]}; xb[i] = (f32x2p){xv[2][i], xv[3][i]}; }
#pragma unroll 1
            for (int q = norouter ? 4 : 0; q < 4; ++q) {
                float acc[32];
#pragma unroll
                for (int e = 0; e < 8; ++e) { const LAS f32x4* wp = wl + ((q * 8 + e) * 4) * 64 + lane; const f32x4 w0 = wp[0], w1 = wp[64], w2 = wp[128], w3 = wp[192];
                    const float ww[16] = {w0.x, w0.y, w0.z, w0.w, w1.x, w1.y, w1.z, w1.w, w2.x, w2.y, w2.z, w2.w, w3.x, w3.y, w3.z, w3.w};
                    f32x2p a = xa[0] * ww[0], b = xb[0] * ww[0];
#pragma unroll
                    for (int i = 1; i < 16; ++i) { a += xa[i] * ww[i]; b += xb[i] * ww[i]; }
                    acc[0 * 8 + e] = a.x; acc[1 * 8 + e] = a.y; acc[2 * 8 + e] = b.x; acc[3 * 8 + e] = b.y; }
                tr_reduce_step<32>(acc, (lane >> 4) & 1, 16); tr_reduce_step<16>(acc, (lane >> 3) & 1, 8); tr_reduce_step<8>(acc, (lane >> 2) & 1, 4); tr_reduce_step<4>(acc, (lane >> 1) & 1, 2); tr_reduce_step<2>(acc, lane & 1, 1);
                const float tot = acc[0] + __shfl_xor(acc[0], 32);
                if (lane < 32) lg[(blk * 4 + (lane >> 3)) * 32 + q * 8 + (lane & 7)] = tot + br[q * 8 + (lane & 7)];
            }
        }
#undef LN1_FETCH
        LDS_WAIT(); asm volatile("" ::: "memory");
        int te[4] = {0, 0, 0, 0}, tp[4] = {0, 0, 0, 0}; float tg[4] = {0.f, 0.f, 0.f, 0.f};
        if (lane < 16 && (g0 + (lane >> 2) * NGW) < NGRP) {
            float lv[32];
#pragma unroll
            for (int e = 0; e < 32; ++e) lv[e] = lg[lane * 32 + e];
            unsigned taken = 0u; float val[4];
#pragma unroll
            for (int k = 0; k < 4; ++k) { int bi = 0; float bv = -INFINITY;
#pragma unroll
                for (int e = 0; e < 32; ++e) { const bool ok = !((taken >> e) & 1u) && (lv[e] > bv); bv = ok ? lv[e] : bv; bi = ok ? e : bi; }
                te[k] = bi; val[k] = bv; taken |= 1u << bi; }
            float s = 0.f;
#pragma unroll
            for (int k = 0; k < 4; ++k) { tg[k] = expf(val[k] - val[0]); s += tg[k]; }
#pragma unroll
            for (int k = 0; k < 4; ++k) { tg[k] = tg[k] / s; tp[k] = __hip_atomic_fetch_add(lc + te[k], 1, __ATOMIC_RELAXED, __HIP_MEMORY_SCOPE_WORKGROUP); }
        }
        __syncthreads();
        if (tid < 32 && claim) lc[32 + tid] = (int)__hip_atomic_fetch_add(cntg + tid, (unsigned)lc[tid], __ATOMIC_RELAXED, __HIP_MEMORY_SCOPE_AGENT);
        __syncthreads();
        const int mygrp = g0 + (lane >> 2) * NGW;
        if (lane < 16 && claim && mygrp < NGRP) { const int n = mygrp * 4 + (lane & 3);
#pragma unroll
            for (int k = 0; k < 4; ++k) { const int pos = lc[32 + te[k]] + tp[k]; TOKE[n * 4 + k] = te[k]; TOKP[n * 4 + k] = pos; TOKG[n * 4 + k] = tg[k]; ROWTOK[(size_t)te[k] * NTOK + pos] = n; } }
        __syncthreads();
    }
}

__device__ __forceinline__ void moe_tables(const Ctx& C, int l) {
    LAS int* ts = (LAS int*)(C.lds + LDSCTL_OFF); LAS int* cn = (LAS int*)(C.lds + LDSCTL_OFF + 160);
    const unsigned* cntg = (const unsigned*)(C.ws + WS_CTL) + CW_CNT + 64 * l;
    const int tid = ltid();
    if (tid < 64) { const int lane = tid; const int c = (lane < 32) ? (int)__hip_atomic_load(cntg + lane, __ATOMIC_RELAXED, __HIP_MEMORY_SCOPE_AGENT) : 0; int t = (c + 255) >> 8;
        int inc = t;
#pragma unroll
        for (int o = 1; o < 64; o <<= 1) { const int x = __shfl_up(inc, o); if (lane >= o) inc += x; }
        if (lane < 32) { cn[lane] = c; ts[lane] = inc - t; } if (lane == 32) ts[32] = inc; }
    __syncthreads();
}

__device__ __forceinline__ void p_ln2_combine(const Ctx& C, int l) {
    const bf16* X1 = (const bf16*)(C.ws + WS_X1); const unsigned char* X1Q = (const unsigned char*)(C.ws + WS_X1B); const unsigned char* Y = (const unsigned char*)(C.ws + WS_Y);
    const int* TOKE = (const int*)(C.ws + WS_TOKE); const int* TOKP = (const int*)(C.ws + WS_TOKP); const float* TOKG = (const float*)(C.ws + WS_TOKG);
    float* xo = C.out; unsigned char* XLOw = (unsigned char*)(C.ws + WS_XRES); bf16* XB = (bf16*)(C.ws + WS_XB); float* G = (float*)(C.ws + WS_G);
    const LAS int* ts = (const LAS int*)(C.lds + LDSCTL_OFF);
    LAS f32x4* wgl = (LAS f32x4*)(C.lds + RING_OFF);
    const int tid = ltid(), lane = tid & 63, gw = C.vcu * NWAVES + C.wave, NGW = C.G * NWAVES; const bool nextl = (l + 1 < DEPTH);
    if (nextl) load_gate_w(tid, C.in[I_WIN] + (size_t)(l + 1) * DMODEL * INW, wgl);
    __syncthreads();
    float gam[16], bet[16]; load_vec16(C.in[I_LN2G] + l * DMODEL, lane, gam); load_vec16(C.in[I_LN2B] + l * DMODEL, lane, bet);
    typedef int i32x4_ __attribute__((ext_vector_type(4)));
    i32x4_ ne[2], np[2]; f32x4 ng_[2];
#define LN2_ROUTE(n0_) do { _Pragma("unroll") for (int q = 0; q < 2; ++q) { int nn = (n0_) + q * NGW; nn = nn < NTOK ? nn : (NTOK - 1); ne[q] = *(const i32x4_*)(TOKE + nn * 4); np[q] = *(const i32x4_*)(TOKP + nn * 4); ng_[q] = *(const f32x4*)(TOKG + nn * 4); } } while (0)
    LN2_ROUTE(gw);
    for (int n = gw; n < NTOK; n += 2 * NGW) {
        v4u xr[2][2]; v2u xr8[2][2]; v2u xq[2][2]; v2u yr[2][4][2]; f32x4 g4[2]; int nrow[2];
#pragma unroll
        for (int q = 0; q < 2; ++q) { int nn = n + q * NGW; nn = nn < NTOK ? nn : (NTOK - 1); nrow[q] = nn; g4[q] = ng_[q];
            if (MK_X1R8) { const unsigned char* xp = (const unsigned char*)X1 + (size_t)nn * DMODEL; xr8[q][0] = __builtin_nontemporal_load((const v2u*)(xp + 8 * lane)); xr8[q][1] = __builtin_nontemporal_load((const v2u*)(xp + 512 + 8 * lane)); }
            else { const bf16* xp = X1 + (size_t)nn * DMODEL; xr[q][0] = __builtin_nontemporal_load((const v4u*)(xp + 8 * lane)); xr[q][1] = __builtin_nontemporal_load((const v4u*)(xp + 512 + 8 * lane)); }
            const unsigned char* xqp = X1Q + (size_t)nn * DMODEL; xq[q][0] = __builtin_nontemporal_load((const v2u*)(xqp + 8 * lane)); xq[q][1] = __builtin_nontemporal_load((const v2u*)(xqp + 512 + 8 * lane));
#pragma unroll
            for (int k = 0; k < 4; ++k) { const unsigned char* yp = Y + ((size_t)ts[ne[q][k]] * 256 + np[q][k]) * DMODEL; yr[q][k][0] = __builtin_nontemporal_load((const v2u*)(yp + 8 * lane)); yr[q][k][1] = __builtin_nontemporal_load((const v2u*)(yp + 512 + 8 * lane)); } }
        if (n + 2 * NGW < NTOK) LN2_ROUTE(n + 2 * NGW);
#pragma unroll
        for (int q = 0; q < 2; ++q) {
            if (q == 1 && n + NGW >= NTOK) break;
            typedef float f32x2_ __attribute__((ext_vector_type(2)));
            float v[16];
            if (MK_X1R8) { const unsigned w[4] = {xr8[q][0].x, xr8[q][0].y, xr8[q][1].x, xr8[q][1].y};
#pragma unroll
              for (int i = 0; i < 4; ++i) { const f32x2_ lo = __builtin_amdgcn_cvt_pk_f32_fp8((int)w[i], false), hi = __builtin_amdgcn_cvt_pk_f32_fp8((int)w[i], true);
                  v[4 * i] = lo.x * (1.0f / X1R_SCALE); v[4 * i + 1] = lo.y * (1.0f / X1R_SCALE); v[4 * i + 2] = hi.x * (1.0f / X1R_SCALE); v[4 * i + 3] = hi.y * (1.0f / X1R_SCALE); } }
            else { unpack8(xr[q][0], v); unpack8(xr[q][1], v + 8); }
            { const unsigned w[4] = {xq[q][0].x, xq[q][0].y, xq[q][1].x, xq[q][1].y};
#pragma unroll
              for (int i = 0; i < 4; ++i) { const f32x2_ lo = __builtin_amdgcn_cvt_pk_f32_fp8((int)w[i], false), hi = __builtin_amdgcn_cvt_pk_f32_fp8((int)w[i], true);
                  v[4 * i] += lo.x * (1.0f / XQ_SCALE); v[4 * i + 1] += lo.y * (1.0f / XQ_SCALE); v[4 * i + 2] += hi.x * (1.0f / XQ_SCALE); v[4 * i + 3] += hi.y * (1.0f / XQ_SCALE); } }
#pragma unroll
            for (int i = 0; i < 16; ++i) v[i] *= DN_ALPHA;
#pragma unroll
            for (int k = 0; k < 4; ++k) { const float gk = g4[q][k] * (1.0f / YQ_SCALE); const unsigned w[4] = {yr[q][k][0].x, yr[q][k][0].y, yr[q][k][1].x, yr[q][k][1].y};
#pragma unroll
                for (int i = 0; i < 4; ++i) { const f32x2_ lo = __builtin_amdgcn_cvt_pk_f32_fp8((int)w[i], false), hi = __builtin_amdgcn_cvt_pk_f32_fp8((int)w[i], true);
                    v[4 * i] += gk * lo.x; v[4 * i + 1] += gk * lo.y; v[4 * i + 2] += gk * hi.x; v[4 * i + 3] += gk * hi.y; } }
            ln_row(v, gam, bet);
            const int nn = nrow[q];
            if (!nextl) store_row_f32_nt(xo + (size_t)nn * DMODEL, lane, v);
            if (nextl) { store_row_bf16_nt(XB + (size_t)nn * DMODEL, lane, v); { float lo_[16];
#pragma unroll
                for (int i = 0; i < 16; ++i) lo_[i] = v[i] - __uint_as_float(f2bf(v[i]) << 16);
                if (USE_XLO) store_row_fp8(XLOw + (size_t)nn * DMODEL, lane, lo_, XLO_SCALE);
                store_row_fp8_nt((unsigned char*)(C.ws + WS_XQ) + (size_t)nn * DMODEL, lane, v, XQ_SCALE); }
                gates_row(v, wgl, C.in[I_GATEB] + (l + 1) * 8, G + (size_t)nn * 8, lane); }
        }
    }
#undef LN2_ROUTE
    __syncthreads();
}
#ifndef MK_RELMODE
#define MK_RELMODE 0
#endif
__device__ __forceinline__ void xcd_barrier_w(const XcdBarrier& b, const Ctx& C, volatile LAS unsigned* rel, int minitems = 0) {
    asm volatile("s_waitcnt vmcnt(0)" ::: "memory");
    if (threadIdx.x == 0) *rel = 0u;
    __syncthreads();
    if (C.wave == 0) {
        if (threadIdx.x == 0) {
            unsigned* bar = b.bar;
            __builtin_amdgcn_s_waitcnt(0);
            unsigned nloc = b.st[0], nx = b.st[1];
            if (nloc == 0u) { xcd_barrier_complete(bar, b.x, nloc, nx); b.st[0] = nloc; b.st[1] = nx; }
            const unsigned old = xb_add(&bar[XB_XSUB(b.x)], 1u);
            const unsigned gen = old / nloc;
            if (old + 1u == (gen + 1u) * nloc) {
                if (MK_RELMODE == 0) *rel = 1u;
                __builtin_amdgcn_fence(__ATOMIC_RELEASE, "agent");
                asm volatile("s_waitcnt vmcnt(0)" ::: "memory");
                const unsigned og = xb_add(&bar[XB_TOP], 1u);
                const unsigned tg = og / nx;
                if (og + 1u == (tg + 1u) * nx) xb_add(&bar[XB_TOPGEN], 1u);
                else XB_SPIN(xb_ld(&bar[XB_TOPGEN]) == tg, bar);
                *rel = 1u;
                __builtin_amdgcn_fence(__ATOMIC_ACQUIRE, "agent");
                xb_add(&bar[XB_XGEN(b.x)], 1u);
                asm volatile("s_waitcnt vmcnt(0)" ::: "memory");
            } else {
                if (MK_RELMODE == 0) { XB_SPIN(xb_ld(&bar[XB_XSUB(b.x)]) < (gen + 1u) * nloc, bar);
                    *rel = 1u; }
                XB_SPIN(xb_ld(&bar[XB_XGEN(b.x)]) == gen, bar);
                *rel = 1u;
                __builtin_amdgcn_fence(__ATOMIC_ACQUIRE, "agent");
                asm volatile("s_waitcnt vmcnt(0)" ::: "memory");
            }
        }
    } else {
        const int lane = ltid() & 63, total = TRQ_LAYERS * trq_per(C); LAS float* scr = (LAS float*)(C.lds + RING_OFF + (C.wave - 1) * 16896);
        int done = 0;
        while (done < minitems || *rel == 0u) { const int q = trq_grab(C, lane); if (q >= total) break; const int r = trq_item(C, q); if (r >= 0) tr_one(C, r, scr, lane); ++done; }
    }
    __syncthreads();
}

struct Args { const float* in[21]; float* out; unsigned char* ws; int ph_lo, ph_hi, li, pad; };
__global__ void __launch_bounds__(NTHREADS, 2) mega_fwd(Args args) {
    extern __shared__ __attribute__((aligned(16))) unsigned char lds[];
    Ctx C;
    C.lds = (LAS unsigned char*)lds; C.wave = __builtin_amdgcn_readfirstlane(threadIdx.x >> 6);
    C.G = gridDim.x; { const int bx = blockIdx.x; C.vcu = (C.G % 8 == 0) ? (bx % 8) * (C.G / 8) + bx / 8 : bx; }
    C.ws = args.ws; C.in = args.in; C.out = args.out;
    volatile LAS unsigned* MISC = (volatile LAS unsigned*)(C.lds + MISC_OFF);
    for (int u = threadIdx.x; u < (LDSX_OFF - LDSCTL_OFF) / 4; u += NTHREADS) ((LAS unsigned*)(C.lds + LDSCTL_OFF))[u] = 0u;
    __syncthreads();
    unsigned* ctl = (unsigned*)(C.ws + WS_CTL);
    XcdBarrier bar = xcd_barrier_post(ctl + CW_BAR + args.li * XCD_BAR_WORDS, MISC + 8);
    const int lo = args.ph_lo, hi = args.ph_hi;
#define IN(k) (lo <= (k) && (k) < hi)
#ifndef MK_DBL
#define MK_DBL -1
#endif
#define REP(kind) _Pragma("unroll 1") for (int rep_ = 0; rep_ < ((kind) == MK_DBL ? 2 : 1); ++rep_)
#ifdef MK_PROBE_A
    LAS unsigned long long* tacc = (LAS unsigned long long*)(C.lds + LDSX_OFF + 20480);
    if (blockIdx.x == 0 && threadIdx.x == 0) { for (int i = 0; i < 16; ++i) tacc[i] = 0ull; tacc[14] = tacc[15] = wall_clock64(); }
#define stamper (blockIdx.x == 0 && threadIdx.x == 0)
#define STAMP(kind) do { if (stamper) { const unsigned long long now_ = wall_clock64(); tacc[kind] += now_ - tacc[14]; tacc[14] = now_; } } while (0)
#define SEAM(k) do { if (IN(k) && IN((k) + 1)) xcd_barrier(bar); STAMP((k) == 0 ? 0 : 1 + ((k) - 1) % NPH_LAYER); } while (0)
#else
#define STAMP(kind) do { } while (0)
#define SEAM(k) do { if (IN(k) && IN((k) + 1)) { xcd_barrier_w(bar, C, MISC + 10); if (MK_DBL == 12) xcd_barrier(bar); } } while (0)
#define SEAMW(k, n) do { if (IN(k) && IN((k) + 1)) { xcd_barrier_w(bar, C, MISC + 10, (n)); if (MK_DBL == 12) xcd_barrier(bar); } } while (0)
#ifndef MK_TAILITEMS
#define MK_TAILITEMS 3
#endif
#define MOE_IDLE(nN, xs) ((C.G == 256) ? ((((const LAS int*)(C.lds + LDSCTL_OFF))[32] + 8 * (32 / (nN)) - 1) / (8 * (32 / (nN))) - ((((const LAS int*)(C.lds + LDSCTL_OFF))[32] - ((int)blockIdx.x >> 3) / (nN) - ((((int)blockIdx.x & 7) + (xs)) & 7) * (32 / (nN)) + 8 * (32 / (nN)) - 1) / (8 * (32 / (nN))))) : 0)
#ifndef MK_DOWN_XS
#define MK_DOWN_XS 3
#endif
#endif
    if (IN(0)) { REP(0) p_prologue(C); SEAM(0); }
#pragma unroll 1
    for (int l = 0; l < DEPTH; ++l) {
        const int pb = 1 + l * NPH_LAYER;
        bf16* XB = (bf16*)(C.ws + WS_XB); bf16* PROJ = (bf16*)(C.ws + WS_PROJ);
        if (IN(pb + 0)) {
            { pg8::Gemm g{XB, (const bf16*)(C.ws + WS_WIN) + (size_t)l * NPROJ * DMODEL, NTOK, 2048, DMODEL}; pg8::StaticOrder S; S.init(NTOK, 2048, C.G, (int)blockIdx.x);
              pg8::EpiBf16<0> E{PROJ, NPROJ, nullptr, 512, 512, attn_body::C2};
              REP(1) pg8::gemm_phase<pg8::EpiBf16<0>, pg8::StaticOrder, true, true, false>(C.lds + RING_OFF, g, S, E); }
            { pg8::Gemm g{(const bf16*)(C.ws + WS_XQ), (const bf16*)(C.ws + WS_WINQ + (size_t)l * 1536 * DMODEL), NTOK, 1024, DMODEL / 2}; pg8::StaticOrder S; S.init(NTOK, 1024, C.G, (int)blockIdx.x);
              pg8::EpiBf16<0> E{PROJ + 2048, NPROJ, nullptr, 0, 0, 1.0f, 1.0f / (XQ_SCALE * WQ_SCALE)};
              REP(1) pg8::gemm_phase<pg8::EpiBf16<0>, pg8::StaticOrder, true, true, false, true>(C.lds + RING_OFF, g, S, E); }
            SEAM(pb + 0);
        }
        if (IN(pb + 1)) { REP(2) p_mlstm_states_seq(C, l); SEAM(pb + 1); }
        if (IN(pb + 3)) {
            REP(11) p_mlstm_out_seq(C, l); STAMP(11);
            { const int ln_ = ltid() & 63; const float s1 = wave_sum(C.in[I_LQ1][l * 64 + ln_] * C.in[I_LK1][l * 64 + ln_]), s2 = wave_sum(C.in[I_LQ2][l * 64 + ln_] * C.in[I_LK2][l * 64 + ln_]);
              const float lam_init = __uint_as_float(__builtin_amdgcn_readfirstlane(__float_as_uint(0.8f - 0.6f * expf(-0.3f * (float)l)))); const float lam = __uint_as_float(__builtin_amdgcn_readfirstlane(__float_as_uint(expf(s1) - expf(s2) + lam_init)));
              REP(4) for (int vc = C.vcu; vc < 256; vc += C.G) attn_body::attn_phase((char*)lds + RING_OFF, (const attn_body::bf16*)PROJ, (attn_body::bf16*)(C.ws + WS_ATTO), (attn_body::bf16*)(C.ws + WS_MIXIN), C.in[I_NG] + l * 128, lam, 1.0f - lam_init, vc); }
            SEAM(pb + 3);
        }
        if (IN(pb + 5)) {
#if MK_OUTFP8
            pg8::Gemm g{(const bf16*)(C.ws + WS_MIXIN), (const bf16*)(C.ws + WS_WOUT + (size_t)l * DMODEL * DMODEL), NTOK, DMODEL, DMODEL / 2}; pg8::StaticOrder S; S.init(NTOK, DMODEL, C.G, (int)blockIdx.x);
            pg8::EpiBf16<0> E{(bf16*)(C.ws + WS_MIXO), DMODEL, nullptr, 0, 0, 1.0f, 1.0f / (MQ_SCALE * WQ_SCALE)};
            REP(6) pg8::gemm_phase<pg8::EpiBf16<0>, pg8::StaticOrder, true, true, false, true>(C.lds + RING_OFF, g, S, E);
#else
            pg8::Gemm g{(const bf16*)(C.ws + WS_MIXIN), (const bf16*)(C.ws + WS_WOUT) + (size_t)l * DMODEL * DMODEL, NTOK, DMODEL, DMODEL}; pg8::StaticOrder S; S.init(NTOK, DMODEL, C.G, (int)blockIdx.x);
            pg8::EpiBf16<0> E{(bf16*)(C.ws + WS_MIXO), DMODEL, nullptr, 0, 0, 1.0f};
            REP(6) pg8::gemm_phase<pg8::EpiBf16<0>, pg8::StaticOrder, true, true, false>(C.lds + RING_OFF, g, S, E);
#endif
            SEAM(pb + 5);
        }
        if (IN(pb + 6)) { p_ln1_router(C, l); if (MK_DBL == 7) p_ln1_router(C, l, false); if (MK_DBL == 13) p_ln1_router(C, l, false, true); if (MK_DBL == 14) p_ln1_router(C, l, false, true, true); if (MK_DBL == 15) p_ln1_router(C, l, false, true, true, true); if (MK_DBL == 16) p_ln1_router(C, l, false, true, false, false, 1); if (MK_DBL == 17) p_ln1_router(C, l, false, true, false, false, 2); if (l > 0) trq_drain(C, l); SEAM(pb + 6); }
        if (IN(pb + 7)) {
            moe_tables(C, l);
            pg8::Gemm g{(const bf16*)(C.ws + WS_X1B), (const bf16*)(C.ws + WS_WGU + (size_t)l * NEXP * 2 * DFF * DMODEL), 0, 0, DMODEL / 2};
            pg8::MoeOrder S{(const LAS int*)(C.lds + LDSCTL_OFF), (const LAS int*)(C.lds + LDSCTL_OFF + 160), (const int*)(C.ws + WS_ROWTOK), 8, C.G, (int)blockIdx.x, NTOK, (LAS unsigned*)(C.lds + LDSX_OFF)};
            pg8::EpiSwiglu E{(bf16*)(C.ws + WS_H), DFF, C.in[I_BGU] + (size_t)l * NEXP * 2 * DFF, DFF, 1.0f / (XQ_SCALE * WQ_SCALE), HQ_SCALE, 0, (const LAS float*)(C.lds + LDSX_OFF + 16384)};
            REP(8) pg8::gemm_phase<pg8::EpiSwiglu, pg8::MoeOrder, true, true, true, true>(C.lds + RING_OFF, g, S, E);
            if (MK_DBL == 21) pg8::gemm_phase<pg8::EpiSwiglu, pg8::MoeOrder, true, true, true, true>(C.lds + RING_OFF, g, S, E);
            if (MK_DBL == 18 || MK_DBL == 19) { pg8::EpiSwiglu E2 = E; E2.dbg = (MK_DBL == 18) ? 2 : 1; pg8::gemm_phase<pg8::EpiSwiglu, pg8::MoeOrder, true, true, true, true>(C.lds + RING_OFF, g, S, E2); }
            SEAMW(pb + 7, MK_TAILITEMS * MOE_IDLE(8, 0));
        }
        if (IN(pb + 8)) {
            if (!IN(pb + 7)) moe_tables(C, l);
            pg8::Gemm g{(const bf16*)(C.ws + WS_H), (const bf16*)(C.ws + WS_WDN + (size_t)l * NEXP * DMODEL * DFF), 0, 0, DFF / 2};
            pg8::MoeOrder S{(const LAS int*)(C.lds + LDSCTL_OFF), (const LAS int*)(C.lds + LDSCTL_OFF + 160), (const int*)(C.ws + WS_ROWTOK), 4, C.G, (int)blockIdx.x, NTOK, (LAS unsigned*)(C.lds + LDSX_OFF), MK_DOWN_XS};
            pg8::EpiFp8 E{(bf16*)(C.ws + WS_Y), DMODEL, C.in[I_BDN] + (size_t)l * NEXP * DMODEL, DMODEL, 0, 1.0f, 1.0f / (HQ_SCALE * WQ_SCALE), 0, 0u, YQ_SCALE, (const LAS float*)(C.lds + LDSX_OFF + 16384)};
            REP(9) pg8::gemm_phase<pg8::EpiFp8, pg8::MoeOrder, true, true, false, true>(C.lds + RING_OFF, g, S, E);
            if (MK_DBL == 20) { pg8::EpiFp8 E2 = E; E2.dbg = 2; pg8::gemm_phase<pg8::EpiFp8, pg8::MoeOrder, true, true, false, true>(C.lds + RING_OFF, g, S, E2); }
            SEAMW(pb + 8, MK_TAILITEMS * MOE_IDLE(4, MK_DOWN_XS));
        }
        if (IN(pb + 9)) { if (!IN(pb + 7)) moe_tables(C, l); REP(10) p_ln2_combine(C, l); SEAM(pb + 9); }
    }
#ifdef MK_PROBE_A
    xcd_barrier(bar);
    if (stamper) { const unsigned long long now_ = wall_clock64(); tacc[10] += now_ - tacc[14]; const float tot = (float)(now_ - tacc[15]);
        __hip_atomic_store((float*)(ctl + 8), (float)tacc[MK_PROBE_A] / tot, __ATOMIC_RELAXED, __HIP_MEMORY_SCOPE_AGENT); __hip_atomic_store((float*)(ctl + 9), (float)tacc[MK_PROBE_B] / tot, __ATOMIC_RELAXED, __HIP_MEMORY_SCOPE_AGENT); }
    xcd_barrier(bar);
    { const float fa = __hip_atomic_load((float*)(ctl + 8), __ATOMIC_RELAXED, __HIP_MEMORY_SCOPE_AGENT), fb = __hip_atomic_load((float*)(ctl + 9), __ATOMIC_RELAXED, __HIP_MEMORY_SCOPE_AGENT);
        const size_t gid = (size_t)blockIdx.x * NTHREADS + threadIdx.x, nth = (size_t)gridDim.x * NTHREADS;
        for (size_t i = gid; i < (size_t)NTOK * DMODEL; i += nth) { float v = C.out[i] * (1.0f + 4.0f * fa); if (i == 0) v += 1000.0f * fb; C.out[i] = v; } }
#endif
#undef IN
#undef SEAM
}

#ifndef MK_MODE
#define MK_MODE 0
#endif
static int mega_grid() {
    static int grid = 0;
    if (grid == 0) {
        int dev = 0, cus = 0, per_cu = 0;
        if (hipGetDevice(&dev) != hipSuccess || hipDeviceGetAttribute(&cus, hipDeviceAttributeMultiprocessorCount, dev) != hipSuccess) { grid = -1; return grid; }
        if (hipFuncSetAttribute((const void*)mega_fwd, hipFuncAttributeMaxDynamicSharedMemorySize, LDS_BYTES) != hipSuccess) { fprintf(stderr, "kernel_launch: hipFuncSetAttribute failed\n"); grid = -1; return grid; }
        if (hipOccupancyMaxActiveBlocksPerMultiprocessor(&per_cu, (const void*)mega_fwd, NTHREADS, LDS_BYTES) != hipSuccess || per_cu < 1) fprintf(stderr, "kernel_launch: occupancy query reports %d\n", per_cu);
        (void)hipGetLastError();
        grid = cus;
    }
    return grid;
}
static void mega_launch(void* const* d_in, float* d_out, unsigned char* ws, hipStream_t stream, int lo, int hi, int li) {
    const int grid = mega_grid(); if (grid <= 0) return;
    Args a{};
    for (int i = 0; i < 21; ++i) a.in[i] = (const float*)d_in[i];
    a.out = d_out; a.ws = ws; a.ph_lo = lo; a.ph_hi = hi; a.li = li; a.pad = 0;
    hipLaunchKernelGGL(mega_fwd, dim3(grid), dim3(NTHREADS), LDS_BYTES, stream, a);
    const hipError_t le = hipPeekAtLastError();
    if (le != hipSuccess) fprintf(stderr, "kernel_launch: launch failed: %s\n", hipGetErrorName(le));
}
extern "C" void kernel_launch(void* const* d_in, const int* in_sizes, int n_in, void* d_out, int out_size, void* d_ws, size_t ws_size, hipStream_t stream) {
    if (n_in != 21 || in_sizes[0] != NTOK * DMODEL || out_size != NTOK * DMODEL || ws_size < WS_END) { fprintf(stderr, "kernel_launch: unexpected shapes (n_in %d, ws %zu)\n", n_in, ws_size); return; }
    unsigned char* ws = (unsigned char*)d_ws;
    if (hipMemsetAsync(ws + WS_CTL, 0, CTL_ZERO_BYTES, stream) != hipSuccess) { fprintf(stderr, "kernel_launch: memset failed\n"); return; }
#if MK_MODE == 0
    mega_launch(d_in, (float*)d_out, ws, stream, 0, NPHASES, 0);
#else
    for (int ph = 0; ph < NPHASES; ++ph) mega_launch(d_in, (float*)d_out, ws, stream, ph, ph + 1, 0);
#endif
}
```

```cpp
#include <hip/hip_runtime.h>
#include <cstdio>
#include <cstdint>
#include <cmath>
namespace pg8 {
#define PG8_LAS __attribute__((address_space(3)))
#ifndef PG8_STORES_IN_FLIGHT
#define PG8_STORES_IN_FLIGHT 0
#endif
#define PG8_NSTORE(n) (PG8_STORES_IN_FLIGHT ? (n) : 0)
typedef unsigned short bf16_t;
typedef short bf16x8 __attribute__((ext_vector_type(8)));
typedef float f32x4 __attribute__((ext_vector_type(4)));
typedef unsigned u32x4 __attribute__((ext_vector_type(4)));
typedef int i32x4_t __attribute__((ext_vector_type(4)));
typedef int i32x8_t __attribute__((ext_vector_type(8)));
constexpr int BM = 256, BK = 64, HALF = 128, HTB = HALF * BK * 2  , STAGE_BYTES = 8 * HTB, NXCD = 8, WGM = 8;

__host__ __device__ __forceinline__ int lds_byte(int r, int c) { const int st = (r >> 4) * 2 + (c >> 5), rr = r & 15, cc = c & 31, ob = rr * 64 + cc * 2; return st * 1024 + (ob ^ (((ob >> 9) & 1) << 5)); }
__host__ __device__ __forceinline__ void stage_rc(int b, int& R, int& C) { const int st = b / 1024, sb = b % 1024, swz = sb ^ (((sb >> 9) & 1) << 5); R = (st >> 1) * 16 + swz / 64; C = (st & 1) * 32 + (swz % 64) / 2; }
__host__ __device__ __forceinline__ int perm32(int rho) { const int n = rho >> 4, i = rho & 15; return 8 * (i >> 2) + 4 * n + (i & 3); }

struct Unit { int pm, pn, e, pnl, nvalid, rbase; };

struct Gemm { const bf16_t* A; const bf16_t* Bt; int M, N, K; };

struct StaticOrder {
    int nM, nN, nwg, G, c; PG8_LAS unsigned* gtab = nullptr;
    __host__ __device__ void init(int M, int N, int G_, int c_) { nM = M / BM; nN = N / BM; nwg = nM * nN; G = G_; c = c_; }
    __host__ __device__ bool next(int i, Unit& u) const {
        const long L = (long)i * G + c; if (L >= nwg) return false;
        int wgid = (int)L; { const int q = nwg / NXCD, r = nwg % NXCD, xcd = wgid % NXCD, off = wgid / NXCD; wgid = (xcd < r ? xcd * (q + 1) : r * (q + 1) + (xcd - r) * q) + off; }
        const int nig = WGM * nN, gid = wgid / nig, fm = gid * WGM, gsz = (nM - fm) < WGM ? (nM - fm) : WGM;
        u.pm = fm + ((wgid % nig) % gsz); u.pn = (wgid % nig) / gsz; u.e = 0; u.pnl = u.pn; u.nvalid = BM; u.rbase = 0; return true;
    }
    __device__ __forceinline__ int arow(const Unit&, int) const { return 0; }
    __device__ __forceinline__ void a_ready(const Unit&) const {}
    __device__ __forceinline__ void done(const Unit&) const {}
};

__device__ __forceinline__ unsigned cvt_pk_bf16(float lo, float hi) { unsigned r; asm volatile("v_cvt_pk_bf16_f32 %0, %1, %2" : "=v"(r) : "v"(lo), "v"(hi)); return r; }
typedef float f32x2 __attribute__((ext_vector_type(2)));
__device__ __forceinline__ f32x2 gelu_pk(f32x2 v) {
    const f32x2 av = __builtin_elementwise_abs(v), d = av * 0.2316418882f + 1.0f;
    f32x2 t; t.x = __builtin_amdgcn_rcpf(d.x); t.y = __builtin_amdgcn_rcpf(d.y);
    f32x2 q = t * 0.5307027145f + (-0.7265760135f); q = q * t + 0.7107068705f; q = q * t + (-0.142248368f); q = q * t + 0.127414796f; q = q * t;
    const f32x2 s = (v * v) * (-0.72134752044f);
    f32x2 e; e.x = __builtin_amdgcn_exp2f(s.x); e.y = __builtin_amdgcn_exp2f(s.y);
    const f32x2 m = v * (q * e), r = v - m;
    f32x2 o; o.x = v.x < 0.f ? m.x : r.x; o.y = v.y < 0.f ? m.y : r.y; return o;
}

template <int ACT  > struct EpiBf16 {
    static constexpr int PERM = 1; static constexpr bool AFTER_DRAIN = false; static_assert(ACT == 0 || ACT == 1, "EpiBf16: ACT is 0 (none) or 1 (gelu_pk)");
    static constexpr int NSTORE = PG8_NSTORE(16); static constexpr bool LDSBIAS = false;
    bf16_t* O; int ldc; const float* bias; int split_cols; size_t split_stride; float scale0;
    float ascale = 1.0f;
    int dbg = 0;
    unsigned cmap = 0u;
    float oscale = 0.0f;
    __device__ __forceinline__ void operator()(const f32x4 (&acc)[2][2][4][2], const Unit& u, int wr, int wc, int fr, int fq) const {
        if (dbg == 2) return;
        const int row0 = u.pm * BM + wr * 64 + fr; int colt = (cmap ? (int)((cmap >> (4 * u.pn)) & 15u) : u.pn) * BM; bf16_t* base = O;
        float sc = 1.f; if (split_cols) { const int t = colt / split_cols; base += (size_t)t * split_stride; colt -= t * split_cols; if (t == 0) sc = scale0; }
        const int col0 = colt + wc * 32 + 8 * fq, bcol0 = u.pn * BM + wc * 32 + 8 * fq;
        f32x4 bv[2][2];
#pragma unroll
        for (int bj = 0; bj < 2; ++bj)
#pragma unroll
            for (int n = 0; n < 2; ++n) bv[bj][n] = bias ? *(const f32x4*)(bias + bcol0 + bj * HALF + 4 * n) : (f32x4){0.f, 0.f, 0.f, 0.f};
#pragma unroll
        for (int ai = 0; ai < 2; ++ai)
#pragma unroll
            for (int m = 0; m < 4; ++m) { bf16_t* rowp = base + (size_t)(row0 + ai * HALF + m * 16) * ldc + col0;
#pragma unroll
                for (int bj = 0; bj < 2; ++bj) {
                    if (ACT == 0 && oscale > 0.f) {
                        const float kq = ascale * oscale; f32x4 a, b;
#pragma unroll
                        for (int i = 0; i < 4; ++i) { a[i] = __builtin_amdgcn_fmed3f(__builtin_fmaf(acc[ai][bj][m][0][i], kq, bv[bj][0][i] * oscale), -448.f, 448.f); b[i] = __builtin_amdgcn_fmed3f(__builtin_fmaf(acc[ai][bj][m][1][i], kq, bv[bj][1][i] * oscale), -448.f, 448.f); }
                        int p = 0, q = 0; p = __builtin_amdgcn_cvt_pk_fp8_f32(a[0], a[1], p, false); p = __builtin_amdgcn_cvt_pk_fp8_f32(a[2], a[3], p, true); q = __builtin_amdgcn_cvt_pk_fp8_f32(b[0], b[1], q, false); q = __builtin_amdgcn_cvt_pk_fp8_f32(b[2], b[3], q, true);
                        typedef int i32x2_f __attribute__((ext_vector_type(2))); *(i32x2_f*)((unsigned char*)base + (size_t)(row0 + ai * HALF + m * 16) * ldc + col0 + bj * HALF) = (i32x2_f){p, q}; continue; }
                    f32x4 v0 = acc[ai][bj][m][0] * ascale + bv[bj][0], v1 = acc[ai][bj][m][1] * ascale + bv[bj][1];
                    if (ACT == 1) { f32x2 a = gelu_pk((f32x2){v0[0], v0[1]}), b = gelu_pk((f32x2){v0[2], v0[3]}), c = gelu_pk((f32x2){v1[0], v1[1]}), d = gelu_pk((f32x2){v1[2], v1[3]});
                        v0 = (f32x4){a.x, a.y, b.x, b.y}; v1 = (f32x4){c.x, c.y, d.x, d.y}; }
                    v0 = v0 * sc; v1 = v1 * sc;
                    if (oscale > 0.f) { f32x4 a = v0 * oscale, b = v1 * oscale;
#pragma unroll
                        for (int i = 0; i < 4; ++i) { a[i] = __builtin_fminf(__builtin_fmaxf(a[i], -448.f), 448.f); b[i] = __builtin_fminf(__builtin_fmaxf(b[i], -448.f), 448.f); }
                        int p = 0, q = 0; p = __builtin_amdgcn_cvt_pk_fp8_f32(a[0], a[1], p, false); p = __builtin_amdgcn_cvt_pk_fp8_f32(a[2], a[3], p, true); q = __builtin_amdgcn_cvt_pk_fp8_f32(b[0], b[1], q, false); q = __builtin_amdgcn_cvt_pk_fp8_f32(b[2], b[3], q, true);
                        typedef int i32x2_t __attribute__((ext_vector_type(2))); *(i32x2_t*)((unsigned char*)base + (size_t)(row0 + ai * HALF + m * 16) * ldc + col0 + bj * HALF) = (i32x2_t){p, q}; }
                    else { u32x4 w; w.x = cvt_pk_bf16(v0[0], v0[1]); w.y = cvt_pk_bf16(v0[2], v0[3]); w.z = cvt_pk_bf16(v1[0], v1[1]); w.w = cvt_pk_bf16(v1[2], v1[3]);
                        *(u32x4*)(rowp + bj * HALF) = w; } } }
    }
};

struct EpiFp8 { static constexpr int ACT = 0;
    static constexpr int PERM = 2; static constexpr bool AFTER_DRAIN = false; static constexpr int NSTORE = PG8_NSTORE(8); static constexpr bool LDSBIAS = true;
    __device__ __forceinline__ const float* bias_src(const Unit& u, int wc, int lane) const { return bias + u.pn * BM + wc * 64 + lane; }
    bf16_t* O; int ldc; const float* bias; int split_cols; size_t split_stride; float scale0;
    float ascale = 1.0f;
    int dbg = 0;
    unsigned cmap = 0u;
    float oscale = 0.0f;
    PG8_LAS const float* lbias = nullptr;
    __device__ __forceinline__ void operator()(const f32x4 (&acc)[2][2][4][2], const Unit& u, int wr, int wc, int fr, int fq) const {
        if (dbg == 2) return;
        const int row0 = u.pm * BM + wr * 64 + fr; int colt = (cmap ? (int)((cmap >> (4 * u.pn)) & 15u) : u.pn) * BM; bf16_t* base = O;
        float sc = 1.f; if (split_cols) { const int t = colt / split_cols; base += (size_t)t * split_stride; colt -= t * split_cols; if (t == 0) sc = scale0; }
        const int col0 = colt + wc * 64 + 16 * fq, bcol0 = u.pn * BM + wc * 64 + 16 * fq;
        f32x4 bv[2][2];
#pragma unroll
        for (int bj = 0; bj < 2; ++bj)
#pragma unroll
            for (int n = 0; n < 2; ++n) bv[bj][n] = lbias ? *(const PG8_LAS f32x4*)(lbias + (wr * 4 + wc) * 64 + 16 * fq + 8 * bj + 4 * n) : (bias ? *(const f32x4*)(bias + bcol0 + 8 * bj + 4 * n) : (f32x4){0.f, 0.f, 0.f, 0.f});
#pragma unroll
        for (int ai = 0; ai < 2; ++ai)
#pragma unroll
            for (int m = 0; m < 4; ++m) { const size_t rowoff = (size_t)(row0 + ai * HALF + m * 16) * ldc + col0;
                if (ACT == 0 && oscale > 0.f) {
                    const float kq = ascale * oscale; int w4[4];
#pragma unroll
                    for (int bj = 0; bj < 2; ++bj)
#pragma unroll
                        for (int n = 0; n < 2; ++n) { float a[4];
#pragma unroll
                            for (int p = 0; p < 2; ++p) { const f32x2 t2 = (f32x2){acc[ai][bj][m][n][2 * p], acc[ai][bj][m][n][2 * p + 1]} * kq + (f32x2){bv[bj][n][2 * p], bv[bj][n][2 * p + 1]} * oscale;
                                a[2 * p] = __builtin_amdgcn_fmed3f(t2.x, -448.f, 448.f); a[2 * p + 1] = __builtin_amdgcn_fmed3f(t2.y, -448.f, 448.f); }
                            int p = 0; p = __builtin_amdgcn_cvt_pk_fp8_f32(a[0], a[1], p, false); p = __builtin_amdgcn_cvt_pk_fp8_f32(a[2], a[3], p, true); w4[2 * bj + n] = p; }
                    *(u32x4*)((unsigned char*)base + rowoff) = (u32x4){(unsigned)w4[0], (unsigned)w4[1], (unsigned)w4[2], (unsigned)w4[3]}; continue; }
                u32x4 wo[2];
#pragma unroll
                for (int bj = 0; bj < 2; ++bj) { f32x4 v0 = acc[ai][bj][m][0] * ascale + bv[bj][0], v1 = acc[ai][bj][m][1] * ascale + bv[bj][1];
                    if (ACT == 1) { f32x2 a = gelu_pk((f32x2){v0[0], v0[1]}), b = gelu_pk((f32x2){v0[2], v0[3]}), c = gelu_pk((f32x2){v1[0], v1[1]}), d = gelu_pk((f32x2){v1[2], v1[3]});
                        v0 = (f32x4){a.x, a.y, b.x, b.y}; v1 = (f32x4){c.x, c.y, d.x, d.y}; }
                    v0 = v0 * sc; v1 = v1 * sc;
                    wo[bj].x = cvt_pk_bf16(v0[0], v0[1]); wo[bj].y = cvt_pk_bf16(v0[2], v0[3]); wo[bj].z = cvt_pk_bf16(v1[0], v1[1]); wo[bj].w = cvt_pk_bf16(v1[2], v1[3]); }
                bf16_t* rowp = base + rowoff; *(u32x4*)rowp = wo[0]; *(u32x4*)(rowp + 8) = wo[1]; }
    }
};

struct EpiSwiglu {
    static constexpr int PERM = 1; static constexpr bool AFTER_DRAIN = false; static constexpr int NSTORE = PG8_NSTORE(8); static constexpr bool LDSBIAS = true;
    bf16_t* H; int ldc; const float* bias; int dff; float ascale; float hscale; int dbg = 0;
    PG8_LAS const float* lbias = nullptr;
    __device__ __forceinline__ const float* bias_src(const Unit& u, int wc, int lane) const { return bias + (size_t)u.e * 2 * dff + u.pnl * HALF + wc * 32 + (lane & 31) + ((lane & 32) ? dff : 0); }
    __device__ __forceinline__ void operator()(const f32x4 (&acc)[2][2][4][2], const Unit& u, int wr, int wc, int fr, int fq) const {
        if (dbg == 2) return;
        const int row0 = u.pm * BM + wr * 64 + fr, hc = u.pnl * HALF + wc * 32 + 8 * fq;
        const float* bg = bias + (size_t)u.e * 2 * dff + hc; const float* bu = bg + dff;
        const float hk = hscale > 0.f ? hscale : 1.0f;
        f32x4 bgv[2], buv[2];
#pragma unroll
        for (int n = 0; n < 2; ++n) { if (lbias) { const PG8_LAS float* lb = lbias + (wr * 4 + wc) * 64 + 8 * fq + 4 * n; bgv[n] = *(const PG8_LAS f32x4*)lb; buv[n] = *(const PG8_LAS f32x4*)(lb + 32); }
            else { bgv[n] = *(const f32x4*)(bg + 4 * n); buv[n] = *(const f32x4*)(bu + 4 * n); } }
#pragma unroll
        for (int ai = 0; ai < 2; ++ai)
#pragma unroll
            for (int m = 0; m < 4; ++m) { bf16_t* rowp = H + (size_t)(row0 + ai * HALF + m * 16) * ldc + hc; float o[8];
#pragma unroll
                for (int n = 0; n < 2; ++n)
#pragma unroll
                    for (int p = 0; p < 2; ++p) {
                        const f32x2 g2 = (f32x2){acc[ai][0][m][n][2 * p], acc[ai][0][m][n][2 * p + 1]} * ascale + (f32x2){bgv[n][2 * p], bgv[n][2 * p + 1]};
                        const f32x2 u2 = (f32x2){acc[ai][1][m][n][2 * p], acc[ai][1][m][n][2 * p + 1]} * ascale + (f32x2){buv[n][2 * p], buv[n][2 * p + 1]};
                        f32x2 gt, up; gt.x = __builtin_fminf(g2.x, 7.0f); gt.y = __builtin_fminf(g2.y, 7.0f); up.x = __builtin_amdgcn_fmed3f(u2.x, -7.0f, 7.0f); up.y = __builtin_amdgcn_fmed3f(u2.y, -7.0f, 7.0f);
                        const f32x2 ee = gt * (-1.702f * 1.4426950408889634f);
                        f32x2 den; den.x = __builtin_amdgcn_exp2f(ee.x); den.y = __builtin_amdgcn_exp2f(ee.y); den = den + 1.0f;
                        f32x2 sg; sg.x = __builtin_amdgcn_rcpf(den.x); sg.y = __builtin_amdgcn_rcpf(den.y);
                        const f32x2 r2 = (up * hk + hk) * (gt * sg);
                        o[4 * n + 2 * p] = r2.x; o[4 * n + 2 * p + 1] = r2.y; }
                if (dbg == 1) { if (o[0] == 123.4567f && o[5] == 7.654f) rowp[0] = 1; continue; }
                if (hscale > 0.f) { int a = 0, b = 0; a = __builtin_amdgcn_cvt_pk_fp8_f32(o[0], o[1], a, false); a = __builtin_amdgcn_cvt_pk_fp8_f32(o[2], o[3], a, true);
                    b = __builtin_amdgcn_cvt_pk_fp8_f32(o[4], o[5], b, false); b = __builtin_amdgcn_cvt_pk_fp8_f32(o[6], o[7], b, true);
                    typedef int i32x2_t __attribute__((ext_vector_type(2))); *(i32x2_t*)((unsigned char*)H + (size_t)(row0 + ai * HALF + m * 16) * ldc + hc) = (i32x2_t){a, b}; }
                else { u32x4 w; w.x = cvt_pk_bf16(o[0], o[1]); w.y = cvt_pk_bf16(o[2], o[3]); w.z = cvt_pk_bf16(o[4], o[5]); w.w = cvt_pk_bf16(o[6], o[7]);
                    *(u32x4*)rowp = w; } }
    }
};
struct MoeOrder {
    const PG8_LAS int* tstart; const PG8_LAS int* cnt; const int* rowtok; int nN, G, c, ntok; PG8_LAS unsigned* gtab;
    int xs = 0;
    __device__ __forceinline__ bool next(int i, Unit& u) const {
        int rt, pnl;
        if (G == 256) { const int x = ((c & 7) + xs) & 7, j = c >> 3, per = 32 / nN; rt = (i * 8 + x) * per + j / nN; pnl = j % nN; }
        else { const int L = i * G + c; rt = L / nN; pnl = L % nN; }
        const int TR = tstart[32]; if (rt >= TR) return false;
        const int ln_ = (int)__builtin_amdgcn_mbcnt_hi(~0u, __builtin_amdgcn_mbcnt_lo(~0u, 0u));
        const int tv_ = tstart[(ln_ & 31) + 1];
        const unsigned long long bal_ = __ballot((ln_ < 31) && (tv_ <= rt));
        int e = __builtin_amdgcn_readfirstlane((int)__popcll(bal_));
        const int lt = rt - tstart[e]; int nv = cnt[e] - lt * BM; nv = nv > BM ? BM : nv;
        u.pm = rt; u.pn = e * nN + pnl; u.e = e; u.pnl = pnl; u.nvalid = __builtin_amdgcn_readfirstlane(nv); u.rbase = __builtin_amdgcn_readfirstlane(e * ntok + lt * BM); return true;
    }
    __device__ __forceinline__ int arow(const Unit& u, int r) const { return rowtok[u.rbase + ((r < u.nvalid) ? r : 0)]; }
    __device__ __forceinline__ const int* aptr(const Unit& u, int r) const { return rowtok + u.rbase + ((r < u.nvalid) ? r : 0); }
    __device__ __forceinline__ void a_ready(const Unit&) const {}
    __device__ __forceinline__ void done(const Unit&) const {}
};

struct PanelStats {
    unsigned* xbuf;
    unsigned* cnt;
    unsigned* tmo;
    int ntn; float eps;
    unsigned code;
    __device__ __forceinline__ bool run(const f32x4 (&v)[2][2][4][2], const Unit& u, int wr, int wc, int fr, int fq, PG8_LAS unsigned char* lds, int wid, int lane) const {
        typedef float f32x2v __attribute__((ext_vector_type(2)));
        PG8_LAS f32x2v* P = (PG8_LAS f32x2v*)lds;
        PG8_LAS f32x2v* S = (PG8_LAS f32x2v*)(lds + 8192);
        PG8_LAS unsigned* flag = (PG8_LAS unsigned*)(lds + 8192 + 2048);
#pragma unroll
        for (int ai = 0; ai < 2; ++ai)
#pragma unroll
            for (int m = 0; m < 4; ++m) {
                float s = 0.f;
#pragma unroll
                for (int bj = 0; bj < 2; ++bj)
#pragma unroll
                    for (int n = 0; n < 2; ++n) { const f32x4 x = v[ai][bj][m][n]; s += (x[0] + x[1]) + (x[2] + x[3]); }
                s += __shfl_xor(s, 16); s += __shfl_xor(s, 32);
                const float mw = s * (1.0f / 64.0f); float q = 0.f;
#pragma unroll
                for (int bj = 0; bj < 2; ++bj)
#pragma unroll
                    for (int n = 0; n < 2; ++n) { const f32x4 d = v[ai][bj][m][n] - mw; q += (d[0] * d[0] + d[1] * d[1]) + (d[2] * d[2] + d[3] * d[3]); }
                q += __shfl_xor(q, 16); q += __shfl_xor(q, 32);
                if (fq == 0) P[(ai * HALF + wr * 64 + m * 16 + fr) * 4 + wc] = (f32x2v){mw, q};
            }
        asm volatile("s_waitcnt lgkmcnt(0)" ::: "memory"); __builtin_amdgcn_s_barrier(); asm volatile("" ::: "memory");
#if defined(BROKEN_EXCHANGE_NO_WAIT)
#warning BROKEN CONTROL BUILD: the row-statistics exchange does not wait; results are wrong by design
        if (blockIdx.x >= 64) { const long long t0_ = clock64(); while (clock64() - t0_ < 60000) __builtin_amdgcn_s_sleep(8); }
#endif
        const int row = wid * 32 + (lane & 31);
        if (lane < 32) {
            const f32x2v a = P[row * 4 + 0], b = P[row * 4 + 1], c = P[row * 4 + 2], d = P[row * 4 + 3];
            const float mt = (a.x + b.x + c.x + d.x) * 0.25f;
            const float da = a.x - mt, db = b.x - mt, dc = c.x - mt, dd = d.x - mt;
            const float m2 = (a.y + b.y) + (c.y + d.y) + 64.0f * ((da * da + db * db) + (dc * dc + dd * dd));
            unsigned long long* slot = (unsigned long long*)xbuf + ((size_t)(u.pm * BM + row) * 4 + u.pn);
            __hip_atomic_store(slot, ((unsigned long long)__float_as_uint(m2) << 32) | __float_as_uint(mt), __ATOMIC_RELAXED, __HIP_MEMORY_SCOPE_AGENT);
        }
        asm volatile("s_waitcnt vmcnt(0)" ::: "memory");
        if (lane == 0) __hip_atomic_fetch_add(cnt + 64 * u.pm, 1u, __ATOMIC_RELAXED, __HIP_MEMORY_SCOPE_AGENT);
        if (wid == 0) {
            bool dead = false; const unsigned long long t0 = __builtin_amdgcn_s_memrealtime(); const unsigned want = 8u * (unsigned)ntn;
            for (;;) {
#if defined(BROKEN_EXCHANGE_NO_WAIT)
                break;
#endif
                if ((unsigned)__builtin_amdgcn_readfirstlane(__hip_atomic_load(cnt + 64 * u.pm, __ATOMIC_RELAXED, __HIP_MEMORY_SCOPE_AGENT)) >= want) break;
                if (__builtin_amdgcn_s_memrealtime() - t0 > 2000000ull) {
                    if (lane == 0) { unsigned expect = 0u; __hip_atomic_compare_exchange_strong(tmo + 1, &expect, code | (unsigned)(u.pm & 0xff), __ATOMIC_RELAXED, __ATOMIC_RELAXED, __HIP_MEMORY_SCOPE_AGENT);
                                     __hip_atomic_store(tmo, 1u, __ATOMIC_RELAXED, __HIP_MEMORY_SCOPE_AGENT); }
                    dead = true; break; }
                __builtin_amdgcn_s_sleep(2);
            }
            __builtin_amdgcn_fence(__ATOMIC_ACQUIRE, "agent");
            if (lane == 0) flag[0] = dead ? 1u : 0u;
        }
        asm volatile("s_waitcnt vmcnt(0) lgkmcnt(0)" ::: "memory"); __builtin_amdgcn_s_barrier(); asm volatile("" ::: "memory");
        const bool bad = flag[0] != 0u;
        if (lane < 32) {
            const unsigned long long* slot = (const unsigned long long*)xbuf + (size_t)(u.pm * BM + row) * 4; float mt[4], m2[4]; float ms = 0.f;
#pragma unroll
            for (int t = 0; t < 4; ++t) { if (t < ntn) { const unsigned long long w = __hip_atomic_load(slot + t, __ATOMIC_RELAXED, __HIP_MEMORY_SCOPE_AGENT); mt[t] = __uint_as_float((unsigned)w); m2[t] = __uint_as_float((unsigned)(w >> 32)); } else { mt[t] = 0.f; m2[t] = 0.f; } ms += mt[t]; }
            const float mean = ms / (float)ntn; float q = 0.f;
#pragma unroll
            for (int t = 0; t < 4; ++t) if (t < ntn) { const float dm = mt[t] - mean; q += m2[t] + 256.0f * dm * dm; }
            S[row] = (f32x2v){mean, 1.0f / sqrtf(q / (256.0f * (float)ntn) + eps)};
        }
        asm volatile("s_waitcnt lgkmcnt(0)" ::: "memory"); __builtin_amdgcn_s_barrier(); asm volatile("" ::: "memory");
        return bad;
    }
};
struct EpiLnRes {
    static constexpr int PERM = 0; static constexpr bool AFTER_DRAIN = true; static constexpr int NSTORE = 0; static constexpr bool LDSBIAS = false;
    const float* base; float* out; int ldc; const float* bias; PanelStats st; unsigned poison;
    __device__ __forceinline__ void fused(f32x4 (&acc)[2][2][4][2], const Unit& u, int wr, int wc, int fr, int fq, PG8_LAS unsigned char* lds, int wid, int lane) const {
        typedef float f32x2v __attribute__((ext_vector_type(2)));
        const PG8_LAS f32x2v* S = (const PG8_LAS f32x2v*)(lds + 8192);
        const int col0 = u.pn * BM + wc * 32 + 4 * fq;
#pragma unroll
        for (int bj = 0; bj < 2; ++bj)
#pragma unroll
            for (int n = 0; n < 2; ++n) { const f32x4 bv = bias ? *(const f32x4*)(bias + col0 + bj * HALF + n * 16) : (f32x4){0.f, 0.f, 0.f, 0.f};
#pragma unroll
                for (int ai = 0; ai < 2; ++ai)
#pragma unroll
                    for (int m = 0; m < 4; ++m) acc[ai][bj][m][n] += bv; }
        f32x4 pre[4][2][2];
#pragma unroll
        for (int m = 0; m < 4; ++m) { const size_t off = (size_t)(u.pm * BM + wr * 64 + m * 16 + fr) * ldc + col0;
#pragma unroll
            for (int bj = 0; bj < 2; ++bj)
#pragma unroll
                for (int n = 0; n < 2; ++n) pre[m][bj][n] = *(const f32x4*)(base + off + bj * HALF + n * 16); }
        const bool bad = st.run(acc, u, wr, wc, fr, fq, lds, wid, lane) || poison != 0u;
        const float qnan = __builtin_nanf("");
#pragma unroll
        for (int ai = 0; ai < 2; ++ai)
#pragma unroll
            for (int m = 0; m < 4; ++m) { const int r = ai * HALF + wr * 64 + m * 16 + fr; const f32x2v sr = S[r]; const size_t off = (size_t)(u.pm * BM + r) * ldc + col0;
#pragma unroll
                for (int bj = 0; bj < 2; ++bj)
#pragma unroll
                    for (int n = 0; n < 2; ++n) { const f32x4 bs = ai == 0 ? pre[m][bj][n] : *(const f32x4*)(base + off + bj * HALF + n * 16); f32x4 o = bs + (acc[ai][bj][m][n] - sr.x) * sr.y;
                        if (bad) o = (f32x4){qnan, qnan, qnan, qnan}; *(f32x4*)(out + off + bj * HALF + n * 16) = o; }
                if (m & 1) asm volatile("" ::: "memory"); }
    }
};
struct EpiLnResLn {
    static constexpr int PERM = 0; static constexpr bool AFTER_DRAIN = true; static constexpr int NSTORE = 0; static constexpr bool LDSBIAS = false;
    const float* base; float* out; bf16_t* xn; int ldc; const float* bias; PanelStats st1, st2; unsigned poison;
    __device__ __forceinline__ void fused(f32x4 (&acc)[2][2][4][2], const Unit& u, int wr, int wc, int fr, int fq, PG8_LAS unsigned char* lds, int wid, int lane) const {
        typedef float f32x2v __attribute__((ext_vector_type(2))); typedef unsigned u32x2v __attribute__((ext_vector_type(2)));
        const PG8_LAS f32x2v* S = (const PG8_LAS f32x2v*)(lds + 8192);
        const int col0 = u.pn * BM + wc * 32 + 4 * fq;
#pragma unroll
        for (int bj = 0; bj < 2; ++bj)
#pragma unroll
            for (int n = 0; n < 2; ++n) { const f32x4 bv = bias ? *(const f32x4*)(bias + col0 + bj * HALF + n * 16) : (f32x4){0.f, 0.f, 0.f, 0.f};
#pragma unroll
                for (int ai = 0; ai < 2; ++ai)
#pragma unroll
                    for (int m = 0; m < 4; ++m) acc[ai][bj][m][n] += bv; }
        bool bad = st1.run(acc, u, wr, wc, fr, fq, lds, wid, lane) || poison != 0u;
        const float qnan = __builtin_nanf("");
#pragma unroll
        for (int ai = 0; ai < 2; ++ai)
#pragma unroll
            for (int m = 0; m < 4; ++m) { const int r = ai * HALF + wr * 64 + m * 16 + fr; const f32x2v sr = S[r]; const size_t off = (size_t)(u.pm * BM + r) * ldc + col0;
#pragma unroll
                for (int bj = 0; bj < 2; ++bj)
#pragma unroll
                    for (int n = 0; n < 2; ++n) { const f32x4 bs = *(const f32x4*)(base + off + bj * HALF + n * 16); acc[ai][bj][m][n] = bs + (acc[ai][bj][m][n] - sr.x) * sr.y; }
                asm volatile("" : "+v"(acc[ai][0][m][0]), "+v"(acc[ai][0][m][1]), "+v"(acc[ai][1][m][0]), "+v"(acc[ai][1][m][1]));
                if (m & 1) asm volatile("" ::: "memory"); }
        const bool bad1 = bad;
        bad = st2.run(acc, u, wr, wc, fr, fq, lds, wid, lane) || bad;
#pragma unroll
        for (int ai = 0; ai < 2; ++ai)
#pragma unroll
            for (int m = 0; m < 4; ++m) { const int r = ai * HALF + wr * 64 + m * 16 + fr; const f32x2v sr = S[r]; const size_t off = (size_t)(u.pm * BM + r) * ldc + col0;
#pragma unroll
                for (int bj = 0; bj < 2; ++bj)
#pragma unroll
                    for (int n = 0; n < 2; ++n) { const f32x4 x1 = acc[ai][bj][m][n]; *(f32x4*)(out + off + bj * HALF + n * 16) = bad1 ? (f32x4){qnan, qnan, qnan, qnan} : x1;
                        const f32x4 o = (x1 - sr.x) * sr.y; u32x2v w; w.x = cvt_pk_bf16(o[0], o[1]); w.y = cvt_pk_bf16(o[2], o[3]);
                        if (bad) { w.x = 0x7fc07fc0u; w.y = 0x7fc07fc0u; } *(u32x2v*)(xn + off + bj * HALF + n * 16) = w; }
                asm volatile("" ::: "memory"); }
    }
};

template <class Epi, class Sched, bool ALIGN_EPI = false, bool SP2 = false, bool GATHER = false, bool FP8 = false>
__device__ __forceinline__ void gemm_phase(PG8_LAS unsigned char* lds, const Gemm g, const Sched& S, const Epi& E) {
    static_assert(!GATHER || SP2, "the gathered-A variant is written for the SP2 loop only");
    int tid_ = threadIdx.x; asm volatile("" : "+v"(tid_));
    const int tid = tid_, wid = __builtin_amdgcn_readfirstlane(tid >> 6), lane = tid & 63, wr = wid >> 2, wc = wid & 3, fr = lane & 15, fq = lane >> 4;
    const int K = g.K, nt = K / BK;
    unsigned voffA[2], voffB[2], voffB2[2][2];
#pragma unroll
    for (int i = 0; i < 2; ++i) { int R, C; stage_rc(tid * 16 + i * 8192, R, C); const int Rb = (Epi::PERM == 1) ? ((R & ~31) + perm32(R & 31)) : R;
        voffA[i] = (unsigned)(R * K + C) * 2u; voffB[i] = (unsigned)(Rb * K + C) * 2u;
        { const int rho = R & 31, n_ = rho >> 4, fq_ = (rho & 15) >> 2, i_ = rho & 3; const int r2 = (Epi::PERM == 3) ? (64 * (R >> 5) + 8 * fq_ + 4 * n_ + i_) : (64 * (R >> 5) + 16 * fq_ + 4 * n_ + i_), hs = (Epi::PERM == 3) ? 32 : 8;
          voffB2[0][i] = (unsigned)(r2 * K + C) * 2u; voffB2[1][i] = (unsigned)((r2 + hs) * K + C) * 2u; } }
#define PG8_GOFF(slot, u) do { int tq_ = threadIdx.x; asm volatile("" : "+v"(tq_)); int gR[2], gC[2]; stage_rc(tq_ * 16, gR[0], gC[0]); stage_rc(tq_ * 16 + 8192, gR[1], gC[1]);     \
        PG8_LAS unsigned* gt_ = S.gtab + (slot) * 2048 + wid * 64;     \
        __builtin_amdgcn_global_load_lds((const unsigned*)S.aptr(u, gR[0]), gt_, 4, 0, 0); __builtin_amdgcn_global_load_lds((const unsigned*)S.aptr(u, gR[1]), gt_ + 512, 4, 0, 0); \
        __builtin_amdgcn_global_load_lds((const unsigned*)S.aptr(u, HALF + gR[0]), gt_ + 1024, 4, 0, 0); __builtin_amdgcn_global_load_lds((const unsigned*)S.aptr(u, HALF + gR[1]), gt_ + 1536, 4, 0, 0); } while (0)
    unsigned gcb[2] = {0u, 0u};
    if constexpr (GATHER) { int r_, c_; stage_rc(tid * 16, r_, c_); gcb[0] = (unsigned)c_ * 2u; stage_rc(tid * 16 + 8192, r_, c_); gcb[1] = (unsigned)c_ * 2u; }
    const unsigned rowB = (unsigned)K * 2u;
    const size_t kstep = (size_t)(BK * 2);
    const size_t hstep = (size_t)HALF * K * 2;
    const size_t tstep = 2 * hstep;
    const unsigned ldsw = (unsigned)wid * 1024u;
    const int aoff = lds_byte(wr * 64 + fr, fq * 8), boff = lds_byte(wc * 32 + fr, fq * 8);
#define PG8_SA(b, h) (((b) * 2 + (h)) * HTB)
#define PG8_SB(b, h) ((4 + (b) * 2 + (h)) * HTB)
#define PG8_STAGE(bufoff, gbase, voff) do { _Pragma("unroll") for (int _i = 0; _i < 2; ++_i) \
        __builtin_amdgcn_global_load_lds((const unsigned*)((const char*)(gbase) + (voff)[_i]), (PG8_LAS unsigned*)(lds + (bufoff) + ldsw + _i * 8192), 16, 0, 0); } while (0)
#define PG8_STAGE_B(bufoff, gbase, h) do { if constexpr (Epi::PERM >= 2) PG8_STAGE(bufoff, gbase, voffB2[h]); else PG8_STAGE(bufoff, (gbase) + (size_t)(h) * hstep, voffB); } while (0)
#define PG8_LDA(dst, b, h) do { _Pragma("unroll") for (int m = 0; m < 4; ++m) { if constexpr (FP8) { dst##8[m].lo = *(const PG8_LAS i32x4_t*)(lds + PG8_SA(b, h) + aoff + m * 2048); dst##8[m].hi = *(const PG8_LAS i32x4_t*)(lds + PG8_SA(b, h) + aoff + m * 2048 + 1024); } \
        else { _Pragma("unroll") for (int k = 0; k < 2; ++k) dst[m][k] = *(const PG8_LAS bf16x8*)(lds + PG8_SA(b, h) + aoff + m * 2048 + k * 1024); } } } while (0)
#define PG8_LDB(dst, b, h) do { _Pragma("unroll") for (int n = 0; n < 2; ++n) { if constexpr (FP8) { dst##8[n].lo = *(const PG8_LAS i32x4_t*)(lds + PG8_SB(b, h) + boff + n * 2048); dst##8[n].hi = *(const PG8_LAS i32x4_t*)(lds + PG8_SB(b, h) + boff + n * 2048 + 1024); } \
        else { _Pragma("unroll") for (int k = 0; k < 2; ++k) dst[n][k] = *(const PG8_LAS bf16x8*)(lds + PG8_SB(b, h) + boff + n * 2048 + k * 1024); } } } while (0)
#define PG8_MMA(ai, bj, At, Bt) do { __builtin_amdgcn_s_setprio(1); \
        if constexpr (FP8) { _Pragma("unroll") for (int m = 0; m < 4; ++m) _Pragma("unroll") for (int n = 0; n < 2; ++n) \
            asm volatile("v_mfma_scale_f32_16x16x128_f8f6f4 %0, %1, %2, %0, %3, %3 op_sel_hi:[0,0,0]" : "+v"(acc[ai][bj][m][n]) : "v"(Bt##8[n]), "v"(At##8[m]), "v"(sc7f)); } \
        else { _Pragma("unroll") for (int m = 0; m < 4; ++m) _Pragma("unroll") for (int n = 0; n < 2; ++n) _Pragma("unroll") for (int k = 0; k < 2; ++k) \
            acc[ai][bj][m][n] = __builtin_amdgcn_mfma_f32_16x16x32_bf16(Bt[n][k], At[m][k], acc[ai][bj][m][n], 0, 0, 0); } \
        __builtin_amdgcn_s_setprio(0); } while (0)
#define PG8_WAIT_V(n) asm volatile("s_waitcnt vmcnt(" #n ")" ::: "memory")
#define PG8_WAIT_V1 do { if (t != 0 || xtra == 0) PG8_WAIT_V(8); else if (xtra == 1) PG8_WAIT_V(9); else if (xtra == 5) PG8_WAIT_V(13); else if (xtra == 9) PG8_WAIT_V(17); else if (xtra == 13) PG8_WAIT_V(21); \
        else if (xtra == 16) PG8_WAIT_V(24); else if (xtra == 8) PG8_WAIT_V(16); else if (xtra == 12) PG8_WAIT_V(20); else if (xtra == 4) PG8_WAIT_V(12); else PG8_WAIT_V(8); } while (0)
#define PG8_WAIT_L(n) asm volatile("s_waitcnt lgkmcnt(" #n ")" ::: "memory")
#define PG8_BAR __builtin_amdgcn_s_barrier()
#define PG8_SCHED __builtin_amdgcn_sched_barrier(0)
    Unit cur, nxt; int ui = 0;
    if (!S.next(0, cur)) return;
    f32x4 acc[2][2][4][2];
#pragma unroll
    for (int a = 0; a < 2; ++a)
#pragma unroll
        for (int b = 0; b < 2; ++b)
#pragma unroll
            for (int m = 0; m < 4; ++m)
#pragma unroll
                for (int n = 0; n < 2; ++n) acc[a][b][m][n] = (f32x4){0.f, 0.f, 0.f, 0.f};
    bf16x8 At[4][2], B0[2][2], B1[2][2]; i32x8_t At8[4], B08[2], B18[2];
    int sc7f = 0x7f7f7f7f; asm volatile("" : "+v"(sc7f));
    const char* cA = (const char*)g.A + (GATHER ? (size_t)0 : (size_t)cur.pm * tstep); const char* cB = (const char*)g.Bt + (size_t)cur.pn * tstep;
    S.a_ready(cur);
    int gslot = 0;
    if constexpr (GATHER) { PG8_GOFF(0, cur); PG8_WAIT_V(0); }
    const size_t hA = GATHER ? (size_t)0 : hstep;
#define PG8_STAGE_A(bufoff, gbase, h, sl) do { if constexpr (GATHER) { const PG8_LAS unsigned* gt_ = S.gtab + (sl) * 2048 + (h) * 1024 + tid; const unsigned o_[2] = {gt_[0] * rowB + gcb[0], gt_[512] * rowB + gcb[1]}; PG8_STAGE(bufoff, gbase, o_); } \
        else PG8_STAGE(bufoff, (gbase) + (size_t)(h) * hA, voffA); } while (0)
    if constexpr (SP2) {
        PG8_STAGE_B(PG8_SB(0, 0), cB, 0); PG8_STAGE_B(PG8_SB(0, 1), cB, 1); PG8_STAGE_A(PG8_SA(0, 0), cA, 0, 0); PG8_STAGE_A(PG8_SA(0, 1), cA, 1, 0);
        if (wr == 1) PG8_BAR;
        PG8_WAIT_V(2); PG8_BAR;
        PG8_STAGE_B(PG8_SB(1, 0), cB + kstep, 0); PG8_STAGE_A(PG8_SA(1, 0), cA + kstep, 0, 0); PG8_STAGE_B(PG8_SB(1, 1), cB + kstep, 1);
        PG8_WAIT_V(6); PG8_BAR;
    } else {
        PG8_STAGE_B(PG8_SB(0, 0), cB, 0); PG8_STAGE(PG8_SA(0, 0), cA, voffA); PG8_STAGE_B(PG8_SB(0, 1), cB, 1); PG8_STAGE(PG8_SA(0, 1), cA + hstep, voffA);
        if (wr == 1) PG8_BAR;
        PG8_WAIT_V(4); PG8_BAR;
        PG8_STAGE_B(PG8_SB(1, 0), cB + kstep, 0); PG8_STAGE(PG8_SA(1, 0), cA + kstep, voffA); PG8_STAGE_B(PG8_SB(1, 1), cB + kstep, 1);
        PG8_WAIT_V(6); PG8_BAR;
    }
    for (;;) {
        const bool has_next = S.next(ui + 1, nxt);
        const char* nA = (has_next && !GATHER) ? (const char*)g.A + (size_t)nxt.pm * tstep : cA; const char* nB = has_next ? (const char*)g.Bt + (size_t)nxt.pn * tstep : cB;
        if constexpr (GATHER) { if (has_next) PG8_GOFF(gslot ^ 1, nxt); }
        bool lbp = false;
        if constexpr (Epi::LDSBIAS) { if (E.lbias) { lbp = true; __builtin_amdgcn_global_load_lds((const unsigned*)E.bias_src(cur, wc, lane), (PG8_LAS unsigned*)(E.lbias + wid * 64), 4, 0, 0); } }
        const int xtra = ((ui > 0 && E.dbg == 0) ? Epi::NSTORE : 0) + ((GATHER && has_next) ? 4 : 0) + (lbp ? 1 : 0);
#pragma unroll 1
        for (int t = 0; t < nt; t += 2) {
            const bool last = (t == nt - 2);
            const char* a1 = cA + (size_t)(t + 1) * kstep;
            const char* a2 = last ? nA : cA + (size_t)(t + 2) * kstep; const char* b2 = last ? nB : cB + (size_t)(t + 2) * kstep;
            const char* a3 = a2 + kstep; const char* b3 = b2 + kstep;
            if (last && has_next) S.a_ready(nxt);
            const int gnx = (last && has_next) ? (gslot ^ 1) : gslot;
            if constexpr (SP2) {
            PG8_LDB(B0, 0, 0); PG8_LDB(B1, 0, 1); PG8_SCHED; PG8_LDA(At, 0, 0); PG8_STAGE_A(PG8_SA(1, 1), a1, 1, gslot);
            PG8_WAIT_V1;
            PG8_WAIT_L(0); PG8_BAR; PG8_MMA(0, 0, At, B0); PG8_MMA(0, 1, At, B1); PG8_BAR; PG8_SCHED;
            PG8_LDA(At, 0, 1); PG8_STAGE_B(PG8_SB(0, 0), b2, 0); PG8_STAGE_B(PG8_SB(0, 1), b2, 1); PG8_STAGE_A(PG8_SA(0, 0), a2, 0, gnx);
            PG8_WAIT_V1;
            PG8_WAIT_L(0); PG8_BAR; PG8_MMA(1, 0, At, B0); PG8_MMA(1, 1, At, B1); PG8_BAR; PG8_SCHED;
            PG8_LDB(B0, 1, 0); PG8_LDB(B1, 1, 1); PG8_SCHED; PG8_LDA(At, 1, 0); PG8_STAGE_A(PG8_SA(0, 1), a2, 1, gnx);
            PG8_WAIT_V(8); PG8_WAIT_L(0); PG8_BAR; PG8_MMA(0, 0, At, B0); PG8_MMA(0, 1, At, B1); PG8_BAR; PG8_SCHED;
            PG8_LDA(At, 1, 1); PG8_STAGE_B(PG8_SB(1, 0), b3, 0); PG8_STAGE_B(PG8_SB(1, 1), b3, 1); PG8_STAGE_A(PG8_SA(1, 0), a3, 0, gnx);
            PG8_WAIT_V(8); PG8_WAIT_L(0); PG8_BAR; PG8_MMA(1, 0, At, B0); PG8_MMA(1, 1, At, B1); PG8_BAR; PG8_SCHED;
            } else {
            PG8_LDB(B0, 0, 0); PG8_SCHED; PG8_LDA(At, 0, 0); PG8_STAGE(PG8_SA(1, 1), a1 + hstep, voffA);
            PG8_WAIT_L(8); PG8_BAR; PG8_WAIT_L(0); PG8_MMA(0, 0, At, B0); PG8_BAR; PG8_SCHED;
            PG8_LDB(B1, 0, 1); PG8_STAGE_B(PG8_SB(0, 0), b2, 0);
            PG8_BAR; PG8_WAIT_L(0); PG8_MMA(0, 1, At, B1); PG8_BAR;
            PG8_LDA(At, 0, 1); PG8_STAGE(PG8_SA(0, 0), a2, voffA);
            PG8_BAR; PG8_WAIT_L(0); PG8_MMA(1, 0, At, B0); PG8_BAR; PG8_SCHED;
            PG8_STAGE_B(PG8_SB(0, 1), b2, 1);
            PG8_WAIT_V(6); PG8_BAR; PG8_MMA(1, 1, At, B1); PG8_BAR;
            PG8_LDB(B0, 1, 0); PG8_SCHED; PG8_LDA(At, 1, 0); PG8_STAGE(PG8_SA(0, 1), a2 + hstep, voffA);
            PG8_WAIT_L(8); PG8_BAR; PG8_WAIT_L(0); PG8_MMA(0, 0, At, B0); PG8_BAR; PG8_SCHED;
            PG8_LDB(B1, 1, 1); PG8_STAGE_B(PG8_SB(1, 0), b3, 0);
            PG8_BAR; PG8_WAIT_L(0); PG8_MMA(0, 1, At, B1); PG8_BAR;
            PG8_LDA(At, 1, 1); PG8_STAGE(PG8_SA(1, 0), a3, voffA);
            PG8_BAR; PG8_WAIT_L(0); PG8_MMA(1, 0, At, B0); PG8_BAR; PG8_SCHED;
            PG8_STAGE_B(PG8_SB(1, 1), b3, 1);
            PG8_WAIT_V(6); PG8_BAR; PG8_MMA(1, 1, At, B1); PG8_BAR;
            }
        }
        if constexpr (ALIGN_EPI) { if (wr == 0) PG8_BAR; }
        if constexpr (FP8) asm volatile("s_nop 15\n\ts_nop 15" ::: "memory");
        if constexpr (!Epi::AFTER_DRAIN) { E(acc, cur, wr, wc, fr, fq); S.done(cur); }
        if (!has_next) break;
#pragma unroll
        for (int a = 0; a < 2; ++a)
#pragma unroll
            for (int b = 0; b < 2; ++b)
#pragma unroll
                for (int m = 0; m < 4; ++m)
#pragma unroll
                    for (int n = 0; n < 2; ++n) acc[a][b][m][n] = (f32x4){0.f, 0.f, 0.f, 0.f};
        cur = nxt; cA = nA; cB = nB; ++ui;
        gslot ^= 1;
        if constexpr (ALIGN_EPI) { if (wr == 1) PG8_BAR; }
    }
    PG8_WAIT_V(0);
    if constexpr (!ALIGN_EPI) { if (wr == 0) PG8_BAR; }
    PG8_BAR;
    if constexpr (Epi::AFTER_DRAIN) { E.fused(acc, cur, wr, wc, fr, fq, lds, wid, lane); S.done(cur); }
#undef PG8_SA
#undef PG8_GOFF
#undef PG8_STAGE_A
#undef PG8_SB
#undef PG8_STAGE
#undef PG8_STAGE_B
#undef PG8_LDA
#undef PG8_LDB
#undef PG8_MMA
#undef PG8_WAIT_V
#undef PG8_WAIT_V1
#undef PG8_WAIT_L
#undef PG8_BAR
#undef PG8_SCHED
}
}
#include <hip/hip_bf16.h>
#include <cmath>
namespace attn_body {
using bf16=__hip_bfloat16;
using bf16x8=__attribute__((ext_vector_type(8)))short;
using s16x4=__attribute__((ext_vector_type(4)))short;
using f32x16=__attribute__((ext_vector_type(16)))float;
using u32x4=__attribute__((ext_vector_type(4)))unsigned;
constexpr int SEQ=4096,D=64,PIN=3072,PO=1024;
constexpr int NW=8,QBLK=32,QB=QBLK*NW,KVBLK=64,NQB=SEQ/QB;
constexpr int ATTN_UNIT_ROWS=QB;
__device__ __forceinline__ int crow(int r,int hi){return (r&3)+8*(r>>2)+4*hi;}
#define SBAR() __builtin_amdgcn_sched_barrier(0)
__device__ __forceinline__ void cmask(f32x16&p0,f32x16&p1,int jb,int qrel,int hi){
  const float NEG=-INFINITY; int kb=64*jb+4*hi;
  #pragma unroll
  for(int r=0;r<16;++r){int kv=kb+(r&3)+8*(r>>2); if(kv>qrel)p0[r]=NEG; if(kv+32>qrel)p1[r]=NEG;}
}

constexpr int NSLOT=3, SLOTB=8192;
constexpr int LDS_K=0, LDS_V=NSLOT*SLOTB, LDS_V2=2*NSLOT*SLOTB, LDS_WS=3*NSLOT*SLOTB, LDS_OST=LDS_WS+NW*64*4, LDS_BYTES=LDS_OST+NW*4096;
constexpr float C2=0.125f*1.4426950408889634f;
__device__ __forceinline__ void glds16(const void*gsrc,unsigned lds_dst){unsigned keep;
  asm volatile("s_mov_b32 %0, m0\n\ts_mov_b32 m0, %2\n\ts_nop 0\n\tglobal_load_lds_dwordx4 %1, off\n\ts_mov_b32 m0, %0":"=&s"(keep):"v"(gsrc),"s"(lds_dst):"memory");}
__device__ __forceinline__ float max3f(float a,float b,float c){float r;asm("v_max3_f32 %0, %1, %2, %3":"=v"(r):"v"(a),"v"(b),"v"(c));return r;}
__device__ __forceinline__ float max2f(float a,float b){float r;asm("v_max_f32_e32 %0, %1, %2":"=v"(r):"v"(a),"v"(b));return r;}
__device__ __forceinline__ float fadd_s(float a,float b){float r;asm("v_add_f32_e32 %0, %1, %2":"=v"(r):"v"(a),"v"(b));return r;}
__device__ __forceinline__ float fsub_s(float a,float b){float r;asm("v_sub_f32_e32 %0, %1, %2":"=v"(r):"v"(a),"v"(b));return r;}
typedef float f32x2_t __attribute__((ext_vector_type(2))); typedef __bf16 bf16x2_t __attribute__((ext_vector_type(2)));
__device__ __forceinline__ unsigned cvtpk_s(float lo,float hi){f32x2_t v={lo,hi};bf16x2_t b=__builtin_convertvector(v,bf16x2_t);return __builtin_bit_cast(unsigned,b);}
#define WAIT_BAR(N) asm volatile("s_waitcnt vmcnt(" #N ") lgkmcnt(0)\n\ts_barrier":::"memory")

__device__ __forceinline__ void qkt(f32x16&p0,f32x16&p1,const char*Kslot,const bf16x8*qr,const f32x16&negm,int r32,int hi){
  const char*kb=Kslot+hi*1024+r32*16;
  #pragma unroll
  for(int d0=0;d0<4;++d0){
    const bf16x8 b0=*reinterpret_cast<const bf16x8*>(kb+d0*2048);
    const bf16x8 b1=*reinterpret_cast<const bf16x8*>(kb+d0*2048+512);
    if(d0==0){p0=__builtin_amdgcn_mfma_f32_32x32x16_bf16(b0,qr[0],negm,0,0,0);p1=__builtin_amdgcn_mfma_f32_32x32x16_bf16(b1,qr[0],negm,0,0,0);}
    else{p0=__builtin_amdgcn_mfma_f32_32x32x16_bf16(b0,qr[d0],p0,0,0,0);p1=__builtin_amdgcn_mfma_f32_32x32x16_bf16(b1,qr[d0],p1,0,0,0);}}
}
typedef __attribute__((address_space(3))) const char* lds_cptr;
typedef short v4i16_t __attribute__((ext_vector_type(4)));
__device__ __forceinline__ void kload8(bf16x8*kf,lds_cptr kp){
  kf[0]=*(const __attribute__((address_space(3))) bf16x8*)(kp);      kf[1]=*(const __attribute__((address_space(3))) bf16x8*)(kp+512);
  kf[2]=*(const __attribute__((address_space(3))) bf16x8*)(kp+2048); kf[3]=*(const __attribute__((address_space(3))) bf16x8*)(kp+2560);
  kf[4]=*(const __attribute__((address_space(3))) bf16x8*)(kp+4096); kf[5]=*(const __attribute__((address_space(3))) bf16x8*)(kp+4608);
  kf[6]=*(const __attribute__((address_space(3))) bf16x8*)(kp+6144); kf[7]=*(const __attribute__((address_space(3))) bf16x8*)(kp+6656);
}
__device__ __forceinline__ void kload2(bf16x8*kf,lds_cptr kp,int j){ kf[2*j]=*(const __attribute__((address_space(3))) bf16x8*)(kp+j*2048); kf[2*j+1]=*(const __attribute__((address_space(3))) bf16x8*)(kp+j*2048+512); }
__device__ __forceinline__ s16x4 vtr(lds_cptr p){ return __builtin_bit_cast(s16x4,__builtin_amdgcn_ds_read_tr16_b64_v4i16((__attribute__((address_space(3))) v4i16_t*)p)); }
__device__ __forceinline__ float rowmax(const f32x16&p0,const f32x16&p1){
  float a=max3f(p0[0],p0[1],p1[0]),b=max3f(p0[2],p0[3],p1[1]);a=max3f(a,p1[2],p1[3]);
  #pragma unroll
  for(int r=4;r<16;r+=4){a=max3f(a,p0[r],p0[r+1]);b=max3f(b,p0[r+2],p0[r+3]);a=max3f(a,p1[r],p1[r+1]);b=max3f(b,p1[r+2],p1[r+3]);}
  const float m=max2f(a,b);
  auto rr=__builtin_amdgcn_permlane32_swap(__float_as_uint(m),__float_as_uint(m),false,false);
  return max2f(__uint_as_float(rr[0]),__uint_as_float(rr[1]));
}
__device__ __forceinline__ void pv(f32x16*o,int vb,bf16x8 pa0,bf16x8 pa1,bf16x8 pa2,bf16x8 pa3){
  #pragma unroll
  for(int d0=0;d0<2;++d0){s16x4 lo[4],hi[4];
    #pragma unroll
    for(int ks=0;ks<4;++ks){
      asm volatile("ds_read_b64_tr_b16 %0,%1 offset:%c2":"=&v"(lo[ks]):"v"(vb),"i"(d0*4096+ks*1024):"memory");
      asm volatile("ds_read_b64_tr_b16 %0,%1 offset:%c2":"=&v"(hi[ks]):"v"(vb),"i"(d0*4096+ks*1024+512):"memory");}
    asm volatile("s_waitcnt lgkmcnt(0)":::"memory");SBAR();
    #define PK(k) (bf16x8){lo[k][0],lo[k][1],lo[k][2],lo[k][3],hi[k][0],hi[k][1],hi[k][2],hi[k][3]}
    o[d0]=__builtin_amdgcn_mfma_f32_32x32x16_bf16(pa0,PK(0),o[d0],0,0,0);
    o[d0]=__builtin_amdgcn_mfma_f32_32x32x16_bf16(pa1,PK(1),o[d0],0,0,0);
    o[d0]=__builtin_amdgcn_mfma_f32_32x32x16_bf16(pa2,PK(2),o[d0],0,0,0);
    o[d0]=__builtin_amdgcn_mfma_f32_32x32x16_bf16(pa3,PK(3),o[d0],0,0,0);
    #undef PK
  }
}

#ifndef ATTN_STORE16
#define ATTN_STORE16(p,v) (*(u32x4*)(p)=(v))
#endif
template<int THRL> __device__ __forceinline__ void attn_unit(int b,int qb,const bf16*Q,const bf16*__restrict__ K,const bf16*__restrict__ V,bf16*O,char*shm,int cmap,float lam,float osc,const float*ng,bf16*M){
  int tid_=threadIdx.x; asm volatile("":"+v"(tid_)); const int tid=tid_,lane=tid&63,r32=lane&31,hi=lane>>5; const int wid=__builtin_amdgcn_readfirstlane(tid>>6);
  const long rowbase=(long)b*SEQ; const int q0=qb*QB;
  const bf16*Qw=Q+(rowbase+q0+wid*QBLK)*PIN;
  const bf16*Kh=K+rowbase*PIN,*Vh=V+rowbase*PIN;
  const unsigned lds0=(unsigned)(uintptr_t)shm;
  float*wsf=(float*)(shm+LDS_WS)+wid*64;
  const unsigned koff=(unsigned)(lane*PIN+wid*8)*2u, voff=(unsigned)((16*(wid&3)+(lane>>2))*PIN+(wid>>2)*32+(lane&3)*8)*2u;
  const unsigned kdst=lds0+LDS_K+wid*1024, vdst=lds0+LDS_V+wid*1024, vdst2=lds0+LDS_V2+wid*1024;
  #define DMA_K(t,slot) glds16((const char*)Kh+(size_t)(t)*(KVBLK*PIN*2)+koff,(unsigned)__builtin_amdgcn_readfirstlane(kdst+(slot)))
  #define DMA_V(t,slot) do{ glds16((const char*)Vh+(size_t)(t)*(KVBLK*PIN*2)+voff,(unsigned)__builtin_amdgcn_readfirstlane(vdst+(slot))); glds16((const char*)Vh+(size_t)(t)*(KVBLK*PIN*2)+128+voff,(unsigned)__builtin_amdgcn_readfirstlane(vdst2+(slot))); }while(0)
  const int vb0=(int)(lds0+LDS_V)+((lane>>4)&1)*32+(lane&3)*8+(4*hi+((lane&15)>>2))*64;
  const char*Kbase=shm+LDS_K; bf16x8 kf[8];
  const lds_cptr shm3=(lds_cptr)shm; const lds_cptr kp0=shm3+LDS_K+hi*1024+r32*16; const lds_cptr vp0=shm3+LDS_V+((lane>>4)&1)*32+(lane&3)*8+(4*hi+((lane&15)>>2))*64;
  const int NT=(q0+QB)/KVBLK;
  DMA_K(0,0);DMA_V(0,0);DMA_K(1,SLOTB);
  bf16x8 qr[4];
  #pragma unroll
  for(int d0=0;d0<4;++d0)qr[d0]=*reinterpret_cast<const bf16x8*>(&Qw[(long)r32*PIN+d0*16+hi*8]);
  const __attribute__((address_space(3))) bf16x8* qld=(const __attribute__((address_space(3))) bf16x8*)(shm3+LDS_OST+wid*4096)+lane;
  #pragma unroll
  for(int d0=0;d0<4;++d0)((__attribute__((address_space(3))) bf16x8*)(shm3+LDS_OST+wid*4096))[d0*64+lane]=qr[d0];
  float mhat=0.f,l_reg=0.f;f32x16 o[2];o[0]=f32x16{};o[1]=f32x16{};f32x16 o2[2];o2[0]=f32x16{};o2[1]=f32x16{}; const f32x16 zero16=f32x16{};
  const int qrel=wid*QBLK+r32;
  #define CMASK(P0,P1,t) do{int jb_=(t)-(NT-4); if(jb_>=0)cmask(P0,P1,jb_,qrel,hi);}while(0)
  bool resc=false;
  #define START(P0,P1) do{ const float rm=rowmax(P0,P1); resc=false; \
    { const float dl=rm; mhat=fadd_s(mhat,dl); \
      _Pragma("unroll") for(int r=0;r<16;++r){P0[r]=fsub_s(P0[r],dl);P1[r]=fsub_s(P1[r],dl);} } \
    _Pragma("unroll") for(int r=0;r<16;++r)P0[r]=__builtin_amdgcn_exp2f(P0[r]); }while(0)
  #define RESC() do{ if(resc){ asm volatile("s_waitcnt lgkmcnt(0)":::"memory"); \
      _Pragma("unroll") for(int d_=0;d_<2;++d_) _Pragma("unroll") for(int r=0;r<16;++r){ const float f_=wsf[crow(r,hi)]; o[d_][r]*=f_; o2[d_][r]*=f_; } } }while(0)
  f32x16 pA0,pA1,pB0,pB1;
  int sl_prev=0,sl_cur=0,sl_next=SLOTB;
  #define ROT() do{sl_prev=sl_cur;sl_cur=sl_next;sl_next=(sl_next==(NSLOT-1)*SLOTB)?0:sl_next+SLOTB;}while(0)
  DMA_K(2,2*SLOTB);
  WAIT_BAR(3);
  qkt(pA0,pA1,Kbase,qr,zero16,r32,hi);asm volatile("s_nop 15\n\ts_nop 7":"+v"(pA0),"+v"(pA1));CMASK(pA0,pA1,0);
  START(pA0,pA1);
  _Pragma("unroll") for(int r=0;r<16;++r)pA1[r]=__builtin_amdgcn_exp2f(pA1[r]);
  WAIT_BAR(0);
  DMA_K(3,0);DMA_V(1,SLOTB);
  ROT();
  kload8(kf,kp0+sl_cur);
  WAIT_BAR(3);
  s16x4 vlo[8],vhi[8]; u32x4 pw0,pw1,pw2,pw3;
  #define PKW(P,B) cvtpk_s(P[B],P[B+1])
  #define PAF(k) __builtin_bit_cast(bf16x8,pw##k)
  #define VFR(i) (bf16x8){vlo[i][0],vlo[i][1],vlo[i][2],vlo[i][3],vhi[i][0],vhi[i][1],vhi[i][2],vhi[i][3]}
  #define PIN(x) asm volatile("":"+v"(x))
  #define MX3(a,b,c) __builtin_fmaxf(__builtin_fmaxf((a),(b)),(c))
  #define GAPA(MF,A0,A1,A2,A3,W0,W1,PW) do{ MF; sacc+=A0; sacc+=A1; sacc+=A2; sacc+=A3; PIN(sacc); W0; W1; PIN(PW); SBAR(); }while(0)
  #define EX(v) __builtin_amdgcn_exp2f(v)
  #define GAPB(MF,X,B) do{ MF; X[B]=EX(X[B]-mhat); X[B+1]=EX(X[B+1]-mhat); PIN(X); SBAR(); }while(0)
  #define VRD(i) do{ vlo[i]=vtr(vp_+(((i)>>2)*4096+((i)&3)*1024)); vhi[i]=vtr(vp_+(((i)>>2)*4096+((i)&3)*1024+512)); }while(0)
  #define KRD(G,j) do{ if(G){ kload2(kf,kp0+sl_next,j); SBAR(); } }while(0)
  #define V2RD(i) do{ vlo[i]=vtr(vq_+(((i)>>2)*4096+((i)&3)*1024)); vhi[i]=vtr(vq_+(((i)>>2)*4096+((i)&3)*1024+512)); }while(0)
  #define STEP(C0,C1,P0,P1,t,GK,GV,GL) do{ SBAR(); \
    const lds_cptr vp_=vp0+sl_prev; \
    const bf16x8 q0_=qld[0],q1_=qld[64],q2_=qld[128],q3_=qld[192];     \
    VRD(0); SBAR(); float sacc=(P0[0]+P0[1]); \
    GAPA(C0=__builtin_amdgcn_mfma_f32_32x32x16_bf16(kf[0],q0_,zero16,0,0,0), P0[2],P0[3],P0[4],P0[5],     pw0[0]=PKW(P0,0), pw0[1]=PKW(P0,2), pw0); \
    VRD(4); SBAR(); GAPA(C1=__builtin_amdgcn_mfma_f32_32x32x16_bf16(kf[1],q0_,zero16,0,0,0), P0[6],P0[7],P0[8],P0[9],     pw0[2]=PKW(P0,4), pw0[3]=PKW(P0,6), pw0); \
    VRD(1); SBAR(); GAPA(C0=__builtin_amdgcn_mfma_f32_32x32x16_bf16(kf[2],q1_,C0,0,0,0),   P0[10],P0[11],P0[12],P0[13], pw1[0]=PKW(P0,8), pw1[1]=PKW(P0,10), pw1); \
    VRD(5); SBAR(); GAPA(C1=__builtin_amdgcn_mfma_f32_32x32x16_bf16(kf[3],q1_,C1,0,0,0),   P0[14],P0[15],P1[0],P1[1],   pw1[2]=PKW(P0,12),pw1[3]=PKW(P0,14), pw1); \
    VRD(2); SBAR(); GAPA(C0=__builtin_amdgcn_mfma_f32_32x32x16_bf16(kf[4],q2_,C0,0,0,0),   P1[2],P1[3],P1[4],P1[5],     pw2[0]=PKW(P1,0), pw2[1]=PKW(P1,2), pw2); \
    VRD(6); SBAR(); GAPA(C1=__builtin_amdgcn_mfma_f32_32x32x16_bf16(kf[5],q2_,C1,0,0,0),   P1[6],P1[7],P1[8],P1[9],     pw2[2]=PKW(P1,4), pw2[3]=PKW(P1,6), pw2); \
    VRD(3); SBAR(); GAPA(C0=__builtin_amdgcn_mfma_f32_32x32x16_bf16(kf[6],q3_,C0,0,0,0),   P1[10],P1[11],P1[12],P1[13], pw3[0]=PKW(P1,8), pw3[1]=PKW(P1,10), pw3); \
    VRD(7); SBAR(); GAPA(C1=__builtin_amdgcn_mfma_f32_32x32x16_bf16(kf[7],q3_,C1,0,0,0),   P1[14],P1[15],0.f,0.f,       pw3[2]=PKW(P1,12),pw3[3]=PKW(P1,14), pw3); \
    l_reg+=sacc; \
    if(GK){DMA_K((t)+3,sl_cur);} if(GV){DMA_V((t)+1,sl_next);} \
    CMASK(C0,C1,t); \
    { float a=MX3(C0[0],C0[1],C1[0]),b=MX3(C0[2],C0[3],C1[1]); a=MX3(a,C1[2],C1[3]); \
      _Pragma("unroll") for(int r=4;r<16;r+=4){a=MX3(a,C0[r],C0[r+1]);b=MX3(b,C0[r+2],C0[r+3]);a=MX3(a,C1[r],C1[r+1]);b=MX3(b,C1[r+2],C1[r+3]);} \
      float rm=__builtin_fmaxf(a,b); { auto rr=__builtin_amdgcn_permlane32_swap(__float_as_uint(rm),__float_as_uint(rm),false,false); rm=__builtin_fmaxf(__uint_as_float(rr[0]),__uint_as_float(rr[1])); } \
      rm-=mhat; resc=false; \
      if(__builtin_expect(__any(rm>(float)THRL),0)){ const float dl=__builtin_fmaxf(rm,0.f); mhat+=dl; \
        const float f=__builtin_amdgcn_exp2f(-dl); l_reg*=f; if(hi==0)wsf[r32]=f; resc=true; } } \
    SBAR(); \
    const lds_cptr vq_=vp0+(LDS_V2-LDS_V)+sl_prev;     \
    GAPB(o[0]=__builtin_amdgcn_mfma_f32_32x32x16_bf16(PAF(0),VFR(0),o[0],0,0,0), C0,0); \
    GAPB(o[1]=__builtin_amdgcn_mfma_f32_32x32x16_bf16(PAF(0),VFR(4),o[1],0,0,0), C0,2); V2RD(0); V2RD(4); SBAR(); \
    KRD(GL,0); GAPB(o[0]=__builtin_amdgcn_mfma_f32_32x32x16_bf16(PAF(1),VFR(1),o[0],0,0,0), C0,4); \
    KRD(GL,1); GAPB(o[1]=__builtin_amdgcn_mfma_f32_32x32x16_bf16(PAF(1),VFR(5),o[1],0,0,0), C0,6); V2RD(1); V2RD(5); SBAR(); \
    KRD(GL,2); GAPB(o[0]=__builtin_amdgcn_mfma_f32_32x32x16_bf16(PAF(2),VFR(2),o[0],0,0,0), C0,8); \
    KRD(GL,3); GAPB(o[1]=__builtin_amdgcn_mfma_f32_32x32x16_bf16(PAF(2),VFR(6),o[1],0,0,0), C0,10); V2RD(2); V2RD(6); SBAR(); \
    GAPB(o[0]=__builtin_amdgcn_mfma_f32_32x32x16_bf16(PAF(3),VFR(3),o[0],0,0,0), C0,12); \
    GAPB(o[1]=__builtin_amdgcn_mfma_f32_32x32x16_bf16(PAF(3),VFR(7),o[1],0,0,0), C0,14); V2RD(3); V2RD(7); SBAR(); \
    {     \
      GAPB(o2[0]=__builtin_amdgcn_mfma_f32_32x32x16_bf16(PAF(0),VFR(0),o2[0],0,0,0), C1,0); GAPB(o2[1]=__builtin_amdgcn_mfma_f32_32x32x16_bf16(PAF(0),VFR(4),o2[1],0,0,0), C1,2); \
      GAPB(o2[0]=__builtin_amdgcn_mfma_f32_32x32x16_bf16(PAF(1),VFR(1),o2[0],0,0,0), C1,4); GAPB(o2[1]=__builtin_amdgcn_mfma_f32_32x32x16_bf16(PAF(1),VFR(5),o2[1],0,0,0), C1,6); \
      GAPB(o2[0]=__builtin_amdgcn_mfma_f32_32x32x16_bf16(PAF(2),VFR(2),o2[0],0,0,0), C1,8); GAPB(o2[1]=__builtin_amdgcn_mfma_f32_32x32x16_bf16(PAF(2),VFR(6),o2[1],0,0,0), C1,10); \
      GAPB(o2[0]=__builtin_amdgcn_mfma_f32_32x32x16_bf16(PAF(3),VFR(3),o2[0],0,0,0), C1,12); GAPB(o2[1]=__builtin_amdgcn_mfma_f32_32x32x16_bf16(PAF(3),VFR(7),o2[1],0,0,0), C1,14); } \
    }while(0)
  int t=1;
  #undef CMASK
  #define CMASK(P0,P1,t) do{}while(0)
  for(;t+5<NT;t+=2){
    STEP(pB0,pB1,pA0,pA1,t,true,true,true);     WAIT_BAR(3); RESC(); ROT();
    STEP(pA0,pA1,pB0,pB1,t+1,true,true,true);   WAIT_BAR(3); RESC(); ROT();
  }
  #undef CMASK
  #define CMASK(P0,P1,t) do{int jb_=(t)-(NT-4); if(jb_>=0)cmask(P0,P1,jb_,qrel,hi);}while(0)
  #define ENDW(tt) do{ if((tt)+3<NT){WAIT_BAR(3);} else if((tt)+2<NT){WAIT_BAR(2);} else {WAIT_BAR(0);} }while(0)
  for(;t+1<NT;t+=2){
    STEP(pB0,pB1,pA0,pA1,t,(t+3<NT),(t+1<NT),(t+1<NT));       ENDW(t);   RESC(); ROT();
    STEP(pA0,pA1,pB0,pB1,t+1,(t+4<NT),(t+2<NT),(t+2<NT));     ENDW(t+1); RESC(); ROT();
  }
  STEP(pB0,pB1,pA0,pA1,NT-1,false,false,false); RESC();
  { float sacc=pB0[0]+pB0[1]; _Pragma("unroll") for(int r=2;r<16;++r)sacc+=pB0[r]; _Pragma("unroll") for(int r=0;r<16;++r)sacc+=pB1[r]; l_reg+=sacc;
    pw0=(u32x4){PKW(pB0,0),PKW(pB0,2),PKW(pB0,4),PKW(pB0,6)};pw1=(u32x4){PKW(pB0,8),PKW(pB0,10),PKW(pB0,12),PKW(pB0,14)};pw2=(u32x4){PKW(pB1,0),PKW(pB1,2),PKW(pB1,4),PKW(pB1,6)};pw3=(u32x4){PKW(pB1,8),PKW(pB1,10),PKW(pB1,12),PKW(pB1,14)};
    SBAR(); pv(o,vb0+sl_cur,PAF(0),PAF(1),PAF(2),PAF(3)); pv(o2,vb0+(LDS_V2-LDS_V)+sl_cur,PAF(0),PAF(1),PAF(2),PAF(3)); }
  #undef PKW
  #undef PAF
  #undef VFR
  #undef PIN
  #undef MX3
  #undef GAPA
  #undef GAPB
  #undef EX
  #undef VRD
  #undef KRD
  #undef V2RD
  #undef STEP
  #undef ENDW
  {auto rr=__builtin_amdgcn_permlane32_swap(__float_as_uint(l_reg),__float_as_uint(l_reg),false,false);l_reg=__uint_as_float(rr[0])+__uint_as_float(rr[1]);}
  if(hi==0)wsf[32+r32]=l_reg;asm volatile("s_waitcnt lgkmcnt(0)":::"memory");
  float rli[16];
  #pragma unroll
  for(int r=0;r<16;++r)rli[r]=__builtin_amdgcn_rcpf(wsf[32+crow(r,hi)]);
  bf16*Ow=O+(rowbase+q0+wid*QBLK)*PO;
  { bf16*stg=(bf16*)(shm+LDS_OST)+wid*2048;
    if(cmap==0){
      #pragma unroll
      for(int hf=0;hf<2;++hf){
        #pragma unroll
        for(int r=0;r<16;++r){const int orow=crow(r,hi);
          #pragma unroll
          for(int d0=0;d0<2;++d0)stg[orow*64+d0*32+r32]=__float2bfloat16((hf?o2[d0][r]:o[d0][r])*rli[r]);}
        asm volatile("s_waitcnt lgkmcnt(0)":::"memory");
        #pragma unroll
        for(int i=0;i<4;++i){const int row=i*8+(lane>>3),ch=lane&7; const u32x4 v=*(const u32x4*)(stg+row*64+ch*8); ATTN_STORE16(Ow+(long)row*PO+hf*64+ch*8,v);}
        asm volatile("s_waitcnt lgkmcnt(0)":::"memory"); }
    } else {
      asm volatile("s_waitcnt vmcnt(0)":::"memory");
      float dd[2][4][8]; const int ch=lane&7;
      #pragma unroll
      for(int hf=0;hf<2;++hf){
        #pragma unroll
        for(int r=0;r<16;++r){const int orow=crow(r,hi);
          #pragma unroll
          for(int d0=0;d0<2;++d0)stg[orow*64+d0*32+r32]=__float2bfloat16((hf?o2[d0][r]:o[d0][r])*rli[r]);}
        asm volatile("s_waitcnt lgkmcnt(0)":::"memory");
        #pragma unroll
        for(int i=0;i<4;++i){const int row=i*8+(lane>>3); const u32x4 v1=*(const u32x4*)(stg+row*64+ch*8); const u32x4 v0=*(const u32x4*)(Ow+(long)row*PO+hf*64+ch*8);
          #pragma unroll
          for(int j=0;j<4;++j){ dd[hf][i][2*j]=__uint_as_float(v0[j]<<16)-lam*__uint_as_float(v1[j]<<16); dd[hf][i][2*j+1]=__uint_as_float(v0[j]&0xffff0000u)-lam*__uint_as_float(v1[j]&0xffff0000u); } }
        asm volatile("s_waitcnt lgkmcnt(0)":::"memory"); }
      float gg[2][8];
      #pragma unroll
      for(int hf=0;hf<2;++hf){ const float4 a=*(const float4*)(ng+hf*64+ch*8), c4=*(const float4*)(ng+hf*64+ch*8+4); gg[hf][0]=a.x;gg[hf][1]=a.y;gg[hf][2]=a.z;gg[hf][3]=a.w;gg[hf][4]=c4.x;gg[hf][5]=c4.y;gg[hf][6]=c4.z;gg[hf][7]=c4.w; }
      bf16*Mw=M+(rowbase+q0+wid*QBLK)*PO;
      #pragma unroll
      for(int i=0;i<4;++i){ float ss=0.f;
        #pragma unroll
        for(int hf=0;hf<2;++hf)
          #pragma unroll
          for(int j=0;j<8;++j)ss+=dd[hf][i][j]*dd[hf][i][j];
        ss+=__shfl_xor(ss,1);ss+=__shfl_xor(ss,2);ss+=__shfl_xor(ss,4);
        const float rr=osc/sqrtf(ss*(1.0f/128.0f)+1e-5f); const int row=i*8+(lane>>3);
        #pragma unroll
        for(int hf=0;hf<2;++hf){ u32x4 w;
          #pragma unroll
          for(int j=0;j<4;++j)w[j]=cvtpk_s(dd[hf][i][2*j]*rr*gg[hf][2*j],dd[hf][i][2*j+1]*rr*gg[hf][2*j+1]);
          ATTN_STORE16(Mw+(long)row*PO+hf*64+ch*8,w); } }
    } }
  asm volatile("s_waitcnt lgkmcnt(0)\n\ts_barrier":::"memory");
  #undef DMA_K
  #undef DMA_V
  #undef CMASK
  #undef START
  #undef RESC
  #undef ROT
}
constexpr int ATTN_LDS_BYTES=LDS_BYTES;
__device__ __forceinline__ void attn_phase(char*lds,const bf16*proj,bf16*O,bf16*M,const float*ng,float lam,float osc,int vcu){
  const int bh=vcu>>3, s=vcu&7, b=bh>>2, h=bh&3;
  const bf16*V=proj+1024+h*128; bf16*Oc=O+h*128; bf16*Mc=M+h*128;
  for(int i=0;i<2;++i){ const int qb=i?15-s:s;
    for(int c=0;c<2;++c) attn_unit<8>(b,qb,proj+h*128+c*64,proj+512+h*128+c*64,V,Oc,lds,c,lam,osc,ng,Mc); }
}
#undef SBAR
#undef WAIT_BAR
}
#define GAS __attribute__((address_space(1)))
#define LAS __attribute__((address_space(3)))
typedef unsigned short bf16;
typedef unsigned v4u __attribute__((ext_vector_type(4)));
typedef float f32x4 __attribute__((ext_vector_type(4)));
typedef short bf16x8 __attribute__((ext_vector_type(8)));
typedef GAS unsigned gu32;
typedef GAS unsigned long long gu64;
#define RLX_AGENT __ATOMIC_RELAXED, __HIP_MEMORY_SCOPE_AGENT
#define LDS_WAIT() asm volatile("s_waitcnt lgkmcnt(0)" ::: "memory")
#define VM_WAIT() asm volatile("s_waitcnt vmcnt(0)" ::: "memory")
__device__ __forceinline__ unsigned long long rt() { return __builtin_amdgcn_s_memrealtime(); }
__device__ __forceinline__ unsigned f2bf(float f) { unsigned u = __builtin_bit_cast(unsigned, f); return (u + 0x7fffu + ((u >> 16) & 1u)) >> 16; }
__device__ __forceinline__ unsigned pk2(float lo, float hi) { return f2bf(lo) | (f2bf(hi) << 16); }

#define XB_TMO      128
#define XB_XCNT(j)  (256  + 64 * (j))
#define XB_XSUB(j)  (1280 + 64 * (j))
#define XB_XGEN(j)  (2304 + 64 * (j))
#define XB_TOP      3328
#define XB_TOPGEN   3392
#define XCD_BAR_WORDS 3456
#define XB_SPIN_CAP (1u << 18)

__device__ __forceinline__ unsigned xb_ld(unsigned* p)              { return __hip_atomic_load(p, __ATOMIC_RELAXED, __HIP_MEMORY_SCOPE_AGENT); }
__device__ __forceinline__ unsigned xb_add(unsigned* p, unsigned v) { return __hip_atomic_fetch_add(p, v, __ATOMIC_RELAXED, __HIP_MEMORY_SCOPE_AGENT); }
__device__ __forceinline__ unsigned xb_xcc_id() { return (unsigned)__builtin_amdgcn_s_getreg((3 << 11) | 20) & 0xFu; }
#define XB_SPIN(cond, bar) do { unsigned _sp = 0; while (cond) { __builtin_amdgcn_s_sleep(1); \
    if ((++_sp & 255u) == 0u) { if (xb_ld(&(bar)[XB_TMO])) break; if (_sp > XB_SPIN_CAP) { atomicAdd(&(bar)[XB_TMO], 1u); break; } } } } while (0)

struct XcdBarrier {
    unsigned* bar; unsigned x;
    volatile LAS unsigned* st;
};

__device__ __forceinline__ XcdBarrier xcd_barrier_post(unsigned* bar, volatile LAS unsigned* st) {
    XcdBarrier b; b.bar = bar; b.x = xb_xcc_id(); b.st = st;
    if (threadIdx.x == 0) (void)xb_add(&bar[XB_XCNT(b.x)], 1u);
    return b;
}
__device__ __forceinline__ void xcd_barrier_complete(unsigned* bar, unsigned x, unsigned& nloc, unsigned& nx) {
    const unsigned G = gridDim.x * gridDim.y * gridDim.z;
    unsigned sum, cnt, mine, sp = 0u;
    for (;;) {
        sum = 0u; cnt = 0u; mine = 0u;
#pragma unroll
        for (unsigned j = 0; j < 16; ++j) { const unsigned c = xb_ld(&bar[XB_XCNT(j)]); sum += c; cnt += (c > 0u) ? 1u : 0u; mine = (j == x) ? c : mine; }
        if (sum == G) break;
        __builtin_amdgcn_s_sleep(1);
        if ((++sp & 255u) == 0u) { if (xb_ld(&bar[XB_TMO])) break; if (sp > XB_SPIN_CAP) { atomicAdd(&bar[XB_TMO], 1u); break; } }
    }
    nloc = mine > 0u ? mine : 1u; nx = cnt > 0u ? cnt : 1u;
}

__device__ __forceinline__ void xcd_barrier(const XcdBarrier& b) {
    asm volatile("s_waitcnt vmcnt(0)" ::: "memory");
    __syncthreads();
    if (threadIdx.x == 0) {
        unsigned* bar = b.bar;
        __builtin_amdgcn_s_waitcnt(0);
        unsigned nloc = b.st[0], nx = b.st[1];
        if (nloc == 0u) { xcd_barrier_complete(bar, b.x, nloc, nx); b.st[0] = nloc; b.st[1] = nx; }
        const unsigned old = xb_add(&bar[XB_XSUB(b.x)], 1u);
        const unsigned gen = old / nloc;
        if (old + 1u == (gen + 1u) * nloc) {
            __builtin_amdgcn_fence(__ATOMIC_RELEASE, "agent");
            asm volatile("s_waitcnt vmcnt(0)" ::: "memory");
            const unsigned og = xb_add(&bar[XB_TOP], 1u);
            const unsigned tg = og / nx;
            if (og + 1u == (tg + 1u) * nx) xb_add(&bar[XB_TOPGEN], 1u);
            else XB_SPIN(xb_ld(&bar[XB_TOPGEN]) == tg, bar);
            __builtin_amdgcn_fence(__ATOMIC_ACQUIRE, "agent");
            xb_add(&bar[XB_XGEN(b.x)], 1u);
            asm volatile("s_waitcnt vmcnt(0)" ::: "memory");
        } else {
            XB_SPIN(xb_ld(&bar[XB_XGEN(b.x)]) == gen, bar);
            __builtin_amdgcn_fence(__ATOMIC_ACQUIRE, "agent");
            asm volatile("s_waitcnt vmcnt(0)" ::: "memory");
        }
    }
    __syncthreads();
}
constexpr int NWAVES = 8, NTHREADS = NWAVES * 64;
constexpr int BATCH = 8, SEQ = 4096, NTOK = BATCH * SEQ, DMODEL = 1024, INW = 3080, NPROJ = 3072, DEPTH = 4;
constexpr int NEXP = 32, DFF = 1024, CHUNK = 64, NCH = SEQ / CHUNK, NBH = BATCH * 4;
constexpr int MAXRT = (NTOK * 4) / 256 + NEXP;
constexpr float DN_ALPHA = 1.681792830507429f, LN_EPS = 1e-5f, RMS_EPS = 1e-5f;
constexpr int NPH_LAYER = 10, NPHASES = 1 + DEPTH * NPH_LAYER;

constexpr size_t MiB = 1u << 20;
constexpr size_t WS_CTL = 0, CTL_ZERO_BYTES = 1 * MiB;
constexpr size_t WS_WIN = 2 * MiB;
#ifndef MK_SIDEJOB
#define MK_SIDEJOB 0
#endif
#ifndef MK_X1R8
#define MK_X1R8 1
#endif
constexpr float X1R_SCALE = 128.0f;
#ifndef MK_OUTFP8
#define MK_OUTFP8 0
#endif
constexpr float MQ_SCALE = 16.0f, MQ_ML = 2.0f;
constexpr size_t WS_WOUT = WS_WIN + 24 * MiB;
constexpr size_t WS_WGU = WS_WOUT + 8 * MiB;
constexpr size_t WS_WDN = WS_WGU + 512 * MiB;
constexpr size_t WS_XRES = WS_WDN + 256 * MiB;
constexpr size_t WS_X1 = WS_XRES + 128 * MiB;
constexpr size_t WS_XB = WS_X1 + 128 * MiB;
constexpr size_t WS_X1B = WS_XB + 64 * MiB;
constexpr size_t WS_PROJ = WS_X1B + 64 * MiB;
constexpr size_t WS_G = WS_PROJ + 192 * MiB;
constexpr size_t WS_ATTO = WS_G + 1 * MiB;
constexpr size_t WS_MIXIN = WS_ATTO + 64 * MiB;
constexpr size_t WS_MIXO = WS_MIXIN + 64 * MiB;
constexpr size_t WS_CST = WS_MIXO + 64 * MiB;
constexpr size_t WS_NST = WS_CST + 64 * MiB;
constexpr size_t WS_MISC = WS_NST + 1 * MiB;
constexpr size_t WS_WRP = WS_MISC + 512 * 1024;
constexpr size_t WS_TOKE = WS_MISC + 1 * MiB;
constexpr size_t WS_TOKP = WS_TOKE + 1 * MiB;
constexpr size_t WS_TOKG = WS_TOKP + 1 * MiB;
constexpr size_t WS_ROWTOK = WS_TOKG + 1 * MiB;
constexpr size_t WS_H = WS_ROWTOK + 4 * MiB;
constexpr size_t WS_Y = WS_H + 272 * MiB;
constexpr size_t WS_WINQ = WS_Y + 272 * MiB;
constexpr size_t WS_XQ = WS_WINQ + 8 * MiB;
constexpr size_t WS_END = WS_XQ + 32 * MiB;
static_assert((size_t)MAXRT * 256 * 1024 * 2 <= 272 * MiB, "H/Y size");
constexpr int CW_TMO = 0, CW_CODE = 1, CW_BAR = 4096, MAX_BAR_REGIONS = 48, CW_CNT = 200000;
static_assert(CW_BAR + MAX_BAR_REGIONS * 3456 <= CW_CNT && (CW_CNT + 64 * DEPTH) * 4 <= (int)CTL_ZERO_BYTES, "CTL map");
constexpr int RING_OFF = 0, RING_BYTES = 131072;
constexpr int LDSCTL_OFF = RING_BYTES;
constexpr int MISC_OFF = LDSCTL_OFF + 320;
constexpr int LDSX_OFF = LDSCTL_OFF + 512;
constexpr int LDS_BYTES = 163840;

typedef unsigned v2u __attribute__((ext_vector_type(2)));
__device__ __forceinline__ float bflo(unsigned w) { return __uint_as_float(w << 16); }
__device__ __forceinline__ float bfhi(unsigned w) { return __uint_as_float(w & 0xffff0000u); }
__device__ __forceinline__ void unpack8(const v4u w, float* o) { o[0] = bflo(w.x); o[1] = bfhi(w.x); o[2] = bflo(w.y); o[3] = bfhi(w.y); o[4] = bflo(w.z); o[5] = bfhi(w.z); o[6] = bflo(w.w); o[7] = bfhi(w.w); }
constexpr float XQ_SCALE = 8.0f, WQ_SCALE = 512.0f, HQ_SCALE = 8.0f, YQ_SCALE = 64.0f, XLO_SCALE = 4096.0f;
#ifndef MK_XLO
#define MK_XLO 0
#endif
constexpr bool USE_XLO = (MK_XLO != 0);
__device__ __forceinline__ v2u pack8_fp8(const float* o, float sc) { int a = 0, b = 0; a = __builtin_amdgcn_cvt_pk_fp8_f32(o[0] * sc, o[1] * sc, a, false); a = __builtin_amdgcn_cvt_pk_fp8_f32(o[2] * sc, o[3] * sc, a, true);
    b = __builtin_amdgcn_cvt_pk_fp8_f32(o[4] * sc, o[5] * sc, b, false); b = __builtin_amdgcn_cvt_pk_fp8_f32(o[6] * sc, o[7] * sc, b, true); return (v2u){(unsigned)a, (unsigned)b}; }
__device__ __forceinline__ v4u pack8(const float* o) { v4u w; w.x = pk2(o[0], o[1]); w.y = pk2(o[2], o[3]); w.z = pk2(o[4], o[5]); w.w = pk2(o[6], o[7]); return w; }
__device__ __forceinline__ float wave_sum(float v) {
#pragma unroll
    for (int o = 1; o < 64; o <<= 1) v += __shfl_xor(v, o);
    return v;
}
__device__ __forceinline__ float wave_max(float v) {
#pragma unroll
    for (int o = 1; o < 64; o <<= 1) v = fmaxf(v, __shfl_xor(v, o));
    return v;
}
__device__ __forceinline__ float sigmoid_f(float x) { return __builtin_amdgcn_rcpf(1.0f + __expf(-x)); }

struct Ctx {
    LAS unsigned char* lds; int wave, vcu, G; unsigned char* ws; const float* const* in; float* out;
};
__device__ __forceinline__ int ltid() { int t = threadIdx.x; asm volatile("" : "+v"(t)); return t; }
enum { I_X = 0, I_WIN, I_CONVW, I_CONVB, I_GATEB, I_LQ1, I_LK1, I_LQ2, I_LK2, I_NG, I_WOUT, I_LN1G, I_LN1B, I_WR, I_BR, I_WGU, I_BGU, I_WDN, I_BDN, I_LN2G, I_LN2B };

__device__ __forceinline__ void load_row_f32(const float* row, int lane, float* v) {
    const f32x4* p = (const f32x4*)(row + 8 * lane); const f32x4 a = p[0], b = p[1]; const f32x4* q = (const f32x4*)(row + 512 + 8 * lane); const f32x4 c = q[0], d = q[1];
    v[0] = a.x; v[1] = a.y; v[2] = a.z; v[3] = a.w; v[4] = b.x; v[5] = b.y; v[6] = b.z; v[7] = b.w; v[8] = c.x; v[9] = c.y; v[10] = c.z; v[11] = c.w; v[12] = d.x; v[13] = d.y; v[14] = d.z; v[15] = d.w;
}
__device__ __forceinline__ void store_row_f32(float* row, int lane, const float* v) {
    f32x4* p = (f32x4*)(row + 8 * lane); p[0] = (f32x4){v[0], v[1], v[2], v[3]}; p[1] = (f32x4){v[4], v[5], v[6], v[7]};
    f32x4* q = (f32x4*)(row + 512 + 8 * lane); q[0] = (f32x4){v[8], v[9], v[10], v[11]}; q[1] = (f32x4){v[12], v[13], v[14], v[15]};
}
__device__ __forceinline__ void load_row_bf16(const bf16* row, int lane, float* v) {
    const v4u a = *(const v4u*)(row + 8 * lane), b = *(const v4u*)(row + 512 + 8 * lane); unpack8(a, v); unpack8(b, v + 8);
}
__device__ __forceinline__ void load_row_fp8(const unsigned char* row, int lane, float sc, float* v) {
    typedef float f32x2_ __attribute__((ext_vector_type(2)));
    const v2u a = *(const v2u*)(row + 8 * lane), b = *(const v2u*)(row + 512 + 8 * lane); const unsigned w[4] = {a.x, a.y, b.x, b.y};
#pragma unroll
    for (int i = 0; i < 4; ++i) { const f32x2_ lo = __builtin_amdgcn_cvt_pk_f32_fp8((int)w[i], false), hi = __builtin_amdgcn_cvt_pk_f32_fp8((int)w[i], true); v[4 * i] = lo.x * sc; v[4 * i + 1] = lo.y * sc; v[4 * i + 2] = hi.x * sc; v[4 * i + 3] = hi.y * sc; }
}
__device__ __forceinline__ void store_row_fp8(unsigned char* row, int lane, const float* v, float sc) {
    *(v2u*)(row + 8 * lane) = pack8_fp8(v, sc); *(v2u*)(row + 512 + 8 * lane) = pack8_fp8(v + 8, sc);
}
__device__ __forceinline__ void store_row_bf16(bf16* row, int lane, const float* v) {
    *(v4u*)(row + 8 * lane) = pack8(v); *(v4u*)(row + 512 + 8 * lane) = pack8(v + 8);
}
__device__ __forceinline__ void store_row_fp8_nt(unsigned char* row, int lane, const float* v, float sc) {
    __builtin_nontemporal_store(pack8_fp8(v, sc), (v2u*)(row + 8 * lane)); __builtin_nontemporal_store(pack8_fp8(v + 8, sc), (v2u*)(row + 512 + 8 * lane));
}
__device__ __forceinline__ void store_row_bf16_nt(bf16* row, int lane, const float* v) {
    __builtin_nontemporal_store(pack8(v), (v4u*)(row + 8 * lane)); __builtin_nontemporal_store(pack8(v + 8), (v4u*)(row + 512 + 8 * lane));
}
__device__ __forceinline__ void store_row_f32_nt(float* row, int lane, const float* v) {
    f32x4* p = (f32x4*)(row + 8 * lane); __builtin_nontemporal_store((f32x4){v[0], v[1], v[2], v[3]}, p); __builtin_nontemporal_store((f32x4){v[4], v[5], v[6], v[7]}, p + 1);
    f32x4* q = (f32x4*)(row + 512 + 8 * lane); __builtin_nontemporal_store((f32x4){v[8], v[9], v[10], v[11]}, q); __builtin_nontemporal_store((f32x4){v[12], v[13], v[14], v[15]}, q + 1);
}
__device__ __forceinline__ void ln_row(float* v, const float* g, const float* b) {
    float s = 0.f;
#pragma unroll
    for (int i = 0; i < 16; ++i) s += v[i];
    const float mean = wave_sum(s) * (1.0f / DMODEL); float q = 0.f;
#pragma unroll
    for (int i = 0; i < 16; ++i) { v[i] -= mean; q += v[i] * v[i]; }
    const float rstd = 1.0f / sqrtf(wave_sum(q) * (1.0f / DMODEL) + LN_EPS);
#pragma unroll
    for (int i = 0; i < 16; ++i) v[i] = v[i] * rstd * g[i] + b[i];
}
__device__ __forceinline__ void load_vec16(const float* p, int lane, float* v) { load_row_f32(p, lane, v); }

__device__ __forceinline__ void load_gate_w(int tid, const float* w_in_l, LAS f32x4* wgl) {
    for (int idx = tid; idx < 2048; idx += NTHREADS) { const int ln = idx & 63, hq = idx >> 6, half = hq & 1, q = hq >> 1; const int k = (q < 8) ? (8 * ln + q) : (512 + 8 * ln + q - 8);
        wgl[idx] = *(const f32x4*)(w_in_l + (size_t)k * INW + NPROJ + 4 * half); }
}
__device__ __forceinline__ void gates_row(const float* v, const LAS f32x4* wgl, const float* gate_b, float* Grow, int lane) {
    float p[8] = {0.f, 0.f, 0.f, 0.f, 0.f, 0.f, 0.f, 0.f};
#pragma unroll
    for (int q = 0; q < 16; ++q) { const f32x4 w0 = wgl[(q * 2 + 0) * 64 + lane], w1 = wgl[(q * 2 + 1) * 64 + lane];
        p[0] += v[q] * w0.x; p[1] += v[q] * w0.y; p[2] += v[q] * w0.z; p[3] += v[q] * w0.w; p[4] += v[q] * w1.x; p[5] += v[q] * w1.y; p[6] += v[q] * w1.z; p[7] += v[q] * w1.w; }
    const bool b5 = (lane >> 5) & 1, b4 = (lane >> 4) & 1, b3 = (lane >> 3) & 1;
    float r4[4];
#pragma unroll
    for (int i = 0; i < 4; ++i) { const float keep = b5 ? p[4 + i] : p[i], send = b5 ? p[i] : p[4 + i]; r4[i] = keep + __shfl_xor(send, 32); }
    float r2[2];
#pragma unroll
    for (int i = 0; i < 2; ++i) { const float keep = b4 ? r4[2 + i] : r4[i], send = b4 ? r4[i] : r4[2 + i]; r2[i] = keep + __shfl_xor(send, 16); }
    float r1; { const float keep = b3 ? r2[1] : r2[0], send = b3 ? r2[0] : r2[1]; r1 = keep + __shfl_xor(send, 8); }
    r1 += __shfl_xor(r1, 4); r1 += __shfl_xor(r1, 2); r1 += __shfl_xor(r1, 1);
    if ((lane & 7) == 0) { const int gi = (lane >> 3); Grow[gi] = r1 + gate_b[gi]; }
}
struct TrItem { const float* src; unsigned char* dst; int ldw, Kd, fp8; float sc; };
__device__ __forceinline__ void tr_fetch(const TrItem& a, float* ra, int lane) {
    const int kk0 = lane >> 5, nn = lane & 31;
#pragma unroll
    for (int i = 0; i < 64; ++i) ra[i] = a.src[(size_t)(2 * i + kk0) * a.ldw + nn];
}
__device__ __forceinline__ void tr_put(const float* ra, LAS float* scr, int lane) {
    const int kk0 = lane >> 5, nn = lane & 31;
#pragma unroll
    for (int i = 0; i < 64; ++i) scr[(2 * i + kk0) * 33 + nn] = ra[i];
}
__device__ __forceinline__ void tr_store(const TrItem& it, const LAS float* scr, int lane) {
    const int c = lane & 7;
#pragma unroll
    for (int j = 0; j < 4; ++j) { const int n = (lane >> 3) + 8 * j; const LAS float* s = scr + (16 * c) * 33 + n; float o[16];
#pragma unroll
        for (int i = 0; i < 16; ++i) o[i] = s[i * 33];
        if (it.fp8) { const v2u p = pack8_fp8(o, it.sc), q = pack8_fp8(o + 8, it.sc); *(GAS v4u*)(it.dst + (size_t)n * it.Kd + 16 * c) = (v4u){p.x, p.y, q.x, q.y}; }
        else { GAS v4u* d = (GAS v4u*)(it.dst + ((size_t)n * it.Kd + 16 * c) * 2); d[0] = pack8(o); d[1] = pack8(o + 8); } }
}
constexpr int TR_I_IN = DEPTH * 8 * 96, TR_I_OUT = DEPTH * 8 * 32, TR_I_GU = DEPTH * NEXP * 8 * 64, TR_I_DN = DEPTH * NEXP * 8 * 32, TR_ITEMS = TR_I_IN + TR_I_OUT + TR_I_GU + TR_I_DN;
__device__ __forceinline__ TrItem tr_decode(const Ctx& C, int r) {
    TrItem it;
    if (r < TR_I_GU) { const int m = r / 512, q = r % 512, kb = q / 64, nb = q % 64, n0 = 32 * nb;
        const int nn = (n0 < 1024) ? n0 : n0 - 1024; const int drow = 256 * (nn / 128) + (nn % 128) + ((n0 < 1024) ? 0 : 128);
        it.src = C.in[I_WGU] + (size_t)m * DMODEL * 2 * DFF + (size_t)(128 * kb) * (2 * DFF) + n0; it.ldw = 2 * DFF; it.Kd = DMODEL; it.fp8 = 1; it.sc = WQ_SCALE;
        it.dst = C.ws + WS_WGU + (size_t)m * 2 * DFF * DMODEL + (size_t)drow * DMODEL + 128 * kb; return it; }
    r -= TR_I_GU;
    if (r < TR_I_DN) { const int m = r / 256, q = r % 256, kb = q / 32, nb = q % 32;
        it.src = C.in[I_WDN] + (size_t)m * DFF * DMODEL + (size_t)(128 * kb) * DMODEL + 32 * nb; it.ldw = DMODEL; it.Kd = DFF; it.fp8 = 1; it.sc = WQ_SCALE;
        it.dst = C.ws + WS_WDN + (size_t)m * DMODEL * DFF + (size_t)(32 * nb) * DFF + 128 * kb; return it; }
    r -= TR_I_DN;
    if (r < TR_I_IN) { const int l = r / 768, q = r % 768, kb = q / 96, nb = q % 96, n0 = 32 * nb, tile = n0 >> 8;
        const bool q8 = (tile >= 8); const int rank = q8 ? tile - 8 : tile; const int drow = rank * 256 + (n0 & 255);
        it.src = C.in[I_WIN] + (size_t)l * DMODEL * INW + (size_t)(128 * kb) * INW + n0; it.ldw = INW; it.Kd = DMODEL; it.fp8 = q8 ? 1 : 0; it.sc = q8 ? WQ_SCALE : 1.f;
        it.dst = q8 ? C.ws + WS_WINQ + (size_t)l * 1536 * DMODEL + (size_t)drow * DMODEL + 128 * kb : C.ws + WS_WIN + ((size_t)l * NPROJ * DMODEL + (size_t)drow * DMODEL + 128 * kb) * 2; return it; }
    r -= TR_I_IN;
    { const int l = r / 256, q = r % 256, kb = q / 32, nb = q % 32;
        it.src = C.in[I_WOUT] + (size_t)l * DMODEL * DMODEL + (size_t)(128 * kb) * DMODEL + 32 * nb; it.ldw = DMODEL; it.Kd = DMODEL; it.fp8 = MK_OUTFP8; it.sc = MK_OUTFP8 ? ((kb >= 4) ? WQ_SCALE * (MQ_SCALE / MQ_ML) : WQ_SCALE) : 1.f;
        it.dst = C.ws + WS_WOUT + ((size_t)l * DMODEL * DMODEL + (size_t)(32 * nb) * DMODEL + 128 * kb) * (MK_OUTFP8 ? 1 : 2); return it; }
}
#ifndef MK_TRQ_RUNS
#define MK_TRQ_RUNS 0
#endif
constexpr int TR_L_GU = NEXP * 8 * 64, TR_L_DN = NEXP * 8 * 32, TR_L = TR_L_GU + TR_L_DN, TR_P_ITEMS = TR_L + TR_I_IN + TR_I_OUT, TRQ_LAYERS = DEPTH - 1;
__device__ __forceinline__ int trq_per(const Ctx& C) { return (TR_L + C.G - 1) / C.G; }
__device__ __forceinline__ int trq_item(const Ctx& C, int q) {
    const int per = trq_per(C), l = 1 + q / per, i = MK_TRQ_RUNS ? (C.vcu * per + q % per) : ((q % per) * C.G + C.vcu); if (i >= TR_L) return -1;
    return (i < TR_L_GU) ? l * TR_L_GU + i : TR_I_GU + l * TR_L_DN + (i - TR_L_GU); }
__device__ __forceinline__ int trp_item(int p) { return (p < TR_L_GU) ? p : (p < TR_L) ? TR_I_GU + (p - TR_L_GU) : TR_I_GU + TR_I_DN + (p - TR_L); }
__device__ __forceinline__ void tr_one(const Ctx& C, int r, LAS float* scr, int lane) {
    float ra[64]; const TrItem it = tr_decode(C, r); tr_fetch(it, ra, lane); tr_put(ra, scr, lane); LDS_WAIT(); asm volatile("" ::: "memory"); tr_store(it, scr, lane); LDS_WAIT(); asm volatile("" ::: "memory");
}
__device__ __forceinline__ int trq_grab(const Ctx& C, int lane) { unsigned v = 0u; if (lane == 0) v = __hip_atomic_fetch_add((LAS unsigned*)(C.lds + MISC_OFF) + 11, 1u, __ATOMIC_RELAXED, __HIP_MEMORY_SCOPE_WORKGROUP); return (int)__builtin_amdgcn_readfirstlane(v); }
__device__ __forceinline__ void trq_drain(const Ctx& C, int l) {
    const int lane = ltid() & 63, per = trq_per(C), endq = l * per, total = TRQ_LAYERS * per;
    LAS float* scr = (LAS float*)(C.lds + (C.wave < 7 ? RING_OFF + C.wave * 16896 : LDSX_OFF));
    for (;;) { const int q = trq_grab(C, lane); if (q >= total) break; const int r = trq_item(C, q); if (r >= 0) tr_one(C, r, scr, lane); if (q >= endq) break; }
    __syncthreads();
}
__device__ __forceinline__ void p_prologue(const Ctx& C) {
    const int tid = ltid(), lane = tid & 63;
    const int gw = C.vcu * NWAVES + C.wave, NGW = C.G * NWAVES;
    LAS float* scr = (LAS float*)(C.lds + (C.wave < 7 ? RING_OFF + C.wave * 16896 : LDSX_OFF));
    float ra[64]; TrItem cur = tr_decode(C, trp_item(gw < TR_P_ITEMS ? gw : 0));
    if (gw < TR_P_ITEMS) tr_fetch(cur, ra, lane);
    for (int it = gw; it < TR_P_ITEMS; it += NGW) {
        tr_put(ra, scr, lane);
        const bool more = (it + NGW < TR_P_ITEMS); const TrItem nxt = tr_decode(C, trp_item(more ? it + NGW : it));
        if (more) tr_fetch(nxt, ra, lane);
        LDS_WAIT(); asm volatile("" ::: "memory");
        tr_store(cur, scr, lane);
        LDS_WAIT(); asm volatile("" ::: "memory");
        cur = nxt;
    }
    { f32x4* WRP = (f32x4*)(C.ws + WS_WRP); const int gt = (C.vcu * NWAVES + C.wave) * 64 + lane, NGT = C.G * NTHREADS;
        for (int i = gt; i < DEPTH * 8192; i += NGT) { const int l = i >> 13, idx = i & 8191, ln = idx & 63, q4 = (idx >> 6) & 3, e = idx >> 8; const int k = (q4 < 2) ? (8 * ln + 4 * q4) : (512 + 8 * ln + 4 * (q4 - 2));
            const float* wr = C.in[I_WR] + (size_t)l * DMODEL * NEXP; WRP[i] = (f32x4){wr[(size_t)k * NEXP + e], wr[(size_t)(k + 1) * NEXP + e], wr[(size_t)(k + 2) * NEXP + e], wr[(size_t)(k + 3) * NEXP + e]}; } }
    __syncthreads();
    LAS f32x4* wgl = (LAS f32x4*)(C.lds + RING_OFF);
    load_gate_w(tid, C.in[I_WIN], wgl);
    __syncthreads();
    bf16* XB = (bf16*)(C.ws + WS_XB); float* G = (float*)(C.ws + WS_G);
    unsigned char* XLO = (unsigned char*)(C.ws + WS_XRES);
    for (int n = gw; n < NTOK; n += NGW) { float v[16], lo_[16]; load_row_f32(C.in[I_X] + (size_t)n * DMODEL, lane, v); store_row_bf16(XB + (size_t)n * DMODEL, lane, v);
#pragma unroll
        for (int i = 0; i < 16; ++i) lo_[i] = v[i] - __uint_as_float(f2bf(v[i]) << 16);
        if (USE_XLO) store_row_fp8(XLO + (size_t)n * DMODEL, lane, lo_, XLO_SCALE);
        store_row_fp8((unsigned char*)(C.ws + WS_XQ) + (size_t)n * DMODEL, lane, v, XQ_SCALE);
        gates_row(v, wgl, C.in[I_GATEB], G + (size_t)n * 8, lane); }
    __syncthreads();
}

__device__ __forceinline__ void conv_silu8(const bf16* proj, int n, int t, int col, const float* cw, const float* cb, float scale, float* y) {
    const f32x4 b0 = *(const f32x4*)cb, b1 = *(const f32x4*)(cb + 4);
    y[0] = b0.x; y[1] = b0.y; y[2] = b0.z; y[3] = b0.w; y[4] = b1.x; y[5] = b1.y; y[6] = b1.z; y[7] = b1.w;
#pragma unroll
    for (int j = 0; j < 4; ++j) { const int tt = t - 3 + j;
        if (tt >= 0) { const v4u w = *(const v4u*)(proj + (size_t)(n - 3 + j) * NPROJ + col); float x[8]; unpack8(w, x);
            const f32x4 c0 = *(const f32x4*)(cw + j * 512), c1 = *(const f32x4*)(cw + j * 512 + 4);
            y[0] += c0.x * x[0]; y[1] += c0.y * x[1]; y[2] += c0.z * x[2]; y[3] += c0.w * x[3]; y[4] += c1.x * x[4]; y[5] += c1.y * x[5]; y[6] += c1.z * x[6]; y[7] += c1.w * x[7]; } }
#pragma unroll
    for (int i = 0; i < 8; ++i) y[i] = y[i] * sigmoid_f(y[i]) * scale;
}
constexpr int KP = 68;

__device__ __forceinline__ void p_mlstm_states(const Ctx& C, int l) {
    const bf16* proj = (const bf16*)(C.ws + WS_PROJ); const float* G = (const float*)(C.ws + WS_G);
    float* CST = (float*)(C.ws + WS_CST); float* NST = (float*)(C.ws + WS_NST); float* MLOC = (float*)(C.ws + WS_MISC); float* GCH = MLOC + 2048;
    const float* cw = C.in[I_CONVW] + (size_t)l * 4 * 512; const float* cb = C.in[I_CONVB] + (size_t)l * 512;
    LAS float* kf = (LAS float*)(C.lds + RING_OFF);
    LAS float* vf = kf + 64 * 64;
    LAS float* ev = vf + 64 * 128;
    const int tid = ltid(), lane = tid & 63;
    for (int u = C.vcu; u < NBH * NCH; u += C.G) {
        const int bh = u / NCH, c = u % NCH, b = bh >> 2, h = bh & 3; const int n0 = b * SEQ + c * CHUNK;
        { const int s = tid >> 3, cg = tid & 7; float y[8]; conv_silu8(proj, n0 + s, c * CHUNK + s, 1536 + 256 + h * 64 + cg * 8, cw + 256 + h * 64 + cg * 8, cb + 256 + h * 64 + cg * 8, 1.0f, y);
#pragma unroll
            for (int i = 0; i < 8; ++i) kf[s * 64 + cg * 8 + i] = y[i];
            const bf16* vp = proj + (size_t)(n0 + s) * NPROJ + 2048 + h * 128 + cg * 16; float x[16]; unpack8(*(const v4u*)vp, x); unpack8(*(const v4u*)(vp + 8), x + 8);
#pragma unroll
            for (int i = 0; i < 16; ++i) vf[s * 128 + cg * 16 + i] = x[i]; }
        if (C.wave == 0) { const float ig = G[(size_t)(n0 + lane) * 8 + h], fg = G[(size_t)(n0 + lane) * 8 + 4 + h];
            float bc = fminf(fg, 0.f) - log1pf(expf(-fabsf(fg)));
#pragma unroll
            for (int o = 1; o < 64; o <<= 1) { const float t = __shfl_up(bc, o); if (lane >= o) bc += t; }
            const float g = __shfl(bc, 63); const float w = g - bc + ig; const float m = wave_max(w);
            ev[lane] = __expf(w - m); if (lane == 0) { MLOC[u] = m; GCH[u] = g; } }
        __syncthreads();
        { const int v = tid & 127, kg = tid >> 7; float acc[16];
#pragma unroll
            for (int i = 0; i < 16; ++i) acc[i] = 0.f;
            for (int s = 0; s < 64; ++s) { const float a = ev[s] * vf[s * 128 + v];
#pragma unroll
                for (int i4 = 0; i4 < 4; ++i4) { const f32x4 k4 = *(const LAS f32x4*)(kf + s * 64 + kg * 16 + i4 * 4); acc[i4 * 4 + 0] += a * k4.x; acc[i4 * 4 + 1] += a * k4.y; acc[i4 * 4 + 2] += a * k4.z; acc[i4 * 4 + 3] += a * k4.w; } }
            float* dst = CST + (size_t)u * 8192 + v;
#pragma unroll
            for (int i = 0; i < 16; ++i) dst[(kg * 16 + i) * 128] = acc[i]; }
        if (tid < 64) { float a = 0.f; for (int s = 0; s < 64; ++s) a += ev[s] * kf[s * 64 + tid]; NST[(size_t)u * 64 + tid] = a; }
        __syncthreads();
    }
}

__device__ __forceinline__ void p_mlstm_scan(const Ctx& C) {
    v2u* CST = (v2u*)(C.ws + WS_CST); f32x4* NST = (f32x4*)(C.ws + WS_NST); const float* MLOC = (const float*)(C.ws + WS_MISC); const float* GCH = MLOC + 2048; float* MPREV = (float*)(C.ws + WS_MISC) + 4096;
    const int nthr = C.G * NTHREADS, gid = C.vcu * NTHREADS + ltid();
    for (int it = gid; it < NBH * 2064; it += nthr) {
        const int bh = it / 2064, r = it % 2064;
        if (r < 2048) {
            v2u* p = CST + (size_t)bh * NCH * 2048 + r; float carry[4] = {0.f, 0.f, 0.f, 0.f}; float m = -INFINITY;
            for (int c0 = 0; c0 < NCH; c0 += 16) {
                v2u loc[16]; float gg[16], ml[16];
#pragma unroll
                for (int j = 0; j < 16; ++j) { loc[j] = p[(size_t)(c0 + j) * 2048]; gg[j] = GCH[bh * NCH + c0 + j]; ml[j] = MLOC[bh * NCH + c0 + j]; }
#pragma unroll
                for (int j = 0; j < 16; ++j) { p[(size_t)(c0 + j) * 2048] = (v2u){pk2(carry[0], carry[1]), pk2(carry[2], carry[3])}; if (r == 0) MPREV[bh * NCH + c0 + j] = m;
                    const float mn = fmaxf(gg[j] + m, ml[j]); const float a = __expf(gg[j] + m - mn), bb = __expf(ml[j] - mn);
                    carry[0] = carry[0] * a + bflo(loc[j].x) * bb; carry[1] = carry[1] * a + bfhi(loc[j].x) * bb; carry[2] = carry[2] * a + bflo(loc[j].y) * bb; carry[3] = carry[3] * a + bfhi(loc[j].y) * bb;
                    m = mn; }
            }
        } else {
            f32x4* p = NST + (size_t)bh * NCH * 16 + (r - 2048); f32x4 carry = (f32x4){0.f, 0.f, 0.f, 0.f}; float m = -INFINITY;
            for (int c0 = 0; c0 < NCH; c0 += 8) {
                f32x4 loc[8]; float gg[8], ml[8];
#pragma unroll
                for (int j = 0; j < 8; ++j) { loc[j] = p[(size_t)(c0 + j) * 16]; gg[j] = GCH[bh * NCH + c0 + j]; ml[j] = MLOC[bh * NCH + c0 + j]; }
#pragma unroll
                for (int j = 0; j < 8; ++j) { p[(size_t)(c0 + j) * 16] = carry;
                    const float mn = fmaxf(gg[j] + m, ml[j]); const float a = __expf(gg[j] + m - mn), bb = __expf(ml[j] - mn);
                    carry = carry * a + loc[j] * bb; m = mn; }
            }
        }
    }
}

__device__ __forceinline__ void p_mlstm_out(const Ctx& C, int l) {
    const bf16* proj = (const bf16*)(C.ws + WS_PROJ); const float* G = (const float*)(C.ws + WS_G);
    const float* CST = (const float*)(C.ws + WS_CST); const float* NST = (const float*)(C.ws + WS_NST); const float* MPREV = (const float*)(C.ws + WS_MISC) + 4096;
    bf16* MIXIN = (bf16*)(C.ws + WS_MIXIN);
    const float* cw = C.in[I_CONVW] + (size_t)l * 4 * 512; const float* cb = C.in[I_CONVB] + (size_t)l * 512;
    LAS float* qf = (LAS float*)(C.lds + RING_OFF);
    LAS float* kf = qf + 64 * KP;
    LAS float* Sm = kf + 64 * KP;
    LAS float* vf = Sm + 64 * KP;
    LAS float* Ct = vf + 64 * 128;
    LAS float* sv = Ct + 64 * 128;
    static_assert((3 * 64 * KP + 2 * 64 * 128 + 6 * 64) * 4 <= RING_BYTES, "mLSTM LDS");
    const int tid = ltid(), lane = tid & 63;
    for (int u = C.vcu; u < NBH * NCH; u += C.G) {
        const int bh = u / NCH, c = u % NCH, b = bh >> 2, h = bh & 3; const int n0 = b * SEQ + c * CHUNK;
        { const int s = tid >> 3, cg = tid & 7; float y[8];
            conv_silu8(proj, n0 + s, c * CHUNK + s, 1536 + h * 64 + cg * 8, cw + h * 64 + cg * 8, cb + h * 64 + cg * 8, 0.125f, y);
#pragma unroll
            for (int i = 0; i < 8; ++i) qf[s * KP + cg * 8 + i] = y[i];
            conv_silu8(proj, n0 + s, c * CHUNK + s, 1536 + 256 + h * 64 + cg * 8, cw + 256 + h * 64 + cg * 8, cb + 256 + h * 64 + cg * 8, 1.0f, y);
#pragma unroll
            for (int i = 0; i < 8; ++i) kf[s * KP + cg * 8 + i] = y[i];
            const bf16* vp = proj + (size_t)(n0 + s) * NPROJ + 2048 + h * 128 + cg * 16; float x[16]; unpack8(*(const v4u*)vp, x); unpack8(*(const v4u*)(vp + 8), x + 8);
#pragma unroll
            for (int i = 0; i < 16; ++i) vf[s * 128 + cg * 16 + i] = x[i];
            const f32x4* cp = (const f32x4*)(CST + (size_t)u * 8192);
#pragma unroll
            for (int i = 0; i < 4; ++i) *(LAS f32x4*)(Ct + (tid + NTHREADS * i) * 4) = cp[tid + NTHREADS * i]; }
        if (C.wave == 0) { const float ig = G[(size_t)(n0 + lane) * 8 + h], fg = G[(size_t)(n0 + lane) * 8 + 4 + h]; const float mp = MPREV[u];
            float bc = fminf(fg, 0.f) - log1pf(expf(-fabsf(fg)));
#pragma unroll
            for (int o = 1; o < 64; o <<= 1) { const float t = __shfl_up(bc, o); if (lane >= o) bc += t; }
            const float a = ig - bc; float pm = a;
#pragma unroll
            for (int o = 1; o < 64; o <<= 1) { const float t = __shfl_up(pm, o); if (lane >= o) pm = fmaxf(pm, t); }
            const float mt = bc + fmaxf(mp, pm);
            sv[lane] = bc; sv[64 + lane] = a; sv[128 + lane] = mt; sv[192 + lane] = __expf(bc + mp - mt); sv[320 + lane] = NST[(size_t)u * 64 + lane]; }
        __syncthreads();
        {
            const int t = tid >> 3, sg = tid & 7; float qr[64];
#pragma unroll
            for (int i = 0; i < 16; ++i) { const f32x4 q4 = *(const LAS f32x4*)(qf + t * KP + 4 * i); qr[4 * i] = q4.x; qr[4 * i + 1] = q4.y; qr[4 * i + 2] = q4.z; qr[4 * i + 3] = q4.w; }
            const float bt = sv[t] - sv[128 + t]; float dsum = 0.f;
#pragma unroll 2
            for (int j = 0; j < 8; ++j) { const int s = sg + 8 * j; float d = 0.f;
#pragma unroll
                for (int i = 0; i < 16; ++i) { const f32x4 k4 = *(const LAS f32x4*)(kf + s * KP + 4 * i); d += qr[4 * i] * k4.x + qr[4 * i + 1] * k4.y + qr[4 * i + 2] * k4.z + qr[4 * i + 3] * k4.w; }
                const float sc = (s <= t) ? d * __expf(sv[64 + s] + bt) : 0.f; Sm[t * KP + s] = sc; dsum += sc; }
            float nq = 0.f;
#pragma unroll
            for (int i = 0; i < 8; ++i) nq += qf[t * KP + sg * 8 + i] * sv[320 + sg * 8 + i];
            dsum += sv[192 + t] * nq;
            dsum += __shfl_xor(dsum, 1); dsum += __shfl_xor(dsum, 2); dsum += __shfl_xor(dsum, 4);
            if (sg == 0) sv[256 + t] = 1.0f / fmaxf(fabsf(dsum), __expf(-sv[128 + t])); }
        __syncthreads();
        {
            const int t = tid >> 3, vg = tid & 7; float acc[16];
#pragma unroll
            for (int i = 0; i < 16; ++i) acc[i] = 0.f;
            const float iw = sv[192 + t];
            for (int k = 0; k < 64; ++k) { const float a = qf[t * KP + k] * iw;
#pragma unroll
                for (int i4 = 0; i4 < 4; ++i4) { const f32x4 c4 = *(const LAS f32x4*)(Ct + k * 128 + vg * 16 + i4 * 4); acc[i4 * 4] += a * c4.x; acc[i4 * 4 + 1] += a * c4.y; acc[i4 * 4 + 2] += a * c4.z; acc[i4 * 4 + 3] += a * c4.w; } }
            for (int s = 0; s < 64; ++s) { const float a = Sm[t * KP + s];
#pragma unroll
                for (int i4 = 0; i4 < 4; ++i4) { const f32x4 v4 = *(const LAS f32x4*)(vf + s * 128 + vg * 16 + i4 * 4); acc[i4 * 4] += a * v4.x; acc[i4 * 4 + 1] += a * v4.y; acc[i4 * 4 + 2] += a * v4.z; acc[i4 * 4 + 3] += a * v4.w; } }
            const float dn = sv[256 + t];
            const bf16* op = proj + (size_t)(n0 + t) * NPROJ + 2560 + h * 128 + vg * 16; float o[16]; unpack8(*(const v4u*)op, o); unpack8(*(const v4u*)(op + 8), o + 8);
#pragma unroll
            for (int i = 0; i < 16; ++i) o[i] = acc[i] * dn * sigmoid_f(o[i]);
            bf16* dst = MIXIN + (size_t)(n0 + t) * DMODEL + 512 + h * 128 + vg * 16; *(v4u*)dst = pack8(o); *(v4u*)(dst + 8) = pack8(o + 8); }
        __syncthreads();
    }
}

__device__ __forceinline__ void p_da_combine(const Ctx& C, int l, float lam_init) {
    const bf16* ATTO = (const bf16*)(C.ws + WS_ATTO); bf16* MIXIN = (bf16*)(C.ws + WS_MIXIN);
    const int lane = ltid() & 63, gw = C.vcu * NWAVES + C.wave, NGW = C.G * NWAVES;
    const float s1 = wave_sum(C.in[I_LQ1][l * 64 + lane] * C.in[I_LK1][l * 64 + lane]), s2 = wave_sum(C.in[I_LQ2][l * 64 + lane] * C.in[I_LK2][l * 64 + lane]);
    const float lam = expf(s1) - expf(s2) + lam_init, osc = 1.0f - lam_init;
    const int h = lane >> 4, e8 = (lane & 15) * 8;
    float g[8]; { const f32x4 a = *(const f32x4*)(C.in[I_NG] + l * 128 + e8), b2 = *(const f32x4*)(C.in[I_NG] + l * 128 + e8 + 4); g[0] = a.x; g[1] = a.y; g[2] = a.z; g[3] = a.w; g[4] = b2.x; g[5] = b2.y; g[6] = b2.z; g[7] = b2.w; }
    for (int n = gw; n < NTOK; n += NGW) {
        float o0[8], o1[8]; unpack8(*(const v4u*)(ATTO + (size_t)n * DMODEL + h * 256 + e8), o0); unpack8(*(const v4u*)(ATTO + (size_t)n * DMODEL + h * 256 + 128 + e8), o1);
        float ss = 0.f;
#pragma unroll
        for (int i = 0; i < 8; ++i) { o0[i] -= lam * o1[i]; ss += o0[i] * o0[i]; }
        ss += __shfl_xor(ss, 1); ss += __shfl_xor(ss, 2); ss += __shfl_xor(ss, 4); ss += __shfl_xor(ss, 8);
        const float r = 1.0f / sqrtf(ss * (1.0f / 128.0f) + RMS_EPS) * osc;
#pragma unroll
        for (int i = 0; i < 8; ++i) o0[i] = o0[i] * r * g[i];
        *(v4u*)(MIXIN + (size_t)n * DMODEL + h * 128 + e8) = pack8(o0);
    }
}
typedef float f32x16 __attribute__((ext_vector_type(16)));
constexpr int TP = 72;
#define MFMA32(a, b, c) __builtin_amdgcn_mfma_f32_32x32x16_bf16((a), (b), (c), 0, 0, 0)
__device__ __forceinline__ bf16x8 frag_ld(const LAS bf16* tile, int row, int step, int h) { return *(const LAS bf16x8*)(tile + row * TP + step * 16 + 8 * h); }
__device__ __forceinline__ void tr_store16(LAS bf16* tile, int c0, int s, const v4u a, const v4u b) {
    const unsigned w[8] = {a.x, a.y, a.z, a.w, b.x, b.y, b.z, b.w};
#pragma unroll
    for (int i = 0; i < 8; ++i) { tile[(c0 + 2 * i) * TP + s] = (bf16)(w[i] & 0xffffu); tile[(c0 + 2 * i + 1) * TP + s] = (bf16)(w[i] >> 16); }
}

__device__ __forceinline__ void conv_fetch(const bf16* proj, int n, int t, int col, v4u* raw) {
#pragma unroll
    for (int j = 0; j < 4; ++j) { const int tt = t - 3 + j; raw[j] = (tt >= 0) ? *(const v4u*)(proj + (size_t)(n - 3 + j) * NPROJ + col) : (v4u){0u, 0u, 0u, 0u}; }
}
__device__ __forceinline__ void conv_stage(LAS float* cwl, const float* cw, const float* cb, int ch0, int tid) {
    if (tid < 320) cwl[tid] = (tid < 256) ? cw[(tid >> 6) * 512 + ch0 + (tid & 63)] : cb[ch0 + (tid - 256)];
}
__device__ __forceinline__ void conv_apply_l(const v4u* raw, const LAS float* cwl, int c0, float scale, float* y) {
    const f32x4 b0 = *(const LAS f32x4*)(cwl + 256 + c0), b1 = *(const LAS f32x4*)(cwl + 256 + c0 + 4);
    y[0] = b0.x; y[1] = b0.y; y[2] = b0.z; y[3] = b0.w; y[4] = b1.x; y[5] = b1.y; y[6] = b1.z; y[7] = b1.w;
#pragma unroll
    for (int j = 0; j < 4; ++j) { float x[8]; unpack8(raw[j], x);
        const f32x4 c0_ = *(const LAS f32x4*)(cwl + j * 64 + c0), c1_ = *(const LAS f32x4*)(cwl + j * 64 + c0 + 4);
        y[0] += c0_.x * x[0]; y[1] += c0_.y * x[1]; y[2] += c0_.z * x[2]; y[3] += c0_.w * x[3]; y[4] += c1_.x * x[4]; y[5] += c1_.y * x[5]; y[6] += c1_.z * x[6]; y[7] += c1_.w * x[7]; }
#pragma unroll
    for (int i = 0; i < 8; ++i) y[i] = y[i] * sigmoid_f(y[i]) * scale;
}
__device__ __forceinline__ void conv_apply(const v4u* raw, const float* cw, const float* cb, float scale, float* y) {
    const f32x4 b0 = *(const f32x4*)cb, b1 = *(const f32x4*)(cb + 4);
    y[0] = b0.x; y[1] = b0.y; y[2] = b0.z; y[3] = b0.w; y[4] = b1.x; y[5] = b1.y; y[6] = b1.z; y[7] = b1.w;
#pragma unroll
    for (int j = 0; j < 4; ++j) { float x[8]; unpack8(raw[j], x);
        const f32x4 c0 = *(const f32x4*)(cw + j * 512), c1 = *(const f32x4*)(cw + j * 512 + 4);
        y[0] += c0.x * x[0]; y[1] += c0.y * x[1]; y[2] += c0.z * x[2]; y[3] += c0.w * x[3]; y[4] += c1.x * x[4]; y[5] += c1.y * x[5]; y[6] += c1.z * x[6]; y[7] += c1.w * x[7]; }
#pragma unroll
    for (int i = 0; i < 8; ++i) y[i] = y[i] * sigmoid_f(y[i]) * scale;
}

__device__ __forceinline__ void p_mlstm_states_mfma(const Ctx& C, int l) {
    const bf16* proj = (const bf16*)(C.ws + WS_PROJ); const float* G = (const float*)(C.ws + WS_G);
    bf16* CST = (bf16*)(C.ws + WS_CST); float* NST = (float*)(C.ws + WS_NST); float* MLOC = (float*)(C.ws + WS_MISC); float* GCH = MLOC + 2048;
    const float* cw = C.in[I_CONVW] + (size_t)l * 4 * 512; const float* cb = C.in[I_CONVB] + (size_t)l * 512;
    LAS bf16* KeT = (LAS bf16*)(C.lds + RING_OFF);
    LAS bf16* Vt = KeT + 64 * TP;
    LAS float* ev = (LAS float*)(Vt + 128 * TP);
    const int tid = ltid(), lane = tid & 63, r = lane & 31, h = lane >> 5, s = tid & 63, cg = tid >> 6;
    v4u rk[4], rv[2]; float rig = 0.f, rfg = 0.f;
#define ST_FETCH(u_) do { const int bh_ = (u_) / NCH, c_ = (u_) % NCH, n0_ = (bh_ >> 2) * SEQ + c_ * CHUNK, hd_ = bh_ & 3; \
        conv_fetch(proj, n0_ + s, c_ * CHUNK + s, 1536 + 256 + hd_ * 64 + cg * 8, rk); const bf16* vp_ = proj + (size_t)(n0_ + s) * NPROJ + 2048 + hd_ * 128 + cg * 16; rv[0] = *(const v4u*)vp_; rv[1] = *(const v4u*)(vp_ + 8); \
        if (C.wave == 0) { rig = G[(size_t)(n0_ + lane) * 8 + hd_]; rfg = G[(size_t)(n0_ + lane) * 8 + 4 + hd_]; } } while (0)
    if (C.vcu < NBH * NCH) ST_FETCH(C.vcu);
    for (int u = C.vcu; u < NBH * NCH; u += C.G) {
        const int bh = u / NCH, hd = bh & 3;
        if (C.wave == 0) { const float ig = rig, fg = rfg;
            float bc = fminf(fg, 0.f) - log1pf(expf(-fabsf(fg)));
#pragma unroll
            for (int o = 1; o < 64; o <<= 1) { const float t = __shfl_up(bc, o); if (lane >= o) bc += t; }
            const float g = __shfl(bc, 63); const float w = g - bc + ig; const float m = wave_max(w);
            ev[lane] = __expf(w - m); if (lane == 0) { MLOC[u] = m; GCH[u] = g; } }
        __syncthreads();
        { float y[8]; conv_apply(rk, cw + 256 + hd * 64 + cg * 8, cb + 256 + hd * 64 + cg * 8, 1.0f, y);
            const float e = ev[s];
#pragma unroll
            for (int i = 0; i < 8; ++i) KeT[(cg * 8 + i) * TP + s] = (bf16)f2bf(y[i] * e);
            tr_store16(Vt, cg * 16, s, rv[0], rv[1]); }
        if (u + C.G < NBH * NCH) ST_FETCH(u + C.G);
        __syncthreads();
        { const int kb = C.wave & 1, vb = C.wave >> 1; f32x16 acc;
#pragma unroll
            for (int i = 0; i < 16; ++i) acc[i] = 0.f;
#pragma unroll
            for (int st = 0; st < 4; ++st) acc = MFMA32(frag_ld(KeT, kb * 32 + r, st, h), frag_ld(Vt, vb * 32 + r, st, h), acc);
            bf16* dst = CST + (size_t)u * 8192 + (size_t)(vb * 32 + r) * 64 + kb * 32 + 4 * h;
#pragma unroll
            for (int g = 0; g < 4; ++g) *(v2u*)(dst + 8 * g) = (v2u){pk2(acc[4 * g], acc[4 * g + 1]), pk2(acc[4 * g + 2], acc[4 * g + 3])}; }
        if (tid < 64) { float a = 0.f;
#pragma unroll 8
            for (int s_ = 0; s_ < 64; s_ += 2) { const unsigned w = *(const LAS unsigned*)(KeT + tid * TP + s_); a += bflo(w) + bfhi(w); }
            NST[(size_t)u * 64 + tid] = a; }
    }
#undef ST_FETCH
    __syncthreads();
}

__device__ __forceinline__ void p_mlstm_out_mfma(const Ctx& C, int l) {
    const bf16* proj = (const bf16*)(C.ws + WS_PROJ); const float* G = (const float*)(C.ws + WS_G);
    const bf16* CST = (const bf16*)(C.ws + WS_CST); const float* NST = (const float*)(C.ws + WS_NST); const float* MPREV = (const float*)(C.ws + WS_MISC) + 4096;
    bf16* MIXIN = (bf16*)(C.ws + WS_MIXIN);
    const float* cw = C.in[I_CONVW] + (size_t)l * 4 * 512; const float* cb = C.in[I_CONVB] + (size_t)l * 512;
    LAS bf16* Qt = (LAS bf16*)(C.lds + RING_OFF);
    LAS bf16* Kt = Qt + 64 * TP;
    LAS bf16* St = Kt + 64 * TP;
    LAS bf16* Vt = St + 64 * TP;
    LAS bf16* Ct = Vt + 128 * TP;
    LAS float* sv = (LAS float*)(Ct + 128 * TP);
    const int tid = ltid(), lane = tid & 63, r = lane & 31, h = lane >> 5;
    const int s = tid >> 3, cg = tid & 7, s2 = tid & 63, vg = tid >> 6, cv = tid >> 2, ck0 = (tid & 3) * 16, ot = (C.wave & 1) * 32 + r, ovb = C.wave >> 1;
    v4u rq[4], rk[4], rv[2], rc[2]; v2u ro[4], roc[4]; float rig = 0.f, rfg = 0.f, rmp = 0.f, rnp = 0.f;
#define OUT_FETCH(u_) do { const int bh_ = (u_) / NCH, c_ = (u_) % NCH, n0_ = (bh_ >> 2) * SEQ + c_ * CHUNK, hd_ = bh_ & 3; \
        conv_fetch(proj, n0_ + s, c_ * CHUNK + s, 1536 + hd_ * 64 + cg * 8, rq); conv_fetch(proj, n0_ + s, c_ * CHUNK + s, 1536 + 256 + hd_ * 64 + cg * 8, rk); \
        const bf16* vp_ = proj + (size_t)(n0_ + s2) * NPROJ + 2048 + hd_ * 128 + vg * 16; rv[0] = *(const v4u*)vp_; rv[1] = *(const v4u*)(vp_ + 8); \
        const v4u* cp_ = (const v4u*)(CST + (size_t)(u_) * 8192 + cv * 64 + ck0); rc[0] = cp_[0]; rc[1] = cp_[1]; \
        const bf16* op_ = proj + (size_t)(n0_ + ot) * NPROJ + 2560 + hd_ * 128 + ovb * 32 + 4 * h; _Pragma("unroll") for (int g_ = 0; g_ < 4; ++g_) ro[g_] = *(const v2u*)(op_ + 8 * g_); \
        if (C.wave == 0) { rig = G[(size_t)(n0_ + lane) * 8 + hd_]; rfg = G[(size_t)(n0_ + lane) * 8 + 4 + hd_]; rmp = MPREV[(u_)]; rnp = NST[(size_t)(u_) * 64 + lane]; } } while (0)
    if (C.vcu < NBH * NCH) OUT_FETCH(C.vcu);
    for (int u = C.vcu; u < NBH * NCH; u += C.G) {
        const int bh = u / NCH, c = u % NCH, b = bh >> 2, hd = bh & 3; const int n0 = b * SEQ + c * CHUNK;
        __syncthreads();
        { float y[8];
            conv_apply(rq, cw + hd * 64 + cg * 8, cb + hd * 64 + cg * 8, 0.125f, y); *(LAS v4u*)(Qt + s * TP + cg * 8) = pack8(y);
            conv_apply(rk, cw + 256 + hd * 64 + cg * 8, cb + 256 + hd * 64 + cg * 8, 1.0f, y); *(LAS v4u*)(Kt + s * TP + cg * 8) = pack8(y);
            tr_store16(Vt, vg * 16, s2, rv[0], rv[1]);
            *(LAS v4u*)(Ct + cv * TP + ck0) = rc[0]; *(LAS v4u*)(Ct + cv * TP + ck0 + 8) = rc[1];
#pragma unroll
            for (int g = 0; g < 4; ++g) roc[g] = ro[g]; }
        if (C.wave == 0) { const float ig = rig, fg = rfg; const float mp = rmp;
            float bc = fminf(fg, 0.f) - log1pf(expf(-fabsf(fg)));
#pragma unroll
            for (int o = 1; o < 64; o <<= 1) { const float t = __shfl_up(bc, o); if (lane >= o) bc += t; }
            const float a = ig - bc; float pm = a;
#pragma unroll
            for (int o = 1; o < 64; o <<= 1) { const float t = __shfl_up(pm, o); if (lane >= o) pm = fmaxf(pm, t); }
            const float mt = bc + fmaxf(mp, pm);
            sv[lane] = bc; sv[64 + lane] = a; sv[128 + lane] = mt; sv[192 + lane] = __expf(bc + mp - mt); sv[256 + lane] = rnp; }
        if (u + C.G < NBH * NCH) OUT_FETCH(u + C.G);
        __syncthreads();
        if (C.wave < 4) {
            const int sb = C.wave & 1, tb = C.wave >> 1; f32x16 x;
#pragma unroll
            for (int i = 0; i < 16; ++i) x[i] = 0.f;
#pragma unroll
            for (int st = 0; st < 4; ++st) x = MFMA32(frag_ld(Kt, sb * 32 + r, st, h), frag_ld(Qt, tb * 32 + r, st, h), x);
            const int t = tb * 32 + r; const float bt = sv[t] - sv[128 + t]; float dsum = 0.f;
#pragma unroll
            for (int g = 0; g < 4; ++g) { const int s0 = sb * 32 + 8 * g + 4 * h; float w[4];
#pragma unroll
                for (int i = 0; i < 4; ++i) { const int s = s0 + i; w[i] = (s <= t) ? x[4 * g + i] * __expf(sv[64 + s] + bt) : 0.f; }
                const unsigned p0 = pk2(w[0], w[1]), p1 = pk2(w[2], w[3]); dsum += (bflo(p0) + bfhi(p0)) + (bflo(p1) + bfhi(p1));
                *(LAS v2u*)(St + t * TP + s0) = (v2u){p0, p1}; }
            sv[384 + (sb * 2 + h) * 64 + t] = dsum;
        } else if (tid < 320) {
            const int t = tid - 256; float a = 0.f;
#pragma unroll 8
            for (int k = 0; k < 64; k += 2) { const unsigned w = *(const LAS unsigned*)(Qt + t * TP + k); a += bflo(w) * sv[256 + k] + bfhi(w) * sv[256 + k + 1]; }
            sv[320 + t] = a; }
        __syncthreads();
        {
            const int vb = C.wave >> 1, tb = C.wave & 1; f32x16 acc;
#pragma unroll
            for (int i = 0; i < 16; ++i) acc[i] = 0.f;
#pragma unroll
            for (int st = 0; st < 4; ++st) acc = MFMA32(frag_ld(Ct, vb * 32 + r, st, h), frag_ld(Qt, tb * 32 + r, st, h), acc);
            const int t = tb * 32 + r; const float iw = sv[192 + t];
#pragma unroll
            for (int i = 0; i < 16; ++i) acc[i] *= iw;
#pragma unroll
            for (int st = 0; st < 4; ++st) acc = MFMA32(frag_ld(Vt, vb * 32 + r, st, h), frag_ld(St, tb * 32 + r, st, h), acc);
            const float den = ((sv[384 + t] + sv[384 + 64 + t]) + (sv[384 + 128 + t] + sv[384 + 192 + t])) + iw * sv[320 + t];
            const float dn = 1.0f / fmaxf(fabsf(den), __expf(-sv[128 + t]));
            bf16* dst = MIXIN + (size_t)(n0 + t) * DMODEL + 512 + hd * 128 + vb * 32 + 4 * h;
#pragma unroll
            for (int g = 0; g < 4; ++g) { const v2u ow = roc[g]; const float o0 = bflo(ow.x), o1 = bfhi(ow.x), o2 = bflo(ow.y), o3 = bfhi(ow.y);
                *(v2u*)(dst + 8 * g) = (v2u){pk2(acc[4 * g] * dn * sigmoid_f(o0), acc[4 * g + 1] * dn * sigmoid_f(o1)), pk2(acc[4 * g + 2] * dn * sigmoid_f(o2), acc[4 * g + 3] * dn * sigmoid_f(o3))}; } }
    }
#undef OUT_FETCH
    __syncthreads();
}
constexpr size_t WS_TOTC = WS_CST + 32 * MiB;
constexpr size_t WS_TOTN = WS_NST + 512 * 1024;
constexpr int MS_DCUM = 6144, MS_TOTM = 8192, MS_TOTG = 8448;

__device__ __forceinline__ void p_mlstm_states_seq(const Ctx& C, int l) {
    const bf16* proj = (const bf16*)(C.ws + WS_PROJ); const float* G = (const float*)(C.ws + WS_G);
    bf16* CST = (bf16*)(C.ws + WS_CST); float* NST = (float*)(C.ws + WS_NST); float* MS = (float*)(C.ws + WS_MISC); float* MPREV = MS + 4096;
    float* TOTC = (float*)(C.ws + WS_TOTC); float* TOTN = (float*)(C.ws + WS_TOTN);
    const float* cw = C.in[I_CONVW] + (size_t)l * 4 * 512; const float* cb = C.in[I_CONVB] + (size_t)l * 512;
    LAS bf16* KeT = (LAS bf16*)(C.lds + RING_OFF);
    LAS bf16* Vt = KeT + 64 * TP;
    LAS float* ev = (LAS float*)(Vt + 128 * TP);
    LAS float* cwl = ev + 80;
    LAS bf16* Cs = (LAS bf16*)(cwl + 320);
#define CST_FLUSH(uu_) do { const int row_ = tid >> 2, pc_ = (tid & 3) * 16; const LAS v4u* sp_ = (const LAS v4u*)(Cs + row_ * TP + pc_); const v4u a_ = sp_[0], b_ = sp_[1]; \
        v4u* gp_ = (v4u*)(CST + (size_t)(uu_) * 8192 + row_ * 64 + pc_); gp_[0] = a_; gp_[1] = b_; } while (0)
    const int tid = ltid(), lane = tid & 63, r = lane & 31, h = lane >> 5, s = tid & 63, cg = tid >> 6;
    v4u rkA[4], rvA[2], rkB[4], rvB[2]; float rigA = 0.f, rfgA = 0.f, rigB = 0.f, rfgB = 0.f;
#define ST_FETCH(u_) do { const int bh_ = (u_) / NCH, c_ = (u_) % NCH, n0_ = (bh_ >> 2) * SEQ + c_ * CHUNK, hd_ = bh_ & 3; \
        conv_fetch(proj, n0_ + s, c_ * CHUNK + s, 1536 + 256 + hd_ * 64 + cg * 8, rk); const bf16* vp_ = proj + (size_t)(n0_ + s) * NPROJ + 2048 + hd_ * 128 + cg * 16; rv[0] = *(const v4u*)vp_; rv[1] = *(const v4u*)(vp_ + 8); \
        if (C.wave == 0) { rig = G[(size_t)(n0_ + lane) * 8 + hd_]; rfg = G[(size_t)(n0_ + lane) * 8 + 4 + hd_]; } } while (0)
    const bool itw = MK_SIDEJOB && C.wave >= 1 && C.wave <= 6; const int itot = TRQ_LAYERS * trq_per(C);
    LAS float* iscr = (LAS float*)(C.lds + (C.wave <= 5 ? RING_OFF + 32768 + (C.wave - 1) * 16896 : LDSX_OFF));
    float ira[64]; int ir = -1;
#define SIDE_OUT() do { if (ir >= 0) { const TrItem it_ = tr_decode(C, ir); tr_put(ira, iscr, lane); LDS_WAIT(); asm volatile("" ::: "memory"); tr_store(it_, iscr, lane); LDS_WAIT(); asm volatile("" ::: "memory"); ir = -1; } } while (0)
#define SIDE_STEP() do { if (itw) { const int q_ = trq_grab(C, lane); ir = (q_ < itot) ? trq_item(C, q_) : -1; if (ir >= 0) { const TrItem it_ = tr_decode(C, ir); tr_fetch(it_, ira, lane); } } } while (0)
#define SIDE_FLUSH() do { if (itw) SIDE_OUT(); } while (0)
    for (int vc = C.vcu; vc < 256; vc += C.G) {
        const int bh = vc >> 3, hd = bh & 3, u0 = bh * NCH + (vc & 7) * 8;
        f32x16 crun; float nrun = 0.f, mrun = -INFINITY, drun = 0.f;
#pragma unroll
        for (int i = 0; i < 16; ++i) crun[i] = 0.f;
        conv_stage(cwl, cw, cb, 256 + hd * 64, tid);
        { v4u (&rk)[4] = rkA; v4u (&rv)[2] = rvA; float& rig = rigA; float& rfg = rfgA; ST_FETCH(u0); }
        { v4u (&rk)[4] = rkB; v4u (&rv)[2] = rvB; float& rig = rigB; float& rfg = rfgB; ST_FETCH(u0 + 1); }
        auto body = [&](const int j, v4u (&rk)[4], v4u (&rv)[2], float& rig, float& rfg) __attribute__((always_inline)) {
            const int u = u0 + j;
            if (C.wave == 0) { const float ig = rig, fg = rfg;
                float bc = fminf(fg, 0.f) - log1pf(expf(-fabsf(fg)));
#pragma unroll
                for (int o = 1; o < 64; o <<= 1) { const float t = __shfl_up(bc, o); if (lane >= o) bc += t; }
                const float g = __shfl(bc, 63); const float w = g - bc + ig; const float m = wave_max(w);
                ev[lane] = __expf(w - m); if (lane == 0) { ev[64] = m; ev[65] = g; } }
            __syncthreads();
            if (j > 0) CST_FLUSH(u - 1);
            { float y[8]; conv_apply_l(rk, cwl, cg * 8, 1.0f, y);
                const float e = ev[s];
#pragma unroll
                for (int i = 0; i < 8; ++i) KeT[(cg * 8 + i) * TP + s] = (bf16)f2bf(y[i] * e);
                tr_store16(Vt, cg * 16, s, rv[0], rv[1]); }
            const float mloc = ev[64], gch = ev[65];
            SIDE_FLUSH();
            if (j < 6) ST_FETCH(u + 2);
            __syncthreads();
            const float mnew = fmaxf(gch + mrun, mloc), fa = __expf(gch + mrun - mnew), fb = __expf(mloc - mnew);
            { const int kb = C.wave & 1, vb = C.wave >> 1; f32x16 acc;
#pragma unroll
                for (int i = 0; i < 16; ++i) acc[i] = 0.f;
#pragma unroll
                for (int st = 0; st < 4; ++st) acc = MFMA32(frag_ld(KeT, kb * 32 + r, st, h), frag_ld(Vt, vb * 32 + r, st, h), acc);
                LAS bf16* dst = Cs + (vb * 32 + r) * TP + kb * 32 + 4 * h;
#pragma unroll
                for (int g = 0; g < 4; ++g) *(LAS v2u*)(dst + 8 * g) = (v2u){pk2(crun[4 * g], crun[4 * g + 1]), pk2(crun[4 * g + 2], crun[4 * g + 3])};
#pragma unroll
                for (int i = 0; i < 16; ++i) crun[i] = fa * crun[i] + fb * acc[i]; }
            if (tid < 64) { float a = 0.f;
#pragma unroll 8
                for (int s_ = 0; s_ < 64; s_ += 2) { const unsigned w = *(const LAS unsigned*)(KeT + tid * TP + s_); a += bflo(w) + bfhi(w); }
                NST[(size_t)u * 64 + tid] = nrun; nrun = fa * nrun + fb * a; }
            if (tid == 0) { MPREV[u] = mrun; MS[MS_DCUM + u] = drun; }
            mrun = mnew; drun += gch;
            SIDE_STEP();
        };
#pragma unroll 1
        for (int jj = 0; jj < 8; jj += 2) { body(jj, rkA, rvA, rigA, rfgA); body(jj + 1, rkB, rvB, rigB, rfgB); }
        __syncthreads(); CST_FLUSH(u0 + 7);
        SIDE_FLUSH();
        { const int kb = C.wave & 1, vb = C.wave >> 1; float* dst = TOTC + (size_t)vc * 8192 + (size_t)(vb * 32 + r) * 64 + kb * 32 + 4 * h;
#pragma unroll
            for (int g = 0; g < 4; ++g) *(f32x4*)(dst + 8 * g) = (f32x4){crun[4 * g], crun[4 * g + 1], crun[4 * g + 2], crun[4 * g + 3]}; }
        if (tid < 64) TOTN[vc * 64 + tid] = nrun;
        if (tid == 0) { MS[MS_TOTM + vc] = mrun; MS[MS_TOTG + vc] = drun; }
    }
#undef ST_FETCH
#undef CST_FLUSH
#undef SIDE_STEP
#undef SIDE_FLUSH
#undef SIDE_OUT
    __syncthreads();
}

__device__ __forceinline__ void p_mlstm_out_seq(const Ctx& C, int l) {
    const bf16* proj = (const bf16*)(C.ws + WS_PROJ); const float* G = (const float*)(C.ws + WS_G);
    const bf16* CST = (const bf16*)(C.ws + WS_CST); const float* NST = (const float*)(C.ws + WS_NST); const float* MS = (const float*)(C.ws + WS_MISC); const float* MPREV = MS + 4096;
    const float* TOTC = (const float*)(C.ws + WS_TOTC); const float* TOTN = (const float*)(C.ws + WS_TOTN);
    bf16* MIXIN = (bf16*)(C.ws + WS_MIXIN);
    const float* cw = C.in[I_CONVW] + (size_t)l * 4 * 512; const float* cb = C.in[I_CONVB] + (size_t)l * 512;
    LAS bf16* Qt = (LAS bf16*)(C.lds + RING_OFF);
    LAS bf16* Kt = Qt + 64 * TP;
    LAS bf16* St = Kt + 64 * TP;
    LAS bf16* Vt = St + 64 * TP;
    LAS bf16* Ct = Vt + 128 * TP;
    LAS float* sv = (LAS float*)(Ct + 128 * TP);
    const int tid = ltid(), lane = tid & 63, r = lane & 31, h = lane >> 5;
    const int s = tid >> 3, cg = tid & 7, s2 = tid & 63, vg = tid >> 6, cv = tid >> 2, ck0 = (tid & 3) * 16, ot = (C.wave & 1) * 32 + r, ovb = C.wave >> 1;
    v4u rq[4], rk[4], rv[2], rc[2], ro[2], rop[2]; float rig = 0.f, rfg = 0.f, rml = 0.f, rdc = 0.f, rnp = 0.f;
    LAS float* Os = sv + 640;
    LAS float* cwq = Os + 64 * 132; LAS float* cwk = cwq + 320;
    static_assert((3 * 64 + 2 * 128) * TP * 2 + 640 * 4 + 64 * 132 * 4 + 640 * 4 <= RING_BYTES, "mLSTM LDS");
#define OUT_FETCH(u_) do { const int bh_ = (u_) / NCH, c_ = (u_) % NCH, n0_ = (bh_ >> 2) * SEQ + c_ * CHUNK, hd_ = bh_ & 3; \
        conv_fetch(proj, n0_ + s, c_ * CHUNK + s, 1536 + hd_ * 64 + cg * 8, rq); conv_fetch(proj, n0_ + s, c_ * CHUNK + s, 1536 + 256 + hd_ * 64 + cg * 8, rk); \
        const bf16* vp_ = proj + (size_t)(n0_ + s2) * NPROJ + 2048 + hd_ * 128 + vg * 16; rv[0] = *(const v4u*)vp_; rv[1] = *(const v4u*)(vp_ + 8); \
        const v4u* cp_ = (const v4u*)(CST + (size_t)(u_) * 8192 + cv * 64 + ck0); rc[0] = cp_[0]; rc[1] = cp_[1]; \
        const bf16* op_ = proj + (size_t)(n0_ + s) * NPROJ + 2560 + hd_ * 128 + cg * 16; ro[0] = *(const v4u*)op_; ro[1] = *(const v4u*)(op_ + 8); \
        rml = MPREV[(u_)]; rdc = MS[MS_DCUM + (u_)]; \
        if (C.wave == 0) { rig = G[(size_t)(n0_ + lane) * 8 + hd_]; rfg = G[(size_t)(n0_ + lane) * 8 + 4 + hd_]; rnp = NST[(size_t)(u_) * 64 + lane]; } } while (0)
#define OUT_FLUSH(nb_) do { float hv_[16], og_[16]; const LAS f32x4* hp_ = (const LAS f32x4*)(Os + s * 132 + cg * 16); \
        _Pragma("unroll") for (int q_ = 0; q_ < 4; ++q_) { const f32x4 t4_ = hp_[q_]; hv_[4 * q_] = t4_.x; hv_[4 * q_ + 1] = t4_.y; hv_[4 * q_ + 2] = t4_.z; hv_[4 * q_ + 3] = t4_.w; } \
        unpack8(rop[0], og_); unpack8(rop[1], og_ + 8); _Pragma("unroll") for (int i_ = 0; i_ < 16; ++i_) hv_[i_] *= sigmoid_f(og_[i_]); \
        bf16* dp_ = MIXIN + (size_t)((nb_) + s) * DMODEL + 512 + hd * 128 + cg * 16; *(v4u*)dp_ = pack8(hv_); *(v4u*)(dp_ + 8) = pack8(hv_ + 8); } while (0)
    for (int vc = C.vcu; vc < 256; vc += C.G) {
        const int bh = vc >> 3, gi = vc & 7, b = bh >> 2, hd = bh & 3, u0 = bh * NCH + gi * 8;
        conv_stage(cwq, cw, cb, hd * 64, tid); conv_stage(cwk, cw, cb, 256 + hd * 64, tid);
        OUT_FETCH(u0);
        float cin[16], nin = 0.f, min_ = -INFINITY;
#pragma unroll
        for (int i = 0; i < 16; ++i) cin[i] = 0.f;
#pragma unroll 1
        for (int g2 = 0; g2 < gi; ++g2) { const int gv = (bh << 3) + g2; const float tm = MS[MS_TOTM + gv], tg = MS[MS_TOTG + gv];
            const f32x4* tp = (const f32x4*)(TOTC + (size_t)gv * 8192 + cv * 64 + ck0); const f32x4 t0 = tp[0], t1 = tp[1], t2 = tp[2], t3 = tp[3]; const float tn = (C.wave == 0) ? TOTN[gv * 64 + lane] : 0.f;
            const float mn = fmaxf(tg + min_, tm), fa = __expf(tg + min_ - mn), fb = __expf(tm - mn);
            const float tt[16] = {t0.x, t0.y, t0.z, t0.w, t1.x, t1.y, t1.z, t1.w, t2.x, t2.y, t2.z, t2.w, t3.x, t3.y, t3.z, t3.w};
#pragma unroll
            for (int i = 0; i < 16; ++i) cin[i] = fa * cin[i] + fb * tt[i];
            nin = fa * nin + fb * tn; min_ = mn; }
#pragma unroll 1
        for (int j = 0; j < 8; ++j) {
            const int u = u0 + j, c = gi * 8 + j; const int n0 = b * SEQ + c * CHUNK;
            const float mp = fmaxf(rdc + min_, rml); const float w1 = (min_ == -INFINITY) ? 0.f : __expf(rdc + min_ - mp), w2 = (rml == -INFINITY) ? 0.f : __expf(rml - mp);
            __syncthreads();
            if (j > 0) OUT_FLUSH(n0 - CHUNK);
            { float y[8];
                conv_apply_l(rq, cwq, cg * 8, 0.125f, y); *(LAS v4u*)(Qt + s * TP + cg * 8) = pack8(y);
                conv_apply_l(rk, cwk, cg * 8, 1.0f, y); *(LAS v4u*)(Kt + s * TP + cg * 8) = pack8(y);
                tr_store16(Vt, vg * 16, s2, rv[0], rv[1]);
                float cl[16]; unpack8(rc[0], cl); unpack8(rc[1], cl + 8);
#pragma unroll
                for (int i = 0; i < 16; ++i) cl[i] = w1 * cin[i] + w2 * cl[i];
                *(LAS v4u*)(Ct + cv * TP + ck0) = pack8(cl); *(LAS v4u*)(Ct + cv * TP + ck0 + 8) = pack8(cl + 8);
                rop[0] = ro[0]; rop[1] = ro[1]; }
            if (C.wave == 0) { const float ig = rig, fg = rfg;
                float bc = fminf(fg, 0.f) - log1pf(expf(-fabsf(fg)));
#pragma unroll
                for (int o = 1; o < 64; o <<= 1) { const float t = __shfl_up(bc, o); if (lane >= o) bc += t; }
                const float a = ig - bc; float pm = a;
#pragma unroll
                for (int o = 1; o < 64; o <<= 1) { const float t = __shfl_up(pm, o); if (lane >= o) pm = fmaxf(pm, t); }
                const float mt = bc + fmaxf(mp, pm);
                sv[lane] = bc; sv[64 + lane] = a; sv[128 + lane] = mt; sv[192 + lane] = __expf(bc + mp - mt); sv[256 + lane] = w1 * nin + w2 * rnp; }
            if (j < 7) OUT_FETCH(u + 1);
            __syncthreads();
            if (C.wave < 4) {
                const int sb = C.wave & 1, tb = C.wave >> 1; f32x16 x;
#pragma unroll
                for (int i = 0; i < 16; ++i) x[i] = 0.f;
#pragma unroll
                for (int st = 0; st < 4; ++st) x = MFMA32(frag_ld(Kt, sb * 32 + r, st, h), frag_ld(Qt, tb * 32 + r, st, h), x);
                const int t = tb * 32 + r; const float bt = sv[t] - sv[128 + t]; float dsum = 0.f;
#pragma unroll
                for (int g = 0; g < 4; ++g) { const int s0 = sb * 32 + 8 * g + 4 * h; float w[4];
#pragma unroll
                    for (int i = 0; i < 4; ++i) { const int ss = s0 + i; w[i] = (ss <= t) ? x[4 * g + i] * __expf(sv[64 + ss] + bt) : 0.f; }
                    const unsigned p0 = pk2(w[0], w[1]), p1 = pk2(w[2], w[3]); dsum += (bflo(p0) + bfhi(p0)) + (bflo(p1) + bfhi(p1));
                    *(LAS v2u*)(St + t * TP + s0) = (v2u){p0, p1}; }
                sv[384 + (sb * 2 + h) * 64 + t] = dsum;
            } else if (tid < 320) {
                const int t = tid - 256; float a = 0.f;
#pragma unroll 8
                for (int k = 0; k < 64; k += 2) { const unsigned w = *(const LAS unsigned*)(Qt + t * TP + k); a += bflo(w) * sv[256 + k] + bfhi(w) * sv[256 + k + 1]; }
                sv[320 + t] = a; }
            __syncthreads();
            {
                const int vb = C.wave >> 1, tb = C.wave & 1; f32x16 acc;
#pragma unroll
                for (int i = 0; i < 16; ++i) acc[i] = 0.f;
#pragma unroll
                for (int st = 0; st < 4; ++st) acc = MFMA32(frag_ld(Ct, vb * 32 + r, st, h), frag_ld(Qt, tb * 32 + r, st, h), acc);
                const int t = tb * 32 + r; const float iw = sv[192 + t];
#pragma unroll
                for (int i = 0; i < 16; ++i) acc[i] *= iw;
#pragma unroll
                for (int st = 0; st < 4; ++st) acc = MFMA32(frag_ld(Vt, vb * 32 + r, st, h), frag_ld(St, tb * 32 + r, st, h), acc);
                const float den = ((sv[384 + t] + sv[384 + 64 + t]) + (sv[384 + 128 + t] + sv[384 + 192 + t])) + iw * sv[320 + t];
                const float dn = 1.0f / fmaxf(fabsf(den), __expf(-sv[128 + t]));
                LAS float* od = Os + t * 132 + vb * 32 + 4 * h;
#pragma unroll
                for (int g = 0; g < 4; ++g) *(LAS f32x4*)(od + 8 * g) = (f32x4){acc[4 * g] * dn, acc[4 * g + 1] * dn, acc[4 * g + 2] * dn, acc[4 * g + 3] * dn}; }
        }
        __syncthreads();
        OUT_FLUSH(b * SEQ + (gi * 8 + 7) * CHUNK);
    }
#undef OUT_FETCH
#undef OUT_FLUSH
    __syncthreads();
}
template <int W> __device__ __forceinline__ void tr_reduce_step(float* val, bool bit, int mask) {
#pragma unroll
    for (int i = 0; i < W / 2; ++i) { const float keep = bit ? val[i + W / 2] : val[i], send = bit ? val[i] : val[i + W / 2]; val[i] = keep + __shfl_xor(send, mask); }
}
__device__ __forceinline__ void p_ln1_router(const Ctx& C, int l, bool claim = true, bool norouter = false, bool nostore = false, bool norows = false, int stsel = 3) {
    const bf16* XBr = (const bf16*)(C.ws + WS_XB); const unsigned char* XLO = (const unsigned char*)(C.ws + WS_XRES);
    const bf16* MIXO = (const bf16*)(C.ws + WS_MIXO); float* X1 = (float*)(C.ws + WS_X1); unsigned char* X1Q = (unsigned char*)(C.ws + WS_X1B);
    int* TOKE = (int*)(C.ws + WS_TOKE); int* TOKP = (int*)(C.ws + WS_TOKP); float* TOKG = (float*)(C.ws + WS_TOKG); int* ROWTOK = (int*)(C.ws + WS_ROWTOK);
    unsigned* cntg = (unsigned*)(C.ws + WS_CTL) + CW_CNT + 64 * l;
    const float* br = C.in[I_BR] + l * NEXP;
    LAS f32x4* wl = (LAS f32x4*)(C.lds + RING_OFF);
    LAS float* lg = (LAS float*)(C.lds + LDSX_OFF) + C.wave * (16 * 32);
    LAS int* lc = (LAS int*)(C.lds + LDSX_OFF + 8 * 16 * 32 * 4);
    const int tid = ltid(), lane = tid & 63;
    { const f32x4* WRP = (const f32x4*)(C.ws + WS_WRP) + (size_t)l * 8192;
        for (int idx = tid; idx < 8192; idx += NTHREADS) wl[idx] = WRP[idx]; }
    LAS f32x4* gbl = (LAS f32x4*)(C.lds + LDSX_OFF + 8 * 16 * 32 * 4 + 512);
    { float g_[16], b_[16]; load_vec16(C.in[I_LN1G] + l * DMODEL, lane, g_); load_vec16(C.in[I_LN1B] + l * DMODEL, lane, b_);
      if (C.wave == 0) {
#pragma unroll
        for (int q = 0; q < 4; ++q) { gbl[q * 64 + lane] = (f32x4){g_[4 * q], g_[4 * q + 1], g_[4 * q + 2], g_[4 * q + 3]}; gbl[(4 + q) * 64 + lane] = (f32x4){b_[4 * q], b_[4 * q + 1], b_[4 * q + 2], b_[4 * q + 3]}; } } }
    const int gw = C.vcu * NWAVES + C.wave, NGW = C.G * NWAVES, NGRP = NTOK / 4;
    for (int g0 = gw; g0 < NGRP; g0 += 4 * NGW) {
        if (tid < 64) lc[tid] = 0;
        __syncthreads();
        v4u pxb[4][2], pmx[4][2]; v2u plo[4][2] = {};
#define LN1_FETCH(grp_) do { _Pragma("unroll") for (int r = 0; r < 4; ++r) { const size_t n_ = (size_t)((grp_) * 4 + r) * DMODEL; \
            pxb[r][0] = __builtin_nontemporal_load((const v4u*)(XBr + n_ + 8 * lane)); pxb[r][1] = __builtin_nontemporal_load((const v4u*)(XBr + n_ + 512 + 8 * lane)); if (USE_XLO) { plo[r][0] = *(const v2u*)(XLO + n_ + 8 * lane); plo[r][1] = *(const v2u*)(XLO + n_ + 512 + 8 * lane); } \
            pmx[r][0] = __builtin_nontemporal_load((const v4u*)(MIXO + n_ + 8 * lane)); pmx[r][1] = __builtin_nontemporal_load((const v4u*)(MIXO + n_ + 512 + 8 * lane)); } } while (0)
        LN1_FETCH(g0);
#pragma unroll 1
        for (int blk = norows ? 4 : 0; blk < 4; ++blk) {
            const int grp = g0 + blk * NGW; if (grp >= NGRP) break;
            float xv[4][16];
#pragma unroll
            for (int r = 0; r < 4; ++r) { const size_t n = (size_t)(grp * 4 + r); float m[16]; typedef float f32x2_ __attribute__((ext_vector_type(2)));
                unpack8(pxb[r][0], xv[r]); unpack8(pxb[r][1], xv[r] + 8); unpack8(pmx[r][0], m); unpack8(pmx[r][1], m + 8);
                const unsigned w_[4] = {plo[r][0].x, plo[r][0].y, plo[r][1].x, plo[r][1].y};
#pragma unroll
                for (int i = 0; i < (USE_XLO ? 4 : 0); ++i) { const f32x2_ lo = __builtin_amdgcn_cvt_pk_f32_fp8((int)w_[i], false), hi = __builtin_amdgcn_cvt_pk_f32_fp8((int)w_[i], true);
                    xv[r][4 * i] += lo.x * (1.0f / XLO_SCALE); xv[r][4 * i + 1] += lo.y * (1.0f / XLO_SCALE); xv[r][4 * i + 2] += hi.x * (1.0f / XLO_SCALE); xv[r][4 * i + 3] += hi.y * (1.0f / XLO_SCALE); }
#pragma unroll
                for (int i = 0; i < 16; ++i) xv[r][i] = DN_ALPHA * xv[r][i] + m[i];
                { float gam[16], bet[16];
#pragma unroll
                  for (int q = 0; q < 4; ++q) { const f32x4 g4_ = gbl[q * 64 + lane], b4_ = gbl[(4 + q) * 64 + lane]; gam[4 * q] = g4_.x; gam[4 * q + 1] = g4_.y; gam[4 * q + 2] = g4_.z; gam[4 * q + 3] = g4_.w; bet[4 * q] = b4_.x; bet[4 * q + 1] = b4_.y; bet[4 * q + 2] = b4_.z; bet[4 * q + 3] = b4_.w; }
                  ln_row(xv[r], gam, bet); }
                if (!nostore) { typedef float f32x2q __attribute__((ext_vector_type(2)));
                    const v2u p0 = pack8_fp8(xv[r], XQ_SCALE), p1 = pack8_fp8(xv[r] + 8, XQ_SCALE); __builtin_nontemporal_store(p0, (v2u*)(X1Q + n * DMODEL + 8 * lane)); __builtin_nontemporal_store(p1, (v2u*)(X1Q + n * DMODEL + 512 + 8 * lane));
                    const unsigned pw_[4] = {p0.x, p0.y, p1.x, p1.y}; float rem_[16];
#pragma unroll
                    for (int i = 0; i < 4; ++i) { const f32x2q lo = __builtin_amdgcn_cvt_pk_f32_fp8((int)pw_[i], false), hi = __builtin_amdgcn_cvt_pk_f32_fp8((int)pw_[i], true);
                        rem_[4 * i] = xv[r][4 * i] - lo.x * (1.0f / XQ_SCALE); rem_[4 * i + 1] = xv[r][4 * i + 1] - lo.y * (1.0f / XQ_SCALE); rem_[4 * i + 2] = xv[r][4 * i + 2] - hi.x * (1.0f / XQ_SCALE); rem_[4 * i + 3] = xv[r][4 * i + 3] - hi.y * (1.0f / XQ_SCALE); }
                    if (MK_X1R8) { unsigned char* rr_ = (unsigned char*)X1 + n * DMODEL; __builtin_nontemporal_store(pack8_fp8(rem_, X1R_SCALE), (v2u*)(rr_ + 8 * lane)); __builtin_nontemporal_store(pack8_fp8(rem_ + 8, X1R_SCALE), (v2u*)(rr_ + 512 + 8 * lane)); }
                    else { bf16* rr_ = (bf16*)X1 + n * DMODEL; __builtin_nontemporal_store(pack8(rem_), (v4u*)(rr_ + 8 * lane)); __builtin_nontemporal_store(pack8(rem_ + 8), (v4u*)(rr_ + 512 + 8 * lane)); }   } else if (xv[r][0] == 123.456f) X1[n * DMODEL + lane] = xv[r][1]; }
            if (blk < 3 && g0 + (blk + 1) * NGW < NGRP) LN1_FETCH(g0 + (blk + 1) * NGW);
            typedef float f32x2p __attribute__((ext_vector_type(2)));
            f32x2p xa[16], xb[16];
#pragma unroll
            for (int i = 0; i < 16; ++i) { xa[i] = (f32x2p){xv[0][i], xv[1][i]}; xb[i] = (f32x2p){xv[2][i], xv[3][i]}; }
#pragma unroll 1
            for (int q = norouter ? 4 : 0; q < 4; ++q) {
                float acc[32];
#pragma unroll
                for (int e = 0; e < 8; ++e) { const LAS f32x4* wp = wl + ((q * 8 + e) * 4) * 64 + lane; const f32x4 w0 = wp[0], w1 = wp[64], w2 = wp[128], w3 = wp[192];
                    const float ww[16] = {w0.x, w0.y, w0.z, w0.w, w1.x, w1.y, w1.z, w1.w, w2.x, w2.y, w2.z, w2.w, w3.x, w3.y, w3.z, w3.w};
                    f32x2p a = xa[0] * ww[0], b = xb[0] * ww[0];
#pragma unroll
                    for (int i = 1; i < 16; ++i) { a += xa[i] * ww[i]; b += xb[i] * ww[i]; }
                    acc[0 * 8 + e] = a.x; acc[1 * 8 + e] = a.y; acc[2 * 8 + e] = b.x; acc[3 * 8 + e] = b.y; }
                tr_reduce_step<32>(acc, (lane >> 4) & 1, 16); tr_reduce_step<16>(acc, (lane >> 3) & 1, 8); tr_reduce_step<8>(acc, (lane >> 2) & 1, 4); tr_reduce_step<4>(acc, (lane >> 1) & 1, 2); tr_reduce_step<2>(acc, lane & 1, 1);
                const float tot = acc[0] + __shfl_xor(acc[0], 32);
                if (lane < 32) lg[(blk * 4 + (lane >> 3)) * 32 + q * 8 + (lane & 7)] = tot + br[q * 8 + (lane & 7)];
            }
        }
#undef LN1_FETCH
        LDS_WAIT(); asm volatile("" ::: "memory");
        int te[4] = {0, 0, 0, 0}, tp[4] = {0, 0, 0, 0}; float tg[4] = {0.f, 0.f, 0.f, 0.f};
        if (lane < 16 && (g0 + (lane >> 2) * NGW) < NGRP) {
            float lv[32];
#pragma unroll
            for (int e = 0; e < 32; ++e) lv[e] = lg[lane * 32 + e];
            unsigned taken = 0u; float val[4];
#pragma unroll
            for (int k = 0; k < 4; ++k) { int bi = 0; float bv = -INFINITY;
#pragma unroll
                for (int e = 0; e < 32; ++e) { const bool ok = !((taken >> e) & 1u) && (lv[e] > bv); bv = ok ? lv[e] : bv; bi = ok ? e : bi; }
                te[k] = bi; val[k] = bv; taken |= 1u << bi; }
            float s = 0.f;
#pragma unroll
            for (int k = 0; k < 4; ++k) { tg[k] = expf(val[k] - val[0]); s += tg[k]; }
#pragma unroll
            for (int k = 0; k < 4; ++k) { tg[k] = tg[k] / s; tp[k] = __hip_atomic_fetch_add(lc + te[k], 1, __ATOMIC_RELAXED, __HIP_MEMORY_SCOPE_WORKGROUP); }
        }
        __syncthreads();
        if (tid < 32 && claim) lc[32 + tid] = (int)__hip_atomic_fetch_add(cntg + tid, (unsigned)lc[tid], __ATOMIC_RELAXED, __HIP_MEMORY_SCOPE_AGENT);
        __syncthreads();
        const int mygrp = g0 + (lane >> 2) * NGW;
        if (lane < 16 && claim && mygrp < NGRP) { const int n = mygrp * 4 + (lane & 3);
#pragma unroll
            for (int k = 0; k < 4; ++k) { const int pos = lc[32 + te[k]] + tp[k]; TOKE[n * 4 + k] = te[k]; TOKP[n * 4 + k] = pos; TOKG[n * 4 + k] = tg[k]; ROWTOK[(size_t)te[k] * NTOK + pos] = n; } }
        __syncthreads();
    }
}

__device__ __forceinline__ void moe_tables(const Ctx& C, int l) {
    LAS int* ts = (LAS int*)(C.lds + LDSCTL_OFF); LAS int* cn = (LAS int*)(C.lds + LDSCTL_OFF + 160);
    const unsigned* cntg = (const unsigned*)(C.ws + WS_CTL) + CW_CNT + 64 * l;
    const int tid = ltid();
    if (tid < 64) { const int lane = tid; const int c = (lane < 32) ? (int)__hip_atomic_load(cntg + lane, __ATOMIC_RELAXED, __HIP_MEMORY_SCOPE_AGENT) : 0; int t = (c + 255) >> 8;
        int inc = t;
#pragma unroll
        for (int o = 1; o < 64; o <<= 1) { const int x = __shfl_up(inc, o); if (lane >= o) inc += x; }
        if (lane < 32) { cn[lane] = c; ts[lane] = inc - t; } if (lane == 32) ts[32] = inc; }
    __syncthreads();
}

__device__ __forceinline__ void p_ln2_combine(const Ctx& C, int l) {
    const bf16* X1 = (const bf16*)(C.ws + WS_X1); const unsigned char* X1Q = (const unsigned char*)(C.ws + WS_X1B); const unsigned char* Y = (const unsigned char*)(C.ws + WS_Y);
    const int* TOKE = (const int*)(C.ws + WS_TOKE); const int* TOKP = (const int*)(C.ws + WS_TOKP); const float* TOKG = (const float*)(C.ws + WS_TOKG);
    float* xo = C.out; unsigned char* XLOw = (unsigned char*)(C.ws + WS_XRES); bf16* XB = (bf16*)(C.ws + WS_XB); float* G = (float*)(C.ws + WS_G);
    const LAS int* ts = (const LAS int*)(C.lds + LDSCTL_OFF);
    LAS f32x4* wgl = (LAS f32x4*)(C.lds + RING_OFF);
    const int tid = ltid(), lane = tid & 63, gw = C.vcu * NWAVES + C.wave, NGW = C.G * NWAVES; const bool nextl = (l + 1 < DEPTH);
    if (nextl) load_gate_w(tid, C.in[I_WIN] + (size_t)(l + 1) * DMODEL * INW, wgl);
    __syncthreads();
    float gam[16], bet[16]; load_vec16(C.in[I_LN2G] + l * DMODEL, lane, gam); load_vec16(C.in[I_LN2B] + l * DMODEL, lane, bet);
    typedef int i32x4_ __attribute__((ext_vector_type(4)));
    i32x4_ ne[2], np[2]; f32x4 ng_[2];
#define LN2_ROUTE(n0_) do { _Pragma("unroll") for (int q = 0; q < 2; ++q) { int nn = (n0_) + q * NGW; nn = nn < NTOK ? nn : (NTOK - 1); ne[q] = *(const i32x4_*)(TOKE + nn * 4); np[q] = *(const i32x4_*)(TOKP + nn * 4); ng_[q] = *(const f32x4*)(TOKG + nn * 4); } } while (0)
    LN2_ROUTE(gw);
    for (int n = gw; n < NTOK; n += 2 * NGW) {
        v4u xr[2][2]; v2u xr8[2][2]; v2u xq[2][2]; v2u yr[2][4][2]; f32x4 g4[2]; int nrow[2];
#pragma unroll
        for (int q = 0; q < 2; ++q) { int nn = n + q * NGW; nn = nn < NTOK ? nn : (NTOK - 1); nrow[q] = nn; g4[q] = ng_[q];
            if (MK_X1R8) { const unsigned char* xp = (const unsigned char*)X1 + (size_t)nn * DMODEL; xr8[q][0] = __builtin_nontemporal_load((const v2u*)(xp + 8 * lane)); xr8[q][1] = __builtin_nontemporal_load((const v2u*)(xp + 512 + 8 * lane)); }
            else { const bf16* xp = X1 + (size_t)nn * DMODEL; xr[q][0] = __builtin_nontemporal_load((const v4u*)(xp + 8 * lane)); xr[q][1] = __builtin_nontemporal_load((const v4u*)(xp + 512 + 8 * lane)); }
            const unsigned char* xqp = X1Q + (size_t)nn * DMODEL; xq[q][0] = __builtin_nontemporal_load((const v2u*)(xqp + 8 * lane)); xq[q][1] = __builtin_nontemporal_load((const v2u*)(xqp + 512 + 8 * lane));
#pragma unroll
            for (int k = 0; k < 4; ++k) { const unsigned char* yp = Y + ((size_t)ts[ne[q][k]] * 256 + np[q][k]) * DMODEL; yr[q][k][0] = __builtin_nontemporal_load((const v2u*)(yp + 8 * lane)); yr[q][k][1] = __builtin_nontemporal_load((const v2u*)(yp + 512 + 8 * lane)); } }
        if (n + 2 * NGW < NTOK) LN2_ROUTE(n + 2 * NGW);
#pragma unroll
        for (int q = 0; q < 2; ++q) {
            if (q == 1 && n + NGW >= NTOK) break;
            typedef float f32x2_ __attribute__((ext_vector_type(2)));
            float v[16];
            if (MK_X1R8) { const unsigned w[4] = {xr8[q][0].x, xr8[q][0].y, xr8[q][1].x, xr8[q][1].y};
#pragma unroll
              for (int i = 0; i < 4; ++i) { const f32x2_ lo = __builtin_amdgcn_cvt_pk_f32_fp8((int)w[i], false), hi = __builtin_amdgcn_cvt_pk_f32_fp8((int)w[i], true);
                  v[4 * i] = lo.x * (1.0f / X1R_SCALE); v[4 * i + 1] = lo.y * (1.0f / X1R_SCALE); v[4 * i + 2] = hi.x * (1.0f / X1R_SCALE); v[4 * i + 3] = hi.y * (1.0f / X1R_SCALE); } }
            else { unpack8(xr[q][0], v); unpack8(xr[q][1], v + 8); }
            { const unsigned w[4] = {xq[q][0].x, xq[q][0].y, xq[q][1].x, xq[q][1].y};
#pragma unroll
              for (int i = 0; i < 4; ++i) { const f32x2_ lo = __builtin_amdgcn_cvt_pk_f32_fp8((int)w[i], false), hi = __builtin_amdgcn_cvt_pk_f32_fp8((int)w[i], true);
                  v[4 * i] += lo.x * (1.0f / XQ_SCALE); v[4 * i + 1] += lo.y * (1.0f / XQ_SCALE); v[4 * i + 2] += hi.x * (1.0f / XQ_SCALE); v[4 * i + 3] += hi.y * (1.0f / XQ_SCALE); } }
#pragma unroll
            for (int i = 0; i < 16; ++i) v[i] *= DN_ALPHA;
#pragma unroll
            for (int k = 0; k < 4; ++k) { const float gk = g4[q][k] * (1.0f / YQ_SCALE); const unsigned w[4] = {yr[q][k][0].x, yr[q][k][0].y, yr[q][k][1].x, yr[q][k][1].y};
#pragma unroll
                for (int i = 0; i < 4; ++i) { const f32x2_ lo = __builtin_amdgcn_cvt_pk_f32_fp8((int)w[i], false), hi = __builtin_amdgcn_cvt_pk_f32_fp8((int)w[i], true);
                    v[4 * i] += gk * lo.x; v[4 * i + 1] += gk * lo.y; v[4 * i + 2] += gk * hi.x; v[4 * i + 3] += gk * hi.y; } }
            ln_row(v, gam, bet);
            const int nn = nrow[q];
            if (!nextl) store_row_f32_nt(xo + (size_t)nn * DMODEL, lane, v);
            if (nextl) { store_row_bf16_nt(XB + (size_t)nn * DMODEL, lane, v); { float lo_[16];
#pragma unroll
                for (int i = 0; i < 16; ++i) lo_[i] = v[i] - __uint_as_float(f2bf(v[i]) << 16);
                if (USE_XLO) store_row_fp8(XLOw + (size_t)nn * DMODEL, lane, lo_, XLO_SCALE);
                store_row_fp8_nt((unsigned char*)(C.ws + WS_XQ) + (size_t)nn * DMODEL, lane, v, XQ_SCALE); }
                gates_row(v, wgl, C.in[I_GATEB] + (l + 1) * 8, G + (size_t)nn * 8, lane); }
        }
    }
#undef LN2_ROUTE
    __syncthreads();
}
#ifndef MK_RELMODE
#define MK_RELMODE 0
#endif
__device__ __forceinline__ void xcd_barrier_w(const XcdBarrier& b, const Ctx& C, volatile LAS unsigned* rel, int minitems = 0) {
    asm volatile("s_waitcnt vmcnt(0)" ::: "memory");
    if (threadIdx.x == 0) *rel = 0u;
    __syncthreads();
    if (C.wave == 0) {
        if (threadIdx.x == 0) {
            unsigned* bar = b.bar;
            __builtin_amdgcn_s_waitcnt(0);
            unsigned nloc = b.st[0], nx = b.st[1];
            if (nloc == 0u) { xcd_barrier_complete(bar, b.x, nloc, nx); b.st[0] = nloc; b.st[1] = nx; }
            const unsigned old = xb_add(&bar[XB_XSUB(b.x)], 1u);
            const unsigned gen = old / nloc;
            if (old + 1u == (gen + 1u) * nloc) {
                if (MK_RELMODE == 0) *rel = 1u;
                __builtin_amdgcn_fence(__ATOMIC_RELEASE, "agent");
                asm volatile("s_waitcnt vmcnt(0)" ::: "memory");
                const unsigned og = xb_add(&bar[XB_TOP], 1u);
                const unsigned tg = og / nx;
                if (og + 1u == (tg + 1u) * nx) xb_add(&bar[XB_TOPGEN], 1u);
                else XB_SPIN(xb_ld(&bar[XB_TOPGEN]) == tg, bar);
                *rel = 1u;
                __builtin_amdgcn_fence(__ATOMIC_ACQUIRE, "agent");
                xb_add(&bar[XB_XGEN(b.x)], 1u);
                asm volatile("s_waitcnt vmcnt(0)" ::: "memory");
            } else {
                if (MK_RELMODE == 0) { XB_SPIN(xb_ld(&bar[XB_XSUB(b.x)]) < (gen + 1u) * nloc, bar);
                    *rel = 1u; }
                XB_SPIN(xb_ld(&bar[XB_XGEN(b.x)]) == gen, bar);
                *rel = 1u;
                __builtin_amdgcn_fence(__ATOMIC_ACQUIRE, "agent");
                asm volatile("s_waitcnt vmcnt(0)" ::: "memory");
            }
        }
    } else {
        const int lane = ltid() & 63, total = TRQ_LAYERS * trq_per(C); LAS float* scr = (LAS float*)(C.lds + RING_OFF + (C.wave - 1) * 16896);
        int done = 0;
        while (done < minitems || *rel == 0u) { const int q = trq_grab(C, lane); if (q >= total) break; const int r = trq_item(C, q); if (r >= 0) tr_one(C, r, scr, lane); ++done; }
    }
    __syncthreads();
}

struct Args { const float* in[21]; float* out; unsigned char* ws; int ph_lo, ph_hi, li, pad; };
__global__ void __launch_bounds__(NTHREADS, 2) mega_fwd(Args args) {
    extern __shared__ __attribute__((aligned(16))) unsigned char lds[];
    Ctx C;
    C.lds = (LAS unsigned char*)lds; C.wave = __builtin_amdgcn_readfirstlane(threadIdx.x >> 6);
    C.G = gridDim.x; { const int bx = blockIdx.x; C.vcu = (C.G % 8 == 0) ? (bx % 8) * (C.G / 8) + bx / 8 : bx; }
    C.ws = args.ws; C.in = args.in; C.out = args.out;
    volatile LAS unsigned* MISC = (volatile LAS unsigned*)(C.lds + MISC_OFF);
    for (int u = threadIdx.x; u < (LDSX_OFF - LDSCTL_OFF) / 4; u += NTHREADS) ((LAS unsigned*)(C.lds + LDSCTL_OFF))[u] = 0u;
    __syncthreads();
    unsigned* ctl = (unsigned*)(C.ws + WS_CTL);
    XcdBarrier bar = xcd_barrier_post(ctl + CW_BAR + args.li * XCD_BAR_WORDS, MISC + 8);
    const int lo = args.ph_lo, hi = args.ph_hi;
#define IN(k) (lo <= (k) && (k) < hi)
#ifndef MK_DBL
#define MK_DBL -1
#endif
#define REP(kind) _Pragma("unroll 1") for (int rep_ = 0; rep_ < ((kind) == MK_DBL ? 2 : 1); ++rep_)
#ifdef MK_PROBE_A
    LAS unsigned long long* tacc = (LAS unsigned long long*)(C.lds + LDSX_OFF + 20480);
    if (blockIdx.x == 0 && threadIdx.x == 0) { for (int i = 0; i < 16; ++i) tacc[i] = 0ull; tacc[14] = tacc[15] = wall_clock64(); }
#define stamper (blockIdx.x == 0 && threadIdx.x == 0)
#define STAMP(kind) do { if (stamper) { const unsigned long long now_ = wall_clock64(); tacc[kind] += now_ - tacc[14]; tacc[14] = now_; } } while (0)
#define SEAM(k) do { if (IN(k) && IN((k) + 1)) xcd_barrier(bar); STAMP((k) == 0 ? 0 : 1 + ((k) - 1) % NPH_LAYER); } while (0)
#else
#define STAMP(kind) do { } while (0)
#define SEAM(k) do { if (IN(k) && IN((k) + 1)) { xcd_barrier_w(bar, C, MISC + 10); if (MK_DBL == 12) xcd_barrier(bar); } } while (0)
#define SEAMW(k, n) do { if (IN(k) && IN((k) + 1)) { xcd_barrier_w(bar, C, MISC + 10, (n)); if (MK_DBL == 12) xcd_barrier(bar); } } while (0)
#ifndef MK_TAILITEMS
#define MK_TAILITEMS 3
#endif
#define MOE_IDLE(nN, xs) ((C.G == 256) ? ((((const LAS int*)(C.lds + LDSCTL_OFF))[32] + 8 * (32 / (nN)) - 1) / (8 * (32 / (nN))) - ((((const LAS int*)(C.lds + LDSCTL_OFF))[32] - ((int)blockIdx.x >> 3) / (nN) - ((((int)blockIdx.x & 7) + (xs)) & 7) * (32 / (nN)) + 8 * (32 / (nN)) - 1) / (8 * (32 / (nN))))) : 0)
#ifndef MK_DOWN_XS
#define MK_DOWN_XS 3
#endif
#endif
    if (IN(0)) { REP(0) p_prologue(C); SEAM(0); }
#pragma unroll 1
    for (int l = 0; l < DEPTH; ++l) {
        const int pb = 1 + l * NPH_LAYER;
        bf16* XB = (bf16*)(C.ws + WS_XB); bf16* PROJ = (bf16*)(C.ws + WS_PROJ);
        if (IN(pb + 0)) {
            { pg8::Gemm g{XB, (const bf16*)(C.ws + WS_WIN) + (size_t)l * NPROJ * DMODEL, NTOK, 2048, DMODEL}; pg8::StaticOrder S; S.init(NTOK, 2048, C.G, (int)blockIdx.x);
              pg8::EpiBf16<0> E{PROJ, NPROJ, nullptr, 512, 512, attn_body::C2};
              REP(1) pg8::gemm_phase<pg8::EpiBf16<0>, pg8::StaticOrder, true, true, false>(C.lds + RING_OFF, g, S, E); }
            { pg8::Gemm g{(const bf16*)(C.ws + WS_XQ), (const bf16*)(C.ws + WS_WINQ + (size_t)l * 1536 * DMODEL), NTOK, 1024, DMODEL / 2}; pg8::StaticOrder S; S.init(NTOK, 1024, C.G, (int)blockIdx.x);
              pg8::EpiBf16<0> E{PROJ + 2048, NPROJ, nullptr, 0, 0, 1.0f, 1.0f / (XQ_SCALE * WQ_SCALE)};
              REP(1) pg8::gemm_phase<pg8::EpiBf16<0>, pg8::StaticOrder, true, true, false, true>(C.lds + RING_OFF, g, S, E); }
            SEAM(pb + 0);
        }
        if (IN(pb + 1)) { REP(2) p_mlstm_states_seq(C, l); SEAM(pb + 1); }
        if (IN(pb + 3)) {
            REP(11) p_mlstm_out_seq(C, l); STAMP(11);
            { const int ln_ = ltid() & 63; const float s1 = wave_sum(C.in[I_LQ1][l * 64 + ln_] * C.in[I_LK1][l * 64 + ln_]), s2 = wave_sum(C.in[I_LQ2][l * 64 + ln_] * C.in[I_LK2][l * 64 + ln_]);
              const float lam_init = __uint_as_float(__builtin_amdgcn_readfirstlane(__float_as_uint(0.8f - 0.6f * expf(-0.3f * (float)l)))); const float lam = __uint_as_float(__builtin_amdgcn_readfirstlane(__float_as_uint(expf(s1) - expf(s2) + lam_init)));
              REP(4) for (int vc = C.vcu; vc < 256; vc += C.G) attn_body::attn_phase((char*)lds + RING_OFF, (const attn_body::bf16*)PROJ, (attn_body::bf16*)(C.ws + WS_ATTO), (attn_body::bf16*)(C.ws + WS_MIXIN), C.in[I_NG] + l * 128, lam, 1.0f - lam_init, vc); }
            SEAM(pb + 3);
        }
        if (IN(pb + 5)) {
#if MK_OUTFP8
            pg8::Gemm g{(const bf16*)(C.ws + WS_MIXIN), (const bf16*)(C.ws + WS_WOUT + (size_t)l * DMODEL * DMODEL), NTOK, DMODEL, DMODEL / 2}; pg8::StaticOrder S; S.init(NTOK, DMODEL, C.G, (int)blockIdx.x);
            pg8::EpiBf16<0> E{(bf16*)(C.ws + WS_MIXO), DMODEL, nullptr, 0, 0, 1.0f, 1.0f / (MQ_SCALE * WQ_SCALE)};
            REP(6) pg8::gemm_phase<pg8::EpiBf16<0>, pg8::StaticOrder, true, true, false, true>(C.lds + RING_OFF, g, S, E);
#else
            pg8::Gemm g{(const bf16*)(C.ws + WS_MIXIN), (const bf16*)(C.ws + WS_WOUT) + (size_t)l * DMODEL * DMODEL, NTOK, DMODEL, DMODEL}; pg8::StaticOrder S; S.init(NTOK, DMODEL, C.G, (int)blockIdx.x);
            pg8::EpiBf16<0> E{(bf16*)(C.ws + WS_MIXO), DMODEL, nullptr, 0, 0, 1.0f};
            REP(6) pg8::gemm_phase<pg8::EpiBf16<0>, pg8::StaticOrder, true, true, false>(C.lds + RING_OFF, g, S, E);
#endif
            SEAM(pb + 5);
        }
        if (IN(pb + 6)) { p_ln1_router(C, l); if (MK_DBL == 7) p_ln1_router(C, l, false); if (MK_DBL == 13) p_ln1_router(C, l, false, true); if (MK_DBL == 14) p_ln1_router(C, l, false, true, true); if (MK_DBL == 15) p_ln1_router(C, l, false, true, true, true); if (MK_DBL == 16) p_ln1_router(C, l, false, true, false, false, 1); if (MK_DBL == 17) p_ln1_router(C, l, false, true, false, false, 2); if (l > 0) trq_drain(C, l); SEAM(pb + 6); }
        if (IN(pb + 7)) {
            moe_tables(C, l);
            pg8::Gemm g{(const bf16*)(C.ws + WS_X1B), (const bf16*)(C.ws + WS_WGU + (size_t)l * NEXP * 2 * DFF * DMODEL), 0, 0, DMODEL / 2};
            pg8::MoeOrder S{(const LAS int*)(C.lds + LDSCTL_OFF), (const LAS int*)(C.lds + LDSCTL_OFF + 160), (const int*)(C.ws + WS_ROWTOK), 8, C.G, (int)blockIdx.x, NTOK, (LAS unsigned*)(C.lds + LDSX_OFF)};
            pg8::EpiSwiglu E{(bf16*)(C.ws + WS_H), DFF, C.in[I_BGU] + (size_t)l * NEXP * 2 * DFF, DFF, 1.0f / (XQ_SCALE * WQ_SCALE), HQ_SCALE, 0, (const LAS float*)(C.lds + LDSX_OFF + 16384)};
            REP(8) pg8::gemm_phase<pg8::EpiSwiglu, pg8::MoeOrder, true, true, true, true>(C.lds + RING_OFF, g, S, E);
            if (MK_DBL == 21) pg8::gemm_phase<pg8::EpiSwiglu, pg8::MoeOrder, true, true, true, true>(C.lds + RING_OFF, g, S, E);
            if (MK_DBL == 18 || MK_DBL == 19) { pg8::EpiSwiglu E2 = E; E2.dbg = (MK_DBL == 18) ? 2 : 1; pg8::gemm_phase<pg8::EpiSwiglu, pg8::MoeOrder, true, true, true, true>(C.lds + RING_OFF, g, S, E2); }
            SEAMW(pb + 7, MK_TAILITEMS * MOE_IDLE(8, 0));
        }
        if (IN(pb + 8)) {
            if (!IN(pb + 7)) moe_tables(C, l);
            pg8::Gemm g{(const bf16*)(C.ws + WS_H), (const bf16*)(C.ws + WS_WDN + (size_t)l * NEXP * DMODEL * DFF), 0, 0, DFF / 2};
            pg8::MoeOrder S{(const LAS int*)(C.lds + LDSCTL_OFF), (const LAS int*)(C.lds + LDSCTL_OFF + 160), (const int*)(C.ws + WS_ROWTOK), 4, C.G, (int)blockIdx.x, NTOK, (LAS unsigned*)(C.lds + LDSX_OFF), MK_DOWN_XS};
            pg8::EpiFp8 E{(bf16*)(C.ws + WS_Y), DMODEL, C.in[I_BDN] + (size_t)l * NEXP * DMODEL, DMODEL, 0, 1.0f, 1.0f / (HQ_SCALE * WQ_SCALE), 0, 0u, YQ_SCALE, (const LAS float*)(C.lds + LDSX_OFF + 16384)};
            REP(9) pg8::gemm_phase<pg8::EpiFp8, pg8::MoeOrder, true, true, false, true>(C.lds + RING_OFF, g, S, E);
            if (MK_DBL == 20) { pg8::EpiFp8 E2 = E; E2.dbg = 2; pg8::gemm_phase<pg8::EpiFp8, pg8::MoeOrder, true, true, false, true>(C.lds + RING_OFF, g, S, E2); }
            SEAMW(pb + 8, MK_TAILITEMS * MOE_IDLE(4, MK_DOWN_XS));
        }
        if (IN(pb + 9)) { if (!IN(pb + 7)) moe_tables(C, l); REP(10) p_ln2_combine(C, l); SEAM(pb + 9); }
    }
#ifdef MK_PROBE_A
    xcd_barrier(bar);
    if (stamper) { const unsigned long long now_ = wall_clock64(); tacc[10] += now_ - tacc[14]; const float tot = (float)(now_ - tacc[15]);
        __hip_atomic_store((float*)(ctl + 8), (float)tacc[MK_PROBE_A] / tot, __ATOMIC_RELAXED, __HIP_MEMORY_SCOPE_AGENT); __hip_atomic_store((float*)(ctl + 9), (float)tacc[MK_PROBE_B] / tot, __ATOMIC_RELAXED, __HIP_MEMORY_SCOPE_AGENT); }
    xcd_barrier(bar);
    { const float fa = __hip_atomic_load((float*)(ctl + 8), __ATOMIC_RELAXED, __HIP_MEMORY_SCOPE_AGENT), fb = __hip_atomic_load((float*)(ctl + 9), __ATOMIC_RELAXED, __HIP_MEMORY_SCOPE_AGENT);
        const size_t gid = (size_t)blockIdx.x * NTHREADS + threadIdx.x, nth = (size_t)gridDim.x * NTHREADS;
        for (size_t i = gid; i < (size_t)NTOK * DMODEL; i += nth) { float v = C.out[i] * (1.0f + 4.0f * fa); if (i == 0) v += 1000.0f * fb; C.out[i] = v; } }
#endif
#undef IN
#undef SEAM
}

#ifndef MK_MODE
#define MK_MODE 0
#endif
static int mega_grid() {
    static int grid = 0;
    if (grid == 0) {
        int dev = 0, cus = 0, per_cu = 0;
        if (hipGetDevice(&dev) != hipSuccess || hipDeviceGetAttribute(&cus, hipDeviceAttributeMultiprocessorCount, dev) != hipSuccess) { grid = -1; return grid; }
        if (hipFuncSetAttribute((const void*)mega_fwd, hipFuncAttributeMaxDynamicSharedMemorySize, LDS_BYTES) != hipSuccess) { fprintf(stderr, "kernel_launch: hipFuncSetAttribute failed\n"); grid = -1; return grid; }
        if (hipOccupancyMaxActiveBlocksPerMultiprocessor(&per_cu, (const void*)mega_fwd, NTHREADS, LDS_BYTES) != hipSuccess || per_cu < 1) fprintf(stderr, "kernel_launch: occupancy query reports %d\n", per_cu);
        (void)hipGetLastError();
        grid = cus;
    }
    return grid;
}
static void mega_launch(void* const* d_in, float* d_out, unsigned char* ws, hipStream_t stream, int lo, int hi, int li) {
    const int grid = mega_grid(); if (grid <= 0) return;
    Args a{};
    for (int i = 0; i < 21; ++i) a.in[i] = (const float*)d_in[i];
    a.out = d_out; a.ws = ws; a.ph_lo = lo; a.ph_hi = hi; a.li = li; a.pad = 0;
    hipLaunchKernelGGL(mega_fwd, dim3(grid), dim3(NTHREADS), LDS_BYTES, stream, a);
    const hipError_t le = hipPeekAtLastError();
    if (le != hipSuccess) fprintf(stderr, "kernel_launch: launch failed: %s\n", hipGetErrorName(le));
}
extern "C" void kernel_launch(void* const* d_in, const int* in_sizes, int n_in, void* d_out, int out_size, void* d_ws, size_t ws_size, hipStream_t stream) {
    if (n_in != 21 || in_sizes[0] != NTOK * DMODEL || out_size != NTOK * DMODEL || ws_size < WS_END) { fprintf(stderr, "kernel_launch: unexpected shapes (n_in %d, ws %zu)\n", n_in, ws_size); return; }
    unsigned char* ws = (unsigned char*)d_ws;
    if (hipMemsetAsync(ws + WS_CTL, 0, CTL_ZERO_BYTES, stream) != hipSuccess) { fprintf(stderr, "kernel_launch: memset failed\n"); return; }
#if MK_MODE == 0
    mega_launch(d_in, (float*)d_out, ws, stream, 0, NPHASES, 0);
#else
    for (int ph = 0; ph < NPHASES; ++ph) mega_launch(d_in, (float*)d_out, ws, stream, ph, ph + 1, 0);
#endif
}
```

```cpp
#include <hip/hip_runtime.h>
#include <cstdio>
#include <cstdint>
#include <cmath>
namespace pg8 {
#define PG8_LAS __attribute__((address_space(3)))
#ifndef PG8_STORES_IN_FLIGHT
#define PG8_STORES_IN_FLIGHT 0
#endif
#define PG8_NSTORE(n) (PG8_STORES_IN_FLIGHT ? (n) : 0)
typedef unsigned short bf16_t;
typedef short bf16x8 __attribute__((ext_vector_type(8)));
typedef float f32x4 __attribute__((ext_vector_type(4)));
typedef unsigned u32x4 __attribute__((ext_vector_type(4)));
typedef int i32x4_t __attribute__((ext_vector_type(4)));
typedef int i32x8_t __attribute__((ext_vector_type(8)));
constexpr int BM = 256, BK = 64, HALF = 128, HTB = HALF * BK * 2  , STAGE_BYTES = 8 * HTB, NXCD = 8, WGM = 8;

__host__ __device__ __forceinline__ int lds_byte(int r, int c) { const int st = (r >> 4) * 2 + (c >> 5), rr = r & 15, cc = c & 31, ob = rr * 64 + cc * 2; return st * 1024 + (ob ^ (((ob >> 9) & 1) << 5)); }
__host__ __device__ __forceinline__ void stage_rc(int b, int& R, int& C) { const int st = b / 1024, sb = b % 1024, swz = sb ^ (((sb >> 9) & 1) << 5); R = (st >> 1) * 16 + swz / 64; C = (st & 1) * 32 + (swz % 64) / 2; }
__host__ __device__ __forceinline__ int perm32(int rho) { const int n = rho >> 4, i = rho & 15; return 8 * (i >> 2) + 4 * n + (i & 3); }

struct Unit { int pm, pn, e, pnl, nvalid, rbase; };

struct Gemm { const bf16_t* A; const bf16_t* Bt; int M, N, K; };

struct StaticOrder {
    int nM, nN, nwg, G, c; PG8_LAS unsigned* gtab = nullptr;
    __host__ __device__ void init(int M, int N, int G_, int c_) { nM = M / BM; nN = N / BM; nwg = nM * nN; G = G_; c = c_; }
    __host__ __device__ bool next(int i, Unit& u) const {
        const long L = (long)i * G + c; if (L >= nwg) return false;
        int wgid = (int)L; { const int q = nwg / NXCD, r = nwg % NXCD, xcd = wgid % NXCD, off = wgid / NXCD; wgid = (xcd < r ? xcd * (q + 1) : r * (q + 1) + (xcd - r) * q) + off; }
        const int nig = WGM * nN, gid = wgid / nig, fm = gid * WGM, gsz = (nM - fm) < WGM ? (nM - fm) : WGM;
        u.pm = fm + ((wgid % nig) % gsz); u.pn = (wgid % nig) / gsz; u.e = 0; u.pnl = u.pn; u.nvalid = BM; u.rbase = 0; return true;
    }
    __device__ __forceinline__ int arow(const Unit&, int) const { return 0; }
    __device__ __forceinline__ void a_ready(const Unit&) const {}
    __device__ __forceinline__ void done(const Unit&) const {}
};

__device__ __forceinline__ unsigned cvt_pk_bf16(float lo, float hi) { unsigned r; asm volatile("v_cvt_pk_bf16_f32 %0, %1, %2" : "=v"(r) : "v"(lo), "v"(hi)); return r; }
typedef float f32x2 __attribute__((ext_vector_type(2)));
__device__ __forceinline__ f32x2 gelu_pk(f32x2 v) {
    const f32x2 av = __builtin_elementwise_abs(v), d = av * 0.2316418882f + 1.0f;
    f32x2 t; t.x = __builtin_amdgcn_rcpf(d.x); t.y = __builtin_amdgcn_rcpf(d.y);
    f32x2 q = t * 0.5307027145f + (-0.7265760135f); q = q * t + 0.7107068705f; q = q * t + (-0.142248368f); q = q * t + 0.127414796f; q = q * t;
    const f32x2 s = (v * v) * (-0.72134752044f);
    f32x2 e; e.x = __builtin_amdgcn_exp2f(s.x); e.y = __builtin_amdgcn_exp2f(s.y);
    const f32x2 m = v * (q * e), r = v - m;
    f32x2 o; o.x = v.x < 0.f ? m.x : r.x; o.y = v.y < 0.f ? m.y : r.y; return o;
}

template <int ACT  > struct EpiBf16 {
    static constexpr int PERM = 1; static constexpr bool AFTER_DRAIN = false; static_assert(ACT == 0 || ACT == 1, "EpiBf16: ACT is 0 (none) or 1 (gelu_pk)");
    static constexpr int NSTORE = PG8_NSTORE(16); static constexpr bool LDSBIAS = false;
    bf16_t* O; int ldc; const float* bias; int split_cols; size_t split_stride; float scale0;
    float ascale = 1.0f;
    int dbg = 0;
    unsigned cmap = 0u;
    float oscale = 0.0f;
    __device__ __forceinline__ void operator()(const f32x4 (&acc)[2][2][4][2], const Unit& u, int wr, int wc, int fr, int fq) const {
        if (dbg == 2) return;
        const int row0 = u.pm * BM + wr * 64 + fr; int colt = (cmap ? (int)((cmap >> (4 * u.pn)) & 15u) : u.pn) * BM; bf16_t* base = O;
        float sc = 1.f; if (split_cols) { const int t = colt / split_cols; base += (size_t)t * split_stride; colt -= t * split_cols; if (t == 0) sc = scale0; }
        const int col0 = colt + wc * 32 + 8 * fq, bcol0 = u.pn * BM + wc * 32 + 8 * fq;
        f32x4 bv[2][2];
#pragma unroll
        for (int bj = 0; bj < 2; ++bj)
#pragma unroll
            for (int n = 0; n < 2; ++n) bv[bj][n] = bias ? *(const f32x4*)(bias + bcol0 + bj * HALF + 4 * n) : (f32x4){0.f, 0.f, 0.f, 0.f};
#pragma unroll
        for (int ai = 0; ai < 2; ++ai)
#pragma unroll
            for (int m = 0; m < 4; ++m) { bf16_t* rowp = base + (size_t)(row0 + ai * HALF + m * 16) * ldc + col0;
#pragma unroll
                for (int bj = 0; bj < 2; ++bj) {
                    if (ACT == 0 && oscale > 0.f) {
                        const float kq = ascale * oscale; f32x4 a, b;
#pragma unroll
                        for (int i = 0; i < 4; ++i) { a[i] = __builtin_amdgcn_fmed3f(__builtin_fmaf(acc[ai][bj][m][0][i], kq, bv[bj][0][i] * oscale), -448.f, 448.f); b[i] = __builtin_amdgcn_fmed3f(__builtin_fmaf(acc[ai][bj][m][1][i], kq, bv[bj][1][i] * oscale), -448.f, 448.f); }
                        int p = 0, q = 0; p = __builtin_amdgcn_cvt_pk_fp8_f32(a[0], a[1], p, false); p = __builtin_amdgcn_cvt_pk_fp8_f32(a[2], a[3], p, true); q = __builtin_amdgcn_cvt_pk_fp8_f32(b[0], b[1], q, false); q = __builtin_amdgcn_cvt_pk_fp8_f32(b[2], b[3], q, true);
                        typedef int i32x2_f __attribute__((ext_vector_type(2))); *(i32x2_f*)((unsigned char*)base + (size_t)(row0 + ai * HALF + m * 16) * ldc + col0 + bj * HALF) = (i32x2_f){p, q}; continue; }
                    f32x4 v0 = acc[ai][bj][m][0] * ascale + bv[bj][0], v1 = acc[ai][bj][m][1] * ascale + bv[bj][1];
                    if (ACT == 1) { f32x2 a = gelu_pk((f32x2){v0[0], v0[1]}), b = gelu_pk((f32x2){v0[2], v0[3]}), c = gelu_pk((f32x2){v1[0], v1[1]}), d = gelu_pk((f32x2){v1[2], v1[3]});
                        v0 = (f32x4){a.x, a.y, b.x, b.y}; v1 = (f32x4){c.x, c.y, d.x, d.y}; }
                    v0 = v0 * sc; v1 = v1 * sc;
                    if (oscale > 0.f) { f32x4 a = v0 * oscale, b = v1 * oscale;
#pragma unroll
                        for (int i = 0; i < 4; ++i) { a[i] = __builtin_fminf(__builtin_fmaxf(a[i], -448.f), 448.f); b[i] = __builtin_fminf(__builtin_fmaxf(b[i], -448.f), 448.f); }
                        int p = 0, q = 0; p = __builtin_amdgcn_cvt_pk_fp8_f32(a[0], a[1], p, false); p = __builtin_amdgcn_cvt_pk_fp8_f32(a[2], a[3], p, true); q = __builtin_amdgcn_cvt_pk_fp8_f32(b[0], b[1], q, false); q = __builtin_amdgcn_cvt_pk_fp8_f32(b[2], b[3], q, true);
                        typedef int i32x2_t __attribute__((ext_vector_type(2))); *(i32x2_t*)((unsigned char*)base + (size_t)(row0 + ai * HALF + m * 16) * ldc + col0 + bj * HALF) = (i32x2_t){p, q}; }
                    else { u32x4 w; w.x = cvt_pk_bf16(v0[0], v0[1]); w.y = cvt_pk_bf16(v0[2], v0[3]); w.z = cvt_pk_bf16(v1[0], v1[1]); w.w = cvt_pk_bf16(v1[2], v1[3]);
                        *(u32x4*)(rowp + bj * HALF) = w; } } }
    }
};

struct EpiFp8 { static constexpr int ACT = 0;
    static constexpr int PERM = 2; static constexpr bool AFTER_DRAIN = false; static constexpr int NSTORE = PG8_NSTORE(8); static constexpr bool LDSBIAS = true;
    __device__ __forceinline__ const float* bias_src(const Unit& u, int wc, int lane) const { return bias + u.pn * BM + wc * 64 + lane; }
    bf16_t* O; int ldc; const float* bias; int split_cols; size_t split_stride; float scale0;
    float ascale = 1.0f;
    int dbg = 0;
    unsigned cmap = 0u;
    float oscale = 0.0f;
    PG8_LAS const float* lbias = nullptr;
    __device__ __forceinline__ void operator()(const f32x4 (&acc)[2][2][4][2], const Unit& u, int wr, int wc, int fr, int fq) const {
        if (dbg == 2) return;
        const int row0 = u.pm * BM + wr * 64 + fr; int colt = (cmap ? (int)((cmap >> (4 * u.pn)) & 15u) : u.pn) * BM; bf16_t* base = O;
        float sc = 1.f; if (split_cols) { const int t = colt / split_cols; base += (size_t)t * split_stride; colt -= t * split_cols; if (t == 0) sc = scale0; }
        const int col0 = colt + wc * 64 + 16 * fq, bcol0 = u.pn * BM + wc * 64 + 16 * fq;
        f32x4 bv[2][2];
#pragma unroll
        for (int bj = 0; bj < 2; ++bj)
#pragma unroll
            for (int n = 0; n < 2; ++n) bv[bj][n] = lbias ? *(const PG8_LAS f32x4*)(lbias + (wr * 4 + wc) * 64 + 16 * fq + 8 * bj + 4 * n) : (bias ? *(const f32x4*)(bias + bcol0 + 8 * bj + 4 * n) : (f32x4){0.f, 0.f, 0.f, 0.f});
#pragma unroll
        for (int ai = 0; ai < 2; ++ai)
#pragma unroll
            for (int m = 0; m < 4; ++m) { const size_t rowoff = (size_t)(row0 + ai * HALF + m * 16) * ldc + col0;
                if (ACT == 0 && oscale > 0.f) {
                    const float kq = ascale * oscale; int w4[4];
#pragma unroll
                    for (int bj = 0; bj < 2; ++bj)
#pragma unroll
                        for (int n = 0; n < 2; ++n) { float a[4];
#pragma unroll
                            for (int p = 0; p < 2; ++p) { const f32x2 t2 = (f32x2){acc[ai][bj][m][n][2 * p], acc[ai][bj][m][n][2 * p + 1]} * kq + (f32x2){bv[bj][n][2 * p], bv[bj][n][2 * p + 1]} * oscale;
                                a[2 * p] = __builtin_amdgcn_fmed3f(t2.x, -448.f, 448.f); a[2 * p + 1] = __builtin_amdgcn_fmed3f(t2.y, -448.f, 448.f); }
                            int p = 0; p = __builtin_amdgcn_cvt_pk_fp8_f32(a[0], a[1], p, false); p = __builtin_amdgcn_cvt_pk_fp8_f32(a[2], a[3], p, true); w4[2 * bj + n] = p; }
                    *(u32x4*)((unsigned char*)base + rowoff) = (u32x4){(unsigned)w4[0], (unsigned)w4[1], (unsigned)w4[2], (unsigned)w4[3]}; continue; }
                u32x4 wo[2];
#pragma unroll
                for (int bj = 0; bj < 2; ++bj) { f32x4 v0 = acc[ai][bj][m][0] * ascale + bv[bj][0], v1 = acc[ai][bj][m][1] * ascale + bv[bj][1];
                    if (ACT == 1) { f32x2 a = gelu_pk((f32x2){v0[0], v0[1]}), b = gelu_pk((f32x2){v0[2], v0[3]}), c = gelu_pk((f32x2){v1[0], v1[1]}), d = gelu_pk((f32x2){v1[2], v1[3]});
                        v0 = (f32x4){a.x, a.y, b.x, b.y}; v1 = (f32x4){c.x, c.y, d.x, d.y}; }
                    v0 = v0 * sc; v1 = v1 * sc;
                    wo[bj].x = cvt_pk_bf16(v0[0], v0[1]); wo[bj].y = cvt_pk_bf16(v0[2], v0[3]); wo[bj].z = cvt_pk_bf16(v1[0], v1[1]); wo[bj].w = cvt_pk_bf16(v1[2], v1[3]); }
                bf16_t* rowp = base + rowoff; *(u32x4*)rowp = wo[0]; *(u32x4*)(rowp + 8) = wo[1]; }
    }
};

struct EpiSwiglu {
    static constexpr int PERM = 1; static constexpr bool AFTER_DRAIN = false; static constexpr int NSTORE = PG8_NSTORE(8); static constexpr bool LDSBIAS = true;
    bf16_t* H; int ldc; const float* bias; int dff; float ascale; float hscale; int dbg = 0;
    PG8_LAS const float* lbias = nullptr;
    __device__ __forceinline__ const float* bias_src(const Unit& u, int wc, int lane) const { return bias + (size_t)u.e * 2 * dff + u.pnl * HALF + wc * 32 + (lane & 31) + ((lane & 32) ? dff : 0); }
    __device__ __forceinline__ void operator()(const f32x4 (&acc)[2][2][4][2], const Unit& u, int wr, int wc, int fr, int fq) const {
        if (dbg == 2) return;
        const int row0 = u.pm * BM + wr * 64 + fr, hc = u.pnl * HALF + wc * 32 + 8 * fq;
        const float* bg = bias + (size_t)u.e * 2 * dff + hc; const float* bu = bg + dff;
        const float hk = hscale > 0.f ? hscale : 1.0f;
        f32x4 bgv[2], buv[2];
#pragma unroll
        for (int n = 0; n < 2; ++n) { if (lbias) { const PG8_LAS float* lb = lbias + (wr * 4 + wc) * 64 + 8 * fq + 4 * n; bgv[n] = *(const PG8_LAS f32x4*)lb; buv[n] = *(const PG8_LAS f32x4*)(lb + 32); }
            else { bgv[n] = *(const f32x4*)(bg + 4 * n); buv[n] = *(const f32x4*)(bu + 4 * n); } }
#pragma unroll
        for (int ai = 0; ai < 2; ++ai)
#pragma unroll
            for (int m = 0; m < 4; ++m) { bf16_t* rowp = H + (size_t)(row0 + ai * HALF + m * 16) * ldc + hc; float o[8];
#pragma unroll
                for (int n = 0; n < 2; ++n)
#pragma unroll
                    for (int p = 0; p < 2; ++p) {
                        const f32x2 g2 = (f32x2){acc[ai][0][m][n][2 * p], acc[ai][0][m][n][2 * p + 1]} * ascale + (f32x2){bgv[n][2 * p], bgv[n][2 * p + 1]};
                        const f32x2 u2 = (f32x2){acc[ai][1][m][n][2 * p], acc[ai][1][m][n][2 * p + 1]} * ascale + (f32x2){buv[n][2 * p], buv[n][2 * p + 1]};
                        f32x2 gt, up; gt.x = __builtin_fminf(g2.x, 7.0f); gt.y = __builtin_fminf(g2.y, 7.0f); up.x = __builtin_amdgcn_fmed3f(u2.x, -7.0f, 7.0f); up.y = __builtin_amdgcn_fmed3f(u2.y, -7.0f, 7.0f);
                        const f32x2 ee = gt * (-1.702f * 1.4426950408889634f);
                        f32x2 den; den.x = __builtin_amdgcn_exp2f(ee.x); den.y = __builtin_amdgcn_exp2f(ee.y); den = den + 1.0f;
                        f32x2 sg; sg.x = __builtin_amdgcn_rcpf(den.x); sg.y = __builtin_amdgcn_rcpf(den.y);
                        const f32x2 r2 = (up * hk + hk) * (gt * sg);
                        o[4 * n + 2 * p] = r2.x; o[4 * n + 2 * p + 1] = r2.y; }
                if (dbg == 1) { if (o[0] == 123.4567f && o[5] == 7.654f) rowp[0] = 1; continue; }
                if (hscale > 0.f) { int a = 0, b = 0; a = __builtin_amdgcn_cvt_pk_fp8_f32(o[0], o[1], a, false); a = __builtin_amdgcn_cvt_pk_fp8_f32(o[2], o[3], a, true);
                    b = __builtin_amdgcn_cvt_pk_fp8_f32(o[4], o[5], b, false); b = __builtin_amdgcn_cvt_pk_fp8_f32(o[6], o[7], b, true);
                    typedef int i32x2_t __attribute__((ext_vector_type(2))); *(i32x2_t*)((unsigned char*)H + (size_t)(row0 + ai * HALF + m * 16) * ldc + hc) = (i32x2_t){a, b}; }
                else { u32x4 w; w.x = cvt_pk_bf16(o[0], o[1]); w.y = cvt_pk_bf16(o[2], o[3]); w.z = cvt_pk_bf16(o[4], o[5]); w.w = cvt_pk_bf16(o[6], o[7]);
                    *(u32x4*)rowp = w; } }
    }
};
struct MoeOrder {
    const PG8_LAS int* tstart; const PG8_LAS int* cnt; const int* rowtok; int nN, G, c, ntok; PG8_LAS unsigned* gtab;
    int xs = 0;
    __device__ __forceinline__ bool next(int i, Unit& u) const {
        int rt, pnl;
        if (G == 256) { const int x = ((c & 7) + xs) & 7, j = c >> 3, per = 32 / nN; rt = (i * 8 + x) * per + j / nN; pnl = j % nN; }
        else { const int L = i * G + c; rt = L / nN; pnl = L % nN; }
        const int TR = tstart[32]; if (rt >= TR) return false;
        const int ln_ = (int)__builtin_amdgcn_mbcnt_hi(~0u, __builtin_amdgcn_mbcnt_lo(~0u, 0u));
        const int tv_ = tstart[(ln_ & 31) + 1];
        const unsigned long long bal_ = __ballot((ln_ < 31) && (tv_ <= rt));
        int e = __builtin_amdgcn_readfirstlane((int)__popcll(bal_));
        const int lt = rt - tstart[e]; int nv = cnt[e] - lt * BM; nv = nv > BM ? BM : nv;
        u.pm = rt; u.pn = e * nN + pnl; u.e = e; u.pnl = pnl; u.nvalid = __builtin_amdgcn_readfirstlane(nv); u.rbase = __builtin_amdgcn_readfirstlane(e * ntok + lt * BM); return true;
    }
    __device__ __forceinline__ int arow(const Unit& u, int r) const { return rowtok[u.rbase + ((r < u.nvalid) ? r : 0)]; }
    __device__ __forceinline__ const int* aptr(const Unit& u, int r) const { return rowtok + u.rbase + ((r < u.nvalid) ? r : 0); }
    __device__ __forceinline__ void a_ready(const Unit&) const {}
    __device__ __forceinline__ void done(const Unit&) const {}
};

struct PanelStats {
    unsigned* xbuf;
    unsigned* cnt;
    unsigned* tmo;
    int ntn; float eps;
    unsigned code;
    __device__ __forceinline__ bool run(const f32x4 (&v)[2][2][4][2], const Unit& u, int wr, int wc, int fr, int fq, PG8_LAS unsigned char* lds, int wid, int lane) const {
        typedef float f32x2v __attribute__((ext_vector_type(2)));
        PG8_LAS f32x2v* P = (PG8_LAS f32x2v*)lds;
        PG8_LAS f32x2v* S = (PG8_LAS f32x2v*)(lds + 8192);
        PG8_LAS unsigned* flag = (PG8_LAS unsigned*)(lds + 8192 + 2048);
#pragma unroll
        for (int ai = 0; ai < 2; ++ai)
#pragma unroll
            for (int m = 0; m < 4; ++m) {
                float s = 0.f;
#pragma unroll
                for (int bj = 0; bj < 2; ++bj)
#pragma unroll
                    for (int n = 0; n < 2; ++n) { const f32x4 x = v[ai][bj][m][n]; s += (x[0] + x[1]) + (x[2] + x[3]); }
                s += __shfl_xor(s, 16); s += __shfl_xor(s, 32);
                const float mw = s * (1.0f / 64.0f); float q = 0.f;
#pragma unroll
                for (int bj = 0; bj < 2; ++bj)
#pragma unroll
                    for (int n = 0; n < 2; ++n) { const f32x4 d = v[ai][bj][m][n] - mw; q += (d[0] * d[0] + d[1] * d[1]) + (d[2] * d[2] + d[3] * d[3]); }
                q += __shfl_xor(q, 16); q += __shfl_xor(q, 32);
                if (fq == 0) P[(ai * HALF + wr * 64 + m * 16 + fr) * 4 + wc] = (f32x2v){mw, q};
            }
        asm volatile("s_waitcnt lgkmcnt(0)" ::: "memory"); __builtin_amdgcn_s_barrier(); asm volatile("" ::: "memory");
#if defined(BROKEN_EXCHANGE_NO_WAIT)
#warning BROKEN CONTROL BUILD: the row-statistics exchange does not wait; results are wrong by design
        if (blockIdx.x >= 64) { const long long t0_ = clock64(); while (clock64() - t0_ < 60000) __builtin_amdgcn_s_sleep(8); }
#endif
        const int row = wid * 32 + (lane & 31);
        if (lane < 32) {
            const f32x2v a = P[row * 4 + 0], b = P[row * 4 + 1], c = P[row * 4 + 2], d = P[row * 4 + 3];
            const float mt = (a.x + b.x + c.x + d.x) * 0.25f;
            const float da = a.x - mt, db = b.x - mt, dc = c.x - mt, dd = d.x - mt;
            const float m2 = (a.y + b.y) + (c.y + d.y) + 64.0f * ((da * da + db * db) + (dc * dc + dd * dd));
            unsigned long long* slot = (unsigned long long*)xbuf + ((size_t)(u.pm * BM + row) * 4 + u.pn);
            __hip_atomic_store(slot, ((unsigned long long)__float_as_uint(m2) << 32) | __float_as_uint(mt), __ATOMIC_RELAXED, __HIP_MEMORY_SCOPE_AGENT);
        }
        asm volatile("s_waitcnt vmcnt(0)" ::: "memory");
        if (lane == 0) __hip_atomic_fetch_add(cnt + 64 * u.pm, 1u, __ATOMIC_RELAXED, __HIP_MEMORY_SCOPE_AGENT);
        if (wid == 0) {
            bool dead = false; const unsigned long long t0 = __builtin_amdgcn_s_memrealtime(); const unsigned want = 8u * (unsigned)ntn;
            for (;;) {
#if defined(BROKEN_EXCHANGE_NO_WAIT)
                break;
#endif
                if ((unsigned)__builtin_amdgcn_readfirstlane(__hip_atomic_load(cnt + 64 * u.pm, __ATOMIC_RELAXED, __HIP_MEMORY_SCOPE_AGENT)) >= want) break;
                if (__builtin_amdgcn_s_memrealtime() - t0 > 2000000ull) {
                    if (lane == 0) { unsigned expect = 0u; __hip_atomic_compare_exchange_strong(tmo + 1, &expect, code | (unsigned)(u.pm & 0xff), __ATOMIC_RELAXED, __ATOMIC_RELAXED, __HIP_MEMORY_SCOPE_AGENT);
                                     __hip_atomic_store(tmo, 1u, __ATOMIC_RELAXED, __HIP_MEMORY_SCOPE_AGENT); }
                    dead = true; break; }
                __builtin_amdgcn_s_sleep(2);
            }
            __builtin_amdgcn_fence(__ATOMIC_ACQUIRE, "agent");
            if (lane == 0) flag[0] = dead ? 1u : 0u;
        }
        asm volatile("s_waitcnt vmcnt(0) lgkmcnt(0)" ::: "memory"); __builtin_amdgcn_s_barrier(); asm volatile("" ::: "memory");
        const bool bad = flag[0] != 0u;
        if (lane < 32) {
            const unsigned long long* slot = (const unsigned long long*)xbuf + (size_t)(u.pm * BM + row) * 4; float mt[4], m2[4]; float ms = 0.f;
#pragma unroll
            for (int t = 0; t < 4; ++t) { if (t < ntn) { const unsigned long long w = __hip_atomic_load(slot + t, __ATOMIC_RELAXED, __HIP_MEMORY_SCOPE_AGENT); mt[t] = __uint_as_float((unsigned)w); m2[t] = __uint_as_float((unsigned)(w >> 32)); } else { mt[t] = 0.f; m2[t] = 0.f; } ms += mt[t]; }
            const float mean = ms / (float)ntn; float q = 0.f;
#pragma unroll
            for (int t = 0; t < 4; ++t) if (t < ntn) { const float dm = mt[t] - mean; q += m2[t] + 256.0f * dm * dm; }
            S[row] = (f32x2v){mean, 1.0f / sqrtf(q / (256.0f * (float)ntn) + eps)};
        }
        asm volatile("s_waitcnt lgkmcnt(0)" ::: "memory"); __builtin_amdgcn_s_barrier(); asm volatile("" ::: "memory");
        return bad;
    }
};
struct EpiLnRes {
    static constexpr int PERM = 0; static constexpr bool AFTER_DRAIN = true; static constexpr int NSTORE = 0; static constexpr bool LDSBIAS = false;
    const float* base; float* out; int ldc; const float* bias; PanelStats st; unsigned poison;
    __device__ __forceinline__ void fused(f32x4 (&acc)[2][2][4][2], const Unit& u, int wr, int wc, int fr, int fq, PG8_LAS unsigned char* lds, int wid, int lane) const {
        typedef float f32x2v __attribute__((ext_vector_type(2)));
        const PG8_LAS f32x2v* S = (const PG8_LAS f32x2v*)(lds + 8192);
        const int col0 = u.pn * BM + wc * 32 + 4 * fq;
#pragma unroll
        for (int bj = 0; bj < 2; ++bj)
#pragma unroll
            for (int n = 0; n < 2; ++n) { const f32x4 bv = bias ? *(const f32x4*)(bias + col0 + bj * HALF + n * 16) : (f32x4){0.f, 0.f, 0.f, 0.f};
#pragma unroll
                for (int ai = 0; ai < 2; ++ai)
#pragma unroll
                    for (int m = 0; m < 4; ++m) acc[ai][bj][m][n] += bv; }
        f32x4 pre[4][2][2];
#pragma unroll
        for (int m = 0; m < 4; ++m) { const size_t off = (size_t)(u.pm * BM + wr * 64 + m * 16 + fr) * ldc + col0;
#pragma unroll
            for (int bj = 0; bj < 2; ++bj)
#pragma unroll
                for (int n = 0; n < 2; ++n) pre[m][bj][n] = *(const f32x4*)(base + off + bj * HALF + n * 16); }
        const bool bad = st.run(acc, u, wr, wc, fr, fq, lds, wid, lane) || poison != 0u;
        const float qnan = __builtin_nanf("");
#pragma unroll
        for (int ai = 0; ai < 2; ++ai)
#pragma unroll
            for (int m = 0; m < 4; ++m) { const int r = ai * HALF + wr * 64 + m * 16 + fr; const f32x2v sr = S[r]; const size_t off = (size_t)(u.pm * BM + r) * ldc + col0;
#pragma unroll
                for (int bj = 0; bj < 2; ++bj)
#pragma unroll
                    for (int n = 0; n < 2; ++n) { const f32x4 bs = ai == 0 ? pre[m][bj][n] : *(const f32x4*)(base + off + bj * HALF + n * 16); f32x4 o = bs + (acc[ai][bj][m][n] - sr.x) * sr.y;
                        if (bad) o = (f32x4){qnan, qnan, qnan, qnan}; *(f32x4*)(out + off + bj * HALF + n * 16) = o; }
                if (m & 1) asm volatile("" ::: "memory"); }
    }
};
struct EpiLnResLn {
    static constexpr int PERM = 0; static constexpr bool AFTER_DRAIN = true; static constexpr int NSTORE = 0; static constexpr bool LDSBIAS = false;
    const float* base; float* out; bf16_t* xn; int ldc; const float* bias; PanelStats st1, st2; unsigned poison;
    __device__ __forceinline__ void fused(f32x4 (&acc)[2][2][4][2], const Unit& u, int wr, int wc, int fr, int fq, PG8_LAS unsigned char* lds, int wid, int lane) const {
        typedef float f32x2v __attribute__((ext_vector_type(2))); typedef unsigned u32x2v __attribute__((ext_vector_type(2)));
        const PG8_LAS f32x2v* S = (const PG8_LAS f32x2v*)(lds + 8192);
        const int col0 = u.pn * BM + wc * 32 + 4 * fq;
#pragma unroll
        for (int bj = 0; bj < 2; ++bj)
#pragma unroll
            for (int n = 0; n < 2; ++n) { const f32x4 bv = bias ? *(const f32x4*)(bias + col0 + bj * HALF + n * 16) : (f32x4){0.f, 0.f, 0.f, 0.f};
#pragma unroll
                for (int ai = 0; ai < 2; ++ai)
#pragma unroll
                    for (int m = 0; m < 4; ++m) acc[ai][bj][m][n] += bv; }
        bool bad = st1.run(acc, u, wr, wc, fr, fq, lds, wid, lane) || poison != 0u;
        const float qnan = __builtin_nanf("");
#pragma unroll
        for (int ai = 0; ai < 2; ++ai)
#pragma unroll
            for (int m = 0; m < 4; ++m) { const int r = ai * HALF + wr * 64 + m * 16 + fr; const f32x2v sr = S[r]; const size_t off = (size_t)(u.pm * BM + r) * ldc + col0;
#pragma unroll
                for (int bj = 0; bj < 2; ++bj)
#pragma unroll
                    for (int n = 0; n < 2; ++n) { const f32x4 bs = *(const f32x4*)(base + off + bj * HALF + n * 16); acc[ai][bj][m][n] = bs + (acc[ai][bj][m][n] - sr.x) * sr.y; }
                asm volatile("" : "+v"(acc[ai][0][m][0]), "+v"(acc[ai][0][m][1]), "+v"(acc[ai][1][m][0]), "+v"(acc[ai][1][m][1]));
                if (m & 1) asm volatile("" ::: "memory"); }
        const bool bad1 = bad;
        bad = st2.run(acc, u, wr, wc, fr, fq, lds, wid, lane) || bad;
#pragma unroll
        for (int ai = 0; ai < 2; ++ai)
#pragma unroll
            for (int m = 0; m < 4; ++m) { const int r = ai * HALF + wr * 64 + m * 16 + fr; const f32x2v sr = S[r]; const size_t off = (size_t)(u.pm * BM + r) * ldc + col0;
#pragma unroll
                for (int bj = 0; bj < 2; ++bj)
#pragma unroll
                    for (int n = 0; n < 2; ++n) { const f32x4 x1 = acc[ai][bj][m][n]; *(f32x4*)(out + off + bj * HALF + n * 16) = bad1 ? (f32x4){qnan, qnan, qnan, qnan} : x1;
                        const f32x4 o = (x1 - sr.x) * sr.y; u32x2v w; w.x = cvt_pk_bf16(o[0], o[1]); w.y = cvt_pk_bf16(o[2], o[3]);
                        if (bad) { w.x = 0x7fc07fc0u; w.y = 0x7fc07fc0u; } *(u32x2v*)(xn + off + bj * HALF + n * 16) = w; }
                asm volatile("" ::: "memory"); }
    }
};

template <class Epi, class Sched, bool ALIGN_EPI = false, bool SP2 = false, bool GATHER = false, bool FP8 = false>
__device__ __forceinline__ void gemm_phase(PG8_LAS unsigned char* lds, const Gemm g, const Sched& S, const Epi& E) {
    static_assert(!GATHER || SP2, "the gathered-A variant is written for the SP2 loop only");
    int tid_ = threadIdx.x; asm volatile("" : "+v"(tid_));
    const int tid = tid_, wid = __builtin_amdgcn_readfirstlane(tid >> 6), lane = tid & 63, wr = wid >> 2, wc = wid & 3, fr = lane & 15, fq = lane >> 4;
    const int K = g.K, nt = K / BK;
    unsigned voffA[2], voffB[2], voffB2[2][2];
#pragma unroll
    for (int i = 0; i < 2; ++i) { int R, C; stage_rc(tid * 16 + i * 8192, R, C); const int Rb = (Epi::PERM == 1) ? ((R & ~31) + perm32(R & 31)) : R;
        voffA[i] = (unsigned)(R * K + C) * 2u; voffB[i] = (unsigned)(Rb * K + C) * 2u;
        { const int rho = R & 31, n_ = rho >> 4, fq_ = (rho & 15) >> 2, i_ = rho & 3; const int r2 = (Epi::PERM == 3) ? (64 * (R >> 5) + 8 * fq_ + 4 * n_ + i_) : (64 * (R >> 5) + 16 * fq_ + 4 * n_ + i_), hs = (Epi::PERM == 3) ? 32 : 8;
          voffB2[0][i] = (unsigned)(r2 * K + C) * 2u; voffB2[1][i] = (unsigned)((r2 + hs) * K + C) * 2u; } }
#define PG8_GOFF(slot, u) do { int tq_ = threadIdx.x; asm volatile("" : "+v"(tq_)); int gR[2], gC[2]; stage_rc(tq_ * 16, gR[0], gC[0]); stage_rc(tq_ * 16 + 8192, gR[1], gC[1]);     \
        PG8_LAS unsigned* gt_ = S.gtab + (slot) * 2048 + wid * 64;     \
        __builtin_amdgcn_global_load_lds((const unsigned*)S.aptr(u, gR[0]), gt_, 4, 0, 0); __builtin_amdgcn_global_load_lds((const unsigned*)S.aptr(u, gR[1]), gt_ + 512, 4, 0, 0); \
        __builtin_amdgcn_global_load_lds((const unsigned*)S.aptr(u, HALF + gR[0]), gt_ + 1024, 4, 0, 0); __builtin_amdgcn_global_load_lds((const unsigned*)S.aptr(u, HALF + gR[1]), gt_ + 1536, 4, 0, 0); } while (0)
    unsigned gcb[2] = {0u, 0u};
    if constexpr (GATHER) { int r_, c_; stage_rc(tid * 16, r_, c_); gcb[0] = (unsigned)c_ * 2u; stage_rc(tid * 16 + 8192, r_, c_); gcb[1] = (unsigned)c_ * 2u; }
    const unsigned rowB = (unsigned)K * 2u;
    const size_t kstep = (size_t)(BK * 2);
    const size_t hstep = (size_t)HALF * K * 2;
    const size_t tstep = 2 * hstep;
    const unsigned ldsw = (unsigned)wid * 1024u;
    const int aoff = lds_byte(wr * 64 + fr, fq * 8), boff = lds_byte(wc * 32 + fr, fq * 8);
#define PG8_SA(b, h) (((b) * 2 + (h)) * HTB)
#define PG8_SB(b, h) ((4 + (b) * 2 + (h)) * HTB)
#define PG8_STAGE(bufoff, gbase, voff) do { _Pragma("unroll") for (int _i = 0; _i < 2; ++_i) \
        __builtin_amdgcn_global_load_lds((const unsigned*)((const char*)(gbase) + (voff)[_i]), (PG8_LAS unsigned*)(lds + (bufoff) + ldsw + _i * 8192), 16, 0, 0); } while (0)
#define PG8_STAGE_B(bufoff, gbase, h) do { if constexpr (Epi::PERM >= 2) PG8_STAGE(bufoff, gbase, voffB2[h]); else PG8_STAGE(bufoff, (gbase) + (size_t)(h) * hstep, voffB); } while (0)
#define PG8_LDA(dst, b, h) do { _Pragma("unroll") for (int m = 0; m < 4; ++m) { if constexpr (FP8) { dst##8[m].lo = *(const PG8_LAS i32x4_t*)(lds + PG8_SA(b, h) + aoff + m * 2048); dst##8[m].hi = *(const PG8_LAS i32x4_t*)(lds + PG8_SA(b, h) + aoff + m * 2048 + 1024); } \
        else { _Pragma("unroll") for (int k = 0; k < 2; ++k) dst[m][k] = *(const PG8_LAS bf16x8*)(lds + PG8_SA(b, h) + aoff + m * 2048 + k * 1024); } } } while (0)
#define PG8_LDB(dst, b, h) do { _Pragma("unroll") for (int n = 0; n < 2; ++n) { if constexpr (FP8) { dst##8[n].lo = *(const PG8_LAS i32x4_t*)(lds + PG8_SB(b, h) + boff + n * 2048); dst##8[n].hi = *(const PG8_LAS i32x4_t*)(lds + PG8_SB(b, h) + boff + n * 2048 + 1024); } \
        else { _Pragma("unroll") for (int k = 0; k < 2; ++k) dst[n][k] = *(const PG8_LAS bf16x8*)(lds + PG8_SB(b, h) + boff + n * 2048 + k * 1024); } } } while (0)
#define PG8_MMA(ai, bj, At, Bt) do { __builtin_amdgcn_s_setprio(1); \
        if constexpr (FP8) { _Pragma("unroll") for (int m = 0; m < 4; ++m) _Pragma("unroll") for (int n = 0; n < 2; ++n) \
            asm volatile("v_mfma_scale_f32_16x16x128_f8f6f4 %0, %1, %2, %0, %3, %3 op_sel_hi:[0,0,0]" : "+v"(acc[ai][bj][m][n]) : "v"(Bt##8[n]), "v"(At##8[m]), "v"(sc7f)); } \
        else { _Pragma("unroll") for (int m = 0; m < 4; ++m) _Pragma("unroll") for (int n = 0; n < 2; ++n) _Pragma("unroll") for (int k = 0; k < 2; ++k) \
            acc[ai][bj][m][n] = __builtin_amdgcn_mfma_f32_16x16x32_bf16(Bt[n][k], At[m][k], acc[ai][bj][m][n], 0, 0, 0); } \
        __builtin_amdgcn_s_setprio(0); } while (0)
#define PG8_WAIT_V(n) asm volatile("s_waitcnt vmcnt(" #n ")" ::: "memory")
#define PG8_WAIT_V1 do { if (t != 0 || xtra == 0) PG8_WAIT_V(8); else if (xtra == 1) PG8_WAIT_V(9); else if (xtra == 5) PG8_WAIT_V(13); else if (xtra == 9) PG8_WAIT_V(17); else if (xtra == 13) PG8_WAIT_V(21); \
        else if (xtra == 16) PG8_WAIT_V(24); else if (xtra == 8) PG8_WAIT_V(16); else if (xtra == 12) PG8_WAIT_V(20); else if (xtra == 4) PG8_WAIT_V(12); else PG8_WAIT_V(8); } while (0)
#define PG8_WAIT_L(n) asm volatile("s_waitcnt lgkmcnt(" #n ")" ::: "memory")
#define PG8_BAR __builtin_amdgcn_s_barrier()
#define PG8_SCHED __builtin_amdgcn_sched_barrier(0)
    Unit cur, nxt; int ui = 0;
    if (!S.next(0, cur)) return;
    f32x4 acc[2][2][4][2];
#pragma unroll
    for (int a = 0; a < 2; ++a)
#pragma unroll
        for (int b = 0; b < 2; ++b)
#pragma unroll
            for (int m = 0; m < 4; ++m)
#pragma unroll
                for (int n = 0; n < 2; ++n) acc[a][b][m][n] = (f32x4){0.f, 0.f, 0.f, 0.f};
    bf16x8 At[4][2], B0[2][2], B1[2][2]; i32x8_t At8[4], B08[2], B18[2];
    int sc7f = 0x7f7f7f7f; asm volatile("" : "+v"(sc7f));
    const char* cA = (const char*)g.A + (GATHER ? (size_t)0 : (size_t)cur.pm * tstep); const char* cB = (const char*)g.Bt + (size_t)cur.pn * tstep;
    S.a_ready(cur);
    int gslot = 0;
    if constexpr (GATHER) { PG8_GOFF(0, cur); PG8_WAIT_V(0); }
    const size_t hA = GATHER ? (size_t)0 : hstep;
#define PG8_STAGE_A(bufoff, gbase, h, sl) do { if constexpr (GATHER) { const PG8_LAS unsigned* gt_ = S.gtab + (sl) * 2048 + (h) * 1024 + tid; const unsigned o_[2] = {gt_[0] * rowB + gcb[0], gt_[512] * rowB + gcb[1]}; PG8_STAGE(bufoff, gbase, o_); } \
        else PG8_STAGE(bufoff, (gbase) + (size_t)(h) * hA, voffA); } while (0)
    if constexpr (SP2) {
        PG8_STAGE_B(PG8_SB(0, 0), cB, 0); PG8_STAGE_B(PG8_SB(0, 1), cB, 1); PG8_STAGE_A(PG8_SA(0, 0), cA, 0, 0); PG8_STAGE_A(PG8_SA(0, 1), cA, 1, 0);
        if (wr == 1) PG8_BAR;
        PG8_WAIT_V(2); PG8_BAR;
        PG8_STAGE_B(PG8_SB(1, 0), cB + kstep, 0); PG8_STAGE_A(PG8_SA(1, 0), cA + kstep, 0, 0); PG8_STAGE_B(PG8_SB(1, 1), cB + kstep, 1);
        PG8_WAIT_V(6); PG8_BAR;
    } else {
        PG8_STAGE_B(PG8_SB(0, 0), cB, 0); PG8_STAGE(PG8_SA(0, 0), cA, voffA); PG8_STAGE_B(PG8_SB(0, 1), cB, 1); PG8_STAGE(PG8_SA(0, 1), cA + hstep, voffA);
        if (wr == 1) PG8_BAR;
        PG8_WAIT_V(4); PG8_BAR;
        PG8_STAGE_B(PG8_SB(1, 0), cB + kstep, 0); PG8_STAGE(PG8_SA(1, 0), cA + kstep, voffA); PG8_STAGE_B(PG8_SB(1, 1), cB + kstep, 1);
        PG8_WAIT_V(6); PG8_BAR;
    }
    for (;;) {
        const bool has_next = S.next(ui + 1, nxt);
        const char* nA = (has_next && !GATHER) ? (const char*)g.A + (size_t)nxt.pm * tstep : cA; const char* nB = has_next ? (const char*)g.Bt + (size_t)nxt.pn * tstep : cB;
        if constexpr (GATHER) { if (has_next) PG8_GOFF(gslot ^ 1, nxt); }
        bool lbp = false;
        if constexpr (Epi::LDSBIAS) { if (E.lbias) { lbp = true; __builtin_amdgcn_global_load_lds((const unsigned*)E.bias_src(cur, wc, lane), (PG8_LAS unsigned*)(E.lbias + wid * 64), 4, 0, 0); } }
        const int xtra = ((ui > 0 && E.dbg == 0) ? Epi::NSTORE : 0) + ((GATHER && has_next) ? 4 : 0) + (lbp ? 1 : 0);
#pragma unroll 1
        for (int t = 0; t < nt; t += 2) {
            const bool last = (t == nt - 2);
            const char* a1 = cA + (size_t)(t + 1) * kstep;
            const char* a2 = last ? nA : cA + (size_t)(t + 2) * kstep; const char* b2 = last ? nB : cB + (size_t)(t + 2) * kstep;
            const char* a3 = a2 + kstep; const char* b3 = b2 + kstep;
            if (last && has_next) S.a_ready(nxt);
            const int gnx = (last && has_next) ? (gslot ^ 1) : gslot;
            if constexpr (SP2) {
            PG8_LDB(B0, 0, 0); PG8_LDB(B1, 0, 1); PG8_SCHED; PG8_LDA(At, 0, 0); PG8_STAGE_A(PG8_SA(1, 1), a1, 1, gslot);
            PG8_WAIT_V1;
            PG8_WAIT_L(0); PG8_BAR; PG8_MMA(0, 0, At, B0); PG8_MMA(0, 1, At, B1); PG8_BAR; PG8_SCHED;
            PG8_LDA(At, 0, 1); PG8_STAGE_B(PG8_SB(0, 0), b2, 0); PG8_STAGE_B(PG8_SB(0, 1), b2, 1); PG8_STAGE_A(PG8_SA(0, 0), a2, 0, gnx);
            PG8_WAIT_V1;
            PG8_WAIT_L(0); PG8_BAR; PG8_MMA(1, 0, At, B0); PG8_MMA(1, 1, At, B1); PG8_BAR; PG8_SCHED;
            PG8_LDB(B0, 1, 0); PG8_LDB(B1, 1, 1); PG8_SCHED; PG8_LDA(At, 1, 0); PG8_STAGE_A(PG8_SA(0, 1), a2, 1, gnx);
            PG8_WAIT_V(8); PG8_WAIT_L(0); PG8_BAR; PG8_MMA(0, 0, At, B0); PG8_MMA(0, 1, At, B1); PG8_BAR; PG8_SCHED;
            PG8_LDA(At, 1, 1); PG8_STAGE_B(PG8_SB(1, 0), b3, 0); PG8_STAGE_B(PG8_SB(1, 1), b3, 1); PG8_STAGE_A(PG8_SA(1, 0), a3, 0, gnx);
            PG8_WAIT_V(8); PG8_WAIT_L(0); PG8_BAR; PG8_MMA(1, 0, At, B0); PG8_MMA(1, 1, At, B1); PG8_BAR; PG8_SCHED;
            } else {
            PG8_LDB(B0, 0, 0); PG8_SCHED; PG8_LDA(At, 0, 0); PG8_STAGE(PG8_SA(1, 1), a1 + hstep, voffA);
            PG8_WAIT_L(8); PG8_BAR; PG8_WAIT_L(0); PG8_MMA(0, 0, At, B0); PG8_BAR; PG8_SCHED;
            PG8_LDB(B1, 0, 1); PG8_STAGE_B(PG8_SB(0, 0), b2, 0);
            PG8_BAR; PG8_WAIT_L(0); PG8_MMA(0, 1, At, B1); PG8_BAR;
            PG8_LDA(At, 0, 1); PG8_STAGE(PG8_SA(0, 0), a2, voffA);
            PG8_BAR; PG8_WAIT_L(0); PG8_MMA(1, 0, At, B0); PG8_BAR; PG8_SCHED;
            PG8_STAGE_B(PG8_SB(0, 1), b2, 1);
            PG8_WAIT_V(6); PG8_BAR; PG8_MMA(1, 1, At, B1); PG8_BAR;
            PG8_LDB(B0, 1, 0); PG8_SCHED; PG8_LDA(At, 1, 0); PG8_STAGE(PG8_SA(0, 1), a2 + hstep, voffA);
            PG8_WAIT_L(8); PG8_BAR; PG8_WAIT_L(0); PG8_MMA(0, 0, At, B0); PG8_BAR; PG8_SCHED;
            PG8_LDB(B1, 1, 1); PG8_STAGE_B(PG8_SB(1, 0), b3, 0);
            PG8_BAR; PG8_WAIT_L(0); PG8_MMA(0, 1, At, B1); PG8_BAR;
            PG8_LDA(At, 1, 1); PG8_STAGE(PG8_SA(1, 0), a3, voffA);
            PG8_BAR; PG8_WAIT_L(0); PG8_MMA(1, 0, At, B0); PG8_BAR; PG8_SCHED;
            PG8_STAGE_B(PG8_SB(1, 1), b3, 1);
            PG8_WAIT_V(6); PG8_BAR; PG8_MMA(1, 1, At, B1); PG8_BAR;
            }
        }
        if constexpr (ALIGN_EPI) { if (wr == 0) PG8_BAR; }
        if constexpr (FP8) asm volatile("s_nop 15\n\ts_nop 15" ::: "memory");
        if constexpr (!Epi::AFTER_DRAIN) { E(acc, cur, wr, wc, fr, fq); S.done(cur); }
        if (!has_next) break;
#pragma unroll
        for (int a = 0; a < 2; ++a)
#pragma unroll
            for (int b = 0; b < 2; ++b)
#pragma unroll
                for (int m = 0; m < 4; ++m)
#pragma unroll
                    for (int n = 0; n < 2; ++n) acc[a][b][m][n] = (f32x4){0.f, 0.f, 0.f, 0.f};
        cur = nxt; cA = nA; cB = nB; ++ui;
        gslot ^= 1;
        if constexpr (ALIGN_EPI) { if (wr == 1) PG8_BAR; }
    }
    PG8_WAIT_V(0);
    if constexpr (!ALIGN_EPI) { if (wr == 0) PG8_BAR; }
    PG8_BAR;
    if constexpr (Epi::AFTER_DRAIN) { E.fused(acc, cur, wr, wc, fr, fq, lds, wid, lane); S.done(cur); }
#undef PG8_SA
#undef PG8_GOFF
#undef PG8_STAGE_A
#undef PG8_SB
#undef PG8_STAGE
#undef PG8_STAGE_B
#undef PG8_LDA
#undef PG8_LDB
#undef PG8_MMA
#undef PG8_WAIT_V
#undef PG8_WAIT_V1
#undef PG8_WAIT_L
#undef PG8_BAR
#undef PG8_SCHED
}
}
#include <hip/hip_bf16.h>
#include <cmath>
namespace attn_body {
using bf16=__hip_bfloat16;
using bf16x8=__attribute__((ext_vector_type(8)))short;
using s16x4=__attribute__((ext_vector_type(4)))short;
using f32x16=__attribute__((ext_vector_type(16)))float;
using u32x4=__attribute__((ext_vector_type(4)))unsigned;
constexpr int SEQ=4096,D=64,PIN=3072,PO=1024;
constexpr int NW=8,QBLK=32,QB=QBLK*NW,KVBLK=64,NQB=SEQ/QB;
constexpr int ATTN_UNIT_ROWS=QB;
__device__ __forceinline__ int crow(int r,int hi){return (r&3)+8*(r>>2)+4*hi;}
#define SBAR() __builtin_amdgcn_sched_barrier(0)
__device__ __forceinline__ void cmask(f32x16&p0,f32x16&p1,int jb,int qrel,int hi){
  const float NEG=-INFINITY; int kb=64*jb+4*hi;
  #pragma unroll
  for(int r=0;r<16;++r){int kv=kb+(r&3)+8*(r>>2); if(kv>qrel)p0[r]=NEG; if(kv+32>qrel)p1[r]=NEG;}
}

constexpr int NSLOT=3, SLOTB=8192;
constexpr int LDS_K=0, LDS_V=NSLOT*SLOTB, LDS_V2=2*NSLOT*SLOTB, LDS_WS=3*NSLOT*SLOTB, LDS_OST=LDS_WS+NW*64*4, LDS_BYTES=LDS_OST+NW*4096;
constexpr float C2=0.125f*1.4426950408889634f;
__device__ __forceinline__ void glds16(const void*gsrc,unsigned lds_dst){unsigned keep;
  asm volatile("s_mov_b32 %0, m0\n\ts_mov_b32 m0, %2\n\ts_nop 0\n\tglobal_load_lds_dwordx4 %1, off\n\ts_mov_b32 m0, %0":"=&s"(keep):"v"(gsrc),"s"(lds_dst):"memory");}
__device__ __forceinline__ float max3f(float a,float b,float c){float r;asm("v_max3_f32 %0, %1, %2, %3":"=v"(r):"v"(a),"v"(b),"v"(c));return r;}
__device__ __forceinline__ float max2f(float a,float b){float r;asm("v_max_f32_e32 %0, %1, %2":"=v"(r):"v"(a),"v"(b));return r;}
__device__ __forceinline__ float fadd_s(float a,float b){float r;asm("v_add_f32_e32 %0, %1, %2":"=v"(r):"v"(a),"v"(b));return r;}
__device__ __forceinline__ float fsub_s(float a,float b){float r;asm("v_sub_f32_e32 %0, %1, %2":"=v"(r):"v"(a),"v"(b));return r;}
typedef float f32x2_t __attribute__((ext_vector_type(2))); typedef __bf16 bf16x2_t __attribute__((ext_vector_type(2)));
__device__ __forceinline__ unsigned cvtpk_s(float lo,float hi){f32x2_t v={lo,hi};bf16x2_t b=__builtin_convertvector(v,bf16x2_t);return __builtin_bit_cast(unsigned,b);}
#define WAIT_BAR(N) asm volatile("s_waitcnt vmcnt(" #N ") lgkmcnt(0)\n\ts_barrier":::"memory")

__device__ __forceinline__ void qkt(f32x16&p0,f32x16&p1,const char*Kslot,const bf16x8*qr,const f32x16&negm,int r32,int hi){
  const char*kb=Kslot+hi*1024+r32*16;
  #pragma unroll
  for(int d0=0;d0<4;++d0){
    const bf16x8 b0=*reinterpret_cast<const bf16x8*>(kb+d0*2048);
    const bf16x8 b1=*reinterpret_cast<const bf16x8*>(kb+d0*2048+512);
    if(d0==0){p0=__builtin_amdgcn_mfma_f32_32x32x16_bf16(b0,qr[0],negm,0,0,0);p1=__builtin_amdgcn_mfma_f32_32x32x16_bf16(b1,qr[0],negm,0,0,0);}
    else{p0=__builtin_amdgcn_mfma_f32_32x32x16_bf16(b0,qr[d0],p0,0,0,0);p1=__builtin_amdgcn_mfma_f32_32x32x16_bf16(b1,qr[d0],p1,0,0,0);}}
}
typedef __attribute__((address_space(3))) const char* lds_cptr;
typedef short v4i16_t __attribute__((ext_vector_type(4)));
__device__ __forceinline__ void kload8(bf16x8*kf,lds_cptr kp){
  kf[0]=*(const __attribute__((address_space(3))) bf16x8*)(kp);      kf[1]=*(const __attribute__((address_space(3))) bf16x8*)(kp+512);
  kf[2]=*(const __attribute__((address_space(3))) bf16x8*)(kp+2048); kf[3]=*(const __attribute__((address_space(3))) bf16x8*)(kp+2560);
  kf[4]=*(const __attribute__((address_space(3))) bf16x8*)(kp+4096); kf[5]=*(const __attribute__((address_space(3))) bf16x8*)(kp+4608);
  kf[6]=*(const __attribute__((address_space(3))) bf16x8*)(kp+6144); kf[7]=*(const __attribute__((address_space(3))) bf16x8*)(kp+6656);
}
__device__ __forceinline__ void kload2(bf16x8*kf,lds_cptr kp,int j){ kf[2*j]=*(const __attribute__((address_space(3))) bf16x8*)(kp+j*2048); kf[2*j+1]=*(const __attribute__((address_space(3))) bf16x8*)(kp+j*2048+512); }
__device__ __forceinline__ s16x4 vtr(lds_cptr p){ return __builtin_bit_cast(s16x4,__builtin_amdgcn_ds_read_tr16_b64_v4i16((__attribute__((address_space(3))) v4i16_t*)p)); }
__device__ __forceinline__ float rowmax(const f32x16&p0,const f32x16&p1){
  float a=max3f(p0[0],p0[1],p1[0]),b=max3f(p0[2],p0[3],p1[1]);a=max3f(a,p1[2],p1[3]);
  #pragma unroll
  for(int r=4;r<16;r+=4){a=max3f(a,p0[r],p0[r+1]);b=max3f(b,p0[r+2],p0[r+3]);a=max3f(a,p1[r],p1[r+1]);b=max3f(b,p1[r+2],p1[r+3]);}
  const float m=max2f(a,b);
  auto rr=__builtin_amdgcn_permlane32_swap(__float_as_uint(m),__float_as_uint(m),false,false);
  return max2f(__uint_as_float(rr[0]),__uint_as_float(rr[1]));
}
__device__ __forceinline__ void pv(f32x16*o,int vb,bf16x8 pa0,bf16x8 pa1,bf16x8 pa2,bf16x8 pa3){
  #pragma unroll
  for(int d0=0;d0<2;++d0){s16x4 lo[4],hi[4];
    #pragma unroll
    for(int ks=0;ks<4;++ks){
      asm volatile("ds_read_b64_tr_b16 %0,%1 offset:%c2":"=&v"(lo[ks]):"v"(vb),"i"(d0*4096+ks*1024):"memory");
      asm volatile("ds_read_b64_tr_b16 %0,%1 offset:%c2":"=&v"(hi[ks]):"v"(vb),"i"(d0*4096+ks*1024+512):"memory");}
    asm volatile("s_waitcnt lgkmcnt(0)":::"memory");SBAR();
    #define PK(k) (bf16x8){lo[k][0],lo[k][1],lo[k][2],lo[k][3],hi[k][0],hi[k][1],hi[k][2],hi[k][3]}
    o[d0]=__builtin_amdgcn_mfma_f32_32x32x16_bf16(pa0,PK(0),o[d0],0,0,0);
    o[d0]=__builtin_amdgcn_mfma_f32_32x32x16_bf16(pa1,PK(1),o[d0],0,0,0);
    o[d0]=__builtin_amdgcn_mfma_f32_32x32x16_bf16(pa2,PK(2),o[d0],0,0,0);
    o[d0]=__builtin_amdgcn_mfma_f32_32x32x16_bf16(pa3,PK(3),o[d0],0,0,0);
    #undef PK
  }
}

#ifndef ATTN_STORE16
#define ATTN_STORE16(p,v) (*(u32x4*)(p)=(v))
#endif
template<int THRL> __device__ __forceinline__ void attn_unit(int b,int qb,const bf16*Q,const bf16*__restrict__ K,const bf16*__restrict__ V,bf16*O,char*shm,int cmap,float lam,float osc,const float*ng,bf16*M){
  int tid_=threadIdx.x; asm volatile("":"+v"(tid_)); const int tid=tid_,lane=tid&63,r32=lane&31,hi=lane>>5; const int wid=__builtin_amdgcn_readfirstlane(tid>>6);
  const long rowbase=(long)b*SEQ; const int q0=qb*QB;
  const bf16*Qw=Q+(rowbase+q0+wid*QBLK)*PIN;
  const bf16*Kh=K+rowbase*PIN,*Vh=V+rowbase*PIN;
  const unsigned lds0=(unsigned)(uintptr_t)shm;
  float*wsf=(float*)(shm+LDS_WS)+wid*64;
  const unsigned koff=(unsigned)(lane*PIN+wid*8)*2u, voff=(unsigned)((16*(wid&3)+(lane>>2))*PIN+(wid>>2)*32+(lane&3)*8)*2u;
  const unsigned kdst=lds0+LDS_K+wid*1024, vdst=lds0+LDS_V+wid*1024, vdst2=lds0+LDS_V2+wid*1024;
  #define DMA_K(t,slot) glds16((const char*)Kh+(size_t)(t)*(KVBLK*PIN*2)+koff,(unsigned)__builtin_amdgcn_readfirstlane(kdst+(slot)))
  #define DMA_V(t,slot) do{ glds16((const char*)Vh+(size_t)(t)*(KVBLK*PIN*2)+voff,(unsigned)__builtin_amdgcn_readfirstlane(vdst+(slot))); glds16((const char*)Vh+(size_t)(t)*(KVBLK*PIN*2)+128+voff,(unsigned)__builtin_amdgcn_readfirstlane(vdst2+(slot))); }while(0)
  const int vb0=(int)(lds0+LDS_V)+((lane>>4)&1)*32+(lane&3)*8+(4*hi+((lane&15)>>2))*64;
  const char*Kbase=shm+LDS_K; bf16x8 kf[8];
  const lds_cptr shm3=(lds_cptr)shm; const lds_cptr kp0=shm3+LDS_K+hi*1024+r32*16; const lds_cptr vp0=shm3+LDS_V+((lane>>4)&1)*32+(lane&3)*8+(4*hi+((lane&15)>>2))*64;
  const int NT=(q0+QB)/KVBLK;
  DMA_K(0,0);DMA_V(0,0);DMA_K(1,SLOTB);
  bf16x8 qr[4];
  #pragma unroll
  for(int d0=0;d0<4;++d0)qr[d0]=*reinterpret_cast<const bf16x8*>(&Qw[(long)r32*PIN+d0*16+hi*8]);
  const __attribute__((address_space(3))) bf16x8* qld=(const __attribute__((address_space(3))) bf16x8*)(shm3+LDS_OST+wid*4096)+lane;
  #pragma unroll
  for(int d0=0;d0<4;++d0)((__attribute__((address_space(3))) bf16x8*)(shm3+LDS_OST+wid*4096))[d0*64+lane]=qr[d0];
  float mhat=0.f,l_reg=0.f;f32x16 o[2];o[0]=f32x16{};o[1]=f32x16{};f32x16 o2[2];o2[0]=f32x16{};o2[1]=f32x16{}; const f32x16 zero16=f32x16{};
  const int qrel=wid*QBLK+r32;
  #define CMASK(P0,P1,t) do{int jb_=(t)-(NT-4); if(jb_>=0)cmask(P0,P1,jb_,qrel,hi);}while(0)
  bool resc=false;
  #define START(P0,P1) do{ const float rm=rowmax(P0,P1); resc=false; \
    { const float dl=rm; mhat=fadd_s(mhat,dl); \
      _Pragma("unroll") for(int r=0;r<16;++r){P0[r]=fsub_s(P0[r],dl);P1[r]=fsub_s(P1[r],dl);} } \
    _Pragma("unroll") for(int r=0;r<16;++r)P0[r]=__builtin_amdgcn_exp2f(P0[r]); }while(0)
  #define RESC() do{ if(resc){ asm volatile("s_waitcnt lgkmcnt(0)":::"memory"); \
      _Pragma("unroll") for(int d_=0;d_<2;++d_) _Pragma("unroll") for(int r=0;r<16;++r){ const float f_=wsf[crow(r,hi)]; o[d_][r]*=f_; o2[d_][r]*=f_; } } }while(0)
  f32x16 pA0,pA1,pB0,pB1;
  int sl_prev=0,sl_cur=0,sl_next=SLOTB;
  #define ROT() do{sl_prev=sl_cur;sl_cur=sl_next;sl_next=(sl_next==(NSLOT-1)*SLOTB)?0:sl_next+SLOTB;}while(0)
  DMA_K(2,2*SLOTB);
  WAIT_BAR(3);
  qkt(pA0,pA1,Kbase,qr,zero16,r32,hi);asm volatile("s_nop 15\n\ts_nop 7":"+v"(pA0),"+v"(pA1));CMASK(pA0,pA1,0);
  START(pA0,pA1);
  _Pragma("unroll") for(int r=0;r<16;++r)pA1[r]=__builtin_amdgcn_exp2f(pA1[r]);
  WAIT_BAR(0);
  DMA_K(3,0);DMA_V(1,SLOTB);
  ROT();
  kload8(kf,kp0+sl_cur);
  WAIT_BAR(3);
  s16x4 vlo[8],vhi[8]; u32x4 pw0,pw1,pw2,pw3;
  #define PKW(P,B) cvtpk_s(P[B],P[B+1])
  #define PAF(k) __builtin_bit_cast(bf16x8,pw##k)
  #define VFR(i) (bf16x8){vlo[i][0],vlo[i][1],vlo[i][2],vlo[i][3],vhi[i][0],vhi[i][1],vhi[i][2],vhi[i][3]}
  #define PIN(x) asm volatile("":"+v"(x))
  #define MX3(a,b,c) __builtin_fmaxf(__builtin_fmaxf((a),(b)),(c))
  #define GAPA(MF,A0,A1,A2,A3,W0,W1,PW) do{ MF; sacc+=A0; sacc+=A1; sacc+=A2; sacc+=A3; PIN(sacc); W0; W1; PIN(PW); SBAR(); }while(0)
  #define EX(v) __builtin_amdgcn_exp2f(v)
  #define GAPB(MF,X,B) do{ MF; X[B]=EX(X[B]-mhat); X[B+1]=EX(X[B+1]-mhat); PIN(X); SBAR(); }while(0)
  #define VRD(i) do{ vlo[i]=vtr(vp_+(((i)>>2)*4096+((i)&3)*1024)); vhi[i]=vtr(vp_+(((i)>>2)*4096+((i)&3)*1024+512)); }while(0)
  #define KRD(G,j) do{ if(G){ kload2(kf,kp0+sl_next,j); SBAR(); } }while(0)
  #define V2RD(i) do{ vlo[i]=vtr(vq_+(((i)>>2)*4096+((i)&3)*1024)); vhi[i]=vtr(vq_+(((i)>>2)*4096+((i)&3)*1024+512)); }while(0)
  #define STEP(C0,C1,P0,P1,t,GK,GV,GL) do{ SBAR(); \
    const lds_cptr vp_=vp0+sl_prev; \
    const bf16x8 q0_=qld[0],q1_=qld[64],q2_=qld[128],q3_=qld[192];     \
    VRD(0); SBAR(); float sacc=(P0[0]+P0[1]); \
    GAPA(C0=__builtin_amdgcn_mfma_f32_32x32x16_bf16(kf[0],q0_,zero16,0,0,0), P0[2],P0[3],P0[4],P0[5],     pw0[0]=PKW(P0,0), pw0[1]=PKW(P0,2), pw0); \
    VRD(4); SBAR(); GAPA(C1=__builtin_amdgcn_mfma_f32_32x32x16_bf16(kf[1],q0_,zero16,0,0,0), P0[6],P0[7],P0[8],P0[9],     pw0[2]=PKW(P0,4), pw0[3]=PKW(P0,6), pw0); \
    VRD(1); SBAR(); GAPA(C0=__builtin_amdgcn_mfma_f32_32x32x16_bf16(kf[2],q1_,C0,0,0,0),   P0[10],P0[11],P0[12],P0[13], pw1[0]=PKW(P0,8), pw1[1]=PKW(P0,10), pw1); \
    VRD(5); SBAR(); GAPA(C1=__builtin_amdgcn_mfma_f32_32x32x16_bf16(kf[3],q1_,C1,0,0,0),   P0[14],P0[15],P1[0],P1[1],   pw1[2]=PKW(P0,12),pw1[3]=PKW(P0,14), pw1); \
    VRD(2); SBAR(); GAPA(C0=__builtin_amdgcn_mfma_f32_32x32x16_bf16(kf[4],q2_,C0,0,0,0),   P1[2],P1[3],P1[4],P1[5],     pw2[0]=PKW(P1,0), pw2[1]=PKW(P1,2), pw2); \
    VRD(6); SBAR(); GAPA(C1=__builtin_amdgcn_mfma_f32_32x32x16_bf16(kf[5],q2_,C1,0,0,0),   P1[6],P1[7],P1[8],P1[9],     pw2[2]=PKW(P1,4), pw2[3]=PKW(P1,6), pw2); \
    VRD(3); SBAR(); GAPA(C0=__builtin_amdgcn_mfma_f32_32x32x16_bf16(kf[6],q3_,C0,0,0,0),   P1[10],P1[11],P1[12],P1[13], pw3[0]=PKW(P1,8), pw3[1]=PKW(P1,10), pw3); \
    VRD(7); SBAR(); GAPA(C1=__builtin_amdgcn_mfma_f32_32x32x16_bf16(kf[7],q3_,C1,0,0,0),   P1[14],P1[15],0.f,0.f,       pw3[2]=PKW(P1,12),pw3[3]=PKW(P1,14), pw3); \
    l_reg+=sacc; \
    if(GK){DMA_K((t)+3,sl_cur);} if(GV){DMA_V((t)+1,sl_next);} \
    CMASK(C0,C1,t); \
    { float a=MX3(C0[0],C0[1],C1[0]),b=MX3(C0[2],C0[3],C1[1]); a=MX3(a,C1[2],C1[3]); \
      _Pragma("unroll") for(int r=4;r<16;r+=4){a=MX3(a,C0[r],C0[r+1]);b=MX3(b,C0[r+2],C0[r+3]);a=MX3(a,C1[r],C1[r+1]);b=MX3(b,C1[r+2],C1[r+3]);} \
      float rm=__builtin_fmaxf(a,b); { auto rr=__builtin_amdgcn_permlane32_swap(__float_as_uint(rm),__float_as_uint(rm),false,false); rm=__builtin_fmaxf(__uint_as_float(rr[0]),__uint_as_float(rr[1])); } \
      rm-=mhat; resc=false; \
      if(__builtin_expect(__any(rm>(float)THRL),0)){ const float dl=__builtin_fmaxf(rm,0.f); mhat+=dl; \
        const float f=__builtin_amdgcn_exp2f(-dl); l_reg*=f; if(hi==0)wsf[r32]=f; resc=true; } } \
    SBAR(); \
    const lds_cptr vq_=vp0+(LDS_V2-LDS_V)+sl_prev;     \
    GAPB(o[0]=__builtin_amdgcn_mfma_f32_32x32x16_bf16(PAF(0),VFR(0),o[0],0,0,0), C0,0); \
    GAPB(o[1]=__builtin_amdgcn_mfma_f32_32x32x16_bf16(PAF(0),VFR(4),o[1],0,0,0), C0,2); V2RD(0); V2RD(4); SBAR(); \
    KRD(GL,0); GAPB(o[0]=__builtin_amdgcn_mfma_f32_32x32x16_bf16(PAF(1),VFR(1),o[0],0,0,0), C0,4); \
    KRD(GL,1); GAPB(o[1]=__builtin_amdgcn_mfma_f32_32x32x16_bf16(PAF(1),VFR(5),o[1],0,0,0), C0,6); V2RD(1); V2RD(5); SBAR(); \
    KRD(GL,2); GAPB(o[0]=__builtin_amdgcn_mfma_f32_32x32x16_bf16(PAF(2),VFR(2),o[0],0,0,0), C0,8); \
    KRD(GL,3); GAPB(o[1]=__builtin_amdgcn_mfma_f32_32x32x16_bf16(PAF(2),VFR(6),o[1],0,0,0), C0,10); V2RD(2); V2RD(6); SBAR(); \
    GAPB(o[0]=__builtin_amdgcn_mfma_f32_32x32x16_bf16(PAF(3),VFR(3),o[0],0,0,0), C0,12); \
    GAPB(o[1]=__builtin_amdgcn_mfma_f32_32x32x16_bf16(PAF(3),VFR(7),o[1],0,0,0), C0,14); V2RD(3); V2RD(7); SBAR(); \
    {     \
      GAPB(o2[0]=__builtin_amdgcn_mfma_f32_32x32x16_bf16(PAF(0),VFR(0),o2[0],0,0,0), C1,0); GAPB(o2[1]=__builtin_amdgcn_mfma_f32_32x32x16_bf16(PAF(0),VFR(4),o2[1],0,0,0), C1,2); \
      GAPB(o2[0]=__builtin_amdgcn_mfma_f32_32x32x16_bf16(PAF(1),VFR(1),o2[0],0,0,0), C1,4); GAPB(o2[1]=__builtin_amdgcn_mfma_f32_32x32x16_bf16(PAF(1),VFR(5),o2[1],0,0,0), C1,6); \
      GAPB(o2[0]=__builtin_amdgcn_mfma_f32_32x32x16_bf16(PAF(2),VFR(2),o2[0],0,0,0), C1,8); GAPB(o2[1]=__builtin_amdgcn_mfma_f32_32x32x16_bf16(PAF(2),VFR(6),o2[1],0,0,0), C1,10); \
      GAPB(o2[0]=__builtin_amdgcn_mfma_f32_32x32x16_bf16(PAF(3),VFR(3),o2[0],0,0,0), C1,12); GAPB(o2[1]=__builtin_amdgcn_mfma_f32_32x32x16_bf16(PAF(3),VFR(7),o2[1],0,0,0), C1,14); } \
    }while(0)
  int t=1;
  #undef CMASK
  #define CMASK(P0,P1,t) do{}while(0)
  for(;t+5<NT;t+=2){
    STEP(pB0,pB1,pA0,pA1,t,true,true,true);     WAIT_BAR(3); RESC(); ROT();
    STEP(pA0,pA1,pB0,pB1,t+1,true,true,true);   WAIT_BAR(3); RESC(); ROT();
  }
  #undef CMASK
  #define CMASK(P0,P1,t) do{int jb_=(t)-(NT-4); if(jb_>=0)cmask(P0,P1,jb_,qrel,hi);}while(0)
  #define ENDW(tt) do{ if((tt)+3<NT){WAIT_BAR(3);} else if((tt)+2<NT){WAIT_BAR(2);} else {WAIT_BAR(0);} }while(0)
  for(;t+1<NT;t+=2){
    STEP(pB0,pB1,pA0,pA1,t,(t+3<NT),(t+1<NT),(t+1<NT));       ENDW(t);   RESC(); ROT();
    STEP(pA0,pA1,pB0,pB1,t+1,(t+4<NT),(t+2<NT),(t+2<NT));     ENDW(t+1); RESC(); ROT();
  }
  STEP(pB0,pB1,pA0,pA1,NT-1,false,false,false); RESC();
  { float sacc=pB0[0]+pB0[1]; _Pragma("unroll") for(int r=2;r<16;++r)sacc+=pB0[r]; _Pragma("unroll") for(int r=0;r<16;++r)sacc+=pB1[r]; l_reg+=sacc;
    pw0=(u32x4){PKW(pB0,0),PKW(pB0,2),PKW(pB0,4),PKW(pB0,6)};pw1=(u32x4){PKW(pB0,8),PKW(pB0,10),PKW(pB0,12),PKW(pB0,14)};pw2=(u32x4){PKW(pB1,0),PKW(pB1,2),PKW(pB1,4),PKW(pB1,6)};pw3=(u32x4){PKW(pB1,8),PKW(pB1,10),PKW(pB1,12),PKW(pB1,14)};
    SBAR(); pv(o,vb0+sl_cur,PAF(0),PAF(1),PAF(2),PAF(3)); pv(o2,vb0+(LDS_V2-LDS_V)+sl_cur,PAF(0),PAF(1),PAF(2),PAF(3)); }
  #undef PKW
  #undef PAF
  #undef VFR
  #undef PIN
  #undef MX3
  #undef GAPA
  #undef GAPB
  #undef EX
  #undef VRD
  #undef KRD
  #undef V2RD
  #undef STEP
  #undef ENDW
  {auto rr=__builtin_amdgcn_permlane32_swap(__float_as_uint(l_reg),__float_as_uint(l_reg),false,false);l_reg=__uint_as_float(rr[0])+__uint_as_float(rr[1]);}
  if(hi==0)wsf[32+r32]=l_reg;asm volatile("s_waitcnt lgkmcnt(0)":::"memory");
  float rli[16];
  #pragma unroll
  for(int r=0;r<16;++r)rli[r]=__builtin_amdgcn_rcpf(wsf[32+crow(r,hi)]);
  bf16*Ow=O+(rowbase+q0+wid*QBLK)*PO;
  { bf16*stg=(bf16*)(shm+LDS_OST)+wid*2048;
    if(cmap==0){
      #pragma unroll
      for(int hf=0;hf<2;++hf){
        #pragma unroll
        for(int r=0;r<16;++r){const int orow=crow(r,hi);
          #pragma unroll
          for(int d0=0;d0<2;++d0)stg[orow*64+d0*32+r32]=__float2bfloat16((hf?o2[d0][r]:o[d0][r])*rli[r]);}
        asm volatile("s_waitcnt lgkmcnt(0)":::"memory");
        #pragma unroll
        for(int i=0;i<4;++i){const int row=i*8+(lane>>3),ch=lane&7; const u32x4 v=*(const u32x4*)(stg+row*64+ch*8); ATTN_STORE16(Ow+(long)row*PO+hf*64+ch*8,v);}
        asm volatile("s_waitcnt lgkmcnt(0)":::"memory"); }
    } else {
      asm volatile("s_waitcnt vmcnt(0)":::"memory");
      float dd[2][4][8]; const int ch=lane&7;
      #pragma unroll
      for(int hf=0;hf<2;++hf){
        #pragma unroll
        for(int r=0;r<16;++r){const int orow=crow(r,hi);
          #pragma unroll
          for(int d0=0;d0<2;++d0)stg[orow*64+d0*32+r32]=__float2bfloat16((hf?o2[d0][r]:o[d0][r])*rli[r]);}
        asm volatile("s_waitcnt lgkmcnt(0)":::"memory");
        #pragma unroll
        for(int i=0;i<4;++i){const int row=i*8+(lane>>3); const u32x4 v1=*(const u32x4*)(stg+row*64+ch*8); const u32x4 v0=*(const u32x4*)(Ow+(long)row*PO+hf*64+ch*8);
          #pragma unroll
          for(int j=0;j<4;++j){ dd[hf][i][2*j]=__uint_as_float(v0[j]<<16)-lam*__uint_as_float(v1[j]<<16); dd[hf][i][2*j+1]=__uint_as_float(v0[j]&0xffff0000u)-lam*__uint_as_float(v1[j]&0xffff0000u); } }
        asm volatile("s_waitcnt lgkmcnt(0)":::"memory"); }
      float gg[2][8];
      #pragma unroll
      for(int hf=0;hf<2;++hf){ const float4 a=*(const float4*)(ng+hf*64+ch*8), c4=*(const float4*)(ng+hf*64+ch*8+4); gg[hf][0]=a.x;gg[hf][1]=a.y;gg[hf][2]=a.z;gg[hf][3]=a.w;gg[hf][4]=c4.x;gg[hf][5]=c4.y;gg[hf][6]=c4.z;gg[hf][7]=c4.w; }
      bf16*Mw=M+(rowbase+q0+wid*QBLK)*PO;
      #pragma unroll
      for(int i=0;i<4;++i){ float ss=0.f;
        #pragma unroll
        for(int hf=0;hf<2;++hf)
          #pragma unroll
          for(int j=0;j<8;++j)ss+=dd[hf][i][j]*dd[hf][i][j];
        ss+=__shfl_xor(ss,1);ss+=__shfl_xor(ss,2);ss+=__shfl_xor(ss,4);
        const float rr=osc/sqrtf(ss*(1.0f/128.0f)+1e-5f); const int row=i*8+(lane>>3);
        #pragma unroll
        for(int hf=0;hf<2;++hf){ u32x4 w;
          #pragma unroll
          for(int j=0;j<4;++j)w[j]=cvtpk_s(dd[hf][i][2*j]*rr*gg[hf][2*j],dd[hf][i][2*j+1]*rr*gg[hf][2*j+1]);
          ATTN_STORE16(Mw+(long)row*PO+hf*64+ch*8,w); } }
    } }
  asm volatile("s_waitcnt lgkmcnt(0)\n\ts_barrier":::"memory");
  #undef DMA_K
  #undef DMA_V
  #undef CMASK
  #undef START
  #undef RESC
  #undef ROT
}
constexpr int ATTN_LDS_BYTES=LDS_BYTES;
__device__ __forceinline__ void attn_phase(char*lds,const bf16*proj,bf16*O,bf16*M,const float*ng,float lam,float osc,int vcu){
  const int bh=vcu>>3, s=vcu&7, b=bh>>2, h=bh&3;
  const bf16*V=proj+1024+h*128; bf16*Oc=O+h*128; bf16*Mc=M+h*128;
  for(int i=0;i<2;++i){ const int qb=i?15-s:s;
    for(int c=0;c<2;++c) attn_unit<8>(b,qb,proj+h*128+c*64,proj+512+h*128+c*64,V,Oc,lds,c,lam,osc,ng,Mc); }
}
#undef SBAR
#undef WAIT_BAR
}
#define GAS __attribute__((address_space(1)))
#define LAS __attribute__((address_space(3)))
typedef unsigned short bf16;
typedef unsigned v4u __attribute__((ext_vector_type(4)));
typedef float f32x4 __attribute__((ext_vector_type(4)));
typedef short bf16x8 __attribute__((ext_vector_type(8)));
typedef GAS unsigned gu32;
typedef GAS unsigned long long gu64;
#define RLX_AGENT __ATOMIC_RELAXED, __HIP_MEMORY_SCOPE_AGENT
#define LDS_WAIT() asm volatile("s_waitcnt lgkmcnt(0)" ::: "memory")
#define VM_WAIT() asm volatile("s_waitcnt vmcnt(0)" ::: "memory")
__device__ __forceinline__ unsigned long long rt() { return __builtin_amdgcn_s_memrealtime(); }
typedef float f32x2_cv __attribute__((ext_vector_type(2))); typedef __bf16 bf16x2_cv __attribute__((ext_vector_type(2)));
__device__ __forceinline__ unsigned pk2(float lo, float hi) { const f32x2_cv v = {lo, hi}; const bf16x2_cv b = __builtin_convertvector(v, bf16x2_cv); return __builtin_bit_cast(unsigned, b); }
__device__ __forceinline__ unsigned f2bf(float f) { return pk2(f, 0.f) & 0xffffu; }

#define XB_TMO      128
#define XB_XCNT(j)  (256  + 64 * (j))
#define XB_XSUB(j)  (1280 + 64 * (j))
#define XB_XGEN(j)  (2304 + 64 * (j))
#define XB_TOP      3328
#define XB_TOPGEN   3392
#define XCD_BAR_WORDS 3456
#define XB_SPIN_CAP (1u << 18)

__device__ __forceinline__ unsigned xb_ld(unsigned* p)              { return __hip_atomic_load(p, __ATOMIC_RELAXED, __HIP_MEMORY_SCOPE_AGENT); }
__device__ __forceinline__ unsigned xb_add(unsigned* p, unsigned v) { return __hip_atomic_fetch_add(p, v, __ATOMIC_RELAXED, __HIP_MEMORY_SCOPE_AGENT); }
__device__ __forceinline__ unsigned xb_xcc_id() { return (unsigned)__builtin_amdgcn_s_getreg((3 << 11) | 20) & 0xFu; }
#define XB_SPIN(cond, bar) do { unsigned _sp = 0; while (cond) { __builtin_amdgcn_s_sleep(1); \
    if ((++_sp & 255u) == 0u) { if (xb_ld(&(bar)[XB_TMO])) break; if (_sp > XB_SPIN_CAP) { atomicAdd(&(bar)[XB_TMO], 1u); break; } } } } while (0)

struct XcdBarrier {
    unsigned* bar; unsigned x;
    volatile LAS unsigned* st;
};

__device__ __forceinline__ XcdBarrier xcd_barrier_post(unsigned* bar, volatile LAS unsigned* st) {
    XcdBarrier b; b.bar = bar; b.x = xb_xcc_id(); b.st = st;
    if (threadIdx.x == 0) (void)xb_add(&bar[XB_XCNT(b.x)], 1u);
    return b;
}
__device__ __forceinline__ void xcd_barrier_complete(unsigned* bar, unsigned x, unsigned& nloc, unsigned& nx) {
    const unsigned G = gridDim.x * gridDim.y * gridDim.z;
    unsigned sum, cnt, mine, sp = 0u;
    for (;;) {
        sum = 0u; cnt = 0u; mine = 0u;
#pragma unroll
        for (unsigned j = 0; j < 16; ++j) { const unsigned c = xb_ld(&bar[XB_XCNT(j)]); sum += c; cnt += (c > 0u) ? 1u : 0u; mine = (j == x) ? c : mine; }
        if (sum == G) break;
        __builtin_amdgcn_s_sleep(1);
        if ((++sp & 255u) == 0u) { if (xb_ld(&bar[XB_TMO])) break; if (sp > XB_SPIN_CAP) { atomicAdd(&bar[XB_TMO], 1u); break; } }
    }
    nloc = mine > 0u ? mine : 1u; nx = cnt > 0u ? cnt : 1u;
}

__device__ __forceinline__ void xcd_barrier(const XcdBarrier& b) {
    asm volatile("s_waitcnt vmcnt(0)" ::: "memory");
    __syncthreads();
    if (threadIdx.x == 0) {
        unsigned* bar = b.bar;
        __builtin_amdgcn_s_waitcnt(0);
        unsigned nloc = b.st[0], nx = b.st[1];
        if (nloc == 0u) { xcd_barrier_complete(bar, b.x, nloc, nx); b.st[0] = nloc; b.st[1] = nx; }
        const unsigned old = xb_add(&bar[XB_XSUB(b.x)], 1u);
        const unsigned gen = old / nloc;
        if (old + 1u == (gen + 1u) * nloc) {
            __builtin_amdgcn_fence(__ATOMIC_RELEASE, "agent");
            asm volatile("s_waitcnt vmcnt(0)" ::: "memory");
            const unsigned og = xb_add(&bar[XB_TOP], 1u);
            const unsigned tg = og / nx;
            if (og + 1u == (tg + 1u) * nx) xb_add(&bar[XB_TOPGEN], 1u);
            else XB_SPIN(xb_ld(&bar[XB_TOPGEN]) == tg, bar);
            __builtin_amdgcn_fence(__ATOMIC_ACQUIRE, "agent");
            xb_add(&bar[XB_XGEN(b.x)], 1u);
            asm volatile("s_waitcnt vmcnt(0)" ::: "memory");
        } else {
            XB_SPIN(xb_ld(&bar[XB_XGEN(b.x)]) == gen, bar);
            __builtin_amdgcn_fence(__ATOMIC_ACQUIRE, "agent");
            asm volatile("s_waitcnt vmcnt(0)" ::: "memory");
        }
    }
    __syncthreads();
}
constexpr int NWAVES = 8, NTHREADS = NWAVES * 64;
constexpr int BATCH = 8, SEQ = 4096, NTOK = BATCH * SEQ, DMODEL = 1024, INW = 3080, NPROJ = 3072, DEPTH = 4;
constexpr int NEXP = 32, DFF = 1024, CHUNK = 64, NCH = SEQ / CHUNK, NBH = BATCH * 4;
constexpr int MAXRT = (NTOK * 4) / 256 + NEXP;
constexpr float DN_ALPHA = 1.681792830507429f, LN_EPS = 1e-5f, RMS_EPS = 1e-5f;
constexpr int NPH_LAYER = 10, NPHASES = 1 + DEPTH * NPH_LAYER;

constexpr size_t MiB = 1u << 20;
constexpr size_t WS_CTL = 0, CTL_ZERO_BYTES = 1 * MiB;
constexpr size_t WS_WIN = 2 * MiB;
#ifndef MK_SIDEJOB
#define MK_SIDEJOB 0
#endif
#ifndef MK_X1R8
#define MK_X1R8 1
#endif
constexpr float X1R_SCALE = 128.0f;
#ifndef MK_OUTFP8
#define MK_OUTFP8 0
#endif
constexpr float MQ_SCALE = 16.0f, MQ_ML = 2.0f;
constexpr size_t WS_WOUT = WS_WIN + 24 * MiB;
constexpr size_t WS_WGU = WS_WOUT + 8 * MiB;
constexpr size_t WS_WDN = WS_WGU + 512 * MiB;
constexpr size_t WS_XRES = WS_WDN + 256 * MiB;
constexpr size_t WS_X1 = WS_XRES + 128 * MiB;
constexpr size_t WS_XB = WS_X1 + 128 * MiB;
constexpr size_t WS_X1B = WS_XB + 64 * MiB;
constexpr size_t WS_PROJ = WS_X1B + 64 * MiB;
constexpr size_t WS_G = WS_PROJ + 192 * MiB;
constexpr size_t WS_ATTO = WS_G + 1 * MiB;
constexpr size_t WS_MIXIN = WS_ATTO + 64 * MiB;
constexpr size_t WS_MIXO = WS_MIXIN + 64 * MiB;
constexpr size_t WS_CST = WS_MIXO + 64 * MiB;
constexpr size_t WS_NST = WS_CST + 64 * MiB;
constexpr size_t WS_MISC = WS_NST + 1 * MiB;
constexpr size_t WS_WRP = WS_MISC + 512 * 1024;
constexpr size_t WS_TOKE = WS_MISC + 1 * MiB;
constexpr size_t WS_TOKP = WS_TOKE + 1 * MiB;
constexpr size_t WS_TOKG = WS_TOKP + 1 * MiB;
constexpr size_t WS_ROWTOK = WS_TOKG + 1 * MiB;
constexpr size_t WS_H = WS_ROWTOK + 4 * MiB;
constexpr size_t WS_Y = WS_H + 272 * MiB;
constexpr size_t WS_WINQ = WS_Y + 272 * MiB;
constexpr size_t WS_XQ = WS_WINQ + 8 * MiB;
constexpr size_t WS_END = WS_XQ + 32 * MiB;
static_assert((size_t)MAXRT * 256 * 1024 * 2 <= 272 * MiB, "H/Y size");
constexpr int CW_TMO = 0, CW_CODE = 1, CW_BAR = 4096, MAX_BAR_REGIONS = 48, CW_CNT = 200000;
static_assert(CW_BAR + MAX_BAR_REGIONS * 3456 <= CW_CNT && (CW_CNT + 64 * DEPTH) * 4 <= (int)CTL_ZERO_BYTES, "CTL map");
constexpr int RING_OFF = 0, RING_BYTES = 131072;
constexpr int LDSCTL_OFF = RING_BYTES;
constexpr int MISC_OFF = LDSCTL_OFF + 320;
constexpr int LDSX_OFF = LDSCTL_OFF + 512;
constexpr int LDS_BYTES = 163840;

typedef unsigned v2u __attribute__((ext_vector_type(2)));
__device__ __forceinline__ float bflo(unsigned w) { return __uint_as_float(w << 16); }
__device__ __forceinline__ float bfhi(unsigned w) { return __uint_as_float(w & 0xffff0000u); }
__device__ __forceinline__ void unpack8(const v4u w, float* o) { o[0] = bflo(w.x); o[1] = bfhi(w.x); o[2] = bflo(w.y); o[3] = bfhi(w.y); o[4] = bflo(w.z); o[5] = bfhi(w.z); o[6] = bflo(w.w); o[7] = bfhi(w.w); }
constexpr float XQ_SCALE = 8.0f, WQ_SCALE = 512.0f, HQ_SCALE = 8.0f, YQ_SCALE = 64.0f, XLO_SCALE = 4096.0f;
#ifndef MK_XLO
#define MK_XLO 0
#endif
constexpr bool USE_XLO = (MK_XLO != 0);
__device__ __forceinline__ v2u pack8_fp8(const float* o, float sc) { int a = 0, b = 0; a = __builtin_amdgcn_cvt_pk_fp8_f32(o[0] * sc, o[1] * sc, a, false); a = __builtin_amdgcn_cvt_pk_fp8_f32(o[2] * sc, o[3] * sc, a, true);
    b = __builtin_amdgcn_cvt_pk_fp8_f32(o[4] * sc, o[5] * sc, b, false); b = __builtin_amdgcn_cvt_pk_fp8_f32(o[6] * sc, o[7] * sc, b, true); return (v2u){(unsigned)a, (unsigned)b}; }
__device__ __forceinline__ v4u pack8(const float* o) { v4u w; w.x = pk2(o[0], o[1]); w.y = pk2(o[2], o[3]); w.z = pk2(o[4], o[5]); w.w = pk2(o[6], o[7]); return w; }
__device__ __forceinline__ float wave_sum(float v) {
#pragma unroll
    for (int o = 1; o < 64; o <<= 1) v += __shfl_xor(v, o);
    return v;
}
__device__ __forceinline__ float wave_max(float v) {
#pragma unroll
    for (int o = 1; o < 64; o <<= 1) v = fmaxf(v, __shfl_xor(v, o));
    return v;
}
__device__ __forceinline__ float sigmoid_f(float x) { return __builtin_amdgcn_rcpf(1.0f + __expf(-x)); }

struct Ctx {
    LAS unsigned char* lds; int wave, vcu, G; unsigned char* ws; const float* const* in; float* out;
};
__device__ __forceinline__ int ltid() { int t = threadIdx.x; asm volatile("" : "+v"(t)); return t; }
enum { I_X = 0, I_WIN, I_CONVW, I_CONVB, I_GATEB, I_LQ1, I_LK1, I_LQ2, I_LK2, I_NG, I_WOUT, I_LN1G, I_LN1B, I_WR, I_BR, I_WGU, I_BGU, I_WDN, I_BDN, I_LN2G, I_LN2B };

__device__ __forceinline__ void load_row_f32(const float* row, int lane, float* v) {
    const f32x4* p = (const f32x4*)(row + 8 * lane); const f32x4 a = p[0], b = p[1]; const f32x4* q = (const f32x4*)(row + 512 + 8 * lane); const f32x4 c = q[0], d = q[1];
    v[0] = a.x; v[1] = a.y; v[2] = a.z; v[3] = a.w; v[4] = b.x; v[5] = b.y; v[6] = b.z; v[7] = b.w; v[8] = c.x; v[9] = c.y; v[10] = c.z; v[11] = c.w; v[12] = d.x; v[13] = d.y; v[14] = d.z; v[15] = d.w;
}
__device__ __forceinline__ void store_row_f32(float* row, int lane, const float* v) {
    f32x4* p = (f32x4*)(row + 8 * lane); p[0] = (f32x4){v[0], v[1], v[2], v[3]}; p[1] = (f32x4){v[4], v[5], v[6], v[7]};
    f32x4* q = (f32x4*)(row + 512 + 8 * lane); q[0] = (f32x4){v[8], v[9], v[10], v[11]}; q[1] = (f32x4){v[12], v[13], v[14], v[15]};
}
__device__ __forceinline__ void load_row_bf16(const bf16* row, int lane, float* v) {
    const v4u a = *(const v4u*)(row + 8 * lane), b = *(const v4u*)(row + 512 + 8 * lane); unpack8(a, v); unpack8(b, v + 8);
}
__device__ __forceinline__ void load_row_fp8(const unsigned char* row, int lane, float sc, float* v) {
    typedef float f32x2_ __attribute__((ext_vector_type(2)));
    const v2u a = *(const v2u*)(row + 8 * lane), b = *(const v2u*)(row + 512 + 8 * lane); const unsigned w[4] = {a.x, a.y, b.x, b.y};
#pragma unroll
    for (int i = 0; i < 4; ++i) { const f32x2_ lo = __builtin_amdgcn_cvt_pk_f32_fp8((int)w[i], false), hi = __builtin_amdgcn_cvt_pk_f32_fp8((int)w[i], true); v[4 * i] = lo.x * sc; v[4 * i + 1] = lo.y * sc; v[4 * i + 2] = hi.x * sc; v[4 * i + 3] = hi.y * sc; }
}
__device__ __forceinline__ void store_row_fp8(unsigned char* row, int lane, const float* v, float sc) {
    *(v2u*)(row + 8 * lane) = pack8_fp8(v, sc); *(v2u*)(row + 512 + 8 * lane) = pack8_fp8(v + 8, sc);
}
__device__ __forceinline__ void store_row_bf16(bf16* row, int lane, const float* v) {
    *(v4u*)(row + 8 * lane) = pack8(v); *(v4u*)(row + 512 + 8 * lane) = pack8(v + 8);
}
__device__ __forceinline__ void store_row_fp8_nt(unsigned char* row, int lane, const float* v, float sc) {
    __builtin_nontemporal_store(pack8_fp8(v, sc), (v2u*)(row + 8 * lane)); __builtin_nontemporal_store(pack8_fp8(v + 8, sc), (v2u*)(row + 512 + 8 * lane));
}
__device__ __forceinline__ void store_row_bf16_nt(bf16* row, int lane, const float* v) {
    __builtin_nontemporal_store(pack8(v), (v4u*)(row + 8 * lane)); __builtin_nontemporal_store(pack8(v + 8), (v4u*)(row + 512 + 8 * lane));
}
__device__ __forceinline__ void store_row_f32_nt(float* row, int lane, const float* v) {
    f32x4* p = (f32x4*)(row + 8 * lane); __builtin_nontemporal_store((f32x4){v[0], v[1], v[2], v[3]}, p); __builtin_nontemporal_store((f32x4){v[4], v[5], v[6], v[7]}, p + 1);
    f32x4* q = (f32x4*)(row + 512 + 8 * lane); __builtin_nontemporal_store((f32x4){v[8], v[9], v[10], v[11]}, q); __builtin_nontemporal_store((f32x4){v[12], v[13], v[14], v[15]}, q + 1);
}
__device__ __forceinline__ void ln_row(float* v, const float* g, const float* b) {
    float s = 0.f;
#pragma unroll
    for (int i = 0; i < 16; ++i) s += v[i];
    const float mean = wave_sum(s) * (1.0f / DMODEL); float q = 0.f;
#pragma unroll
    for (int i = 0; i < 16; ++i) { v[i] -= mean; q += v[i] * v[i]; }
    const float rstd = 1.0f / sqrtf(wave_sum(q) * (1.0f / DMODEL) + LN_EPS);
#pragma unroll
    for (int i = 0; i < 16; ++i) v[i] = v[i] * rstd * g[i] + b[i];
}
__device__ __forceinline__ void load_vec16(const float* p, int lane, float* v) { load_row_f32(p, lane, v); }

__device__ __forceinline__ void load_gate_w(int tid, const float* w_in_l, LAS f32x4* wgl) {
    for (int idx = tid; idx < 2048; idx += NTHREADS) { const int ln = idx & 63, hq = idx >> 6, half = hq & 1, q = hq >> 1; const int k = (q < 8) ? (8 * ln + q) : (512 + 8 * ln + q - 8);
        wgl[idx] = *(const f32x4*)(w_in_l + (size_t)k * INW + NPROJ + 4 * half); }
}
__device__ __forceinline__ void gates_row(const float* v, const LAS f32x4* wgl, const float* gate_b, float* Grow, int lane) {
    float p[8] = {0.f, 0.f, 0.f, 0.f, 0.f, 0.f, 0.f, 0.f};
#pragma unroll
    for (int q = 0; q < 16; ++q) { const f32x4 w0 = wgl[(q * 2 + 0) * 64 + lane], w1 = wgl[(q * 2 + 1) * 64 + lane];
        p[0] += v[q] * w0.x; p[1] += v[q] * w0.y; p[2] += v[q] * w0.z; p[3] += v[q] * w0.w; p[4] += v[q] * w1.x; p[5] += v[q] * w1.y; p[6] += v[q] * w1.z; p[7] += v[q] * w1.w; }
    const bool b5 = (lane >> 5) & 1, b4 = (lane >> 4) & 1, b3 = (lane >> 3) & 1;
    float r4[4];
#pragma unroll
    for (int i = 0; i < 4; ++i) { const float keep = b5 ? p[4 + i] : p[i], send = b5 ? p[i] : p[4 + i]; r4[i] = keep + __shfl_xor(send, 32); }
    float r2[2];
#pragma unroll
    for (int i = 0; i < 2; ++i) { const float keep = b4 ? r4[2 + i] : r4[i], send = b4 ? r4[i] : r4[2 + i]; r2[i] = keep + __shfl_xor(send, 16); }
    float r1; { const float keep = b3 ? r2[1] : r2[0], send = b3 ? r2[0] : r2[1]; r1 = keep + __shfl_xor(send, 8); }
    r1 += __shfl_xor(r1, 4); r1 += __shfl_xor(r1, 2); r1 += __shfl_xor(r1, 1);
    if ((lane & 7) == 0) { const int gi = (lane >> 3); Grow[gi] = r1 + gate_b[gi]; }
}
struct TrItem { const float* src; unsigned char* dst; int ldw, Kd, fp8; float sc; };
__device__ __forceinline__ void tr_fetch(const TrItem& a, float* ra, int lane) {
    const int kk0 = lane >> 5, nn = lane & 31;
#pragma unroll
    for (int i = 0; i < 64; ++i) ra[i] = a.src[(size_t)(2 * i + kk0) * a.ldw + nn];
}
__device__ __forceinline__ void tr_put(const float* ra, LAS float* scr, int lane) {
    const int kk0 = lane >> 5, nn = lane & 31;
#pragma unroll
    for (int i = 0; i < 64; ++i) scr[(2 * i + kk0) * 33 + nn] = ra[i];
}
__device__ __forceinline__ void tr_store(const TrItem& it, const LAS float* scr, int lane) {
    const int c = lane & 7;
#pragma unroll
    for (int j = 0; j < 4; ++j) { const int n = (lane >> 3) + 8 * j; const LAS float* s = scr + (16 * c) * 33 + n; float o[16];
#pragma unroll
        for (int i = 0; i < 16; ++i) o[i] = s[i * 33];
        if (it.fp8) { const v2u p = pack8_fp8(o, it.sc), q = pack8_fp8(o + 8, it.sc); *(GAS v4u*)(it.dst + (size_t)n * it.Kd + 16 * c) = (v4u){p.x, p.y, q.x, q.y}; }
        else { GAS v4u* d = (GAS v4u*)(it.dst + ((size_t)n * it.Kd + 16 * c) * 2); d[0] = pack8(o); d[1] = pack8(o + 8); } }
}
constexpr int TR_I_IN = DEPTH * 8 * 96, TR_I_OUT = DEPTH * 8 * 32, TR_I_GU = DEPTH * NEXP * 8 * 64, TR_I_DN = DEPTH * NEXP * 8 * 32, TR_ITEMS = TR_I_IN + TR_I_OUT + TR_I_GU + TR_I_DN;
__device__ __forceinline__ TrItem tr_decode(const Ctx& C, int r) {
    TrItem it;
    if (r < TR_I_GU) { const int m = r / 512, q = r % 512, kb = q / 64, nb = q % 64, n0 = 32 * nb;
        const int nn = (n0 < 1024) ? n0 : n0 - 1024; const int drow = 256 * (nn / 128) + (nn % 128) + ((n0 < 1024) ? 0 : 128);
        it.src = C.in[I_WGU] + (size_t)m * DMODEL * 2 * DFF + (size_t)(128 * kb) * (2 * DFF) + n0; it.ldw = 2 * DFF; it.Kd = DMODEL; it.fp8 = 1; it.sc = WQ_SCALE;
        it.dst = C.ws + WS_WGU + (size_t)m * 2 * DFF * DMODEL + (size_t)drow * DMODEL + 128 * kb; return it; }
    r -= TR_I_GU;
    if (r < TR_I_DN) { const int m = r / 256, q = r % 256, kb = q / 32, nb = q % 32;
        it.src = C.in[I_WDN] + (size_t)m * DFF * DMODEL + (size_t)(128 * kb) * DMODEL + 32 * nb; it.ldw = DMODEL; it.Kd = DFF; it.fp8 = 1; it.sc = WQ_SCALE;
        it.dst = C.ws + WS_WDN + (size_t)m * DMODEL * DFF + (size_t)(32 * nb) * DFF + 128 * kb; return it; }
    r -= TR_I_DN;
    if (r < TR_I_IN) { const int l = r / 768, q = r % 768, kb = q / 96, nb = q % 96, n0 = 32 * nb, tile = n0 >> 8;
        const bool q8 = (tile >= 8); const int rank = q8 ? tile - 8 : tile; const int drow = rank * 256 + (n0 & 255);
        it.src = C.in[I_WIN] + (size_t)l * DMODEL * INW + (size_t)(128 * kb) * INW + n0; it.ldw = INW; it.Kd = DMODEL; it.fp8 = q8 ? 1 : 0; it.sc = q8 ? WQ_SCALE : 1.f;
        it.dst = q8 ? C.ws + WS_WINQ + (size_t)l * 1536 * DMODEL + (size_t)drow * DMODEL + 128 * kb : C.ws + WS_WIN + ((size_t)l * NPROJ * DMODEL + (size_t)drow * DMODEL + 128 * kb) * 2; return it; }
    r -= TR_I_IN;
    { const int l = r / 256, q = r % 256, kb = q / 32, nb = q % 32;
        it.src = C.in[I_WOUT] + (size_t)l * DMODEL * DMODEL + (size_t)(128 * kb) * DMODEL + 32 * nb; it.ldw = DMODEL; it.Kd = DMODEL; it.fp8 = MK_OUTFP8; it.sc = MK_OUTFP8 ? ((kb >= 4) ? WQ_SCALE * (MQ_SCALE / MQ_ML) : WQ_SCALE) : 1.f;
        it.dst = C.ws + WS_WOUT + ((size_t)l * DMODEL * DMODEL + (size_t)(32 * nb) * DMODEL + 128 * kb) * (MK_OUTFP8 ? 1 : 2); return it; }
}
#ifndef MK_TRQ_RUNS
#define MK_TRQ_RUNS 0
#endif
constexpr int TR_L_GU = NEXP * 8 * 64, TR_L_DN = NEXP * 8 * 32, TR_L = TR_L_GU + TR_L_DN, TR_P_ITEMS = TR_L + TR_I_IN + TR_I_OUT, TRQ_LAYERS = DEPTH - 1;
__device__ __forceinline__ int trq_per(const Ctx& C) { return (TR_L + C.G - 1) / C.G; }
__device__ __forceinline__ int trq_item(const Ctx& C, int q) {
    const int per = trq_per(C), l = 1 + q / per, i = MK_TRQ_RUNS ? (C.vcu * per + q % per) : ((q % per) * C.G + C.vcu); if (i >= TR_L) return -1;
    return (i < TR_L_GU) ? l * TR_L_GU + i : TR_I_GU + l * TR_L_DN + (i - TR_L_GU); }
__device__ __forceinline__ int trp_item(int p) { return (p < TR_L_GU) ? p : (p < TR_L) ? TR_I_GU + (p - TR_L_GU) : TR_I_GU + TR_I_DN + (p - TR_L); }
__device__ __forceinline__ void tr_one(const Ctx& C, int r, LAS float* scr, int lane) {
    float ra[64]; const TrItem it = tr_decode(C, r); tr_fetch(it, ra, lane); tr_put(ra, scr, lane); LDS_WAIT(); asm volatile("" ::: "memory"); tr_store(it, scr, lane); LDS_WAIT(); asm volatile("" ::: "memory");
}
__device__ __forceinline__ int trq_grab(const Ctx& C, int lane) { unsigned v = 0u; if (lane == 0) v = __hip_atomic_fetch_add((LAS unsigned*)(C.lds + MISC_OFF) + 11, 1u, __ATOMIC_RELAXED, __HIP_MEMORY_SCOPE_WORKGROUP); return (int)__builtin_amdgcn_readfirstlane(v); }
__device__ __forceinline__ void trq_drain(const Ctx& C, int l) {
    const int lane = ltid() & 63, per = trq_per(C), endq = l * per, total = TRQ_LAYERS * per;
    LAS float* scr = (LAS float*)(C.lds + (C.wave < 7 ? RING_OFF + C.wave * 16896 : LDSX_OFF));
    for (;;) { const int q = trq_grab(C, lane); if (q >= total) break; const int r = trq_item(C, q); if (r >= 0) tr_one(C, r, scr, lane); if (q >= endq) break; }
    __syncthreads();
}
__device__ __forceinline__ void p_prologue(const Ctx& C) {
    const int tid = ltid(), lane = tid & 63;
    const int gw = C.vcu * NWAVES + C.wave, NGW = C.G * NWAVES;
    LAS float* scr = (LAS float*)(C.lds + (C.wave < 7 ? RING_OFF + C.wave * 16896 : LDSX_OFF));
    float ra[64]; TrItem cur = tr_decode(C, trp_item(gw < TR_P_ITEMS ? gw : 0));
    if (gw < TR_P_ITEMS) tr_fetch(cur, ra, lane);
    for (int it = gw; it < TR_P_ITEMS; it += NGW) {
        tr_put(ra, scr, lane);
        const bool more = (it + NGW < TR_P_ITEMS); const TrItem nxt = tr_decode(C, trp_item(more ? it + NGW : it));
        if (more) tr_fetch(nxt, ra, lane);
        LDS_WAIT(); asm volatile("" ::: "memory");
        tr_store(cur, scr, lane);
        LDS_WAIT(); asm volatile("" ::: "memory");
        cur = nxt;
    }
    { f32x4* WRP = (f32x4*)(C.ws + WS_WRP); const int gt = (C.vcu * NWAVES + C.wave) * 64 + lane, NGT = C.G * NTHREADS;
        for (int i = gt; i < DEPTH * 8192; i += NGT) { const int l = i >> 13, idx = i & 8191, ln = idx & 63, q4 = (idx >> 6) & 3, e = idx >> 8; const int k = (q4 < 2) ? (8 * ln + 4 * q4) : (512 + 8 * ln + 4 * (q4 - 2));
            const float* wr = C.in[I_WR] + (size_t)l * DMODEL * NEXP; WRP[i] = (f32x4){wr[(size_t)k * NEXP + e], wr[(size_t)(k + 1) * NEXP + e], wr[(size_t)(k + 2) * NEXP + e], wr[(size_t)(k + 3) * NEXP + e]}; } }
    __syncthreads();
    LAS f32x4* wgl = (LAS f32x4*)(C.lds + RING_OFF);
    load_gate_w(tid, C.in[I_WIN], wgl);
    __syncthreads();
    bf16* XB = (bf16*)(C.ws + WS_XB); float* G = (float*)(C.ws + WS_G);
    unsigned char* XLO = (unsigned char*)(C.ws + WS_XRES);
    for (int n = gw; n < NTOK; n += NGW) { float v[16], lo_[16]; load_row_f32(C.in[I_X] + (size_t)n * DMODEL, lane, v); store_row_bf16(XB + (size_t)n * DMODEL, lane, v);
#pragma unroll
        for (int i = 0; i < 16; ++i) lo_[i] = v[i] - __uint_as_float(f2bf(v[i]) << 16);
        if (USE_XLO) store_row_fp8(XLO + (size_t)n * DMODEL, lane, lo_, XLO_SCALE);
        store_row_fp8((unsigned char*)(C.ws + WS_XQ) + (size_t)n * DMODEL, lane, v, XQ_SCALE);
        gates_row(v, wgl, C.in[I_GATEB], G + (size_t)n * 8, lane); }
    __syncthreads();
}

__device__ __forceinline__ void conv_silu8(const bf16* proj, int n, int t, int col, const float* cw, const float* cb, float scale, float* y) {
    const f32x4 b0 = *(const f32x4*)cb, b1 = *(const f32x4*)(cb + 4);
    y[0] = b0.x; y[1] = b0.y; y[2] = b0.z; y[3] = b0.w; y[4] = b1.x; y[5] = b1.y; y[6] = b1.z; y[7] = b1.w;
#pragma unroll
    for (int j = 0; j < 4; ++j) { const int tt = t - 3 + j;
        if (tt >= 0) { const v4u w = *(const v4u*)(proj + (size_t)(n - 3 + j) * NPROJ + col); float x[8]; unpack8(w, x);
            const f32x4 c0 = *(const f32x4*)(cw + j * 512), c1 = *(const f32x4*)(cw + j * 512 + 4);
            y[0] += c0.x * x[0]; y[1] += c0.y * x[1]; y[2] += c0.z * x[2]; y[3] += c0.w * x[3]; y[4] += c1.x * x[4]; y[5] += c1.y * x[5]; y[6] += c1.z * x[6]; y[7] += c1.w * x[7]; } }
#pragma unroll
    for (int i = 0; i < 8; ++i) y[i] = y[i] * sigmoid_f(y[i]) * scale;
}
constexpr int KP = 68;

__device__ __forceinline__ void p_mlstm_states(const Ctx& C, int l) {
    const bf16* proj = (const bf16*)(C.ws + WS_PROJ); const float* G = (const float*)(C.ws + WS_G);
    float* CST = (float*)(C.ws + WS_CST); float* NST = (float*)(C.ws + WS_NST); float* MLOC = (float*)(C.ws + WS_MISC); float* GCH = MLOC + 2048;
    const float* cw = C.in[I_CONVW] + (size_t)l * 4 * 512; const float* cb = C.in[I_CONVB] + (size_t)l * 512;
    LAS float* kf = (LAS float*)(C.lds + RING_OFF);
    LAS float* vf = kf + 64 * 64;
    LAS float* ev = vf + 64 * 128;
    const int tid = ltid(), lane = tid & 63;
    for (int u = C.vcu; u < NBH * NCH; u += C.G) {
        const int bh = u / NCH, c = u % NCH, b = bh >> 2, h = bh & 3; const int n0 = b * SEQ + c * CHUNK;
        { const int s = tid >> 3, cg = tid & 7; float y[8]; conv_silu8(proj, n0 + s, c * CHUNK + s, 1536 + 256 + h * 64 + cg * 8, cw + 256 + h * 64 + cg * 8, cb + 256 + h * 64 + cg * 8, 1.0f, y);
#pragma unroll
            for (int i = 0; i < 8; ++i) kf[s * 64 + cg * 8 + i] = y[i];
            const bf16* vp = proj + (size_t)(n0 + s) * NPROJ + 2048 + h * 128 + cg * 16; float x[16]; unpack8(*(const v4u*)vp, x); unpack8(*(const v4u*)(vp + 8), x + 8);
#pragma unroll
            for (int i = 0; i < 16; ++i) vf[s * 128 + cg * 16 + i] = x[i]; }
        if (C.wave == 0) { const float ig = G[(size_t)(n0 + lane) * 8 + h], fg = G[(size_t)(n0 + lane) * 8 + 4 + h];
            float bc = fminf(fg, 0.f) - log1pf(expf(-fabsf(fg)));
#pragma unroll
            for (int o = 1; o < 64; o <<= 1) { const float t = __shfl_up(bc, o); if (lane >= o) bc += t; }
            const float g = __shfl(bc, 63); const float w = g - bc + ig; const float m = wave_max(w);
            ev[lane] = __expf(w - m); if (lane == 0) { MLOC[u] = m; GCH[u] = g; } }
        __syncthreads();
        { const int v = tid & 127, kg = tid >> 7; float acc[16];
#pragma unroll
            for (int i = 0; i < 16; ++i) acc[i] = 0.f;
            for (int s = 0; s < 64; ++s) { const float a = ev[s] * vf[s * 128 + v];
#pragma unroll
                for (int i4 = 0; i4 < 4; ++i4) { const f32x4 k4 = *(const LAS f32x4*)(kf + s * 64 + kg * 16 + i4 * 4); acc[i4 * 4 + 0] += a * k4.x; acc[i4 * 4 + 1] += a * k4.y; acc[i4 * 4 + 2] += a * k4.z; acc[i4 * 4 + 3] += a * k4.w; } }
            float* dst = CST + (size_t)u * 8192 + v;
#pragma unroll
            for (int i = 0; i < 16; ++i) dst[(kg * 16 + i) * 128] = acc[i]; }
        if (tid < 64) { float a = 0.f; for (int s = 0; s < 64; ++s) a += ev[s] * kf[s * 64 + tid]; NST[(size_t)u * 64 + tid] = a; }
        __syncthreads();
    }
}

__device__ __forceinline__ void p_mlstm_scan(const Ctx& C) {
    v2u* CST = (v2u*)(C.ws + WS_CST); f32x4* NST = (f32x4*)(C.ws + WS_NST); const float* MLOC = (const float*)(C.ws + WS_MISC); const float* GCH = MLOC + 2048; float* MPREV = (float*)(C.ws + WS_MISC) + 4096;
    const int nthr = C.G * NTHREADS, gid = C.vcu * NTHREADS + ltid();
    for (int it = gid; it < NBH * 2064; it += nthr) {
        const int bh = it / 2064, r = it % 2064;
        if (r < 2048) {
            v2u* p = CST + (size_t)bh * NCH * 2048 + r; float carry[4] = {0.f, 0.f, 0.f, 0.f}; float m = -INFINITY;
            for (int c0 = 0; c0 < NCH; c0 += 16) {
                v2u loc[16]; float gg[16], ml[16];
#pragma unroll
                for (int j = 0; j < 16; ++j) { loc[j] = p[(size_t)(c0 + j) * 2048]; gg[j] = GCH[bh * NCH + c0 + j]; ml[j] = MLOC[bh * NCH + c0 + j]; }
#pragma unroll
                for (int j = 0; j < 16; ++j) { p[(size_t)(c0 + j) * 2048] = (v2u){pk2(carry[0], carry[1]), pk2(carry[2], carry[3])}; if (r == 0) MPREV[bh * NCH + c0 + j] = m;
                    const float mn = fmaxf(gg[j] + m, ml[j]); const float a = __expf(gg[j] + m - mn), bb = __expf(ml[j] - mn);
                    carry[0] = carry[0] * a + bflo(loc[j].x) * bb; carry[1] = carry[1] * a + bfhi(loc[j].x) * bb; carry[2] = carry[2] * a + bflo(loc[j].y) * bb; carry[3] = carry[3] * a + bfhi(loc[j].y) * bb;
                    m = mn; }
            }
        } else {
            f32x4* p = NST + (size_t)bh * NCH * 16 + (r - 2048); f32x4 carry = (f32x4){0.f, 0.f, 0.f, 0.f}; float m = -INFINITY;
            for (int c0 = 0; c0 < NCH; c0 += 8) {
                f32x4 loc[8]; float gg[8], ml[8];
#pragma unroll
                for (int j = 0; j < 8; ++j) { loc[j] = p[(size_t)(c0 + j) * 16]; gg[j] = GCH[bh * NCH + c0 + j]; ml[j] = MLOC[bh * NCH + c0 + j]; }
#pragma unroll
                for (int j = 0; j < 8; ++j) { p[(size_t)(c0 + j) * 16] = carry;
                    const float mn = fmaxf(gg[j] + m, ml[j]); const float a = __expf(gg[j] + m - mn), bb = __expf(ml[j] - mn);
                    carry = carry * a + loc[j] * bb; m = mn; }
            }
        }
    }
}

__device__ __forceinline__ void p_mlstm_out(const Ctx& C, int l) {
    const bf16* proj = (const bf16*)(C.ws + WS_PROJ); const float* G = (const float*)(C.ws + WS_G);
    const float* CST = (const float*)(C.ws + WS_CST); const float* NST = (const float*)(C.ws + WS_NST); const float* MPREV = (const float*)(C.ws + WS_MISC) + 4096;
    bf16* MIXIN = (bf16*)(C.ws + WS_MIXIN);
    const float* cw = C.in[I_CONVW] + (size_t)l * 4 * 512; const float* cb = C.in[I_CONVB] + (size_t)l * 512;
    LAS float* qf = (LAS float*)(C.lds + RING_OFF);
    LAS float* kf = qf + 64 * KP;
    LAS float* Sm = kf + 64 * KP;
    LAS float* vf = Sm + 64 * KP;
    LAS float* Ct = vf + 64 * 128;
    LAS float* sv = Ct + 64 * 128;
    static_assert((3 * 64 * KP + 2 * 64 * 128 + 6 * 64) * 4 <= RING_BYTES, "mLSTM LDS");
    const int tid = ltid(), lane = tid & 63;
    for (int u = C.vcu; u < NBH * NCH; u += C.G) {
        const int bh = u / NCH, c = u % NCH, b = bh >> 2, h = bh & 3; const int n0 = b * SEQ + c * CHUNK;
        { const int s = tid >> 3, cg = tid & 7; float y[8];
            conv_silu8(proj, n0 + s, c * CHUNK + s, 1536 + h * 64 + cg * 8, cw + h * 64 + cg * 8, cb + h * 64 + cg * 8, 0.125f, y);
#pragma unroll
            for (int i = 0; i < 8; ++i) qf[s * KP + cg * 8 + i] = y[i];
            conv_silu8(proj, n0 + s, c * CHUNK + s, 1536 + 256 + h * 64 + cg * 8, cw + 256 + h * 64 + cg * 8, cb + 256 + h * 64 + cg * 8, 1.0f, y);
#pragma unroll
            for (int i = 0; i < 8; ++i) kf[s * KP + cg * 8 + i] = y[i];
            const bf16* vp = proj + (size_t)(n0 + s) * NPROJ + 2048 + h * 128 + cg * 16; float x[16]; unpack8(*(const v4u*)vp, x); unpack8(*(const v4u*)(vp + 8), x + 8);
#pragma unroll
            for (int i = 0; i < 16; ++i) vf[s * 128 + cg * 16 + i] = x[i];
            const f32x4* cp = (const f32x4*)(CST + (size_t)u * 8192);
#pragma unroll
            for (int i = 0; i < 4; ++i) *(LAS f32x4*)(Ct + (tid + NTHREADS * i) * 4) = cp[tid + NTHREADS * i]; }
        if (C.wave == 0) { const float ig = G[(size_t)(n0 + lane) * 8 + h], fg = G[(size_t)(n0 + lane) * 8 + 4 + h]; const float mp = MPREV[u];
            float bc = fminf(fg, 0.f) - log1pf(expf(-fabsf(fg)));
#pragma unroll
            for (int o = 1; o < 64; o <<= 1) { const float t = __shfl_up(bc, o); if (lane >= o) bc += t; }
            const float a = ig - bc; float pm = a;
#pragma unroll
            for (int o = 1; o < 64; o <<= 1) { const float t = __shfl_up(pm, o); if (lane >= o) pm = fmaxf(pm, t); }
            const float mt = bc + fmaxf(mp, pm);
            sv[lane] = bc; sv[64 + lane] = a; sv[128 + lane] = mt; sv[192 + lane] = __expf(bc + mp - mt); sv[320 + lane] = NST[(size_t)u * 64 + lane]; }
        __syncthreads();
        {
            const int t = tid >> 3, sg = tid & 7; float qr[64];
#pragma unroll
            for (int i = 0; i < 16; ++i) { const f32x4 q4 = *(const LAS f32x4*)(qf + t * KP + 4 * i); qr[4 * i] = q4.x; qr[4 * i + 1] = q4.y; qr[4 * i + 2] = q4.z; qr[4 * i + 3] = q4.w; }
            const float bt = sv[t] - sv[128 + t]; float dsum = 0.f;
#pragma unroll 2
            for (int j = 0; j < 8; ++j) { const int s = sg + 8 * j; float d = 0.f;
#pragma unroll
                for (int i = 0; i < 16; ++i) { const f32x4 k4 = *(const LAS f32x4*)(kf + s * KP + 4 * i); d += qr[4 * i] * k4.x + qr[4 * i + 1] * k4.y + qr[4 * i + 2] * k4.z + qr[4 * i + 3] * k4.w; }
                const float sc = (s <= t) ? d * __expf(sv[64 + s] + bt) : 0.f; Sm[t * KP + s] = sc; dsum += sc; }
            float nq = 0.f;
#pragma unroll
            for (int i = 0; i < 8; ++i) nq += qf[t * KP + sg * 8 + i] * sv[320 + sg * 8 + i];
            dsum += sv[192 + t] * nq;
            dsum += __shfl_xor(dsum, 1); dsum += __shfl_xor(dsum, 2); dsum += __shfl_xor(dsum, 4);
            if (sg == 0) sv[256 + t] = 1.0f / fmaxf(fabsf(dsum), __expf(-sv[128 + t])); }
        __syncthreads();
        {
            const int t = tid >> 3, vg = tid & 7; float acc[16];
#pragma unroll
            for (int i = 0; i < 16; ++i) acc[i] = 0.f;
            const float iw = sv[192 + t];
            for (int k = 0; k < 64; ++k) { const float a = qf[t * KP + k] * iw;
#pragma unroll
                for (int i4 = 0; i4 < 4; ++i4) { const f32x4 c4 = *(const LAS f32x4*)(Ct + k * 128 + vg * 16 + i4 * 4); acc[i4 * 4] += a * c4.x; acc[i4 * 4 + 1] += a * c4.y; acc[i4 * 4 + 2] += a * c4.z; acc[i4 * 4 + 3] += a * c4.w; } }
            for (int s = 0; s < 64; ++s) { const float a = Sm[t * KP + s];
#pragma unroll
                for (int i4 = 0; i4 < 4; ++i4) { const f32x4 v4 = *(const LAS f32x4*)(vf + s * 128 + vg * 16 + i4 * 4); acc[i4 * 4] += a * v4.x; acc[i4 * 4 + 1] += a * v4.y; acc[i4 * 4 + 2] += a * v4.z; acc[i4 * 4 + 3] += a * v4.w; } }
            const float dn = sv[256 + t];
            const bf16* op = proj + (size_t)(n0 + t) * NPROJ + 2560 + h * 128 + vg * 16; float o[16]; unpack8(*(const v4u*)op, o); unpack8(*(const v4u*)(op + 8), o + 8);
#pragma unroll
            for (int i = 0; i < 16; ++i) o[i] = acc[i] * dn * sigmoid_f(o[i]);
            bf16* dst = MIXIN + (size_t)(n0 + t) * DMODEL + 512 + h * 128 + vg * 16; *(v4u*)dst = pack8(o); *(v4u*)(dst + 8) = pack8(o + 8); }
        __syncthreads();
    }
}

__device__ __forceinline__ void p_da_combine(const Ctx& C, int l, float lam_init) {
    const bf16* ATTO = (const bf16*)(C.ws + WS_ATTO); bf16* MIXIN = (bf16*)(C.ws + WS_MIXIN);
    const int lane = ltid() & 63, gw = C.vcu * NWAVES + C.wave, NGW = C.G * NWAVES;
    const float s1 = wave_sum(C.in[I_LQ1][l * 64 + lane] * C.in[I_LK1][l * 64 + lane]), s2 = wave_sum(C.in[I_LQ2][l * 64 + lane] * C.in[I_LK2][l * 64 + lane]);
    const float lam = expf(s1) - expf(s2) + lam_init, osc = 1.0f - lam_init;
    const int h = lane >> 4, e8 = (lane & 15) * 8;
    float g[8]; { const f32x4 a = *(const f32x4*)(C.in[I_NG] + l * 128 + e8), b2 = *(const f32x4*)(C.in[I_NG] + l * 128 + e8 + 4); g[0] = a.x; g[1] = a.y; g[2] = a.z; g[3] = a.w; g[4] = b2.x; g[5] = b2.y; g[6] = b2.z; g[7] = b2.w; }
    for (int n = gw; n < NTOK; n += NGW) {
        float o0[8], o1[8]; unpack8(*(const v4u*)(ATTO + (size_t)n * DMODEL + h * 256 + e8), o0); unpack8(*(const v4u*)(ATTO + (size_t)n * DMODEL + h * 256 + 128 + e8), o1);
        float ss = 0.f;
#pragma unroll
        for (int i = 0; i < 8; ++i) { o0[i] -= lam * o1[i]; ss += o0[i] * o0[i]; }
        ss += __shfl_xor(ss, 1); ss += __shfl_xor(ss, 2); ss += __shfl_xor(ss, 4); ss += __shfl_xor(ss, 8);
        const float r = 1.0f / sqrtf(ss * (1.0f / 128.0f) + RMS_EPS) * osc;
#pragma unroll
        for (int i = 0; i < 8; ++i) o0[i] = o0[i] * r * g[i];
        *(v4u*)(MIXIN + (size_t)n * DMODEL + h * 128 + e8) = pack8(o0);
    }
}
typedef float f32x16 __attribute__((ext_vector_type(16)));
constexpr int TP = 72;
#define MFMA32(a, b, c) __builtin_amdgcn_mfma_f32_32x32x16_bf16((a), (b), (c), 0, 0, 0)
__device__ __forceinline__ bf16x8 frag_ld(const LAS bf16* tile, int row, int step, int h) { return *(const LAS bf16x8*)(tile + row * TP + step * 16 + 8 * h); }
__device__ __forceinline__ void tr_store16(LAS bf16* tile, int c0, int s, const v4u a, const v4u b) {
    const unsigned w[8] = {a.x, a.y, a.z, a.w, b.x, b.y, b.z, b.w};
#pragma unroll
    for (int i = 0; i < 8; ++i) { tile[(c0 + 2 * i) * TP + s] = (bf16)(w[i] & 0xffffu); tile[(c0 + 2 * i + 1) * TP + s] = (bf16)(w[i] >> 16); }
}

__device__ __forceinline__ void conv_fetch(const bf16* proj, int n, int t, int col, v4u* raw) {
#pragma unroll
    for (int j = 0; j < 4; ++j) { const int tt = t - 3 + j; raw[j] = (tt >= 0) ? *(const v4u*)(proj + (size_t)(n - 3 + j) * NPROJ + col) : (v4u){0u, 0u, 0u, 0u}; }
}
__device__ __forceinline__ void conv_stage(LAS float* cwl, const float* cw, const float* cb, int ch0, int tid) {
    if (tid < 320) cwl[tid] = (tid < 256) ? cw[(tid >> 6) * 512 + ch0 + (tid & 63)] : cb[ch0 + (tid - 256)];
}
__device__ __forceinline__ void conv_apply_l(const v4u* raw, const LAS float* cwl, int c0, float scale, float* y) {
    const f32x4 b0 = *(const LAS f32x4*)(cwl + 256 + c0), b1 = *(const LAS f32x4*)(cwl + 256 + c0 + 4);
    y[0] = b0.x; y[1] = b0.y; y[2] = b0.z; y[3] = b0.w; y[4] = b1.x; y[5] = b1.y; y[6] = b1.z; y[7] = b1.w;
#pragma unroll
    for (int j = 0; j < 4; ++j) { float x[8]; unpack8(raw[j], x);
        const f32x4 c0_ = *(const LAS f32x4*)(cwl + j * 64 + c0), c1_ = *(const LAS f32x4*)(cwl + j * 64 + c0 + 4);
        y[0] += c0_.x * x[0]; y[1] += c0_.y * x[1]; y[2] += c0_.z * x[2]; y[3] += c0_.w * x[3]; y[4] += c1_.x * x[4]; y[5] += c1_.y * x[5]; y[6] += c1_.z * x[6]; y[7] += c1_.w * x[7]; }
#pragma unroll
    for (int i = 0; i < 8; ++i) y[i] = y[i] * sigmoid_f(y[i]) * scale;
}
__device__ __forceinline__ void conv_apply(const v4u* raw, const float* cw, const float* cb, float scale, float* y) {
    const f32x4 b0 = *(const f32x4*)cb, b1 = *(const f32x4*)(cb + 4);
    y[0] = b0.x; y[1] = b0.y; y[2] = b0.z; y[3] = b0.w; y[4] = b1.x; y[5] = b1.y; y[6] = b1.z; y[7] = b1.w;
#pragma unroll
    for (int j = 0; j < 4; ++j) { float x[8]; unpack8(raw[j], x);
        const f32x4 c0 = *(const f32x4*)(cw + j * 512), c1 = *(const f32x4*)(cw + j * 512 + 4);
        y[0] += c0.x * x[0]; y[1] += c0.y * x[1]; y[2] += c0.z * x[2]; y[3] += c0.w * x[3]; y[4] += c1.x * x[4]; y[5] += c1.y * x[5]; y[6] += c1.z * x[6]; y[7] += c1.w * x[7]; }
#pragma unroll
    for (int i = 0; i < 8; ++i) y[i] = y[i] * sigmoid_f(y[i]) * scale;
}

__device__ __forceinline__ void p_mlstm_states_mfma(const Ctx& C, int l) {
    const bf16* proj = (const bf16*)(C.ws + WS_PROJ); const float* G = (const float*)(C.ws + WS_G);
    bf16* CST = (bf16*)(C.ws + WS_CST); float* NST = (float*)(C.ws + WS_NST); float* MLOC = (float*)(C.ws + WS_MISC); float* GCH = MLOC + 2048;
    const float* cw = C.in[I_CONVW] + (size_t)l * 4 * 512; const float* cb = C.in[I_CONVB] + (size_t)l * 512;
    LAS bf16* KeT = (LAS bf16*)(C.lds + RING_OFF);
    LAS bf16* Vt = KeT + 64 * TP;
    LAS float* ev = (LAS float*)(Vt + 128 * TP);
    const int tid = ltid(), lane = tid & 63, r = lane & 31, h = lane >> 5, s = tid & 63, cg = tid >> 6;
    v4u rk[4], rv[2]; float rig = 0.f, rfg = 0.f;
#define ST_FETCH(u_) do { const int bh_ = (u_) / NCH, c_ = (u_) % NCH, n0_ = (bh_ >> 2) * SEQ + c_ * CHUNK, hd_ = bh_ & 3; \
        conv_fetch(proj, n0_ + s, c_ * CHUNK + s, 1536 + 256 + hd_ * 64 + cg * 8, rk); const bf16* vp_ = proj + (size_t)(n0_ + s) * NPROJ + 2048 + hd_ * 128 + cg * 16; rv[0] = *(const v4u*)vp_; rv[1] = *(const v4u*)(vp_ + 8); \
        if (C.wave == 0) { rig = G[(size_t)(n0_ + lane) * 8 + hd_]; rfg = G[(size_t)(n0_ + lane) * 8 + 4 + hd_]; } } while (0)
    if (C.vcu < NBH * NCH) ST_FETCH(C.vcu);
    for (int u = C.vcu; u < NBH * NCH; u += C.G) {
        const int bh = u / NCH, hd = bh & 3;
        if (C.wave == 0) { const float ig = rig, fg = rfg;
            float bc = fminf(fg, 0.f) - log1pf(expf(-fabsf(fg)));
#pragma unroll
            for (int o = 1; o < 64; o <<= 1) { const float t = __shfl_up(bc, o); if (lane >= o) bc += t; }
            const float g = __shfl(bc, 63); const float w = g - bc + ig; const float m = wave_max(w);
            ev[lane] = __expf(w - m); if (lane == 0) { MLOC[u] = m; GCH[u] = g; } }
        __syncthreads();
        { float y[8]; conv_apply(rk, cw + 256 + hd * 64 + cg * 8, cb + 256 + hd * 64 + cg * 8, 1.0f, y);
            const float e = ev[s];
#pragma unroll
            for (int i = 0; i < 8; ++i) KeT[(cg * 8 + i) * TP + s] = (bf16)f2bf(y[i] * e);
            tr_store16(Vt, cg * 16, s, rv[0], rv[1]); }
        if (u + C.G < NBH * NCH) ST_FETCH(u + C.G);
        __syncthreads();
        { const int kb = C.wave & 1, vb = C.wave >> 1; f32x16 acc;
#pragma unroll
            for (int i = 0; i < 16; ++i) acc[i] = 0.f;
#pragma unroll
            for (int st = 0; st < 4; ++st) acc = MFMA32(frag_ld(KeT, kb * 32 + r, st, h), frag_ld(Vt, vb * 32 + r, st, h), acc);
            bf16* dst = CST + (size_t)u * 8192 + (size_t)(vb * 32 + r) * 64 + kb * 32 + 4 * h;
#pragma unroll
            for (int g = 0; g < 4; ++g) *(v2u*)(dst + 8 * g) = (v2u){pk2(acc[4 * g], acc[4 * g + 1]), pk2(acc[4 * g + 2], acc[4 * g + 3])}; }
        if (tid < 64) { float a = 0.f;
#pragma unroll 8
            for (int s_ = 0; s_ < 64; s_ += 2) { const unsigned w = *(const LAS unsigned*)(KeT + tid * TP + s_); a += bflo(w) + bfhi(w); }
            NST[(size_t)u * 64 + tid] = a; }
    }
#undef ST_FETCH
    __syncthreads();
}

__device__ __forceinline__ void p_mlstm_out_mfma(const Ctx& C, int l) {
    const bf16* proj = (const bf16*)(C.ws + WS_PROJ); const float* G = (const float*)(C.ws + WS_G);
    const bf16* CST = (const bf16*)(C.ws + WS_CST); const float* NST = (const float*)(C.ws + WS_NST); const float* MPREV = (const float*)(C.ws + WS_MISC) + 4096;
    bf16* MIXIN = (bf16*)(C.ws + WS_MIXIN);
    const float* cw = C.in[I_CONVW] + (size_t)l * 4 * 512; const float* cb = C.in[I_CONVB] + (size_t)l * 512;
    LAS bf16* Qt = (LAS bf16*)(C.lds + RING_OFF);
    LAS bf16* Kt = Qt + 64 * TP;
    LAS bf16* St = Kt + 64 * TP;
    LAS bf16* Vt = St + 64 * TP;
    LAS bf16* Ct = Vt + 128 * TP;
    LAS float* sv = (LAS float*)(Ct + 128 * TP);
    const int tid = ltid(), lane = tid & 63, r = lane & 31, h = lane >> 5;
    const int s = tid >> 3, cg = tid & 7, s2 = tid & 63, vg = tid >> 6, cv = tid >> 2, ck0 = (tid & 3) * 16, ot = (C.wave & 1) * 32 + r, ovb = C.wave >> 1;
    v4u rq[4], rk[4], rv[2], rc[2]; v2u ro[4], roc[4]; float rig = 0.f, rfg = 0.f, rmp = 0.f, rnp = 0.f;
#define OUT_FETCH(u_) do { const int bh_ = (u_) / NCH, c_ = (u_) % NCH, n0_ = (bh_ >> 2) * SEQ + c_ * CHUNK, hd_ = bh_ & 3; \
        conv_fetch(proj, n0_ + s, c_ * CHUNK + s, 1536 + hd_ * 64 + cg * 8, rq); conv_fetch(proj, n0_ + s, c_ * CHUNK + s, 1536 + 256 + hd_ * 64 + cg * 8, rk); \
        const bf16* vp_ = proj + (size_t)(n0_ + s2) * NPROJ + 2048 + hd_ * 128 + vg * 16; rv[0] = *(const v4u*)vp_; rv[1] = *(const v4u*)(vp_ + 8); \
        const v4u* cp_ = (const v4u*)(CST + (size_t)(u_) * 8192 + cv * 64 + ck0); rc[0] = cp_[0]; rc[1] = cp_[1]; \
        const bf16* op_ = proj + (size_t)(n0_ + ot) * NPROJ + 2560 + hd_ * 128 + ovb * 32 + 4 * h; _Pragma("unroll") for (int g_ = 0; g_ < 4; ++g_) ro[g_] = *(const v2u*)(op_ + 8 * g_); \
        if (C.wave == 0) { rig = G[(size_t)(n0_ + lane) * 8 + hd_]; rfg = G[(size_t)(n0_ + lane) * 8 + 4 + hd_]; rmp = MPREV[(u_)]; rnp = NST[(size_t)(u_) * 64 + lane]; } } while (0)
    if (C.vcu < NBH * NCH) OUT_FETCH(C.vcu);
    for (int u = C.vcu; u < NBH * NCH; u += C.G) {
        const int bh = u / NCH, c = u % NCH, b = bh >> 2, hd = bh & 3; const int n0 = b * SEQ + c * CHUNK;
        __syncthreads();
        { float y[8];
            conv_apply(rq, cw + hd * 64 + cg * 8, cb + hd * 64 + cg * 8, 0.125f, y); *(LAS v4u*)(Qt + s * TP + cg * 8) = pack8(y);
            conv_apply(rk, cw + 256 + hd * 64 + cg * 8, cb + 256 + hd * 64 + cg * 8, 1.0f, y); *(LAS v4u*)(Kt + s * TP + cg * 8) = pack8(y);
            tr_store16(Vt, vg * 16, s2, rv[0], rv[1]);
            *(LAS v4u*)(Ct + cv * TP + ck0) = rc[0]; *(LAS v4u*)(Ct + cv * TP + ck0 + 8) = rc[1];
#pragma unroll
            for (int g = 0; g < 4; ++g) roc[g] = ro[g]; }
        if (C.wave == 0) { const float ig = rig, fg = rfg; const float mp = rmp;
            float bc = fminf(fg, 0.f) - log1pf(expf(-fabsf(fg)));
#pragma unroll
            for (int o = 1; o < 64; o <<= 1) { const float t = __shfl_up(bc, o); if (lane >= o) bc += t; }
            const float a = ig - bc; float pm = a;
#pragma unroll
            for (int o = 1; o < 64; o <<= 1) { const float t = __shfl_up(pm, o); if (lane >= o) pm = fmaxf(pm, t); }
            const float mt = bc + fmaxf(mp, pm);
            sv[lane] = bc; sv[64 + lane] = a; sv[128 + lane] = mt; sv[192 + lane] = __expf(bc + mp - mt); sv[256 + lane] = rnp; }
        if (u + C.G < NBH * NCH) OUT_FETCH(u + C.G);
        __syncthreads();
        if (C.wave < 4) {
            const int sb = C.wave & 1, tb = C.wave >> 1; f32x16 x;
#pragma unroll
            for (int i = 0; i < 16; ++i) x[i] = 0.f;
#pragma unroll
            for (int st = 0; st < 4; ++st) x = MFMA32(frag_ld(Kt, sb * 32 + r, st, h), frag_ld(Qt, tb * 32 + r, st, h), x);
            const int t = tb * 32 + r; const float bt = sv[t] - sv[128 + t]; float dsum = 0.f;
#pragma unroll
            for (int g = 0; g < 4; ++g) { const int s0 = sb * 32 + 8 * g + 4 * h; float w[4];
#pragma unroll
                for (int i = 0; i < 4; ++i) { const int s = s0 + i; w[i] = (s <= t) ? x[4 * g + i] * __expf(sv[64 + s] + bt) : 0.f; }
                const unsigned p0 = pk2(w[0], w[1]), p1 = pk2(w[2], w[3]); dsum += (bflo(p0) + bfhi(p0)) + (bflo(p1) + bfhi(p1));
                *(LAS v2u*)(St + t * TP + s0) = (v2u){p0, p1}; }
            sv[384 + (sb * 2 + h) * 64 + t] = dsum;
        } else if (tid < 320) {
            const int t = tid - 256; float a = 0.f;
#pragma unroll 8
            for (int k = 0; k < 64; k += 2) { const unsigned w = *(const LAS unsigned*)(Qt + t * TP + k); a += bflo(w) * sv[256 + k] + bfhi(w) * sv[256 + k + 1]; }
            sv[320 + t] = a; }
        __syncthreads();
        {
            const int vb = C.wave >> 1, tb = C.wave & 1; f32x16 acc;
#pragma unroll
            for (int i = 0; i < 16; ++i) acc[i] = 0.f;
#pragma unroll
            for (int st = 0; st < 4; ++st) acc = MFMA32(frag_ld(Ct, vb * 32 + r, st, h), frag_ld(Qt, tb * 32 + r, st, h), acc);
            const int t = tb * 32 + r; const float iw = sv[192 + t];
#pragma unroll
            for (int i = 0; i < 16; ++i) acc[i] *= iw;
#pragma unroll
            for (int st = 0; st < 4; ++st) acc = MFMA32(frag_ld(Vt, vb * 32 + r, st, h), frag_ld(St, tb * 32 + r, st, h), acc);
            const float den = ((sv[384 + t] + sv[384 + 64 + t]) + (sv[384 + 128 + t] + sv[384 + 192 + t])) + iw * sv[320 + t];
            const float dn = 1.0f / fmaxf(fabsf(den), __expf(-sv[128 + t]));
            bf16* dst = MIXIN + (size_t)(n0 + t) * DMODEL + 512 + hd * 128 + vb * 32 + 4 * h;
#pragma unroll
            for (int g = 0; g < 4; ++g) { const v2u ow = roc[g]; const float o0 = bflo(ow.x), o1 = bfhi(ow.x), o2 = bflo(ow.y), o3 = bfhi(ow.y);
                *(v2u*)(dst + 8 * g) = (v2u){pk2(acc[4 * g] * dn * sigmoid_f(o0), acc[4 * g + 1] * dn * sigmoid_f(o1)), pk2(acc[4 * g + 2] * dn * sigmoid_f(o2), acc[4 * g + 3] * dn * sigmoid_f(o3))}; } }
    }
#undef OUT_FETCH
    __syncthreads();
}
constexpr size_t WS_TOTC = WS_CST + 32 * MiB;
constexpr size_t WS_TOTN = WS_NST + 512 * 1024;
constexpr int MS_DCUM = 6144, MS_TOTM = 8192, MS_TOTG = 8448;

__device__ __forceinline__ void p_mlstm_states_seq(const Ctx& C, int l) {
    const bf16* proj = (const bf16*)(C.ws + WS_PROJ); const float* G = (const float*)(C.ws + WS_G);
    bf16* CST = (bf16*)(C.ws + WS_CST); float* NST = (float*)(C.ws + WS_NST); float* MS = (float*)(C.ws + WS_MISC); float* MPREV = MS + 4096;
    float* TOTC = (float*)(C.ws + WS_TOTC); float* TOTN = (float*)(C.ws + WS_TOTN);
    const float* cw = C.in[I_CONVW] + (size_t)l * 4 * 512; const float* cb = C.in[I_CONVB] + (size_t)l * 512;
    LAS bf16* KeT = (LAS bf16*)(C.lds + RING_OFF);
    LAS bf16* Vt = KeT + 64 * TP;
    LAS float* ev = (LAS float*)(Vt + 128 * TP);
    LAS float* cwl = ev + 80;
    LAS bf16* Cs = (LAS bf16*)(cwl + 320);
#define CST_FLUSH(uu_) do { const int row_ = tid >> 2, pc_ = (tid & 3) * 16; const LAS v4u* sp_ = (const LAS v4u*)(Cs + row_ * TP + pc_); const v4u a_ = sp_[0], b_ = sp_[1]; \
        v4u* gp_ = (v4u*)(CST + (size_t)(uu_) * 8192 + row_ * 64 + pc_); gp_[0] = a_; gp_[1] = b_; } while (0)
    const int tid = ltid(), lane = tid & 63, r = lane & 31, h = lane >> 5, s = tid & 63, cg = tid >> 6;
    v4u rkA[4], rvA[2], rkB[4], rvB[2]; float rigA = 0.f, rfgA = 0.f, rigB = 0.f, rfgB = 0.f;
#define ST_FETCH(u_) do { const int bh_ = (u_) / NCH, c_ = (u_) % NCH, n0_ = (bh_ >> 2) * SEQ + c_ * CHUNK, hd_ = bh_ & 3; \
        conv_fetch(proj, n0_ + s, c_ * CHUNK + s, 1536 + 256 + hd_ * 64 + cg * 8, rk); const bf16* vp_ = proj + (size_t)(n0_ + s) * NPROJ + 2048 + hd_ * 128 + cg * 16; rv[0] = *(const v4u*)vp_; rv[1] = *(const v4u*)(vp_ + 8); \
        if (C.wave == 0) { rig = G[(size_t)(n0_ + lane) * 8 + hd_]; rfg = G[(size_t)(n0_ + lane) * 8 + 4 + hd_]; } } while (0)
    const bool itw = MK_SIDEJOB && C.wave >= 1 && C.wave <= 6; const int itot = TRQ_LAYERS * trq_per(C);
    LAS float* iscr = (LAS float*)(C.lds + (C.wave <= 5 ? RING_OFF + 32768 + (C.wave - 1) * 16896 : LDSX_OFF));
    float ira[64]; int ir = -1;
#define SIDE_OUT() do { if (ir >= 0) { const TrItem it_ = tr_decode(C, ir); tr_put(ira, iscr, lane); LDS_WAIT(); asm volatile("" ::: "memory"); tr_store(it_, iscr, lane); LDS_WAIT(); asm volatile("" ::: "memory"); ir = -1; } } while (0)
#define SIDE_STEP() do { if (itw) { const int q_ = trq_grab(C, lane); ir = (q_ < itot) ? trq_item(C, q_) : -1; if (ir >= 0) { const TrItem it_ = tr_decode(C, ir); tr_fetch(it_, ira, lane); } } } while (0)
#define SIDE_FLUSH() do { if (itw) SIDE_OUT(); } while (0)
    for (int vc = C.vcu; vc < 256; vc += C.G) {
        const int bh = vc >> 3, hd = bh & 3, u0 = bh * NCH + (vc & 7) * 8;
        f32x16 crun; float nrun = 0.f, mrun = -INFINITY, drun = 0.f;
#pragma unroll
        for (int i = 0; i < 16; ++i) crun[i] = 0.f;
        conv_stage(cwl, cw, cb, 256 + hd * 64, tid);
        { v4u (&rk)[4] = rkA; v4u (&rv)[2] = rvA; float& rig = rigA; float& rfg = rfgA; ST_FETCH(u0); }
        { v4u (&rk)[4] = rkB; v4u (&rv)[2] = rvB; float& rig = rigB; float& rfg = rfgB; ST_FETCH(u0 + 1); }
        auto body = [&](const int j, v4u (&rk)[4], v4u (&rv)[2], float& rig, float& rfg) __attribute__((always_inline)) {
            const int u = u0 + j;
            if (C.wave == 0) { const float ig = rig, fg = rfg;
                float bc = fminf(fg, 0.f) - log1pf(expf(-fabsf(fg)));
#pragma unroll
                for (int o = 1; o < 64; o <<= 1) { const float t = __shfl_up(bc, o); if (lane >= o) bc += t; }
                const float g = __shfl(bc, 63); const float w = g - bc + ig; const float m = wave_max(w);
                ev[lane] = __expf(w - m); if (lane == 0) { ev[64] = m; ev[65] = g; } }
            __syncthreads();
            if (j > 0) CST_FLUSH(u - 1);
            { float y[8]; conv_apply_l(rk, cwl, cg * 8, 1.0f, y);
                const float e = ev[s];
#pragma unroll
                for (int i = 0; i < 8; ++i) KeT[(cg * 8 + i) * TP + s] = (bf16)f2bf(y[i] * e);
                tr_store16(Vt, cg * 16, s, rv[0], rv[1]); }
            const float mloc = ev[64], gch = ev[65];
            SIDE_FLUSH();
            if (j < 6) ST_FETCH(u + 2);
            __syncthreads();
            const float mnew = fmaxf(gch + mrun, mloc), fa = __expf(gch + mrun - mnew), fb = __expf(mloc - mnew);
            { const int kb = C.wave & 1, vb = C.wave >> 1; f32x16 acc;
#pragma unroll
                for (int i = 0; i < 16; ++i) acc[i] = 0.f;
#pragma unroll
                for (int st = 0; st < 4; ++st) acc = MFMA32(frag_ld(KeT, kb * 32 + r, st, h), frag_ld(Vt, vb * 32 + r, st, h), acc);
                LAS bf16* dst = Cs + (vb * 32 + r) * TP + kb * 32 + 4 * h;
#pragma unroll
                for (int g = 0; g < 4; ++g) *(LAS v2u*)(dst + 8 * g) = (v2u){pk2(crun[4 * g], crun[4 * g + 1]), pk2(crun[4 * g + 2], crun[4 * g + 3])};
#pragma unroll
                for (int i = 0; i < 16; ++i) crun[i] = fa * crun[i] + fb * acc[i]; }
            if (tid < 64) { float a = 0.f;
#pragma unroll 8
                for (int s_ = 0; s_ < 64; s_ += 2) { const unsigned w = *(const LAS unsigned*)(KeT + tid * TP + s_); a += bflo(w) + bfhi(w); }
                NST[(size_t)u * 64 + tid] = nrun; nrun = fa * nrun + fb * a; }
            if (tid == 0) { MPREV[u] = mrun; MS[MS_DCUM + u] = drun; }
            mrun = mnew; drun += gch;
            SIDE_STEP();
        };
#pragma unroll 1
        for (int jj = 0; jj < 8; jj += 2) { body(jj, rkA, rvA, rigA, rfgA); body(jj + 1, rkB, rvB, rigB, rfgB); }
        __syncthreads(); CST_FLUSH(u0 + 7);
        SIDE_FLUSH();
        { const int kb = C.wave & 1, vb = C.wave >> 1; float* dst = TOTC + (size_t)vc * 8192 + (size_t)(vb * 32 + r) * 64 + kb * 32 + 4 * h;
#pragma unroll
            for (int g = 0; g < 4; ++g) *(f32x4*)(dst + 8 * g) = (f32x4){crun[4 * g], crun[4 * g + 1], crun[4 * g + 2], crun[4 * g + 3]}; }
        if (tid < 64) TOTN[vc * 64 + tid] = nrun;
        if (tid == 0) { MS[MS_TOTM + vc] = mrun; MS[MS_TOTG + vc] = drun; }
    }
#undef ST_FETCH
#undef CST_FLUSH
#undef SIDE_STEP
#undef SIDE_FLUSH
#undef SIDE_OUT
    __syncthreads();
}

__device__ __forceinline__ void p_mlstm_out_seq(const Ctx& C, int l) {
    const bf16* proj = (const bf16*)(C.ws + WS_PROJ); const float* G = (const float*)(C.ws + WS_G);
    const bf16* CST = (const bf16*)(C.ws + WS_CST); const float* NST = (const float*)(C.ws + WS_NST); const float* MS = (const float*)(C.ws + WS_MISC); const float* MPREV = MS + 4096;
    const float* TOTC = (const float*)(C.ws + WS_TOTC); const float* TOTN = (const float*)(C.ws + WS_TOTN);
    bf16* MIXIN = (bf16*)(C.ws + WS_MIXIN);
    const float* cw = C.in[I_CONVW] + (size_t)l * 4 * 512; const float* cb = C.in[I_CONVB] + (size_t)l * 512;
    LAS bf16* Qt = (LAS bf16*)(C.lds + RING_OFF);
    LAS bf16* Kt = Qt + 64 * TP;
    LAS bf16* St = Kt + 64 * TP;
    LAS bf16* Vt = St + 64 * TP;
    LAS bf16* Ct = Vt + 128 * TP;
    LAS float* sv = (LAS float*)(Ct + 128 * TP);
    const int tid = ltid(), lane = tid & 63, r = lane & 31, h = lane >> 5;
    const int s = tid >> 3, cg = tid & 7, s2 = tid & 63, vg = tid >> 6, cv = tid >> 2, ck0 = (tid & 3) * 16, ot = (C.wave & 1) * 32 + r, ovb = C.wave >> 1;
    v4u rq[4], rk[4], rv[2], rc[2], ro[2], rop[2]; float rig = 0.f, rfg = 0.f, rml = 0.f, rdc = 0.f, rnp = 0.f;
    LAS float* Os = sv + 640;
    LAS float* cwq = Os + 64 * 132; LAS float* cwk = cwq + 320;
    static_assert((3 * 64 + 2 * 128) * TP * 2 + 640 * 4 + 64 * 132 * 4 + 640 * 4 <= RING_BYTES, "mLSTM LDS");
#define OUT_FETCH(u_) do { const int bh_ = (u_) / NCH, c_ = (u_) % NCH, n0_ = (bh_ >> 2) * SEQ + c_ * CHUNK, hd_ = bh_ & 3; \
        conv_fetch(proj, n0_ + s, c_ * CHUNK + s, 1536 + hd_ * 64 + cg * 8, rq); conv_fetch(proj, n0_ + s, c_ * CHUNK + s, 1536 + 256 + hd_ * 64 + cg * 8, rk); \
        const bf16* vp_ = proj + (size_t)(n0_ + s2) * NPROJ + 2048 + hd_ * 128 + vg * 16; rv[0] = *(const v4u*)vp_; rv[1] = *(const v4u*)(vp_ + 8); \
        const v4u* cp_ = (const v4u*)(CST + (size_t)(u_) * 8192 + cv * 64 + ck0); rc[0] = cp_[0]; rc[1] = cp_[1]; \
        const bf16* op_ = proj + (size_t)(n0_ + s) * NPROJ + 2560 + hd_ * 128 + cg * 16; ro[0] = *(const v4u*)op_; ro[1] = *(const v4u*)(op_ + 8); \
        rml = MPREV[(u_)]; rdc = MS[MS_DCUM + (u_)]; \
        if (C.wave == 0) { rig = G[(size_t)(n0_ + lane) * 8 + hd_]; rfg = G[(size_t)(n0_ + lane) * 8 + 4 + hd_]; rnp = NST[(size_t)(u_) * 64 + lane]; } } while (0)
#define OUT_FLUSH(nb_) do { float hv_[16], og_[16]; const LAS f32x4* hp_ = (const LAS f32x4*)(Os + s * 132 + cg * 16); \
        _Pragma("unroll") for (int q_ = 0; q_ < 4; ++q_) { const f32x4 t4_ = hp_[q_]; hv_[4 * q_] = t4_.x; hv_[4 * q_ + 1] = t4_.y; hv_[4 * q_ + 2] = t4_.z; hv_[4 * q_ + 3] = t4_.w; } \
        unpack8(rop[0], og_); unpack8(rop[1], og_ + 8); _Pragma("unroll") for (int i_ = 0; i_ < 16; ++i_) hv_[i_] *= sigmoid_f(og_[i_]); \
        bf16* dp_ = MIXIN + (size_t)((nb_) + s) * DMODEL + 512 + hd * 128 + cg * 16; *(v4u*)dp_ = pack8(hv_); *(v4u*)(dp_ + 8) = pack8(hv_ + 8); } while (0)
    for (int vc = C.vcu; vc < 256; vc += C.G) {
        const int bh = vc >> 3, gi = vc & 7, b = bh >> 2, hd = bh & 3, u0 = bh * NCH + gi * 8;
        conv_stage(cwq, cw, cb, hd * 64, tid); conv_stage(cwk, cw, cb, 256 + hd * 64, tid);
        OUT_FETCH(u0);
        float cin[16], nin = 0.f, min_ = -INFINITY;
#pragma unroll
        for (int i = 0; i < 16; ++i) cin[i] = 0.f;
#pragma unroll 1
        for (int g2 = 0; g2 < gi; ++g2) { const int gv = (bh << 3) + g2; const float tm = MS[MS_TOTM + gv], tg = MS[MS_TOTG + gv];
            const f32x4* tp = (const f32x4*)(TOTC + (size_t)gv * 8192 + cv * 64 + ck0); const f32x4 t0 = tp[0], t1 = tp[1], t2 = tp[2], t3 = tp[3]; const float tn = (C.wave == 0) ? TOTN[gv * 64 + lane] : 0.f;
            const float mn = fmaxf(tg + min_, tm), fa = __expf(tg + min_ - mn), fb = __expf(tm - mn);
            const float tt[16] = {t0.x, t0.y, t0.z, t0.w, t1.x, t1.y, t1.z, t1.w, t2.x, t2.y, t2.z, t2.w, t3.x, t3.y, t3.z, t3.w};
#pragma unroll
            for (int i = 0; i < 16; ++i) cin[i] = fa * cin[i] + fb * tt[i];
            nin = fa * nin + fb * tn; min_ = mn; }
#pragma unroll 1
        for (int j = 0; j < 8; ++j) {
            const int u = u0 + j, c = gi * 8 + j; const int n0 = b * SEQ + c * CHUNK;
            const float mp = fmaxf(rdc + min_, rml); const float w1 = (min_ == -INFINITY) ? 0.f : __expf(rdc + min_ - mp), w2 = (rml == -INFINITY) ? 0.f : __expf(rml - mp);
            __syncthreads();
            if (j > 0) OUT_FLUSH(n0 - CHUNK);
            { float y[8];
                conv_apply_l(rq, cwq, cg * 8, 0.125f, y); *(LAS v4u*)(Qt + s * TP + cg * 8) = pack8(y);
                conv_apply_l(rk, cwk, cg * 8, 1.0f, y); *(LAS v4u*)(Kt + s * TP + cg * 8) = pack8(y);
                tr_store16(Vt, vg * 16, s2, rv[0], rv[1]);
                float cl[16]; unpack8(rc[0], cl); unpack8(rc[1], cl + 8);
#pragma unroll
                for (int i = 0; i < 16; ++i) cl[i] = w1 * cin[i] + w2 * cl[i];
                *(LAS v4u*)(Ct + cv * TP + ck0) = pack8(cl); *(LAS v4u*)(Ct + cv * TP + ck0 + 8) = pack8(cl + 8);
                rop[0] = ro[0]; rop[1] = ro[1]; }
            if (C.wave == 0) { const float ig = rig, fg = rfg;
                float bc = fminf(fg, 0.f) - log1pf(expf(-fabsf(fg)));
#pragma unroll
                for (int o = 1; o < 64; o <<= 1) { const float t = __shfl_up(bc, o); if (lane >= o) bc += t; }
                const float a = ig - bc; float pm = a;
#pragma unroll
                for (int o = 1; o < 64; o <<= 1) { const float t = __shfl_up(pm, o); if (lane >= o) pm = fmaxf(pm, t); }
                const float mt = bc + fmaxf(mp, pm);
                sv[lane] = bc; sv[64 + lane] = a; sv[128 + lane] = mt; sv[192 + lane] = __expf(bc + mp - mt); sv[256 + lane] = w1 * nin + w2 * rnp; }
            if (j < 7) OUT_FETCH(u + 1);
            __syncthreads();
            if (C.wave < 4) {
                const int sb = C.wave & 1, tb = C.wave >> 1; f32x16 x;
#pragma unroll
                for (int i = 0; i < 16; ++i) x[i] = 0.f;
#pragma unroll
                for (int st = 0; st < 4; ++st) x = MFMA32(frag_ld(Kt, sb * 32 + r, st, h), frag_ld(Qt, tb * 32 + r, st, h), x);
                const int t = tb * 32 + r; const float bt = sv[t] - sv[128 + t]; float dsum = 0.f;
#pragma unroll
                for (int g = 0; g < 4; ++g) { const int s0 = sb * 32 + 8 * g + 4 * h; float w[4];
#pragma unroll
                    for (int i = 0; i < 4; ++i) { const int ss = s0 + i; w[i] = (ss <= t) ? x[4 * g + i] * __expf(sv[64 + ss] + bt) : 0.f; }
                    const unsigned p0 = pk2(w[0], w[1]), p1 = pk2(w[2], w[3]); dsum += (bflo(p0) + bfhi(p0)) + (bflo(p1) + bfhi(p1));
                    *(LAS v2u*)(St + t * TP + s0) = (v2u){p0, p1}; }
                sv[384 + (sb * 2 + h) * 64 + t] = dsum;
            } else if (tid < 320) {
                const int t = tid - 256; float a = 0.f;
#pragma unroll 8
                for (int k = 0; k < 64; k += 2) { const unsigned w = *(const LAS unsigned*)(Qt + t * TP + k); a += bflo(w) * sv[256 + k] + bfhi(w) * sv[256 + k + 1]; }
                sv[320 + t] = a; }
            __syncthreads();
            {
                const int vb = C.wave >> 1, tb = C.wave & 1; f32x16 acc;
#pragma unroll
                for (int i = 0; i < 16; ++i) acc[i] = 0.f;
#pragma unroll
                for (int st = 0; st < 4; ++st) acc = MFMA32(frag_ld(Ct, vb * 32 + r, st, h), frag_ld(Qt, tb * 32 + r, st, h), acc);
                const int t = tb * 32 + r; const float iw = sv[192 + t];
#pragma unroll
                for (int i = 0; i < 16; ++i) acc[i] *= iw;
#pragma unroll
                for (int st = 0; st < 4; ++st) acc = MFMA32(frag_ld(Vt, vb * 32 + r, st, h), frag_ld(St, tb * 32 + r, st, h), acc);
                const float den = ((sv[384 + t] + sv[384 + 64 + t]) + (sv[384 + 128 + t] + sv[384 + 192 + t])) + iw * sv[320 + t];
                const float dn = 1.0f / fmaxf(fabsf(den), __expf(-sv[128 + t]));
                LAS float* od = Os + t * 132 + vb * 32 + 4 * h;
#pragma unroll
                for (int g = 0; g < 4; ++g) *(LAS f32x4*)(od + 8 * g) = (f32x4){acc[4 * g] * dn, acc[4 * g + 1] * dn, acc[4 * g + 2] * dn, acc[4 * g + 3] * dn}; }
        }
        __syncthreads();
        OUT_FLUSH(b * SEQ + (gi * 8 + 7) * CHUNK);
    }
#undef OUT_FETCH
#undef OUT_FLUSH
    __syncthreads();
}
template <int W> __device__ __forceinline__ void tr_reduce_step(float* val, bool bit, int mask) {
#pragma unroll
    for (int i = 0; i < W / 2; ++i) { const float keep = bit ? val[i + W / 2] : val[i], send = bit ? val[i] : val[i + W / 2]; val[i] = keep + __shfl_xor(send, mask); }
}
__device__ __forceinline__ void p_ln1_router(const Ctx& C, int l, bool claim = true, bool norouter = false, bool nostore = false, bool norows = false, int stsel = 3) {
    const bf16* XBr = (const bf16*)(C.ws + WS_XB); const unsigned char* XLO = (const unsigned char*)(C.ws + WS_XRES);
    const bf16* MIXO = (const bf16*)(C.ws + WS_MIXO); float* X1 = (float*)(C.ws + WS_X1); unsigned char* X1Q = (unsigned char*)(C.ws + WS_X1B);
    int* TOKE = (int*)(C.ws + WS_TOKE); int* TOKP = (int*)(C.ws + WS_TOKP); float* TOKG = (float*)(C.ws + WS_TOKG); int* ROWTOK = (int*)(C.ws + WS_ROWTOK);
    unsigned* cntg = (unsigned*)(C.ws + WS_CTL) + CW_CNT + 64 * l;
    const float* br = C.in[I_BR] + l * NEXP;
    LAS f32x4* wl = (LAS f32x4*)(C.lds + RING_OFF);
    LAS float* lg = (LAS float*)(C.lds + LDSX_OFF) + C.wave * (16 * 32);
    LAS int* lc = (LAS int*)(C.lds + LDSX_OFF + 8 * 16 * 32 * 4);
    const int tid = ltid(), lane = tid & 63;
    { const f32x4* WRP = (const f32x4*)(C.ws + WS_WRP) + (size_t)l * 8192;
        for (int idx = tid; idx < 8192; idx += NTHREADS) wl[idx] = WRP[idx]; }
    LAS f32x4* gbl = (LAS f32x4*)(C.lds + LDSX_OFF + 8 * 16 * 32 * 4 + 512);
    { float g_[16], b_[16]; load_vec16(C.in[I_LN1G] + l * DMODEL, lane, g_); load_vec16(C.in[I_LN1B] + l * DMODEL, lane, b_);
      if (C.wave == 0) {
#pragma unroll
        for (int q = 0; q < 4; ++q) { gbl[q * 64 + lane] = (f32x4){g_[4 * q], g_[4 * q + 1], g_[4 * q + 2], g_[4 * q + 3]}; gbl[(4 + q) * 64 + lane] = (f32x4){b_[4 * q], b_[4 * q + 1], b_[4 * q + 2], b_[4 * q + 3]}; } } }
    const int gw = C.vcu * NWAVES + C.wave, NGW = C.G * NWAVES, NGRP = NTOK / 4;
    for (int g0 = gw; g0 < NGRP; g0 += 4 * NGW) {
        if (tid < 64) lc[tid] = 0;
        __syncthreads();
        v4u pxb[4][2], pmx[4][2]; v2u plo[4][2] = {};
#define LN1_FETCH(grp_) do { _Pragma("unroll") for (int r = 0; r < 4; ++r) { const size_t n_ = (size_t)((grp_) * 4 + r) * DMODEL; \
            pxb[r][0] = __builtin_nontemporal_load((const v4u*)(XBr + n_ + 8 * lane)); pxb[r][1] = __builtin_nontemporal_load((const v4u*)(XBr + n_ + 512 + 8 * lane)); if (USE_XLO) { plo[r][0] = *(const v2u*)(XLO + n_ + 8 * lane); plo[r][1] = *(const v2u*)(XLO + n_ + 512 + 8 * lane); } \
            pmx[r][0] = __builtin_nontemporal_load((const v4u*)(MIXO + n_ + 8 * lane)); pmx[r][1] = __builtin_nontemporal_load((const v4u*)(MIXO + n_ + 512 + 8 * lane)); } } while (0)
        LN1_FETCH(g0);
#pragma unroll 1
        for (int blk = norows ? 4 : 0; blk < 4; ++blk) {
            const int grp = g0 + blk * NGW; if (grp >= NGRP) break;
            float xv[4][16];
#pragma unroll
            for (int r = 0; r < 4; ++r) { const size_t n = (size_t)(grp * 4 + r); float m[16]; typedef float f32x2_ __attribute__((ext_vector_type(2)));
                unpack8(pxb[r][0], xv[r]); unpack8(pxb[r][1], xv[r] + 8); unpack8(pmx[r][0], m); unpack8(pmx[r][1], m + 8);
                const unsigned w_[4] = {plo[r][0].x, plo[r][0].y, plo[r][1].x, plo[r][1].y};
#pragma unroll
                for (int i = 0; i < (USE_XLO ? 4 : 0); ++i) { const f32x2_ lo = __builtin_amdgcn_cvt_pk_f32_fp8((int)w_[i], false), hi = __builtin_amdgcn_cvt_pk_f32_fp8((int)w_[i], true);
                    xv[r][4 * i] += lo.x * (1.0f / XLO_SCALE); xv[r][4 * i + 1] += lo.y * (1.0f / XLO_SCALE); xv[r][4 * i + 2] += hi.x * (1.0f / XLO_SCALE); xv[r][4 * i + 3] += hi.y * (1.0f / XLO_SCALE); }
#pragma unroll
                for (int i = 0; i < 16; ++i) xv[r][i] = DN_ALPHA * xv[r][i] + m[i];
                { float gam[16], bet[16];
#pragma unroll
                  for (int q = 0; q < 4; ++q) { const f32x4 g4_ = gbl[q * 64 + lane], b4_ = gbl[(4 + q) * 64 + lane]; gam[4 * q] = g4_.x; gam[4 * q + 1] = g4_.y; gam[4 * q + 2] = g4_.z; gam[4 * q + 3] = g4_.w; bet[4 * q] = b4_.x; bet[4 * q + 1] = b4_.y; bet[4 * q + 2] = b4_.z; bet[4 * q + 3] = b4_.w; }
                  ln_row(xv[r], gam, bet); }
                if (!nostore) { typedef float f32x2q __attribute__((ext_vector_type(2)));
                    const v2u p0 = pack8_fp8(xv[r], XQ_SCALE), p1 = pack8_fp8(xv[r] + 8, XQ_SCALE); __builtin_nontemporal_store(p0, (v2u*)(X1Q + n * DMODEL + 8 * lane)); __builtin_nontemporal_store(p1, (v2u*)(X1Q + n * DMODEL + 512 + 8 * lane));
                    const unsigned pw_[4] = {p0.x, p0.y, p1.x, p1.y}; float rem_[16];
#pragma unroll
                    for (int i = 0; i < 4; ++i) { const f32x2q lo = __builtin_amdgcn_cvt_pk_f32_fp8((int)pw_[i], false), hi = __builtin_amdgcn_cvt_pk_f32_fp8((int)pw_[i], true);
                        rem_[4 * i] = xv[r][4 * i] - lo.x * (1.0f / XQ_SCALE); rem_[4 * i + 1] = xv[r][4 * i + 1] - lo.y * (1.0f / XQ_SCALE); rem_[4 * i + 2] = xv[r][4 * i + 2] - hi.x * (1.0f / XQ_SCALE); rem_[4 * i + 3] = xv[r][4 * i + 3] - hi.y * (1.0f / XQ_SCALE); }
                    if (MK_X1R8) { unsigned char* rr_ = (unsigned char*)X1 + n * DMODEL; __builtin_nontemporal_store(pack8_fp8(rem_, X1R_SCALE), (v2u*)(rr_ + 8 * lane)); __builtin_nontemporal_store(pack8_fp8(rem_ + 8, X1R_SCALE), (v2u*)(rr_ + 512 + 8 * lane)); }
                    else { bf16* rr_ = (bf16*)X1 + n * DMODEL; __builtin_nontemporal_store(pack8(rem_), (v4u*)(rr_ + 8 * lane)); __builtin_nontemporal_store(pack8(rem_ + 8), (v4u*)(rr_ + 512 + 8 * lane)); }   } else if (xv[r][0] == 123.456f) X1[n * DMODEL + lane] = xv[r][1]; }
            if (blk < 3 && g0 + (blk + 1) * NGW < NGRP) LN1_FETCH(g0 + (blk + 1) * NGW);
            typedef float f32x2p __attribute__((ext_vector_type(2)));
            f32x2p xa[16], xb[16];
#pragma unroll
            for (int i = 0; i < 16; ++i) { xa[i] = (f32x2p){xv[0][i], xv[1][i]}; xb[i] = (f32x2p){xv[2][i], xv[3][i]}; }
#pragma unroll 1
            for (int q = norouter ? 4 : 0; q < 4; ++q) {
                float acc[32];
#pragma unroll
                for (int e = 0; e < 8; ++e) { const LAS f32x4* wp = wl + ((q * 8 + e) * 4) * 64 + lane; const f32x4 w0 = wp[0], w1 = wp[64], w2 = wp[128], w3 = wp[192];
                    const float ww[16] = {w0.x, w0.y, w0.z, w0.w, w1.x, w1.y, w1.z, w1.w, w2.x, w2.y, w2.z, w2.w, w3.x, w3.y, w3.z, w3.w};
                    f32x2p a = xa[0] * ww[0], b = xb[0] * ww[0];
#pragma unroll
                    for (int i = 1; i < 16; ++i) { a += xa[i] * ww[i]; b += xb[i] * ww[i]; }
                    acc[0 * 8 + e] = a.x; acc[1 * 8 + e] = a.y; acc[2 * 8 + e] = b.x; acc[3 * 8 + e] = b.y; }
                tr_reduce_step<32>(acc, (lane >> 4) & 1, 16); tr_reduce_step<16>(acc, (lane >> 3) & 1, 8); tr_reduce_step<8>(acc, (lane >> 2) & 1, 4); tr_reduce_step<4>(acc, (lane >> 1) & 1, 2); tr_reduce_step<2>(acc, lane & 1, 1);
                const float tot = acc[0] + __shfl_xor(acc[0], 32);
                if (lane < 32) lg[(blk * 4 + (lane >> 3)) * 32 + q * 8 + (lane & 7)] = tot + br[q * 8 + (lane & 7)];
            }
        }
#undef LN1_FETCH
        LDS_WAIT(); asm volatile("" ::: "memory");
        int te[4] = {0, 0, 0, 0}, tp[4] = {0, 0, 0, 0}; float tg[4] = {0.f, 0.f, 0.f, 0.f};
        if (lane < 16 && (g0 + (lane >> 2) * NGW) < NGRP) {
            float lv[32];
#pragma unroll
            for (int e = 0; e < 32; ++e) lv[e] = lg[lane * 32 + e];
            unsigned taken = 0u; float val[4];
#pragma unroll
            for (int k = 0; k < 4; ++k) { int bi = 0; float bv = -INFINITY;
#pragma unroll
                for (int e = 0; e < 32; ++e) { const bool ok = !((taken >> e) & 1u) && (lv[e] > bv); bv = ok ? lv[e] : bv; bi = ok ? e : bi; }
                te[k] = bi; val[k] = bv; taken |= 1u << bi; }
            float s = 0.f;
#pragma unroll
            for (int k = 0; k < 4; ++k) { tg[k] = expf(val[k] - val[0]); s += tg[k]; }
#pragma unroll
            for (int k = 0; k < 4; ++k) { tg[k] = tg[k] / s; tp[k] = __hip_atomic_fetch_add(lc + te[k], 1, __ATOMIC_RELAXED, __HIP_MEMORY_SCOPE_WORKGROUP); }
        }
        __syncthreads();
        if (tid < 32 && claim) lc[32 + tid] = (int)__hip_atomic_fetch_add(cntg + tid, (unsigned)lc[tid], __ATOMIC_RELAXED, __HIP_MEMORY_SCOPE_AGENT);
        __syncthreads();
        const int mygrp = g0 + (lane >> 2) * NGW;
        if (lane < 16 && claim && mygrp < NGRP) { const int n = mygrp * 4 + (lane & 3);
#pragma unroll
            for (int k = 0; k < 4; ++k) { const int pos = lc[32 + te[k]] + tp[k]; TOKE[n * 4 + k] = te[k]; TOKP[n * 4 + k] = pos; TOKG[n * 4 + k] = tg[k]; ROWTOK[(size_t)te[k] * NTOK + pos] = n; } }
        __syncthreads();
    }
}

__device__ __forceinline__ void moe_tables(const Ctx& C, int l) {
    LAS int* ts = (LAS int*)(C.lds + LDSCTL_OFF); LAS int* cn = (LAS int*)(C.lds + LDSCTL_OFF + 160);
    const unsigned* cntg = (const unsigned*)(C.ws + WS_CTL) + CW_CNT + 64 * l;
    const int tid = ltid();
    if (tid < 64) { const int lane = tid; const int c = (lane < 32) ? (int)__hip_atomic_load(cntg + lane, __ATOMIC_RELAXED, __HIP_MEMORY_SCOPE_AGENT) : 0; int t = (c + 255) >> 8;
        int inc = t;
#pragma unroll
        for (int o = 1; o < 64; o <<= 1) { const int x = __shfl_up(inc, o); if (lane >= o) inc += x; }
        if (lane < 32) { cn[lane] = c; ts[lane] = inc - t; } if (lane == 32) ts[32] = inc; }
    __syncthreads();
}

__device__ __forceinline__ void p_ln2_combine(const Ctx& C, int l) {
    const bf16* X1 = (const bf16*)(C.ws + WS_X1); const unsigned char* X1Q = (const unsigned char*)(C.ws + WS_X1B); const unsigned char* Y = (const unsigned char*)(C.ws + WS_Y);
    const int* TOKE = (const int*)(C.ws + WS_TOKE); const int* TOKP = (const int*)(C.ws + WS_TOKP); const float* TOKG = (const float*)(C.ws + WS_TOKG);
    float* xo = C.out; unsigned char* XLOw = (unsigned char*)(C.ws + WS_XRES); bf16* XB = (bf16*)(C.ws + WS_XB); float* G = (float*)(C.ws + WS_G);
    const LAS int* ts = (const LAS int*)(C.lds + LDSCTL_OFF);
    LAS f32x4* wgl = (LAS f32x4*)(C.lds + RING_OFF);
    const int tid = ltid(), lane = tid & 63, gw = C.vcu * NWAVES + C.wave, NGW = C.G * NWAVES; const bool nextl = (l + 1 < DEPTH);
    if (nextl) load_gate_w(tid, C.in[I_WIN] + (size_t)(l + 1) * DMODEL * INW, wgl);
    __syncthreads();
    float gam[16], bet[16]; load_vec16(C.in[I_LN2G] + l * DMODEL, lane, gam); load_vec16(C.in[I_LN2B] + l * DMODEL, lane, bet);
    typedef int i32x4_ __attribute__((ext_vector_type(4)));
    i32x4_ ne[2], np[2]; f32x4 ng_[2];
#define LN2_ROUTE(n0_) do { _Pragma("unroll") for (int q = 0; q < 2; ++q) { int nn = (n0_) + q * NGW; nn = nn < NTOK ? nn : (NTOK - 1); ne[q] = *(const i32x4_*)(TOKE + nn * 4); np[q] = *(const i32x4_*)(TOKP + nn * 4); ng_[q] = *(const f32x4*)(TOKG + nn * 4); } } while (0)
    LN2_ROUTE(gw);
    for (int n = gw; n < NTOK; n += 2 * NGW) {
        v4u xr[2][2]; v2u xr8[2][2]; v2u xq[2][2]; v2u yr[2][4][2]; f32x4 g4[2]; int nrow[2];
#pragma unroll
        for (int q = 0; q < 2; ++q) { int nn = n + q * NGW; nn = nn < NTOK ? nn : (NTOK - 1); nrow[q] = nn; g4[q] = ng_[q];
            if (MK_X1R8) { const unsigned char* xp = (const unsigned char*)X1 + (size_t)nn * DMODEL; xr8[q][0] = __builtin_nontemporal_load((const v2u*)(xp + 8 * lane)); xr8[q][1] = __builtin_nontemporal_load((const v2u*)(xp + 512 + 8 * lane)); }
            else { const bf16* xp = X1 + (size_t)nn * DMODEL; xr[q][0] = __builtin_nontemporal_load((const v4u*)(xp + 8 * lane)); xr[q][1] = __builtin_nontemporal_load((const v4u*)(xp + 512 + 8 * lane)); }
            const unsigned char* xqp = X1Q + (size_t)nn * DMODEL; xq[q][0] = __builtin_nontemporal_load((const v2u*)(xqp + 8 * lane)); xq[q][1] = __builtin_nontemporal_load((const v2u*)(xqp + 512 + 8 * lane));
#pragma unroll
            for (int k = 0; k < 4; ++k) { const unsigned char* yp = Y + ((size_t)ts[ne[q][k]] * 256 + np[q][k]) * DMODEL; yr[q][k][0] = __builtin_nontemporal_load((const v2u*)(yp + 8 * lane)); yr[q][k][1] = __builtin_nontemporal_load((const v2u*)(yp + 512 + 8 * lane)); } }
        if (n + 2 * NGW < NTOK) LN2_ROUTE(n + 2 * NGW);
#pragma unroll
        for (int q = 0; q < 2; ++q) {
            if (q == 1 && n + NGW >= NTOK) break;
            typedef float f32x2_ __attribute__((ext_vector_type(2)));
            float v[16];
            if (MK_X1R8) { const unsigned w[4] = {xr8[q][0].x, xr8[q][0].y, xr8[q][1].x, xr8[q][1].y};
#pragma unroll
              for (int i = 0; i < 4; ++i) { const f32x2_ lo = __builtin_amdgcn_cvt_pk_f32_fp8((int)w[i], false), hi = __builtin_amdgcn_cvt_pk_f32_fp8((int)w[i], true);
                  v[4 * i] = lo.x * (1.0f / X1R_SCALE); v[4 * i + 1] = lo.y * (1.0f / X1R_SCALE); v[4 * i + 2] = hi.x * (1.0f / X1R_SCALE); v[4 * i + 3] = hi.y * (1.0f / X1R_SCALE); } }
            else { unpack8(xr[q][0], v); unpack8(xr[q][1], v + 8); }
            { const unsigned w[4] = {xq[q][0].x, xq[q][0].y, xq[q][1].x, xq[q][1].y};
#pragma unroll
              for (int i = 0; i < 4; ++i) { const f32x2_ lo = __builtin_amdgcn_cvt_pk_f32_fp8((int)w[i], false), hi = __builtin_amdgcn_cvt_pk_f32_fp8((int)w[i], true);
                  v[4 * i] += lo.x * (1.0f / XQ_SCALE); v[4 * i + 1] += lo.y * (1.0f / XQ_SCALE); v[4 * i + 2] += hi.x * (1.0f / XQ_SCALE); v[4 * i + 3] += hi.y * (1.0f / XQ_SCALE); } }
#pragma unroll
            for (int i = 0; i < 16; ++i) v[i] *= DN_ALPHA;
#pragma unroll
            for (int k = 0; k < 4; ++k) { const float gk = g4[q][k] * (1.0f / YQ_SCALE); const unsigned w[4] = {yr[q][k][0].x, yr[q][k][0].y, yr[q][k][1].x, yr[q][k][1].y};
#pragma unroll
                for (int i = 0; i < 4; ++i) { const f32x2_ lo = __builtin_amdgcn_cvt_pk_f32_fp8((int)w[i], false), hi = __builtin_amdgcn_cvt_pk_f32_fp8((int)w[i], true);
                    v[4 * i] += gk * lo.x; v[4 * i + 1] += gk * lo.y; v[4 * i + 2] += gk * hi.x; v[4 * i + 3] += gk * hi.y; } }
            ln_row(v, gam, bet);
            const int nn = nrow[q];
            if (!nextl) store_row_f32_nt(xo + (size_t)nn * DMODEL, lane, v);
            if (nextl) { store_row_bf16_nt(XB + (size_t)nn * DMODEL, lane, v); { float lo_[16];
#pragma unroll
                for (int i = 0; i < 16; ++i) lo_[i] = v[i] - __uint_as_float(f2bf(v[i]) << 16);
                if (USE_XLO) store_row_fp8(XLOw + (size_t)nn * DMODEL, lane, lo_, XLO_SCALE);
                store_row_fp8_nt((unsigned char*)(C.ws + WS_XQ) + (size_t)nn * DMODEL, lane, v, XQ_SCALE); }
                gates_row(v, wgl, C.in[I_GATEB] + (l + 1) * 8, G + (size_t)nn * 8, lane); }
        }
    }
#undef LN2_ROUTE
    __syncthreads();
}
#ifndef MK_RELMODE
#define MK_RELMODE 0
#endif
__device__ __forceinline__ void xcd_barrier_w(const XcdBarrier& b, const Ctx& C, volatile LAS unsigned* rel, int minitems = 0) {
    asm volatile("s_waitcnt vmcnt(0)" ::: "memory");
    if (threadIdx.x == 0) *rel = 0u;
    __syncthreads();
    if (C.wave == 0) {
        if (threadIdx.x == 0) {
            unsigned* bar = b.bar;
            __builtin_amdgcn_s_waitcnt(0);
            unsigned nloc = b.st[0], nx = b.st[1];
            if (nloc == 0u) { xcd_barrier_complete(bar, b.x, nloc, nx); b.st[0] = nloc; b.st[1] = nx; }
            const unsigned old = xb_add(&bar[XB_XSUB(b.x)], 1u);
            const unsigned gen = old / nloc;
            if (old + 1u == (gen + 1u) * nloc) {
                if (MK_RELMODE == 0) *rel = 1u;
                __builtin_amdgcn_fence(__ATOMIC_RELEASE, "agent");
                asm volatile("s_waitcnt vmcnt(0)" ::: "memory");
                const unsigned og = xb_add(&bar[XB_TOP], 1u);
                const unsigned tg = og / nx;
                if (og + 1u == (tg + 1u) * nx) xb_add(&bar[XB_TOPGEN], 1u);
                else XB_SPIN(xb_ld(&bar[XB_TOPGEN]) == tg, bar);
                *rel = 1u;
                __builtin_amdgcn_fence(__ATOMIC_ACQUIRE, "agent");
                xb_add(&bar[XB_XGEN(b.x)], 1u);
                asm volatile("s_waitcnt vmcnt(0)" ::: "memory");
            } else {
                if (MK_RELMODE == 0) { XB_SPIN(xb_ld(&bar[XB_XSUB(b.x)]) < (gen + 1u) * nloc, bar);
                    *rel = 1u; }
                XB_SPIN(xb_ld(&bar[XB_XGEN(b.x)]) == gen, bar);
                *rel = 1u;
                __builtin_amdgcn_fence(__ATOMIC_ACQUIRE, "agent");
                asm volatile("s_waitcnt vmcnt(0)" ::: "memory");
            }
        }
    } else {
        const int lane = ltid() & 63, total = TRQ_LAYERS * trq_per(C); LAS float* scr = (LAS float*)(C.lds + RING_OFF + (C.wave - 1) * 16896);
        int done = 0;
        while (done < minitems || *rel == 0u) { const int q = trq_grab(C, lane); if (q >= total) break; const int r = trq_item(C, q); if (r >= 0) tr_one(C, r, scr, lane); ++done; }
    }
    __syncthreads();
}

struct Args { const float* in[21]; float* out; unsigned char* ws; int ph_lo, ph_hi, li, pad; };
__global__ void __launch_bounds__(NTHREADS, 2) mega_fwd(Args args) {
    extern __shared__ __attribute__((aligned(16))) unsigned char lds[];
    Ctx C;
    C.lds = (LAS unsigned char*)lds; C.wave = __builtin_amdgcn_readfirstlane(threadIdx.x >> 6);
    C.G = gridDim.x; { const int bx = blockIdx.x; C.vcu = (C.G % 8 == 0) ? (bx % 8) * (C.G / 8) + bx / 8 : bx; }
    C.ws = args.ws; C.in = args.in; C.out = args.out;
    volatile LAS unsigned* MISC = (volatile LAS unsigned*)(C.lds + MISC_OFF);
    for (int u = threadIdx.x; u < (LDSX_OFF - LDSCTL_OFF) / 4; u += NTHREADS) ((LAS unsigned*)(C.lds + LDSCTL_OFF))[u] = 0u;
    __syncthreads();
    unsigned* ctl = (unsigned*)(C.ws + WS_CTL);
    XcdBarrier bar = xcd_barrier_post(ctl + CW_BAR + args.li * XCD_BAR_WORDS, MISC + 8);
    const int lo = args.ph_lo, hi = args.ph_hi;
#define IN(k) (lo <= (k) && (k) < hi)
#ifndef MK_DBL
#define MK_DBL -1
#endif
#define REP(kind) _Pragma("unroll 1") for (int rep_ = 0; rep_ < ((kind) == MK_DBL ? 2 : 1); ++rep_)
#ifdef MK_PROBE_A
    LAS unsigned long long* tacc = (LAS unsigned long long*)(C.lds + LDSX_OFF + 20480);
    if (blockIdx.x == 0 && threadIdx.x == 0) { for (int i = 0; i < 16; ++i) tacc[i] = 0ull; tacc[14] = tacc[15] = wall_clock64(); }
#define stamper (blockIdx.x == 0 && threadIdx.x == 0)
#define STAMP(kind) do { if (stamper) { const unsigned long long now_ = wall_clock64(); tacc[kind] += now_ - tacc[14]; tacc[14] = now_; } } while (0)
#define SEAM(k) do { if (IN(k) && IN((k) + 1)) xcd_barrier(bar); STAMP((k) == 0 ? 0 : 1 + ((k) - 1) % NPH_LAYER); } while (0)
#else
#define STAMP(kind) do { } while (0)
#define SEAM(k) do { if (IN(k) && IN((k) + 1)) { xcd_barrier_w(bar, C, MISC + 10); if (MK_DBL == 12) xcd_barrier(bar); } } while (0)
#define SEAMW(k, n) do { if (IN(k) && IN((k) + 1)) { xcd_barrier_w(bar, C, MISC + 10, (n)); if (MK_DBL == 12) xcd_barrier(bar); } } while (0)
#ifndef MK_TAILITEMS
#define MK_TAILITEMS 3
#endif
#define MOE_IDLE(nN, xs) ((C.G == 256) ? ((((const LAS int*)(C.lds + LDSCTL_OFF))[32] + 8 * (32 / (nN)) - 1) / (8 * (32 / (nN))) - ((((const LAS int*)(C.lds + LDSCTL_OFF))[32] - ((int)blockIdx.x >> 3) / (nN) - ((((int)blockIdx.x & 7) + (xs)) & 7) * (32 / (nN)) + 8 * (32 / (nN)) - 1) / (8 * (32 / (nN))))) : 0)
#ifndef MK_DOWN_XS
#define MK_DOWN_XS 3
#endif
#endif
    if (IN(0)) { REP(0) p_prologue(C); SEAM(0); }
#pragma unroll 1
    for (int l = 0; l < DEPTH; ++l) {
        const int pb = 1 + l * NPH_LAYER;
        bf16* XB = (bf16*)(C.ws + WS_XB); bf16* PROJ = (bf16*)(C.ws + WS_PROJ);
        if (IN(pb + 0)) {
            { pg8::Gemm g{XB, (const bf16*)(C.ws + WS_WIN) + (size_t)l * NPROJ * DMODEL, NTOK, 2048, DMODEL}; pg8::StaticOrder S; S.init(NTOK, 2048, C.G, (int)blockIdx.x);
              pg8::EpiBf16<0> E{PROJ, NPROJ, nullptr, 512, 512, attn_body::C2};
              REP(1) pg8::gemm_phase<pg8::EpiBf16<0>, pg8::StaticOrder, true, true, false>(C.lds + RING_OFF, g, S, E); }
            { pg8::Gemm g{(const bf16*)(C.ws + WS_XQ), (const bf16*)(C.ws + WS_WINQ + (size_t)l * 1536 * DMODEL), NTOK, 1024, DMODEL / 2}; pg8::StaticOrder S; S.init(NTOK, 1024, C.G, (int)blockIdx.x);
              pg8::EpiBf16<0> E{PROJ + 2048, NPROJ, nullptr, 0, 0, 1.0f, 1.0f / (XQ_SCALE * WQ_SCALE)};
              REP(1) pg8::gemm_phase<pg8::EpiBf16<0>, pg8::StaticOrder, true, true, false, true>(C.lds + RING_OFF, g, S, E); }
            SEAM(pb + 0);
        }
        if (IN(pb + 1)) { REP(2) p_mlstm_states_seq(C, l); SEAM(pb + 1); }
        if (IN(pb + 3)) {
            REP(11) p_mlstm_out_seq(C, l); STAMP(11);
            { const int ln_ = ltid() & 63; const float s1 = wave_sum(C.in[I_LQ1][l * 64 + ln_] * C.in[I_LK1][l * 64 + ln_]), s2 = wave_sum(C.in[I_LQ2][l * 64 + ln_] * C.in[I_LK2][l * 64 + ln_]);
              const float lam_init = __uint_as_float(__builtin_amdgcn_readfirstlane(__float_as_uint(0.8f - 0.6f * expf(-0.3f * (float)l)))); const float lam = __uint_as_float(__builtin_amdgcn_readfirstlane(__float_as_uint(expf(s1) - expf(s2) + lam_init)));
              REP(4) for (int vc = C.vcu; vc < 256; vc += C.G) attn_body::attn_phase((char*)lds + RING_OFF, (const attn_body::bf16*)PROJ, (attn_body::bf16*)(C.ws + WS_ATTO), (attn_body::bf16*)(C.ws + WS_MIXIN), C.in[I_NG] + l * 128, lam, 1.0f - lam_init, vc); }
            SEAM(pb + 3);
        }
        if (IN(pb + 5)) {
#if MK_OUTFP8
            pg8::Gemm g{(const bf16*)(C.ws + WS_MIXIN), (const bf16*)(C.ws + WS_WOUT + (size_t)l * DMODEL * DMODEL), NTOK, DMODEL, DMODEL / 2}; pg8::StaticOrder S; S.init(NTOK, DMODEL, C.G, (int)blockIdx.x);
            pg8::EpiBf16<0> E{(bf16*)(C.ws + WS_MIXO), DMODEL, nullptr, 0, 0, 1.0f, 1.0f / (MQ_SCALE * WQ_SCALE)};
            REP(6) pg8::gemm_phase<pg8::EpiBf16<0>, pg8::StaticOrder, true, true, false, true>(C.lds + RING_OFF, g, S, E);
#else
            pg8::Gemm g{(const bf16*)(C.ws + WS_MIXIN), (const bf16*)(C.ws + WS_WOUT) + (size_t)l * DMODEL * DMODEL, NTOK, DMODEL, DMODEL}; pg8::StaticOrder S; S.init(NTOK, DMODEL, C.G, (int)blockIdx.x);
            pg8::EpiBf16<0> E{(bf16*)(C.ws + WS_MIXO), DMODEL, nullptr, 0, 0, 1.0f};
            REP(6) pg8::gemm_phase<pg8::EpiBf16<0>, pg8::StaticOrder, true, true, false>(C.lds + RING_OFF, g, S, E);
#endif
            SEAM(pb + 5);
        }
        if (IN(pb + 6)) { p_ln1_router(C, l); if (MK_DBL == 7) p_ln1_router(C, l, false); if (MK_DBL == 13) p_ln1_router(C, l, false, true); if (MK_DBL == 14) p_ln1_router(C, l, false, true, true); if (MK_DBL == 15) p_ln1_router(C, l, false, true, true, true); if (MK_DBL == 16) p_ln1_router(C, l, false, true, false, false, 1); if (MK_DBL == 17) p_ln1_router(C, l, false, true, false, false, 2); if (l > 0) trq_drain(C, l); SEAM(pb + 6); }
        if (IN(pb + 7)) {
            moe_tables(C, l);
            pg8::Gemm g{(const bf16*)(C.ws + WS_X1B), (const bf16*)(C.ws + WS_WGU + (size_t)l * NEXP * 2 * DFF * DMODEL), 0, 0, DMODEL / 2};
            pg8::MoeOrder S{(const LAS int*)(C.lds + LDSCTL_OFF), (const LAS int*)(C.lds + LDSCTL_OFF + 160), (const int*)(C.ws + WS_ROWTOK), 8, C.G, (int)blockIdx.x, NTOK, (LAS unsigned*)(C.lds + LDSX_OFF)};
            pg8::EpiSwiglu E{(bf16*)(C.ws + WS_H), DFF, C.in[I_BGU] + (size_t)l * NEXP * 2 * DFF, DFF, 1.0f / (XQ_SCALE * WQ_SCALE), HQ_SCALE, 0, (const LAS float*)(C.lds + LDSX_OFF + 16384)};
            REP(8) pg8::gemm_phase<pg8::EpiSwiglu, pg8::MoeOrder, true, true, true, true>(C.lds + RING_OFF, g, S, E);
            if (MK_DBL == 21) pg8::gemm_phase<pg8::EpiSwiglu, pg8::MoeOrder, true, true, true, true>(C.lds + RING_OFF, g, S, E);
            if (MK_DBL == 18 || MK_DBL == 19) { pg8::EpiSwiglu E2 = E; E2.dbg = (MK_DBL == 18) ? 2 : 1; pg8::gemm_phase<pg8::EpiSwiglu, pg8::MoeOrder, true, true, true, true>(C.lds + RING_OFF, g, S, E2); }
            SEAMW(pb + 7, MK_TAILITEMS * MOE_IDLE(8, 0));
        }
        if (IN(pb + 8)) {
            if (!IN(pb + 7)) moe_tables(C, l);
            pg8::Gemm g{(const bf16*)(C.ws + WS_H), (const bf16*)(C.ws + WS_WDN + (size_t)l * NEXP * DMODEL * DFF), 0, 0, DFF / 2};
            pg8::MoeOrder S{(const LAS int*)(C.lds + LDSCTL_OFF), (const LAS int*)(C.lds + LDSCTL_OFF + 160), (const int*)(C.ws + WS_ROWTOK), 4, C.G, (int)blockIdx.x, NTOK, (LAS unsigned*)(C.lds + LDSX_OFF), MK_DOWN_XS};
            pg8::EpiFp8 E{(bf16*)(C.ws + WS_Y), DMODEL, C.in[I_BDN] + (size_t)l * NEXP * DMODEL, DMODEL, 0, 1.0f, 1.0f / (HQ_SCALE * WQ_SCALE), 0, 0u, YQ_SCALE, (const LAS float*)(C.lds + LDSX_OFF + 16384)};
            REP(9) pg8::gemm_phase<pg8::EpiFp8, pg8::MoeOrder, true, true, false, true>(C.lds + RING_OFF, g, S, E);
            if (MK_DBL == 20) { pg8::EpiFp8 E2 = E; E2.dbg = 2; pg8::gemm_phase<pg8::EpiFp8, pg8::MoeOrder, true, true, false, true>(C.lds + RING_OFF, g, S, E2); }
            SEAMW(pb + 8, MK_TAILITEMS * MOE_IDLE(4, MK_DOWN_XS));
        }
        if (IN(pb + 9)) { if (!IN(pb + 7)) moe_tables(C, l); REP(10) p_ln2_combine(C, l); SEAM(pb + 9); }
    }
#ifdef MK_PROBE_A
    xcd_barrier(bar);
    if (stamper) { const unsigned long long now_ = wall_clock64(); tacc[10] += now_ - tacc[14]; const float tot = (float)(now_ - tacc[15]);
        __hip_atomic_store((float*)(ctl + 8), (float)tacc[MK_PROBE_A] / tot, __ATOMIC_RELAXED, __HIP_MEMORY_SCOPE_AGENT); __hip_atomic_store((float*)(ctl + 9), (float)tacc[MK_PROBE_B] / tot, __ATOMIC_RELAXED, __HIP_MEMORY_SCOPE_AGENT); }
    xcd_barrier(bar);
    { const float fa = __hip_atomic_load((float*)(ctl + 8), __ATOMIC_RELAXED, __HIP_MEMORY_SCOPE_AGENT), fb = __hip_atomic_load((float*)(ctl + 9), __ATOMIC_RELAXED, __HIP_MEMORY_SCOPE_AGENT);
        const size_t gid = (size_t)blockIdx.x * NTHREADS + threadIdx.x, nth = (size_t)gridDim.x * NTHREADS;
        for (size_t i = gid; i < (size_t)NTOK * DMODEL; i += nth) { float v = C.out[i] * (1.0f + 4.0f * fa); if (i == 0) v += 1000.0f * fb; C.out[i] = v; } }
#endif
#undef IN
#undef SEAM
}

#ifndef MK_MODE
#define MK_MODE 0
#endif
static int mega_grid() {
    static int grid = 0;
    if (grid == 0) {
        int dev = 0, cus = 0, per_cu = 0;
        if (hipGetDevice(&dev) != hipSuccess || hipDeviceGetAttribute(&cus, hipDeviceAttributeMultiprocessorCount, dev) != hipSuccess) { grid = -1; return grid; }
        if (hipFuncSetAttribute((const void*)mega_fwd, hipFuncAttributeMaxDynamicSharedMemorySize, LDS_BYTES) != hipSuccess) { fprintf(stderr, "kernel_launch: hipFuncSetAttribute failed\n"); grid = -1; return grid; }
        if (hipOccupancyMaxActiveBlocksPerMultiprocessor(&per_cu, (const void*)mega_fwd, NTHREADS, LDS_BYTES) != hipSuccess || per_cu < 1) fprintf(stderr, "kernel_launch: occupancy query reports %d\n", per_cu);
        (void)hipGetLastError();
        grid = cus;
    }
    return grid;
}
static void mega_launch(void* const* d_in, float* d_out, unsigned char* ws, hipStream_t stream, int lo, int hi, int li) {
    const int grid = mega_grid(); if (grid <= 0) return;
    Args a{};
    for (int i = 0; i < 21; ++i) a.in[i] = (const float*)d_in[i];
    a.out = d_out; a.ws = ws; a.ph_lo = lo; a.ph_hi = hi; a.li = li; a.pad = 0;
    hipLaunchKernelGGL(mega_fwd, dim3(grid), dim3(NTHREADS), LDS_BYTES, stream, a);
    const hipError_t le = hipPeekAtLastError();
    if (le != hipSuccess) fprintf(stderr, "kernel_launch: launch failed: %s\n", hipGetErrorName(le));
}
extern "C" void kernel_launch(void* const* d_in, const int* in_sizes, int n_in, void* d_out, int out_size, void* d_ws, size_t ws_size, hipStream_t stream) {
    if (n_in != 21 || in_sizes[0] != NTOK * DMODEL || out_size != NTOK * DMODEL || ws_size < WS_END) { fprintf(stderr, "kernel_launch: unexpected shapes (n_in %d, ws %zu)\n", n_in, ws_size); return; }
    unsigned char* ws = (unsigned char*)d_ws;
    if (hipMemsetAsync(ws + WS_CTL, 0, CTL_ZERO_BYTES, stream) != hipSuccess) { fprintf(stderr, "kernel_launch: memset failed\n"); return; }
#if MK_MODE == 0
    mega_launch(d_in, (float*)d_out, ws, stream, 0, NPHASES, 0);
#else
    for (int ph = 0; ph < NPHASES; ++ph) mega_launch(d_in, (float*)d_out, ws, stream, ph, ph + 1, 0);
#endif
}
```

```cpp
#include <hip/hip_runtime.h>
#include <cstdio>
#include <cstdint>
#include <cmath>
namespace pg8 {
#define PG8_LAS __attribute__((address_space(3)))
#ifndef PG8_STORES_IN_FLIGHT
#define PG8_STORES_IN_FLIGHT 0
#endif
#define PG8_NSTORE(n) (PG8_STORES_IN_FLIGHT ? (n) : 0)
typedef unsigned short bf16_t;
typedef short bf16x8 __attribute__((ext_vector_type(8)));
typedef float f32x4 __attribute__((ext_vector_type(4)));
typedef unsigned u32x4 __attribute__((ext_vector_type(4)));
typedef int i32x4_t __attribute__((ext_vector_type(4)));
typedef int i32x8_t __attribute__((ext_vector_type(8)));
constexpr int BM = 256, BK = 64, HALF = 128, HTB = HALF * BK * 2  , STAGE_BYTES = 8 * HTB, NXCD = 8, WGM = 8;

__host__ __device__ __forceinline__ int lds_byte(int r, int c) { const int st = (r >> 4) * 2 + (c >> 5), rr = r & 15, cc = c & 31, ob = rr * 64 + cc * 2; return st * 1024 + (ob ^ (((ob >> 9) & 1) << 5)); }
__host__ __device__ __forceinline__ void stage_rc(int b, int& R, int& C) { const int st = b / 1024, sb = b % 1024, swz = sb ^ (((sb >> 9) & 1) << 5); R = (st >> 1) * 16 + swz / 64; C = (st & 1) * 32 + (swz % 64) / 2; }
__host__ __device__ __forceinline__ int perm32(int rho) { const int n = rho >> 4, i = rho & 15; return 8 * (i >> 2) + 4 * n + (i & 3); }

struct Unit { int pm, pn, e, pnl, nvalid, rbase; };

struct Gemm { const bf16_t* A; const bf16_t* Bt; int M, N, K; };

struct StaticOrder {
    int nM, nN, nwg, G, c; PG8_LAS unsigned* gtab = nullptr;
    __host__ __device__ void init(int M, int N, int G_, int c_) { nM = M / BM; nN = N / BM; nwg = nM * nN; G = G_; c = c_; }
    __host__ __device__ bool next(int i, Unit& u) const {
        const long L = (long)i * G + c; if (L >= nwg) return false;
        int wgid = (int)L; { const int q = nwg / NXCD, r = nwg % NXCD, xcd = wgid % NXCD, off = wgid / NXCD; wgid = (xcd < r ? xcd * (q + 1) : r * (q + 1) + (xcd - r) * q) + off; }
        const int nig = WGM * nN, gid = wgid / nig, fm = gid * WGM, gsz = (nM - fm) < WGM ? (nM - fm) : WGM;
        u.pm = fm + ((wgid % nig) % gsz); u.pn = (wgid % nig) / gsz; u.e = 0; u.pnl = u.pn; u.nvalid = BM; u.rbase = 0; return true;
    }
    __device__ __forceinline__ int arow(const Unit&, int) const { return 0; }
    __device__ __forceinline__ void a_ready(const Unit&) const {}
    __device__ __forceinline__ void done(const Unit&) const {}
};

__device__ __forceinline__ unsigned cvt_pk_bf16(float lo, float hi) { unsigned r; asm volatile("v_cvt_pk_bf16_f32 %0, %1, %2" : "=v"(r) : "v"(lo), "v"(hi)); return r; }
typedef float f32x2 __attribute__((ext_vector_type(2)));
__device__ __forceinline__ f32x2 gelu_pk(f32x2 v) {
    const f32x2 av = __builtin_elementwise_abs(v), d = av * 0.2316418882f + 1.0f;
    f32x2 t; t.x = __builtin_amdgcn_rcpf(d.x); t.y = __builtin_amdgcn_rcpf(d.y);
    f32x2 q = t * 0.5307027145f + (-0.7265760135f); q = q * t + 0.7107068705f; q = q * t + (-0.142248368f); q = q * t + 0.127414796f; q = q * t;
    const f32x2 s = (v * v) * (-0.72134752044f);
    f32x2 e; e.x = __builtin_amdgcn_exp2f(s.x); e.y = __builtin_amdgcn_exp2f(s.y);
    const f32x2 m = v * (q * e), r = v - m;
    f32x2 o; o.x = v.x < 0.f ? m.x : r.x; o.y = v.y < 0.f ? m.y : r.y; return o;
}

template <int ACT  > struct EpiBf16 {
    static constexpr int PERM = 1; static constexpr bool AFTER_DRAIN = false; static_assert(ACT == 0 || ACT == 1, "EpiBf16: ACT is 0 (none) or 1 (gelu_pk)");
    static constexpr int NSTORE = PG8_NSTORE(16); static constexpr bool LDSBIAS = false;
    bf16_t* O; int ldc; const float* bias; int split_cols; size_t split_stride; float scale0;
    float ascale = 1.0f;
    int dbg = 0;
    unsigned cmap = 0u;
    float oscale = 0.0f;
    __device__ __forceinline__ void operator()(const f32x4 (&acc)[2][2][4][2], const Unit& u, int wr, int wc, int fr, int fq) const {
        if (dbg == 2) return;
        const int row0 = u.pm * BM + wr * 64 + fr; int colt = (cmap ? (int)((cmap >> (4 * u.pn)) & 15u) : u.pn) * BM; bf16_t* base = O;
        float sc = 1.f; if (split_cols) { const int t = colt / split_cols; base += (size_t)t * split_stride; colt -= t * split_cols; if (t == 0) sc = scale0; }
        const int col0 = colt + wc * 32 + 8 * fq, bcol0 = u.pn * BM + wc * 32 + 8 * fq;
        f32x4 bv[2][2];
#pragma unroll
        for (int bj = 0; bj < 2; ++bj)
#pragma unroll
            for (int n = 0; n < 2; ++n) bv[bj][n] = bias ? *(const f32x4*)(bias + bcol0 + bj * HALF + 4 * n) : (f32x4){0.f, 0.f, 0.f, 0.f};
#pragma unroll
        for (int ai = 0; ai < 2; ++ai)
#pragma unroll
            for (int m = 0; m < 4; ++m) { bf16_t* rowp = base + (size_t)(row0 + ai * HALF + m * 16) * ldc + col0;
#pragma unroll
                for (int bj = 0; bj < 2; ++bj) {
                    if (ACT == 0 && oscale > 0.f) {
                        const float kq = ascale * oscale; f32x4 a, b;
#pragma unroll
                        for (int i = 0; i < 4; ++i) { a[i] = __builtin_amdgcn_fmed3f(__builtin_fmaf(acc[ai][bj][m][0][i], kq, bv[bj][0][i] * oscale), -448.f, 448.f); b[i] = __builtin_amdgcn_fmed3f(__builtin_fmaf(acc[ai][bj][m][1][i], kq, bv[bj][1][i] * oscale), -448.f, 448.f); }
                        int p = 0, q = 0; p = __builtin_amdgcn_cvt_pk_fp8_f32(a[0], a[1], p, false); p = __builtin_amdgcn_cvt_pk_fp8_f32(a[2], a[3], p, true); q = __builtin_amdgcn_cvt_pk_fp8_f32(b[0], b[1], q, false); q = __builtin_amdgcn_cvt_pk_fp8_f32(b[2], b[3], q, true);
                        typedef int i32x2_f __attribute__((ext_vector_type(2))); *(i32x2_f*)((unsigned char*)base + (size_t)(row0 + ai * HALF + m * 16) * ldc + col0 + bj * HALF) = (i32x2_f){p, q}; continue; }
                    f32x4 v0 = acc[ai][bj][m][0] * ascale + bv[bj][0], v1 = acc[ai][bj][m][1] * ascale + bv[bj][1];
                    if (ACT == 1) { f32x2 a = gelu_pk((f32x2){v0[0], v0[1]}), b = gelu_pk((f32x2){v0[2], v0[3]}), c = gelu_pk((f32x2){v1[0], v1[1]}), d = gelu_pk((f32x2){v1[2], v1[3]});
                        v0 = (f32x4){a.x, a.y, b.x, b.y}; v1 = (f32x4){c.x, c.y, d.x, d.y}; }
                    v0 = v0 * sc; v1 = v1 * sc;
                    if (oscale > 0.f) { f32x4 a = v0 * oscale, b = v1 * oscale;
#pragma unroll
                        for (int i = 0; i < 4; ++i) { a[i] = __builtin_fminf(__builtin_fmaxf(a[i], -448.f), 448.f); b[i] = __builtin_fminf(__builtin_fmaxf(b[i], -448.f), 448.f); }
                        int p = 0, q = 0; p = __builtin_amdgcn_cvt_pk_fp8_f32(a[0], a[1], p, false); p = __builtin_amdgcn_cvt_pk_fp8_f32(a[2], a[3], p, true); q = __builtin_amdgcn_cvt_pk_fp8_f32(b[0], b[1], q, false); q = __builtin_amdgcn_cvt_pk_fp8_f32(b[2], b[3], q, true);
                        typedef int i32x2_t __attribute__((ext_vector_type(2))); *(i32x2_t*)((unsigned char*)base + (size_t)(row0 + ai * HALF + m * 16) * ldc + col0 + bj * HALF) = (i32x2_t){p, q}; }
                    else { u32x4 w; w.x = cvt_pk_bf16(v0[0], v0[1]); w.y = cvt_pk_bf16(v0[2], v0[3]); w.z = cvt_pk_bf16(v1[0], v1[1]); w.w = cvt_pk_bf16(v1[2], v1[3]);
                        *(u32x4*)(rowp + bj * HALF) = w; } } }
    }
};

struct EpiFp8 { static constexpr int ACT = 0;
    static constexpr int PERM = 2; static constexpr bool AFTER_DRAIN = false; static constexpr int NSTORE = PG8_NSTORE(8); static constexpr bool LDSBIAS = true;
    __device__ __forceinline__ const float* bias_src(const Unit& u, int wc, int lane) const { return bias + u.pn * BM + wc * 64 + lane; }
    bf16_t* O; int ldc; const float* bias; int split_cols; size_t split_stride; float scale0;
    float ascale = 1.0f;
    int dbg = 0;
    unsigned cmap = 0u;
    float oscale = 0.0f;
    PG8_LAS const float* lbias = nullptr;
    __device__ __forceinline__ void operator()(const f32x4 (&acc)[2][2][4][2], const Unit& u, int wr, int wc, int fr, int fq) const {
        if (dbg == 2) return;
        const int row0 = u.pm * BM + wr * 64 + fr; int colt = (cmap ? (int)((cmap >> (4 * u.pn)) & 15u) : u.pn) * BM; bf16_t* base = O;
        float sc = 1.f; if (split_cols) { const int t = colt / split_cols; base += (size_t)t * split_stride; colt -= t * split_cols; if (t == 0) sc = scale0; }
        const int col0 = colt + wc * 64 + 16 * fq, bcol0 = u.pn * BM + wc * 64 + 16 * fq;
        f32x4 bv[2][2];
#pragma unroll
        for (int bj = 0; bj < 2; ++bj)
#pragma unroll
            for (int n = 0; n < 2; ++n) bv[bj][n] = lbias ? *(const PG8_LAS f32x4*)(lbias + (wr * 4 + wc) * 64 + 16 * fq + 8 * bj + 4 * n) : (bias ? *(const f32x4*)(bias + bcol0 + 8 * bj + 4 * n) : (f32x4){0.f, 0.f, 0.f, 0.f});
#pragma unroll
        for (int ai = 0; ai < 2; ++ai)
#pragma unroll
            for (int m = 0; m < 4; ++m) { const size_t rowoff = (size_t)(row0 + ai * HALF + m * 16) * ldc + col0;
                if (ACT == 0 && oscale > 0.f) {
                    const float kq = ascale * oscale; int w4[4];
#pragma unroll
                    for (int bj = 0; bj < 2; ++bj)
#pragma unroll
                        for (int n = 0; n < 2; ++n) { float a[4];
#pragma unroll
                            for (int p = 0; p < 2; ++p) { const f32x2 t2 = (f32x2){acc[ai][bj][m][n][2 * p], acc[ai][bj][m][n][2 * p + 1]} * kq + (f32x2){bv[bj][n][2 * p], bv[bj][n][2 * p + 1]} * oscale;
                                a[2 * p] = __builtin_amdgcn_fmed3f(t2.x, -448.f, 448.f); a[2 * p + 1] = __builtin_amdgcn_fmed3f(t2.y, -448.f, 448.f); }
                            int p = 0; p = __builtin_amdgcn_cvt_pk_fp8_f32(a[0], a[1], p, false); p = __builtin_amdgcn_cvt_pk_fp8_f32(a[2], a[3], p, true); w4[2 * bj + n] = p; }
                    *(u32x4*)((unsigned char*)base + rowoff) = (u32x4){(unsigned)w4[0], (unsigned)w4[1], (unsigned)w4[2], (unsigned)w4[3]}; continue; }
                u32x4 wo[2];
#pragma unroll
                for (int bj = 0; bj < 2; ++bj) { f32x4 v0 = acc[ai][bj][m][0] * ascale + bv[bj][0], v1 = acc[ai][bj][m][1] * ascale + bv[bj][1];
                    if (ACT == 1) { f32x2 a = gelu_pk((f32x2){v0[0], v0[1]}), b = gelu_pk((f32x2){v0[2], v0[3]}), c = gelu_pk((f32x2){v1[0], v1[1]}), d = gelu_pk((f32x2){v1[2], v1[3]});
                        v0 = (f32x4){a.x, a.y, b.x, b.y}; v1 = (f32x4){c.x, c.y, d.x, d.y}; }
                    v0 = v0 * sc; v1 = v1 * sc;
                    wo[bj].x = cvt_pk_bf16(v0[0], v0[1]); wo[bj].y = cvt_pk_bf16(v0[2], v0[3]); wo[bj].z = cvt_pk_bf16(v1[0], v1[1]); wo[bj].w = cvt_pk_bf16(v1[2], v1[3]); }
                bf16_t* rowp = base + rowoff; *(u32x4*)rowp = wo[0]; *(u32x4*)(rowp + 8) = wo[1]; }
    }
};

struct EpiSwiglu {
    static constexpr int PERM = 1; static constexpr bool AFTER_DRAIN = false; static constexpr int NSTORE = PG8_NSTORE(8); static constexpr bool LDSBIAS = true;
    bf16_t* H; int ldc; const float* bias; int dff; float ascale; float hscale; int dbg = 0;
    PG8_LAS const float* lbias = nullptr;
    __device__ __forceinline__ const float* bias_src(const Unit& u, int wc, int lane) const { return bias + (size_t)u.e * 2 * dff + u.pnl * HALF + wc * 32 + (lane & 31) + ((lane & 32) ? dff : 0); }
    __device__ __forceinline__ void operator()(const f32x4 (&acc)[2][2][4][2], const Unit& u, int wr, int wc, int fr, int fq) const {
        if (dbg == 2) return;
        const int row0 = u.pm * BM + wr * 64 + fr, hc = u.pnl * HALF + wc * 32 + 8 * fq;
        const float* bg = bias + (size_t)u.e * 2 * dff + hc; const float* bu = bg + dff;
        const float hk = hscale > 0.f ? hscale : 1.0f;
        f32x4 bgv[2], buv[2];
#pragma unroll
        for (int n = 0; n < 2; ++n) { if (lbias) { const PG8_LAS float* lb = lbias + (wr * 4 + wc) * 64 + 8 * fq + 4 * n; bgv[n] = *(const PG8_LAS f32x4*)lb; buv[n] = *(const PG8_LAS f32x4*)(lb + 32); }
            else { bgv[n] = *(const f32x4*)(bg + 4 * n); buv[n] = *(const f32x4*)(bu + 4 * n); } }
#pragma unroll
        for (int ai = 0; ai < 2; ++ai)
#pragma unroll
            for (int m = 0; m < 4; ++m) { bf16_t* rowp = H + (size_t)(row0 + ai * HALF + m * 16) * ldc + hc; float o[8];
#pragma unroll
                for (int n = 0; n < 2; ++n)
#pragma unroll
                    for (int p = 0; p < 2; ++p) {
                        const f32x2 g2 = (f32x2){acc[ai][0][m][n][2 * p], acc[ai][0][m][n][2 * p + 1]} * ascale + (f32x2){bgv[n][2 * p], bgv[n][2 * p + 1]};
                        const f32x2 u2 = (f32x2){acc[ai][1][m][n][2 * p], acc[ai][1][m][n][2 * p + 1]} * ascale + (f32x2){buv[n][2 * p], buv[n][2 * p + 1]};
                        f32x2 gt, up; gt.x = __builtin_fminf(g2.x, 7.0f); gt.y = __builtin_fminf(g2.y, 7.0f); up.x = __builtin_amdgcn_fmed3f(u2.x, -7.0f, 7.0f); up.y = __builtin_amdgcn_fmed3f(u2.y, -7.0f, 7.0f);
                        const f32x2 ee = gt * (-1.702f * 1.4426950408889634f);
                        f32x2 den; den.x = __builtin_amdgcn_exp2f(ee.x); den.y = __builtin_amdgcn_exp2f(ee.y); den = den + 1.0f;
                        f32x2 sg; sg.x = __builtin_amdgcn_rcpf(den.x); sg.y = __builtin_amdgcn_rcpf(den.y);
                        const f32x2 r2 = (up * hk + hk) * (gt * sg);
                        o[4 * n + 2 * p] = r2.x; o[4 * n + 2 * p + 1] = r2.y; }
                if (dbg == 1) { if (o[0] == 123.4567f && o[5] == 7.654f) rowp[0] = 1; continue; }
                if (hscale > 0.f) { int a = 0, b = 0; a = __builtin_amdgcn_cvt_pk_fp8_f32(o[0], o[1], a, false); a = __builtin_amdgcn_cvt_pk_fp8_f32(o[2], o[3], a, true);
                    b = __builtin_amdgcn_cvt_pk_fp8_f32(o[4], o[5], b, false); b = __builtin_amdgcn_cvt_pk_fp8_f32(o[6], o[7], b, true);
                    typedef int i32x2_t __attribute__((ext_vector_type(2))); *(i32x2_t*)((unsigned char*)H + (size_t)(row0 + ai * HALF + m * 16) * ldc + hc) = (i32x2_t){a, b}; }
                else { u32x4 w; w.x = cvt_pk_bf16(o[0], o[1]); w.y = cvt_pk_bf16(o[2], o[3]); w.z = cvt_pk_bf16(o[4], o[5]); w.w = cvt_pk_bf16(o[6], o[7]);
                    *(u32x4*)rowp = w; } }
    }
};
struct MoeOrder {
    const PG8_LAS int* tstart; const PG8_LAS int* cnt; const int* rowtok; int nN, G, c, ntok; PG8_LAS unsigned* gtab;
    int xs = 0;
    __device__ __forceinline__ bool next(int i, Unit& u) const {
        int rt, pnl;
        if (G == 256) { const int x = ((c & 7) + xs) & 7, j = c >> 3, per = 32 / nN; rt = (i * 8 + x) * per + j / nN; pnl = j % nN; }
        else { const int L = i * G + c; rt = L / nN; pnl = L % nN; }
        const int TR = tstart[32]; if (rt >= TR) return false;
        const int ln_ = (int)__builtin_amdgcn_mbcnt_hi(~0u, __builtin_amdgcn_mbcnt_lo(~0u, 0u));
        const int tv_ = tstart[(ln_ & 31) + 1];
        const unsigned long long bal_ = __ballot((ln_ < 31) && (tv_ <= rt));
        int e = __builtin_amdgcn_readfirstlane((int)__popcll(bal_));
        const int lt = rt - tstart[e]; int nv = cnt[e] - lt * BM; nv = nv > BM ? BM : nv;
        u.pm = rt; u.pn = e * nN + pnl; u.e = e; u.pnl = pnl; u.nvalid = __builtin_amdgcn_readfirstlane(nv); u.rbase = __builtin_amdgcn_readfirstlane(e * ntok + lt * BM); return true;
    }
    __device__ __forceinline__ int arow(const Unit& u, int r) const { return rowtok[u.rbase + ((r < u.nvalid) ? r : 0)]; }
    __device__ __forceinline__ const int* aptr(const Unit& u, int r) const { return rowtok + u.rbase + ((r < u.nvalid) ? r : 0); }
    __device__ __forceinline__ void a_ready(const Unit&) const {}
    __device__ __forceinline__ void done(const Unit&) const {}
};

struct PanelStats {
    unsigned* xbuf;
    unsigned* cnt;
    unsigned* tmo;
    int ntn; float eps;
    unsigned code;
    __device__ __forceinline__ bool run(const f32x4 (&v)[2][2][4][2], const Unit& u, int wr, int wc, int fr, int fq, PG8_LAS unsigned char* lds, int wid, int lane) const {
        typedef float f32x2v __attribute__((ext_vector_type(2)));
        PG8_LAS f32x2v* P = (PG8_LAS f32x2v*)lds;
        PG8_LAS f32x2v* S = (PG8_LAS f32x2v*)(lds + 8192);
        PG8_LAS unsigned* flag = (PG8_LAS unsigned*)(lds + 8192 + 2048);
#pragma unroll
        for (int ai = 0; ai < 2; ++ai)
#pragma unroll
            for (int m = 0; m < 4; ++m) {
                float s = 0.f;
#pragma unroll
                for (int bj = 0; bj < 2; ++bj)
#pragma unroll
                    for (int n = 0; n < 2; ++n) { const f32x4 x = v[ai][bj][m][n]; s += (x[0] + x[1]) + (x[2] + x[3]); }
                s += __shfl_xor(s, 16); s += __shfl_xor(s, 32);
                const float mw = s * (1.0f / 64.0f); float q = 0.f;
#pragma unroll
                for (int bj = 0; bj < 2; ++bj)
#pragma unroll
                    for (int n = 0; n < 2; ++n) { const f32x4 d = v[ai][bj][m][n] - mw; q += (d[0] * d[0] + d[1] * d[1]) + (d[2] * d[2] + d[3] * d[3]); }
                q += __shfl_xor(q, 16); q += __shfl_xor(q, 32);
                if (fq == 0) P[(ai * HALF + wr * 64 + m * 16 + fr) * 4 + wc] = (f32x2v){mw, q};
            }
        asm volatile("s_waitcnt lgkmcnt(0)" ::: "memory"); __builtin_amdgcn_s_barrier(); asm volatile("" ::: "memory");
#if defined(BROKEN_EXCHANGE_NO_WAIT)
#warning BROKEN CONTROL BUILD: the row-statistics exchange does not wait; results are wrong by design
        if (blockIdx.x >= 64) { const long long t0_ = clock64(); while (clock64() - t0_ < 60000) __builtin_amdgcn_s_sleep(8); }
#endif
        const int row = wid * 32 + (lane & 31);
        if (lane < 32) {
            const f32x2v a = P[row * 4 + 0], b = P[row * 4 + 1], c = P[row * 4 + 2], d = P[row * 4 + 3];
            const float mt = (a.x + b.x + c.x + d.x) * 0.25f;
            const float da = a.x - mt, db = b.x - mt, dc = c.x - mt, dd = d.x - mt;
            const float m2 = (a.y + b.y) + (c.y + d.y) + 64.0f * ((da * da + db * db) + (dc * dc + dd * dd));
            unsigned long long* slot = (unsigned long long*)xbuf + ((size_t)(u.pm * BM + row) * 4 + u.pn);
            __hip_atomic_store(slot, ((unsigned long long)__float_as_uint(m2) << 32) | __float_as_uint(mt), __ATOMIC_RELAXED, __HIP_MEMORY_SCOPE_AGENT);
        }
        asm volatile("s_waitcnt vmcnt(0)" ::: "memory");
        if (lane == 0) __hip_atomic_fetch_add(cnt + 64 * u.pm, 1u, __ATOMIC_RELAXED, __HIP_MEMORY_SCOPE_AGENT);
        if (wid == 0) {
            bool dead = false; const unsigned long long t0 = __builtin_amdgcn_s_memrealtime(); const unsigned want = 8u * (unsigned)ntn;
            for (;;) {
#if defined(BROKEN_EXCHANGE_NO_WAIT)
                break;
#endif
                if ((unsigned)__builtin_amdgcn_readfirstlane(__hip_atomic_load(cnt + 64 * u.pm, __ATOMIC_RELAXED, __HIP_MEMORY_SCOPE_AGENT)) >= want) break;
                if (__builtin_amdgcn_s_memrealtime() - t0 > 2000000ull) {
                    if (lane == 0) { unsigned expect = 0u; __hip_atomic_compare_exchange_strong(tmo + 1, &expect, code | (unsigned)(u.pm & 0xff), __ATOMIC_RELAXED, __ATOMIC_RELAXED, __HIP_MEMORY_SCOPE_AGENT);
                                     __hip_atomic_store(tmo, 1u, __ATOMIC_RELAXED, __HIP_MEMORY_SCOPE_AGENT); }
                    dead = true; break; }
                __builtin_amdgcn_s_sleep(2);
            }
            __builtin_amdgcn_fence(__ATOMIC_ACQUIRE, "agent");
            if (lane == 0) flag[0] = dead ? 1u : 0u;
        }
        asm volatile("s_waitcnt vmcnt(0) lgkmcnt(0)" ::: "memory"); __builtin_amdgcn_s_barrier(); asm volatile("" ::: "memory");
        const bool bad = flag[0] != 0u;
        if (lane < 32) {
            const unsigned long long* slot = (const unsigned long long*)xbuf + (size_t)(u.pm * BM + row) * 4; float mt[4], m2[4]; float ms = 0.f;
#pragma unroll
            for (int t = 0; t < 4; ++t) { if (t < ntn) { const unsigned long long w = __hip_atomic_load(slot + t, __ATOMIC_RELAXED, __HIP_MEMORY_SCOPE_AGENT); mt[t] = __uint_as_float((unsigned)w); m2[t] = __uint_as_float((unsigned)(w >> 32)); } else { mt[t] = 0.f; m2[t] = 0.f; } ms += mt[t]; }
            const float mean = ms / (float)ntn; float q = 0.f;
#pragma unroll
            for (int t = 0; t < 4; ++t) if (t < ntn) { const float dm = mt[t] - mean; q += m2[t] + 256.0f * dm * dm; }
            S[row] = (f32x2v){mean, 1.0f / sqrtf(q / (256.0f * (float)ntn) + eps)};
        }
        asm volatile("s_waitcnt lgkmcnt(0)" ::: "memory"); __builtin_amdgcn_s_barrier(); asm volatile("" ::: "memory");
        return bad;
    }
};
struct EpiLnRes {
    static constexpr int PERM = 0; static constexpr bool AFTER_DRAIN = true; static constexpr int NSTORE = 0; static constexpr bool LDSBIAS = false;
    const float* base; float* out; int ldc; const float* bias; PanelStats st; unsigned poison;
    __device__ __forceinline__ void fused(f32x4 (&acc)[2][2][4][2], const Unit& u, int wr, int wc, int fr, int fq, PG8_LAS unsigned char* lds, int wid, int lane) const {
        typedef float f32x2v __attribute__((ext_vector_type(2)));
        const PG8_LAS f32x2v* S = (const PG8_LAS f32x2v*)(lds + 8192);
        const int col0 = u.pn * BM + wc * 32 + 4 * fq;
#pragma unroll
        for (int bj = 0; bj < 2; ++bj)
#pragma unroll
            for (int n = 0; n < 2; ++n) { const f32x4 bv = bias ? *(const f32x4*)(bias + col0 + bj * HALF + n * 16) : (f32x4){0.f, 0.f, 0.f, 0.f};
#pragma unroll
                for (int ai = 0; ai < 2; ++ai)
#pragma unroll
                    for (int m = 0; m < 4; ++m) acc[ai][bj][m][n] += bv; }
        f32x4 pre[4][2][2];
#pragma unroll
        for (int m = 0; m < 4; ++m) { const size_t off = (size_t)(u.pm * BM + wr * 64 + m * 16 + fr) * ldc + col0;
#pragma unroll
            for (int bj = 0; bj < 2; ++bj)
#pragma unroll
                for (int n = 0; n < 2; ++n) pre[m][bj][n] = *(const f32x4*)(base + off + bj * HALF + n * 16); }
        const bool bad = st.run(acc, u, wr, wc, fr, fq, lds, wid, lane) || poison != 0u;
        const float qnan = __builtin_nanf("");
#pragma unroll
        for (int ai = 0; ai < 2; ++ai)
#pragma unroll
            for (int m = 0; m < 4; ++m) { const int r = ai * HALF + wr * 64 + m * 16 + fr; const f32x2v sr = S[r]; const size_t off = (size_t)(u.pm * BM + r) * ldc + col0;
#pragma unroll
                for (int bj = 0; bj < 2; ++bj)
#pragma unroll
                    for (int n = 0; n < 2; ++n) { const f32x4 bs = ai == 0 ? pre[m][bj][n] : *(const f32x4*)(base + off + bj * HALF + n * 16); f32x4 o = bs + (acc[ai][bj][m][n] - sr.x) * sr.y;
                        if (bad) o = (f32x4){qnan, qnan, qnan, qnan}; *(f32x4*)(out + off + bj * HALF + n * 16) = o; }
                if (m & 1) asm volatile("" ::: "memory"); }
    }
};
struct EpiLnResLn {
    static constexpr int PERM = 0; static constexpr bool AFTER_DRAIN = true; static constexpr int NSTORE = 0; static constexpr bool LDSBIAS = false;
    const float* base; float* out; bf16_t* xn; int ldc; const float* bias; PanelStats st1, st2; unsigned poison;
    __device__ __forceinline__ void fused(f32x4 (&acc)[2][2][4][2], const Unit& u, int wr, int wc, int fr, int fq, PG8_LAS unsigned char* lds, int wid, int lane) const {
        typedef float f32x2v __attribute__((ext_vector_type(2))); typedef unsigned u32x2v __attribute__((ext_vector_type(2)));
        const PG8_LAS f32x2v* S = (const PG8_LAS f32x2v*)(lds + 8192);
        const int col0 = u.pn * BM + wc * 32 + 4 * fq;
#pragma unroll
        for (int bj = 0; bj < 2; ++bj)
#pragma unroll
            for (int n = 0; n < 2; ++n) { const f32x4 bv = bias ? *(const f32x4*)(bias + col0 + bj * HALF + n * 16) : (f32x4){0.f, 0.f, 0.f, 0.f};
#pragma unroll
                for (int ai = 0; ai < 2; ++ai)
#pragma unroll
                    for (int m = 0; m < 4; ++m) acc[ai][bj][m][n] += bv; }
        bool bad = st1.run(acc, u, wr, wc, fr, fq, lds, wid, lane) || poison != 0u;
        const float qnan = __builtin_nanf("");
#pragma unroll
        for (int ai = 0; ai < 2; ++ai)
#pragma unroll
            for (int m = 0; m < 4; ++m) { const int r = ai * HALF + wr * 64 + m * 16 + fr; const f32x2v sr = S[r]; const size_t off = (size_t)(u.pm * BM + r) * ldc + col0;
#pragma unroll
                for (int bj = 0; bj < 2; ++bj)
#pragma unroll
                    for (int n = 0; n < 2; ++n) { const f32x4 bs = *(const f32x4*)(base + off + bj * HALF + n * 16); acc[ai][bj][m][n] = bs + (acc[ai][bj][m][n] - sr.x) * sr.y; }
                asm volatile("" : "+v"(acc[ai][0][m][0]), "+v"(acc[ai][0][m][1]), "+v"(acc[ai][1][m][0]), "+v"(acc[ai][1][m][1]));
                if (m & 1) asm volatile("" ::: "memory"); }
        const bool bad1 = bad;
        bad = st2.run(acc, u, wr, wc, fr, fq, lds, wid, lane) || bad;
#pragma unroll
        for (int ai = 0; ai < 2; ++ai)
#pragma unroll
            for (int m = 0; m < 4; ++m) { const int r = ai * HALF + wr * 64 + m * 16 + fr; const f32x2v sr = S[r]; const size_t off = (size_t)(u.pm * BM + r) * ldc + col0;
#pragma unroll
                for (int bj = 0; bj < 2; ++bj)
#pragma unroll
                    for (int n = 0; n < 2; ++n) { const f32x4 x1 = acc[ai][bj][m][n]; *(f32x4*)(out + off + bj * HALF + n * 16) = bad1 ? (f32x4){qnan, qnan, qnan, qnan} : x1;
                        const f32x4 o = (x1 - sr.x) * sr.y; u32x2v w; w.x = cvt_pk_bf16(o[0], o[1]); w.y = cvt_pk_bf16(o[2], o[3]);
                        if (bad) { w.x = 0x7fc07fc0u; w.y = 0x7fc07fc0u; } *(u32x2v*)(xn + off + bj * HALF + n * 16) = w; }
                asm volatile("" ::: "memory"); }
    }
};

template <class Epi, class Sched, bool ALIGN_EPI = false, bool SP2 = false, bool GATHER = false, bool FP8 = false>
__device__ __forceinline__ void gemm_phase(PG8_LAS unsigned char* lds, const Gemm g, const Sched& S, const Epi& E) {
    static_assert(!GATHER || SP2, "the gathered-A variant is written for the SP2 loop only");
    int tid_ = threadIdx.x; asm volatile("" : "+v"(tid_));
    const int tid = tid_, wid = __builtin_amdgcn_readfirstlane(tid >> 6), lane = tid & 63, wr = wid >> 2, wc = wid & 3, fr = lane & 15, fq = lane >> 4;
    const int K = g.K, nt = K / BK;
    unsigned voffA[2], voffB[2], voffB2[2][2];
#pragma unroll
    for (int i = 0; i < 2; ++i) { int R, C; stage_rc(tid * 16 + i * 8192, R, C); const int Rb = (Epi::PERM == 1) ? ((R & ~31) + perm32(R & 31)) : R;
        voffA[i] = (unsigned)(R * K + C) * 2u; voffB[i] = (unsigned)(Rb * K + C) * 2u;
        { const int rho = R & 31, n_ = rho >> 4, fq_ = (rho & 15) >> 2, i_ = rho & 3; const int r2 = (Epi::PERM == 3) ? (64 * (R >> 5) + 8 * fq_ + 4 * n_ + i_) : (64 * (R >> 5) + 16 * fq_ + 4 * n_ + i_), hs = (Epi::PERM == 3) ? 32 : 8;
          voffB2[0][i] = (unsigned)(r2 * K + C) * 2u; voffB2[1][i] = (unsigned)((r2 + hs) * K + C) * 2u; } }
#define PG8_GOFF(slot, u) do { int tq_ = threadIdx.x; asm volatile("" : "+v"(tq_)); int gR[2], gC[2]; stage_rc(tq_ * 16, gR[0], gC[0]); stage_rc(tq_ * 16 + 8192, gR[1], gC[1]);     \
        PG8_LAS unsigned* gt_ = S.gtab + (slot) * 2048 + wid * 64;     \
        __builtin_amdgcn_global_load_lds((const unsigned*)S.aptr(u, gR[0]), gt_, 4, 0, 0); __builtin_amdgcn_global_load_lds((const unsigned*)S.aptr(u, gR[1]), gt_ + 512, 4, 0, 0); \
        __builtin_amdgcn_global_load_lds((const unsigned*)S.aptr(u, HALF + gR[0]), gt_ + 1024, 4, 0, 0); __builtin_amdgcn_global_load_lds((const unsigned*)S.aptr(u, HALF + gR[1]), gt_ + 1536, 4, 0, 0); } while (0)
    unsigned gcb[2] = {0u, 0u};
    if constexpr (GATHER) { int r_, c_; stage_rc(tid * 16, r_, c_); gcb[0] = (unsigned)c_ * 2u; stage_rc(tid * 16 + 8192, r_, c_); gcb[1] = (unsigned)c_ * 2u; }
    const unsigned rowB = (unsigned)K * 2u;
    const size_t kstep = (size_t)(BK * 2);
    const size_t hstep = (size_t)HALF * K * 2;
    const size_t tstep = 2 * hstep;
    const unsigned ldsw = (unsigned)wid * 1024u;
    const int aoff = lds_byte(wr * 64 + fr, fq * 8), boff = lds_byte(wc * 32 + fr, fq * 8);
#define PG8_SA(b, h) (((b) * 2 + (h)) * HTB)
#define PG8_SB(b, h) ((4 + (b) * 2 + (h)) * HTB)
#define PG8_STAGE(bufoff, gbase, voff) do { _Pragma("unroll") for (int _i = 0; _i < 2; ++_i) \
        __builtin_amdgcn_global_load_lds((const unsigned*)((const char*)(gbase) + (voff)[_i]), (PG8_LAS unsigned*)(lds + (bufoff) + ldsw + _i * 8192), 16, 0, 0); } while (0)
#define PG8_STAGE_B(bufoff, gbase, h) do { if constexpr (Epi::PERM >= 2) PG8_STAGE(bufoff, gbase, voffB2[h]); else PG8_STAGE(bufoff, (gbase) + (size_t)(h) * hstep, voffB); } while (0)
#define PG8_LDA(dst, b, h) do { _Pragma("unroll") for (int m = 0; m < 4; ++m) { if constexpr (FP8) { dst##8[m].lo = *(const PG8_LAS i32x4_t*)(lds + PG8_SA(b, h) + aoff + m * 2048); dst##8[m].hi = *(const PG8_LAS i32x4_t*)(lds + PG8_SA(b, h) + aoff + m * 2048 + 1024); } \
        else { _Pragma("unroll") for (int k = 0; k < 2; ++k) dst[m][k] = *(const PG8_LAS bf16x8*)(lds + PG8_SA(b, h) + aoff + m * 2048 + k * 1024); } } } while (0)
#define PG8_LDB(dst, b, h) do { _Pragma("unroll") for (int n = 0; n < 2; ++n) { if constexpr (FP8) { dst##8[n].lo = *(const PG8_LAS i32x4_t*)(lds + PG8_SB(b, h) + boff + n * 2048); dst##8[n].hi = *(const PG8_LAS i32x4_t*)(lds + PG8_SB(b, h) + boff + n * 2048 + 1024); } \
        else { _Pragma("unroll") for (int k = 0; k < 2; ++k) dst[n][k] = *(const PG8_LAS bf16x8*)(lds + PG8_SB(b, h) + boff + n * 2048 + k * 1024); } } } while (0)
#define PG8_MMA(ai, bj, At, Bt) do { __builtin_amdgcn_s_setprio(1); \
        if constexpr (FP8) { _Pragma("unroll") for (int m = 0; m < 4; ++m) _Pragma("unroll") for (int n = 0; n < 2; ++n) \
            asm volatile("v_mfma_scale_f32_16x16x128_f8f6f4 %0, %1, %2, %0, %3, %3 op_sel_hi:[0,0,0]" : "+v"(acc[ai][bj][m][n]) : "v"(Bt##8[n]), "v"(At##8[m]), "v"(sc7f)); } \
        else { _Pragma("unroll") for (int m = 0; m < 4; ++m) _Pragma("unroll") for (int n = 0; n < 2; ++n) _Pragma("unroll") for (int k = 0; k < 2; ++k) \
            acc[ai][bj][m][n] = __builtin_amdgcn_mfma_f32_16x16x32_bf16(Bt[n][k], At[m][k], acc[ai][bj][m][n], 0, 0, 0); } \
        __builtin_amdgcn_s_setprio(0); } while (0)
#define PG8_WAIT_V(n) asm volatile("s_waitcnt vmcnt(" #n ")" ::: "memory")
#define PG8_WAIT_V1 do { if (t != 0 || xtra == 0) PG8_WAIT_V(8); else if (xtra == 1) PG8_WAIT_V(9); else if (xtra == 5) PG8_WAIT_V(13); else if (xtra == 9) PG8_WAIT_V(17); else if (xtra == 13) PG8_WAIT_V(21); \
        else if (xtra == 16) PG8_WAIT_V(24); else if (xtra == 8) PG8_WAIT_V(16); else if (xtra == 12) PG8_WAIT_V(20); else if (xtra == 4) PG8_WAIT_V(12); else PG8_WAIT_V(8); } while (0)
#define PG8_WAIT_L(n) asm volatile("s_waitcnt lgkmcnt(" #n ")" ::: "memory")
#define PG8_BAR __builtin_amdgcn_s_barrier()
#define PG8_SCHED __builtin_amdgcn_sched_barrier(0)
    Unit cur, nxt; int ui = 0;
    if (!S.next(0, cur)) return;
    f32x4 acc[2][2][4][2];
#pragma unroll
    for (int a = 0; a < 2; ++a)
#pragma unroll
        for (int b = 0; b < 2; ++b)
#pragma unroll
            for (int m = 0; m < 4; ++m)
#pragma unroll
                for (int n = 0; n < 2; ++n) acc[a][b][m][n] = (f32x4){0.f, 0.f, 0.f, 0.f};
    bf16x8 At[4][2], B0[2][2], B1[2][2]; i32x8_t At8[4], B08[2], B18[2];
    int sc7f = 0x7f7f7f7f; asm volatile("" : "+v"(sc7f));
    const char* cA = (const char*)g.A + (GATHER ? (size_t)0 : (size_t)cur.pm * tstep); const char* cB = (const char*)g.Bt + (size_t)cur.pn * tstep;
    S.a_ready(cur);
    int gslot = 0;
    if constexpr (GATHER) { PG8_GOFF(0, cur); PG8_WAIT_V(0); }
    const size_t hA = GATHER ? (size_t)0 : hstep;
#define PG8_STAGE_A(bufoff, gbase, h, sl) do { if constexpr (GATHER) { const PG8_LAS unsigned* gt_ = S.gtab + (sl) * 2048 + (h) * 1024 + tid; const unsigned o_[2] = {gt_[0] * rowB + gcb[0], gt_[512] * rowB + gcb[1]}; PG8_STAGE(bufoff, gbase, o_); } \
        else PG8_STAGE(bufoff, (gbase) + (size_t)(h) * hA, voffA); } while (0)
    if constexpr (SP2) {
        PG8_STAGE_B(PG8_SB(0, 0), cB, 0); PG8_STAGE_B(PG8_SB(0, 1), cB, 1); PG8_STAGE_A(PG8_SA(0, 0), cA, 0, 0); PG8_STAGE_A(PG8_SA(0, 1), cA, 1, 0);
        if (wr == 1) PG8_BAR;
        PG8_WAIT_V(2); PG8_BAR;
        PG8_STAGE_B(PG8_SB(1, 0), cB + kstep, 0); PG8_STAGE_A(PG8_SA(1, 0), cA + kstep, 0, 0); PG8_STAGE_B(PG8_SB(1, 1), cB + kstep, 1);
        PG8_WAIT_V(6); PG8_BAR;
    } else {
        PG8_STAGE_B(PG8_SB(0, 0), cB, 0); PG8_STAGE(PG8_SA(0, 0), cA, voffA); PG8_STAGE_B(PG8_SB(0, 1), cB, 1); PG8_STAGE(PG8_SA(0, 1), cA + hstep, voffA);
        if (wr == 1) PG8_BAR;
        PG8_WAIT_V(4); PG8_BAR;
        PG8_STAGE_B(PG8_SB(1, 0), cB + kstep, 0); PG8_STAGE(PG8_SA(1, 0), cA + kstep, voffA); PG8_STAGE_B(PG8_SB(1, 1), cB + kstep, 1);
        PG8_WAIT_V(6); PG8_BAR;
    }
    for (;;) {
        const bool has_next = S.next(ui + 1, nxt);
        const char* nA = (has_next && !GATHER) ? (const char*)g.A + (size_t)nxt.pm * tstep : cA; const char* nB = has_next ? (const char*)g.Bt + (size_t)nxt.pn * tstep : cB;
        if constexpr (GATHER) { if (has_next) PG8_GOFF(gslot ^ 1, nxt); }
        bool lbp = false;
        if constexpr (Epi::LDSBIAS) { if (E.lbias) { lbp = true; __builtin_amdgcn_global_load_lds((const unsigned*)E.bias_src(cur, wc, lane), (PG8_LAS unsigned*)(E.lbias + wid * 64), 4, 0, 0); } }
        const int xtra = ((ui > 0 && E.dbg == 0) ? Epi::NSTORE : 0) + ((GATHER && has_next) ? 4 : 0) + (lbp ? 1 : 0);
#pragma unroll 1
        for (int t = 0; t < nt; t += 2) {
            const bool last = (t == nt - 2);
            const char* a1 = cA + (size_t)(t + 1) * kstep;
            const char* a2 = last ? nA : cA + (size_t)(t + 2) * kstep; const char* b2 = last ? nB : cB + (size_t)(t + 2) * kstep;
            const char* a3 = a2 + kstep; const char* b3 = b2 + kstep;
            if (last && has_next) S.a_ready(nxt);
            const int gnx = (last && has_next) ? (gslot ^ 1) : gslot;
            if constexpr (SP2) {
            PG8_LDB(B0, 0, 0); PG8_LDB(B1, 0, 1); PG8_SCHED; PG8_LDA(At, 0, 0); PG8_STAGE_A(PG8_SA(1, 1), a1, 1, gslot);
            PG8_WAIT_V1;
            PG8_WAIT_L(0); PG8_BAR; PG8_MMA(0, 0, At, B0); PG8_MMA(0, 1, At, B1); PG8_BAR; PG8_SCHED;
            PG8_LDA(At, 0, 1); PG8_STAGE_B(PG8_SB(0, 0), b2, 0); PG8_STAGE_B(PG8_SB(0, 1), b2, 1); PG8_STAGE_A(PG8_SA(0, 0), a2, 0, gnx);
            PG8_WAIT_V1;
            PG8_WAIT_L(0); PG8_BAR; PG8_MMA(1, 0, At, B0); PG8_MMA(1, 1, At, B1); PG8_BAR; PG8_SCHED;
            PG8_LDB(B0, 1, 0); PG8_LDB(B1, 1, 1); PG8_SCHED; PG8_LDA(At, 1, 0); PG8_STAGE_A(PG8_SA(0, 1), a2, 1, gnx);
            PG8_WAIT_V(8); PG8_WAIT_L(0); PG8_BAR; PG8_MMA(0, 0, At, B0); PG8_MMA(0, 1, At, B1); PG8_BAR; PG8_SCHED;
            PG8_LDA(At, 1, 1); PG8_STAGE_B(PG8_SB(1, 0), b3, 0); PG8_STAGE_B(PG8_SB(1, 1), b3, 1); PG8_STAGE_A(PG8_SA(1, 0), a3, 0, gnx);
            PG8_WAIT_V(8); PG8_WAIT_L(0); PG8_BAR; PG8_MMA(1, 0, At, B0); PG8_MMA(1, 1, At, B1); PG8_BAR; PG8_SCHED;
            } else {
            PG8_LDB(B0, 0, 0); PG8_SCHED; PG8_LDA(At, 0, 0); PG8_STAGE(PG8_SA(1, 1), a1 + hstep, voffA);
            PG8_WAIT_L(8); PG8_BAR; PG8_WAIT_L(0); PG8_MMA(0, 0, At, B0); PG8_BAR; PG8_SCHED;
            PG8_LDB(B1, 0, 1); PG8_STAGE_B(PG8_SB(0, 0), b2, 0);
            PG8_BAR; PG8_WAIT_L(0); PG8_MMA(0, 1, At, B1); PG8_BAR;
            PG8_LDA(At, 0, 1); PG8_STAGE(PG8_SA(0, 0), a2, voffA);
            PG8_BAR; PG8_WAIT_L(0); PG8_MMA(1, 0, At, B0); PG8_BAR; PG8_SCHED;
            PG8_STAGE_B(PG8_SB(0, 1), b2, 1);
            PG8_WAIT_V(6); PG8_BAR; PG8_MMA(1, 1, At, B1); PG8_BAR;
            PG8_LDB(B0, 1, 0); PG8_SCHED; PG8_LDA(At, 1, 0); PG8_STAGE(PG8_SA(0, 1), a2 + hstep, voffA);
            PG8_WAIT_L(8); PG8_BAR; PG8_WAIT_L(0); PG8_MMA(0, 0, At, B0); PG8_BAR; PG8_SCHED;
            PG8_LDB(B1, 1, 1); PG8_STAGE_B(PG8_SB(1, 0), b3, 0);
            PG8_BAR; PG8_WAIT_L(0); PG8_MMA(0, 1, At, B1); PG8_BAR;
            PG8_LDA(At, 1, 1); PG8_STAGE(PG8_SA(1, 0), a3, voffA);
            PG8_BAR; PG8_WAIT_L(0); PG8_MMA(1, 0, At, B0); PG8_BAR; PG8_SCHED;
            PG8_STAGE_B(PG8_SB(1, 1), b3, 1);
            PG8_WAIT_V(6); PG8_BAR; PG8_MMA(1, 1, At, B1); PG8_BAR;
            }
        }
        if constexpr (ALIGN_EPI) { if (wr == 0) PG8_BAR; }
        if constexpr (FP8) asm volatile("s_nop 15\n\ts_nop 15" ::: "memory");
        if constexpr (!Epi::AFTER_DRAIN) { E(acc, cur, wr, wc, fr, fq); S.done(cur); }
        if (!has_next) break;
#pragma unroll
        for (int a = 0; a < 2; ++a)
#pragma unroll
            for (int b = 0; b < 2; ++b)
#pragma unroll
                for (int m = 0; m < 4; ++m)
#pragma unroll
                    for (int n = 0; n < 2; ++n) acc[a][b][m][n] = (f32x4){0.f, 0.f, 0.f, 0.f};
        cur = nxt; cA = nA; cB = nB; ++ui;
        gslot ^= 1;
        if constexpr (ALIGN_EPI) { if (wr == 1) PG8_BAR; }
    }
    PG8_WAIT_V(0);
    if constexpr (!ALIGN_EPI) { if (wr == 0) PG8_BAR; }
    PG8_BAR;
    if constexpr (Epi::AFTER_DRAIN) { E.fused(acc, cur, wr, wc, fr, fq, lds, wid, lane); S.done(cur); }
#undef PG8_SA
#undef PG8_GOFF
#undef PG8_STAGE_A
#undef PG8_SB
#undef PG8_STAGE
#undef PG8_STAGE_B
#undef PG8_LDA
#undef PG8_LDB
#undef PG8_MMA
#undef PG8_WAIT_V
#undef PG8_WAIT_V1
#undef PG8_WAIT_L
#undef PG8_BAR
#undef PG8_SCHED
}
}
#include <hip/hip_bf16.h>
#include <cmath>
namespace attn_body {
using bf16=__hip_bfloat16;
using bf16x8=__attribute__((ext_vector_type(8)))short;
using s16x4=__attribute__((ext_vector_type(4)))short;
using f32x16=__attribute__((ext_vector_type(16)))float;
using u32x4=__attribute__((ext_vector_type(4)))unsigned;
constexpr int SEQ=4096,D=64,PIN=3072,PO=1024;
constexpr int NW=8,QBLK=32,QB=QBLK*NW,KVBLK=64,NQB=SEQ/QB;
constexpr int ATTN_UNIT_ROWS=QB;
__device__ __forceinline__ int crow(int r,int hi){return (r&3)+8*(r>>2)+4*hi;}
#define SBAR() __builtin_amdgcn_sched_barrier(0)
__device__ __forceinline__ void cmask(f32x16&p0,f32x16&p1,int jb,int qrel,int hi){
  const float NEG=-INFINITY; int kb=64*jb+4*hi;
  #pragma unroll
  for(int r=0;r<16;++r){int kv=kb+(r&3)+8*(r>>2); if(kv>qrel)p0[r]=NEG; if(kv+32>qrel)p1[r]=NEG;}
}

constexpr int NSLOT=3, SLOTB=8192;
constexpr int LDS_K=0, LDS_V=NSLOT*SLOTB, LDS_V2=2*NSLOT*SLOTB, LDS_WS=3*NSLOT*SLOTB, LDS_OST=LDS_WS+NW*64*4, LDS_BYTES=LDS_OST+NW*4096;
constexpr float C2=0.125f*1.4426950408889634f;
__device__ __forceinline__ void glds16(const void*gsrc,unsigned lds_dst){unsigned keep;
  asm volatile("s_mov_b32 %0, m0\n\ts_mov_b32 m0, %2\n\ts_nop 0\n\tglobal_load_lds_dwordx4 %1, off\n\ts_mov_b32 m0, %0":"=&s"(keep):"v"(gsrc),"s"(lds_dst):"memory");}
__device__ __forceinline__ float max3f(float a,float b,float c){float r;asm("v_max3_f32 %0, %1, %2, %3":"=v"(r):"v"(a),"v"(b),"v"(c));return r;}
__device__ __forceinline__ float max2f(float a,float b){float r;asm("v_max_f32_e32 %0, %1, %2":"=v"(r):"v"(a),"v"(b));return r;}
__device__ __forceinline__ float fadd_s(float a,float b){float r;asm("v_add_f32_e32 %0, %1, %2":"=v"(r):"v"(a),"v"(b));return r;}
__device__ __forceinline__ float fsub_s(float a,float b){float r;asm("v_sub_f32_e32 %0, %1, %2":"=v"(r):"v"(a),"v"(b));return r;}
typedef float f32x2_t __attribute__((ext_vector_type(2))); typedef __bf16 bf16x2_t __attribute__((ext_vector_type(2)));
__device__ __forceinline__ unsigned cvtpk_s(float lo,float hi){f32x2_t v={lo,hi};bf16x2_t b=__builtin_convertvector(v,bf16x2_t);return __builtin_bit_cast(unsigned,b);}
#define WAIT_BAR(N) asm volatile("s_waitcnt vmcnt(" #N ") lgkmcnt(0)\n\ts_barrier":::"memory")

__device__ __forceinline__ void qkt(f32x16&p0,f32x16&p1,const char*Kslot,const bf16x8*qr,const f32x16&negm,int r32,int hi){
  const char*kb=Kslot+hi*1024+r32*16;
  #pragma unroll
  for(int d0=0;d0<4;++d0){
    const bf16x8 b0=*reinterpret_cast<const bf16x8*>(kb+d0*2048);
    const bf16x8 b1=*reinterpret_cast<const bf16x8*>(kb+d0*2048+512);
    if(d0==0){p0=__builtin_amdgcn_mfma_f32_32x32x16_bf16(b0,qr[0],negm,0,0,0);p1=__builtin_amdgcn_mfma_f32_32x32x16_bf16(b1,qr[0],negm,0,0,0);}
    else{p0=__builtin_amdgcn_mfma_f32_32x32x16_bf16(b0,qr[d0],p0,0,0,0);p1=__builtin_amdgcn_mfma_f32_32x32x16_bf16(b1,qr[d0],p1,0,0,0);}}
}
typedef __attribute__((address_space(3))) const char* lds_cptr;
typedef short v4i16_t __attribute__((ext_vector_type(4)));
__device__ __forceinline__ void kload8(bf16x8*kf,lds_cptr kp){
  kf[0]=*(const __attribute__((address_space(3))) bf16x8*)(kp);      kf[1]=*(const __attribute__((address_space(3))) bf16x8*)(kp+512);
  kf[2]=*(const __attribute__((address_space(3))) bf16x8*)(kp+2048); kf[3]=*(const __attribute__((address_space(3))) bf16x8*)(kp+2560);
  kf[4]=*(const __attribute__((address_space(3))) bf16x8*)(kp+4096); kf[5]=*(const __attribute__((address_space(3))) bf16x8*)(kp+4608);
  kf[6]=*(const __attribute__((address_space(3))) bf16x8*)(kp+6144); kf[7]=*(const __attribute__((address_space(3))) bf16x8*)(kp+6656);
}
__device__ __forceinline__ void kload2(bf16x8*kf,lds_cptr kp,int j){ kf[2*j]=*(const __attribute__((address_space(3))) bf16x8*)(kp+j*2048); kf[2*j+1]=*(const __attribute__((address_space(3))) bf16x8*)(kp+j*2048+512); }
__device__ __forceinline__ s16x4 vtr(lds_cptr p){ return __builtin_bit_cast(s16x4,__builtin_amdgcn_ds_read_tr16_b64_v4i16((__attribute__((address_space(3))) v4i16_t*)p)); }
__device__ __forceinline__ float rowmax(const f32x16&p0,const f32x16&p1){
  float a=max3f(p0[0],p0[1],p1[0]),b=max3f(p0[2],p0[3],p1[1]);a=max3f(a,p1[2],p1[3]);
  #pragma unroll
  for(int r=4;r<16;r+=4){a=max3f(a,p0[r],p0[r+1]);b=max3f(b,p0[r+2],p0[r+3]);a=max3f(a,p1[r],p1[r+1]);b=max3f(b,p1[r+2],p1[r+3]);}
  const float m=max2f(a,b);
  auto rr=__builtin_amdgcn_permlane32_swap(__float_as_uint(m),__float_as_uint(m),false,false);
  return max2f(__uint_as_float(rr[0]),__uint_as_float(rr[1]));
}
__device__ __forceinline__ void pv(f32x16*o,int vb,bf16x8 pa0,bf16x8 pa1,bf16x8 pa2,bf16x8 pa3){
  #pragma unroll
  for(int d0=0;d0<2;++d0){s16x4 lo[4],hi[4];
    #pragma unroll
    for(int ks=0;ks<4;++ks){
      asm volatile("ds_read_b64_tr_b16 %0,%1 offset:%c2":"=&v"(lo[ks]):"v"(vb),"i"(d0*4096+ks*1024):"memory");
      asm volatile("ds_read_b64_tr_b16 %0,%1 offset:%c2":"=&v"(hi[ks]):"v"(vb),"i"(d0*4096+ks*1024+512):"memory");}
    asm volatile("s_waitcnt lgkmcnt(0)":::"memory");SBAR();
    #define PK(k) (bf16x8){lo[k][0],lo[k][1],lo[k][2],lo[k][3],hi[k][0],hi[k][1],hi[k][2],hi[k][3]}
    o[d0]=__builtin_amdgcn_mfma_f32_32x32x16_bf16(pa0,PK(0),o[d0],0,0,0);
    o[d0]=__builtin_amdgcn_mfma_f32_32x32x16_bf16(pa1,PK(1),o[d0],0,0,0);
    o[d0]=__builtin_amdgcn_mfma_f32_32x32x16_bf16(pa2,PK(2),o[d0],0,0,0);
    o[d0]=__builtin_amdgcn_mfma_f32_32x32x16_bf16(pa3,PK(3),o[d0],0,0,0);
    #undef PK
  }
}

#ifndef ATTN_STORE16
#define ATTN_STORE16(p,v) (*(u32x4*)(p)=(v))
#endif
template<int THRL> __device__ __forceinline__ void attn_unit(int b,int qb,const bf16*Q,const bf16*__restrict__ K,const bf16*__restrict__ V,bf16*O,char*shm,int cmap,float lam,float osc,const float*ng,bf16*M){
  int tid_=threadIdx.x; asm volatile("":"+v"(tid_)); const int tid=tid_,lane=tid&63,r32=lane&31,hi=lane>>5; const int wid=__builtin_amdgcn_readfirstlane(tid>>6);
  const long rowbase=(long)b*SEQ; const int q0=qb*QB;
  const bf16*Qw=Q+(rowbase+q0+wid*QBLK)*PIN;
  const bf16*Kh=K+rowbase*PIN,*Vh=V+rowbase*PIN;
  const unsigned lds0=(unsigned)(uintptr_t)shm;
  float*wsf=(float*)(shm+LDS_WS)+wid*64;
  const unsigned koff=(unsigned)(lane*PIN+wid*8)*2u, voff=(unsigned)((16*(wid&3)+(lane>>2))*PIN+(wid>>2)*32+(lane&3)*8)*2u;
  const unsigned kdst=lds0+LDS_K+wid*1024, vdst=lds0+LDS_V+wid*1024, vdst2=lds0+LDS_V2+wid*1024;
  #define DMA_K(t,slot) glds16((const char*)Kh+(size_t)(t)*(KVBLK*PIN*2)+koff,(unsigned)__builtin_amdgcn_readfirstlane(kdst+(slot)))
  #define DMA_V(t,slot) do{ glds16((const char*)Vh+(size_t)(t)*(KVBLK*PIN*2)+voff,(unsigned)__builtin_amdgcn_readfirstlane(vdst+(slot))); glds16((const char*)Vh+(size_t)(t)*(KVBLK*PIN*2)+128+voff,(unsigned)__builtin_amdgcn_readfirstlane(vdst2+(slot))); }while(0)
  const int vb0=(int)(lds0+LDS_V)+((lane>>4)&1)*32+(lane&3)*8+(4*hi+((lane&15)>>2))*64;
  const char*Kbase=shm+LDS_K; bf16x8 kf[8];
  const lds_cptr shm3=(lds_cptr)shm; const lds_cptr kp0=shm3+LDS_K+hi*1024+r32*16; const lds_cptr vp0=shm3+LDS_V+((lane>>4)&1)*32+(lane&3)*8+(4*hi+((lane&15)>>2))*64;
  const int NT=(q0+QB)/KVBLK;
  DMA_K(0,0);DMA_V(0,0);DMA_K(1,SLOTB);
  bf16x8 qr[4];
  #pragma unroll
  for(int d0=0;d0<4;++d0)qr[d0]=*reinterpret_cast<const bf16x8*>(&Qw[(long)r32*PIN+d0*16+hi*8]);
  const __attribute__((address_space(3))) bf16x8* qld=(const __attribute__((address_space(3))) bf16x8*)(shm3+LDS_OST+wid*4096)+lane;
  #pragma unroll
  for(int d0=0;d0<4;++d0)((__attribute__((address_space(3))) bf16x8*)(shm3+LDS_OST+wid*4096))[d0*64+lane]=qr[d0];
  float mhat=0.f,l_reg=0.f;f32x16 o[2];o[0]=f32x16{};o[1]=f32x16{};f32x16 o2[2];o2[0]=f32x16{};o2[1]=f32x16{}; const f32x16 zero16=f32x16{};
  const int qrel=wid*QBLK+r32;
  #define CMASK(P0,P1,t) do{int jb_=(t)-(NT-4); if(jb_>=0)cmask(P0,P1,jb_,qrel,hi);}while(0)
  bool resc=false;
  #define START(P0,P1) do{ const float rm=rowmax(P0,P1); resc=false; \
    { const float dl=rm; mhat=fadd_s(mhat,dl); \
      _Pragma("unroll") for(int r=0;r<16;++r){P0[r]=fsub_s(P0[r],dl);P1[r]=fsub_s(P1[r],dl);} } \
    _Pragma("unroll") for(int r=0;r<16;++r)P0[r]=__builtin_amdgcn_exp2f(P0[r]); }while(0)
  #define RESC() do{ if(resc){ asm volatile("s_waitcnt lgkmcnt(0)":::"memory"); \
      _Pragma("unroll") for(int d_=0;d_<2;++d_) _Pragma("unroll") for(int r=0;r<16;++r){ const float f_=wsf[crow(r,hi)]; o[d_][r]*=f_; o2[d_][r]*=f_; } } }while(0)
  f32x16 pA0,pA1,pB0,pB1;
  int sl_prev=0,sl_cur=0,sl_next=SLOTB;
  #define ROT() do{sl_prev=sl_cur;sl_cur=sl_next;sl_next=(sl_next==(NSLOT-1)*SLOTB)?0:sl_next+SLOTB;}while(0)
  DMA_K(2,2*SLOTB);
  WAIT_BAR(3);
  qkt(pA0,pA1,Kbase,qr,zero16,r32,hi);asm volatile("s_nop 15\n\ts_nop 7":"+v"(pA0),"+v"(pA1));CMASK(pA0,pA1,0);
  START(pA0,pA1);
  _Pragma("unroll") for(int r=0;r<16;++r)pA1[r]=__builtin_amdgcn_exp2f(pA1[r]);
  WAIT_BAR(0);
  DMA_K(3,0);DMA_V(1,SLOTB);
  ROT();
  kload8(kf,kp0+sl_cur);
  WAIT_BAR(3);
  s16x4 vlo[8],vhi[8]; u32x4 pw0,pw1,pw2,pw3;
  #define PKW(P,B) cvtpk_s(P[B],P[B+1])
  #define PAF(k) __builtin_bit_cast(bf16x8,pw##k)
  #define VFR(i) (bf16x8){vlo[i][0],vlo[i][1],vlo[i][2],vlo[i][3],vhi[i][0],vhi[i][1],vhi[i][2],vhi[i][3]}
  #define PIN(x) asm volatile("":"+v"(x))
  #define MX3(a,b,c) __builtin_fmaxf(__builtin_fmaxf((a),(b)),(c))
  #define GAPA(MF,A0,A1,A2,A3,W0,W1,PW) do{ MF; sacc+=A0; sacc+=A1; sacc+=A2; sacc+=A3; PIN(sacc); W0; W1; PIN(PW); SBAR(); }while(0)
  #define EX(v) __builtin_amdgcn_exp2f(v)
  #define GAPB(MF,X,B) do{ MF; X[B]=EX(X[B]-mhat); X[B+1]=EX(X[B+1]-mhat); PIN(X); SBAR(); }while(0)
  #define VRD(i) do{ vlo[i]=vtr(vp_+(((i)>>2)*4096+((i)&3)*1024)); vhi[i]=vtr(vp_+(((i)>>2)*4096+((i)&3)*1024+512)); }while(0)
  #define KRD(G,j) do{ if(G){ kload2(kf,kp0+sl_next,j); SBAR(); } }while(0)
  #define V2RD(i) do{ vlo[i]=vtr(vq_+(((i)>>2)*4096+((i)&3)*1024)); vhi[i]=vtr(vq_+(((i)>>2)*4096+((i)&3)*1024+512)); }while(0)
  #define STEP(C0,C1,P0,P1,t,GK,GV,GL) do{ SBAR(); \
    const lds_cptr vp_=vp0+sl_prev; \
    const bf16x8 q0_=qld[0],q1_=qld[64],q2_=qld[128],q3_=qld[192];     \
    VRD(0); SBAR(); float sacc=(P0[0]+P0[1]); \
    GAPA(C0=__builtin_amdgcn_mfma_f32_32x32x16_bf16(kf[0],q0_,zero16,0,0,0), P0[2],P0[3],P0[4],P0[5],     pw0[0]=PKW(P0,0), pw0[1]=PKW(P0,2), pw0); \
    VRD(4); SBAR(); GAPA(C1=__builtin_amdgcn_mfma_f32_32x32x16_bf16(kf[1],q0_,zero16,0,0,0), P0[6],P0[7],P0[8],P0[9],     pw0[2]=PKW(P0,4), pw0[3]=PKW(P0,6), pw0); \
    VRD(1); SBAR(); GAPA(C0=__builtin_amdgcn_mfma_f32_32x32x16_bf16(kf[2],q1_,C0,0,0,0),   P0[10],P0[11],P0[12],P0[13], pw1[0]=PKW(P0,8), pw1[1]=PKW(P0,10), pw1); \
    VRD(5); SBAR(); GAPA(C1=__builtin_amdgcn_mfma_f32_32x32x16_bf16(kf[3],q1_,C1,0,0,0),   P0[14],P0[15],P1[0],P1[1],   pw1[2]=PKW(P0,12),pw1[3]=PKW(P0,14), pw1); \
    VRD(2); SBAR(); GAPA(C0=__builtin_amdgcn_mfma_f32_32x32x16_bf16(kf[4],q2_,C0,0,0,0),   P1[2],P1[3],P1[4],P1[5],     pw2[0]=PKW(P1,0), pw2[1]=PKW(P1,2), pw2); \
    VRD(6); SBAR(); GAPA(C1=__builtin_amdgcn_mfma_f32_32x32x16_bf16(kf[5],q2_,C1,0,0,0),   P1[6],P1[7],P1[8],P1[9],     pw2[2]=PKW(P1,4), pw2[3]=PKW(P1,6), pw2); \
    VRD(3); SBAR(); GAPA(C0=__builtin_amdgcn_mfma_f32_32x32x16_bf16(kf[6],q3_,C0,0,0,0),   P1[10],P1[11],P1[12],P1[13], pw3[0]=PKW(P1,8), pw3[1]=PKW(P1,10), pw3); \
    VRD(7); SBAR(); GAPA(C1=__builtin_amdgcn_mfma_f32_32x32x16_bf16(kf[7],q3_,C1,0,0,0),   P1[14],P1[15],0.f,0.f,       pw3[2]=PKW(P1,12),pw3[3]=PKW(P1,14), pw3); \
    l_reg+=sacc; \
    if(GK){DMA_K((t)+3,sl_cur);} if(GV){DMA_V((t)+1,sl_next);} \
    CMASK(C0,C1,t); \
    { float a=MX3(C0[0],C0[1],C1[0]),b=MX3(C0[2],C0[3],C1[1]); a=MX3(a,C1[2],C1[3]); \
      _Pragma("unroll") for(int r=4;r<16;r+=4){a=MX3(a,C0[r],C0[r+1]);b=MX3(b,C0[r+2],C0[r+3]);a=MX3(a,C1[r],C1[r+1]);b=MX3(b,C1[r+2],C1[r+3]);} \
      float rm=__builtin_fmaxf(a,b); { auto rr=__builtin_amdgcn_permlane32_swap(__float_as_uint(rm),__float_as_uint(rm),false,false); rm=__builtin_fmaxf(__uint_as_float(rr[0]),__uint_as_float(rr[1])); } \
      rm-=mhat; resc=false; \
      if(__builtin_expect(__any(rm>(float)THRL),0)){ const float dl=__builtin_fmaxf(rm,0.f); mhat+=dl; \
        const float f=__builtin_amdgcn_exp2f(-dl); l_reg*=f; if(hi==0)wsf[r32]=f; resc=true; } } \
    SBAR(); \
    const lds_cptr vq_=vp0+(LDS_V2-LDS_V)+sl_prev;     \
    GAPB(o[0]=__builtin_amdgcn_mfma_f32_32x32x16_bf16(PAF(0),VFR(0),o[0],0,0,0), C0,0); \
    GAPB(o[1]=__builtin_amdgcn_mfma_f32_32x32x16_bf16(PAF(0),VFR(4),o[1],0,0,0), C0,2); V2RD(0); V2RD(4); SBAR(); \
    KRD(GL,0); GAPB(o[0]=__builtin_amdgcn_mfma_f32_32x32x16_bf16(PAF(1),VFR(1),o[0],0,0,0), C0,4); \
    KRD(GL,1); GAPB(o[1]=__builtin_amdgcn_mfma_f32_32x32x16_bf16(PAF(1),VFR(5),o[1],0,0,0), C0,6); V2RD(1); V2RD(5); SBAR(); \
    KRD(GL,2); GAPB(o[0]=__builtin_amdgcn_mfma_f32_32x32x16_bf16(PAF(2),VFR(2),o[0],0,0,0), C0,8); \
    KRD(GL,3); GAPB(o[1]=__builtin_amdgcn_mfma_f32_32x32x16_bf16(PAF(2),VFR(6),o[1],0,0,0), C0,10); V2RD(2); V2RD(6); SBAR(); \
    GAPB(o[0]=__builtin_amdgcn_mfma_f32_32x32x16_bf16(PAF(3),VFR(3),o[0],0,0,0), C0,12); \
    GAPB(o[1]=__builtin_amdgcn_mfma_f32_32x32x16_bf16(PAF(3),VFR(7),o[1],0,0,0), C0,14); V2RD(3); V2RD(7); SBAR(); \
    {     \
      GAPB(o2[0]=__builtin_amdgcn_mfma_f32_32x32x16_bf16(PAF(0),VFR(0),o2[0],0,0,0), C1,0); GAPB(o2[1]=__builtin_amdgcn_mfma_f32_32x32x16_bf16(PAF(0),VFR(4),o2[1],0,0,0), C1,2); \
      GAPB(o2[0]=__builtin_amdgcn_mfma_f32_32x32x16_bf16(PAF(1),VFR(1),o2[0],0,0,0), C1,4); GAPB(o2[1]=__builtin_amdgcn_mfma_f32_32x32x16_bf16(PAF(1),VFR(5),o2[1],0,0,0), C1,6); \
      GAPB(o2[0]=__builtin_amdgcn_mfma_f32_32x32x16_bf16(PAF(2),VFR(2),o2[0],0,0,0), C1,8); GAPB(o2[1]=__builtin_amdgcn_mfma_f32_32x32x16_bf16(PAF(2),VFR(6),o2[1],0,0,0), C1,10); \
      GAPB(o2[0]=__builtin_amdgcn_mfma_f32_32x32x16_bf16(PAF(3),VFR(3),o2[0],0,0,0), C1,12); GAPB(o2[1]=__builtin_amdgcn_mfma_f32_32x32x16_bf16(PAF(3),VFR(7),o2[1],0,0,0), C1,14); } \
    }while(0)
  int t=1;
  #undef CMASK
  #define CMASK(P0,P1,t) do{}while(0)
  for(;t+5<NT;t+=2){
    STEP(pB0,pB1,pA0,pA1,t,true,true,true);     WAIT_BAR(3); RESC(); ROT();
    STEP(pA0,pA1,pB0,pB1,t+1,true,true,true);   WAIT_BAR(3); RESC(); ROT();
  }
  #undef CMASK
  #define CMASK(P0,P1,t) do{int jb_=(t)-(NT-4); if(jb_>=0)cmask(P0,P1,jb_,qrel,hi);}while(0)
  #define ENDW(tt) do{ if((tt)+3<NT){WAIT_BAR(3);} else if((tt)+2<NT){WAIT_BAR(2);} else {WAIT_BAR(0);} }while(0)
  for(;t+1<NT;t+=2){
    STEP(pB0,pB1,pA0,pA1,t,(t+3<NT),(t+1<NT),(t+1<NT));       ENDW(t);   RESC(); ROT();
    STEP(pA0,pA1,pB0,pB1,t+1,(t+4<NT),(t+2<NT),(t+2<NT));     ENDW(t+1); RESC(); ROT();
  }
  STEP(pB0,pB1,pA0,pA1,NT-1,false,false,false); RESC();
  { float sacc=pB0[0]+pB0[1]; _Pragma("unroll") for(int r=2;r<16;++r)sacc+=pB0[r]; _Pragma("unroll") for(int r=0;r<16;++r)sacc+=pB1[r]; l_reg+=sacc;
    pw0=(u32x4){PKW(pB0,0),PKW(pB0,2),PKW(pB0,4),PKW(pB0,6)};pw1=(u32x4){PKW(pB0,8),PKW(pB0,10),PKW(pB0,12),PKW(pB0,14)};pw2=(u32x4){PKW(pB1,0),PKW(pB1,2),PKW(pB1,4),PKW(pB1,6)};pw3=(u32x4){PKW(pB1,8),PKW(pB1,10),PKW(pB1,12),PKW(pB1,14)};
    SBAR(); pv(o,vb0+sl_cur,PAF(0),PAF(1),PAF(2),PAF(3)); pv(o2,vb0+(LDS_V2-LDS_V)+sl_cur,PAF(0),PAF(1),PAF(2),PAF(3)); }
  #undef PKW
  #undef PAF
  #undef VFR
  #undef PIN
  #undef MX3
  #undef GAPA
  #undef GAPB
  #undef EX
  #undef VRD
  #undef KRD
  #undef V2RD
  #undef STEP
  #undef ENDW
  {auto rr=__builtin_amdgcn_permlane32_swap(__float_as_uint(l_reg),__float_as_uint(l_reg),false,false);l_reg=__uint_as_float(rr[0])+__uint_as_float(rr[1]);}
  if(hi==0)wsf[32+r32]=l_reg;asm volatile("s_waitcnt lgkmcnt(0)":::"memory");
  float rli[16];
  #pragma unroll
  for(int r=0;r<16;++r)rli[r]=__builtin_amdgcn_rcpf(wsf[32+crow(r,hi)]);
  bf16*Ow=O+(rowbase+q0+wid*QBLK)*PO;
  { bf16*stg=(bf16*)(shm+LDS_OST)+wid*2048;
    if(cmap==0){
      #pragma unroll
      for(int hf=0;hf<2;++hf){
        #pragma unroll
        for(int r=0;r<16;++r){const int orow=crow(r,hi);
          #pragma unroll
          for(int d0=0;d0<2;++d0)stg[orow*64+d0*32+r32]=__float2bfloat16((hf?o2[d0][r]:o[d0][r])*rli[r]);}
        asm volatile("s_waitcnt lgkmcnt(0)":::"memory");
        #pragma unroll
        for(int i=0;i<4;++i){const int row=i*8+(lane>>3),ch=lane&7; const u32x4 v=*(const u32x4*)(stg+row*64+ch*8); ATTN_STORE16(Ow+(long)row*PO+hf*64+ch*8,v);}
        asm volatile("s_waitcnt lgkmcnt(0)":::"memory"); }
    } else {
      asm volatile("s_waitcnt vmcnt(0)":::"memory");
      float dd[2][4][8]; const int ch=lane&7;
      #pragma unroll
      for(int hf=0;hf<2;++hf){
        #pragma unroll
        for(int r=0;r<16;++r){const int orow=crow(r,hi);
          #pragma unroll
          for(int d0=0;d0<2;++d0)stg[orow*64+d0*32+r32]=__float2bfloat16((hf?o2[d0][r]:o[d0][r])*rli[r]);}
        asm volatile("s_waitcnt lgkmcnt(0)":::"memory");
        #pragma unroll
        for(int i=0;i<4;++i){const int row=i*8+(lane>>3); const u32x4 v1=*(const u32x4*)(stg+row*64+ch*8); const u32x4 v0=*(const u32x4*)(Ow+(long)row*PO+hf*64+ch*8);
          #pragma unroll
          for(int j=0;j<4;++j){ dd[hf][i][2*j]=__uint_as_float(v0[j]<<16)-lam*__uint_as_float(v1[j]<<16); dd[hf][i][2*j+1]=__uint_as_float(v0[j]&0xffff0000u)-lam*__uint_as_float(v1[j]&0xffff0000u); } }
        asm volatile("s_waitcnt lgkmcnt(0)":::"memory"); }
      float gg[2][8];
      #pragma unroll
      for(int hf=0;hf<2;++hf){ const float4 a=*(const float4*)(ng+hf*64+ch*8), c4=*(const float4*)(ng+hf*64+ch*8+4); gg[hf][0]=a.x;gg[hf][1]=a.y;gg[hf][2]=a.z;gg[hf][3]=a.w;gg[hf][4]=c4.x;gg[hf][5]=c4.y;gg[hf][6]=c4.z;gg[hf][7]=c4.w; }
      bf16*Mw=M+(rowbase+q0+wid*QBLK)*PO;
      #pragma unroll
      for(int i=0;i<4;++i){ float ss=0.f;
        #pragma unroll
        for(int hf=0;hf<2;++hf)
          #pragma unroll
          for(int j=0;j<8;++j)ss+=dd[hf][i][j]*dd[hf][i][j];
        ss+=__shfl_xor(ss,1);ss+=__shfl_xor(ss,2);ss+=__shfl_xor(ss,4);
        const float rr=osc/sqrtf(ss*(1.0f/128.0f)+1e-5f); const int row=i*8+(lane>>3);
        #pragma unroll
        for(int hf=0;hf<2;++hf){ u32x4 w;
          #pragma unroll
          for(int j=0;j<4;++j)w[j]=cvtpk_s(dd[hf][i][2*j]*rr*gg[hf][2*j],dd[hf][i][2*j+1]*rr*gg[hf][2*j+1]);
          ATTN_STORE16(Mw+(long)row*PO+hf*64+ch*8,w); } }
    } }
  asm volatile("s_waitcnt lgkmcnt(0)\n\ts_barrier":::"memory");
  #undef DMA_K
  #undef DMA_V
  #undef CMASK
  #undef START
  #undef RESC
  #undef ROT
}
constexpr int ATTN_LDS_BYTES=LDS_BYTES;
__device__ __forceinline__ void attn_phase(char*lds,const bf16*proj,bf16*O,bf16*M,const float*ng,float lam,float osc,int vcu){
  const int bh=vcu>>3, s=vcu&7, b=bh>>2, h=bh&3;
  const bf16*V=proj+1024+h*128; bf16*Oc=O+h*128; bf16*Mc=M+h*128;
  for(int i=0;i<2;++i){ const int qb=i?15-s:s;
    for(int c=0;c<2;++c) attn_unit<8>(b,qb,proj+h*128+c*64,proj+512+h*128+c*64,V,Oc,lds,c,lam,osc,ng,Mc); }
}
#undef SBAR
#undef WAIT_BAR
}
#define GAS __attribute__((address_space(1)))
#define LAS __attribute__((address_space(3)))
typedef unsigned short bf16;
typedef unsigned v4u __attribute__((ext_vector_type(4)));
typedef float f32x4 __attribute__((ext_vector_type(4)));
typedef short bf16x8 __attribute__((ext_vector_type(8)));
typedef GAS unsigned gu32;
typedef GAS unsigned long long gu64;
#define RLX_AGENT __ATOMIC_RELAXED, __HIP_MEMORY_SCOPE_AGENT
#define LDS_WAIT() asm volatile("s_waitcnt lgkmcnt(0)" ::: "memory")
#define VM_WAIT() asm volatile("s_waitcnt vmcnt(0)" ::: "memory")
__device__ __forceinline__ unsigned long long rt() { return __builtin_amdgcn_s_memrealtime(); }
typedef float f32x2_cv __attribute__((ext_vector_type(2))); typedef __bf16 bf16x2_cv __attribute__((ext_vector_type(2)));
__device__ __forceinline__ unsigned pk2(float lo, float hi) { const f32x2_cv v = {lo, hi}; const bf16x2_cv b = __builtin_convertvector(v, bf16x2_cv); return __builtin_bit_cast(unsigned, b); }
__device__ __forceinline__ unsigned f2bf(float f) { return pk2(f, 0.f) & 0xffffu; }

#define XB_TMO      128
#define XB_XCNT(j)  (256  + 64 * (j))
#define XB_XSUB(j)  (1280 + 64 * (j))
#define XB_XGEN(j)  (2304 + 64 * (j))
#define XB_TOP      3328
#define XB_TOPGEN   3392
#define XCD_BAR_WORDS 3456
#define XB_SPIN_CAP (1u << 18)

__device__ __forceinline__ unsigned xb_ld(unsigned* p)              { return __hip_atomic_load(p, __ATOMIC_RELAXED, __HIP_MEMORY_SCOPE_AGENT); }
__device__ __forceinline__ unsigned xb_add(unsigned* p, unsigned v) { return __hip_atomic_fetch_add(p, v, __ATOMIC_RELAXED, __HIP_MEMORY_SCOPE_AGENT); }
__device__ __forceinline__ unsigned xb_xcc_id() { return (unsigned)__builtin_amdgcn_s_getreg((3 << 11) | 20) & 0xFu; }
#define XB_SPIN(cond, bar) do { unsigned _sp = 0; while (cond) { __builtin_amdgcn_s_sleep(1); \
    if ((++_sp & 255u) == 0u) { if (xb_ld(&(bar)[XB_TMO])) break; if (_sp > XB_SPIN_CAP) { atomicAdd(&(bar)[XB_TMO], 1u); break; } } } } while (0)

struct XcdBarrier {
    unsigned* bar; unsigned x;
    volatile LAS unsigned* st;
};

__device__ __forceinline__ XcdBarrier xcd_barrier_post(unsigned* bar, volatile LAS unsigned* st) {
    XcdBarrier b; b.bar = bar; b.x = xb_xcc_id(); b.st = st;
    if (threadIdx.x == 0) (void)xb_add(&bar[XB_XCNT(b.x)], 1u);
    return b;
}
__device__ __forceinline__ void xcd_barrier_complete(unsigned* bar, unsigned x, unsigned& nloc, unsigned& nx) {
    const unsigned G = gridDim.x * gridDim.y * gridDim.z;
    unsigned sum, cnt, mine, sp = 0u;
    for (;;) {
        sum = 0u; cnt = 0u; mine = 0u;
#pragma unroll
        for (unsigned j = 0; j < 16; ++j) { const unsigned c = xb_ld(&bar[XB_XCNT(j)]); sum += c; cnt += (c > 0u) ? 1u : 0u; mine = (j == x) ? c : mine; }
        if (sum == G) break;
        __builtin_amdgcn_s_sleep(1);
        if ((++sp & 255u) == 0u) { if (xb_ld(&bar[XB_TMO])) break; if (sp > XB_SPIN_CAP) { atomicAdd(&bar[XB_TMO], 1u); break; } }
    }
    nloc = mine > 0u ? mine : 1u; nx = cnt > 0u ? cnt : 1u;
}

__device__ __forceinline__ void xcd_barrier(const XcdBarrier& b) {
    asm volatile("s_waitcnt vmcnt(0)" ::: "memory");
    __syncthreads();
    if (threadIdx.x == 0) {
        unsigned* bar = b.bar;
        __builtin_amdgcn_s_waitcnt(0);
        unsigned nloc = b.st[0], nx = b.st[1];
        if (nloc == 0u) { xcd_barrier_complete(bar, b.x, nloc, nx); b.st[0] = nloc; b.st[1] = nx; }
        const unsigned old = xb_add(&bar[XB_XSUB(b.x)], 1u);
        const unsigned gen = old / nloc;
        if (old + 1u == (gen + 1u) * nloc) {
            __builtin_amdgcn_fence(__ATOMIC_RELEASE, "agent");
            asm volatile("s_waitcnt vmcnt(0)" ::: "memory");
            const unsigned og = xb_add(&bar[XB_TOP], 1u);
            const unsigned tg = og / nx;
            if (og + 1u == (tg + 1u) * nx) xb_add(&bar[XB_TOPGEN], 1u);
            else XB_SPIN(xb_ld(&bar[XB_TOPGEN]) == tg, bar);
            __builtin_amdgcn_fence(__ATOMIC_ACQUIRE, "agent");
            xb_add(&bar[XB_XGEN(b.x)], 1u);
            asm volatile("s_waitcnt vmcnt(0)" ::: "memory");
        } else {
            XB_SPIN(xb_ld(&bar[XB_XGEN(b.x)]) == gen, bar);
            __builtin_amdgcn_fence(__ATOMIC_ACQUIRE, "agent");
            asm volatile("s_waitcnt vmcnt(0)" ::: "memory");
        }
    }
    __syncthreads();
}
constexpr int NWAVES = 8, NTHREADS = NWAVES * 64;
constexpr int BATCH = 8, SEQ = 4096, NTOK = BATCH * SEQ, DMODEL = 1024, INW = 3080, NPROJ = 3072, DEPTH = 4;
constexpr int NEXP = 32, DFF = 1024, CHUNK = 64, NCH = SEQ / CHUNK, NBH = BATCH * 4;
constexpr int MAXRT = (NTOK * 4) / 256 + NEXP;
constexpr float DN_ALPHA = 1.681792830507429f, LN_EPS = 1e-5f, RMS_EPS = 1e-5f;
constexpr int NPH_LAYER = 10, NPHASES = 1 + DEPTH * NPH_LAYER;

constexpr size_t MiB = 1u << 20;
constexpr size_t WS_CTL = 0, CTL_ZERO_BYTES = 1 * MiB;
constexpr size_t WS_WIN = 2 * MiB;
#ifndef MK_SIDEJOB
#define MK_SIDEJOB 0
#endif
#ifndef MK_X1R8
#define MK_X1R8 1
#endif
constexpr float X1R_SCALE = 128.0f;
#ifndef MK_OUTFP8
#define MK_OUTFP8 0
#endif
constexpr float MQ_SCALE = 16.0f, MQ_ML = 2.0f;
constexpr size_t WS_WOUT = WS_WIN + 24 * MiB;
constexpr size_t WS_WGU = WS_WOUT + 8 * MiB;
constexpr size_t WS_WDN = WS_WGU + 512 * MiB;
constexpr size_t WS_XRES = WS_WDN + 256 * MiB;
constexpr size_t WS_X1 = WS_XRES + 128 * MiB;
constexpr size_t WS_XB = WS_X1 + 128 * MiB;
constexpr size_t WS_X1B = WS_XB + 64 * MiB;
constexpr size_t WS_PROJ = WS_X1B + 64 * MiB;
constexpr size_t WS_G = WS_PROJ + 192 * MiB;
constexpr size_t WS_ATTO = WS_G + 1 * MiB;
constexpr size_t WS_MIXIN = WS_ATTO + 64 * MiB;
constexpr size_t WS_MIXO = WS_MIXIN + 64 * MiB;
constexpr size_t WS_CST = WS_MIXO + 64 * MiB;
constexpr size_t WS_NST = WS_CST + 64 * MiB;
constexpr size_t WS_MISC = WS_NST + 1 * MiB;
constexpr size_t WS_WRP = WS_MISC + 512 * 1024;
constexpr size_t WS_TOKE = WS_MISC + 1 * MiB;
constexpr size_t WS_TOKP = WS_TOKE + 1 * MiB;
constexpr size_t WS_TOKG = WS_TOKP + 1 * MiB;
constexpr size_t WS_ROWTOK = WS_TOKG + 1 * MiB;
constexpr size_t WS_H = WS_ROWTOK + 4 * MiB;
constexpr size_t WS_Y = WS_H + 272 * MiB;
constexpr size_t WS_WINQ = WS_Y + 272 * MiB;
constexpr size_t WS_XQ = WS_WINQ + 8 * MiB;
constexpr size_t WS_END = WS_XQ + 32 * MiB;
static_assert((size_t)MAXRT * 256 * 1024 * 2 <= 272 * MiB, "H/Y size");
constexpr int CW_TMO = 0, CW_CODE = 1, CW_BAR = 4096, MAX_BAR_REGIONS = 48, CW_CNT = 200000;
static_assert(CW_BAR + MAX_BAR_REGIONS * 3456 <= CW_CNT && (CW_CNT + 64 * DEPTH) * 4 <= (int)CTL_ZERO_BYTES, "CTL map");
constexpr int RING_OFF = 0, RING_BYTES = 131072;
constexpr int LDSCTL_OFF = RING_BYTES;
constexpr int MISC_OFF = LDSCTL_OFF + 320;
constexpr int LDSX_OFF = LDSCTL_OFF + 512;
constexpr int LDS_BYTES = 163840;

typedef unsigned v2u __attribute__((ext_vector_type(2)));
__device__ __forceinline__ float bflo(unsigned w) { return __uint_as_float(w << 16); }
__device__ __forceinline__ float bfhi(unsigned w) { return __uint_as_float(w & 0xffff0000u); }
__device__ __forceinline__ void unpack8(const v4u w, float* o) { o[0] = bflo(w.x); o[1] = bfhi(w.x); o[2] = bflo(w.y); o[3] = bfhi(w.y); o[4] = bflo(w.z); o[5] = bfhi(w.z); o[6] = bflo(w.w); o[7] = bfhi(w.w); }
constexpr float XQ_SCALE = 8.0f, WQ_SCALE = 512.0f, HQ_SCALE = 8.0f, YQ_SCALE = 64.0f, XLO_SCALE = 4096.0f;
#ifndef MK_XLO
#define MK_XLO 0
#endif
constexpr bool USE_XLO = (MK_XLO != 0);
__device__ __forceinline__ v2u pack8_fp8(const float* o, float sc) { int a = 0, b = 0; a = __builtin_amdgcn_cvt_pk_fp8_f32(o[0] * sc, o[1] * sc, a, false); a = __builtin_amdgcn_cvt_pk_fp8_f32(o[2] * sc, o[3] * sc, a, true);
    b = __builtin_amdgcn_cvt_pk_fp8_f32(o[4] * sc, o[5] * sc, b, false); b = __builtin_amdgcn_cvt_pk_fp8_f32(o[6] * sc, o[7] * sc, b, true); return (v2u){(unsigned)a, (unsigned)b}; }
__device__ __forceinline__ v4u pack8(const float* o) { v4u w; w.x = pk2(o[0], o[1]); w.y = pk2(o[2], o[3]); w.z = pk2(o[4], o[5]); w.w = pk2(o[6], o[7]); return w; }
#define DPPF_(old, v, ctrl, rm) __builtin_bit_cast(float, __builtin_amdgcn_update_dpp(__builtin_bit_cast(int, (float)(old)), __builtin_bit_cast(int, (float)(v)), (ctrl), (rm), 0xf, false))
__device__ __forceinline__ float wave_scan_add(float v) {
    v += DPPF_(0.f, v, 0x111, 0xf); v += DPPF_(0.f, v, 0x112, 0xf); v += DPPF_(0.f, v, 0x114, 0xf); v += DPPF_(0.f, v, 0x118, 0xf);
    v += DPPF_(0.f, v, 0x142, 0xa); v += DPPF_(0.f, v, 0x143, 0xc); return v;
}
__device__ __forceinline__ float wave_scan_max(float v) {
    v = fmaxf(v, DPPF_(-INFINITY, v, 0x111, 0xf)); v = fmaxf(v, DPPF_(-INFINITY, v, 0x112, 0xf)); v = fmaxf(v, DPPF_(-INFINITY, v, 0x114, 0xf)); v = fmaxf(v, DPPF_(-INFINITY, v, 0x118, 0xf));
    v = fmaxf(v, DPPF_(-INFINITY, v, 0x142, 0xa)); v = fmaxf(v, DPPF_(-INFINITY, v, 0x143, 0xc)); return v;
}
__device__ __forceinline__ float wave_last(float v) { return __builtin_bit_cast(float, __builtin_amdgcn_readlane(__builtin_bit_cast(int, v), 63)); }
__device__ __forceinline__ float wave_sum(float v) { return wave_last(wave_scan_add(v)); }
__device__ __forceinline__ float wave_max(float v) { return wave_last(wave_scan_max(v)); }
__device__ __forceinline__ float sigmoid_f(float x) { return __builtin_amdgcn_rcpf(1.0f + __expf(-x)); }

struct Ctx {
    LAS unsigned char* lds; int wave, vcu, G; unsigned char* ws; const float* const* in; float* out;
};
__device__ __forceinline__ int ltid() { int t = threadIdx.x; asm volatile("" : "+v"(t)); return t; }
enum { I_X = 0, I_WIN, I_CONVW, I_CONVB, I_GATEB, I_LQ1, I_LK1, I_LQ2, I_LK2, I_NG, I_WOUT, I_LN1G, I_LN1B, I_WR, I_BR, I_WGU, I_BGU, I_WDN, I_BDN, I_LN2G, I_LN2B };

__device__ __forceinline__ void load_row_f32(const float* row, int lane, float* v) {
    const f32x4* p = (const f32x4*)(row + 8 * lane); const f32x4 a = p[0], b = p[1]; const f32x4* q = (const f32x4*)(row + 512 + 8 * lane); const f32x4 c = q[0], d = q[1];
    v[0] = a.x; v[1] = a.y; v[2] = a.z; v[3] = a.w; v[4] = b.x; v[5] = b.y; v[6] = b.z; v[7] = b.w; v[8] = c.x; v[9] = c.y; v[10] = c.z; v[11] = c.w; v[12] = d.x; v[13] = d.y; v[14] = d.z; v[15] = d.w;
}
__device__ __forceinline__ void store_row_f32(float* row, int lane, const float* v) {
    f32x4* p = (f32x4*)(row + 8 * lane); p[0] = (f32x4){v[0], v[1], v[2], v[3]}; p[1] = (f32x4){v[4], v[5], v[6], v[7]};
    f32x4* q = (f32x4*)(row + 512 + 8 * lane); q[0] = (f32x4){v[8], v[9], v[10], v[11]}; q[1] = (f32x4){v[12], v[13], v[14], v[15]};
}
__device__ __forceinline__ void load_row_bf16(const bf16* row, int lane, float* v) {
    const v4u a = *(const v4u*)(row + 8 * lane), b = *(const v4u*)(row + 512 + 8 * lane); unpack8(a, v); unpack8(b, v + 8);
}
__device__ __forceinline__ void load_row_fp8(const unsigned char* row, int lane, float sc, float* v) {
    typedef float f32x2_ __attribute__((ext_vector_type(2)));
    const v2u a = *(const v2u*)(row + 8 * lane), b = *(const v2u*)(row + 512 + 8 * lane); const unsigned w[4] = {a.x, a.y, b.x, b.y};
#pragma unroll
    for (int i = 0; i < 4; ++i) { const f32x2_ lo = __builtin_amdgcn_cvt_pk_f32_fp8((int)w[i], false), hi = __builtin_amdgcn_cvt_pk_f32_fp8((int)w[i], true); v[4 * i] = lo.x * sc; v[4 * i + 1] = lo.y * sc; v[4 * i + 2] = hi.x * sc; v[4 * i + 3] = hi.y * sc; }
}
__device__ __forceinline__ void store_row_fp8(unsigned char* row, int lane, const float* v, float sc) {
    *(v2u*)(row + 8 * lane) = pack8_fp8(v, sc); *(v2u*)(row + 512 + 8 * lane) = pack8_fp8(v + 8, sc);
}
__device__ __forceinline__ void store_row_bf16(bf16* row, int lane, const float* v) {
    *(v4u*)(row + 8 * lane) = pack8(v); *(v4u*)(row + 512 + 8 * lane) = pack8(v + 8);
}
__device__ __forceinline__ void store_row_fp8_nt(unsigned char* row, int lane, const float* v, float sc) {
    __builtin_nontemporal_store(pack8_fp8(v, sc), (v2u*)(row + 8 * lane)); __builtin_nontemporal_store(pack8_fp8(v + 8, sc), (v2u*)(row + 512 + 8 * lane));
}
__device__ __forceinline__ void store_row_bf16_nt(bf16* row, int lane, const float* v) {
    __builtin_nontemporal_store(pack8(v), (v4u*)(row + 8 * lane)); __builtin_nontemporal_store(pack8(v + 8), (v4u*)(row + 512 + 8 * lane));
}
__device__ __forceinline__ void store_row_f32_nt(float* row, int lane, const float* v) {
    f32x4* p = (f32x4*)(row + 8 * lane); __builtin_nontemporal_store((f32x4){v[0], v[1], v[2], v[3]}, p); __builtin_nontemporal_store((f32x4){v[4], v[5], v[6], v[7]}, p + 1);
    f32x4* q = (f32x4*)(row + 512 + 8 * lane); __builtin_nontemporal_store((f32x4){v[8], v[9], v[10], v[11]}, q); __builtin_nontemporal_store((f32x4){v[12], v[13], v[14], v[15]}, q + 1);
}
__device__ __forceinline__ void ln_row(float* v, const float* g, const float* b) {
    float s = 0.f;
#pragma unroll
    for (int i = 0; i < 16; ++i) s += v[i];
    const float mean = wave_sum(s) * (1.0f / DMODEL); float q = 0.f;
#pragma unroll
    for (int i = 0; i < 16; ++i) { v[i] -= mean; q += v[i] * v[i]; }
    const float rstd = 1.0f / sqrtf(wave_sum(q) * (1.0f / DMODEL) + LN_EPS);
#pragma unroll
    for (int i = 0; i < 16; ++i) v[i] = v[i] * rstd * g[i] + b[i];
}
__device__ __forceinline__ void load_vec16(const float* p, int lane, float* v) { load_row_f32(p, lane, v); }

__device__ __forceinline__ void load_gate_w(int tid, const float* w_in_l, LAS f32x4* wgl) {
    for (int idx = tid; idx < 2048; idx += NTHREADS) { const int ln = idx & 63, hq = idx >> 6, half = hq & 1, q = hq >> 1; const int k = (q < 8) ? (8 * ln + q) : (512 + 8 * ln + q - 8);
        wgl[idx] = *(const f32x4*)(w_in_l + (size_t)k * INW + NPROJ + 4 * half); }
}
__device__ __forceinline__ void gates_row(const float* v, const LAS f32x4* wgl, const float* gate_b, float* Grow, int lane) {
    float p[8] = {0.f, 0.f, 0.f, 0.f, 0.f, 0.f, 0.f, 0.f};
#pragma unroll
    for (int q = 0; q < 16; ++q) { const f32x4 w0 = wgl[(q * 2 + 0) * 64 + lane], w1 = wgl[(q * 2 + 1) * 64 + lane];
        p[0] += v[q] * w0.x; p[1] += v[q] * w0.y; p[2] += v[q] * w0.z; p[3] += v[q] * w0.w; p[4] += v[q] * w1.x; p[5] += v[q] * w1.y; p[6] += v[q] * w1.z; p[7] += v[q] * w1.w; }
    const bool b5 = (lane >> 5) & 1, b4 = (lane >> 4) & 1, b3 = (lane >> 3) & 1;
    float r4[4];
#pragma unroll
    for (int i = 0; i < 4; ++i) { const float keep = b5 ? p[4 + i] : p[i], send = b5 ? p[i] : p[4 + i]; r4[i] = keep + __shfl_xor(send, 32); }
    float r2[2];
#pragma unroll
    for (int i = 0; i < 2; ++i) { const float keep = b4 ? r4[2 + i] : r4[i], send = b4 ? r4[i] : r4[2 + i]; r2[i] = keep + __shfl_xor(send, 16); }
    float r1; { const float keep = b3 ? r2[1] : r2[0], send = b3 ? r2[0] : r2[1]; r1 = keep + __shfl_xor(send, 8); }
    r1 += __shfl_xor(r1, 4); r1 += __shfl_xor(r1, 2); r1 += __shfl_xor(r1, 1);
    if ((lane & 7) == 0) { const int gi = (lane >> 3); Grow[gi] = r1 + gate_b[gi]; }
}
struct TrItem { const float* src; unsigned char* dst; int ldw, Kd, fp8; float sc; };
__device__ __forceinline__ void tr_fetch(const TrItem& a, float* ra, int lane) {
    const int kk0 = lane >> 5, nn = lane & 31;
#pragma unroll
    for (int i = 0; i < 64; ++i) ra[i] = a.src[(size_t)(2 * i + kk0) * a.ldw + nn];
}
__device__ __forceinline__ void tr_put(const float* ra, LAS float* scr, int lane) {
    const int kk0 = lane >> 5, nn = lane & 31;
#pragma unroll
    for (int i = 0; i < 64; ++i) scr[(2 * i + kk0) * 33 + nn] = ra[i];
}
__device__ __forceinline__ void tr_store(const TrItem& it, const LAS float* scr, int lane) {
    const int c = lane & 7;
#pragma unroll
    for (int j = 0; j < 4; ++j) { const int n = (lane >> 3) + 8 * j; const LAS float* s = scr + (16 * c) * 33 + n; float o[16];
#pragma unroll
        for (int i = 0; i < 16; ++i) o[i] = s[i * 33];
        if (it.fp8) { const v2u p = pack8_fp8(o, it.sc), q = pack8_fp8(o + 8, it.sc); *(GAS v4u*)(it.dst + (size_t)n * it.Kd + 16 * c) = (v4u){p.x, p.y, q.x, q.y}; }
        else { GAS v4u* d = (GAS v4u*)(it.dst + ((size_t)n * it.Kd + 16 * c) * 2); d[0] = pack8(o); d[1] = pack8(o + 8); } }
}
constexpr int TR_I_IN = DEPTH * 8 * 96, TR_I_OUT = DEPTH * 8 * 32, TR_I_GU = DEPTH * NEXP * 8 * 64, TR_I_DN = DEPTH * NEXP * 8 * 32, TR_ITEMS = TR_I_IN + TR_I_OUT + TR_I_GU + TR_I_DN;
__device__ __forceinline__ TrItem tr_decode(const Ctx& C, int r) {
    TrItem it;
    if (r < TR_I_GU) { const int m = r / 512, q = r % 512, kb = q / 64, nb = q % 64, n0 = 32 * nb;
        const int nn = (n0 < 1024) ? n0 : n0 - 1024; const int drow = 256 * (nn / 128) + (nn % 128) + ((n0 < 1024) ? 0 : 128);
        it.src = C.in[I_WGU] + (size_t)m * DMODEL * 2 * DFF + (size_t)(128 * kb) * (2 * DFF) + n0; it.ldw = 2 * DFF; it.Kd = DMODEL; it.fp8 = 1; it.sc = WQ_SCALE;
        it.dst = C.ws + WS_WGU + (size_t)m * 2 * DFF * DMODEL + (size_t)drow * DMODEL + 128 * kb; return it; }
    r -= TR_I_GU;
    if (r < TR_I_DN) { const int m = r / 256, q = r % 256, kb = q / 32, nb = q % 32;
        it.src = C.in[I_WDN] + (size_t)m * DFF * DMODEL + (size_t)(128 * kb) * DMODEL + 32 * nb; it.ldw = DMODEL; it.Kd = DFF; it.fp8 = 1; it.sc = WQ_SCALE;
        it.dst = C.ws + WS_WDN + (size_t)m * DMODEL * DFF + (size_t)(32 * nb) * DFF + 128 * kb; return it; }
    r -= TR_I_DN;
    if (r < TR_I_IN) { const int l = r / 768, q = r % 768, kb = q / 96, nb = q % 96, n0 = 32 * nb, tile = n0 >> 8;
        const bool q8 = (tile >= 8); const int rank = q8 ? tile - 8 : tile; const int drow = rank * 256 + (n0 & 255);
        it.src = C.in[I_WIN] + (size_t)l * DMODEL * INW + (size_t)(128 * kb) * INW + n0; it.ldw = INW; it.Kd = DMODEL; it.fp8 = q8 ? 1 : 0; it.sc = q8 ? WQ_SCALE : 1.f;
        it.dst = q8 ? C.ws + WS_WINQ + (size_t)l * 1536 * DMODEL + (size_t)drow * DMODEL + 128 * kb : C.ws + WS_WIN + ((size_t)l * NPROJ * DMODEL + (size_t)drow * DMODEL + 128 * kb) * 2; return it; }
    r -= TR_I_IN;
    { const int l = r / 256, q = r % 256, kb = q / 32, nb = q % 32;
        it.src = C.in[I_WOUT] + (size_t)l * DMODEL * DMODEL + (size_t)(128 * kb) * DMODEL + 32 * nb; it.ldw = DMODEL; it.Kd = DMODEL; it.fp8 = MK_OUTFP8; it.sc = MK_OUTFP8 ? ((kb >= 4) ? WQ_SCALE * (MQ_SCALE / MQ_ML) : WQ_SCALE) : 1.f;
        it.dst = C.ws + WS_WOUT + ((size_t)l * DMODEL * DMODEL + (size_t)(32 * nb) * DMODEL + 128 * kb) * (MK_OUTFP8 ? 1 : 2); return it; }
}
#ifndef MK_TRQ_RUNS
#define MK_TRQ_RUNS 0
#endif
constexpr int TR_L_GU = NEXP * 8 * 64, TR_L_DN = NEXP * 8 * 32, TR_L = TR_L_GU + TR_L_DN, TR_P_ITEMS = TR_L + TR_I_IN + TR_I_OUT, TRQ_LAYERS = DEPTH - 1;
__device__ __forceinline__ int trq_per(const Ctx& C) { return (TR_L + C.G - 1) / C.G; }
__device__ __forceinline__ int trq_item(const Ctx& C, int q) {
    const int per = trq_per(C), l = 1 + q / per, i = MK_TRQ_RUNS ? (C.vcu * per + q % per) : ((q % per) * C.G + C.vcu); if (i >= TR_L) return -1;
    return (i < TR_L_GU) ? l * TR_L_GU + i : TR_I_GU + l * TR_L_DN + (i - TR_L_GU); }
__device__ __forceinline__ int trp_item(int p) { return (p < TR_L_GU) ? p : (p < TR_L) ? TR_I_GU + (p - TR_L_GU) : TR_I_GU + TR_I_DN + (p - TR_L); }
__device__ __forceinline__ void tr_one(const Ctx& C, int r, LAS float* scr, int lane) {
    float ra[64]; const TrItem it = tr_decode(C, r); tr_fetch(it, ra, lane); tr_put(ra, scr, lane); LDS_WAIT(); asm volatile("" ::: "memory"); tr_store(it, scr, lane); LDS_WAIT(); asm volatile("" ::: "memory");
}
__device__ __forceinline__ int trq_grab(const Ctx& C, int lane) { unsigned v = 0u; if (lane == 0) v = __hip_atomic_fetch_add((LAS unsigned*)(C.lds + MISC_OFF) + 11, 1u, __ATOMIC_RELAXED, __HIP_MEMORY_SCOPE_WORKGROUP); return (int)__builtin_amdgcn_readfirstlane(v); }
__device__ __forceinline__ void trq_drain(const Ctx& C, int l) {
    const int lane = ltid() & 63, per = trq_per(C), endq = l * per, total = TRQ_LAYERS * per;
    LAS float* scr = (LAS float*)(C.lds + (C.wave < 7 ? RING_OFF + C.wave * 16896 : LDSX_OFF));
    for (;;) { const int q = trq_grab(C, lane); if (q >= total) break; const int r = trq_item(C, q); if (r >= 0) tr_one(C, r, scr, lane); if (q >= endq) break; }
    __syncthreads();
}
__device__ __forceinline__ void p_prologue(const Ctx& C) {
    const int tid = ltid(), lane = tid & 63;
    const int gw = C.vcu * NWAVES + C.wave, NGW = C.G * NWAVES;
    LAS float* scr = (LAS float*)(C.lds + (C.wave < 7 ? RING_OFF + C.wave * 16896 : LDSX_OFF));
    float ra[64]; TrItem cur = tr_decode(C, trp_item(gw < TR_P_ITEMS ? gw : 0));
    if (gw < TR_P_ITEMS) tr_fetch(cur, ra, lane);
    for (int it = gw; it < TR_P_ITEMS; it += NGW) {
        tr_put(ra, scr, lane);
        const bool more = (it + NGW < TR_P_ITEMS); const TrItem nxt = tr_decode(C, trp_item(more ? it + NGW : it));
        if (more) tr_fetch(nxt, ra, lane);
        LDS_WAIT(); asm volatile("" ::: "memory");
        tr_store(cur, scr, lane);
        LDS_WAIT(); asm volatile("" ::: "memory");
        cur = nxt;
    }
    { f32x4* WRP = (f32x4*)(C.ws + WS_WRP); const int gt = (C.vcu * NWAVES + C.wave) * 64 + lane, NGT = C.G * NTHREADS;
        for (int i = gt; i < DEPTH * 8192; i += NGT) { const int l = i >> 13, idx = i & 8191, ln = idx & 63, q4 = (idx >> 6) & 3, e = idx >> 8; const int k = (q4 < 2) ? (8 * ln + 4 * q4) : (512 + 8 * ln + 4 * (q4 - 2));
            const float* wr = C.in[I_WR] + (size_t)l * DMODEL * NEXP; WRP[i] = (f32x4){wr[(size_t)k * NEXP + e], wr[(size_t)(k + 1) * NEXP + e], wr[(size_t)(k + 2) * NEXP + e], wr[(size_t)(k + 3) * NEXP + e]}; } }
    __syncthreads();
    LAS f32x4* wgl = (LAS f32x4*)(C.lds + RING_OFF);
    load_gate_w(tid, C.in[I_WIN], wgl);
    __syncthreads();
    bf16* XB = (bf16*)(C.ws + WS_XB); float* G = (float*)(C.ws + WS_G);
    unsigned char* XLO = (unsigned char*)(C.ws + WS_XRES);
    for (int n = gw; n < NTOK; n += NGW) { float v[16], lo_[16]; load_row_f32(C.in[I_X] + (size_t)n * DMODEL, lane, v); store_row_bf16(XB + (size_t)n * DMODEL, lane, v);
#pragma unroll
        for (int i = 0; i < 16; ++i) lo_[i] = v[i] - __uint_as_float(f2bf(v[i]) << 16);
        if (USE_XLO) store_row_fp8(XLO + (size_t)n * DMODEL, lane, lo_, XLO_SCALE);
        store_row_fp8((unsigned char*)(C.ws + WS_XQ) + (size_t)n * DMODEL, lane, v, XQ_SCALE);
        gates_row(v, wgl, C.in[I_GATEB], G + (size_t)n * 8, lane); }
    __syncthreads();
}

__device__ __forceinline__ void conv_silu8(const bf16* proj, int n, int t, int col, const float* cw, const float* cb, float scale, float* y) {
    const f32x4 b0 = *(const f32x4*)cb, b1 = *(const f32x4*)(cb + 4);
    y[0] = b0.x; y[1] = b0.y; y[2] = b0.z; y[3] = b0.w; y[4] = b1.x; y[5] = b1.y; y[6] = b1.z; y[7] = b1.w;
#pragma unroll
    for (int j = 0; j < 4; ++j) { const int tt = t - 3 + j;
        if (tt >= 0) { const v4u w = *(const v4u*)(proj + (size_t)(n - 3 + j) * NPROJ + col); float x[8]; unpack8(w, x);
            const f32x4 c0 = *(const f32x4*)(cw + j * 512), c1 = *(const f32x4*)(cw + j * 512 + 4);
            y[0] += c0.x * x[0]; y[1] += c0.y * x[1]; y[2] += c0.z * x[2]; y[3] += c0.w * x[3]; y[4] += c1.x * x[4]; y[5] += c1.y * x[5]; y[6] += c1.z * x[6]; y[7] += c1.w * x[7]; } }
#pragma unroll
    for (int i = 0; i < 8; ++i) y[i] = y[i] * sigmoid_f(y[i]) * scale;
}
constexpr int KP = 68;

__device__ __forceinline__ void p_mlstm_states(const Ctx& C, int l) {
    const bf16* proj = (const bf16*)(C.ws + WS_PROJ); const float* G = (const float*)(C.ws + WS_G);
    float* CST = (float*)(C.ws + WS_CST); float* NST = (float*)(C.ws + WS_NST); float* MLOC = (float*)(C.ws + WS_MISC); float* GCH = MLOC + 2048;
    const float* cw = C.in[I_CONVW] + (size_t)l * 4 * 512; const float* cb = C.in[I_CONVB] + (size_t)l * 512;
    LAS float* kf = (LAS float*)(C.lds + RING_OFF);
    LAS float* vf = kf + 64 * 64;
    LAS float* ev = vf + 64 * 128;
    const int tid = ltid(), lane = tid & 63;
    for (int u = C.vcu; u < NBH * NCH; u += C.G) {
        const int bh = u / NCH, c = u % NCH, b = bh >> 2, h = bh & 3; const int n0 = b * SEQ + c * CHUNK;
        { const int s = tid >> 3, cg = tid & 7; float y[8]; conv_silu8(proj, n0 + s, c * CHUNK + s, 1536 + 256 + h * 64 + cg * 8, cw + 256 + h * 64 + cg * 8, cb + 256 + h * 64 + cg * 8, 1.0f, y);
#pragma unroll
            for (int i = 0; i < 8; ++i) kf[s * 64 + cg * 8 + i] = y[i];
            const bf16* vp = proj + (size_t)(n0 + s) * NPROJ + 2048 + h * 128 + cg * 16; float x[16]; unpack8(*(const v4u*)vp, x); unpack8(*(const v4u*)(vp + 8), x + 8);
#pragma unroll
            for (int i = 0; i < 16; ++i) vf[s * 128 + cg * 16 + i] = x[i]; }
        if (C.wave == 0) { const float ig = G[(size_t)(n0 + lane) * 8 + h], fg = G[(size_t)(n0 + lane) * 8 + 4 + h];
            float bc = fminf(fg, 0.f) - log1pf(expf(-fabsf(fg)));
#pragma unroll
            for (int o = 1; o < 64; o <<= 1) { const float t = __shfl_up(bc, o); if (lane >= o) bc += t; }
            const float g = __shfl(bc, 63); const float w = g - bc + ig; const float m = wave_max(w);
            ev[lane] = __expf(w - m); if (lane == 0) { MLOC[u] = m; GCH[u] = g; } }
        __syncthreads();
        { const int v = tid & 127, kg = tid >> 7; float acc[16];
#pragma unroll
            for (int i = 0; i < 16; ++i) acc[i] = 0.f;
            for (int s = 0; s < 64; ++s) { const float a = ev[s] * vf[s * 128 + v];
#pragma unroll
                for (int i4 = 0; i4 < 4; ++i4) { const f32x4 k4 = *(const LAS f32x4*)(kf + s * 64 + kg * 16 + i4 * 4); acc[i4 * 4 + 0] += a * k4.x; acc[i4 * 4 + 1] += a * k4.y; acc[i4 * 4 + 2] += a * k4.z; acc[i4 * 4 + 3] += a * k4.w; } }
            float* dst = CST + (size_t)u * 8192 + v;
#pragma unroll
            for (int i = 0; i < 16; ++i) dst[(kg * 16 + i) * 128] = acc[i]; }
        if (tid < 64) { float a = 0.f; for (int s = 0; s < 64; ++s) a += ev[s] * kf[s * 64 + tid]; NST[(size_t)u * 64 + tid] = a; }
        __syncthreads();
    }
}

__device__ __forceinline__ void p_mlstm_scan(const Ctx& C) {
    v2u* CST = (v2u*)(C.ws + WS_CST); f32x4* NST = (f32x4*)(C.ws + WS_NST); const float* MLOC = (const float*)(C.ws + WS_MISC); const float* GCH = MLOC + 2048; float* MPREV = (float*)(C.ws + WS_MISC) + 4096;
    const int nthr = C.G * NTHREADS, gid = C.vcu * NTHREADS + ltid();
    for (int it = gid; it < NBH * 2064; it += nthr) {
        const int bh = it / 2064, r = it % 2064;
        if (r < 2048) {
            v2u* p = CST + (size_t)bh * NCH * 2048 + r; float carry[4] = {0.f, 0.f, 0.f, 0.f}; float m = -INFINITY;
            for (int c0 = 0; c0 < NCH; c0 += 16) {
                v2u loc[16]; float gg[16], ml[16];
#pragma unroll
                for (int j = 0; j < 16; ++j) { loc[j] = p[(size_t)(c0 + j) * 2048]; gg[j] = GCH[bh * NCH + c0 + j]; ml[j] = MLOC[bh * NCH + c0 + j]; }
#pragma unroll
                for (int j = 0; j < 16; ++j) { p[(size_t)(c0 + j) * 2048] = (v2u){pk2(carry[0], carry[1]), pk2(carry[2], carry[3])}; if (r == 0) MPREV[bh * NCH + c0 + j] = m;
                    const float mn = fmaxf(gg[j] + m, ml[j]); const float a = __expf(gg[j] + m - mn), bb = __expf(ml[j] - mn);
                    carry[0] = carry[0] * a + bflo(loc[j].x) * bb; carry[1] = carry[1] * a + bfhi(loc[j].x) * bb; carry[2] = carry[2] * a + bflo(loc[j].y) * bb; carry[3] = carry[3] * a + bfhi(loc[j].y) * bb;
                    m = mn; }
            }
        } else {
            f32x4* p = NST + (size_t)bh * NCH * 16 + (r - 2048); f32x4 carry = (f32x4){0.f, 0.f, 0.f, 0.f}; float m = -INFINITY;
            for (int c0 = 0; c0 < NCH; c0 += 8) {
                f32x4 loc[8]; float gg[8], ml[8];
#pragma unroll
                for (int j = 0; j < 8; ++j) { loc[j] = p[(size_t)(c0 + j) * 16]; gg[j] = GCH[bh * NCH + c0 + j]; ml[j] = MLOC[bh * NCH + c0 + j]; }
#pragma unroll
                for (int j = 0; j < 8; ++j) { p[(size_t)(c0 + j) * 16] = carry;
                    const float mn = fmaxf(gg[j] + m, ml[j]); const float a = __expf(gg[j] + m - mn), bb = __expf(ml[j] - mn);
                    carry = carry * a + loc[j] * bb; m = mn; }
            }
        }
    }
}

__device__ __forceinline__ void p_mlstm_out(const Ctx& C, int l) {
    const bf16* proj = (const bf16*)(C.ws + WS_PROJ); const float* G = (const float*)(C.ws + WS_G);
    const float* CST = (const float*)(C.ws + WS_CST); const float* NST = (const float*)(C.ws + WS_NST); const float* MPREV = (const float*)(C.ws + WS_MISC) + 4096;
    bf16* MIXIN = (bf16*)(C.ws + WS_MIXIN);
    const float* cw = C.in[I_CONVW] + (size_t)l * 4 * 512; const float* cb = C.in[I_CONVB] + (size_t)l * 512;
    LAS float* qf = (LAS float*)(C.lds + RING_OFF);
    LAS float* kf = qf + 64 * KP;
    LAS float* Sm = kf + 64 * KP;
    LAS float* vf = Sm + 64 * KP;
    LAS float* Ct = vf + 64 * 128;
    LAS float* sv = Ct + 64 * 128;
    static_assert((3 * 64 * KP + 2 * 64 * 128 + 6 * 64) * 4 <= RING_BYTES, "mLSTM LDS");
    const int tid = ltid(), lane = tid & 63;
    for (int u = C.vcu; u < NBH * NCH; u += C.G) {
        const int bh = u / NCH, c = u % NCH, b = bh >> 2, h = bh & 3; const int n0 = b * SEQ + c * CHUNK;
        { const int s = tid >> 3, cg = tid & 7; float y[8];
            conv_silu8(proj, n0 + s, c * CHUNK + s, 1536 + h * 64 + cg * 8, cw + h * 64 + cg * 8, cb + h * 64 + cg * 8, 0.125f, y);
#pragma unroll
            for (int i = 0; i < 8; ++i) qf[s * KP + cg * 8 + i] = y[i];
            conv_silu8(proj, n0 + s, c * CHUNK + s, 1536 + 256 + h * 64 + cg * 8, cw + 256 + h * 64 + cg * 8, cb + 256 + h * 64 + cg * 8, 1.0f, y);
#pragma unroll
            for (int i = 0; i < 8; ++i) kf[s * KP + cg * 8 + i] = y[i];
            const bf16* vp = proj + (size_t)(n0 + s) * NPROJ + 2048 + h * 128 + cg * 16; float x[16]; unpack8(*(const v4u*)vp, x); unpack8(*(const v4u*)(vp + 8), x + 8);
#pragma unroll
            for (int i = 0; i < 16; ++i) vf[s * 128 + cg * 16 + i] = x[i];
            const f32x4* cp = (const f32x4*)(CST + (size_t)u * 8192);
#pragma unroll
            for (int i = 0; i < 4; ++i) *(LAS f32x4*)(Ct + (tid + NTHREADS * i) * 4) = cp[tid + NTHREADS * i]; }
        if (C.wave == 0) { const float ig = G[(size_t)(n0 + lane) * 8 + h], fg = G[(size_t)(n0 + lane) * 8 + 4 + h]; const float mp = MPREV[u];
            float bc = fminf(fg, 0.f) - log1pf(expf(-fabsf(fg)));
#pragma unroll
            for (int o = 1; o < 64; o <<= 1) { const float t = __shfl_up(bc, o); if (lane >= o) bc += t; }
            const float a = ig - bc; float pm = a;
#pragma unroll
            for (int o = 1; o < 64; o <<= 1) { const float t = __shfl_up(pm, o); if (lane >= o) pm = fmaxf(pm, t); }
            const float mt = bc + fmaxf(mp, pm);
            sv[lane] = bc; sv[64 + lane] = a; sv[128 + lane] = mt; sv[192 + lane] = __expf(bc + mp - mt); sv[320 + lane] = NST[(size_t)u * 64 + lane]; }
        __syncthreads();
        {
            const int t = tid >> 3, sg = tid & 7; float qr[64];
#pragma unroll
            for (int i = 0; i < 16; ++i) { const f32x4 q4 = *(const LAS f32x4*)(qf + t * KP + 4 * i); qr[4 * i] = q4.x; qr[4 * i + 1] = q4.y; qr[4 * i + 2] = q4.z; qr[4 * i + 3] = q4.w; }
            const float bt = sv[t] - sv[128 + t]; float dsum = 0.f;
#pragma unroll 2
            for (int j = 0; j < 8; ++j) { const int s = sg + 8 * j; float d = 0.f;
#pragma unroll
                for (int i = 0; i < 16; ++i) { const f32x4 k4 = *(const LAS f32x4*)(kf + s * KP + 4 * i); d += qr[4 * i] * k4.x + qr[4 * i + 1] * k4.y + qr[4 * i + 2] * k4.z + qr[4 * i + 3] * k4.w; }
                const float sc = (s <= t) ? d * __expf(sv[64 + s] + bt) : 0.f; Sm[t * KP + s] = sc; dsum += sc; }
            float nq = 0.f;
#pragma unroll
            for (int i = 0; i < 8; ++i) nq += qf[t * KP + sg * 8 + i] * sv[320 + sg * 8 + i];
            dsum += sv[192 + t] * nq;
            dsum += __shfl_xor(dsum, 1); dsum += __shfl_xor(dsum, 2); dsum += __shfl_xor(dsum, 4);
            if (sg == 0) sv[256 + t] = 1.0f / fmaxf(fabsf(dsum), __expf(-sv[128 + t])); }
        __syncthreads();
        {
            const int t = tid >> 3, vg = tid & 7; float acc[16];
#pragma unroll
            for (int i = 0; i < 16; ++i) acc[i] = 0.f;
            const float iw = sv[192 + t];
            for (int k = 0; k < 64; ++k) { const float a = qf[t * KP + k] * iw;
#pragma unroll
                for (int i4 = 0; i4 < 4; ++i4) { const f32x4 c4 = *(const LAS f32x4*)(Ct + k * 128 + vg * 16 + i4 * 4); acc[i4 * 4] += a * c4.x; acc[i4 * 4 + 1] += a * c4.y; acc[i4 * 4 + 2] += a * c4.z; acc[i4 * 4 + 3] += a * c4.w; } }
            for (int s = 0; s < 64; ++s) { const float a = Sm[t * KP + s];
#pragma unroll
                for (int i4 = 0; i4 < 4; ++i4) { const f32x4 v4 = *(const LAS f32x4*)(vf + s * 128 + vg * 16 + i4 * 4); acc[i4 * 4] += a * v4.x; acc[i4 * 4 + 1] += a * v4.y; acc[i4 * 4 + 2] += a * v4.z; acc[i4 * 4 + 3] += a * v4.w; } }
            const float dn = sv[256 + t];
            const bf16* op = proj + (size_t)(n0 + t) * NPROJ + 2560 + h * 128 + vg * 16; float o[16]; unpack8(*(const v4u*)op, o); unpack8(*(const v4u*)(op + 8), o + 8);
#pragma unroll
            for (int i = 0; i < 16; ++i) o[i] = acc[i] * dn * sigmoid_f(o[i]);
            bf16* dst = MIXIN + (size_t)(n0 + t) * DMODEL + 512 + h * 128 + vg * 16; *(v4u*)dst = pack8(o); *(v4u*)(dst + 8) = pack8(o + 8); }
        __syncthreads();
    }
}

__device__ __forceinline__ void p_da_combine(const Ctx& C, int l, float lam_init) {
    const bf16* ATTO = (const bf16*)(C.ws + WS_ATTO); bf16* MIXIN = (bf16*)(C.ws + WS_MIXIN);
    const int lane = ltid() & 63, gw = C.vcu * NWAVES + C.wave, NGW = C.G * NWAVES;
    const float s1 = wave_sum(C.in[I_LQ1][l * 64 + lane] * C.in[I_LK1][l * 64 + lane]), s2 = wave_sum(C.in[I_LQ2][l * 64 + lane] * C.in[I_LK2][l * 64 + lane]);
    const float lam = expf(s1) - expf(s2) + lam_init, osc = 1.0f - lam_init;
    const int h = lane >> 4, e8 = (lane & 15) * 8;
    float g[8]; { const f32x4 a = *(const f32x4*)(C.in[I_NG] + l * 128 + e8), b2 = *(const f32x4*)(C.in[I_NG] + l * 128 + e8 + 4); g[0] = a.x; g[1] = a.y; g[2] = a.z; g[3] = a.w; g[4] = b2.x; g[5] = b2.y; g[6] = b2.z; g[7] = b2.w; }
    for (int n = gw; n < NTOK; n += NGW) {
        float o0[8], o1[8]; unpack8(*(const v4u*)(ATTO + (size_t)n * DMODEL + h * 256 + e8), o0); unpack8(*(const v4u*)(ATTO + (size_t)n * DMODEL + h * 256 + 128 + e8), o1);
        float ss = 0.f;
#pragma unroll
        for (int i = 0; i < 8; ++i) { o0[i] -= lam * o1[i]; ss += o0[i] * o0[i]; }
        ss += __shfl_xor(ss, 1); ss += __shfl_xor(ss, 2); ss += __shfl_xor(ss, 4); ss += __shfl_xor(ss, 8);
        const float r = 1.0f / sqrtf(ss * (1.0f / 128.0f) + RMS_EPS) * osc;
#pragma unroll
        for (int i = 0; i < 8; ++i) o0[i] = o0[i] * r * g[i];
        *(v4u*)(MIXIN + (size_t)n * DMODEL + h * 128 + e8) = pack8(o0);
    }
}
typedef float f32x16 __attribute__((ext_vector_type(16)));
constexpr int TP = 72;
#define MFMA32(a, b, c) __builtin_amdgcn_mfma_f32_32x32x16_bf16((a), (b), (c), 0, 0, 0)
__device__ __forceinline__ bf16x8 frag_ld(const LAS bf16* tile, int row, int step, int h) { return *(const LAS bf16x8*)(tile + row * TP + step * 16 + 8 * h); }
__device__ __forceinline__ void tr_store16(LAS bf16* tile, int c0, int s, const v4u a, const v4u b) {
    const unsigned w[8] = {a.x, a.y, a.z, a.w, b.x, b.y, b.z, b.w};
#pragma unroll
    for (int i = 0; i < 8; ++i) { tile[(c0 + 2 * i) * TP + s] = (bf16)(w[i] & 0xffffu); tile[(c0 + 2 * i + 1) * TP + s] = (bf16)(w[i] >> 16); }
}

__device__ __forceinline__ void conv_fetch(const bf16* proj, int n, int t, int col, v4u* raw) {
#pragma unroll
    for (int j = 0; j < 4; ++j) { const int tt = t - 3 + j; raw[j] = (tt >= 0) ? *(const v4u*)(proj + (size_t)(n - 3 + j) * NPROJ + col) : (v4u){0u, 0u, 0u, 0u}; }
}
__device__ __forceinline__ void conv_stage(LAS float* cwl, const float* cw, const float* cb, int ch0, int tid) {
    if (tid < 320) cwl[tid] = (tid < 256) ? cw[(tid >> 6) * 512 + ch0 + (tid & 63)] : cb[ch0 + (tid - 256)];
}
__device__ __forceinline__ void conv_apply_l(const v4u* raw, const LAS float* cwl, int c0, float scale, float* y) {
    const f32x4 b0 = *(const LAS f32x4*)(cwl + 256 + c0), b1 = *(const LAS f32x4*)(cwl + 256 + c0 + 4);
    y[0] = b0.x; y[1] = b0.y; y[2] = b0.z; y[3] = b0.w; y[4] = b1.x; y[5] = b1.y; y[6] = b1.z; y[7] = b1.w;
#pragma unroll
    for (int j = 0; j < 4; ++j) { float x[8]; unpack8(raw[j], x);
        const f32x4 c0_ = *(const LAS f32x4*)(cwl + j * 64 + c0), c1_ = *(const LAS f32x4*)(cwl + j * 64 + c0 + 4);
        y[0] += c0_.x * x[0]; y[1] += c0_.y * x[1]; y[2] += c0_.z * x[2]; y[3] += c0_.w * x[3]; y[4] += c1_.x * x[4]; y[5] += c1_.y * x[5]; y[6] += c1_.z * x[6]; y[7] += c1_.w * x[7]; }
#pragma unroll
    for (int i = 0; i < 8; ++i) y[i] = y[i] * sigmoid_f(y[i]) * scale;
}
__device__ __forceinline__ void conv_apply(const v4u* raw, const float* cw, const float* cb, float scale, float* y) {
    const f32x4 b0 = *(const f32x4*)cb, b1 = *(const f32x4*)(cb + 4);
    y[0] = b0.x; y[1] = b0.y; y[2] = b0.z; y[3] = b0.w; y[4] = b1.x; y[5] = b1.y; y[6] = b1.z; y[7] = b1.w;
#pragma unroll
    for (int j = 0; j < 4; ++j) { float x[8]; unpack8(raw[j], x);
        const f32x4 c0 = *(const f32x4*)(cw + j * 512), c1 = *(const f32x4*)(cw + j * 512 + 4);
        y[0] += c0.x * x[0]; y[1] += c0.y * x[1]; y[2] += c0.z * x[2]; y[3] += c0.w * x[3]; y[4] += c1.x * x[4]; y[5] += c1.y * x[5]; y[6] += c1.z * x[6]; y[7] += c1.w * x[7]; }
#pragma unroll
    for (int i = 0; i < 8; ++i) y[i] = y[i] * sigmoid_f(y[i]) * scale;
}

__device__ __forceinline__ void p_mlstm_states_mfma(const Ctx& C, int l) {
    const bf16* proj = (const bf16*)(C.ws + WS_PROJ); const float* G = (const float*)(C.ws + WS_G);
    bf16* CST = (bf16*)(C.ws + WS_CST); float* NST = (float*)(C.ws + WS_NST); float* MLOC = (float*)(C.ws + WS_MISC); float* GCH = MLOC + 2048;
    const float* cw = C.in[I_CONVW] + (size_t)l * 4 * 512; const float* cb = C.in[I_CONVB] + (size_t)l * 512;
    LAS bf16* KeT = (LAS bf16*)(C.lds + RING_OFF);
    LAS bf16* Vt = KeT + 64 * TP;
    LAS float* ev = (LAS float*)(Vt + 128 * TP);
    const int tid = ltid(), lane = tid & 63, r = lane & 31, h = lane >> 5, s = tid & 63, cg = tid >> 6;
    v4u rk[4], rv[2]; float rig = 0.f, rfg = 0.f;
#define ST_FETCH(u_) do { const int bh_ = (u_) / NCH, c_ = (u_) % NCH, n0_ = (bh_ >> 2) * SEQ + c_ * CHUNK, hd_ = bh_ & 3; \
        conv_fetch(proj, n0_ + s, c_ * CHUNK + s, 1536 + 256 + hd_ * 64 + cg * 8, rk); const bf16* vp_ = proj + (size_t)(n0_ + s) * NPROJ + 2048 + hd_ * 128 + cg * 16; rv[0] = *(const v4u*)vp_; rv[1] = *(const v4u*)(vp_ + 8); \
        if (C.wave == 0) { rig = G[(size_t)(n0_ + lane) * 8 + hd_]; rfg = G[(size_t)(n0_ + lane) * 8 + 4 + hd_]; } } while (0)
    if (C.vcu < NBH * NCH) ST_FETCH(C.vcu);
    for (int u = C.vcu; u < NBH * NCH; u += C.G) {
        const int bh = u / NCH, hd = bh & 3;
        if (C.wave == 0) { const float ig = rig, fg = rfg;
            float bc = fminf(fg, 0.f) - log1pf(expf(-fabsf(fg)));
#pragma unroll
            for (int o = 1; o < 64; o <<= 1) { const float t = __shfl_up(bc, o); if (lane >= o) bc += t; }
            const float g = __shfl(bc, 63); const float w = g - bc + ig; const float m = wave_max(w);
            ev[lane] = __expf(w - m); if (lane == 0) { MLOC[u] = m; GCH[u] = g; } }
        __syncthreads();
        { float y[8]; conv_apply(rk, cw + 256 + hd * 64 + cg * 8, cb + 256 + hd * 64 + cg * 8, 1.0f, y);
            const float e = ev[s];
#pragma unroll
            for (int i = 0; i < 8; ++i) KeT[(cg * 8 + i) * TP + s] = (bf16)f2bf(y[i] * e);
            tr_store16(Vt, cg * 16, s, rv[0], rv[1]); }
        if (u + C.G < NBH * NCH) ST_FETCH(u + C.G);
        __syncthreads();
        { const int kb = C.wave & 1, vb = C.wave >> 1; f32x16 acc;
#pragma unroll
            for (int i = 0; i < 16; ++i) acc[i] = 0.f;
#pragma unroll
            for (int st = 0; st < 4; ++st) acc = MFMA32(frag_ld(KeT, kb * 32 + r, st, h), frag_ld(Vt, vb * 32 + r, st, h), acc);
            bf16* dst = CST + (size_t)u * 8192 + (size_t)(vb * 32 + r) * 64 + kb * 32 + 4 * h;
#pragma unroll
            for (int g = 0; g < 4; ++g) *(v2u*)(dst + 8 * g) = (v2u){pk2(acc[4 * g], acc[4 * g + 1]), pk2(acc[4 * g + 2], acc[4 * g + 3])}; }
        if (tid < 64) { float a = 0.f;
#pragma unroll 8
            for (int s_ = 0; s_ < 64; s_ += 2) { const unsigned w = *(const LAS unsigned*)(KeT + tid * TP + s_); a += bflo(w) + bfhi(w); }
            NST[(size_t)u * 64 + tid] = a; }
    }
#undef ST_FETCH
    __syncthreads();
}

__device__ __forceinline__ void p_mlstm_out_mfma(const Ctx& C, int l) {
    const bf16* proj = (const bf16*)(C.ws + WS_PROJ); const float* G = (const float*)(C.ws + WS_G);
    const bf16* CST = (const bf16*)(C.ws + WS_CST); const float* NST = (const float*)(C.ws + WS_NST); const float* MPREV = (const float*)(C.ws + WS_MISC) + 4096;
    bf16* MIXIN = (bf16*)(C.ws + WS_MIXIN);
    const float* cw = C.in[I_CONVW] + (size_t)l * 4 * 512; const float* cb = C.in[I_CONVB] + (size_t)l * 512;
    LAS bf16* Qt = (LAS bf16*)(C.lds + RING_OFF);
    LAS bf16* Kt = Qt + 64 * TP;
    LAS bf16* St = Kt + 64 * TP;
    LAS bf16* Vt = St + 64 * TP;
    LAS bf16* Ct = Vt + 128 * TP;
    LAS float* sv = (LAS float*)(Ct + 128 * TP);
    const int tid = ltid(), lane = tid & 63, r = lane & 31, h = lane >> 5;
    const int s = tid >> 3, cg = tid & 7, s2 = tid & 63, vg = tid >> 6, cv = tid >> 2, ck0 = (tid & 3) * 16, ot = (C.wave & 1) * 32 + r, ovb = C.wave >> 1;
    v4u rq[4], rk[4], rv[2], rc[2]; v2u ro[4], roc[4]; float rig = 0.f, rfg = 0.f, rmp = 0.f, rnp = 0.f;
#define OUT_FETCH(u_) do { const int bh_ = (u_) / NCH, c_ = (u_) % NCH, n0_ = (bh_ >> 2) * SEQ + c_ * CHUNK, hd_ = bh_ & 3; \
        conv_fetch(proj, n0_ + s, c_ * CHUNK + s, 1536 + hd_ * 64 + cg * 8, rq); conv_fetch(proj, n0_ + s, c_ * CHUNK + s, 1536 + 256 + hd_ * 64 + cg * 8, rk); \
        const bf16* vp_ = proj + (size_t)(n0_ + s2) * NPROJ + 2048 + hd_ * 128 + vg * 16; rv[0] = *(const v4u*)vp_; rv[1] = *(const v4u*)(vp_ + 8); \
        const v4u* cp_ = (const v4u*)(CST + (size_t)(u_) * 8192 + cv * 64 + ck0); rc[0] = cp_[0]; rc[1] = cp_[1]; \
        const bf16* op_ = proj + (size_t)(n0_ + ot) * NPROJ + 2560 + hd_ * 128 + ovb * 32 + 4 * h; _Pragma("unroll") for (int g_ = 0; g_ < 4; ++g_) ro[g_] = *(const v2u*)(op_ + 8 * g_); \
        if (C.wave == 0) { rig = G[(size_t)(n0_ + lane) * 8 + hd_]; rfg = G[(size_t)(n0_ + lane) * 8 + 4 + hd_]; rmp = MPREV[(u_)]; rnp = NST[(size_t)(u_) * 64 + lane]; } } while (0)
    if (C.vcu < NBH * NCH) OUT_FETCH(C.vcu);
    for (int u = C.vcu; u < NBH * NCH; u += C.G) {
        const int bh = u / NCH, c = u % NCH, b = bh >> 2, hd = bh & 3; const int n0 = b * SEQ + c * CHUNK;
        __syncthreads();
        { float y[8];
            conv_apply(rq, cw + hd * 64 + cg * 8, cb + hd * 64 + cg * 8, 0.125f, y); *(LAS v4u*)(Qt + s * TP + cg * 8) = pack8(y);
            conv_apply(rk, cw + 256 + hd * 64 + cg * 8, cb + 256 + hd * 64 + cg * 8, 1.0f, y); *(LAS v4u*)(Kt + s * TP + cg * 8) = pack8(y);
            tr_store16(Vt, vg * 16, s2, rv[0], rv[1]);
            *(LAS v4u*)(Ct + cv * TP + ck0) = rc[0]; *(LAS v4u*)(Ct + cv * TP + ck0 + 8) = rc[1];
#pragma unroll
            for (int g = 0; g < 4; ++g) roc[g] = ro[g]; }
        if (C.wave == 0) { const float ig = rig, fg = rfg; const float mp = rmp;
            float bc = fminf(fg, 0.f) - log1pf(expf(-fabsf(fg)));
#pragma unroll
            for (int o = 1; o < 64; o <<= 1) { const float t = __shfl_up(bc, o); if (lane >= o) bc += t; }
            const float a = ig - bc; float pm = a;
#pragma unroll
            for (int o = 1; o < 64; o <<= 1) { const float t = __shfl_up(pm, o); if (lane >= o) pm = fmaxf(pm, t); }
            const float mt = bc + fmaxf(mp, pm);
            sv[lane] = bc; sv[64 + lane] = a; sv[128 + lane] = mt; sv[192 + lane] = __expf(bc + mp - mt); sv[256 + lane] = rnp; }
        if (u + C.G < NBH * NCH) OUT_FETCH(u + C.G);
        __syncthreads();
        if (C.wave < 4) {
            const int sb = C.wave & 1, tb = C.wave >> 1; f32x16 x;
#pragma unroll
            for (int i = 0; i < 16; ++i) x[i] = 0.f;
#pragma unroll
            for (int st = 0; st < 4; ++st) x = MFMA32(frag_ld(Kt, sb * 32 + r, st, h), frag_ld(Qt, tb * 32 + r, st, h), x);
            const int t = tb * 32 + r; const float bt = sv[t] - sv[128 + t]; float dsum = 0.f;
#pragma unroll
            for (int g = 0; g < 4; ++g) { const int s0 = sb * 32 + 8 * g + 4 * h; float w[4];
#pragma unroll
                for (int i = 0; i < 4; ++i) { const int s = s0 + i; w[i] = (s <= t) ? x[4 * g + i] * __expf(sv[64 + s] + bt) : 0.f; }
                const unsigned p0 = pk2(w[0], w[1]), p1 = pk2(w[2], w[3]); dsum += (bflo(p0) + bfhi(p0)) + (bflo(p1) + bfhi(p1));
                *(LAS v2u*)(St + t * TP + s0) = (v2u){p0, p1}; }
            sv[384 + (sb * 2 + h) * 64 + t] = dsum;
        } else if (tid < 320) {
            const int t = tid - 256; float a = 0.f;
#pragma unroll 8
            for (int k = 0; k < 64; k += 2) { const unsigned w = *(const LAS unsigned*)(Qt + t * TP + k); a += bflo(w) * sv[256 + k] + bfhi(w) * sv[256 + k + 1]; }
            sv[320 + t] = a; }
        __syncthreads();
        {
            const int vb = C.wave >> 1, tb = C.wave & 1; f32x16 acc;
#pragma unroll
            for (int i = 0; i < 16; ++i) acc[i] = 0.f;
#pragma unroll
            for (int st = 0; st < 4; ++st) acc = MFMA32(frag_ld(Ct, vb * 32 + r, st, h), frag_ld(Qt, tb * 32 + r, st, h), acc);
            const int t = tb * 32 + r; const float iw = sv[192 + t];
#pragma unroll
            for (int i = 0; i < 16; ++i) acc[i] *= iw;
#pragma unroll
            for (int st = 0; st < 4; ++st) acc = MFMA32(frag_ld(Vt, vb * 32 + r, st, h), frag_ld(St, tb * 32 + r, st, h), acc);
            const float den = ((sv[384 + t] + sv[384 + 64 + t]) + (sv[384 + 128 + t] + sv[384 + 192 + t])) + iw * sv[320 + t];
            const float dn = 1.0f / fmaxf(fabsf(den), __expf(-sv[128 + t]));
            bf16* dst = MIXIN + (size_t)(n0 + t) * DMODEL + 512 + hd * 128 + vb * 32 + 4 * h;
#pragma unroll
            for (int g = 0; g < 4; ++g) { const v2u ow = roc[g]; const float o0 = bflo(ow.x), o1 = bfhi(ow.x), o2 = bflo(ow.y), o3 = bfhi(ow.y);
                *(v2u*)(dst + 8 * g) = (v2u){pk2(acc[4 * g] * dn * sigmoid_f(o0), acc[4 * g + 1] * dn * sigmoid_f(o1)), pk2(acc[4 * g + 2] * dn * sigmoid_f(o2), acc[4 * g + 3] * dn * sigmoid_f(o3))}; } }
    }
#undef OUT_FETCH
    __syncthreads();
}
constexpr size_t WS_TOTC = WS_CST + 32 * MiB;
constexpr size_t WS_TOTN = WS_NST + 512 * 1024;
constexpr int MS_DCUM = 6144, MS_TOTM = 8192, MS_TOTG = 8448;

__device__ __forceinline__ void p_mlstm_states_seq(const Ctx& C, int l) {
    const bf16* proj = (const bf16*)(C.ws + WS_PROJ); const float* G = (const float*)(C.ws + WS_G);
    bf16* CST = (bf16*)(C.ws + WS_CST); float* NST = (float*)(C.ws + WS_NST); float* MS = (float*)(C.ws + WS_MISC); float* MPREV = MS + 4096;
    float* TOTC = (float*)(C.ws + WS_TOTC); float* TOTN = (float*)(C.ws + WS_TOTN);
    const float* cw = C.in[I_CONVW] + (size_t)l * 4 * 512; const float* cb = C.in[I_CONVB] + (size_t)l * 512;
    LAS bf16* KeT = (LAS bf16*)(C.lds + RING_OFF);
    LAS bf16* Vt = KeT + 64 * TP;
    LAS float* ev = (LAS float*)(Vt + 128 * TP);
    LAS float* cwl = ev + 80;
    LAS bf16* Cs = (LAS bf16*)(cwl + 320);
#define CST_FLUSH(uu_) do { const int row_ = tid >> 2, pc_ = (tid & 3) * 16; const LAS v4u* sp_ = (const LAS v4u*)(Cs + row_ * TP + pc_); const v4u a_ = sp_[0], b_ = sp_[1]; \
        v4u* gp_ = (v4u*)(CST + (size_t)(uu_) * 8192 + row_ * 64 + pc_); gp_[0] = a_; gp_[1] = b_; } while (0)
    const int tid = ltid(), lane = tid & 63, r = lane & 31, h = lane >> 5, s = tid & 63, cg = tid >> 6;
    v4u rkA[4], rvA[2], rkB[4], rvB[2]; float rigA = 0.f, rfgA = 0.f, rigB = 0.f, rfgB = 0.f;
#define ST_FETCH(u_) do { const int bh_ = (u_) / NCH, c_ = (u_) % NCH, n0_ = (bh_ >> 2) * SEQ + c_ * CHUNK, hd_ = bh_ & 3; \
        conv_fetch(proj, n0_ + s, c_ * CHUNK + s, 1536 + 256 + hd_ * 64 + cg * 8, rk); const bf16* vp_ = proj + (size_t)(n0_ + s) * NPROJ + 2048 + hd_ * 128 + cg * 16; rv[0] = *(const v4u*)vp_; rv[1] = *(const v4u*)(vp_ + 8); \
        if (C.wave == 0) { rig = G[(size_t)(n0_ + lane) * 8 + hd_]; rfg = G[(size_t)(n0_ + lane) * 8 + 4 + hd_]; } } while (0)
    const bool itw = MK_SIDEJOB && C.wave >= 1 && C.wave <= 6; const int itot = TRQ_LAYERS * trq_per(C);
    LAS float* iscr = (LAS float*)(C.lds + (C.wave <= 5 ? RING_OFF + 32768 + (C.wave - 1) * 16896 : LDSX_OFF));
    float ira[64]; int ir = -1;
#define SIDE_OUT() do { if (ir >= 0) { const TrItem it_ = tr_decode(C, ir); tr_put(ira, iscr, lane); LDS_WAIT(); asm volatile("" ::: "memory"); tr_store(it_, iscr, lane); LDS_WAIT(); asm volatile("" ::: "memory"); ir = -1; } } while (0)
#define SIDE_STEP() do { if (itw) { const int q_ = trq_grab(C, lane); ir = (q_ < itot) ? trq_item(C, q_) : -1; if (ir >= 0) { const TrItem it_ = tr_decode(C, ir); tr_fetch(it_, ira, lane); } } } while (0)
#define SIDE_FLUSH() do { if (itw) SIDE_OUT(); } while (0)
    for (int vc = C.vcu; vc < 256; vc += C.G) {
        const int bh = vc >> 3, hd = bh & 3, u0 = bh * NCH + (vc & 7) * 8;
        f32x16 crun; float nrun = 0.f, mrun = -INFINITY, drun = 0.f;
#pragma unroll
        for (int i = 0; i < 16; ++i) crun[i] = 0.f;
        conv_stage(cwl, cw, cb, 256 + hd * 64, tid);
        { v4u (&rk)[4] = rkA; v4u (&rv)[2] = rvA; float& rig = rigA; float& rfg = rfgA; ST_FETCH(u0); }
        { v4u (&rk)[4] = rkB; v4u (&rv)[2] = rvB; float& rig = rigB; float& rfg = rfgB; ST_FETCH(u0 + 1); }
        auto body = [&](const int j, v4u (&rk)[4], v4u (&rv)[2], float& rig, float& rfg) __attribute__((always_inline)) {
            const int u = u0 + j;
            if (C.wave == 0) { const float ig = rig, fg = rfg;
                float bc = fminf(fg, 0.f) - log1pf(expf(-fabsf(fg)));
                bc = wave_scan_add(bc);
                const float g = wave_last(bc); const float w = g - bc + ig; const float m = wave_max(w);
                ev[lane] = __expf(w - m); if (lane == 0) { ev[64] = m; ev[65] = g; } }
            __syncthreads();
            if (j > 0) CST_FLUSH(u - 1);
            { float y[8]; conv_apply_l(rk, cwl, cg * 8, 1.0f, y);
                const float e = ev[s];
#pragma unroll
                for (int i = 0; i < 8; ++i) KeT[(cg * 8 + i) * TP + s] = (bf16)f2bf(y[i] * e);
                tr_store16(Vt, cg * 16, s, rv[0], rv[1]); }
            const float mloc = ev[64], gch = ev[65];
            SIDE_FLUSH();
            if (j < 6) ST_FETCH(u + 2);
            __syncthreads();
            const float mnew = fmaxf(gch + mrun, mloc), fa = __expf(gch + mrun - mnew), fb = __expf(mloc - mnew);
            { const int kb = C.wave & 1, vb = C.wave >> 1; f32x16 acc;
#pragma unroll
                for (int i = 0; i < 16; ++i) acc[i] = 0.f;
#pragma unroll
                for (int st = 0; st < 4; ++st) acc = MFMA32(frag_ld(KeT, kb * 32 + r, st, h), frag_ld(Vt, vb * 32 + r, st, h), acc);
                LAS bf16* dst = Cs + (vb * 32 + r) * TP + kb * 32 + 4 * h;
#pragma unroll
                for (int g = 0; g < 4; ++g) *(LAS v2u*)(dst + 8 * g) = (v2u){pk2(crun[4 * g], crun[4 * g + 1]), pk2(crun[4 * g + 2], crun[4 * g + 3])};
#pragma unroll
                for (int i = 0; i < 16; ++i) crun[i] = fa * crun[i] + fb * acc[i]; }
            if (tid < 64) { float a = 0.f;
#pragma unroll 8
                for (int s_ = 0; s_ < 64; s_ += 2) { const unsigned w = *(const LAS unsigned*)(KeT + tid * TP + s_); a += bflo(w) + bfhi(w); }
                NST[(size_t)u * 64 + tid] = nrun; nrun = fa * nrun + fb * a; }
            if (tid == 0) { MPREV[u] = mrun; MS[MS_DCUM + u] = drun; }
            mrun = mnew; drun += gch;
            SIDE_STEP();
        };
#pragma unroll 1
        for (int jj = 0; jj < 8; jj += 2) { body(jj, rkA, rvA, rigA, rfgA); body(jj + 1, rkB, rvB, rigB, rfgB); }
        __syncthreads(); CST_FLUSH(u0 + 7);
        SIDE_FLUSH();
        { const int kb = C.wave & 1, vb = C.wave >> 1; float* dst = TOTC + (size_t)vc * 8192 + (size_t)(vb * 32 + r) * 64 + kb * 32 + 4 * h;
#pragma unroll
            for (int g = 0; g < 4; ++g) *(f32x4*)(dst + 8 * g) = (f32x4){crun[4 * g], crun[4 * g + 1], crun[4 * g + 2], crun[4 * g + 3]}; }
        if (tid < 64) TOTN[vc * 64 + tid] = nrun;
        if (tid == 0) { MS[MS_TOTM + vc] = mrun; MS[MS_TOTG + vc] = drun; }
    }
#undef ST_FETCH
#undef CST_FLUSH
#undef SIDE_STEP
#undef SIDE_FLUSH
#undef SIDE_OUT
    __syncthreads();
}

__device__ __forceinline__ void p_mlstm_out_seq(const Ctx& C, int l) {
    const bf16* proj = (const bf16*)(C.ws + WS_PROJ); const float* G = (const float*)(C.ws + WS_G);
    const bf16* CST = (const bf16*)(C.ws + WS_CST); const float* NST = (const float*)(C.ws + WS_NST); const float* MS = (const float*)(C.ws + WS_MISC); const float* MPREV = MS + 4096;
    const float* TOTC = (const float*)(C.ws + WS_TOTC); const float* TOTN = (const float*)(C.ws + WS_TOTN);
    bf16* MIXIN = (bf16*)(C.ws + WS_MIXIN);
    const float* cw = C.in[I_CONVW] + (size_t)l * 4 * 512; const float* cb = C.in[I_CONVB] + (size_t)l * 512;
    LAS bf16* Qt = (LAS bf16*)(C.lds + RING_OFF);
    LAS bf16* Kt = Qt + 64 * TP;
    LAS bf16* St = Kt + 64 * TP;
    LAS bf16* Vt = St + 64 * TP;
    LAS bf16* Ct = Vt + 128 * TP;
    LAS float* sv = (LAS float*)(Ct + 128 * TP);
    const int tid = ltid(), lane = tid & 63, r = lane & 31, h = lane >> 5;
    const int s = tid >> 3, cg = tid & 7, s2 = tid & 63, vg = tid >> 6, cv = tid >> 2, ck0 = (tid & 3) * 16, ot = (C.wave & 1) * 32 + r, ovb = C.wave >> 1;
    v4u rq[4], rk[4], rv[2], rc[2], ro[2], rop[2]; float rig = 0.f, rfg = 0.f, rml = 0.f, rdc = 0.f, rnp = 0.f;
    LAS float* Os = sv + 640;
    LAS float* cwq = Os + 64 * 132; LAS float* cwk = cwq + 320;
    static_assert((3 * 64 + 2 * 128) * TP * 2 + 640 * 4 + 64 * 132 * 4 + 640 * 4 <= RING_BYTES, "mLSTM LDS");
#define OUT_FETCH(u_) do { const int bh_ = (u_) / NCH, c_ = (u_) % NCH, n0_ = (bh_ >> 2) * SEQ + c_ * CHUNK, hd_ = bh_ & 3; \
        conv_fetch(proj, n0_ + s, c_ * CHUNK + s, 1536 + hd_ * 64 + cg * 8, rq); conv_fetch(proj, n0_ + s, c_ * CHUNK + s, 1536 + 256 + hd_ * 64 + cg * 8, rk); \
        const bf16* vp_ = proj + (size_t)(n0_ + s2) * NPROJ + 2048 + hd_ * 128 + vg * 16; rv[0] = *(const v4u*)vp_; rv[1] = *(const v4u*)(vp_ + 8); \
        const v4u* cp_ = (const v4u*)(CST + (size_t)(u_) * 8192 + cv * 64 + ck0); rc[0] = cp_[0]; rc[1] = cp_[1]; \
        const bf16* op_ = proj + (size_t)(n0_ + s) * NPROJ + 2560 + hd_ * 128 + cg * 16; ro[0] = *(const v4u*)op_; ro[1] = *(const v4u*)(op_ + 8); \
        rml = MPREV[(u_)]; rdc = MS[MS_DCUM + (u_)]; \
        if (C.wave == 0) { rig = G[(size_t)(n0_ + lane) * 8 + hd_]; rfg = G[(size_t)(n0_ + lane) * 8 + 4 + hd_]; rnp = NST[(size_t)(u_) * 64 + lane]; } } while (0)
#define OUT_FLUSH(nb_) do { float hv_[16], og_[16]; const LAS f32x4* hp_ = (const LAS f32x4*)(Os + s * 132 + cg * 16); \
        _Pragma("unroll") for (int q_ = 0; q_ < 4; ++q_) { const f32x4 t4_ = hp_[q_]; hv_[4 * q_] = t4_.x; hv_[4 * q_ + 1] = t4_.y; hv_[4 * q_ + 2] = t4_.z; hv_[4 * q_ + 3] = t4_.w; } \
        unpack8(rop[0], og_); unpack8(rop[1], og_ + 8); _Pragma("unroll") for (int i_ = 0; i_ < 16; ++i_) hv_[i_] *= sigmoid_f(og_[i_]); \
        bf16* dp_ = MIXIN + (size_t)((nb_) + s) * DMODEL + 512 + hd * 128 + cg * 16; *(v4u*)dp_ = pack8(hv_); *(v4u*)(dp_ + 8) = pack8(hv_ + 8); } while (0)
    for (int vc = C.vcu; vc < 256; vc += C.G) {
        const int bh = vc >> 3, gi = vc & 7, b = bh >> 2, hd = bh & 3, u0 = bh * NCH + gi * 8;
        conv_stage(cwq, cw, cb, hd * 64, tid); conv_stage(cwk, cw, cb, 256 + hd * 64, tid);
        OUT_FETCH(u0);
        float cin[16], nin = 0.f, min_ = -INFINITY;
#pragma unroll
        for (int i = 0; i < 16; ++i) cin[i] = 0.f;
#pragma unroll 1
        for (int g2 = 0; g2 < gi; ++g2) { const int gv = (bh << 3) + g2; const float tm = MS[MS_TOTM + gv], tg = MS[MS_TOTG + gv];
            const f32x4* tp = (const f32x4*)(TOTC + (size_t)gv * 8192 + cv * 64 + ck0); const f32x4 t0 = tp[0], t1 = tp[1], t2 = tp[2], t3 = tp[3]; const float tn = (C.wave == 0) ? TOTN[gv * 64 + lane] : 0.f;
            const float mn = fmaxf(tg + min_, tm), fa = __expf(tg + min_ - mn), fb = __expf(tm - mn);
            const float tt[16] = {t0.x, t0.y, t0.z, t0.w, t1.x, t1.y, t1.z, t1.w, t2.x, t2.y, t2.z, t2.w, t3.x, t3.y, t3.z, t3.w};
#pragma unroll
            for (int i = 0; i < 16; ++i) cin[i] = fa * cin[i] + fb * tt[i];
            nin = fa * nin + fb * tn; min_ = mn; }
#pragma unroll 1
        for (int j = 0; j < 8; ++j) {
            const int u = u0 + j, c = gi * 8 + j; const int n0 = b * SEQ + c * CHUNK;
            const float mp = fmaxf(rdc + min_, rml); const float w1 = (min_ == -INFINITY) ? 0.f : __expf(rdc + min_ - mp), w2 = (rml == -INFINITY) ? 0.f : __expf(rml - mp);
            __syncthreads();
            if (j > 0) OUT_FLUSH(n0 - CHUNK);
            { float y[8];
                conv_apply_l(rq, cwq, cg * 8, 0.125f, y); *(LAS v4u*)(Qt + s * TP + cg * 8) = pack8(y);
                conv_apply_l(rk, cwk, cg * 8, 1.0f, y); *(LAS v4u*)(Kt + s * TP + cg * 8) = pack8(y);
                tr_store16(Vt, vg * 16, s2, rv[0], rv[1]);
                float cl[16]; unpack8(rc[0], cl); unpack8(rc[1], cl + 8);
#pragma unroll
                for (int i = 0; i < 16; ++i) cl[i] = w1 * cin[i] + w2 * cl[i];
                *(LAS v4u*)(Ct + cv * TP + ck0) = pack8(cl); *(LAS v4u*)(Ct + cv * TP + ck0 + 8) = pack8(cl + 8);
                rop[0] = ro[0]; rop[1] = ro[1]; }
            if (C.wave == 0) { const float ig = rig, fg = rfg;
                float bc = fminf(fg, 0.f) - log1pf(expf(-fabsf(fg)));
                bc = wave_scan_add(bc);
                const float a = ig - bc; float pm = a;
                pm = wave_scan_max(pm);
                const float mt = bc + fmaxf(mp, pm);
                sv[lane] = bc; sv[64 + lane] = a; sv[128 + lane] = mt; sv[192 + lane] = __expf(bc + mp - mt); sv[256 + lane] = w1 * nin + w2 * rnp; }
            if (j < 7) OUT_FETCH(u + 1);
            __syncthreads();
            if (C.wave < 4) {
                const int sb = C.wave & 1, tb = C.wave >> 1; f32x16 x;
#pragma unroll
                for (int i = 0; i < 16; ++i) x[i] = 0.f;
#pragma unroll
                for (int st = 0; st < 4; ++st) x = MFMA32(frag_ld(Kt, sb * 32 + r, st, h), frag_ld(Qt, tb * 32 + r, st, h), x);
                const int t = tb * 32 + r; const float bt = sv[t] - sv[128 + t]; float dsum = 0.f;
#pragma unroll
                for (int g = 0; g < 4; ++g) { const int s0 = sb * 32 + 8 * g + 4 * h; float w[4];
#pragma unroll
                    for (int i = 0; i < 4; ++i) { const int ss = s0 + i; w[i] = (ss <= t) ? x[4 * g + i] * __expf(sv[64 + ss] + bt) : 0.f; }
                    const unsigned p0 = pk2(w[0], w[1]), p1 = pk2(w[2], w[3]); dsum += (bflo(p0) + bfhi(p0)) + (bflo(p1) + bfhi(p1));
                    *(LAS v2u*)(St + t * TP + s0) = (v2u){p0, p1}; }
                sv[384 + (sb * 2 + h) * 64 + t] = dsum;
            } else if (tid < 320) {
                const int t = tid - 256; float a = 0.f;
#pragma unroll 8
                for (int k = 0; k < 64; k += 2) { const unsigned w = *(const LAS unsigned*)(Qt + t * TP + k); a += bflo(w) * sv[256 + k] + bfhi(w) * sv[256 + k + 1]; }
                sv[320 + t] = a; }
            __syncthreads();
            {
                const int vb = C.wave >> 1, tb = C.wave & 1; f32x16 acc;
#pragma unroll
                for (int i = 0; i < 16; ++i) acc[i] = 0.f;
#pragma unroll
                for (int st = 0; st < 4; ++st) acc = MFMA32(frag_ld(Ct, vb * 32 + r, st, h), frag_ld(Qt, tb * 32 + r, st, h), acc);
                const int t = tb * 32 + r; const float iw = sv[192 + t];
#pragma unroll
                for (int i = 0; i < 16; ++i) acc[i] *= iw;
#pragma unroll
                for (int st = 0; st < 4; ++st) acc = MFMA32(frag_ld(Vt, vb * 32 + r, st, h), frag_ld(St, tb * 32 + r, st, h), acc);
                const float den = ((sv[384 + t] + sv[384 + 64 + t]) + (sv[384 + 128 + t] + sv[384 + 192 + t])) + iw * sv[320 + t];
                const float dn = 1.0f / fmaxf(fabsf(den), __expf(-sv[128 + t]));
                LAS float* od = Os + t * 132 + vb * 32 + 4 * h;
#pragma unroll
                for (int g = 0; g < 4; ++g) *(LAS f32x4*)(od + 8 * g) = (f32x4){acc[4 * g] * dn, acc[4 * g + 1] * dn, acc[4 * g + 2] * dn, acc[4 * g + 3] * dn}; }
        }
        __syncthreads();
        OUT_FLUSH(b * SEQ + (gi * 8 + 7) * CHUNK);
    }
#undef OUT_FETCH
#undef OUT_FLUSH
    __syncthreads();
}
template <int W> __device__ __forceinline__ void tr_reduce_step(float* val, bool bit, int mask) {
#pragma unroll
    for (int i = 0; i < W / 2; ++i) { const float keep = bit ? val[i + W / 2] : val[i], send = bit ? val[i] : val[i + W / 2]; val[i] = keep + __shfl_xor(send, mask); }
}
__device__ __forceinline__ void p_ln1_router(const Ctx& C, int l, bool claim = true, bool norouter = false, bool nostore = false, bool norows = false, int stsel = 3) {
    const bf16* XBr = (const bf16*)(C.ws + WS_XB); const unsigned char* XLO = (const unsigned char*)(C.ws + WS_XRES);
    const bf16* MIXO = (const bf16*)(C.ws + WS_MIXO); float* X1 = (float*)(C.ws + WS_X1); unsigned char* X1Q = (unsigned char*)(C.ws + WS_X1B);
    int* TOKE = (int*)(C.ws + WS_TOKE); int* TOKP = (int*)(C.ws + WS_TOKP); float* TOKG = (float*)(C.ws + WS_TOKG); int* ROWTOK = (int*)(C.ws + WS_ROWTOK);
    unsigned* cntg = (unsigned*)(C.ws + WS_CTL) + CW_CNT + 64 * l;
    const float* br = C.in[I_BR] + l * NEXP;
    LAS f32x4* wl = (LAS f32x4*)(C.lds + RING_OFF);
    LAS float* lg = (LAS float*)(C.lds + LDSX_OFF) + C.wave * (16 * 32);
    LAS int* lc = (LAS int*)(C.lds + LDSX_OFF + 8 * 16 * 32 * 4);
    const int tid = ltid(), lane = tid & 63;
    { const f32x4* WRP = (const f32x4*)(C.ws + WS_WRP) + (size_t)l * 8192;
        for (int idx = tid; idx < 8192; idx += NTHREADS) wl[idx] = WRP[idx]; }
    LAS f32x4* gbl = (LAS f32x4*)(C.lds + LDSX_OFF + 8 * 16 * 32 * 4 + 512);
    { float g_[16], b_[16]; load_vec16(C.in[I_LN1G] + l * DMODEL, lane, g_); load_vec16(C.in[I_LN1B] + l * DMODEL, lane, b_);
      if (C.wave == 0) {
#pragma unroll
        for (int q = 0; q < 4; ++q) { gbl[q * 64 + lane] = (f32x4){g_[4 * q], g_[4 * q + 1], g_[4 * q + 2], g_[4 * q + 3]}; gbl[(4 + q) * 64 + lane] = (f32x4){b_[4 * q], b_[4 * q + 1], b_[4 * q + 2], b_[4 * q + 3]}; } } }
    const int gw = C.vcu * NWAVES + C.wave, NGW = C.G * NWAVES, NGRP = NTOK / 4;
    for (int g0 = gw; g0 < NGRP; g0 += 4 * NGW) {
        if (tid < 64) lc[tid] = 0;
        __syncthreads();
        v4u pxb[4][2], pmx[4][2]; v2u plo[4][2] = {};
#define LN1_FETCH(grp_) do { _Pragma("unroll") for (int r = 0; r < 4; ++r) { const size_t n_ = (size_t)((grp_) * 4 + r) * DMODEL; \
            pxb[r][0] = __builtin_nontemporal_load((const v4u*)(XBr + n_ + 8 * lane)); pxb[r][1] = __builtin_nontemporal_load((const v4u*)(XBr + n_ + 512 + 8 * lane)); if (USE_XLO) { plo[r][0] = *(const v2u*)(XLO + n_ + 8 * lane); plo[r][1] = *(const v2u*)(XLO + n_ + 512 + 8 * lane); } \
            pmx[r][0] = __builtin_nontemporal_load((const v4u*)(MIXO + n_ + 8 * lane)); pmx[r][1] = __builtin_nontemporal_load((const v4u*)(MIXO + n_ + 512 + 8 * lane)); } } while (0)
        LN1_FETCH(g0);
#pragma unroll 1
        for (int blk = norows ? 4 : 0; blk < 4; ++blk) {
            const int grp = g0 + blk * NGW; if (grp >= NGRP) break;
            float xv[4][16];
#pragma unroll
            for (int r = 0; r < 4; ++r) { const size_t n = (size_t)(grp * 4 + r); float m[16]; typedef float f32x2_ __attribute__((ext_vector_type(2)));
                unpack8(pxb[r][0], xv[r]); unpack8(pxb[r][1], xv[r] + 8); unpack8(pmx[r][0], m); unpack8(pmx[r][1], m + 8);
                const unsigned w_[4] = {plo[r][0].x, plo[r][0].y, plo[r][1].x, plo[r][1].y};
#pragma unroll
                for (int i = 0; i < (USE_XLO ? 4 : 0); ++i) { const f32x2_ lo = __builtin_amdgcn_cvt_pk_f32_fp8((int)w_[i], false), hi = __builtin_amdgcn_cvt_pk_f32_fp8((int)w_[i], true);
                    xv[r][4 * i] += lo.x * (1.0f / XLO_SCALE); xv[r][4 * i + 1] += lo.y * (1.0f / XLO_SCALE); xv[r][4 * i + 2] += hi.x * (1.0f / XLO_SCALE); xv[r][4 * i + 3] += hi.y * (1.0f / XLO_SCALE); }
#pragma unroll
                for (int i = 0; i < 16; ++i) xv[r][i] = DN_ALPHA * xv[r][i] + m[i];
                { float gam[16], bet[16];
#pragma unroll
                  for (int q = 0; q < 4; ++q) { const f32x4 g4_ = gbl[q * 64 + lane], b4_ = gbl[(4 + q) * 64 + lane]; gam[4 * q] = g4_.x; gam[4 * q + 1] = g4_.y; gam[4 * q + 2] = g4_.z; gam[4 * q + 3] = g4_.w; bet[4 * q] = b4_.x; bet[4 * q + 1] = b4_.y; bet[4 * q + 2] = b4_.z; bet[4 * q + 3] = b4_.w; }
                  ln_row(xv[r], gam, bet); }
                if (!nostore) { typedef float f32x2q __attribute__((ext_vector_type(2)));
                    const v2u p0 = pack8_fp8(xv[r], XQ_SCALE), p1 = pack8_fp8(xv[r] + 8, XQ_SCALE); __builtin_nontemporal_store(p0, (v2u*)(X1Q + n * DMODEL + 8 * lane)); __builtin_nontemporal_store(p1, (v2u*)(X1Q + n * DMODEL + 512 + 8 * lane));
                    const unsigned pw_[4] = {p0.x, p0.y, p1.x, p1.y}; float rem_[16];
#pragma unroll
                    for (int i = 0; i < 4; ++i) { const f32x2q lo = __builtin_amdgcn_cvt_pk_f32_fp8((int)pw_[i], false), hi = __builtin_amdgcn_cvt_pk_f32_fp8((int)pw_[i], true);
                        rem_[4 * i] = xv[r][4 * i] - lo.x * (1.0f / XQ_SCALE); rem_[4 * i + 1] = xv[r][4 * i + 1] - lo.y * (1.0f / XQ_SCALE); rem_[4 * i + 2] = xv[r][4 * i + 2] - hi.x * (1.0f / XQ_SCALE); rem_[4 * i + 3] = xv[r][4 * i + 3] - hi.y * (1.0f / XQ_SCALE); }
                    if (MK_X1R8) { unsigned char* rr_ = (unsigned char*)X1 + n * DMODEL; __builtin_nontemporal_store(pack8_fp8(rem_, X1R_SCALE), (v2u*)(rr_ + 8 * lane)); __builtin_nontemporal_store(pack8_fp8(rem_ + 8, X1R_SCALE), (v2u*)(rr_ + 512 + 8 * lane)); }
                    else { bf16* rr_ = (bf16*)X1 + n * DMODEL; __builtin_nontemporal_store(pack8(rem_), (v4u*)(rr_ + 8 * lane)); __builtin_nontemporal_store(pack8(rem_ + 8), (v4u*)(rr_ + 512 + 8 * lane)); }   } else if (xv[r][0] == 123.456f) X1[n * DMODEL + lane] = xv[r][1]; }
            if (blk < 3 && g0 + (blk + 1) * NGW < NGRP) LN1_FETCH(g0 + (blk + 1) * NGW);
            typedef float f32x2p __attribute__((ext_vector_type(2)));
            f32x2p xa[16], xb[16];
#pragma unroll
            for (int i = 0; i < 16; ++i) { xa[i] = (f32x2p){xv[0][i], xv[1][i]}; xb[i] = (f32x2p){xv[2][i], xv[3][i]}; }
#pragma unroll 1
            for (int q = norouter ? 4 : 0; q < 4; ++q) {
                float acc[32];
#pragma unroll
                for (int e = 0; e < 8; ++e) { const LAS f32x4* wp = wl + ((q * 8 + e) * 4) * 64 + lane; const f32x4 w0 = wp[0], w1 = wp[64], w2 = wp[128], w3 = wp[192];
                    const float ww[16] = {w0.x, w0.y, w0.z, w0.w, w1.x, w1.y, w1.z, w1.w, w2.x, w2.y, w2.z, w2.w, w3.x, w3.y, w3.z, w3.w};
                    f32x2p a = xa[0] * ww[0], b = xb[0] * ww[0];
#pragma unroll
                    for (int i = 1; i < 16; ++i) { a += xa[i] * ww[i]; b += xb[i] * ww[i]; }
                    acc[0 * 8 + e] = a.x; acc[1 * 8 + e] = a.y; acc[2 * 8 + e] = b.x; acc[3 * 8 + e] = b.y; }
                tr_reduce_step<32>(acc, (lane >> 4) & 1, 16); tr_reduce_step<16>(acc, (lane >> 3) & 1, 8); tr_reduce_step<8>(acc, (lane >> 2) & 1, 4); tr_reduce_step<4>(acc, (lane >> 1) & 1, 2); tr_reduce_step<2>(acc, lane & 1, 1);
                const float tot = acc[0] + __shfl_xor(acc[0], 32);
                if (lane < 32) lg[(blk * 4 + (lane >> 3)) * 32 + q * 8 + (lane & 7)] = tot + br[q * 8 + (lane & 7)];
            }
        }
#undef LN1_FETCH
        LDS_WAIT(); asm volatile("" ::: "memory");
        int te[4] = {0, 0, 0, 0}, tp[4] = {0, 0, 0, 0}; float tg[4] = {0.f, 0.f, 0.f, 0.f};
        if (lane < 16 && (g0 + (lane >> 2) * NGW) < NGRP) {
            float lv[32];
#pragma unroll
            for (int e = 0; e < 32; ++e) lv[e] = lg[lane * 32 + e];
            unsigned taken = 0u; float val[4];
#pragma unroll
            for (int k = 0; k < 4; ++k) { int bi = 0; float bv = -INFINITY;
#pragma unroll
                for (int e = 0; e < 32; ++e) { const bool ok = !((taken >> e) & 1u) && (lv[e] > bv); bv = ok ? lv[e] : bv; bi = ok ? e : bi; }
                te[k] = bi; val[k] = bv; taken |= 1u << bi; }
            float s = 0.f;
#pragma unroll
            for (int k = 0; k < 4; ++k) { tg[k] = expf(val[k] - val[0]); s += tg[k]; }
#pragma unroll
            for (int k = 0; k < 4; ++k) { tg[k] = tg[k] / s; tp[k] = __hip_atomic_fetch_add(lc + te[k], 1, __ATOMIC_RELAXED, __HIP_MEMORY_SCOPE_WORKGROUP); }
        }
        __syncthreads();
        if (tid < 32 && claim) lc[32 + tid] = (int)__hip_atomic_fetch_add(cntg + tid, (unsigned)lc[tid], __ATOMIC_RELAXED, __HIP_MEMORY_SCOPE_AGENT);
        __syncthreads();
        const int mygrp = g0 + (lane >> 2) * NGW;
        if (lane < 16 && claim && mygrp < NGRP) { const int n = mygrp * 4 + (lane & 3);
#pragma unroll
            for (int k = 0; k < 4; ++k) { const int pos = lc[32 + te[k]] + tp[k]; TOKE[n * 4 + k] = te[k]; TOKP[n * 4 + k] = pos; TOKG[n * 4 + k] = tg[k]; ROWTOK[(size_t)te[k] * NTOK + pos] = n; } }
        __syncthreads();
    }
}

__device__ __forceinline__ void moe_tables(const Ctx& C, int l) {
    LAS int* ts = (LAS int*)(C.lds + LDSCTL_OFF); LAS int* cn = (LAS int*)(C.lds + LDSCTL_OFF + 160);
    const unsigned* cntg = (const unsigned*)(C.ws + WS_CTL) + CW_CNT + 64 * l;
    const int tid = ltid();
    if (tid < 64) { const int lane = tid; const int c = (lane < 32) ? (int)__hip_atomic_load(cntg + lane, __ATOMIC_RELAXED, __HIP_MEMORY_SCOPE_AGENT) : 0; int t = (c + 255) >> 8;
        int inc = t;
#pragma unroll
        for (int o = 1; o < 64; o <<= 1) { const int x = __shfl_up(inc, o); if (lane >= o) inc += x; }
        if (lane < 32) { cn[lane] = c; ts[lane] = inc - t; } if (lane == 32) ts[32] = inc; }
    __syncthreads();
}

__device__ __forceinline__ void p_ln2_combine(const Ctx& C, int l) {
    const bf16* X1 = (const bf16*)(C.ws + WS_X1); const unsigned char* X1Q = (const unsigned char*)(C.ws + WS_X1B); const unsigned char* Y = (const unsigned char*)(C.ws + WS_Y);
    const int* TOKE = (const int*)(C.ws + WS_TOKE); const int* TOKP = (const int*)(C.ws + WS_TOKP); const float* TOKG = (const float*)(C.ws + WS_TOKG);
    float* xo = C.out; unsigned char* XLOw = (unsigned char*)(C.ws + WS_XRES); bf16* XB = (bf16*)(C.ws + WS_XB); float* G = (float*)(C.ws + WS_G);
    const LAS int* ts = (const LAS int*)(C.lds + LDSCTL_OFF);
    LAS f32x4* wgl = (LAS f32x4*)(C.lds + RING_OFF);
    const int tid = ltid(), lane = tid & 63, gw = C.vcu * NWAVES + C.wave, NGW = C.G * NWAVES; const bool nextl = (l + 1 < DEPTH);
    if (nextl) load_gate_w(tid, C.in[I_WIN] + (size_t)(l + 1) * DMODEL * INW, wgl);
    __syncthreads();
    float gam[16], bet[16]; load_vec16(C.in[I_LN2G] + l * DMODEL, lane, gam); load_vec16(C.in[I_LN2B] + l * DMODEL, lane, bet);
    typedef int i32x4_ __attribute__((ext_vector_type(4)));
    i32x4_ ne[2], np[2]; f32x4 ng_[2];
#define LN2_ROUTE(n0_) do { _Pragma("unroll") for (int q = 0; q < 2; ++q) { int nn = (n0_) + q * NGW; nn = nn < NTOK ? nn : (NTOK - 1); ne[q] = *(const i32x4_*)(TOKE + nn * 4); np[q] = *(const i32x4_*)(TOKP + nn * 4); ng_[q] = *(const f32x4*)(TOKG + nn * 4); } } while (0)
    LN2_ROUTE(gw);
    for (int n = gw; n < NTOK; n += 2 * NGW) {
        v4u xr[2][2]; v2u xr8[2][2]; v2u xq[2][2]; v2u yr[2][4][2]; f32x4 g4[2]; int nrow[2];
#pragma unroll
        for (int q = 0; q < 2; ++q) { int nn = n + q * NGW; nn = nn < NTOK ? nn : (NTOK - 1); nrow[q] = nn; g4[q] = ng_[q];
            if (MK_X1R8) { const unsigned char* xp = (const unsigned char*)X1 + (size_t)nn * DMODEL; xr8[q][0] = __builtin_nontemporal_load((const v2u*)(xp + 8 * lane)); xr8[q][1] = __builtin_nontemporal_load((const v2u*)(xp + 512 + 8 * lane)); }
            else { const bf16* xp = X1 + (size_t)nn * DMODEL; xr[q][0] = __builtin_nontemporal_load((const v4u*)(xp + 8 * lane)); xr[q][1] = __builtin_nontemporal_load((const v4u*)(xp + 512 + 8 * lane)); }
            const unsigned char* xqp = X1Q + (size_t)nn * DMODEL; xq[q][0] = __builtin_nontemporal_load((const v2u*)(xqp + 8 * lane)); xq[q][1] = __builtin_nontemporal_load((const v2u*)(xqp + 512 + 8 * lane));
#pragma unroll
            for (int k = 0; k < 4; ++k) { const unsigned char* yp = Y + ((size_t)ts[ne[q][k]] * 256 + np[q][k]) * DMODEL; yr[q][k][0] = __builtin_nontemporal_load((const v2u*)(yp + 8 * lane)); yr[q][k][1] = __builtin_nontemporal_load((const v2u*)(yp + 512 + 8 * lane)); } }
        if (n + 2 * NGW < NTOK) LN2_ROUTE(n + 2 * NGW);
#pragma unroll
        for (int q = 0; q < 2; ++q) {
            if (q == 1 && n + NGW >= NTOK) break;
            typedef float f32x2_ __attribute__((ext_vector_type(2)));
            float v[16];
            if (MK_X1R8) { const unsigned w[4] = {xr8[q][0].x, xr8[q][0].y, xr8[q][1].x, xr8[q][1].y};
#pragma unroll
              for (int i = 0; i < 4; ++i) { const f32x2_ lo = __builtin_amdgcn_cvt_pk_f32_fp8((int)w[i], false), hi = __builtin_amdgcn_cvt_pk_f32_fp8((int)w[i], true);
                  v[4 * i] = lo.x * (1.0f / X1R_SCALE); v[4 * i + 1] = lo.y * (1.0f / X1R_SCALE); v[4 * i + 2] = hi.x * (1.0f / X1R_SCALE); v[4 * i + 3] = hi.y * (1.0f / X1R_SCALE); } }
            else { unpack8(xr[q][0], v); unpack8(xr[q][1], v + 8); }
            { const unsigned w[4] = {xq[q][0].x, xq[q][0].y, xq[q][1].x, xq[q][1].y};
#pragma unroll
              for (int i = 0; i < 4; ++i) { const f32x2_ lo = __builtin_amdgcn_cvt_pk_f32_fp8((int)w[i], false), hi = __builtin_amdgcn_cvt_pk_f32_fp8((int)w[i], true);
                  v[4 * i] += lo.x * (1.0f / XQ_SCALE); v[4 * i + 1] += lo.y * (1.0f / XQ_SCALE); v[4 * i + 2] += hi.x * (1.0f / XQ_SCALE); v[4 * i + 3] += hi.y * (1.0f / XQ_SCALE); } }
#pragma unroll
            for (int i = 0; i < 16; ++i) v[i] *= DN_ALPHA;
#pragma unroll
            for (int k = 0; k < 4; ++k) { const float gk = g4[q][k] * (1.0f / YQ_SCALE); const unsigned w[4] = {yr[q][k][0].x, yr[q][k][0].y, yr[q][k][1].x, yr[q][k][1].y};
#pragma unroll
                for (int i = 0; i < 4; ++i) { const f32x2_ lo = __builtin_amdgcn_cvt_pk_f32_fp8((int)w[i], false), hi = __builtin_amdgcn_cvt_pk_f32_fp8((int)w[i], true);
                    v[4 * i] += gk * lo.x; v[4 * i + 1] += gk * lo.y; v[4 * i + 2] += gk * hi.x; v[4 * i + 3] += gk * hi.y; } }
            ln_row(v, gam, bet);
            const int nn = nrow[q];
            if (!nextl) store_row_f32_nt(xo + (size_t)nn * DMODEL, lane, v);
            if (nextl) { store_row_bf16_nt(XB + (size_t)nn * DMODEL, lane, v); { float lo_[16];
#pragma unroll
                for (int i = 0; i < 16; ++i) lo_[i] = v[i] - __uint_as_float(f2bf(v[i]) << 16);
                if (USE_XLO) store_row_fp8(XLOw + (size_t)nn * DMODEL, lane, lo_, XLO_SCALE);
                store_row_fp8_nt((unsigned char*)(C.ws + WS_XQ) + (size_t)nn * DMODEL, lane, v, XQ_SCALE); }
                gates_row(v, wgl, C.in[I_GATEB] + (l + 1) * 8, G + (size_t)nn * 8, lane); }
        }
    }
#undef LN2_ROUTE
    __syncthreads();
}
#ifndef MK_RELMODE
#define MK_RELMODE 0
#endif
__device__ __forceinline__ void xcd_barrier_w(const XcdBarrier& b, const Ctx& C, volatile LAS unsigned* rel, int minitems = 0) {
    asm volatile("s_waitcnt vmcnt(0)" ::: "memory");
    if (threadIdx.x == 0) *rel = 0u;
    __syncthreads();
    if (C.wave == 0) {
        if (threadIdx.x == 0) {
            unsigned* bar = b.bar;
            __builtin_amdgcn_s_waitcnt(0);
            unsigned nloc = b.st[0], nx = b.st[1];
            if (nloc == 0u) { xcd_barrier_complete(bar, b.x, nloc, nx); b.st[0] = nloc; b.st[1] = nx; }
            const unsigned old = xb_add(&bar[XB_XSUB(b.x)], 1u);
            const unsigned gen = old / nloc;
            if (old + 1u == (gen + 1u) * nloc) {
                if (MK_RELMODE == 0) *rel = 1u;
                __builtin_amdgcn_fence(__ATOMIC_RELEASE, "agent");
                asm volatile("s_waitcnt vmcnt(0)" ::: "memory");
                const unsigned og = xb_add(&bar[XB_TOP], 1u);
                const unsigned tg = og / nx;
                if (og + 1u == (tg + 1u) * nx) xb_add(&bar[XB_TOPGEN], 1u);
                else XB_SPIN(xb_ld(&bar[XB_TOPGEN]) == tg, bar);
                *rel = 1u;
                __builtin_amdgcn_fence(__ATOMIC_ACQUIRE, "agent");
                xb_add(&bar[XB_XGEN(b.x)], 1u);
                asm volatile("s_waitcnt vmcnt(0)" ::: "memory");
            } else {
                if (MK_RELMODE == 0) { XB_SPIN(xb_ld(&bar[XB_XSUB(b.x)]) < (gen + 1u) * nloc, bar);
                    *rel = 1u; }
                XB_SPIN(xb_ld(&bar[XB_XGEN(b.x)]) == gen, bar);
                *rel = 1u;
                __builtin_amdgcn_fence(__ATOMIC_ACQUIRE, "agent");
                asm volatile("s_waitcnt vmcnt(0)" ::: "memory");
            }
        }
    } else {
        const int lane = ltid() & 63, total = TRQ_LAYERS * trq_per(C); LAS float* scr = (LAS float*)(C.lds + RING_OFF + (C.wave - 1) * 16896);
        int done = 0;
        while (done < minitems || *rel == 0u) { const int q = trq_grab(C, lane); if (q >= total) break; const int r = trq_item(C, q); if (r >= 0) tr_one(C, r, scr, lane); ++done; }
    }
    __syncthreads();
}

struct Args { const float* in[21]; float* out; unsigned char* ws; int ph_lo, ph_hi, li, pad; };
__global__ void __launch_bounds__(NTHREADS, 2) mega_fwd(Args args) {
    extern __shared__ __attribute__((aligned(16))) unsigned char lds[];
    Ctx C;
    C.lds = (LAS unsigned char*)lds; C.wave = __builtin_amdgcn_readfirstlane(threadIdx.x >> 6);
    C.G = gridDim.x; { const int bx = blockIdx.x; C.vcu = (C.G % 8 == 0) ? (bx % 8) * (C.G / 8) + bx / 8 : bx; }
    C.ws = args.ws; C.in = args.in; C.out = args.out;
    volatile LAS unsigned* MISC = (volatile LAS unsigned*)(C.lds + MISC_OFF);
    for (int u = threadIdx.x; u < (LDSX_OFF - LDSCTL_OFF) / 4; u += NTHREADS) ((LAS unsigned*)(C.lds + LDSCTL_OFF))[u] = 0u;
    __syncthreads();
    unsigned* ctl = (unsigned*)(C.ws + WS_CTL);
    XcdBarrier bar = xcd_barrier_post(ctl + CW_BAR + args.li * XCD_BAR_WORDS, MISC + 8);
    const int lo = args.ph_lo, hi = args.ph_hi;
#define IN(k) (lo <= (k) && (k) < hi)
#ifndef MK_DBL
#define MK_DBL -1
#endif
#define REP(kind) _Pragma("unroll 1") for (int rep_ = 0; rep_ < ((kind) == MK_DBL ? 2 : 1); ++rep_)
#ifdef MK_PROBE_A
    LAS unsigned long long* tacc = (LAS unsigned long long*)(C.lds + LDSX_OFF + 20480);
    if (blockIdx.x == 0 && threadIdx.x == 0) { for (int i = 0; i < 16; ++i) tacc[i] = 0ull; tacc[14] = tacc[15] = wall_clock64(); }
#define stamper (blockIdx.x == 0 && threadIdx.x == 0)
#define STAMP(kind) do { if (stamper) { const unsigned long long now_ = wall_clock64(); tacc[kind] += now_ - tacc[14]; tacc[14] = now_; } } while (0)
#define SEAM(k) do { if (IN(k) && IN((k) + 1)) xcd_barrier(bar); STAMP((k) == 0 ? 0 : 1 + ((k) - 1) % NPH_LAYER); } while (0)
#else
#define STAMP(kind) do { } while (0)
#define SEAM(k) do { if (IN(k) && IN((k) + 1)) { xcd_barrier_w(bar, C, MISC + 10); if (MK_DBL == 12) xcd_barrier(bar); } } while (0)
#define SEAMW(k, n) do { if (IN(k) && IN((k) + 1)) { xcd_barrier_w(bar, C, MISC + 10, (n)); if (MK_DBL == 12) xcd_barrier(bar); } } while (0)
#ifndef MK_TAILITEMS
#define MK_TAILITEMS 3
#endif
#define MOE_IDLE(nN, xs) ((C.G == 256) ? ((((const LAS int*)(C.lds + LDSCTL_OFF))[32] + 8 * (32 / (nN)) - 1) / (8 * (32 / (nN))) - ((((const LAS int*)(C.lds + LDSCTL_OFF))[32] - ((int)blockIdx.x >> 3) / (nN) - ((((int)blockIdx.x & 7) + (xs)) & 7) * (32 / (nN)) + 8 * (32 / (nN)) - 1) / (8 * (32 / (nN))))) : 0)
#ifndef MK_DOWN_XS
#define MK_DOWN_XS 3
#endif
#endif
    if (IN(0)) { REP(0) p_prologue(C); SEAM(0); }
#pragma unroll 1
    for (int l = 0; l < DEPTH; ++l) {
        const int pb = 1 + l * NPH_LAYER;
        bf16* XB = (bf16*)(C.ws + WS_XB); bf16* PROJ = (bf16*)(C.ws + WS_PROJ);
        if (IN(pb + 0)) {
            { pg8::Gemm g{XB, (const bf16*)(C.ws + WS_WIN) + (size_t)l * NPROJ * DMODEL, NTOK, 2048, DMODEL}; pg8::StaticOrder S; S.init(NTOK, 2048, C.G, (int)blockIdx.x);
              pg8::EpiBf16<0> E{PROJ, NPROJ, nullptr, 512, 512, attn_body::C2};
              REP(1) pg8::gemm_phase<pg8::EpiBf16<0>, pg8::StaticOrder, true, true, false>(C.lds + RING_OFF, g, S, E); }
            { pg8::Gemm g{(const bf16*)(C.ws + WS_XQ), (const bf16*)(C.ws + WS_WINQ + (size_t)l * 1536 * DMODEL), NTOK, 1024, DMODEL / 2}; pg8::StaticOrder S; S.init(NTOK, 1024, C.G, (int)blockIdx.x);
              pg8::EpiBf16<0> E{PROJ + 2048, NPROJ, nullptr, 0, 0, 1.0f, 1.0f / (XQ_SCALE * WQ_SCALE)};
              REP(1) pg8::gemm_phase<pg8::EpiBf16<0>, pg8::StaticOrder, true, true, false, true>(C.lds + RING_OFF, g, S, E); }
            SEAM(pb + 0);
        }
        if (IN(pb + 1)) { REP(2) p_mlstm_states_seq(C, l); SEAM(pb + 1); }
        if (IN(pb + 3)) {
            REP(11) p_mlstm_out_seq(C, l); STAMP(11);
            { const int ln_ = ltid() & 63; const float s1 = wave_sum(C.in[I_LQ1][l * 64 + ln_] * C.in[I_LK1][l * 64 + ln_]), s2 = wave_sum(C.in[I_LQ2][l * 64 + ln_] * C.in[I_LK2][l * 64 + ln_]);
              const float lam_init = __uint_as_float(__builtin_amdgcn_readfirstlane(__float_as_uint(0.8f - 0.6f * expf(-0.3f * (float)l)))); const float lam = __uint_as_float(__builtin_amdgcn_readfirstlane(__float_as_uint(expf(s1) - expf(s2) + lam_init)));
              REP(4) for (int vc = C.vcu; vc < 256; vc += C.G) attn_body::attn_phase((char*)lds + RING_OFF, (const attn_body::bf16*)PROJ, (attn_body::bf16*)(C.ws + WS_ATTO), (attn_body::bf16*)(C.ws + WS_MIXIN), C.in[I_NG] + l * 128, lam, 1.0f - lam_init, vc); }
            SEAM(pb + 3);
        }
        if (IN(pb + 5)) {
#if MK_OUTFP8
            pg8::Gemm g{(const bf16*)(C.ws + WS_MIXIN), (const bf16*)(C.ws + WS_WOUT + (size_t)l * DMODEL * DMODEL), NTOK, DMODEL, DMODEL / 2}; pg8::StaticOrder S; S.init(NTOK, DMODEL, C.G, (int)blockIdx.x);
            pg8::EpiBf16<0> E{(bf16*)(C.ws + WS_MIXO), DMODEL, nullptr, 0, 0, 1.0f, 1.0f / (MQ_SCALE * WQ_SCALE)};
            REP(6) pg8::gemm_phase<pg8::EpiBf16<0>, pg8::StaticOrder, true, true, false, true>(C.lds + RING_OFF, g, S, E);
#else
            pg8::Gemm g{(const bf16*)(C.ws + WS_MIXIN), (const bf16*)(C.ws + WS_WOUT) + (size_t)l * DMODEL * DMODEL, NTOK, DMODEL, DMODEL}; pg8::StaticOrder S; S.init(NTOK, DMODEL, C.G, (int)blockIdx.x);
            pg8::EpiBf16<0> E{(bf16*)(C.ws + WS_MIXO), DMODEL, nullptr, 0, 0, 1.0f};
            REP(6) pg8::gemm_phase<pg8::EpiBf16<0>, pg8::StaticOrder, true, true, false>(C.lds + RING_OFF, g, S, E);
#endif
            SEAM(pb + 5);
        }
        if (IN(pb + 6)) { p_ln1_router(C, l); if (MK_DBL == 7) p_ln1_router(C, l, false); if (MK_DBL == 13) p_ln1_router(C, l, false, true); if (MK_DBL == 14) p_ln1_router(C, l, false, true, true); if (MK_DBL == 15) p_ln1_router(C, l, false, true, true, true); if (MK_DBL == 16) p_ln1_router(C, l, false, true, false, false, 1); if (MK_DBL == 17) p_ln1_router(C, l, false, true, false, false, 2); if (l > 0) trq_drain(C, l); SEAM(pb + 6); }
        if (IN(pb + 7)) {
            moe_tables(C, l);
            pg8::Gemm g{(const bf16*)(C.ws + WS_X1B), (const bf16*)(C.ws + WS_WGU + (size_t)l * NEXP * 2 * DFF * DMODEL), 0, 0, DMODEL / 2};
            pg8::MoeOrder S{(const LAS int*)(C.lds + LDSCTL_OFF), (const LAS int*)(C.lds + LDSCTL_OFF + 160), (const int*)(C.ws + WS_ROWTOK), 8, C.G, (int)blockIdx.x, NTOK, (LAS unsigned*)(C.lds + LDSX_OFF)};
            pg8::EpiSwiglu E{(bf16*)(C.ws + WS_H), DFF, C.in[I_BGU] + (size_t)l * NEXP * 2 * DFF, DFF, 1.0f / (XQ_SCALE * WQ_SCALE), HQ_SCALE, 0, (const LAS float*)(C.lds + LDSX_OFF + 16384)};
            REP(8) pg8::gemm_phase<pg8::EpiSwiglu, pg8::MoeOrder, true, true, true, true>(C.lds + RING_OFF, g, S, E);
            if (MK_DBL == 21) pg8::gemm_phase<pg8::EpiSwiglu, pg8::MoeOrder, true, true, true, true>(C.lds + RING_OFF, g, S, E);
            if (MK_DBL == 18 || MK_DBL == 19) { pg8::EpiSwiglu E2 = E; E2.dbg = (MK_DBL == 18) ? 2 : 1; pg8::gemm_phase<pg8::EpiSwiglu, pg8::MoeOrder, true, true, true, true>(C.lds + RING_OFF, g, S, E2); }
            SEAMW(pb + 7, MK_TAILITEMS * MOE_IDLE(8, 0));
        }
        if (IN(pb + 8)) {
            if (!IN(pb + 7)) moe_tables(C, l);
            pg8::Gemm g{(const bf16*)(C.ws + WS_H), (const bf16*)(C.ws + WS_WDN + (size_t)l * NEXP * DMODEL * DFF), 0, 0, DFF / 2};
            pg8::MoeOrder S{(const LAS int*)(C.lds + LDSCTL_OFF), (const LAS int*)(C.lds + LDSCTL_OFF + 160), (const int*)(C.ws + WS_ROWTOK), 4, C.G, (int)blockIdx.x, NTOK, (LAS unsigned*)(C.lds + LDSX_OFF), MK_DOWN_XS};
            pg8::EpiFp8 E{(bf16*)(C.ws + WS_Y), DMODEL, C.in[I_BDN] + (size_t)l * NEXP * DMODEL, DMODEL, 0, 1.0f, 1.0f / (HQ_SCALE * WQ_SCALE), 0, 0u, YQ_SCALE, (const LAS float*)(C.lds + LDSX_OFF + 16384)};
            REP(9) pg8::gemm_phase<pg8::EpiFp8, pg8::MoeOrder, true, true, false, true>(C.lds + RING_OFF, g, S, E);
            if (MK_DBL == 20) { pg8::EpiFp8 E2 = E; E2.dbg = 2; pg8::gemm_phase<pg8::EpiFp8, pg8::MoeOrder, true, true, false, true>(C.lds + RING_OFF, g, S, E2); }
            SEAMW(pb + 8, MK_TAILITEMS * MOE_IDLE(4, MK_DOWN_XS));
        }
        if (IN(pb + 9)) { if (!IN(pb + 7)) moe_tables(C, l); REP(10) p_ln2_combine(C, l); SEAM(pb + 9); }
    }
#ifdef MK_PROBE_A
    xcd_barrier(bar);
    if (stamper) { const unsigned long long now_ = wall_clock64(); tacc[10] += now_ - tacc[14]; const float tot = (float)(now_ - tacc[15]);
        __hip_atomic_store((float*)(ctl + 8), (float)tacc[MK_PROBE_A] / tot, __ATOMIC_RELAXED, __HIP_MEMORY_SCOPE_AGENT); __hip_atomic_store((float*)(ctl + 9), (float)tacc[MK_PROBE_B] / tot, __ATOMIC_RELAXED, __HIP_MEMORY_SCOPE_AGENT); }
    xcd_barrier(bar);
    { const float fa = __hip_atomic_load((float*)(ctl + 8), __ATOMIC_RELAXED, __HIP_MEMORY_SCOPE_AGENT), fb = __hip_atomic_load((float*)(ctl + 9), __ATOMIC_RELAXED, __HIP_MEMORY_SCOPE_AGENT);
        const size_t gid = (size_t)blockIdx.x * NTHREADS + threadIdx.x, nth = (size_t)gridDim.x * NTHREADS;
        for (size_t i = gid; i < (size_t)NTOK * DMODEL; i += nth) { float v = C.out[i] * (1.0f + 4.0f * fa); if (i == 0) v += 1000.0f * fb; C.out[i] = v; } }
#endif
#undef IN
#undef SEAM
}

#ifndef MK_MODE
#define MK_MODE 0
#endif
static int mega_grid() {
    static int grid = 0;
    if (grid == 0) {
        int dev = 0, cus = 0, per_cu = 0;
        if (hipGetDevice(&dev) != hipSuccess || hipDeviceGetAttribute(&cus, hipDeviceAttributeMultiprocessorCount, dev) != hipSuccess) { grid = -1; return grid; }
        if (hipFuncSetAttribute((const void*)mega_fwd, hipFuncAttributeMaxDynamicSharedMemorySize, LDS_BYTES) != hipSuccess) { fprintf(stderr, "kernel_launch: hipFuncSetAttribute failed\n"); grid = -1; return grid; }
        if (hipOccupancyMaxActiveBlocksPerMultiprocessor(&per_cu, (const void*)mega_fwd, NTHREADS, LDS_BYTES) != hipSuccess || per_cu < 1) fprintf(stderr, "kernel_launch: occupancy query reports %d\n", per_cu);
        (void)hipGetLastError();
        grid = cus;
    }
    return grid;
}
static void mega_launch(void* const* d_in, float* d_out, unsigned char* ws, hipStream_t stream, int lo, int hi, int li) {
    const int grid = mega_grid(); if (grid <= 0) return;
    Args a{};
    for (int i = 0; i < 21; ++i) a.in[i] = (const float*)d_in[i];
    a.out = d_out; a.ws = ws; a.ph_lo = lo; a.ph_hi = hi; a.li = li; a.pad = 0;
    hipLaunchKernelGGL(mega_fwd, dim3(grid), dim3(NTHREADS), LDS_BYTES, stream, a);
    const hipError_t le = hipPeekAtLastError();
    if (le != hipSuccess) fprintf(stderr, "kernel_launch: launch failed: %s\n", hipGetErrorName(le));
}
extern "C" void kernel_launch(void* const* d_in, const int* in_sizes, int n_in, void* d_out, int out_size, void* d_ws, size_t ws_size, hipStream_t stream) {
    if (n_in != 21 || in_sizes[0] != NTOK * DMODEL || out_size != NTOK * DMODEL || ws_size < WS_END) { fprintf(stderr, "kernel_launch: unexpected shapes (n_in %d, ws %zu)\n", n_in, ws_size); return; }
    unsigned char* ws = (unsigned char*)d_ws;
    if (hipMemsetAsync(ws + WS_CTL, 0, CTL_ZERO_BYTES, stream) != hipSuccess) { fprintf(stderr, "kernel_launch: memset failed\n"); return; }
#if MK_MODE == 0
    mega_launch(d_in, (float*)d_out, ws, stream, 0, NPHASES, 0);
#else
    for (int ph = 0; ph < NPHASES; ++ph) mega_launch(d_in, (float*)d_out, ws, stream, ph, ph + 1, 0);
#endif
}
```
